# Optimizing an MI355X kernel written in HIP

```python
import math
import jax, jax.numpy as jnp
from jax import lax
import numpy as np

D_MODEL = 1024
BATCH = 8
SEQ = 2048
DEPTH = 4

N_MIXERS = 2
N_RWKV_LAYERS = (DEPTH + 1) // 2
N_ATTN_LAYERS = DEPTH // 2
RMS_EPS = 1e-6
N_MOD = 6

RWKV_HEAD = 64
RWKV_HEADS = D_MODEL // RWKV_HEAD
D_DECAY_LORA = 64
D_AAA_LORA = 64
D_GATE_LORA = 128
RWKV_GN_EPS = 64e-5
N_DIRS = 2
N_SHIFT_MIX = 6

ATTN_GROUPS = ((128, 1), (512, 4), (2048, 16))
N_GROUPS = len(ATTN_GROUPS)
ATTN_HEADS = 8
ATTN_HEAD_DIM = D_MODEL // ATTN_HEADS
QKV_WIDTH = N_GROUPS * 3 * ATTN_HEADS * ATTN_HEAD_DIM
Q_BLOCK = 64
NEG_INF = -1e30

N_EXPERT_GROUPS = 4
EXPERTS_PER_GROUP = 8
TOP_K_INNER = 2
D_EXPERT = D_MODEL // 4

kernel_name = "hybrid_rwkv7_dilated_alibi_hmoe_encoder"


def rms_norm(x, g):
    x32 = x.astype(jnp.float32)
    y = x32 * lax.rsqrt(jnp.mean(x32 * x32, axis=-1, keepdims=True) + RMS_EPS)
    return (y * g.astype(jnp.float32)).astype(x.dtype)


def modulate(h, shift, scale):
    return h * (1.0 + scale[:, None, :]) + shift[:, None, :]


def _wkv7_scan(r, w, k, v, a, b, reverse):
    bsz, _, h, n = r.shape

    def step(state, inp):
        r_t, w_t, k_t, v_t, a_t, b_t = inp
        sa = jnp.einsum('bhvk,bhk->bhv', state, a_t)
        state = (state * w_t[:, :, None, :]
                 + sa[:, :, :, None] * b_t[:, :, None, :]
                 + v_t[:, :, :, None] * k_t[:, :, None, :])
        y_t = jnp.einsum('bhvk,bhk->bhv', state, r_t)
        return state, y_t

    s0 = jnp.zeros((bsz, h, n, n), jnp.float32)
    xs = tuple(jnp.moveaxis(t, 1, 0) for t in (r, w, k, v, a, b))
    _, ys = lax.scan(step, s0, xs, reverse=reverse)
    return jnp.moveaxis(ys, 0, 1)


def rwkv7_mix(h, mu, w_rkv, w0, w1, w2, a0, a1, a2, g1, g2, k_k, k_a, r_k, ln_w, ln_b, w_o):
    bsz, s, d = h.shape
    f32 = jnp.float32
    x_prev = jnp.pad(h, ((0, 0), (1, 0), (0, 0)))[:, :-1]
    x_next = jnp.pad(h, ((0, 0), (0, 1), (0, 0)))[:, 1:]
    xx = 0.5 * (x_prev + x_next) - h
    xs = h[:, :, None, :] + xx[:, :, None, :] * mu
    rkv = jnp.einsum('bsjd,jde->bsje', xs[:, :, :3], w_rkv)
    r, k, v = rkv[:, :, 0], rkv[:, :, 1], rkv[:, :, 2]
    xw, xa, xg = xs[:, :, 3], xs[:, :, 4], xs[:, :, 5]

    def lora(xin, A, Bm, act):
        return jnp.einsum('zbsr,zre->zbse', act(jnp.einsum('bsd,zdr->zbsr', xin, A)), Bm)

    w_log = -jax.nn.softplus(-(w0[:, None, None, :] + lora(xw, w1, w2, jnp.tanh)).astype(f32)) - 0.5
    decay = jnp.exp(-jnp.exp(w_log))
    a = jax.nn.sigmoid((a0[:, None, None, :] + lora(xa, a1, a2, lambda t: t)).astype(f32))
    g = lora(xg, g1, g2, jax.nn.sigmoid).astype(f32)

    def heads(t):
        return t.reshape(t.shape[:-1] + (RWKV_HEADS, RWKV_HEAD))

    r32, k32, v32 = (heads(t.astype(f32)) for t in (r, k, v))
    kk = k32 * heads(k_k.astype(f32))
    kk = kk / jnp.maximum(jnp.sqrt(jnp.sum(kk * kk, axis=-1, keepdims=True)), 1e-12)
    a_h, decay_h = heads(a), heads(decay)
    k_dir = k32[None] * (1.0 + (a_h - 1.0) * heads(k_a.astype(f32)))
    b_dir = kk[None] * a_h
    y_f = _wkv7_scan(r32, decay_h[0], k_dir[0], v32, -kk, b_dir[0], reverse=False)
    y_b = _wkv7_scan(r32, decay_h[1], k_dir[1], v32, -kk, b_dir[1], reverse=True)
    y = jnp.stack([y_f, y_b])
    mean = jnp.mean(y, axis=-1, keepdims=True)
    var = jnp.mean(jnp.square(y - mean), axis=-1, keepdims=True)
    y = (y - mean) * lax.rsqrt(var + RWKV_GN_EPS) * heads(ln_w.astype(f32)) + heads(ln_b.astype(f32))
    bonus = jnp.sum(r32[None] * k_dir * r_k.astype(f32), axis=-1, keepdims=True) * v32[None]
    o = jnp.sum(heads(g) * (y + bonus), axis=0).reshape(bsz, s, d)
    return jnp.einsum('bsd,de->bse', o.astype(h.dtype), w_o)


def alibi_slopes(n):
    return 2.0 ** (-8.0 * jnp.arange(1, n + 1, dtype=jnp.float32) / n)


def _dilated_group(q, k, v, slopes, window, dilation):
    bsz, s, h, dh = q.shape
    half = window // (2 * dilation)
    L = s // dilation
    nb = -(-L // Q_BLOCK)
    lp = nb * Q_BLOCK
    kb_len = Q_BLOCK + 2 * half

    def strided(t):
        return t.reshape(bsz, L, dilation, h, dh).transpose(0, 2, 3, 1, 4)

    qd = jnp.pad(strided(q), ((0, 0), (0, 0), (0, 0), (0, lp - L), (0, 0)))
    qd = qd.reshape(bsz, dilation, h, nb, Q_BLOCK, dh)
    pad_kv = ((0, 0), (0, 0), (0, 0), (half, lp - L + half), (0, 0))
    kd = jnp.pad(strided(k), pad_kv)
    vd = jnp.pad(strided(v), pad_kv)
    key_idx = jnp.arange(nb)[:, None] * Q_BLOCK + jnp.arange(kb_len)[None, :]
    kblk = kd[:, :, :, key_idx]
    vblk = vd[:, :, :, key_idx]
    scores = jnp.einsum('brhnqd,brhnkd->brhnqk', qd, kblk) * (dh ** -0.5)
    q_pos = jnp.arange(lp).reshape(nb, Q_BLOCK)
    k_pos = key_idx - half
    rel = jnp.abs(k_pos[:, None, :] - q_pos[:, :, None])
    valid = (rel <= half) & (k_pos[:, None, :] >= 0) & (k_pos[:, None, :] < L)
    alibi = -slopes[:, None, None, None] * (rel * dilation).astype(jnp.float32)
    scores = jnp.where(valid, scores + alibi[None, None], NEG_INF)
    m = jnp.max(scores, axis=-1, keepdims=True)
    e = jnp.exp(scores - m)
    den = jnp.sum(e, axis=-1, keepdims=True)
    o = jnp.einsum('brhnqk,brhnkd->brhnqd', e, vblk) / den
    lse = (m + jnp.log(den))[..., 0]

    def unstride(t):
        t = t.reshape((bsz, dilation, h, lp) + t.shape[5:])[:, :, :, :L]
        t = jnp.moveaxis(t, 3, 1)
        return t.reshape((bsz, s, h) + t.shape[4:])

    return unstride(o), unstride(lse)


def dilated_attention_mix(h, w_qkv, w_o):
    bsz, s, d = h.shape
    qkv = jnp.einsum('bsd,de->bse', h, w_qkv).astype(jnp.float32)
    qkv = qkv.reshape(bsz, s, N_GROUPS, 3, ATTN_HEADS, ATTN_HEAD_DIM)
    slopes = alibi_slopes(N_GROUPS * ATTN_HEADS).reshape(N_GROUPS, ATTN_HEADS)
    outs, lses = [], []
    for gi, (window, dil) in enumerate(ATTN_GROUPS):
        o, lse = _dilated_group(qkv[:, :, gi, 0], qkv[:, :, gi, 1], qkv[:, :, gi, 2], slopes[gi], window, dil)
        outs.append(o)
        lses.append(lse)
    o = jnp.stack(outs)
    alpha = jax.nn.softmax(jnp.stack(lses), axis=0)
    merged = jnp.sum(alpha[..., None] * o, axis=0).reshape(bsz, s, d)
    return jnp.einsum('bsd,de->bse', merged.astype(h.dtype), w_o)


def hier_moe(h, router_g, router_g_b, router_e, router_e_b, w_gate, w_up, w_down):
    bsz, s, d = h.shape
    xt = h.reshape(-1, d)
    f32 = jnp.float32
    g_logits = (xt @ router_g + router_g_b).astype(f32)
    g_prob = jax.nn.softmax(g_logits, axis=-1)
    _, g_top = lax.top_k(g_logits, 1)
    p_group = jnp.take_along_axis(g_prob, g_top, axis=-1)
    e_logits = (jnp.einsum('td,gde->tge', xt, router_e) + router_e_b).astype(f32)
    e_sel = jnp.take_along_axis(e_logits, g_top[:, :, None], axis=1)[:, 0]
    top_v, top_i = lax.top_k(e_sel, TOP_K_INNER)
    top_w = jax.nn.softmax(top_v, axis=-1) * p_group
    inner = jnp.sum(jax.nn.one_hot(top_i, EXPERTS_PER_GROUP, dtype=f32) * top_w[..., None], axis=1)
    gates = jax.nn.one_hot(g_top[:, 0], N_EXPERT_GROUPS, dtype=f32)[:, :, None] * inner[:, None, :]
    out = jnp.zeros((xt.shape[0], d), f32)
    for gi in range(N_EXPERT_GROUPS):
        hid = jax.nn.silu(jnp.einsum('td,edf->tef', xt, w_gate[gi])) * jnp.einsum('td,edf->tef', xt, w_up[gi])
        hid = hid * gates[:, gi, :, None].astype(hid.dtype)
        out = out + jnp.einsum('tef,efd->td', hid, w_down[gi]).astype(f32)
    return out.reshape(bsz, s, d).astype(h.dtype)


def setup_inputs(seed: int = 0) -> dict:
    key = jax.random.key(seed)
    ks = iter(jax.random.split(key, 48))
    f32 = jnp.float32
    D, NR, NA = D_MODEL, N_RWKV_LAYERS, N_ATTN_LAYERS
    G, E, F = N_EXPERT_GROUPS, EXPERTS_PER_GROUP, D_EXPERT

    def nrm(shape, scale):
        return jax.random.normal(next(ks), shape, f32) * scale

    def uni(shape, lo, hi):
        return jax.random.uniform(next(ks), shape, f32, minval=lo, maxval=hi)

    return {
        "x": nrm((BATCH, SEQ, D), 1.0),
        "c": nrm((BATCH, D), 1.0),
        "ada_w": nrm((DEPTH, D, N_MOD * D), 0.5 * D ** -0.5),
        "ada_b": nrm((DEPTH, N_MOD * D), 0.01),
        "norm_tm_g": 1.0 + nrm((DEPTH, D), 0.02),
        "norm_cm_g": 1.0 + nrm((DEPTH, D), 0.02),
        "rw_mu": uni((NR, N_SHIFT_MIX, D), 0.0, 1.0),
        "rw_w_rkv": nrm((NR, 3, D, D), D ** -0.5),
        "rw_w0": uni((NR, N_DIRS, D), -4.5, -0.5),
        "rw_w1": nrm((NR, N_DIRS, D, D_DECAY_LORA), D ** -0.5),
        "rw_w2": nrm((NR, N_DIRS, D_DECAY_LORA, D), 0.5 * D_DECAY_LORA ** -0.5),
        "rw_a0": nrm((NR, N_DIRS, D), 0.5),
        "rw_a1": nrm((NR, N_DIRS, D, D_AAA_LORA), D ** -0.5),
        "rw_a2": nrm((NR, N_DIRS, D_AAA_LORA, D), 0.5 * D_AAA_LORA ** -0.5),
        "rw_g1": nrm((NR, N_DIRS, D, D_GATE_LORA), D ** -0.5),
        "rw_g2": nrm((NR, N_DIRS, D_GATE_LORA, D), D_GATE_LORA ** -0.5),
        "rw_k_k": 0.85 + nrm((NR, D), 0.05),
        "rw_k_a": 1.0 + nrm((NR, D), 0.05),
        "rw_r_k": nrm((NR, RWKV_HEADS, RWKV_HEAD), 0.1),
        "rw_ln_w": 1.0 + nrm((NR, D), 0.02),
        "rw_ln_b": nrm((NR, D), 0.01),
        "rw_w_o": nrm((NR, D, D), D ** -0.5),
        "at_w_qkv": nrm((NA, D, QKV_WIDTH), D ** -0.5),
        "at_w_o": nrm((NA, D, D), D ** -0.5),
        "moe_router_g": nrm((DEPTH, D, G), D ** -0.5),
        "moe_router_g_b": nrm((DEPTH, G), 0.01),
        "moe_router_e": nrm((DEPTH, G, D, E), D ** -0.5),
        "moe_router_e_b": nrm((DEPTH, G, E), 0.01),
        "moe_w_gate": nrm((DEPTH, G, E, D, F), D ** -0.5),
        "moe_w_up": nrm((DEPTH, G, E, D, F), D ** -0.5),
        "moe_w_down": nrm((DEPTH, G, E, F, D), F ** -0.5),
        "final_g": 1.0 + nrm((D,), 0.02),
    }


def reference(x, c, ada_w, ada_b, norm_tm_g, norm_cm_g,
              rw_mu, rw_w_rkv, rw_w0, rw_w1, rw_w2, rw_a0, rw_a1, rw_a2, rw_g1, rw_g2,
              rw_k_k, rw_k_a, rw_r_k, rw_ln_w, rw_ln_b, rw_w_o,
              at_w_qkv, at_w_o,
              moe_router_g, moe_router_g_b, moe_router_e, moe_router_e_b,
              moe_w_gate, moe_w_up, moe_w_down, final_g):
    silu_c = jax.nn.silu(c)
    for i in range(DEPTH):
        mod = silu_c @ ada_w[i] + ada_b[i]
        sh_t, sc_t, ga_t, sh_c, sc_c, ga_c = jnp.split(mod, N_MOD, axis=-1)
        hn = modulate(rms_norm(x, norm_tm_g[i]), sh_t, sc_t)
        j = i // N_MIXERS
        if i % N_MIXERS == 0:
            tm = rwkv7_mix(hn, rw_mu[j], rw_w_rkv[j], rw_w0[j], rw_w1[j], rw_w2[j],
                           rw_a0[j], rw_a1[j], rw_a2[j], rw_g1[j], rw_g2[j],
                           rw_k_k[j], rw_k_a[j], rw_r_k[j], rw_ln_w[j], rw_ln_b[j], rw_w_o[j])
        else:
            tm = dilated_attention_mix(hn, at_w_qkv[j], at_w_o[j])
        x = x + ga_t[:, None, :] * tm
        hn = modulate(rms_norm(x, norm_cm_g[i]), sh_c, sc_c)
        cm = hier_moe(hn, moe_router_g[i], moe_router_g_b[i], moe_router_e[i], moe_router_e_b[i],
                      moe_w_gate[i], moe_w_up[i], moe_w_down[i])
        x = x + ga_c[:, None, :] * cm
    return rms_norm(x, final_g)
```

```cpp
#include <hip/hip_runtime.h>
#include <cstdio>
#include <cstdint>

#ifndef ONE_LAUNCH
#define ONE_LAUNCH 1
#endif


#define LAS __attribute__((address_space(3)))
typedef unsigned short bf16;
typedef short bf16x8 __attribute__((ext_vector_type(8)));
typedef float f32x4 __attribute__((ext_vector_type(4)));
typedef float f32x2 __attribute__((ext_vector_type(2)));
typedef unsigned u32x4 __attribute__((ext_vector_type(4)));
typedef unsigned u32x2 __attribute__((ext_vector_type(2)));

constexpr int NB = 8, SEQ = 2048, D = 1024, T = NB * SEQ, DEPTH = 4;
constexpr int NH_R = 16, HD_R = 64;
constexpr int QKVW = 9216;
constexpr int NEXP = 32, FEXP = 256;
constexpr int MAXROWS = 40960;
constexpr int NWAVES = 8, NTHREADS = 512;
constexpr float RMS_EPS = 1e-6f, GN_EPS = 64e-5f;
constexpr float LOG2E = 1.4426950408889634f;

constexpr size_t MiB = 1u << 20;
constexpr size_t WS_CTL = 0, CTL_ZERO_BYTES = 64 * 1024;
constexpr size_t WS_MOD = 1 * MiB;
constexpr size_t WS_TOKE = 2 * MiB;
constexpr size_t WS_TOKR = WS_TOKE + 128 * 1024;
constexpr size_t WS_TOKW = WS_TOKR + 128 * 1024;
constexpr size_t WS_TOKP = WS_TOKW + 128 * 1024;
constexpr size_t WS_ROWW = WS_TOKP + 128 * 1024;
constexpr size_t WS_TILEE = WS_ROWW + 192 * 1024;
constexpr size_t WS_SB = 4 * MiB;
constexpr size_t WS_W = 8 * MiB;
constexpr size_t W_RKV = 0, W_LDN = 6 * MiB, W_LUPWA = 8 * MiB, W_LUPG = 10 * MiB, W_RWO = 11 * MiB, W_RW_STRIDE = 13 * MiB;
constexpr size_t WS_WA = WS_W + 2 * W_RW_STRIDE;
constexpr size_t W_QKV = 0, W_AWO = 18 * MiB, W_AT_STRIDE = 20 * MiB;
constexpr size_t WS_WM = WS_WA + 2 * W_AT_STRIDE;
constexpr size_t W_GU = 0, W_DN = 32 * MiB;
constexpr size_t WS_X1 = 128 * MiB;
constexpr size_t WS_ACT = 192 * MiB;
constexpr size_t A_XS = 0, A_HX = 96 * MiB;
constexpr size_t A_LDEC = 0, A_ASIG = 64 * MiB, A_G = 128 * MiB;
constexpr size_t A_RKV = 192 * MiB;
constexpr size_t A_O = 192 * MiB;
constexpr size_t A_LORAH = 288 * MiB;
constexpr size_t A_Y = 304 * MiB;
constexpr size_t A_H = 0;
constexpr size_t A_Q = 32 * MiB, A_K = 128 * MiB, A_VT = 224 * MiB;
constexpr size_t A_AO = 320 * MiB;
constexpr size_t A_HN2 = 0, A_ASORT = 32 * MiB, A_HID = 112 * MiB, A_YS = 288 * MiB;
constexpr size_t WS_END = WS_ACT + 368 * MiB;

constexpr int CW_BAR = 4096;
constexpr int CW_CNT = 8192;

constexpr int LDS_BYTES = 147456;
constexpr int MISC_OFF = 131072 + 320;
constexpr int TILEE_OFF = 131072 + 1024;
constexpr int OFFS_OFF = 131072 + 2048;

__device__ __forceinline__ float bf_lo(unsigned u) { return __uint_as_float(u << 16); }
__device__ __forceinline__ float bf_hi(unsigned u) { return __uint_as_float(u & 0xffff0000u); }
__device__ __forceinline__ float bf2f(bf16 v) { return __uint_as_float(((unsigned)v) << 16); }
__device__ __forceinline__ unsigned f2bf(float f) { unsigned u = __float_as_uint(f); return (u + 0x7fffu + ((u >> 16) & 1u)) >> 16; }
__device__ __forceinline__ unsigned pk2(float lo, float hi) { return f2bf(lo) | (f2bf(hi) << 16); }
__device__ __forceinline__ float dpp_ror(float x, const int ctrl_sel) {
    int r;
    if (ctrl_sel == 8) r = __builtin_amdgcn_update_dpp(0, __float_as_int(x), 0x128, 0xf, 0xf, false);
    else if (ctrl_sel == 4) r = __builtin_amdgcn_update_dpp(0, __float_as_int(x), 0x124, 0xf, 0xf, false);
    else if (ctrl_sel == 2) r = __builtin_amdgcn_update_dpp(0, __float_as_int(x), 0x122, 0xf, 0xf, false);
    else r = __builtin_amdgcn_update_dpp(0, __float_as_int(x), 0x121, 0xf, 0xf, false);
    return __int_as_float(r);
}
__device__ __forceinline__ float rowsum16(float x) { x += dpp_ror(x, 8); x += dpp_ror(x, 4); x += dpp_ror(x, 2); x += dpp_ror(x, 1); return x; }
__device__ __forceinline__ float lane_xor(float v, int lane, int o) { return __int_as_float(__builtin_amdgcn_ds_bpermute((lane ^ o) << 2, __float_as_int(v))); }
__device__ __forceinline__ float wave_sum(float v, int lane) { v = rowsum16(v); v += lane_xor(v, lane, 16); v += lane_xor(v, lane, 32); return v; }
__device__ __forceinline__ float sigmoidf_(float x) { return 1.0f / (1.0f + __expf(-x)); }
#define LDS_WAIT() asm volatile("s_waitcnt lgkmcnt(0)" ::: "memory")
#define VM_WAIT() asm volatile("s_waitcnt vmcnt(0)" ::: "memory")

#define XB_TMO      128
#define XB_XCNT(j)  (256  + 64 * (j))
#define XB_XSUB(j)  (1280 + 64 * (j))
#define XB_XGEN(j)  (2304 + 64 * (j))
#define XB_TOP      3328
#define XB_TOPGEN   3392
#define XCD_BAR_WORDS 3456
#define XB_SPIN_CAP (1u << 18)
__device__ __forceinline__ unsigned xb_ld(unsigned* p)              { return __hip_atomic_load(p, __ATOMIC_RELAXED, __HIP_MEMORY_SCOPE_AGENT); }
__device__ __forceinline__ unsigned xb_add(unsigned* p, unsigned v) { return __hip_atomic_fetch_add(p, v, __ATOMIC_RELAXED, __HIP_MEMORY_SCOPE_AGENT); }
__device__ __forceinline__ unsigned xb_xcc_id() { return (unsigned)__builtin_amdgcn_s_getreg((3 << 11) | 20) & 0xFu; }
#define XB_SPIN(cond, bar) do { unsigned _sp = 0; while (cond) { __builtin_amdgcn_s_sleep(1); \
    if ((++_sp & 255u) == 0u) { if (xb_ld(&(bar)[XB_TMO])) break; if (_sp > XB_SPIN_CAP) { atomicAdd(&(bar)[XB_TMO], 1u); break; } } } } while (0)
struct XcdBarrier { unsigned* bar; unsigned x; volatile LAS unsigned* st; };
__device__ __forceinline__ XcdBarrier xcd_barrier_post(unsigned* bar, volatile LAS unsigned* st) {
    XcdBarrier b; b.bar = bar; b.x = xb_xcc_id(); b.st = st;
    if (threadIdx.x == 0) (void)xb_add(&bar[XB_XCNT(b.x)], 1u);
    return b;
}
__device__ __forceinline__ void xcd_barrier_complete(unsigned* bar, unsigned x, unsigned& nloc, unsigned& nx) {
    const unsigned G = gridDim.x * gridDim.y * gridDim.z;
    unsigned sum, cnt, mine, sp = 0u;
    for (;;) {
        sum = 0u; cnt = 0u; mine = 0u;
#pragma clang loop unroll(disable)
        for (unsigned j = 0; j < 16; ++j) { const unsigned c = xb_ld(&bar[XB_XCNT(j)]); sum += c; cnt += (c > 0u) ? 1u : 0u; mine = (j == x) ? c : mine; }
        if (sum == G) break;
        __builtin_amdgcn_s_sleep(1);
        if ((++sp & 255u) == 0u) { if (xb_ld(&bar[XB_TMO])) break; if (sp > XB_SPIN_CAP) { atomicAdd(&bar[XB_TMO], 1u); break; } }
    }
    nloc = mine > 0u ? mine : 1u; nx = cnt > 0u ? cnt : 1u;
}
__device__ __forceinline__ void xcd_barrier(const XcdBarrier& b) {
    asm volatile("s_waitcnt vmcnt(0)" ::: "memory");
    __syncthreads();
    if (threadIdx.x == 0) {
        unsigned* bar = b.bar;
        __builtin_amdgcn_s_waitcnt(0);
        unsigned nloc = b.st[0], nx = b.st[1];
        if (nloc == 0u) { xcd_barrier_complete(bar, b.x, nloc, nx); b.st[0] = nloc; b.st[1] = nx; }
        const unsigned old = xb_add(&bar[XB_XSUB(b.x)], 1u);
        const unsigned gen = old / nloc;
        if (old + 1u == (gen + 1u) * nloc) {
            __builtin_amdgcn_fence(__ATOMIC_RELEASE, "agent");
            asm volatile("s_waitcnt vmcnt(0)" ::: "memory");
            const unsigned og = xb_add(&bar[XB_TOP], 1u);
            const unsigned tg = og / nx;
            if (og + 1u == (tg + 1u) * nx) xb_add(&bar[XB_TOPGEN], 1u);
            else XB_SPIN(xb_ld(&bar[XB_TOPGEN]) == tg, bar);
            __builtin_amdgcn_fence(__ATOMIC_ACQUIRE, "agent");
            xb_add(&bar[XB_XGEN(b.x)], 1u);
            asm volatile("s_waitcnt vmcnt(0)" ::: "memory");
        } else {
            XB_SPIN(xb_ld(&bar[XB_XGEN(b.x)]) == gen, bar);
            __builtin_amdgcn_fence(__ATOMIC_ACQUIRE, "agent");
            asm volatile("s_waitcnt vmcnt(0)" ::: "memory");
        }
    }
    __syncthreads();
}

namespace pg8 {
constexpr int BM = 256, BK = 64, HALF = 128, HTB = HALF * BK * 2, STAGE_BYTES = 8 * HTB;
__device__ __forceinline__ int lds_byte(int r, int c) { const int st = (r >> 4) * 2 + (c >> 5), rr = r & 15, cc = c & 31, ob = rr * 64 + cc * 2; return st * 1024 + (ob ^ (((ob >> 9) & 1) << 5)); }
__device__ __forceinline__ void stage_rc(int b, int& R, int& C) { const int st = b / 1024, sb = b % 1024, swz = sb ^ (((sb >> 9) & 1) << 5); R = (st >> 1) * 16 + swz / 64; C = (st & 1) * 32 + (swz % 64) / 2; }
__device__ __forceinline__ int perm32(int rho) { const int n = rho >> 4, i = rho & 15; return 8 * (i >> 2) + 4 * n + (i & 3); }
struct Unit { int pm, pn; const char* a; const char* b; };
__device__ __forceinline__ unsigned cvt_pk_bf16(float lo, float hi) { unsigned r; asm volatile("v_cvt_pk_bf16_f32 %0, %1, %2" : "=v"(r) : "v"(lo), "v"(hi)); return r; }

template <class Epi, class Sched>
__device__ __forceinline__ void gemm_phase(LAS unsigned char* lds, const int tid, const int K, const int lda, const int ldb, const Sched& S, const Epi& E) {
    const int wid = __builtin_amdgcn_readfirstlane(tid >> 6), lane = tid & 63, wr = wid >> 2, wc = wid & 3, fr = lane & 15, fq = lane >> 4;
    int Kq = K; asm volatile("" : "+s"(Kq));
    const int nt = Kq / BK;
    unsigned voffA[2], voffB[2];
#pragma unroll
    for (int i = 0; i < 2; ++i) { int R, C; stage_rc(tid * 16 + i * 8192, R, C); const int Rb = Epi::PERM ? ((R & ~31) + perm32(R & 31)) : R;
        voffA[i] = (unsigned)(R * lda + C) * 2u; voffB[i] = (unsigned)(Rb * ldb + C) * 2u; }
    const size_t kstep = (size_t)(BK * 2);
    const size_t hstepA = (size_t)HALF * lda * 2, hstepB = (size_t)HALF * ldb * 2;
    const unsigned ldsw = (unsigned)wid * 1024u;
    const int aoff = lds_byte(wr * 64 + fr, fq * 8), boff = lds_byte(wc * 32 + fr, fq * 8);
#define PG8_SA(b, h) (((b) * 2 + (h)) * HTB)
#define PG8_SB(b, h) ((4 + (b) * 2 + (h)) * HTB)
#define PG8_STAGE(bufoff, gbase, voff) do { _Pragma("unroll") for (int _i = 0; _i < 2; ++_i) \
        __builtin_amdgcn_global_load_lds((const unsigned*)((const char*)(gbase) + (voff)[_i]), (LAS unsigned*)(lds + (bufoff) + ldsw + _i * 8192), 16, 0, 0); } while (0)
#define PG8_LDA(dst, b, h) do { _Pragma("unroll") for (int m = 0; m < 4; ++m) _Pragma("unroll") for (int k = 0; k < 2; ++k) dst[m][k] = *(const LAS bf16x8*)(lds + PG8_SA(b, h) + aoff + m * 2048 + k * 1024); } while (0)
#define PG8_LDB(dst, b, h) do { _Pragma("unroll") for (int n = 0; n < 2; ++n) _Pragma("unroll") for (int k = 0; k < 2; ++k) dst[n][k] = *(const LAS bf16x8*)(lds + PG8_SB(b, h) + boff + n * 2048 + k * 1024); } while (0)
#define PG8_MMA(ai, bj, At, Bt) do { __builtin_amdgcn_s_setprio(1); _Pragma("unroll") for (int m = 0; m < 4; ++m) _Pragma("unroll") for (int n = 0; n < 2; ++n) _Pragma("unroll") for (int k = 0; k < 2; ++k) \
        acc[ai][bj][m][n] = __builtin_amdgcn_mfma_f32_16x16x32_bf16(Bt[n][k], At[m][k], acc[ai][bj][m][n], 0, 0, 0); __builtin_amdgcn_s_setprio(0); } while (0)
#define PG8_WAIT_V(n) asm volatile("s_waitcnt vmcnt(" #n ")" ::: "memory")
#define PG8_WAIT_L(n) asm volatile("s_waitcnt lgkmcnt(" #n ")" ::: "memory")
#define PG8_BAR __builtin_amdgcn_s_barrier()
#define PG8_SCHED __builtin_amdgcn_sched_barrier(0)
    Unit cur, nxt; int ui = 0;
    if (!S.next(0, cur)) return;
    f32x4 acc[2][2][4][2];
#pragma unroll
    for (int a = 0; a < 2; ++a)
#pragma unroll
        for (int b = 0; b < 2; ++b)
#pragma unroll
            for (int m = 0; m < 4; ++m)
#pragma unroll
                for (int n = 0; n < 2; ++n) acc[a][b][m][n] = (f32x4){0.f, 0.f, 0.f, 0.f};
    bf16x8 At[4][2], B0[2][2], B1[2][2];
    const char* cA = cur.a; const char* cB = cur.b;
    PG8_STAGE(PG8_SB(0, 0), cB, voffB); PG8_STAGE(PG8_SB(0, 1), cB + hstepB, voffB); PG8_STAGE(PG8_SA(0, 0), cA, voffA); PG8_STAGE(PG8_SA(0, 1), cA + hstepA, voffA);
    if (wr == 1) PG8_BAR;
    PG8_WAIT_V(2); PG8_BAR;
    PG8_STAGE(PG8_SB(1, 0), cB + kstep, voffB); PG8_STAGE(PG8_SA(1, 0), cA + kstep, voffA); PG8_STAGE(PG8_SB(1, 1), cB + hstepB + kstep, voffB);
    PG8_WAIT_V(6); PG8_BAR;
    for (;;) {
        const bool has_next = S.next(ui + 1, nxt);
        const char* nA = has_next ? nxt.a : cA; const char* nB = has_next ? nxt.b : cB;
#pragma clang loop unroll(disable)
        for (int t = 0; t < nt; t += 2) {
            const bool last = (t == nt - 2);
            const char* a1 = cA + (size_t)(t + 1) * kstep;
            const char* a2 = last ? nA : cA + (size_t)(t + 2) * kstep; const char* b2 = last ? nB : cB + (size_t)(t + 2) * kstep;
            const char* a3 = a2 + kstep; const char* b3 = b2 + kstep;
            PG8_LDB(B0, 0, 0); PG8_LDB(B1, 0, 1); PG8_SCHED; PG8_LDA(At, 0, 0); PG8_STAGE(PG8_SA(1, 1), a1 + hstepA, voffA);
            PG8_WAIT_V(8); PG8_WAIT_L(0); PG8_BAR; PG8_MMA(0, 0, At, B0); PG8_MMA(0, 1, At, B1); PG8_BAR; PG8_SCHED;
            PG8_LDA(At, 0, 1); PG8_STAGE(PG8_SB(0, 0), b2, voffB); PG8_STAGE(PG8_SB(0, 1), b2 + hstepB, voffB); PG8_STAGE(PG8_SA(0, 0), a2, voffA);
            PG8_WAIT_V(8); PG8_WAIT_L(0); PG8_BAR; PG8_MMA(1, 0, At, B0); PG8_MMA(1, 1, At, B1); PG8_BAR; PG8_SCHED;
            PG8_LDB(B0, 1, 0); PG8_LDB(B1, 1, 1); PG8_SCHED; PG8_LDA(At, 1, 0); PG8_STAGE(PG8_SA(0, 1), a2 + hstepA, voffA);
            PG8_WAIT_V(8); PG8_WAIT_L(0); PG8_BAR; PG8_MMA(0, 0, At, B0); PG8_MMA(0, 1, At, B1); PG8_BAR; PG8_SCHED;
            PG8_LDA(At, 1, 1); PG8_STAGE(PG8_SB(1, 0), b3, voffB); PG8_STAGE(PG8_SB(1, 1), b3 + hstepB, voffB); PG8_STAGE(PG8_SA(1, 0), a3, voffA);
            PG8_WAIT_V(8); PG8_WAIT_L(0); PG8_BAR; PG8_MMA(1, 0, At, B0); PG8_MMA(1, 1, At, B1); PG8_BAR; PG8_SCHED;
        }
        if (wr == 0) PG8_BAR;
        { int te = tid; asm volatile("" : "+v"(te));
          const int we = __builtin_amdgcn_readfirstlane(te >> 6), le = te & 63;
          E(acc, cur, we >> 2, we & 3, le & 15, le >> 4); }
        if (!has_next) break;
#pragma unroll
        for (int a = 0; a < 2; ++a)
#pragma unroll
            for (int b = 0; b < 2; ++b)
#pragma unroll
                for (int m = 0; m < 4; ++m)
#pragma unroll
                    for (int n = 0; n < 2; ++n) acc[a][b][m][n] = (f32x4){0.f, 0.f, 0.f, 0.f};
        cur = nxt; cA = nA; cB = nB; ++ui;
        if (wr == 1) PG8_BAR;
    }
    PG8_WAIT_V(0);
    PG8_BAR;
#undef PG8_SA
#undef PG8_SB
#undef PG8_STAGE
#undef PG8_LDA
#undef PG8_LDB
#undef PG8_MMA
#undef PG8_WAIT_V
#undef PG8_WAIT_L
#undef PG8_BAR
#undef PG8_SCHED
}

struct GridOrder {
    int nM, nN, nwg, G, c;
    __device__ __forceinline__ void init(int nM_, int nN_, int G_, int c_) { nM = nM_; nN = nN_; nwg = nM * nN; G = G_; c = c_; }
    __device__ __forceinline__ bool tile(int i, int& pm, int& pn) const {
        const long L = (long)i * G + c; if (L >= nwg) return false;
        int wgid = (int)L; { const int q = nwg / 8, r = nwg % 8, xcd = wgid % 8, off = wgid / 8; wgid = (xcd < r ? xcd * (q + 1) : r * (q + 1) + (xcd - r) * q) + off; }
        const int nig = 8 * nN, gid = wgid / nig, fm = gid * 8, gsz = (nM - fm) < 8 ? (nM - fm) : 8;
        pm = fm + ((wgid % nig) % gsz); pn = (wgid % nig) / gsz; return true;
    }
};
}

__device__ __forceinline__ int uni(int v) { return __builtin_amdgcn_readfirstlane(v); }
__device__ __forceinline__ const char* uniptr(const char* p) { const unsigned long long v = (unsigned long long)p; const unsigned lo = __builtin_amdgcn_readfirstlane((unsigned)v), hi = __builtin_amdgcn_readfirstlane((unsigned)(v >> 32)); return (const char*)(((unsigned long long)hi << 32) | lo); }
struct DenseSched {
    pg8::GridOrder o; const char* A; size_t a_sel_stride; int pn_per_a; const char* B; size_t tstepA, tstepB;
    __device__ __forceinline__ bool next(int i, pg8::Unit& u) const {
        if (!o.tile(i, u.pm, u.pn)) return false;
        u.pm = uni(u.pm); u.pn = uni(u.pn);
        u.a = uniptr(A + (size_t)(u.pn / pn_per_a) * a_sel_stride + (size_t)u.pm * tstepA); u.b = uniptr(B + (size_t)u.pn * tstepB); return true;
    }
};
struct MoeSched {
    const int* tileE; int ntiles, npn, G, c; const char* A; const char* B; size_t tstepA, tstepB, estride;
    __device__ __forceinline__ bool next(int i, pg8::Unit& u) const {
        const int L = i * G + c; if (L >= ntiles * npn) return false;
        u.pm = uni(L / npn); u.pn = uni(L % npn);
        const int e = __builtin_amdgcn_readfirstlane(tileE[u.pm]);
        u.a = uniptr(A + (size_t)u.pm * tstepA); u.b = uniptr(B + (size_t)e * estride + (size_t)u.pn * tstepB); return true;
    }
};

using pg8::Unit; using pg8::cvt_pk_bf16;
__device__ __forceinline__ void st8(bf16* p, const f32x4& v0, const f32x4& v1) {
    u32x4 w; w.x = cvt_pk_bf16(v0[0], v0[1]); w.y = cvt_pk_bf16(v0[2], v0[3]); w.z = cvt_pk_bf16(v1[0], v1[1]); w.w = cvt_pk_bf16(v1[2], v1[3]);
    *(u32x4*)p = w;
}
struct EpiSplit {
    static constexpr bool PERM = true;
    bf16* O; size_t split_stride; float scale;
    __device__ __forceinline__ void operator()(const f32x4 (&acc)[2][2][4][2], const Unit& u, int wr, int wc, int fr, int fq) const {
        const int row0 = u.pm * 256 + wr * 64 + fr; const int colt = u.pn * 256; const int t = colt >> 10;
        bf16* base = O + (size_t)t * split_stride; const int col0 = (colt & 1023) + wc * 32 + 8 * fq;
#pragma unroll
        for (int ai = 0; ai < 2; ++ai)
#pragma unroll
            for (int m = 0; m < 4; ++m) { bf16* rowp = base + (size_t)(row0 + ai * 128 + m * 16) * 1024 + col0;
#pragma unroll
                for (int bj = 0; bj < 2; ++bj) st8(rowp + bj * 128, acc[ai][bj][m][0] * scale, acc[ai][bj][m][1] * scale); }
    }
};
struct EpiLoraDn {
    static constexpr bool PERM = true;
    bf16* O;
    __device__ __forceinline__ void operator()(const f32x4 (&acc)[2][2][4][2], const Unit& u, int wr, int wc, int fr, int fq) const {
        const int row0 = u.pm * 256 + wr * 64 + fr; const int col0 = u.pn * 256 + wc * 32 + 8 * fq;
#pragma unroll
        for (int ai = 0; ai < 2; ++ai)
#pragma unroll
            for (int m = 0; m < 4; ++m) { bf16* rowp = O + (size_t)(row0 + ai * 128 + m * 16) * 512 + col0;
#pragma unroll
                for (int bj = 0; bj < 2; ++bj) { f32x4 v0 = acc[ai][bj][m][0], v1 = acc[ai][bj][m][1];
                    const int mode = (u.pn == 1) ? 2 : bj;
                    if (mode == 0) {
#pragma unroll
                        for (int j = 0; j < 4; ++j) { v0[j] = tanhf(v0[j]); v1[j] = tanhf(v1[j]); } }
                    else if (mode == 2) {
#pragma unroll
                        for (int j = 0; j < 4; ++j) { v0[j] = sigmoidf_(v0[j]); v1[j] = sigmoidf_(v1[j]); } }
                    st8(rowp + bj * 128, v0, v1); } }
    }
};
struct EpiLoraUpWA {
    static constexpr bool PERM = true;
    bf16* LD; bf16* AS; const float* w0; const float* a0;
    __device__ __forceinline__ void operator()(const f32x4 (&acc)[2][2][4][2], const Unit& u, int wr, int wc, int fr, int fq) const {
        const int kind = u.pn >> 3, z = (u.pn >> 2) & 1;
        const int row0 = u.pm * 256 + wr * 64 + fr; const int col0 = (u.pn & 3) * 256 + wc * 32 + 8 * fq;
        bf16* base = (kind ? AS : LD) + (size_t)z * T * D; const float* bias = (kind ? a0 : w0) + z * 1024;
        f32x4 bv[2][2];
#pragma unroll
        for (int bj = 0; bj < 2; ++bj)
#pragma unroll
            for (int n = 0; n < 2; ++n) bv[bj][n] = *(const f32x4*)(bias + col0 + bj * 128 + 4 * n);
#pragma unroll
        for (int ai = 0; ai < 2; ++ai)
#pragma unroll
            for (int m = 0; m < 4; ++m) { bf16* rowp = base + (size_t)(row0 + ai * 128 + m * 16) * 1024 + col0;
#pragma unroll
                for (int bj = 0; bj < 2; ++bj) { f32x4 v[2];
#pragma unroll
                    for (int n = 0; n < 2; ++n) { v[n] = acc[ai][bj][m][n] + bv[bj][n];
#pragma unroll
                        for (int j = 0; j < 4; ++j) { const float x = v[n][j];
                            if (kind == 0) { const float zz = -x; const float sp = fmaxf(zz, 0.f) + __logf(1.f + __expf(-fabsf(zz))); v[n][j] = -__expf(-sp - 0.5f) * LOG2E; }
                            else v[n][j] = sigmoidf_(x); } }
                    st8(rowp + bj * 128, v[0], v[1]); } }
    }
};
struct EpiResid {
    static constexpr bool PERM = false;
    const float* xin; float* out; const float* gate;
    __device__ __forceinline__ void operator()(const f32x4 (&acc)[2][2][4][2], const Unit& u, int wr, int wc, int fr, int fq) const {
        const int row0 = u.pm * 256 + wr * 64 + fr, col0 = u.pn * 256 + wc * 32 + 4 * fq; const int b = u.pm >> 3;
        f32x4 gv[2][2];
#pragma unroll
        for (int bj = 0; bj < 2; ++bj)
#pragma unroll
            for (int n = 0; n < 2; ++n) gv[bj][n] = *(const f32x4*)(gate + (size_t)b * 6144 + col0 + bj * 128 + n * 16);
#pragma unroll
        for (int ai = 0; ai < 2; ++ai)
#pragma unroll
            for (int m = 0; m < 4; ++m) { const size_t off = (size_t)(row0 + ai * 128 + m * 16) * D + col0;
#pragma unroll
                for (int bj = 0; bj < 2; ++bj)
#pragma unroll
                    for (int n = 0; n < 2; ++n) { const f32x4 xv = *(const f32x4*)(xin + off + bj * 128 + n * 16);
                        *(f32x4*)(out + off + bj * 128 + n * 16) = xv + gv[bj][n] * acc[ai][bj][m][n]; } }
    }
};
struct EpiQKV {
    static constexpr bool PERM = true;
    bf16* Q; bf16* Kb; bf16* VT; float qscale;
    __device__ __forceinline__ void operator()(const f32x4 (&acc)[2][2][4][2], const Unit& u, int wr, int wc, int fr, int fq) const {
        const int g = u.pn / 12, which = (u.pn % 12) >> 2, hp = u.pn & 3;
        const int row0 = u.pm * 256 + wr * 64 + fr;
        if (which < 2) {
            bf16* base = (which ? Kb : Q) + (size_t)g * T * D; const float sc = which ? 1.0f : qscale; const int col0 = hp * 256 + wc * 32 + 8 * fq;
#pragma unroll
            for (int ai = 0; ai < 2; ++ai)
#pragma unroll
                for (int m = 0; m < 4; ++m) { bf16* rowp = base + (size_t)(row0 + ai * 128 + m * 16) * 1024 + col0;
#pragma unroll
                    for (int bj = 0; bj < 2; ++bj) st8(rowp + bj * 128, acc[ai][bj][m][0] * sc, acc[ai][bj][m][1] * sc); }
        } else {
            const int b = u.pm >> 3; const int dsh = (g == 0) ? 0 : (g == 1 ? 2 : 4); const int Lg = SEQ >> dsh, dmask = (1 << dsh) - 1;
#pragma unroll
            for (int ai = 0; ai < 2; ++ai)
#pragma unroll
                for (int m = 0; m < 4; ++m) { const int t = (row0 + ai * 128 + m * 16) & (SEQ - 1); const int idx = (t & dmask) * Lg + (t >> dsh);
#pragma unroll
                    for (int bj = 0; bj < 2; ++bj) { const int hs = hp * 2 + bj; bf16* hb = VT + ((size_t)((g * 8 + b) * 8 + hs) * 128) * SEQ + idx;
#pragma unroll
                        for (int n = 0; n < 2; ++n)
#pragma unroll
                            for (int j = 0; j < 4; ++j) { const int d = wc * 32 + 8 * fq + 4 * n + j; hb[(size_t)d * SEQ] = (bf16)f2bf(acc[ai][bj][m][n][j]); } } }
        }
    }
};
struct EpiGateUp {
    static constexpr bool PERM = true;
    bf16* H; const float* roww;
    __device__ __forceinline__ void operator()(const f32x4 (&acc)[2][2][4][2], const Unit& u, int wr, int wc, int fr, int fq) const {
        const int row0 = u.pm * 256 + wr * 64 + fr; const int col0 = u.pn * 128 + wc * 32 + 8 * fq;
#pragma unroll
        for (int ai = 0; ai < 2; ++ai)
#pragma unroll
            for (int m = 0; m < 4; ++m) { const int row = row0 + ai * 128 + m * 16; const float rw = roww[row]; f32x4 v[2];
#pragma unroll
                for (int n = 0; n < 2; ++n)
#pragma unroll
                    for (int j = 0; j < 4; ++j) { const float gg = acc[ai][0][m][n][j], uu = acc[ai][1][m][n][j]; v[n][j] = gg * sigmoidf_(gg) * uu * rw; }
                st8(H + (size_t)row * FEXP + col0, v[0], v[1]); }
    }
};
struct EpiPlain {
    static constexpr bool PERM = true;
    bf16* O;
    __device__ __forceinline__ void operator()(const f32x4 (&acc)[2][2][4][2], const Unit& u, int wr, int wc, int fr, int fq) const {
        const int row0 = u.pm * 256 + wr * 64 + fr; const int col0 = u.pn * 256 + wc * 32 + 8 * fq;
#pragma unroll
        for (int ai = 0; ai < 2; ++ai)
#pragma unroll
            for (int m = 0; m < 4; ++m) { bf16* rowp = O + (size_t)(row0 + ai * 128 + m * 16) * 1024 + col0;
#pragma unroll
                for (int bj = 0; bj < 2; ++bj) st8(rowp + bj * 128, acc[ai][bj][m][0], acc[ai][bj][m][1]); }
    }
};

struct Args {
    const float* in[32]; float* out; unsigned char* ws; int ph_lo, ph_hi;
};
enum { I_X = 0, I_C, I_ADAW, I_ADAB, I_NTM, I_NCM, I_MU, I_WRKV, I_W0, I_W1, I_W2, I_A0, I_A1, I_A2, I_G1, I_G2, I_KK, I_KA, I_RK, I_LNW, I_LNB, I_RWO,
       I_AQKV, I_AWO, I_RG, I_RGB, I_RE, I_REB, I_WG, I_WU, I_WD, I_FG };

struct Frame {
    LAS unsigned char* lds; int tid, lane, wave, G, gw, NGW;
    unsigned char* ws; const float* const* in; float* out;
};

__device__ __forceinline__ void row_load(const float* p, int lane, f32x4 (&v)[4]) {
#pragma unroll
    for (int j = 0; j < 4; ++j) v[j] = *(const f32x4*)(p + 4 * lane + 256 * j);
}
__device__ __forceinline__ void row_store(float* p, int lane, const f32x4 (&v)[4]) {
#pragma unroll
    for (int j = 0; j < 4; ++j) *(f32x4*)(p + 4 * lane + 256 * j) = v[j];
}
__device__ __forceinline__ void row_store_bf16(bf16* p, int lane, const f32x4 (&v)[4]) {
#pragma unroll
    for (int j = 0; j < 4; ++j) { u32x2 w; w.x = pk2(v[j][0], v[j][1]); w.y = pk2(v[j][2], v[j][3]); *(u32x2*)(p + 4 * lane + 256 * j) = w; }
}
__device__ __forceinline__ void row_combine(f32x4 (&v)[4], const bf16* ys, const int* tokp, int row, const float* gac, int lane) {
    const int p0 = tokp[2 * row], p1 = tokp[2 * row + 1];
    const bf16* y0 = ys + (size_t)p0 * D; const bf16* y1 = ys + (size_t)p1 * D;
#pragma unroll
    for (int j = 0; j < 4; ++j) { const u32x2 a = *(const u32x2*)(y0 + 4 * lane + 256 * j), b = *(const u32x2*)(y1 + 4 * lane + 256 * j); const f32x4 g = *(const f32x4*)(gac + 4 * lane + 256 * j);
        v[j][0] += g[0] * (bf_lo(a.x) + bf_lo(b.x)); v[j][1] += g[1] * (bf_hi(a.x) + bf_hi(b.x)); v[j][2] += g[2] * (bf_lo(a.y) + bf_lo(b.y)); v[j][3] += g[3] * (bf_hi(a.y) + bf_hi(b.y)); }
}
__device__ __forceinline__ void row_norm_mod(const f32x4 (&x)[4], const float* gain, const float* sc, const float* sh, int lane, f32x4 (&h)[4]) {
    float s = 0.f;
#pragma unroll
    for (int j = 0; j < 4; ++j) s += (x[j][0] * x[j][0] + x[j][1] * x[j][1]) + (x[j][2] * x[j][2] + x[j][3] * x[j][3]);
    const float rstd = rsqrtf(wave_sum(s, lane) * (1.0f / D) + RMS_EPS);
#pragma unroll
    for (int j = 0; j < 4; ++j) { const f32x4 g = *(const f32x4*)(gain + 4 * lane + 256 * j), c = *(const f32x4*)(sc + 4 * lane + 256 * j), b = *(const f32x4*)(sh + 4 * lane + 256 * j);
        h[j] = x[j] * rstd * g * (1.0f + c) + b; }
}
__device__ __forceinline__ void transpose_item(const float* W, int ldw, bf16* dst, int ldd, LAS float* scr, int lane) {
#pragma unroll 8
    for (int i = 0; i < 32; ++i) { const int kk = 2 * i + (lane >> 5); scr[kk * 33 + (lane & 31)] = W[(size_t)kk * ldw + (lane & 31)]; }
    LDS_WAIT(); asm volatile("" ::: "memory");
    const int c = lane & 7;
#pragma unroll
    for (int j = 0; j < 4; ++j) { const int n = (lane >> 3) + 8 * j; const LAS float* s = scr + (8 * c) * 33 + n;
        u32x4 o; o.x = pk2(s[0 * 33], s[1 * 33]); o.y = pk2(s[2 * 33], s[3 * 33]); o.z = pk2(s[4 * 33], s[5 * 33]); o.w = pk2(s[6 * 33], s[7 * 33]);
        *(u32x4*)(dst + (size_t)n * ldd + 8 * c) = o; }
    LDS_WAIT(); asm volatile("" ::: "memory");
}

__device__ __forceinline__ void phase_prologue(Frame& F) {
    const float* c = F.in[I_C]; const float* adaw = F.in[I_ADAW]; const float* adab = F.in[I_ADAB];
    float* mod = (float*)(F.ws + WS_MOD);
    LAS float* sc = (LAS float*)F.lds;
    LAS float* part = (LAS float*)(F.lds + 32768);
    for (int i = F.tid; i < NB * D; i += NTHREADS) { const float v = c[i]; sc[i] = v / (1.0f + __expf(-v)); }
    __syncthreads();
    for (int u = blockIdx.x; u < DEPTH * 96; u += F.G) {
        const int l = u / 96, n0 = (u % 96) * 64, col = n0 + F.lane;
        const float* W = adaw + (size_t)l * D * 6144 + col;
        float acc[8];
#pragma unroll
        for (int b = 0; b < 8; ++b) acc[b] = 0.f;
        const int kbeg = F.wave * 128;
#pragma unroll 8
        for (int k = kbeg; k < kbeg + 128; ++k) { const float w = W[(size_t)k * 6144];
#pragma unroll
            for (int b = 0; b < 8; ++b) acc[b] += sc[b * D + k] * w; }
#pragma unroll
        for (int b = 0; b < 8; ++b) part[(F.wave * 8 + b) * 64 + F.lane] = acc[b];
        __syncthreads();
        { const int b = F.tid >> 6; float s = adab[l * 6144 + col];
#pragma unroll
          for (int w = 0; w < 8; ++w) s += part[(w * 8 + b) * 64 + F.lane];
          mod[(size_t)(l * 8 + b) * 6144 + col] = s; }
        __syncthreads();
    }
    LAS float* scr = (LAS float*)(F.lds + 49152 + F.wave * 8704);
    constexpr int I_SQ = 16 * 32;
    constexpr int I_QKV = 16 * 288;
    constexpr int PER_RW = 4 * I_SQ, PER_AT = I_QKV + I_SQ, NIT = 2 * PER_RW + 2 * PER_AT;
    for (int it = F.gw; it < NIT; it += F.NGW) {
        int r = it;
        if (r < 2 * PER_RW) { const int j = r / PER_RW; r %= PER_RW; const int mi = r / I_SQ; r %= I_SQ; const int kb = r / 32, nb = r % 32;
            if (mi < 3) transpose_item(F.in[I_WRKV] + ((size_t)(j * 3 + mi) * D + kb * 64) * D + nb * 32, D, (bf16*)(F.ws + WS_W + j * W_RW_STRIDE + W_RKV) + (size_t)(mi * D + nb * 32) * D + kb * 64, D, scr, F.lane);
            else transpose_item(F.in[I_RWO] + ((size_t)j * D + kb * 64) * D + nb * 32, D, (bf16*)(F.ws + WS_W + j * W_RW_STRIDE + W_RWO) + (size_t)(nb * 32) * D + kb * 64, D, scr, F.lane);
        } else { r -= 2 * PER_RW; const int j = r / PER_AT; r %= PER_AT;
            if (r < I_QKV) { const int kb = r / 288, nb = r % 288;
                transpose_item(F.in[I_AQKV] + ((size_t)j * D + kb * 64) * QKVW + nb * 32, QKVW, (bf16*)(F.ws + WS_WA + j * W_AT_STRIDE + W_QKV) + (size_t)(nb * 32) * D + kb * 64, D, scr, F.lane); }
            else { r -= I_QKV; const int kb = r / 32, nb = r % 32;
                transpose_item(F.in[I_AWO] + ((size_t)j * D + kb * 64) * D + nb * 32, D, (bf16*)(F.ws + WS_WA + j * W_AT_STRIDE + W_AWO) + (size_t)(nb * 32) * D + kb * 64, D, scr, F.lane); }
        }
    }
    const int gt = blockIdx.x * NTHREADS + F.tid, NGT = F.G * NTHREADS;
    for (int j = 0; j < 2; ++j) {
        bf16* ldn = (bf16*)(F.ws + WS_W + j * W_RW_STRIDE + W_LDN);
        const float* mu = F.in[I_MU] + (size_t)j * 6 * D;
        for (int i = gt; i < 512 * 2048; i += NGT) { const int n = i >> 11, k = i & 2047, kk = k & 1023;
            float v; int mi;
            if (n < 128) { const int z = n >> 6, nn = n & 63; v = F.in[I_W1][((size_t)(j * 2 + z) * D + kk) * 64 + nn]; mi = 3; }
            else if (n < 256) { const int z = (n - 128) >> 6, nn = n & 63; v = F.in[I_A1][((size_t)(j * 2 + z) * D + kk) * 64 + nn]; mi = 4; }
            else { const int z = (n - 256) >> 7, nn = n & 127; v = F.in[I_G1][((size_t)(j * 2 + z) * D + kk) * 128 + nn]; mi = 5; }
            if (k >= 1024) v *= mu[mi * D + kk];
            ldn[i] = (bf16)f2bf(v); }
        bf16* lwa = (bf16*)(F.ws + WS_W + j * W_RW_STRIDE + W_LUPWA);
        for (int i = gt; i < 4096 * 256; i += NGT) { const int n = i >> 8, k = i & 255; const int kind = n >> 11, z = (n >> 10) & 1, col = n & 1023;
            float v = 0.f;
            if ((k >> 6) == kind * 2 + z) v = (kind ? F.in[I_A2] : F.in[I_W2])[((size_t)(j * 2 + z) * 64 + (k & 63)) * D + col];
            lwa[i] = (bf16)f2bf(v); }
        bf16* lg = (bf16*)(F.ws + WS_W + j * W_RW_STRIDE + W_LUPG);
        for (int i = gt; i < 2048 * 256; i += NGT) { const int n = i >> 8, k = i & 255; const int z = n >> 10, col = n & 1023;
            float v = 0.f;
            if ((k >> 7) == z) v = F.in[I_G2][((size_t)(j * 2 + z) * 128 + (k & 127)) * D + col];
            lg[i] = (bf16)f2bf(v); }
    }
}

__device__ __forceinline__ void rw_hrow(Frame& F, int l, bool combine, const float* xsrc, float* xdst, bool own, int row, f32x4 (&h)[4]) {
    const int b = row >> 11; const float* mod = (const float*)(F.ws + WS_MOD);
    f32x4 x[4]; row_load(xsrc + (size_t)row * D, F.lane, x);
    if (combine) { row_combine(x, (const bf16*)(F.ws + WS_ACT + A_YS), (const int*)(F.ws + WS_TOKP), row, mod + (size_t)((l - 1) * 8 + b) * 6144 + 5 * D, F.lane);
        if (own) row_store(xdst + (size_t)row * D, F.lane, x); }
    const float* mp = mod + (size_t)(l * 8 + b) * 6144;
    row_norm_mod(x, F.in[I_NTM] + l * D, mp + 1 * D, mp + 0 * D, F.lane, h);
}
__device__ __forceinline__ void phase_rw_norm(Frame& F, int l, bool combine, const float* xsrc, float* xdst) {
    const int j = l >> 1; const float* mu = F.in[I_MU] + (size_t)j * 6 * D;
    bf16* xs = (bf16*)(F.ws + WS_ACT + A_XS); bf16* hx = (bf16*)(F.ws + WS_ACT + A_HX);
    for (int ch = F.gw; ch < T / 8; ch += F.NGW) {
        const int row0 = ch * 8, t0 = row0 & (SEQ - 1);
        f32x4 prev[4], cur[4], nxt[4];
        if (t0 > 0) rw_hrow(F, l, combine, xsrc, xdst, false, row0 - 1, prev);
        else {
#pragma unroll
            for (int q = 0; q < 4; ++q) prev[q] = (f32x4){0.f, 0.f, 0.f, 0.f}; }
        rw_hrow(F, l, combine, xsrc, xdst, true, row0, cur);
        for (int i = 0; i < 8; ++i) {
            const int row = row0 + i;
            if (t0 + i + 1 < SEQ) rw_hrow(F, l, combine, xsrc, xdst, i < 7, row + 1, nxt);
            else {
#pragma unroll
                for (int q = 0; q < 4; ++q) nxt[q] = (f32x4){0.f, 0.f, 0.f, 0.f}; }
            f32x4 xx[4];
#pragma unroll
            for (int q = 0; q < 4; ++q) xx[q] = 0.5f * (prev[q] + nxt[q]) - cur[q];
#pragma unroll
            for (int mi = 0; mi < 3; ++mi) { f32x4 o[4];
#pragma unroll
                for (int q = 0; q < 4; ++q) { const f32x4 m = *(const f32x4*)(mu + mi * D + 4 * F.lane + 256 * q); o[q] = cur[q] + xx[q] * m; }
                row_store_bf16(xs + ((size_t)mi * T + row) * D, F.lane, o); }
            row_store_bf16(hx + (size_t)row * 2048, F.lane, cur);
            row_store_bf16(hx + (size_t)row * 2048 + D, F.lane, xx);
#pragma unroll
            for (int q = 0; q < 4; ++q) { prev[q] = cur[q]; cur[q] = nxt[q]; }
        }
    }
}

__device__ __forceinline__ void phase_at_norm(Frame& F, int l, const float* xsrc, float* xdst) {
    const float* mod = (const float*)(F.ws + WS_MOD); bf16* H = (bf16*)(F.ws + WS_ACT + A_H);
    for (int row = F.gw; row < T; row += F.NGW) {
        const int b = row >> 11; f32x4 x[4], h[4]; row_load(xsrc + (size_t)row * D, F.lane, x);
        row_combine(x, (const bf16*)(F.ws + WS_ACT + A_YS), (const int*)(F.ws + WS_TOKP), row, mod + (size_t)((l - 1) * 8 + b) * 6144 + 5 * D, F.lane);
        row_store(xdst + (size_t)row * D, F.lane, x);
        const float* mp = mod + (size_t)(l * 8 + b) * 6144;
        row_norm_mod(x, F.in[I_NTM] + l * D, mp + 1 * D, mp + 0 * D, F.lane, h);
        row_store_bf16(H + (size_t)row * D, F.lane, h);
    }
}
__device__ __forceinline__ void phase_final(Frame& F, const float* xsrc) {
    const float* mod = (const float*)(F.ws + WS_MOD); const float* fg = F.in[I_FG];
    for (int row = F.gw; row < T; row += F.NGW) {
        const int b = row >> 11; f32x4 x[4]; row_load(xsrc + (size_t)row * D, F.lane, x);
        row_combine(x, (const bf16*)(F.ws + WS_ACT + A_YS), (const int*)(F.ws + WS_TOKP), row, mod + (size_t)(3 * 8 + b) * 6144 + 5 * D, F.lane);
        float s = 0.f;
#pragma unroll
        for (int j = 0; j < 4; ++j) s += (x[j][0] * x[j][0] + x[j][1] * x[j][1]) + (x[j][2] * x[j][2] + x[j][3] * x[j][3]);
        const float rstd = rsqrtf(wave_sum(s, F.lane) * (1.0f / D) + RMS_EPS);
#pragma unroll
        for (int j = 0; j < 4; ++j) { const f32x4 g = *(const f32x4*)(fg + 4 * F.lane + 256 * j); x[j] = x[j] * rstd * g; }
        row_store(F.out + (size_t)row * D, F.lane, x);
    }
}

__device__ __forceinline__ void phase_moe_route(Frame& F, int l, const float* xsrc) {
    const float* mod = (const float*)(F.ws + WS_MOD); bf16* HN = (bf16*)(F.ws + WS_ACT + A_HN2);
    LAS int* lcnt = (LAS int*)F.lds; LAS int* gbase = lcnt + 32; LAS int* inf_e = lcnt + 64; LAS int* inf_r = inf_e + 128; LAS float* inf_w = (LAS float*)(inf_r + 128);
    unsigned* cnt = (unsigned*)(F.ws + WS_CTL) + CW_CNT + l * 32;
    int* toke = (int*)(F.ws + WS_TOKE); int* tokr = (int*)(F.ws + WS_TOKR); float* tokw = (float*)(F.ws + WS_TOKW);
    const float* rg = F.in[I_RG] + (size_t)l * D * 4; const float* rgb = F.in[I_RGB] + l * 4;
    for (int cb = blockIdx.x; cb < T / 64; cb += F.G) {
        if (F.tid < 32) lcnt[F.tid] = 0;
        __syncthreads();
        for (int i = 0; i < 8; ++i) {
            const int lr = F.wave * 8 + i, row = cb * 64 + lr, b = row >> 11;
            f32x4 x[4], h[4]; row_load(xsrc + (size_t)row * D, F.lane, x);
            const float* mp = mod + (size_t)(l * 8 + b) * 6144;
            row_norm_mod(x, F.in[I_NCM] + l * D, mp + 4 * D, mp + 3 * D, F.lane, h);
            row_store_bf16(HN + (size_t)row * D, F.lane, h);
            float gl[4] = {0.f, 0.f, 0.f, 0.f};
#pragma unroll
            for (int j = 0; j < 4; ++j)
#pragma unroll
                for (int q = 0; q < 4; ++q) { const f32x4 w = *(const f32x4*)(rg + (size_t)(4 * F.lane + 256 * j + q) * 4);
#pragma unroll
                    for (int e = 0; e < 4; ++e) gl[e] += h[j][q] * w[e]; }
#pragma unroll
            for (int e = 0; e < 4; ++e) gl[e] = wave_sum(gl[e], F.lane) + rgb[e];
            const float gm = fmaxf(fmaxf(gl[0], gl[1]), fmaxf(gl[2], gl[3]));
            const int gtop = (gl[0] == gm) ? 0 : (gl[1] == gm) ? 1 : (gl[2] == gm) ? 2 : 3;
            const float pg = 1.0f / (__expf(gl[0] - gm) + __expf(gl[1] - gm) + __expf(gl[2] - gm) + __expf(gl[3] - gm));
            const float* re = F.in[I_RE] + (size_t)(l * 4 + gtop) * D * 8; const float* reb = F.in[I_REB] + (l * 4 + gtop) * 8;
            float el[8];
#pragma unroll
            for (int e = 0; e < 8; ++e) el[e] = 0.f;
#pragma unroll
            for (int j = 0; j < 4; ++j)
#pragma unroll
                for (int q = 0; q < 4; ++q) { const float* wp = re + (size_t)(4 * F.lane + 256 * j + q) * 8; const f32x4 w0 = *(const f32x4*)wp, w1 = *(const f32x4*)(wp + 4);
#pragma unroll
                    for (int e = 0; e < 4; ++e) { el[e] += h[j][q] * w0[e]; el[4 + e] += h[j][q] * w1[e]; } }
#pragma unroll
            for (int e = 0; e < 8; ++e) el[e] = wave_sum(el[e], F.lane) + reb[e];
            float v0 = el[0]; int i0 = 0;
#pragma unroll
            for (int e = 1; e < 8; ++e) if (el[e] > v0) { v0 = el[e]; i0 = e; }
            float v1 = -3.0e38f; int i1 = 0;
#pragma unroll
            for (int e = 0; e < 8; ++e) if (e != i0 && el[e] > v1) { v1 = el[e]; i1 = e; }
            const float ex = __expf(v1 - v0); const float w0 = pg / (1.0f + ex), w1 = pg * ex / (1.0f + ex);
            if (F.lane == 0) {
                const int e0 = gtop * 8 + i0, e1 = gtop * 8 + i1;
                const int r0 = __hip_atomic_fetch_add(lcnt + e0, 1, __ATOMIC_RELAXED, __HIP_MEMORY_SCOPE_WORKGROUP);
                const int r1 = __hip_atomic_fetch_add(lcnt + e1, 1, __ATOMIC_RELAXED, __HIP_MEMORY_SCOPE_WORKGROUP);
                inf_e[lr * 2] = e0; inf_e[lr * 2 + 1] = e1; inf_r[lr * 2] = r0; inf_r[lr * 2 + 1] = r1; inf_w[lr * 2] = w0; inf_w[lr * 2 + 1] = w1;
            }
        }
        __syncthreads();
        if (F.tid < 32) gbase[F.tid] = (int)__hip_atomic_fetch_add(cnt + F.tid, (unsigned)lcnt[F.tid], __ATOMIC_RELAXED, __HIP_MEMORY_SCOPE_AGENT);
        __syncthreads();
        if (F.tid < 128) { const int idx = cb * 128 + F.tid; const int e = inf_e[F.tid]; toke[idx] = e; tokr[idx] = gbase[e] + inf_r[F.tid]; tokw[idx] = inf_w[F.tid]; }
        __syncthreads();
    }
}
__device__ __forceinline__ void moe_tables(Frame& F, int l) {
    LAS int* tileE = (LAS int*)(F.lds + TILEE_OFF); LAS int* offs = (LAS int*)(F.lds + OFFS_OFF);
    const unsigned* cnt = (const unsigned*)(F.ws + WS_CTL) + CW_CNT + l * 32;
    if (F.tid == 0) { int o = 0, nt = 0;
#pragma clang loop unroll(disable)
        for (int e = 0; e < 32; ++e) { const int c = (int)__hip_atomic_load(cnt + e, __ATOMIC_RELAXED, __HIP_MEMORY_SCOPE_AGENT); offs[e] = o; const int ne = (c + 255) >> 8;
#pragma clang loop unroll(disable)
            for (int k = 0; k < ne && nt < 160; ++k) tileE[nt++] = e;
            o += ne * 256; }
        tileE[160] = nt; offs[32] = o; }
    __syncthreads();
}
__device__ __forceinline__ void phase_moe_gather(Frame& F, int l) {
    moe_tables(F, l);
    const LAS int* offs = (const LAS int*)(F.lds + OFFS_OFF);
    if (blockIdx.x == 0 && F.tid < 161) ((int*)(F.ws + WS_TILEE))[F.tid] = ((const LAS int*)(F.lds + TILEE_OFF))[F.tid];
    const int* toke = (const int*)(F.ws + WS_TOKE); const int* tokr = (const int*)(F.ws + WS_TOKR); const float* tokw = (const float*)(F.ws + WS_TOKW);
    int* tokp = (int*)(F.ws + WS_TOKP); float* roww = (float*)(F.ws + WS_ROWW);
    const bf16* HN = (const bf16*)(F.ws + WS_ACT + A_HN2); bf16* AS = (bf16*)(F.ws + WS_ACT + A_ASORT);
    for (int idx = F.gw; idx < 2 * T; idx += F.NGW) {
        const int e = toke[idx]; const int pos = offs[e] + tokr[idx];
        if (F.lane == 0) { tokp[idx] = pos; roww[pos] = tokw[idx]; }
        const bf16* src = HN + (size_t)(idx >> 1) * D; bf16* dst = AS + (size_t)pos * D;
        const u32x4 a = *(const u32x4*)(src + 8 * F.lane), b = *(const u32x4*)(src + 512 + 8 * F.lane);
        *(u32x4*)(dst + 8 * F.lane) = a; *(u32x4*)(dst + 512 + 8 * F.lane) = b;
    }
    LAS float* scr = (LAS float*)(F.lds + 49152 + F.wave * 8704);
    bf16* WGU = (bf16*)(F.ws + WS_WM + W_GU); bf16* WDN = (bf16*)(F.ws + WS_WM + W_DN);
    constexpr int I_GATE = 16 * 8, I_DOWN = 4 * 32;
    for (int it = F.gw; it < NEXP * (2 * I_GATE + I_DOWN); it += F.NGW) {
        const int e = it / (2 * I_GATE + I_DOWN); int r = it % (2 * I_GATE + I_DOWN);
        if (r < 2 * I_GATE) { const int up = r / I_GATE; r %= I_GATE; const int kb = r / 8, nb = r % 8, n0 = nb * 32;
            const float* src = (up ? F.in[I_WU] : F.in[I_WG]) + ((size_t)(l * 32 + e) * D + kb * 64) * FEXP + n0;
            const int drow = (n0 >> 7) * 256 + up * 128 + (n0 & 127);
            transpose_item(src, FEXP, WGU + ((size_t)e * 512 + drow) * D + kb * 64, D, scr, F.lane);
        } else { r -= 2 * I_GATE; const int kb = r / 32, nb = r % 32;
            const float* src = F.in[I_WD] + ((size_t)(l * 32 + e) * FEXP + kb * 64) * D + nb * 32;
            transpose_item(src, D, WDN + ((size_t)e * D + nb * 32) * FEXP + kb * 64, FEXP, scr, F.lane); }
    }
}

__device__ __forceinline__ void phase_scan(Frame& F, int l) {
    const int j = l >> 1;
    const bf16* Rb = (const bf16*)(F.ws + WS_ACT + A_RKV); const bf16* Kb = Rb + (size_t)T * D; const bf16* Vb = Kb + (size_t)T * D;
    const bf16* LD = (const bf16*)(F.ws + WS_ACT + A_LDEC); const bf16* AS = (const bf16*)(F.ws + WS_ACT + A_ASIG);
    bf16* Y = (bf16*)(F.ws + WS_ACT + A_Y); float* SB = (float*)(F.ws + WS_SB);
    LAS float* vb = (LAS float*)F.lds;
    LAS float* yb = (LAS float*)(F.lds + 98304);
    const int sp = F.tid >> 4, c4 = F.tid & 15, k0 = 4 * c4;
    const int rp = F.tid >> 4, seg = F.tid & 15;
    for (int unit = blockIdx.x; unit < NB * NH_R * 2; unit += F.G) {
        const int b = unit >> 5, h = (unit >> 1) & 15, dir = unit & 1; const int col = h * 64 + k0;
        const f32x4 kkc = *(const f32x4*)(F.in[I_KK] + j * D + col), kac = *(const f32x4*)(F.in[I_KA] + j * D + col), rkc = *(const f32x4*)(F.in[I_RK] + j * D + col);
        f32x4 S0 = {0.f, 0.f, 0.f, 0.f}, S1 = {0.f, 0.f, 0.f, 0.f};
        u32x2 gr, gk, gv, gl, ga;
#define SCAN_LOAD(blk) do { const int st = (blk) * 32 + sp; const int t = dir ? (SEQ - 1 - st) : st; const size_t ro = ((size_t)b * SEQ + t) * D + col; \
            gr = *(const u32x2*)(Rb + ro); gk = *(const u32x2*)(Kb + ro); gv = *(const u32x2*)(Vb + ro); gl = *(const u32x2*)(LD + (size_t)dir * T * D + ro); ga = *(const u32x2*)(AS + (size_t)dir * T * D + ro); } while (0)
#define SCAN_PREP(blk) do { LAS float* dst = vb + ((blk) & 1) * (6 * 32 * 64) + sp * 64 + k0; \
            const f32x4 kf = {bf_lo(gk.x), bf_hi(gk.x), bf_lo(gk.y), bf_hi(gk.y)}; const f32x4 rf = {bf_lo(gr.x), bf_hi(gr.x), bf_lo(gr.y), bf_hi(gr.y)}; \
            const f32x4 vf = {bf_lo(gv.x), bf_hi(gv.x), bf_lo(gv.y), bf_hi(gv.y)}; const f32x4 lf = {bf_lo(gl.x), bf_hi(gl.x), bf_lo(gl.y), bf_hi(gl.y)}; \
            const f32x4 af = {bf_lo(ga.x), bf_hi(ga.x), bf_lo(ga.y), bf_hi(ga.y)}; \
            f32x4 kkv = kf * kkc; float ss = (kkv[0] * kkv[0] + kkv[1] * kkv[1]) + (kkv[2] * kkv[2] + kkv[3] * kkv[3]); ss = rowsum16(ss); \
            const float inv = 1.0f / fmaxf(sqrtf(ss), 1e-12f); kkv = kkv * inv; \
            const f32x4 kd = kf * (1.0f + (af - 1.0f) * kac); \
            f32x4 wv; wv[0] = __builtin_amdgcn_exp2f(lf[0]); wv[1] = __builtin_amdgcn_exp2f(lf[1]); wv[2] = __builtin_amdgcn_exp2f(lf[2]); wv[3] = __builtin_amdgcn_exp2f(lf[3]); \
            float bo = (rf[0] * kd[0] * rkc[0] + rf[1] * kd[1] * rkc[1]) + (rf[2] * kd[2] * rkc[2] + rf[3] * kd[3] * rkc[3]); bo = rowsum16(bo); \
            { const int st = (blk) * 32 + sp; const int t = dir ? (SEQ - 1 - st) : st; if (c4 == 0) SB[((size_t)dir * T + (size_t)b * SEQ + t) * 16 + h] = bo; } \
            *(LAS f32x4*)(dst + 0 * 2048) = wv; *(LAS f32x4*)(dst + 1 * 2048) = kd; *(LAS f32x4*)(dst + 2 * 2048) = -kkv; *(LAS f32x4*)(dst + 3 * 2048) = kkv * af; \
            *(LAS f32x4*)(dst + 4 * 2048) = rf; *(LAS f32x4*)(dst + 5 * 2048) = vf; } while (0)
        SCAN_LOAD(0); SCAN_PREP(0); SCAN_LOAD(1);
        __syncthreads();
        for (int blk = 0; blk < SEQ / 32; ++blk) {
            if (blk + 1 < SEQ / 32) SCAN_PREP(blk + 1);
            if (blk + 2 < SEQ / 32) SCAN_LOAD(blk + 2);
            const LAS float* src = vb + (blk & 1) * (6 * 32 * 64) + 4 * seg; LAS float* yo = yb + (blk & 1) * 2048 + 2 * rp;
#pragma unroll 4
            for (int s = 0; s < 32; ++s) {
                const f32x4 w = *(const LAS f32x4*)(src + 0 * 2048 + s * 64), kd = *(const LAS f32x4*)(src + 1 * 2048 + s * 64), av = *(const LAS f32x4*)(src + 2 * 2048 + s * 64);
                const f32x4 bv = *(const LAS f32x4*)(src + 3 * 2048 + s * 64), rv = *(const LAS f32x4*)(src + 4 * 2048 + s * 64);
                const f32x2 vv = *(const LAS f32x2*)(vb + (blk & 1) * (6 * 32 * 64) + 5 * 2048 + s * 64 + 2 * rp);
                float sa0 = (S0[0] * av[0] + S0[1] * av[1]) + (S0[2] * av[2] + S0[3] * av[3]);
                float sa1 = (S1[0] * av[0] + S1[1] * av[1]) + (S1[2] * av[2] + S1[3] * av[3]);
                sa0 = rowsum16(sa0); sa1 = rowsum16(sa1);
                S0 = S0 * w + sa0 * bv + vv[0] * kd; S1 = S1 * w + sa1 * bv + vv[1] * kd;
                float y0 = (S0[0] * rv[0] + S0[1] * rv[1]) + (S0[2] * rv[2] + S0[3] * rv[3]);
                float y1 = (S1[0] * rv[0] + S1[1] * rv[1]) + (S1[2] * rv[2] + S1[3] * rv[3]);
                y0 = rowsum16(y0); y1 = rowsum16(y1);
                if (seg == 0) *(LAS f32x2*)(yo + s * 64) = (f32x2){y0, y1};
            }
            __syncthreads();
            { const int st = blk * 32 + sp; const int t = dir ? (SEQ - 1 - st) : st; const f32x4 yv = *(const LAS f32x4*)(yb + (blk & 1) * 2048 + sp * 64 + k0);
              u32x2 o; o.x = pk2(yv[0], yv[1]); o.y = pk2(yv[2], yv[3]); *(u32x2*)(Y + ((size_t)dir * T + (size_t)b * SEQ + t) * D + col) = o; }
        }
        __syncthreads();
#undef SCAN_LOAD
#undef SCAN_PREP
    }
}

__device__ __forceinline__ void phase_rw_post(Frame& F, int l) {
    const int j = l >> 1; const float* lnw = F.in[I_LNW] + j * D; const float* lnb = F.in[I_LNB] + j * D;
    const bf16* Vb = (const bf16*)(F.ws + WS_ACT + A_RKV) + (size_t)2 * T * D; const bf16* Y = (const bf16*)(F.ws + WS_ACT + A_Y); const bf16* Gb = (const bf16*)(F.ws + WS_ACT + A_G);
    const float* SB = (const float*)(F.ws + WS_SB); bf16* O = (bf16*)(F.ws + WS_ACT + A_O);
    for (int row = F.gw; row < T; row += F.NGW) {
        f32x4 o[4];
#pragma unroll
        for (int q = 0; q < 4; ++q) {
            const int c = 4 * F.lane + 256 * q; const int head = 4 * q + (F.lane >> 4);
            const u32x2 vr = *(const u32x2*)(Vb + (size_t)row * D + c); const f32x4 vf = {bf_lo(vr.x), bf_hi(vr.x), bf_lo(vr.y), bf_hi(vr.y)};
            const f32x4 w = *(const f32x4*)(lnw + c), bb = *(const f32x4*)(lnb + c);
            f32x4 acc = {0.f, 0.f, 0.f, 0.f};
#pragma unroll
            for (int dir = 0; dir < 2; ++dir) {
                const size_t ro = ((size_t)dir * T + row) * D + c;
                const u32x2 yr = *(const u32x2*)(Y + ro), gr = *(const u32x2*)(Gb + ro);
                const f32x4 yf = {bf_lo(yr.x), bf_hi(yr.x), bf_lo(yr.y), bf_hi(yr.y)}; const f32x4 gf = {bf_lo(gr.x), bf_hi(gr.x), bf_lo(gr.y), bf_hi(gr.y)};
                const float sbv = SB[((size_t)dir * T + row) * 16 + head];
                const float mean = rowsum16((yf[0] + yf[1]) + (yf[2] + yf[3])) * (1.0f / 64.0f);
                const f32x4 d = yf - mean; const float var = rowsum16((d[0] * d[0] + d[1] * d[1]) + (d[2] * d[2] + d[3] * d[3])) * (1.0f / 64.0f);
                const float rs = rsqrtf(var + GN_EPS);
                acc += gf * (d * rs * w + bb + sbv * vf);
            }
            o[q] = acc;
        }
        row_store_bf16(O + (size_t)row * D, F.lane, o);
    }
}

__device__ __forceinline__ void phase_attn(Frame& F) {
    const bf16* Qb = (const bf16*)(F.ws + WS_ACT + A_Q); const bf16* Kb = (const bf16*)(F.ws + WS_ACT + A_K); const bf16* VT = (const bf16*)(F.ws + WS_ACT + A_VT);
    bf16* AO = (bf16*)(F.ws + WS_ACT + A_AO);
    const int qi = F.lane & 15, q4 = F.lane >> 4;
    for (int u = blockIdx.x; u < NB * 8 * 8; u += F.G) {
        const int b = u >> 6, hs = (u >> 3) & 7, p0 = (u & 7) * 16;
        for (int it = 0; it < 2; ++it) {
            const int r16 = F.wave + 8 * it; const int tq = r16 + 16 * (p0 + qi);
            float m_run = -1e30f, l_run = 0.f; f32x4 O[8];
#pragma unroll
            for (int dt = 0; dt < 8; ++dt) O[dt] = (f32x4){0.f, 0.f, 0.f, 0.f};
            for (int g = 0; g < 3; ++g) {
                const int dsh = 2 * g, Lg = SEQ >> dsh, rg = r16 & ((1 << dsh) - 1), Pq = tq >> dsh;
                const int nsteps = (g == 0) ? 12 : ((g == 1) ? 6 : 5);
                const int pbase0 = ((16 * p0) >> dsh) - 64;
                const float slope2 = exp2f(-8.0f * (float)(g * 8 + hs + 1) / 24.0f) * LOG2E * (float)(1 << dsh);
                bf16x8 Qf[4];
                { const bf16* qp = Qb + ((size_t)g * T + (size_t)b * SEQ + tq) * D + hs * 128 + 8 * q4;
#pragma unroll
                  for (int kt = 0; kt < 4; ++kt) Qf[kt] = *(const bf16x8*)(qp + 32 * kt); }
                const bf16* kbase = Kb + ((size_t)g * T + (size_t)b * SEQ) * D + hs * 128 + 8 * q4;
                const bf16* vtbase = VT + ((size_t)((g * 8 + b) * 8 + hs) * 128 + qi) * SEQ + rg * Lg;
                for (int s = 0; s < nsteps; ++s) {
                    const int base = pbase0 + 32 * s;
                    const int pA = base + 8 * (qi >> 2) + (qi & 3), pB = pA + 4;
                    const int pAc = min(max(pA, 0), Lg - 1), pBc = min(max(pB, 0), Lg - 1);
                    const bf16* ka = kbase + (size_t)(rg + (pAc << dsh)) * D; const bf16* kb = kbase + (size_t)(rg + (pBc << dsh)) * D;
                    bf16x8 KA[4], KB[4], Vf[8];
#pragma unroll
                    for (int kt = 0; kt < 4; ++kt) { KA[kt] = *(const bf16x8*)(ka + 32 * kt); KB[kt] = *(const bf16x8*)(kb + 32 * kt); }
                    const int cb = base + 8 * q4; const int cbc = (cb < 0 || cb >= Lg) ? 0 : cb;
#pragma unroll
                    for (int dt = 0; dt < 8; ++dt) Vf[dt] = *(const bf16x8*)(vtbase + (size_t)(16 * dt) * SEQ + cbc);
                    f32x4 SA = {0.f, 0.f, 0.f, 0.f}, SBt = {0.f, 0.f, 0.f, 0.f};
#pragma unroll
                    for (int kt = 0; kt < 4; ++kt) { SA = __builtin_amdgcn_mfma_f32_16x16x32_bf16(KA[kt], Qf[kt], SA, 0, 0, 0); SBt = __builtin_amdgcn_mfma_f32_16x16x32_bf16(KB[kt], Qf[kt], SBt, 0, 0, 0); }
                    float sv[8]; bool ok[8]; float mx = -1e30f;
#pragma unroll
                    for (int r = 0; r < 8; ++r) { const int p = cb + r; const int rel = abs(p - Pq); ok[r] = (p >= 0) && (p < Lg) && (rel <= 64);
                        const float sc = (r < 4 ? SA[r & 3] : SBt[r & 3]) - slope2 * (float)rel; sv[r] = ok[r] ? sc : -1e30f; mx = fmaxf(mx, sv[r]); }
                    mx = fmaxf(mx, lane_xor(mx, F.lane, 16)); mx = fmaxf(mx, lane_xor(mx, F.lane, 32));
                    const float m_new = fmaxf(m_run, mx); const float alpha = __builtin_amdgcn_exp2f(m_run - m_new); m_run = m_new;
                    float pe[8]; float rs = 0.f;
#pragma unroll
                    for (int r = 0; r < 8; ++r) { pe[r] = ok[r] ? __builtin_amdgcn_exp2f(sv[r] - m_new) : 0.f; rs += pe[r]; }
                    rs += lane_xor(rs, F.lane, 16); rs += lane_xor(rs, F.lane, 32);
                    l_run = l_run * alpha + rs;
                    union { u32x4 u; bf16x8 v; } pf; pf.u.x = pk2(pe[0], pe[1]); pf.u.y = pk2(pe[2], pe[3]); pf.u.z = pk2(pe[4], pe[5]); pf.u.w = pk2(pe[6], pe[7]);
#pragma unroll
                    for (int dt = 0; dt < 8; ++dt) { O[dt] = O[dt] * alpha; O[dt] = __builtin_amdgcn_mfma_f32_16x16x32_bf16(Vf[dt], pf.v, O[dt], 0, 0, 0); }
                }
            }
            const float inv = 1.0f / l_run;
            bf16* op = AO + ((size_t)b * SEQ + tq) * D + hs * 128 + 4 * q4;
#pragma unroll
            for (int dt = 0; dt < 8; ++dt) { u32x2 o; o.x = pk2(O[dt][0] * inv, O[dt][1] * inv); o.y = pk2(O[dt][2] * inv, O[dt][3] * inv); *(u32x2*)(op + 16 * dt) = o; }
        }
    }
}

constexpr int PH_PER_LAYER = 10, N_PHASES = 1 + DEPTH * PH_PER_LAYER + 1;
template <int MASK> __global__ void __launch_bounds__(NTHREADS, 2) mk_fwd(Args args) {
    extern __shared__ __attribute__((aligned(16))) unsigned char lds_raw[];
#define PHASE_FRAME() Frame F; { int t_ = threadIdx.x; asm volatile("" : "+v"(t_)); unsigned char* w_ = args.ws; asm volatile("" : "+s"(w_)); \
        unsigned lb_ = 0; asm volatile("" : "+s"(lb_)); F.lds = (LAS unsigned char*)lds_raw + lb_; F.tid = t_; F.lane = t_ & 63; F.wave = __builtin_amdgcn_readfirstlane(t_ >> 6); \
        F.G = gridDim.x; F.gw = blockIdx.x * NWAVES + F.wave; F.NGW = F.G * NWAVES; F.ws = w_; F.in = args.in; F.out = args.out; }
    LAS unsigned char* lds0 = (LAS unsigned char*)lds_raw;
    volatile LAS unsigned* MISC = (volatile LAS unsigned*)(lds0 + MISC_OFF);
    if (threadIdx.x < 64) ((LAS unsigned*)(lds0 + 131072))[threadIdx.x + 64] = 0u;
    __syncthreads();
    unsigned* ctl = (unsigned*)(args.ws + WS_CTL);
    XcdBarrier bar; bar.bar = ctl + CW_BAR; bar.x = 0; bar.st = nullptr;
#if ONE_LAUNCH
    bar = xcd_barrier_post(ctl + CW_BAR, MISC + 8);
#endif
    const int lo = args.ph_lo, hi = args.ph_hi;
#define EN(b) ((MASK >> (b)) & 1)
#define IN(k) (lo <= (k) && (k) < hi)
#if ONE_LAUNCH
#define SEAM(k) do { if (IN((k) + 1) || (k) + 1 < hi) xcd_barrier(bar); } while (0)
#else
#define SEAM(k) do { } while (0)
#endif
    float* X0 = args.out; float* X1 = (float*)(args.ws + WS_X1);
    if (EN(0) && IN(0)) { PHASE_FRAME(); phase_prologue(F); SEAM(0); }
    for (int l = 0; l < DEPTH; ++l) {
        const int pb = 1 + l * PH_PER_LAYER; const int j = l >> 1;
        const float* xin = (l == 0) ? args.in[I_X] : ((l & 1) ? X0 : X1);
        float* xcur = (l == 0) ? X0 : ((l & 1) ? X1 : X0);
        if ((l & 1) == 0) {
            if (EN(1) && IN(pb + 0)) { PHASE_FRAME(); phase_rw_norm(F, l, l > 0, xin, xcur); SEAM(pb + 0); }
            if (EN(2) && IN(pb + 1)) { PHASE_FRAME();
                { DenseSched S; S.o.init(T / 256, 12, F.G, blockIdx.x); S.A = (const char*)(F.ws + WS_ACT + A_XS); S.a_sel_stride = (size_t)T * D * 2; S.pn_per_a = 4;
                  S.B = (const char*)(F.ws + WS_W + j * W_RW_STRIDE + W_RKV); S.tstepA = (size_t)256 * D * 2; S.tstepB = (size_t)256 * D * 2;
                  EpiSplit E{(bf16*)(F.ws + WS_ACT + A_RKV), (size_t)T * D, 1.0f};
                  pg8::gemm_phase(F.lds, F.tid, D, D, D, S, E); }
                { DenseSched S; S.o.init(T / 256, 2, F.G, blockIdx.x); S.A = (const char*)(F.ws + WS_ACT + A_HX); S.a_sel_stride = 0; S.pn_per_a = 1 << 20;
                  S.B = (const char*)(F.ws + WS_W + j * W_RW_STRIDE + W_LDN); S.tstepA = (size_t)256 * 2048 * 2; S.tstepB = (size_t)256 * 2048 * 2;
                  EpiLoraDn E{(bf16*)(F.ws + WS_ACT + A_LORAH)};
                  pg8::gemm_phase(F.lds, F.tid, 2048, 2048, 2048, S, E); }
                SEAM(pb + 1);
            }
            if (EN(3) && IN(pb + 2)) { PHASE_FRAME();
                { DenseSched S; S.o.init(T / 256, 16, F.G, blockIdx.x); S.A = (const char*)(F.ws + WS_ACT + A_LORAH); S.a_sel_stride = 0; S.pn_per_a = 1 << 20;
                  S.B = (const char*)(F.ws + WS_W + j * W_RW_STRIDE + W_LUPWA); S.tstepA = (size_t)256 * 512 * 2; S.tstepB = (size_t)256 * 256 * 2;
                  EpiLoraUpWA E{(bf16*)(F.ws + WS_ACT + A_LDEC), (bf16*)(F.ws + WS_ACT + A_ASIG), F.in[I_W0] + j * 2 * D, F.in[I_A0] + j * 2 * D};
                  pg8::gemm_phase(F.lds, F.tid, 256, 512, 256, S, E); }
                { DenseSched S; S.o.init(T / 256, 8, F.G, blockIdx.x); S.A = (const char*)(F.ws + WS_ACT + A_LORAH) + 512; S.a_sel_stride = 0; S.pn_per_a = 1 << 20;
                  S.B = (const char*)(F.ws + WS_W + j * W_RW_STRIDE + W_LUPG); S.tstepA = (size_t)256 * 512 * 2; S.tstepB = (size_t)256 * 256 * 2;
                  EpiSplit E{(bf16*)(F.ws + WS_ACT + A_G), (size_t)T * D, 1.0f};
                  pg8::gemm_phase(F.lds, F.tid, 256, 512, 256, S, E); }
                SEAM(pb + 2);
            }
            if (EN(4) && IN(pb + 3)) { PHASE_FRAME(); phase_scan(F, l); SEAM(pb + 3); }
            if (EN(5) && IN(pb + 4)) { PHASE_FRAME(); phase_rw_post(F, l); SEAM(pb + 4); }
            if (EN(6) && IN(pb + 5)) { PHASE_FRAME();
                DenseSched S; S.o.init(T / 256, 4, F.G, blockIdx.x); S.A = (const char*)(F.ws + WS_ACT + A_O); S.a_sel_stride = 0; S.pn_per_a = 1 << 20;
                S.B = (const char*)(F.ws + WS_W + j * W_RW_STRIDE + W_RWO); S.tstepA = (size_t)256 * D * 2; S.tstepB = (size_t)256 * D * 2;
                EpiResid E{(l == 0) ? F.in[I_X] : (const float*)xcur, xcur, (const float*)(F.ws + WS_MOD) + (size_t)l * 8 * 6144 + 2 * D};
                pg8::gemm_phase(F.lds, F.tid, D, D, D, S, E);
                SEAM(pb + 5);
            }
        } else {
            if (EN(7) && IN(pb + 0)) { PHASE_FRAME(); phase_at_norm(F, l, xin, xcur); SEAM(pb + 0); }
            if (EN(8) && IN(pb + 1)) { PHASE_FRAME();
                DenseSched S; S.o.init(T / 256, 36, F.G, blockIdx.x); S.A = (const char*)(F.ws + WS_ACT + A_H); S.a_sel_stride = 0; S.pn_per_a = 1 << 20;
                S.B = (const char*)(F.ws + WS_WA + j * W_AT_STRIDE + W_QKV); S.tstepA = (size_t)256 * D * 2; S.tstepB = (size_t)256 * D * 2;
                EpiQKV E{(bf16*)(F.ws + WS_ACT + A_Q), (bf16*)(F.ws + WS_ACT + A_K), (bf16*)(F.ws + WS_ACT + A_VT), 0.08838834764831845f * LOG2E};
                pg8::gemm_phase(F.lds, F.tid, D, D, D, S, E);
                SEAM(pb + 1);
            }
            if (EN(9) && IN(pb + 2)) { PHASE_FRAME(); phase_attn(F); SEAM(pb + 2); }
            if (EN(10) && IN(pb + 3)) { PHASE_FRAME();
                DenseSched S; S.o.init(T / 256, 4, F.G, blockIdx.x); S.A = (const char*)(F.ws + WS_ACT + A_AO); S.a_sel_stride = 0; S.pn_per_a = 1 << 20;
                S.B = (const char*)(F.ws + WS_WA + j * W_AT_STRIDE + W_AWO); S.tstepA = (size_t)256 * D * 2; S.tstepB = (size_t)256 * D * 2;
                EpiResid E{(const float*)xcur, xcur, (const float*)(F.ws + WS_MOD) + (size_t)l * 8 * 6144 + 2 * D};
                pg8::gemm_phase(F.lds, F.tid, D, D, D, S, E);
                SEAM(pb + 3);
            }
        }
        if (EN(11) && IN(pb + 6)) { PHASE_FRAME(); phase_moe_route(F, l, xcur); SEAM(pb + 6); }
        if (EN(12) && IN(pb + 7)) { PHASE_FRAME(); phase_moe_gather(F, l); SEAM(pb + 7); }
        if (EN(13) && IN(pb + 8)) { PHASE_FRAME();
            MoeSched S; S.tileE = (const int*)(F.ws + WS_TILEE); S.ntiles = uni(S.tileE[160]); S.npn = 2; S.G = F.G; S.c = blockIdx.x;
            S.A = (const char*)(F.ws + WS_ACT + A_ASORT); S.B = (const char*)(F.ws + WS_WM + W_GU); S.tstepA = (size_t)256 * D * 2; S.tstepB = (size_t)256 * D * 2; S.estride = (size_t)512 * D * 2;
            EpiGateUp E{(bf16*)(F.ws + WS_ACT + A_HID), (const float*)(F.ws + WS_ROWW)};
            pg8::gemm_phase(F.lds, F.tid, D, D, D, S, E);
            SEAM(pb + 8);
        }
        if (EN(14) && IN(pb + 9)) { PHASE_FRAME();
            MoeSched S; S.tileE = (const int*)(F.ws + WS_TILEE); S.ntiles = uni(S.tileE[160]); S.npn = 4; S.G = F.G; S.c = blockIdx.x;
            S.A = (const char*)(F.ws + WS_ACT + A_HID); S.B = (const char*)(F.ws + WS_WM + W_DN); S.tstepA = (size_t)256 * FEXP * 2; S.tstepB = (size_t)256 * FEXP * 2; S.estride = (size_t)D * FEXP * 2;
            EpiPlain E{(bf16*)(F.ws + WS_ACT + A_YS)};
            pg8::gemm_phase(F.lds, F.tid, FEXP, FEXP, FEXP, S, E);
            SEAM(pb + 9);
        }
    }
    if (EN(15) && IN(N_PHASES - 1)) { PHASE_FRAME(); phase_final(F, X1); }
#undef IN
#undef SEAM
}

typedef void (*kern_t)(Args);
template <int B> static kern_t kern_of_bit(int b) { if (b == B) return mk_fwd<(1 << B)>; if constexpr (B > 0) return kern_of_bit<B - 1>(b); else return nullptr; }
static int kind_of_phase(int p) {
    if (p == 0) return 0; if (p == N_PHASES - 1) return 15;
    const int l = (p - 1) / PH_PER_LAYER, k = (p - 1) % PH_PER_LAYER;
    if (k >= 6) return 11 + (k - 6);
    if ((l & 1) == 0) return 1 + k;
    return (k < 4) ? 7 + k : -1;
}
extern "C" void kernel_launch(void* const* d_in, const int* in_sizes, int n_in, void* d_out, int out_size, void* d_ws, size_t ws_size, hipStream_t stream) {
    static int grid = 0;
    if (grid == 0) {
        if (n_in != 32 || out_size != T * D || ws_size < WS_END) { fprintf(stderr, "kernel_launch: unexpected shapes (n_in %d out %d ws %zu need %zu)\n", n_in, out_size, ws_size, (size_t)WS_END); grid = -1; return; }
        int dev = 0, cus = 0;
        if (hipGetDevice(&dev) != hipSuccess || hipDeviceGetAttribute(&cus, hipDeviceAttributeMultiprocessorCount, dev) != hipSuccess) { grid = -1; return; }
#if ONE_LAUNCH
        if (hipFuncSetAttribute((const void*)mk_fwd<0xffff>, hipFuncAttributeMaxDynamicSharedMemorySize, LDS_BYTES) != hipSuccess) { fprintf(stderr, "kernel_launch: hipFuncSetAttribute failed\n"); grid = -1; return; }
#else
        for (int b = 0; b < 16; ++b) if (hipFuncSetAttribute((const void*)kern_of_bit<15>(b), hipFuncAttributeMaxDynamicSharedMemorySize, LDS_BYTES) != hipSuccess) { fprintf(stderr, "kernel_launch: hipFuncSetAttribute failed\n"); grid = -1; return; }
#endif
        (void)hipGetLastError();
        grid = cus;
    }
    if (grid < 0) return;
    (void)hipMemsetAsync((char*)d_ws + WS_CTL, 0, CTL_ZERO_BYTES, stream);
    Args a{};
    for (int i = 0; i < 32; ++i) a.in[i] = (const float*)d_in[i];
    a.out = (float*)d_out; a.ws = (unsigned char*)d_ws;
#if ONE_LAUNCH
#ifndef SPLIT_EVERY
#define SPLIT_EVERY N_PHASES
#endif
    for (int p = 0; p < N_PHASES; p += SPLIT_EVERY) {
        a.ph_lo = p; a.ph_hi = (p + SPLIT_EVERY < N_PHASES) ? p + SPLIT_EVERY : N_PHASES;
        hipLaunchKernelGGL(mk_fwd<0xffff>, dim3(grid), dim3(NTHREADS), LDS_BYTES, stream, a);
    }
#else
    for (int p = 0; p < N_PHASES; ++p) {
        const int kind = kind_of_phase(p); if (kind < 0) continue;
        a.ph_lo = p; a.ph_hi = p + 1;
        hipLaunchKernelGGL(kern_of_bit<15>(kind), dim3(grid), dim3(NTHREADS), LDS_BYTES, stream, a);
    }
#endif
}
```

```cpp
#include <hip/hip_runtime.h>
#include <cstdio>
#include <cstdint>

#ifndef ONE_LAUNCH
#define ONE_LAUNCH 1
#endif


#define LAS __attribute__((address_space(3)))
typedef unsigned short bf16;
typedef short bf16x8 __attribute__((ext_vector_type(8)));
typedef float f32x4 __attribute__((ext_vector_type(4)));
typedef float f32x2 __attribute__((ext_vector_type(2)));
typedef unsigned u32x4 __attribute__((ext_vector_type(4)));
typedef unsigned u32x2 __attribute__((ext_vector_type(2)));

constexpr int NB = 8, SEQ = 2048, D = 1024, T = NB * SEQ, DEPTH = 4;
constexpr int NH_R = 16, HD_R = 64;
constexpr int QKVW = 9216;
constexpr int NEXP = 32, FEXP = 256;
constexpr int MAXROWS = 40960;
constexpr int NWAVES = 8, NTHREADS = 512;
constexpr float RMS_EPS = 1e-6f, GN_EPS = 64e-5f;
constexpr float LOG2E = 1.4426950408889634f;

constexpr size_t MiB = 1u << 20;
constexpr size_t WS_CTL = 0, CTL_ZERO_BYTES = 64 * 1024;
constexpr size_t WS_MOD = 1 * MiB;
constexpr size_t WS_TOKE = 2 * MiB;
constexpr size_t WS_TOKR = WS_TOKE + 128 * 1024;
constexpr size_t WS_TOKW = WS_TOKR + 128 * 1024;
constexpr size_t WS_TOKP = WS_TOKW + 128 * 1024;
constexpr size_t WS_ROWW = WS_TOKP + 128 * 1024;
constexpr size_t WS_TILEE = WS_ROWW + 192 * 1024;
constexpr size_t WS_SB = 4 * MiB;
constexpr size_t WS_W = 8 * MiB;
constexpr size_t W_RKV = 0, W_LDN = 6 * MiB, W_LUPWA = 8 * MiB, W_LUPG = 10 * MiB, W_RWO = 11 * MiB, W_RW_STRIDE = 13 * MiB;
constexpr size_t WS_WA = WS_W + 2 * W_RW_STRIDE;
constexpr size_t W_QKV = 0, W_AWO = 18 * MiB, W_AT_STRIDE = 20 * MiB;
constexpr size_t WS_WM = WS_WA + 2 * W_AT_STRIDE;
constexpr size_t W_GU = 0, W_DN = 32 * MiB;
constexpr size_t WS_X1 = 128 * MiB;
constexpr size_t WS_ACT = 192 * MiB;
constexpr size_t A_XS = 0, A_HX = 96 * MiB;
constexpr size_t A_LDEC = 0, A_ASIG = 64 * MiB, A_G = 128 * MiB;
constexpr size_t A_RKV = 192 * MiB;
constexpr size_t A_O = 192 * MiB;
constexpr size_t A_LORAH = 288 * MiB;
constexpr size_t A_Y = 304 * MiB;
constexpr size_t A_H = 0;
constexpr size_t A_Q = 32 * MiB, A_K = 128 * MiB, A_VT = 224 * MiB;
constexpr size_t A_AO = 320 * MiB;
constexpr size_t A_HN2 = 0, A_ASORT = 32 * MiB, A_HID = 112 * MiB, A_YS = 288 * MiB;
static_assert(A_K - A_Q == A_VT - A_K, "q/k/v spacing");
constexpr size_t WS_END = WS_ACT + 368 * MiB;

constexpr int CW_BAR = 4096;
constexpr int CW_CNT = 8192;

constexpr int LDS_BYTES = 147456;
constexpr int MISC_OFF = 131072 + 320;
constexpr int TILEE_OFF = 131072 + 1024;
constexpr int OFFS_OFF = 131072 + 2048;

__device__ __forceinline__ float bf_lo(unsigned u) { return __uint_as_float(u << 16); }
__device__ __forceinline__ float bf_hi(unsigned u) { return __uint_as_float(u & 0xffff0000u); }
__device__ __forceinline__ float bf2f(bf16 v) { return __uint_as_float(((unsigned)v) << 16); }
__device__ __forceinline__ unsigned f2bf(float f) { unsigned u = __float_as_uint(f); return (u + 0x7fffu + ((u >> 16) & 1u)) >> 16; }
__device__ __forceinline__ unsigned pk2(float lo, float hi) { return f2bf(lo) | (f2bf(hi) << 16); }
__device__ __forceinline__ float dpp_ror(float x, const int ctrl_sel) {
    int r;
    if (ctrl_sel == 8) r = __builtin_amdgcn_update_dpp(0, __float_as_int(x), 0x128, 0xf, 0xf, false);
    else if (ctrl_sel == 4) r = __builtin_amdgcn_update_dpp(0, __float_as_int(x), 0x124, 0xf, 0xf, false);
    else if (ctrl_sel == 2) r = __builtin_amdgcn_update_dpp(0, __float_as_int(x), 0x122, 0xf, 0xf, false);
    else r = __builtin_amdgcn_update_dpp(0, __float_as_int(x), 0x121, 0xf, 0xf, false);
    return __int_as_float(r);
}
__device__ __forceinline__ float rowsum16(float x) { x += dpp_ror(x, 8); x += dpp_ror(x, 4); x += dpp_ror(x, 2); x += dpp_ror(x, 1); return x; }
__device__ __forceinline__ float lane_xor(float v, int lane, int o) { return __int_as_float(__builtin_amdgcn_ds_bpermute((lane ^ o) << 2, __float_as_int(v))); }
__device__ __forceinline__ float wave_sum(float v, int lane) { v = rowsum16(v); v += lane_xor(v, lane, 16); v += lane_xor(v, lane, 32); return v; }
__device__ __forceinline__ float sigmoidf_(float x) { return 1.0f / (1.0f + __expf(-x)); }
#define LDS_WAIT() asm volatile("s_waitcnt lgkmcnt(0)" ::: "memory")
#define VM_WAIT() asm volatile("s_waitcnt vmcnt(0)" ::: "memory")

#define XB_TMO      128
#define XB_XCNT(j)  (256  + 64 * (j))
#define XB_XSUB(j)  (1280 + 64 * (j))
#define XB_XGEN(j)  (2304 + 64 * (j))
#define XB_TOP      3328
#define XB_TOPGEN   3392
#define XCD_BAR_WORDS 3456
#define XB_SPIN_CAP (1u << 18)
__device__ __forceinline__ unsigned xb_ld(unsigned* p)              { return __hip_atomic_load(p, __ATOMIC_RELAXED, __HIP_MEMORY_SCOPE_AGENT); }
__device__ __forceinline__ unsigned xb_add(unsigned* p, unsigned v) { return __hip_atomic_fetch_add(p, v, __ATOMIC_RELAXED, __HIP_MEMORY_SCOPE_AGENT); }
__device__ __forceinline__ unsigned xb_xcc_id() { return (unsigned)__builtin_amdgcn_s_getreg((3 << 11) | 20) & 0xFu; }
#define XB_SPIN(cond, bar) do { unsigned _sp = 0; while (cond) { __builtin_amdgcn_s_sleep(1); \
    if ((++_sp & 255u) == 0u) { if (xb_ld(&(bar)[XB_TMO])) break; if (_sp > XB_SPIN_CAP) { atomicAdd(&(bar)[XB_TMO], 1u); break; } } } } while (0)
struct XcdBarrier { unsigned* bar; unsigned x; volatile LAS unsigned* st; };
__device__ __forceinline__ XcdBarrier xcd_barrier_post(unsigned* bar, volatile LAS unsigned* st, bool t0) {
    XcdBarrier b; b.bar = bar; b.x = xb_xcc_id(); b.st = st;
    if (t0) (void)xb_add(&bar[XB_XCNT(b.x)], 1u);
    return b;
}
__device__ __forceinline__ void xcd_barrier_complete(unsigned* bar, unsigned x, unsigned& nloc, unsigned& nx) {
    const unsigned G = gridDim.x * gridDim.y * gridDim.z;
    unsigned sum, cnt, mine, sp = 0u;
    for (;;) {
        sum = 0u; cnt = 0u; mine = 0u;
#pragma clang loop unroll(disable)
        for (unsigned j = 0; j < 16; ++j) { const unsigned c = xb_ld(&bar[XB_XCNT(j)]); sum += c; cnt += (c > 0u) ? 1u : 0u; mine = (j == x) ? c : mine; }
        if (sum == G) break;
        __builtin_amdgcn_s_sleep(1);
        if ((++sp & 255u) == 0u) { if (xb_ld(&bar[XB_TMO])) break; if (sp > XB_SPIN_CAP) { atomicAdd(&bar[XB_TMO], 1u); break; } }
    }
    nloc = mine > 0u ? mine : 1u; nx = cnt > 0u ? cnt : 1u;
}
__device__ __forceinline__ void xcd_barrier(const XcdBarrier& b, bool t0) {
    asm volatile("s_waitcnt vmcnt(0)" ::: "memory");
    __syncthreads();
    if (t0) {
        unsigned* bar = b.bar;
        __builtin_amdgcn_s_waitcnt(0);
        unsigned nloc = b.st[0], nx = b.st[1];
        if (nloc == 0u) { xcd_barrier_complete(bar, b.x, nloc, nx); b.st[0] = nloc; b.st[1] = nx; }
        const unsigned old = xb_add(&bar[XB_XSUB(b.x)], 1u);
        const unsigned gen = old / nloc;
        if (old + 1u == (gen + 1u) * nloc) {
            __builtin_amdgcn_fence(__ATOMIC_RELEASE, "agent");
            asm volatile("s_waitcnt vmcnt(0)" ::: "memory");
            const unsigned og = xb_add(&bar[XB_TOP], 1u);
            const unsigned tg = og / nx;
            if (og + 1u == (tg + 1u) * nx) xb_add(&bar[XB_TOPGEN], 1u);
            else XB_SPIN(xb_ld(&bar[XB_TOPGEN]) == tg, bar);
            __builtin_amdgcn_fence(__ATOMIC_ACQUIRE, "agent");
            xb_add(&bar[XB_XGEN(b.x)], 1u);
            asm volatile("s_waitcnt vmcnt(0)" ::: "memory");
        } else {
            XB_SPIN(xb_ld(&bar[XB_XGEN(b.x)]) == gen, bar);
            __builtin_amdgcn_fence(__ATOMIC_ACQUIRE, "agent");
            asm volatile("s_waitcnt vmcnt(0)" ::: "memory");
        }
    }
    __syncthreads();
}

namespace pg8 {
constexpr int BM = 256, BK = 64, HALF = 128, HTB = HALF * BK * 2, STAGE_BYTES = 8 * HTB;
__device__ __forceinline__ int lds_byte(int r, int c) { const int st = (r >> 4) * 2 + (c >> 5), rr = r & 15, cc = c & 31, ob = rr * 64 + cc * 2; return st * 1024 + (ob ^ (((ob >> 9) & 1) << 5)); }
__device__ __forceinline__ void stage_rc(int b, int& R, int& C) { const int st = b / 1024, sb = b % 1024, swz = sb ^ (((sb >> 9) & 1) << 5); R = (st >> 1) * 16 + swz / 64; C = (st & 1) * 32 + (swz % 64) / 2; }
__device__ __forceinline__ int perm32(int rho) { const int n = rho >> 4, i = rho & 15; return 8 * (i >> 2) + 4 * n + (i & 3); }
struct Unit { int pm, pn; const char* a; const char* b; };
__device__ __forceinline__ unsigned cvt_pk_bf16(float lo, float hi) { unsigned r; asm volatile("v_cvt_pk_bf16_f32 %0, %1, %2" : "=v"(r) : "v"(lo), "v"(hi)); return r; }

template <class Epi, class Sched>
__device__ __forceinline__ void gemm_phase(LAS unsigned char* lds, const int tid, const int K, const int lda, const int ldb, const Sched& S, const Epi& E) {
    const int wid = __builtin_amdgcn_readfirstlane(tid >> 6), lane = tid & 63, wr = wid >> 2, wc = wid & 3, fr = lane & 15, fq = lane >> 4;
    int Kq = K; asm volatile("" : "+s"(Kq));
    const int nt = Kq / BK;
    unsigned voffA[2], voffB[2];
#pragma unroll
    for (int i = 0; i < 2; ++i) { int R, C; stage_rc(tid * 16 + i * 8192, R, C); const int Rb = Epi::PERM ? ((R & ~31) + perm32(R & 31)) : R;
        voffA[i] = (unsigned)(R * lda + C) * 2u; voffB[i] = (unsigned)(Rb * ldb + C) * 2u; }
    const size_t kstep = (size_t)(BK * 2);
    const size_t hstepA = (size_t)HALF * lda * 2, hstepB = (size_t)HALF * ldb * 2;
    const unsigned ldsw = (unsigned)wid * 1024u;
    const int aoff = lds_byte(wr * 64 + fr, fq * 8), boff = lds_byte(wc * 32 + fr, fq * 8);
#define PG8_SA(b, h) (((b) * 2 + (h)) * HTB)
#define PG8_SB(b, h) ((4 + (b) * 2 + (h)) * HTB)
#define PG8_STAGE(bufoff, gbase, voff) do { _Pragma("unroll") for (int _i = 0; _i < 2; ++_i) \
        __builtin_amdgcn_global_load_lds((const unsigned*)((const char*)(gbase) + (voff)[_i]), (LAS unsigned*)(lds + (bufoff) + ldsw + _i * 8192), 16, 0, 0); } while (0)
#define PG8_LDA(dst, b, h) do { _Pragma("unroll") for (int m = 0; m < 4; ++m) _Pragma("unroll") for (int k = 0; k < 2; ++k) dst[m][k] = *(const LAS bf16x8*)(lds + PG8_SA(b, h) + aoff + m * 2048 + k * 1024); } while (0)
#define PG8_LDB(dst, b, h) do { _Pragma("unroll") for (int n = 0; n < 2; ++n) _Pragma("unroll") for (int k = 0; k < 2; ++k) dst[n][k] = *(const LAS bf16x8*)(lds + PG8_SB(b, h) + boff + n * 2048 + k * 1024); } while (0)
#define PG8_MMA(ai, bj, At, Bt) do { __builtin_amdgcn_s_setprio(1); _Pragma("unroll") for (int m = 0; m < 4; ++m) _Pragma("unroll") for (int n = 0; n < 2; ++n) _Pragma("unroll") for (int k = 0; k < 2; ++k) \
        acc[ai][bj][m][n] = __builtin_amdgcn_mfma_f32_16x16x32_bf16(Bt[n][k], At[m][k], acc[ai][bj][m][n], 0, 0, 0); __builtin_amdgcn_s_setprio(0); } while (0)
#define PG8_WAIT_V(n) asm volatile("s_waitcnt vmcnt(" #n ")" ::: "memory")
#define PG8_WAIT_L(n) asm volatile("s_waitcnt lgkmcnt(" #n ")" ::: "memory")
#define PG8_BAR __builtin_amdgcn_s_barrier()
#define PG8_SCHED __builtin_amdgcn_sched_barrier(0)
    Unit cur, nxt; int ui = 0;
    if (!S.next(0, cur)) return;
    f32x4 acc[2][2][4][2];
#pragma unroll
    for (int a = 0; a < 2; ++a)
#pragma unroll
        for (int b = 0; b < 2; ++b)
#pragma unroll
            for (int m = 0; m < 4; ++m)
#pragma unroll
                for (int n = 0; n < 2; ++n) acc[a][b][m][n] = (f32x4){0.f, 0.f, 0.f, 0.f};
    bf16x8 At[4][2], B0[2][2], B1[2][2];
    const char* cA = cur.a; const char* cB = cur.b;
    PG8_STAGE(PG8_SB(0, 0), cB, voffB); PG8_STAGE(PG8_SB(0, 1), cB + hstepB, voffB); PG8_STAGE(PG8_SA(0, 0), cA, voffA); PG8_STAGE(PG8_SA(0, 1), cA + hstepA, voffA);
    if (wr == 1) PG8_BAR;
    PG8_WAIT_V(2); PG8_BAR;
    PG8_STAGE(PG8_SB(1, 0), cB + kstep, voffB); PG8_STAGE(PG8_SA(1, 0), cA + kstep, voffA); PG8_STAGE(PG8_SB(1, 1), cB + hstepB + kstep, voffB);
    PG8_WAIT_V(6); PG8_BAR;
    for (;;) {
        const bool has_next = S.next(ui + 1, nxt);
        const char* nA = has_next ? nxt.a : cA; const char* nB = has_next ? nxt.b : cB;
#pragma clang loop unroll(disable)
        for (int t = 0; t < nt; t += 2) {
            const bool last = (t == nt - 2);
            const char* a1 = cA + (size_t)(t + 1) * kstep;
            const char* a2 = last ? nA : cA + (size_t)(t + 2) * kstep; const char* b2 = last ? nB : cB + (size_t)(t + 2) * kstep;
            const char* a3 = a2 + kstep; const char* b3 = b2 + kstep;
            PG8_LDB(B0, 0, 0); PG8_LDB(B1, 0, 1); PG8_SCHED; PG8_LDA(At, 0, 0); PG8_STAGE(PG8_SA(1, 1), a1 + hstepA, voffA);
            PG8_WAIT_V(8); PG8_WAIT_L(0); PG8_BAR; PG8_MMA(0, 0, At, B0); PG8_MMA(0, 1, At, B1); PG8_BAR; PG8_SCHED;
            PG8_LDA(At, 0, 1); PG8_STAGE(PG8_SB(0, 0), b2, voffB); PG8_STAGE(PG8_SB(0, 1), b2 + hstepB, voffB); PG8_STAGE(PG8_SA(0, 0), a2, voffA);
            PG8_WAIT_V(8); PG8_WAIT_L(0); PG8_BAR; PG8_MMA(1, 0, At, B0); PG8_MMA(1, 1, At, B1); PG8_BAR; PG8_SCHED;
            PG8_LDB(B0, 1, 0); PG8_LDB(B1, 1, 1); PG8_SCHED; PG8_LDA(At, 1, 0); PG8_STAGE(PG8_SA(0, 1), a2 + hstepA, voffA);
            PG8_WAIT_V(8); PG8_WAIT_L(0); PG8_BAR; PG8_MMA(0, 0, At, B0); PG8_MMA(0, 1, At, B1); PG8_BAR; PG8_SCHED;
            PG8_LDA(At, 1, 1); PG8_STAGE(PG8_SB(1, 0), b3, voffB); PG8_STAGE(PG8_SB(1, 1), b3 + hstepB, voffB); PG8_STAGE(PG8_SA(1, 0), a3, voffA);
            PG8_WAIT_V(8); PG8_WAIT_L(0); PG8_BAR; PG8_MMA(1, 0, At, B0); PG8_MMA(1, 1, At, B1); PG8_BAR; PG8_SCHED;
        }
        if (wr == 0) PG8_BAR;
        { int te = tid; asm volatile("" : "+v"(te));
          const int we = __builtin_amdgcn_readfirstlane(te >> 6), le = te & 63;
          E(acc, cur, we >> 2, we & 3, le & 15, le >> 4); }
        if (!has_next) break;
#pragma unroll
        for (int a = 0; a < 2; ++a)
#pragma unroll
            for (int b = 0; b < 2; ++b)
#pragma unroll
                for (int m = 0; m < 4; ++m)
#pragma unroll
                    for (int n = 0; n < 2; ++n) acc[a][b][m][n] = (f32x4){0.f, 0.f, 0.f, 0.f};
        cur = nxt; cA = nA; cB = nB; ++ui;
        if (wr == 1) PG8_BAR;
    }
    PG8_WAIT_V(0);
    PG8_BAR;
#undef PG8_SA
#undef PG8_SB
#undef PG8_STAGE
#undef PG8_LDA
#undef PG8_LDB
#undef PG8_MMA
#undef PG8_WAIT_V
#undef PG8_WAIT_L
#undef PG8_BAR
#undef PG8_SCHED
}

struct GridOrder {
    int nM, nN, nwg, G, c;
    __device__ __forceinline__ void init(int nM_, int nN_, int G_, int c_) { nM = nM_; nN = nN_; nwg = nM * nN; G = G_; c = c_; }
    __device__ __forceinline__ bool tile(int i, int& pm, int& pn) const {
        const long L = (long)i * G + c; if (L >= nwg) return false;
        int wgid = (int)L; { const int q = nwg / 8, r = nwg % 8, xcd = wgid % 8, off = wgid / 8; wgid = (xcd < r ? xcd * (q + 1) : r * (q + 1) + (xcd - r) * q) + off; }
        const int nig = 8 * nN, gid = wgid / nig, fm = gid * 8, gsz = (nM - fm) < 8 ? (nM - fm) : 8;
        pm = fm + ((wgid % nig) % gsz); pn = (wgid % nig) / gsz; return true;
    }
};
}

__device__ __forceinline__ int uni(int v) { return __builtin_amdgcn_readfirstlane(v); }
__device__ __forceinline__ const char* uniptr(const char* p) { const unsigned long long v = (unsigned long long)p; const unsigned lo = __builtin_amdgcn_readfirstlane((unsigned)v), hi = __builtin_amdgcn_readfirstlane((unsigned)(v >> 32)); return (const char*)(((unsigned long long)hi << 32) | lo); }
struct DenseSched {
    pg8::GridOrder o; const char* A; size_t a_sel_stride; int pn_per_a; const char* B; size_t tstepA, tstepB;
    __device__ __forceinline__ bool next(int i, pg8::Unit& u) const {
        if (!o.tile(i, u.pm, u.pn)) return false;
        u.pm = uni(u.pm); u.pn = uni(u.pn);
        u.a = uniptr(A + (size_t)(u.pn / pn_per_a) * a_sel_stride + (size_t)u.pm * tstepA); u.b = uniptr(B + (size_t)u.pn * tstepB); return true;
    }
};
struct MoeSched {
    const int* tileE; int ntiles, npn, G, c; const char* A; const char* B; size_t tstepA, tstepB, estride;
    __device__ __forceinline__ bool next(int i, pg8::Unit& u) const {
        const int L = i * G + c; if (L >= ntiles * npn) return false;
        u.pm = uni(L / npn); u.pn = uni(L % npn);
        const int e = __builtin_amdgcn_readfirstlane(tileE[u.pm]);
        u.a = uniptr(A + (size_t)u.pm * tstepA); u.b = uniptr(B + (size_t)e * estride + (size_t)u.pn * tstepB); return true;
    }
};

using pg8::Unit; using pg8::cvt_pk_bf16;
__device__ __forceinline__ void st8(bf16* p, const f32x4& v0, const f32x4& v1) {
    u32x4 w; w.x = cvt_pk_bf16(v0[0], v0[1]); w.y = cvt_pk_bf16(v0[2], v0[3]); w.z = cvt_pk_bf16(v1[0], v1[1]); w.w = cvt_pk_bf16(v1[2], v1[3]);
    *(u32x4*)p = w;
}
struct EpiSplit {
    static constexpr bool PERM = true;
    bf16* O; size_t split_stride; float scale;
    __device__ __forceinline__ void operator()(const f32x4 (&acc)[2][2][4][2], const Unit& u, int wr, int wc, int fr, int fq) const {
        const int row0 = u.pm * 256 + wr * 64 + fr; const int colt = u.pn * 256; const int t = colt >> 10;
        bf16* base = O + (size_t)t * split_stride; const int col0 = (colt & 1023) + wc * 32 + 8 * fq;
#pragma unroll
        for (int ai = 0; ai < 2; ++ai)
#pragma unroll
            for (int m = 0; m < 4; ++m) { bf16* rowp = base + (size_t)(row0 + ai * 128 + m * 16) * 1024 + col0;
#pragma unroll
                for (int bj = 0; bj < 2; ++bj) st8(rowp + bj * 128, acc[ai][bj][m][0] * scale, acc[ai][bj][m][1] * scale); }
    }
};
struct EpiLoraDn {
    static constexpr bool PERM = true;
    bf16* O;
    __device__ __forceinline__ void operator()(const f32x4 (&acc)[2][2][4][2], const Unit& u, int wr, int wc, int fr, int fq) const {
        const int row0 = u.pm * 256 + wr * 64 + fr; const int col0 = u.pn * 256 + wc * 32 + 8 * fq;
#pragma unroll
        for (int ai = 0; ai < 2; ++ai)
#pragma unroll
            for (int m = 0; m < 4; ++m) { bf16* rowp = O + (size_t)(row0 + ai * 128 + m * 16) * 512 + col0;
#pragma unroll
                for (int bj = 0; bj < 2; ++bj) { f32x4 v0 = acc[ai][bj][m][0], v1 = acc[ai][bj][m][1];
                    const int mode = (u.pn == 1) ? 2 : bj;
                    if (mode == 0) {
#pragma unroll
                        for (int j = 0; j < 4; ++j) { v0[j] = tanhf(v0[j]); v1[j] = tanhf(v1[j]); } }
                    else if (mode == 2) {
#pragma unroll
                        for (int j = 0; j < 4; ++j) { v0[j] = sigmoidf_(v0[j]); v1[j] = sigmoidf_(v1[j]); } }
                    st8(rowp + bj * 128, v0, v1); } }
    }
};
struct EpiLoraUpWA {
    static constexpr bool PERM = true;
    bf16* LD; bf16* AS; const float* w0; const float* a0;
    __device__ __forceinline__ void operator()(const f32x4 (&acc)[2][2][4][2], const Unit& u, int wr, int wc, int fr, int fq) const {
        const int kind = u.pn >> 3, z = (u.pn >> 2) & 1;
        const int row0 = u.pm * 256 + wr * 64 + fr; const int col0 = (u.pn & 3) * 256 + wc * 32 + 8 * fq;
        bf16* base = (kind ? AS : LD) + (size_t)z * T * D; const float* bias = (kind ? a0 : w0) + z * 1024;
        f32x4 bv[2][2];
#pragma unroll
        for (int bj = 0; bj < 2; ++bj)
#pragma unroll
            for (int n = 0; n < 2; ++n) bv[bj][n] = *(const f32x4*)(bias + col0 + bj * 128 + 4 * n);
#pragma unroll
        for (int ai = 0; ai < 2; ++ai)
#pragma unroll
            for (int m = 0; m < 4; ++m) { bf16* rowp = base + (size_t)(row0 + ai * 128 + m * 16) * 1024 + col0;
#pragma unroll
                for (int bj = 0; bj < 2; ++bj) { f32x4 v[2];
#pragma unroll
                    for (int n = 0; n < 2; ++n) { v[n] = acc[ai][bj][m][n] + bv[bj][n];
#pragma unroll
                        for (int j = 0; j < 4; ++j) { const float x = v[n][j];
                            if (kind == 0) { const float zz = -x; const float sp = fmaxf(zz, 0.f) + __logf(1.f + __expf(-fabsf(zz))); v[n][j] = -__expf(-sp - 0.5f) * LOG2E; }
                            else v[n][j] = sigmoidf_(x); } }
                    st8(rowp + bj * 128, v[0], v[1]); } }
    }
};
struct EpiResid {
    static constexpr bool PERM = false;
    const float* xin; float* out; const float* gate;
    __device__ __forceinline__ void operator()(const f32x4 (&acc)[2][2][4][2], const Unit& u, int wr, int wc, int fr, int fq) const {
        const int row0 = u.pm * 256 + wr * 64 + fr, col0 = u.pn * 256 + wc * 32 + 4 * fq; const int b = u.pm >> 3;
        f32x4 gv[2][2];
#pragma unroll
        for (int bj = 0; bj < 2; ++bj)
#pragma unroll
            for (int n = 0; n < 2; ++n) gv[bj][n] = *(const f32x4*)(gate + (size_t)b * 6144 + col0 + bj * 128 + n * 16);
#pragma unroll
        for (int ai = 0; ai < 2; ++ai)
#pragma unroll
            for (int m = 0; m < 4; ++m) { const size_t off = (size_t)(row0 + ai * 128 + m * 16) * D + col0;
#pragma unroll
                for (int bj = 0; bj < 2; ++bj)
#pragma unroll
                    for (int n = 0; n < 2; ++n) { const f32x4 xv = *(const f32x4*)(xin + off + bj * 128 + n * 16);
                        *(f32x4*)(out + off + bj * 128 + n * 16) = xv + gv[bj][n] * acc[ai][bj][m][n]; } }
    }
};
struct EpiQKV {
    static constexpr bool PERM = true;
    bf16* Q; bf16* Kb; bf16* Vb; float qscale;
    __device__ __forceinline__ void operator()(const f32x4 (&acc)[2][2][4][2], const Unit& u, int wr, int wc, int fr, int fq) const {
        const int g = u.pn / 12, which = (u.pn % 12) >> 2, hp = u.pn & 3;
        const int row0 = u.pm * 256 + wr * 64 + fr;
        bf16* base = Q + (size_t)which * ((A_K - A_Q) / 2) + (size_t)g * T * D; const float sc = which ? 1.0f : qscale; const int col0 = hp * 256 + wc * 32 + 8 * fq;
#pragma unroll
        for (int ai = 0; ai < 2; ++ai)
#pragma unroll
            for (int m = 0; m < 4; ++m) { bf16* rowp = base + (size_t)(row0 + ai * 128 + m * 16) * 1024 + col0;
#pragma unroll
                for (int bj = 0; bj < 2; ++bj) st8(rowp + bj * 128, acc[ai][bj][m][0] * sc, acc[ai][bj][m][1] * sc); }
    }
};
struct EpiGateUp {
    static constexpr bool PERM = true;
    bf16* H; const float* roww;
    __device__ __forceinline__ void operator()(const f32x4 (&acc)[2][2][4][2], const Unit& u, int wr, int wc, int fr, int fq) const {
        const int row0 = u.pm * 256 + wr * 64 + fr; const int col0 = u.pn * 128 + wc * 32 + 8 * fq;
#pragma unroll
        for (int ai = 0; ai < 2; ++ai)
#pragma unroll
            for (int m = 0; m < 4; ++m) { const int row = row0 + ai * 128 + m * 16; const float rw = roww[row]; f32x4 v[2];
#pragma unroll
                for (int n = 0; n < 2; ++n)
#pragma unroll
                    for (int j = 0; j < 4; ++j) { const float gg = acc[ai][0][m][n][j], uu = acc[ai][1][m][n][j]; v[n][j] = gg * sigmoidf_(gg) * uu * rw; }
                st8(H + (size_t)row * FEXP + col0, v[0], v[1]); }
    }
};
struct EpiPlain {
    static constexpr bool PERM = true;
    bf16* O;
    __device__ __forceinline__ void operator()(const f32x4 (&acc)[2][2][4][2], const Unit& u, int wr, int wc, int fr, int fq) const {
        const int row0 = u.pm * 256 + wr * 64 + fr; const int col0 = u.pn * 256 + wc * 32 + 8 * fq;
#pragma unroll
        for (int ai = 0; ai < 2; ++ai)
#pragma unroll
            for (int m = 0; m < 4; ++m) { bf16* rowp = O + (size_t)(row0 + ai * 128 + m * 16) * 1024 + col0;
#pragma unroll
                for (int bj = 0; bj < 2; ++bj) st8(rowp + bj * 128, acc[ai][bj][m][0], acc[ai][bj][m][1]); }
    }
};

struct Args {
    const float* in[32]; float* out; unsigned char* ws; int ph_lo, ph_hi;
};
enum { I_X = 0, I_C, I_ADAW, I_ADAB, I_NTM, I_NCM, I_MU, I_WRKV, I_W0, I_W1, I_W2, I_A0, I_A1, I_A2, I_G1, I_G2, I_KK, I_KA, I_RK, I_LNW, I_LNB, I_RWO,
       I_AQKV, I_AWO, I_RG, I_RGB, I_RE, I_REB, I_WG, I_WU, I_WD, I_FG };

struct Frame {
    LAS unsigned char* lds; int tid, lane, wave, G, gw, NGW;
    unsigned char* ws; const float* const* in; float* out;
};

__device__ __forceinline__ void row_load(const float* p, int lane, f32x4 (&v)[4]) {
#pragma unroll
    for (int j = 0; j < 4; ++j) v[j] = *(const f32x4*)(p + 4 * lane + 256 * j);
}
__device__ __forceinline__ void row_store(float* p, int lane, const f32x4 (&v)[4]) {
#pragma unroll
    for (int j = 0; j < 4; ++j) *(f32x4*)(p + 4 * lane + 256 * j) = v[j];
}
__device__ __forceinline__ void row_store_bf16(bf16* p, int lane, const f32x4 (&v)[4]) {
#pragma unroll
    for (int j = 0; j < 4; ++j) { u32x2 w; w.x = pk2(v[j][0], v[j][1]); w.y = pk2(v[j][2], v[j][3]); *(u32x2*)(p + 4 * lane + 256 * j) = w; }
}
__device__ __forceinline__ void row_combine(f32x4 (&v)[4], const bf16* ys, const int* tokp, int row, const float* gac, int lane) {
    const int p0 = tokp[2 * row], p1 = tokp[2 * row + 1];
    const bf16* y0 = ys + (size_t)p0 * D; const bf16* y1 = ys + (size_t)p1 * D;
#pragma unroll
    for (int j = 0; j < 4; ++j) { const u32x2 a = *(const u32x2*)(y0 + 4 * lane + 256 * j), b = *(const u32x2*)(y1 + 4 * lane + 256 * j); const f32x4 g = *(const f32x4*)(gac + 4 * lane + 256 * j);
        v[j][0] += g[0] * (bf_lo(a.x) + bf_lo(b.x)); v[j][1] += g[1] * (bf_hi(a.x) + bf_hi(b.x)); v[j][2] += g[2] * (bf_lo(a.y) + bf_lo(b.y)); v[j][3] += g[3] * (bf_hi(a.y) + bf_hi(b.y)); }
}
__device__ __forceinline__ void row_norm_mod(const f32x4 (&x)[4], const float* gain, const float* sc, const float* sh, int lane, f32x4 (&h)[4]) {
    float s = 0.f;
#pragma unroll
    for (int j = 0; j < 4; ++j) s += (x[j][0] * x[j][0] + x[j][1] * x[j][1]) + (x[j][2] * x[j][2] + x[j][3] * x[j][3]);
    const float rstd = rsqrtf(wave_sum(s, lane) * (1.0f / D) + RMS_EPS);
#pragma unroll
    for (int j = 0; j < 4; ++j) { const f32x4 g = *(const f32x4*)(gain + 4 * lane + 256 * j), c = *(const f32x4*)(sc + 4 * lane + 256 * j), b = *(const f32x4*)(sh + 4 * lane + 256 * j);
        h[j] = x[j] * rstd * g * (1.0f + c) + b; }
}
__device__ __forceinline__ void transpose_item(const float* W, int ldw, bf16* dst, int ldd, LAS float* scr, int lane) {
#pragma unroll 8
    for (int i = 0; i < 32; ++i) { const int kk = 2 * i + (lane >> 5); scr[kk * 33 + (lane & 31)] = W[(size_t)kk * ldw + (lane & 31)]; }
    LDS_WAIT(); asm volatile("" ::: "memory");
    const int c = lane & 7;
#pragma unroll
    for (int j = 0; j < 4; ++j) { const int n = (lane >> 3) + 8 * j; const LAS float* s = scr + (8 * c) * 33 + n;
        u32x4 o; o.x = pk2(s[0 * 33], s[1 * 33]); o.y = pk2(s[2 * 33], s[3 * 33]); o.z = pk2(s[4 * 33], s[5 * 33]); o.w = pk2(s[6 * 33], s[7 * 33]);
        *(u32x4*)(dst + (size_t)n * ldd + 8 * c) = o; }
    LDS_WAIT(); asm volatile("" ::: "memory");
}

__device__ __forceinline__ void phase_prologue(Frame& F) {
    const float* c = F.in[I_C]; const float* adaw = F.in[I_ADAW]; const float* adab = F.in[I_ADAB];
    float* mod = (float*)(F.ws + WS_MOD);
    LAS float* sc = (LAS float*)F.lds;
    LAS float* part = (LAS float*)(F.lds + 32768);
    for (int i = F.tid; i < NB * D; i += NTHREADS) { const float v = c[i]; sc[i] = v / (1.0f + __expf(-v)); }
    __syncthreads();
    for (int u = blockIdx.x; u < DEPTH * 96; u += F.G) {
        const int l = u / 96, n0 = (u % 96) * 64, col = n0 + F.lane;
        const float* W = adaw + (size_t)l * D * 6144 + col;
        float acc[8];
#pragma unroll
        for (int b = 0; b < 8; ++b) acc[b] = 0.f;
        const int kbeg = F.wave * 128;
#pragma unroll 8
        for (int k = kbeg; k < kbeg + 128; ++k) { const float w = W[(size_t)k * 6144];
#pragma unroll
            for (int b = 0; b < 8; ++b) acc[b] += sc[b * D + k] * w; }
#pragma unroll
        for (int b = 0; b < 8; ++b) part[(F.wave * 8 + b) * 64 + F.lane] = acc[b];
        __syncthreads();
        { const int b = F.tid >> 6; float s = adab[l * 6144 + col];
#pragma unroll
          for (int w = 0; w < 8; ++w) s += part[(w * 8 + b) * 64 + F.lane];
          mod[(size_t)(l * 8 + b) * 6144 + col] = s; }
        __syncthreads();
    }
    LAS float* scr = (LAS float*)(F.lds + 49152 + F.wave * 8704);
    constexpr int I_SQ = 16 * 32;
    constexpr int I_QKV = 16 * 288;
    constexpr int PER_RW = 4 * I_SQ, PER_AT = I_QKV + I_SQ, NIT = 2 * PER_RW + 2 * PER_AT;
    for (int it = F.gw; it < NIT; it += F.NGW) {
        int r = it;
        if (r < 2 * PER_RW) { const int j = r / PER_RW; r %= PER_RW; const int mi = r / I_SQ; r %= I_SQ; const int kb = r / 32, nb = r % 32;
            if (mi < 3) transpose_item(F.in[I_WRKV] + ((size_t)(j * 3 + mi) * D + kb * 64) * D + nb * 32, D, (bf16*)(F.ws + WS_W + j * W_RW_STRIDE + W_RKV) + (size_t)(mi * D + nb * 32) * D + kb * 64, D, scr, F.lane);
            else transpose_item(F.in[I_RWO] + ((size_t)j * D + kb * 64) * D + nb * 32, D, (bf16*)(F.ws + WS_W + j * W_RW_STRIDE + W_RWO) + (size_t)(nb * 32) * D + kb * 64, D, scr, F.lane);
        } else { r -= 2 * PER_RW; const int j = r / PER_AT; r %= PER_AT;
            if (r < I_QKV) { const int kb = r / 288, nb = r % 288;
                transpose_item(F.in[I_AQKV] + ((size_t)j * D + kb * 64) * QKVW + nb * 32, QKVW, (bf16*)(F.ws + WS_WA + j * W_AT_STRIDE + W_QKV) + (size_t)(nb * 32) * D + kb * 64, D, scr, F.lane); }
            else { r -= I_QKV; const int kb = r / 32, nb = r % 32;
                transpose_item(F.in[I_AWO] + ((size_t)j * D + kb * 64) * D + nb * 32, D, (bf16*)(F.ws + WS_WA + j * W_AT_STRIDE + W_AWO) + (size_t)(nb * 32) * D + kb * 64, D, scr, F.lane); }
        }
    }
    const int gt = blockIdx.x * NTHREADS + F.tid, NGT = F.G * NTHREADS;
    for (int j = 0; j < 2; ++j) {
        bf16* ldn = (bf16*)(F.ws + WS_W + j * W_RW_STRIDE + W_LDN);
        const float* mu = F.in[I_MU] + (size_t)j * 6 * D;
        for (int i = gt; i < 512 * 2048; i += NGT) { const int n = i >> 11, k = i & 2047, kk = k & 1023;
            float v; int mi;
            if (n < 128) { const int z = n >> 6, nn = n & 63; v = F.in[I_W1][((size_t)(j * 2 + z) * D + kk) * 64 + nn]; mi = 3; }
            else if (n < 256) { const int z = (n - 128) >> 6, nn = n & 63; v = F.in[I_A1][((size_t)(j * 2 + z) * D + kk) * 64 + nn]; mi = 4; }
            else { const int z = (n - 256) >> 7, nn = n & 127; v = F.in[I_G1][((size_t)(j * 2 + z) * D + kk) * 128 + nn]; mi = 5; }
            if (k >= 1024) v *= mu[mi * D + kk];
            ldn[i] = (bf16)f2bf(v); }
        bf16* lwa = (bf16*)(F.ws + WS_W + j * W_RW_STRIDE + W_LUPWA);
        for (int i = gt; i < 4096 * 256; i += NGT) { const int n = i >> 8, k = i & 255; const int kind = n >> 11, z = (n >> 10) & 1, col = n & 1023;
            float v = 0.f;
            if ((k >> 6) == kind * 2 + z) v = (kind ? F.in[I_A2] : F.in[I_W2])[((size_t)(j * 2 + z) * 64 + (k & 63)) * D + col];
            lwa[i] = (bf16)f2bf(v); }
        bf16* lg = (bf16*)(F.ws + WS_W + j * W_RW_STRIDE + W_LUPG);
        for (int i = gt; i < 2048 * 256; i += NGT) { const int n = i >> 8, k = i & 255; const int z = n >> 10, col = n & 1023;
            float v = 0.f;
            if ((k >> 7) == z) v = F.in[I_G2][((size_t)(j * 2 + z) * 128 + (k & 127)) * D + col];
            lg[i] = (bf16)f2bf(v); }
    }
}

__device__ __forceinline__ void rw_hrow(Frame& F, int l, bool combine, const float* xsrc, float* xdst, bool own, int row, f32x4 (&h)[4]) {
    const int b = row >> 11; const float* mod = (const float*)(F.ws + WS_MOD);
    f32x4 x[4]; row_load(xsrc + (size_t)row * D, F.lane, x);
    if (combine) { row_combine(x, (const bf16*)(F.ws + WS_ACT + A_YS), (const int*)(F.ws + WS_TOKP), row, mod + (size_t)((l - 1) * 8 + b) * 6144 + 5 * D, F.lane);
        if (own) row_store(xdst + (size_t)row * D, F.lane, x); }
    const float* mp = mod + (size_t)(l * 8 + b) * 6144;
    row_norm_mod(x, F.in[I_NTM] + l * D, mp + 1 * D, mp + 0 * D, F.lane, h);
}
__device__ __forceinline__ void phase_rw_norm(Frame& F, int l, bool combine, const float* xsrc, float* xdst) {
    const int j = l >> 1; const float* mu = F.in[I_MU] + (size_t)j * 6 * D;
    bf16* xs = (bf16*)(F.ws + WS_ACT + A_XS); bf16* hx = (bf16*)(F.ws + WS_ACT + A_HX);
    for (int ch = F.gw; ch < T / 8; ch += F.NGW) {
        const int row0 = ch * 8, t0 = row0 & (SEQ - 1);
        f32x4 prev[4], cur[4], nxt[4];
        if (t0 > 0) rw_hrow(F, l, combine, xsrc, xdst, false, row0 - 1, prev);
        else {
#pragma unroll
            for (int q = 0; q < 4; ++q) prev[q] = (f32x4){0.f, 0.f, 0.f, 0.f}; }
        rw_hrow(F, l, combine, xsrc, xdst, true, row0, cur);
        for (int i = 0; i < 8; ++i) {
            const int row = row0 + i;
            if (t0 + i + 1 < SEQ) rw_hrow(F, l, combine, xsrc, xdst, i < 7, row + 1, nxt);
            else {
#pragma unroll
                for (int q = 0; q < 4; ++q) nxt[q] = (f32x4){0.f, 0.f, 0.f, 0.f}; }
            f32x4 xx[4];
#pragma unroll
            for (int q = 0; q < 4; ++q) xx[q] = 0.5f * (prev[q] + nxt[q]) - cur[q];
#pragma unroll
            for (int mi = 0; mi < 3; ++mi) { f32x4 o[4];
#pragma unroll
                for (int q = 0; q < 4; ++q) { const f32x4 m = *(const f32x4*)(mu + mi * D + 4 * F.lane + 256 * q); o[q] = cur[q] + xx[q] * m; }
                row_store_bf16(xs + ((size_t)mi * T + row) * D, F.lane, o); }
            row_store_bf16(hx + (size_t)row * 2048, F.lane, cur);
            row_store_bf16(hx + (size_t)row * 2048 + D, F.lane, xx);
#pragma unroll
            for (int q = 0; q < 4; ++q) { prev[q] = cur[q]; cur[q] = nxt[q]; }
        }
    }
}

__device__ __forceinline__ void phase_at_norm(Frame& F, int l, const float* xsrc, float* xdst) {
    const float* mod = (const float*)(F.ws + WS_MOD); bf16* H = (bf16*)(F.ws + WS_ACT + A_H);
    for (int row = F.gw; row < T; row += F.NGW) {
        const int b = row >> 11; f32x4 x[4], h[4]; row_load(xsrc + (size_t)row * D, F.lane, x);
        row_combine(x, (const bf16*)(F.ws + WS_ACT + A_YS), (const int*)(F.ws + WS_TOKP), row, mod + (size_t)((l - 1) * 8 + b) * 6144 + 5 * D, F.lane);
        row_store(xdst + (size_t)row * D, F.lane, x);
        const float* mp = mod + (size_t)(l * 8 + b) * 6144;
        row_norm_mod(x, F.in[I_NTM] + l * D, mp + 1 * D, mp + 0 * D, F.lane, h);
        row_store_bf16(H + (size_t)row * D, F.lane, h);
    }
}
__device__ __forceinline__ void phase_final(Frame& F, const float* xsrc) {
    const float* mod = (const float*)(F.ws + WS_MOD); const float* fg = F.in[I_FG];
    for (int row = F.gw; row < T; row += F.NGW) {
        const int b = row >> 11; f32x4 x[4]; row_load(xsrc + (size_t)row * D, F.lane, x);
        row_combine(x, (const bf16*)(F.ws + WS_ACT + A_YS), (const int*)(F.ws + WS_TOKP), row, mod + (size_t)(3 * 8 + b) * 6144 + 5 * D, F.lane);
        float s = 0.f;
#pragma unroll
        for (int j = 0; j < 4; ++j) s += (x[j][0] * x[j][0] + x[j][1] * x[j][1]) + (x[j][2] * x[j][2] + x[j][3] * x[j][3]);
        const float rstd = rsqrtf(wave_sum(s, F.lane) * (1.0f / D) + RMS_EPS);
#pragma unroll
        for (int j = 0; j < 4; ++j) { const f32x4 g = *(const f32x4*)(fg + 4 * F.lane + 256 * j); x[j] = x[j] * rstd * g; }
        row_store(F.out + (size_t)row * D, F.lane, x);
    }
}

__device__ __forceinline__ void phase_moe_route(Frame& F, int l, const float* xsrc, int cnt_shift = 0) {
    const float* mod = (const float*)(F.ws + WS_MOD); bf16* HN = (bf16*)(F.ws + WS_ACT + A_HN2);
    LAS int* lcnt = (LAS int*)F.lds; LAS int* gbase = lcnt + 32; LAS int* inf_e = lcnt + 64; LAS int* inf_r = inf_e + 128; LAS float* inf_w = (LAS float*)(inf_r + 128);
    unsigned* cnt = (unsigned*)(F.ws + WS_CTL) + CW_CNT + (l + cnt_shift) * 32;
    int* toke = (int*)(F.ws + WS_TOKE); int* tokr = (int*)(F.ws + WS_TOKR); float* tokw = (float*)(F.ws + WS_TOKW);
    const float* rg = F.in[I_RG] + (size_t)l * D * 4; const float* rgb = F.in[I_RGB] + l * 4;
    for (int cb = blockIdx.x; cb < T / 64; cb += F.G) {
        if (F.tid < 32) lcnt[F.tid] = 0;
        __syncthreads();
        for (int i = 0; i < 8; ++i) {
            const int lr = F.wave * 8 + i, row = cb * 64 + lr, b = row >> 11;
            f32x4 x[4], h[4]; row_load(xsrc + (size_t)row * D, F.lane, x);
            const float* mp = mod + (size_t)(l * 8 + b) * 6144;
            row_norm_mod(x, F.in[I_NCM] + l * D, mp + 4 * D, mp + 3 * D, F.lane, h);
            row_store_bf16(HN + (size_t)row * D, F.lane, h);
            float gl[4] = {0.f, 0.f, 0.f, 0.f};
#pragma unroll
            for (int j = 0; j < 4; ++j)
#pragma unroll
                for (int q = 0; q < 4; ++q) { const f32x4 w = *(const f32x4*)(rg + (size_t)(4 * F.lane + 256 * j + q) * 4);
#pragma unroll
                    for (int e = 0; e < 4; ++e) gl[e] += h[j][q] * w[e]; }
#pragma unroll
            for (int e = 0; e < 4; ++e) gl[e] = wave_sum(gl[e], F.lane) + rgb[e];
            const float gm = fmaxf(fmaxf(gl[0], gl[1]), fmaxf(gl[2], gl[3]));
            const int gtop = (gl[0] == gm) ? 0 : (gl[1] == gm) ? 1 : (gl[2] == gm) ? 2 : 3;
            const float pg = 1.0f / (__expf(gl[0] - gm) + __expf(gl[1] - gm) + __expf(gl[2] - gm) + __expf(gl[3] - gm));
            const float* re = F.in[I_RE] + (size_t)(l * 4 + gtop) * D * 8; const float* reb = F.in[I_REB] + (l * 4 + gtop) * 8;
            float el[8];
#pragma unroll
            for (int e = 0; e < 8; ++e) el[e] = 0.f;
#pragma unroll
            for (int j = 0; j < 4; ++j)
#pragma unroll
                for (int q = 0; q < 4; ++q) { const float* wp = re + (size_t)(4 * F.lane + 256 * j + q) * 8; const f32x4 w0 = *(const f32x4*)wp, w1 = *(const f32x4*)(wp + 4);
#pragma unroll
                    for (int e = 0; e < 4; ++e) { el[e] += h[j][q] * w0[e]; el[4 + e] += h[j][q] * w1[e]; } }
#pragma unroll
            for (int e = 0; e < 8; ++e) el[e] = wave_sum(el[e], F.lane) + reb[e];
            float v0 = el[0]; int i0 = 0;
#pragma unroll
            for (int e = 1; e < 8; ++e) if (el[e] > v0) { v0 = el[e]; i0 = e; }
            float v1 = -3.0e38f; int i1 = 0;
#pragma unroll
            for (int e = 0; e < 8; ++e) if (e != i0 && el[e] > v1) { v1 = el[e]; i1 = e; }
            const float ex = __expf(v1 - v0); const float w0 = pg / (1.0f + ex), w1 = pg * ex / (1.0f + ex);
            if (F.lane == 0) {
                const int e0 = gtop * 8 + i0, e1 = gtop * 8 + i1;
                const int r0 = __hip_atomic_fetch_add(lcnt + e0, 1, __ATOMIC_RELAXED, __HIP_MEMORY_SCOPE_WORKGROUP);
                const int r1 = __hip_atomic_fetch_add(lcnt + e1, 1, __ATOMIC_RELAXED, __HIP_MEMORY_SCOPE_WORKGROUP);
                inf_e[lr * 2] = e0; inf_e[lr * 2 + 1] = e1; inf_r[lr * 2] = r0; inf_r[lr * 2 + 1] = r1; inf_w[lr * 2] = w0; inf_w[lr * 2 + 1] = w1;
            }
        }
        __syncthreads();
        if (F.tid < 32) gbase[F.tid] = (int)__hip_atomic_fetch_add(cnt + F.tid, (unsigned)lcnt[F.tid], __ATOMIC_RELAXED, __HIP_MEMORY_SCOPE_AGENT);
        __syncthreads();
        if (F.tid < 128) { const int idx = cb * 128 + F.tid; const int e = inf_e[F.tid]; toke[idx] = e; tokr[idx] = gbase[e] + inf_r[F.tid]; tokw[idx] = inf_w[F.tid]; }
        __syncthreads();
    }
}
__device__ __forceinline__ void moe_tables(Frame& F, int l) {
    LAS int* tileE = (LAS int*)(F.lds + TILEE_OFF); LAS int* offs = (LAS int*)(F.lds + OFFS_OFF);
    const unsigned* cnt = (const unsigned*)(F.ws + WS_CTL) + CW_CNT + l * 32;
    if (F.tid == 0) { int o = 0, nt = 0;
#pragma clang loop unroll(disable)
        for (int e = 0; e < 32; ++e) { const int c = (int)__hip_atomic_load(cnt + e, __ATOMIC_RELAXED, __HIP_MEMORY_SCOPE_AGENT); offs[e] = o; const int ne = (c + 255) >> 8;
#pragma clang loop unroll(disable)
            for (int k = 0; k < ne && nt < 160; ++k) tileE[nt++] = e;
            o += ne * 256; }
        tileE[160] = nt; offs[32] = o; }
    __syncthreads();
}
__device__ __forceinline__ void phase_moe_gather(Frame& F, int l) {
    moe_tables(F, l);
    const LAS int* offs = (const LAS int*)(F.lds + OFFS_OFF);
    if (blockIdx.x == 0 && F.tid < 161) ((int*)(F.ws + WS_TILEE))[F.tid] = ((const LAS int*)(F.lds + TILEE_OFF))[F.tid];
    const int* toke = (const int*)(F.ws + WS_TOKE); const int* tokr = (const int*)(F.ws + WS_TOKR); const float* tokw = (const float*)(F.ws + WS_TOKW);
    int* tokp = (int*)(F.ws + WS_TOKP); float* roww = (float*)(F.ws + WS_ROWW);
    const bf16* HN = (const bf16*)(F.ws + WS_ACT + A_HN2); bf16* AS = (bf16*)(F.ws + WS_ACT + A_ASORT);
    for (int idx = F.gw; idx < 2 * T; idx += F.NGW) {
        const int e = toke[idx]; const int pos = offs[e] + tokr[idx];
        if (F.lane == 0) { tokp[idx] = pos; roww[pos] = tokw[idx]; }
        const bf16* src = HN + (size_t)(idx >> 1) * D; bf16* dst = AS + (size_t)pos * D;
        const u32x4 a = *(const u32x4*)(src + 8 * F.lane), b = *(const u32x4*)(src + 512 + 8 * F.lane);
        *(u32x4*)(dst + 8 * F.lane) = a; *(u32x4*)(dst + 512 + 8 * F.lane) = b;
    }
    LAS float* scr = (LAS float*)(F.lds + 49152 + F.wave * 8704);
    bf16* WGU = (bf16*)(F.ws + WS_WM + W_GU); bf16* WDN = (bf16*)(F.ws + WS_WM + W_DN);
    constexpr int I_GATE = 16 * 8, I_DOWN = 4 * 32;
    for (int it = F.gw; it < NEXP * (2 * I_GATE + I_DOWN); it += F.NGW) {
        const int e = it / (2 * I_GATE + I_DOWN); int r = it % (2 * I_GATE + I_DOWN);
        if (r < 2 * I_GATE) { const int up = r / I_GATE; r %= I_GATE; const int kb = r / 8, nb = r % 8, n0 = nb * 32;
            const float* src = (up ? F.in[I_WU] : F.in[I_WG]) + ((size_t)(l * 32 + e) * D + kb * 64) * FEXP + n0;
            const int drow = (n0 >> 7) * 256 + up * 128 + (n0 & 127);
            transpose_item(src, FEXP, WGU + ((size_t)e * 512 + drow) * D + kb * 64, D, scr, F.lane);
        } else { r -= 2 * I_GATE; const int kb = r / 32, nb = r % 32;
            const float* src = F.in[I_WD] + ((size_t)(l * 32 + e) * FEXP + kb * 64) * D + nb * 32;
            transpose_item(src, D, WDN + ((size_t)e * D + nb * 32) * FEXP + kb * 64, FEXP, scr, F.lane); }
    }
}

__device__ __forceinline__ void phase_scan(Frame& F, int l) {
    const int j = l >> 1;
    const bf16* Rb = (const bf16*)(F.ws + WS_ACT + A_RKV); const bf16* Kb = Rb + (size_t)T * D; const bf16* Vb = Kb + (size_t)T * D;
    const bf16* LD = (const bf16*)(F.ws + WS_ACT + A_LDEC); const bf16* AS = (const bf16*)(F.ws + WS_ACT + A_ASIG);
    bf16* Y = (bf16*)(F.ws + WS_ACT + A_Y); float* SB = (float*)(F.ws + WS_SB);
    LAS float* vb = (LAS float*)F.lds;
    LAS float* yb = (LAS float*)(F.lds + 98304);
    const int sp = F.tid >> 4, c4 = F.tid & 15, k0 = 4 * c4;
    const int rp = F.tid >> 4, seg = F.tid & 15;
    for (int unit = blockIdx.x; unit < NB * NH_R * 2; unit += F.G) {
        const int b = unit >> 5, h = (unit >> 1) & 15, dir = unit & 1; const int col = h * 64 + k0;
        const f32x4 kkc = *(const f32x4*)(F.in[I_KK] + j * D + col), kac = *(const f32x4*)(F.in[I_KA] + j * D + col), rkc = *(const f32x4*)(F.in[I_RK] + j * D + col);
        f32x4 S0 = {0.f, 0.f, 0.f, 0.f}, S1 = {0.f, 0.f, 0.f, 0.f};
        u32x2 gr, gk, gv, gl, ga;
#define SCAN_LOAD(blk) do { const int st = (blk) * 32 + sp; const int t = dir ? (SEQ - 1 - st) : st; const size_t ro = ((size_t)b * SEQ + t) * D + col; \
            gr = *(const u32x2*)(Rb + ro); gk = *(const u32x2*)(Kb + ro); gv = *(const u32x2*)(Vb + ro); gl = *(const u32x2*)(LD + (size_t)dir * T * D + ro); ga = *(const u32x2*)(AS + (size_t)dir * T * D + ro); } while (0)
#define SCAN_PREP(blk) do { LAS float* dst = vb + ((blk) & 1) * (6 * 32 * 64) + sp * 64 + k0; \
            const f32x4 kf = {bf_lo(gk.x), bf_hi(gk.x), bf_lo(gk.y), bf_hi(gk.y)}; const f32x4 rf = {bf_lo(gr.x), bf_hi(gr.x), bf_lo(gr.y), bf_hi(gr.y)}; \
            const f32x4 vf = {bf_lo(gv.x), bf_hi(gv.x), bf_lo(gv.y), bf_hi(gv.y)}; const f32x4 lf = {bf_lo(gl.x), bf_hi(gl.x), bf_lo(gl.y), bf_hi(gl.y)}; \
            const f32x4 af = {bf_lo(ga.x), bf_hi(ga.x), bf_lo(ga.y), bf_hi(ga.y)}; \
            f32x4 kkv = kf * kkc; float ss = (kkv[0] * kkv[0] + kkv[1] * kkv[1]) + (kkv[2] * kkv[2] + kkv[3] * kkv[3]); ss = rowsum16(ss); \
            const float inv = 1.0f / fmaxf(sqrtf(ss), 1e-12f); kkv = kkv * inv; \
            const f32x4 kd = kf * (1.0f + (af - 1.0f) * kac); \
            f32x4 wv; wv[0] = __builtin_amdgcn_exp2f(lf[0]); wv[1] = __builtin_amdgcn_exp2f(lf[1]); wv[2] = __builtin_amdgcn_exp2f(lf[2]); wv[3] = __builtin_amdgcn_exp2f(lf[3]); \
            float bo = (rf[0] * kd[0] * rkc[0] + rf[1] * kd[1] * rkc[1]) + (rf[2] * kd[2] * rkc[2] + rf[3] * kd[3] * rkc[3]); bo = rowsum16(bo); \
            { const int st = (blk) * 32 + sp; const int t = dir ? (SEQ - 1 - st) : st; if (c4 == 0) SB[((size_t)dir * T + (size_t)b * SEQ + t) * 16 + h] = bo; } \
            *(LAS f32x4*)(dst + 0 * 2048) = wv; *(LAS f32x4*)(dst + 1 * 2048) = kd; *(LAS f32x4*)(dst + 2 * 2048) = -kkv; *(LAS f32x4*)(dst + 3 * 2048) = kkv * af; \
            *(LAS f32x4*)(dst + 4 * 2048) = rf; *(LAS f32x4*)(dst + 5 * 2048) = vf; } while (0)
        SCAN_LOAD(0); SCAN_PREP(0); SCAN_LOAD(1);
        __syncthreads();
        for (int blk = 0; blk < SEQ / 32; ++blk) {
            if (blk + 1 < SEQ / 32) SCAN_PREP(blk + 1);
            if (blk + 2 < SEQ / 32) SCAN_LOAD(blk + 2);
            const LAS float* src = vb + (blk & 1) * (6 * 32 * 64) + 4 * seg; LAS float* yo = yb + (blk & 1) * 2048 + 2 * rp;
#pragma unroll 4
            for (int s = 0; s < 32; ++s) {
                const f32x4 w = *(const LAS f32x4*)(src + 0 * 2048 + s * 64), kd = *(const LAS f32x4*)(src + 1 * 2048 + s * 64), av = *(const LAS f32x4*)(src + 2 * 2048 + s * 64);
                const f32x4 bv = *(const LAS f32x4*)(src + 3 * 2048 + s * 64), rv = *(const LAS f32x4*)(src + 4 * 2048 + s * 64);
                const f32x2 vv = *(const LAS f32x2*)(vb + (blk & 1) * (6 * 32 * 64) + 5 * 2048 + s * 64 + 2 * rp);
                float sa0 = (S0[0] * av[0] + S0[1] * av[1]) + (S0[2] * av[2] + S0[3] * av[3]);
                float sa1 = (S1[0] * av[0] + S1[1] * av[1]) + (S1[2] * av[2] + S1[3] * av[3]);
                sa0 = rowsum16(sa0); sa1 = rowsum16(sa1);
                S0 = S0 * w + sa0 * bv + vv[0] * kd; S1 = S1 * w + sa1 * bv + vv[1] * kd;
                float y0 = (S0[0] * rv[0] + S0[1] * rv[1]) + (S0[2] * rv[2] + S0[3] * rv[3]);
                float y1 = (S1[0] * rv[0] + S1[1] * rv[1]) + (S1[2] * rv[2] + S1[3] * rv[3]);
                y0 = rowsum16(y0); y1 = rowsum16(y1);
                if (seg == 0) *(LAS f32x2*)(yo + s * 64) = (f32x2){y0, y1};
            }
            __syncthreads();
            { const int st = blk * 32 + sp; const int t = dir ? (SEQ - 1 - st) : st; const f32x4 yv = *(const LAS f32x4*)(yb + (blk & 1) * 2048 + sp * 64 + k0);
              u32x2 o; o.x = pk2(yv[0], yv[1]); o.y = pk2(yv[2], yv[3]); *(u32x2*)(Y + ((size_t)dir * T + (size_t)b * SEQ + t) * D + col) = o; }
        }
        __syncthreads();
#undef SCAN_LOAD
#undef SCAN_PREP
    }
}

__device__ __forceinline__ void phase_rw_post(Frame& F, int l) {
    const int j = l >> 1; const float* lnw = F.in[I_LNW] + j * D; const float* lnb = F.in[I_LNB] + j * D;
    const bf16* Vb = (const bf16*)(F.ws + WS_ACT + A_RKV) + (size_t)2 * T * D; const bf16* Y = (const bf16*)(F.ws + WS_ACT + A_Y); const bf16* Gb = (const bf16*)(F.ws + WS_ACT + A_G);
    const float* SB = (const float*)(F.ws + WS_SB); bf16* O = (bf16*)(F.ws + WS_ACT + A_O);
    for (int row = F.gw; row < T; row += F.NGW) {
        f32x4 o[4];
#pragma unroll
        for (int q = 0; q < 4; ++q) {
            const int c = 4 * F.lane + 256 * q; const int head = 4 * q + (F.lane >> 4);
            const u32x2 vr = *(const u32x2*)(Vb + (size_t)row * D + c); const f32x4 vf = {bf_lo(vr.x), bf_hi(vr.x), bf_lo(vr.y), bf_hi(vr.y)};
            const f32x4 w = *(const f32x4*)(lnw + c), bb = *(const f32x4*)(lnb + c);
            f32x4 acc = {0.f, 0.f, 0.f, 0.f};
#pragma unroll
            for (int dir = 0; dir < 2; ++dir) {
                const size_t ro = ((size_t)dir * T + row) * D + c;
                const u32x2 yr = *(const u32x2*)(Y + ro), gr = *(const u32x2*)(Gb + ro);
                const f32x4 yf = {bf_lo(yr.x), bf_hi(yr.x), bf_lo(yr.y), bf_hi(yr.y)}; const f32x4 gf = {bf_lo(gr.x), bf_hi(gr.x), bf_lo(gr.y), bf_hi(gr.y)};
                const float sbv = SB[((size_t)dir * T + row) * 16 + head];
                const float mean = rowsum16((yf[0] + yf[1]) + (yf[2] + yf[3])) * (1.0f / 64.0f);
                const f32x4 d = yf - mean; const float var = rowsum16((d[0] * d[0] + d[1] * d[1]) + (d[2] * d[2] + d[3] * d[3])) * (1.0f / 64.0f);
                const float rs = rsqrtf(var + GN_EPS);
                acc += gf * (d * rs * w + bb + sbv * vf);
            }
            o[q] = acc;
        }
        row_store_bf16(O + (size_t)row * D, F.lane, o);
    }
}

__device__ __forceinline__ unsigned att_f(unsigned row) { return ((row & 3u) << 2) | ((row >> 2) & 3u); }
__device__ __forceinline__ unsigned att_off_b(unsigned row, unsigned ch) { return 256u * row + 16u * (ch ^ att_f(row)); }
__device__ __forceinline__ void phase_attn(Frame& F) {
    const bf16* Qb = (const bf16*)(F.ws + WS_ACT + A_Q); const bf16* Kb = (const bf16*)(F.ws + WS_ACT + A_K); const bf16* Vb = (const bf16*)(F.ws + WS_ACT + A_VT);
    bf16* AO = (bf16*)(F.ws + WS_ACT + A_AO);
    const int lane = F.lane, qi = lane & 15, q4 = lane >> 4;
    LAS unsigned char* kl = F.lds + F.wave * 16384; LAS unsigned char* vl = kl + 8192;
    const unsigned kl_a = (unsigned)(size_t)kl, vl_a = (unsigned)(size_t)vl;
    unsigned ka[2][4], va[8][2];
#pragma unroll
    for (int rb = 0; rb < 2; ++rb)
#pragma unroll
        for (int s = 0; s < 4; ++s) ka[rb][s] = att_off_b((unsigned)(qi + 16 * rb), (unsigned)(4 * s + q4));
    { const unsigned q = (unsigned)qi >> 2, p = (unsigned)lane & 3u;
#pragma unroll
      for (int c = 0; c < 8; ++c)
#pragma unroll
          for (int t = 0; t < 2; ++t) va[c][t] = vl_a + att_off_b(8u * q4 + 4u * t + q, 2u * c + (p >> 1)) + 8u * (p & 1u); }
    unsigned fk[8];
#pragma unroll
    for (int i = 0; i < 8; ++i) { const unsigned rho = 4u * i + (unsigned)q4, m = rho & 15u, rb = rho >> 4; const unsigned kidx = 8u * (m >> 2) + (m & 3u) + 4u * rb;
        fk[i] = kidx | ((16u * ((unsigned)qi ^ att_f(rho))) << 8); }
    for (int u = blockIdx.x; u < NB * 8 * 8; u += F.G) {
        const int b = u >> 6, hs = (u >> 3) & 7, p0 = (u & 7) * 16;
        const int rX = F.wave, rY = F.wave + 8;
        const int tqX = rX + 16 * (p0 + qi), tqY = rY + 16 * (p0 + qi);
        float m_run[2] = {-1e30f, -1e30f}, l_run[2] = {0.f, 0.f}; f32x4 O[2][8];
#pragma unroll
        for (int qt = 0; qt < 2; ++qt)
#pragma unroll
            for (int dt = 0; dt < 8; ++dt) O[qt][dt] = (f32x4){0.f, 0.f, 0.f, 0.f};
        bf16x8 Qf[2][4];
#define ATT_PARAMS(vs, g_, s_, act_) const int g_ = (vs) < 12 ? 0 : ((vs) < 18 ? 1 : 2); const int s_ = (vs) < 12 ? (vs) : ((vs) < 18 ? (vs) - 12 : ((vs) < 23 ? (vs) - 18 : (vs) - 23)); const int act_ = (vs) < 18 ? 3 : ((vs) < 23 ? 1 : 2);
#define ATT_FILL(vs, WHICH) do { ATT_PARAMS(vs, g_, s_, act_) const int dsh_ = 2 * g_, Lg_ = SEQ >> dsh_; const int rg_ = ((act_ == 2) ? rY : rX) & ((1 << dsh_) - 1); \
            const int base_ = ((16 * p0) >> dsh_) - 64 + 32 * s_; const bf16* src_ = ((WHICH) ? Vb : Kb) + ((size_t)g_ * T + (size_t)b * SEQ) * D + hs * 128; \
            _Pragma("unroll") for (int i_ = 0; i_ < 8; ++i_) { const int kidx_ = (WHICH) ? (4 * i_ + q4) : (int)(fk[i_] & 255u); const int p_ = min(max(base_ + kidx_, 0), Lg_ - 1); \
                const char* gp_ = (const char*)(src_ + (size_t)(rg_ + (p_ << dsh_)) * D) + (fk[i_] >> 8); \
                __builtin_amdgcn_global_load_lds((const unsigned*)gp_, (LAS unsigned*)(((WHICH) ? vl : kl) + i_ * 1024), 16, 0, 0); } } while (0)
        ATT_FILL(0, 0); ATT_FILL(0, 1);
        for (int vs = 0; vs < 28; ++vs) {
            ATT_PARAMS(vs, g, s, act)
            const int dsh = 2 * g, Lg = SEQ >> dsh;
            if (vs == 0 || vs == 12 || vs == 18) {
                const bf16* qx = Qb + ((size_t)g * T + (size_t)b * SEQ + tqX) * D + hs * 128 + 8 * q4; const bf16* qy = Qb + ((size_t)g * T + (size_t)b * SEQ + tqY) * D + hs * 128 + 8 * q4;
#pragma unroll
                for (int kt = 0; kt < 4; ++kt) { Qf[0][kt] = *(const bf16x8*)(qx + 32 * kt); Qf[1][kt] = *(const bf16x8*)(qy + 32 * kt); }
            }
            const float slope2 = exp2f(-8.0f * (float)(g * 8 + hs + 1) / 24.0f) * LOG2E * (float)(1 << dsh);
            const int base = ((16 * p0) >> dsh) - 64 + 32 * s;
            asm volatile("s_waitcnt vmcnt(8)" ::: "memory");
            bf16x8 KA[4], KB[4];
#pragma unroll
            for (int kt = 0; kt < 4; ++kt) { KA[kt] = *(const LAS bf16x8*)(kl + ka[0][kt]); KB[kt] = *(const LAS bf16x8*)(kl + ka[1][kt]); }
            asm volatile("s_waitcnt lgkmcnt(0)" ::: "memory");
            if (vs + 1 < 28) ATT_FILL(vs + 1, 0);
            f32x4 SA[2], SBt[2];
#pragma unroll
            for (int qt = 0; qt < 2; ++qt) { SA[qt] = (f32x4){0.f, 0.f, 0.f, 0.f}; SBt[qt] = (f32x4){0.f, 0.f, 0.f, 0.f};
                if ((act >> qt) & 1) {
#pragma unroll
                    for (int kt = 0; kt < 4; ++kt) { SA[qt] = __builtin_amdgcn_mfma_f32_16x16x32_bf16(KA[kt], Qf[qt][kt], SA[qt], 0, 0, 0); SBt[qt] = __builtin_amdgcn_mfma_f32_16x16x32_bf16(KB[kt], Qf[qt][kt], SBt[qt], 0, 0, 0); } } }
            bf16x8 pf[2]; float alpha[2];
#pragma unroll
            for (int qt = 0; qt < 2; ++qt) {
                alpha[qt] = 1.0f; { union { u32x4 u; bf16x8 v; } z; z.u = (u32x4){0u, 0u, 0u, 0u}; pf[qt] = z.v; }
                if ((act >> qt) & 1) {
                    const int Pq = (qt ? tqY : tqX) >> dsh; const int cb = base + 8 * q4;
                    float sv[8]; bool ok[8]; float mx = -1e30f;
#pragma unroll
                    for (int r = 0; r < 8; ++r) { const int p = cb + r; const int rel = abs(p - Pq); ok[r] = (p >= 0) && (p < Lg) && (rel <= 64);
                        const float sc = (r < 4 ? SA[qt][r & 3] : SBt[qt][r & 3]) - slope2 * (float)rel; sv[r] = ok[r] ? sc : -1e30f; mx = fmaxf(mx, sv[r]); }
                    mx = fmaxf(mx, lane_xor(mx, lane, 16)); mx = fmaxf(mx, lane_xor(mx, lane, 32));
                    const float m_new = fmaxf(m_run[qt], mx); alpha[qt] = __builtin_amdgcn_exp2f(m_run[qt] - m_new); m_run[qt] = m_new;
                    float pe[8]; float rs = 0.f;
#pragma unroll
                    for (int r = 0; r < 8; ++r) { pe[r] = ok[r] ? __builtin_amdgcn_exp2f(sv[r] - m_new) : 0.f; rs += pe[r]; }
                    rs += lane_xor(rs, lane, 16); rs += lane_xor(rs, lane, 32);
                    l_run[qt] = l_run[qt] * alpha[qt] + rs;
                    union { u32x4 u; bf16x8 v; } z; z.u.x = pk2(pe[0], pe[1]); z.u.y = pk2(pe[2], pe[3]); z.u.z = pk2(pe[4], pe[5]); z.u.w = pk2(pe[6], pe[7]); pf[qt] = z.v;
                }
            }
            if (vs + 1 < 28) asm volatile("s_waitcnt vmcnt(8)" ::: "memory"); else asm volatile("s_waitcnt vmcnt(0)" ::: "memory");
#pragma unroll
            for (int hf = 0; hf < 2; ++hf) {
                u32x2 vr[4][2];
                asm volatile("ds_read_b64_tr_b16 %0, %8\n\tds_read_b64_tr_b16 %1, %9\n\tds_read_b64_tr_b16 %2, %10\n\tds_read_b64_tr_b16 %3, %11\n\t"
                             "ds_read_b64_tr_b16 %4, %12\n\tds_read_b64_tr_b16 %5, %13\n\tds_read_b64_tr_b16 %6, %14\n\tds_read_b64_tr_b16 %7, %15\n\ts_waitcnt lgkmcnt(0)"
                             : "=&v"(vr[0][0]), "=&v"(vr[0][1]), "=&v"(vr[1][0]), "=&v"(vr[1][1]), "=&v"(vr[2][0]), "=&v"(vr[2][1]), "=&v"(vr[3][0]), "=&v"(vr[3][1])
                             : "v"(va[4 * hf + 0][0]), "v"(va[4 * hf + 0][1]), "v"(va[4 * hf + 1][0]), "v"(va[4 * hf + 1][1]), "v"(va[4 * hf + 2][0]), "v"(va[4 * hf + 2][1]), "v"(va[4 * hf + 3][0]), "v"(va[4 * hf + 3][1])
                             : "memory");
                if (hf == 1 && vs + 1 < 28) ATT_FILL(vs + 1, 1);
#pragma unroll
                for (int c = 0; c < 4; ++c) { const int dt = 4 * hf + c; union { u32x4 u; bf16x8 v; } vf; vf.u.x = vr[c][0].x; vf.u.y = vr[c][0].y; vf.u.z = vr[c][1].x; vf.u.w = vr[c][1].y;
#pragma unroll
                    for (int qt = 0; qt < 2; ++qt) if ((act >> qt) & 1) { O[qt][dt] = O[qt][dt] * alpha[qt]; O[qt][dt] = __builtin_amdgcn_mfma_f32_16x16x32_bf16(vf.v, pf[qt], O[qt][dt], 0, 0, 0); } }
            }
        }
#pragma unroll
        for (int qt = 0; qt < 2; ++qt) { const float inv = 1.0f / l_run[qt];
            bf16* op = AO + ((size_t)b * SEQ + (qt ? tqY : tqX)) * D + hs * 128 + 4 * q4;
#pragma unroll
            for (int dt = 0; dt < 8; ++dt) { u32x2 o; o.x = pk2(O[qt][dt][0] * inv, O[qt][dt][1] * inv); o.y = pk2(O[qt][dt][2] * inv, O[qt][dt][3] * inv); *(u32x2*)(op + 16 * dt) = o; } }
#undef ATT_PARAMS
#undef ATT_FILL
    }
}

constexpr int PH_PER_LAYER = 10, N_PHASES = 1 + DEPTH * PH_PER_LAYER + 1;
template <int MASK> __global__ void __launch_bounds__(NTHREADS, 2) mk_fwd(Args args) {
    extern __shared__ __attribute__((aligned(16))) unsigned char lds_raw[];
#define PHASE_FRAME() Frame F; { int t_ = wave0 * 64 + (int)__lane_id(); asm volatile("" : "+v"(t_)); unsigned char* w_ = args.ws; asm volatile("" : "+s"(w_)); \
        unsigned lb_ = 0; asm volatile("" : "+s"(lb_)); F.lds = (LAS unsigned char*)lds_raw + lb_; F.tid = t_; F.lane = t_ & 63; F.wave = __builtin_amdgcn_readfirstlane(t_ >> 6); \
        F.G = gridDim.x; F.gw = blockIdx.x * NWAVES + F.wave; F.NGW = F.G * NWAVES; F.ws = w_; F.in = args.in; F.out = args.out; }
    LAS unsigned char* lds0 = (LAS unsigned char*)lds_raw;
    const int wave0 = __builtin_amdgcn_readfirstlane((int)threadIdx.x >> 6);
    volatile LAS unsigned* MISC = (volatile LAS unsigned*)(lds0 + MISC_OFF);
    if (wave0 == 0) ((LAS unsigned*)(lds0 + 131072))[__lane_id() + 64] = 0u;
    __syncthreads();
    unsigned* ctl = (unsigned*)(args.ws + WS_CTL);
    XcdBarrier bar; bar.bar = ctl + CW_BAR; bar.x = 0; bar.st = nullptr;
#if ONE_LAUNCH
    bar = xcd_barrier_post(ctl + CW_BAR, MISC + 8, wave0 == 0 && __lane_id() == 0);
#endif
    const int lo = args.ph_lo, hi = args.ph_hi;
#define EN(b) ((MASK >> (b)) & 1)
#ifndef DUP_MASK
#define DUP_MASK 0
#endif
#define REP(b) for (int rep_ = 0; rep_ < 1 + ((DUP_MASK >> (b)) & 1); ++rep_)
#define IN(k) (lo <= (k) && (k) < hi)
#if ONE_LAUNCH
#ifndef BAR_REP
#define BAR_REP 1
#endif
#define SEAM(k) do { if (IN((k) + 1) || (k) + 1 < hi) { for (int br_ = 0; br_ < BAR_REP; ++br_) xcd_barrier(bar, wave0 == 0 && __lane_id() == 0); } } while (0)
#else
#define SEAM(k) do { } while (0)
#endif
    float* X0 = args.out; float* X1 = (float*)(args.ws + WS_X1);
    if (EN(0) && IN(0)) { PHASE_FRAME(); REP(0) phase_prologue(F); SEAM(0); }
    for (int l = 0; l < DEPTH; ++l) {
        const int pb = 1 + l * PH_PER_LAYER; const int j = l >> 1;
        const float* xin = (l == 0) ? args.in[I_X] : ((l & 1) ? X0 : X1);
        float* xcur = (l == 0) ? X0 : ((l & 1) ? X1 : X0);
        if ((l & 1) == 0) {
            if (EN(1) && IN(pb + 0)) { PHASE_FRAME(); REP(1) phase_rw_norm(F, l, l > 0, xin, xcur); SEAM(pb + 0); }
            if (EN(2) && IN(pb + 1)) { PHASE_FRAME(); REP(2) {
                { DenseSched S; S.o.init(T / 256, 12, F.G, blockIdx.x); S.A = (const char*)(F.ws + WS_ACT + A_XS); S.a_sel_stride = (size_t)T * D * 2; S.pn_per_a = 4;
                  S.B = (const char*)(F.ws + WS_W + j * W_RW_STRIDE + W_RKV); S.tstepA = (size_t)256 * D * 2; S.tstepB = (size_t)256 * D * 2;
                  EpiSplit E{(bf16*)(F.ws + WS_ACT + A_RKV), (size_t)T * D, 1.0f};
                  pg8::gemm_phase(F.lds, F.tid, D, D, D, S, E); }
                { DenseSched S; S.o.init(T / 256, 2, F.G, blockIdx.x); S.A = (const char*)(F.ws + WS_ACT + A_HX); S.a_sel_stride = 0; S.pn_per_a = 1 << 20;
                  S.B = (const char*)(F.ws + WS_W + j * W_RW_STRIDE + W_LDN); S.tstepA = (size_t)256 * 2048 * 2; S.tstepB = (size_t)256 * 2048 * 2;
                  EpiLoraDn E{(bf16*)(F.ws + WS_ACT + A_LORAH)};
                  pg8::gemm_phase(F.lds, F.tid, 2048, 2048, 2048, S, E); }
                }
                SEAM(pb + 1);
            }
            if (EN(3) && IN(pb + 2)) { PHASE_FRAME(); REP(3) {
                { DenseSched S; S.o.init(T / 256, 16, F.G, blockIdx.x); S.A = (const char*)(F.ws + WS_ACT + A_LORAH); S.a_sel_stride = 0; S.pn_per_a = 1 << 20;
                  S.B = (const char*)(F.ws + WS_W + j * W_RW_STRIDE + W_LUPWA); S.tstepA = (size_t)256 * 512 * 2; S.tstepB = (size_t)256 * 256 * 2;
                  EpiLoraUpWA E{(bf16*)(F.ws + WS_ACT + A_LDEC), (bf16*)(F.ws + WS_ACT + A_ASIG), F.in[I_W0] + j * 2 * D, F.in[I_A0] + j * 2 * D};
                  pg8::gemm_phase(F.lds, F.tid, 256, 512, 256, S, E); }
                { DenseSched S; S.o.init(T / 256, 8, F.G, blockIdx.x); S.A = (const char*)(F.ws + WS_ACT + A_LORAH) + 512; S.a_sel_stride = 0; S.pn_per_a = 1 << 20;
                  S.B = (const char*)(F.ws + WS_W + j * W_RW_STRIDE + W_LUPG); S.tstepA = (size_t)256 * 512 * 2; S.tstepB = (size_t)256 * 256 * 2;
                  EpiSplit E{(bf16*)(F.ws + WS_ACT + A_G), (size_t)T * D, 1.0f};
                  pg8::gemm_phase(F.lds, F.tid, 256, 512, 256, S, E); }
                }
                SEAM(pb + 2);
            }
            if (EN(4) && IN(pb + 3)) { PHASE_FRAME(); REP(4) phase_scan(F, l); SEAM(pb + 3); }
            if (EN(5) && IN(pb + 4)) { PHASE_FRAME(); REP(5) phase_rw_post(F, l); SEAM(pb + 4); }
            if (EN(6) && IN(pb + 5)) { PHASE_FRAME();
                DenseSched S; S.o.init(T / 256, 4, F.G, blockIdx.x); S.A = (const char*)(F.ws + WS_ACT + A_O); S.a_sel_stride = 0; S.pn_per_a = 1 << 20;
                S.B = (const char*)(F.ws + WS_W + j * W_RW_STRIDE + W_RWO); S.tstepA = (size_t)256 * D * 2; S.tstepB = (size_t)256 * D * 2;
                EpiResid E{(l == 0) ? F.in[I_X] : (const float*)xcur, xcur, (const float*)(F.ws + WS_MOD) + (size_t)l * 8 * 6144 + 2 * D};
                pg8::gemm_phase(F.lds, F.tid, D, D, D, S, E);
                SEAM(pb + 5);
            }
        } else {
            if (EN(7) && IN(pb + 0)) { PHASE_FRAME(); REP(7) phase_at_norm(F, l, xin, xcur); SEAM(pb + 0); }
            if (EN(8) && IN(pb + 1)) { PHASE_FRAME(); REP(8) {
                DenseSched S; S.o.init(T / 256, 36, F.G, blockIdx.x); S.A = (const char*)(F.ws + WS_ACT + A_H); S.a_sel_stride = 0; S.pn_per_a = 1 << 20;
                S.B = (const char*)(F.ws + WS_WA + j * W_AT_STRIDE + W_QKV); S.tstepA = (size_t)256 * D * 2; S.tstepB = (size_t)256 * D * 2;
                EpiQKV E{(bf16*)(F.ws + WS_ACT + A_Q), (bf16*)(F.ws + WS_ACT + A_K), (bf16*)(F.ws + WS_ACT + A_VT), 0.08838834764831845f * LOG2E};
                pg8::gemm_phase(F.lds, F.tid, D, D, D, S, E);
                }
                SEAM(pb + 1);
            }
            if (EN(9) && IN(pb + 2)) { PHASE_FRAME(); REP(9) phase_attn(F); SEAM(pb + 2); }
            if (EN(10) && IN(pb + 3)) { PHASE_FRAME();
                DenseSched S; S.o.init(T / 256, 4, F.G, blockIdx.x); S.A = (const char*)(F.ws + WS_ACT + A_AO); S.a_sel_stride = 0; S.pn_per_a = 1 << 20;
                S.B = (const char*)(F.ws + WS_WA + j * W_AT_STRIDE + W_AWO); S.tstepA = (size_t)256 * D * 2; S.tstepB = (size_t)256 * D * 2;
                EpiResid E{(const float*)xcur, xcur, (const float*)(F.ws + WS_MOD) + (size_t)l * 8 * 6144 + 2 * D};
                pg8::gemm_phase(F.lds, F.tid, D, D, D, S, E);
                SEAM(pb + 3);
            }
        }
        if (EN(11) && IN(pb + 6)) { PHASE_FRAME(); if ((DUP_MASK >> 11) & 1) phase_moe_route(F, l, xcur, 4); phase_moe_route(F, l, xcur); SEAM(pb + 6); }
        if (EN(12) && IN(pb + 7)) { PHASE_FRAME(); REP(12) phase_moe_gather(F, l); SEAM(pb + 7); }
        if (EN(13) && IN(pb + 8)) { PHASE_FRAME(); REP(13) {
            MoeSched S; S.tileE = (const int*)(F.ws + WS_TILEE); S.ntiles = uni(S.tileE[160]); S.npn = 2; S.G = F.G; S.c = blockIdx.x;
            S.A = (const char*)(F.ws + WS_ACT + A_ASORT); S.B = (const char*)(F.ws + WS_WM + W_GU); S.tstepA = (size_t)256 * D * 2; S.tstepB = (size_t)256 * D * 2; S.estride = (size_t)512 * D * 2;
            EpiGateUp E{(bf16*)(F.ws + WS_ACT + A_HID), (const float*)(F.ws + WS_ROWW)};
            pg8::gemm_phase(F.lds, F.tid, D, D, D, S, E);
            }
                SEAM(pb + 8);
        }
        if (EN(14) && IN(pb + 9)) { PHASE_FRAME(); REP(14) {
            MoeSched S; S.tileE = (const int*)(F.ws + WS_TILEE); S.ntiles = uni(S.tileE[160]); S.npn = 4; S.G = F.G; S.c = blockIdx.x;
            S.A = (const char*)(F.ws + WS_ACT + A_HID); S.B = (const char*)(F.ws + WS_WM + W_DN); S.tstepA = (size_t)256 * FEXP * 2; S.tstepB = (size_t)256 * FEXP * 2; S.estride = (size_t)D * FEXP * 2;
            EpiPlain E{(bf16*)(F.ws + WS_ACT + A_YS)};
            pg8::gemm_phase(F.lds, F.tid, FEXP, FEXP, FEXP, S, E);
            }
                SEAM(pb + 9);
        }
    }
    if (EN(15) && IN(N_PHASES - 1)) { PHASE_FRAME(); phase_final(F, X1); }
#undef IN
#undef SEAM
}

typedef void (*kern_t)(Args);
template <int B> static kern_t kern_of_bit(int b) { if (b == B) return mk_fwd<(1 << B)>; if constexpr (B > 0) return kern_of_bit<B - 1>(b); else return nullptr; }
static int kind_of_phase(int p) {
    if (p == 0) return 0; if (p == N_PHASES - 1) return 15;
    const int l = (p - 1) / PH_PER_LAYER, k = (p - 1) % PH_PER_LAYER;
    if (k >= 6) return 11 + (k - 6);
    if ((l & 1) == 0) return 1 + k;
    return (k < 4) ? 7 + k : -1;
}
extern "C" void kernel_launch(void* const* d_in, const int* in_sizes, int n_in, void* d_out, int out_size, void* d_ws, size_t ws_size, hipStream_t stream) {
    static int grid = 0;
    if (grid == 0) {
        if (n_in != 32 || out_size != T * D || ws_size < WS_END) { fprintf(stderr, "kernel_launch: unexpected shapes (n_in %d out %d ws %zu need %zu)\n", n_in, out_size, ws_size, (size_t)WS_END); grid = -1; return; }
        int dev = 0, cus = 0;
        if (hipGetDevice(&dev) != hipSuccess || hipDeviceGetAttribute(&cus, hipDeviceAttributeMultiprocessorCount, dev) != hipSuccess) { grid = -1; return; }
#if ONE_LAUNCH
        if (hipFuncSetAttribute((const void*)mk_fwd<0xffff>, hipFuncAttributeMaxDynamicSharedMemorySize, LDS_BYTES) != hipSuccess) { fprintf(stderr, "kernel_launch: hipFuncSetAttribute failed\n"); grid = -1; return; }
#else
        for (int b = 0; b < 16; ++b) if (hipFuncSetAttribute((const void*)kern_of_bit<15>(b), hipFuncAttributeMaxDynamicSharedMemorySize, LDS_BYTES) != hipSuccess) { fprintf(stderr, "kernel_launch: hipFuncSetAttribute failed\n"); grid = -1; return; }
#endif
        (void)hipGetLastError();
        grid = cus;
    }
    if (grid < 0) return;
    (void)hipMemsetAsync((char*)d_ws + WS_CTL, 0, CTL_ZERO_BYTES, stream);
    Args a{};
    for (int i = 0; i < 32; ++i) a.in[i] = (const float*)d_in[i];
    a.out = (float*)d_out; a.ws = (unsigned char*)d_ws;
#if ONE_LAUNCH
#ifndef SPLIT_EVERY
#define SPLIT_EVERY N_PHASES
#endif
    for (int p = 0; p < N_PHASES; p += SPLIT_EVERY) {
        a.ph_lo = p; a.ph_hi = (p + SPLIT_EVERY < N_PHASES) ? p + SPLIT_EVERY : N_PHASES;
        hipLaunchKernelGGL(mk_fwd<0xffff>, dim3(grid), dim3(NTHREADS), LDS_BYTES, stream, a);
    }
#else
    for (int p = 0; p < N_PHASES; ++p) {
        const int kind = kind_of_phase(p); if (kind < 0) continue;
        a.ph_lo = p; a.ph_hi = p + 1;
        hipLaunchKernelGGL(kern_of_bit<15>(kind), dim3(grid), dim3(NTHREADS), LDS_BYTES, stream, a);
    }
#endif
}
```

```cpp
#include <hip/hip_runtime.h>
#include <cstdio>
#include <cstdint>

#ifndef ONE_LAUNCH
#define ONE_LAUNCH 1
#endif


#define LAS __attribute__((address_space(3)))
typedef unsigned short bf16;
typedef short bf16x8 __attribute__((ext_vector_type(8)));
typedef float f32x4 __attribute__((ext_vector_type(4)));
typedef float f32x2 __attribute__((ext_vector_type(2)));
typedef unsigned u32x4 __attribute__((ext_vector_type(4)));
typedef unsigned u32x2 __attribute__((ext_vector_type(2)));

constexpr int NB = 8, SEQ = 2048, D = 1024, T = NB * SEQ, DEPTH = 4;
constexpr int NH_R = 16, HD_R = 64;
constexpr int QKVW = 9216;
constexpr int NEXP = 32, FEXP = 256;
constexpr int MAXROWS = 40960;
constexpr int NWAVES = 8, NTHREADS = 512;
constexpr float RMS_EPS = 1e-6f, GN_EPS = 64e-5f;
constexpr float LOG2E = 1.4426950408889634f;

constexpr size_t MiB = 1u << 20;
constexpr size_t WS_CTL = 0, CTL_ZERO_BYTES = 64 * 1024;
constexpr size_t WS_MOD = 1 * MiB;
constexpr size_t WS_TOKE = 2 * MiB;
constexpr size_t WS_TOKR = WS_TOKE + 128 * 1024;
constexpr size_t WS_TOKW = WS_TOKR + 128 * 1024;
constexpr size_t WS_TOKP = WS_TOKW + 128 * 1024;
constexpr size_t WS_ROWW = WS_TOKP + 128 * 1024;
constexpr size_t WS_TILEE = WS_ROWW + 192 * 1024;
constexpr size_t WS_SB = 4 * MiB;
constexpr size_t WS_W = 8 * MiB;
constexpr size_t W_RKV = 0, W_LDN = 6 * MiB, W_LUPWA = 8 * MiB, W_LUPG = 10 * MiB, W_RWO = 11 * MiB, W_RW_STRIDE = 13 * MiB;
constexpr size_t WS_WA = WS_W + 2 * W_RW_STRIDE;
constexpr size_t W_QKV = 0, W_AWO = 18 * MiB, W_AT_STRIDE = 20 * MiB;
constexpr size_t WS_WM = WS_WA + 2 * W_AT_STRIDE;
constexpr size_t W_GU = 0, W_DN = 32 * MiB;
constexpr size_t WS_X1 = 128 * MiB;
constexpr size_t WS_ACT = 192 * MiB;
constexpr size_t A_XS = 0, A_HX = 96 * MiB;
constexpr size_t A_LDEC = 0, A_ASIG = 64 * MiB, A_G = 128 * MiB;
constexpr size_t A_RKV = 192 * MiB;
constexpr size_t A_O = 192 * MiB;
constexpr size_t A_LORAH = 288 * MiB;
constexpr size_t A_Y = 304 * MiB;
constexpr size_t A_H = 0;
constexpr size_t A_Q = 32 * MiB, A_K = 128 * MiB, A_VT = 224 * MiB;
constexpr size_t A_AO = 320 * MiB;
constexpr size_t A_HN2 = 0, A_ASORT = 32 * MiB, A_HID = 112 * MiB, A_YS = 288 * MiB;
static_assert(A_K - A_Q == A_VT - A_K, "q/k/v spacing");
constexpr size_t WS_END = WS_ACT + 368 * MiB;

constexpr int CW_BAR = 4096;
constexpr int CW_CNT = 8192;

constexpr int LDS_BYTES = 163840;
constexpr int LDS_MISC = 159744;
constexpr int MISC_OFF = LDS_MISC + 320;
constexpr int TILEE_OFF = LDS_MISC + 1024;
constexpr int OFFS_OFF = LDS_MISC + 2048;

__device__ __forceinline__ float bf_lo(unsigned u) { return __uint_as_float(u << 16); }
__device__ __forceinline__ float bf_hi(unsigned u) { return __uint_as_float(u & 0xffff0000u); }
__device__ __forceinline__ float bf2f(bf16 v) { return __uint_as_float(((unsigned)v) << 16); }
__device__ __forceinline__ unsigned f2bf(float f) { unsigned u = __float_as_uint(f); return (u + 0x7fffu + ((u >> 16) & 1u)) >> 16; }
__device__ __forceinline__ unsigned pk2(float lo, float hi) { return f2bf(lo) | (f2bf(hi) << 16); }
__device__ __forceinline__ float dpp_ror(float x, const int ctrl_sel) {
    int r;
    if (ctrl_sel == 8) r = __builtin_amdgcn_update_dpp(0, __float_as_int(x), 0x128, 0xf, 0xf, false);
    else if (ctrl_sel == 4) r = __builtin_amdgcn_update_dpp(0, __float_as_int(x), 0x124, 0xf, 0xf, false);
    else if (ctrl_sel == 2) r = __builtin_amdgcn_update_dpp(0, __float_as_int(x), 0x122, 0xf, 0xf, false);
    else r = __builtin_amdgcn_update_dpp(0, __float_as_int(x), 0x121, 0xf, 0xf, false);
    return __int_as_float(r);
}
__device__ __forceinline__ float rowsum16(float x) { x += dpp_ror(x, 8); x += dpp_ror(x, 4); x += dpp_ror(x, 2); x += dpp_ror(x, 1); return x; }
__device__ __forceinline__ float lane_xor(float v, int lane, int o) { return __int_as_float(__builtin_amdgcn_ds_bpermute((lane ^ o) << 2, __float_as_int(v))); }
__device__ __forceinline__ float wave_sum(float v, int lane) { v = rowsum16(v); v += lane_xor(v, lane, 16); v += lane_xor(v, lane, 32); return v; }
__device__ __forceinline__ int lane_id_nh() { int lid; asm volatile("v_mbcnt_lo_u32_b32 %0, -1, 0\n\tv_mbcnt_hi_u32_b32 %0, -1, %0" : "=v"(lid)); return lid; }
__device__ __forceinline__ float sigmoidf_(float x) { return 1.0f / (1.0f + __expf(-x)); }
#define LDS_WAIT() asm volatile("s_waitcnt lgkmcnt(0)" ::: "memory")
#define VM_WAIT() asm volatile("s_waitcnt vmcnt(0)" ::: "memory")

#define XB_TMO      128
#define XB_XCNT(j)  (256  + 64 * (j))
#define XB_XSUB(j)  (1280 + 64 * (j))
#define XB_XGEN(j)  (2304 + 64 * (j))
#define XB_TOP      3328
#define XB_TOPGEN   3392
#define XCD_BAR_WORDS 3456
#define XB_SPIN_CAP (1u << 18)
__device__ __forceinline__ unsigned xb_ld(unsigned* p)              { return __hip_atomic_load(p, __ATOMIC_RELAXED, __HIP_MEMORY_SCOPE_AGENT); }
__device__ __forceinline__ unsigned xb_add(unsigned* p, unsigned v) { return __hip_atomic_fetch_add(p, v, __ATOMIC_RELAXED, __HIP_MEMORY_SCOPE_AGENT); }
__device__ __forceinline__ unsigned xb_xcc_id() { return (unsigned)__builtin_amdgcn_s_getreg((3 << 11) | 20) & 0xFu; }
#define XB_SPIN(cond, bar) do { unsigned _sp = 0; while (cond) { __builtin_amdgcn_s_sleep(1); \
    if ((++_sp & 255u) == 0u) { if (xb_ld(&(bar)[XB_TMO])) break; if (_sp > XB_SPIN_CAP) { atomicAdd(&(bar)[XB_TMO], 1u); break; } } } } while (0)
struct XcdBarrier { unsigned* bar; unsigned x; volatile LAS unsigned* st; };
__device__ __forceinline__ XcdBarrier xcd_barrier_post(unsigned* bar, volatile LAS unsigned* st, bool t0) {
    XcdBarrier b; b.bar = bar; b.x = xb_xcc_id(); b.st = st;
    if (t0) (void)xb_add(&bar[XB_XCNT(b.x)], 1u);
    return b;
}
__device__ __forceinline__ void xcd_barrier_complete(unsigned* bar, unsigned x, unsigned& nloc, unsigned& nx) {
    const unsigned G = gridDim.x * gridDim.y * gridDim.z;
    unsigned sum, cnt, mine, sp = 0u;
    for (;;) {
        sum = 0u; cnt = 0u; mine = 0u;
#pragma clang loop unroll(disable)
        for (unsigned j = 0; j < 16; ++j) { const unsigned c = xb_ld(&bar[XB_XCNT(j)]); sum += c; cnt += (c > 0u) ? 1u : 0u; mine = (j == x) ? c : mine; }
        if (sum == G) break;
        __builtin_amdgcn_s_sleep(1);
        if ((++sp & 255u) == 0u) { if (xb_ld(&bar[XB_TMO])) break; if (sp > XB_SPIN_CAP) { atomicAdd(&bar[XB_TMO], 1u); break; } }
    }
    nloc = mine > 0u ? mine : 1u; nx = cnt > 0u ? cnt : 1u;
}
__device__ __forceinline__ void xcd_barrier(const XcdBarrier& b, bool t0) {
    asm volatile("s_waitcnt vmcnt(0)" ::: "memory");
    __syncthreads();
    if (t0) {
        unsigned* bar = b.bar;
        __builtin_amdgcn_s_waitcnt(0);
        unsigned nloc = b.st[0], nx = b.st[1];
        if (nloc == 0u) { xcd_barrier_complete(bar, b.x, nloc, nx); b.st[0] = nloc; b.st[1] = nx; }
        const unsigned old = xb_add(&bar[XB_XSUB(b.x)], 1u);
        const unsigned gen = old / nloc;
        if (old + 1u == (gen + 1u) * nloc) {
            __builtin_amdgcn_fence(__ATOMIC_RELEASE, "agent");
            asm volatile("s_waitcnt vmcnt(0)" ::: "memory");
            const unsigned og = xb_add(&bar[XB_TOP], 1u);
            const unsigned tg = og / nx;
            if (og + 1u == (tg + 1u) * nx) xb_add(&bar[XB_TOPGEN], 1u);
            else XB_SPIN(xb_ld(&bar[XB_TOPGEN]) == tg, bar);
            __builtin_amdgcn_fence(__ATOMIC_ACQUIRE, "agent");
            xb_add(&bar[XB_XGEN(b.x)], 1u);
            asm volatile("s_waitcnt vmcnt(0)" ::: "memory");
        } else {
            XB_SPIN(xb_ld(&bar[XB_XGEN(b.x)]) == gen, bar);
            __builtin_amdgcn_fence(__ATOMIC_ACQUIRE, "agent");
            asm volatile("s_waitcnt vmcnt(0)" ::: "memory");
        }
    }
    __syncthreads();
}

namespace pg8 {
constexpr int BM = 256, BK = 64, HALF = 128, HTB = HALF * BK * 2, STAGE_BYTES = 8 * HTB;
__device__ __forceinline__ int lds_byte(int r, int c) { const int st = (r >> 4) * 2 + (c >> 5), rr = r & 15, cc = c & 31, ob = rr * 64 + cc * 2; return st * 1024 + (ob ^ (((ob >> 9) & 1) << 5)); }
__device__ __forceinline__ void stage_rc(int b, int& R, int& C) { const int st = b / 1024, sb = b % 1024, swz = sb ^ (((sb >> 9) & 1) << 5); R = (st >> 1) * 16 + swz / 64; C = (st & 1) * 32 + (swz % 64) / 2; }
__device__ __forceinline__ int perm32(int rho) { const int n = rho >> 4, i = rho & 15; return 8 * (i >> 2) + 4 * n + (i & 3); }
struct Unit { int pm, pn; const char* a; const char* b; };
__device__ __forceinline__ unsigned cvt_pk_bf16(float lo, float hi) { unsigned r; asm volatile("v_cvt_pk_bf16_f32 %0, %1, %2" : "=v"(r) : "v"(lo), "v"(hi)); return r; }

template <class Epi, class Sched>
__device__ __forceinline__ void gemm_phase(LAS unsigned char* lds, const int tid, const int K, const int lda, const int ldb, const Sched& S, const Epi& E) {
    const int wid = __builtin_amdgcn_readfirstlane(tid >> 6), lane = tid & 63, wr = wid >> 2, wc = wid & 3, fr = lane & 15, fq = lane >> 4;
    int Kq = K; asm volatile("" : "+s"(Kq));
    const int nt = Kq / BK;
    unsigned voffA[2], voffB[2];
#pragma unroll
    for (int i = 0; i < 2; ++i) { int R, C; stage_rc(tid * 16 + i * 8192, R, C); const int Rb = Epi::PERM ? ((R & ~31) + perm32(R & 31)) : R;
        voffA[i] = (unsigned)(R * lda + C) * 2u; voffB[i] = (unsigned)(Rb * ldb + C) * 2u; }
    const size_t kstep = (size_t)(BK * 2);
    const size_t hstepA = (size_t)HALF * lda * 2, hstepB = (size_t)HALF * ldb * 2;
    const unsigned ldsw = (unsigned)wid * 1024u;
    const int aoff = lds_byte(wr * 64 + fr, fq * 8), boff = lds_byte(wc * 32 + fr, fq * 8);
#define PG8_SA(b, h) (((b) * 2 + (h)) * HTB)
#define PG8_SB(b, h) ((4 + (b) * 2 + (h)) * HTB)
#define PG8_STAGE(bufoff, gbase, voff) do { _Pragma("unroll") for (int _i = 0; _i < 2; ++_i) \
        __builtin_amdgcn_global_load_lds((const unsigned*)((const char*)(gbase) + (voff)[_i]), (LAS unsigned*)(lds + (bufoff) + ldsw + _i * 8192), 16, 0, 0); } while (0)
#define PG8_LDA(dst, b, h) do { _Pragma("unroll") for (int m = 0; m < 4; ++m) _Pragma("unroll") for (int k = 0; k < 2; ++k) dst[m][k] = *(const LAS bf16x8*)(lds + PG8_SA(b, h) + aoff + m * 2048 + k * 1024); } while (0)
#define PG8_LDB(dst, b, h) do { _Pragma("unroll") for (int n = 0; n < 2; ++n) _Pragma("unroll") for (int k = 0; k < 2; ++k) dst[n][k] = *(const LAS bf16x8*)(lds + PG8_SB(b, h) + boff + n * 2048 + k * 1024); } while (0)
#define PG8_MMA(ai, bj, At, Bt) do { __builtin_amdgcn_s_setprio(1); _Pragma("unroll") for (int m = 0; m < 4; ++m) _Pragma("unroll") for (int n = 0; n < 2; ++n) _Pragma("unroll") for (int k = 0; k < 2; ++k) \
        acc[ai][bj][m][n] = __builtin_amdgcn_mfma_f32_16x16x32_bf16(Bt[n][k], At[m][k], acc[ai][bj][m][n], 0, 0, 0); __builtin_amdgcn_s_setprio(0); } while (0)
#define PG8_WAIT_V(n) asm volatile("s_waitcnt vmcnt(" #n ")" ::: "memory")
#define PG8_WAIT_L(n) asm volatile("s_waitcnt lgkmcnt(" #n ")" ::: "memory")
#define PG8_BAR __builtin_amdgcn_s_barrier()
#define PG8_SCHED __builtin_amdgcn_sched_barrier(0)
    Unit cur, nxt; int ui = 0;
    if (!S.next(0, cur)) return;
    f32x4 acc[2][2][4][2];
#pragma unroll
    for (int a = 0; a < 2; ++a)
#pragma unroll
        for (int b = 0; b < 2; ++b)
#pragma unroll
            for (int m = 0; m < 4; ++m)
#pragma unroll
                for (int n = 0; n < 2; ++n) acc[a][b][m][n] = (f32x4){0.f, 0.f, 0.f, 0.f};
    bf16x8 At[4][2], B0[2][2], B1[2][2];
    const char* cA = cur.a; const char* cB = cur.b;
    PG8_STAGE(PG8_SB(0, 0), cB, voffB); PG8_STAGE(PG8_SB(0, 1), cB + hstepB, voffB); PG8_STAGE(PG8_SA(0, 0), cA, voffA); PG8_STAGE(PG8_SA(0, 1), cA + hstepA, voffA);
    if (wr == 1) PG8_BAR;
    PG8_WAIT_V(2); PG8_BAR;
    PG8_STAGE(PG8_SB(1, 0), cB + kstep, voffB); PG8_STAGE(PG8_SA(1, 0), cA + kstep, voffA); PG8_STAGE(PG8_SB(1, 1), cB + hstepB + kstep, voffB);
    PG8_WAIT_V(6); PG8_BAR;
    for (;;) {
        const bool has_next = S.next(ui + 1, nxt);
        const char* nA = has_next ? nxt.a : cA; const char* nB = has_next ? nxt.b : cB;
#pragma clang loop unroll(disable)
        for (int t = 0; t < nt; t += 2) {
            const bool last = (t == nt - 2);
            const char* a1 = cA + (size_t)(t + 1) * kstep;
            const char* a2 = last ? nA : cA + (size_t)(t + 2) * kstep; const char* b2 = last ? nB : cB + (size_t)(t + 2) * kstep;
            const char* a3 = a2 + kstep; const char* b3 = b2 + kstep;
            PG8_LDB(B0, 0, 0); PG8_LDB(B1, 0, 1); PG8_SCHED; PG8_LDA(At, 0, 0); PG8_STAGE(PG8_SA(1, 1), a1 + hstepA, voffA);
            PG8_WAIT_V(8); PG8_WAIT_L(0); PG8_BAR; PG8_MMA(0, 0, At, B0); PG8_MMA(0, 1, At, B1); PG8_BAR; PG8_SCHED;
            PG8_LDA(At, 0, 1); PG8_STAGE(PG8_SB(0, 0), b2, voffB); PG8_STAGE(PG8_SB(0, 1), b2 + hstepB, voffB); PG8_STAGE(PG8_SA(0, 0), a2, voffA);
            PG8_WAIT_V(8); PG8_WAIT_L(0); PG8_BAR; PG8_MMA(1, 0, At, B0); PG8_MMA(1, 1, At, B1); PG8_BAR; PG8_SCHED;
            PG8_LDB(B0, 1, 0); PG8_LDB(B1, 1, 1); PG8_SCHED; PG8_LDA(At, 1, 0); PG8_STAGE(PG8_SA(0, 1), a2 + hstepA, voffA);
            PG8_WAIT_V(8); PG8_WAIT_L(0); PG8_BAR; PG8_MMA(0, 0, At, B0); PG8_MMA(0, 1, At, B1); PG8_BAR; PG8_SCHED;
            PG8_LDA(At, 1, 1); PG8_STAGE(PG8_SB(1, 0), b3, voffB); PG8_STAGE(PG8_SB(1, 1), b3 + hstepB, voffB); PG8_STAGE(PG8_SA(1, 0), a3, voffA);
            PG8_WAIT_V(8); PG8_WAIT_L(0); PG8_BAR; PG8_MMA(1, 0, At, B0); PG8_MMA(1, 1, At, B1); PG8_BAR; PG8_SCHED;
        }
        if (wr == 0) PG8_BAR;
        { int te = tid; asm volatile("" : "+v"(te));
          const int we = __builtin_amdgcn_readfirstlane(te >> 6), le = te & 63;
          E(acc, cur, we >> 2, we & 3, le & 15, le >> 4); }
        if (!has_next) break;
#pragma unroll
        for (int a = 0; a < 2; ++a)
#pragma unroll
            for (int b = 0; b < 2; ++b)
#pragma unroll
                for (int m = 0; m < 4; ++m)
#pragma unroll
                    for (int n = 0; n < 2; ++n) acc[a][b][m][n] = (f32x4){0.f, 0.f, 0.f, 0.f};
        cur = nxt; cA = nA; cB = nB; ++ui;
        if (wr == 1) PG8_BAR;
    }
    PG8_WAIT_V(0);
    PG8_BAR;
#undef PG8_SA
#undef PG8_SB
#undef PG8_STAGE
#undef PG8_LDA
#undef PG8_LDB
#undef PG8_MMA
#undef PG8_WAIT_V
#undef PG8_WAIT_L
#undef PG8_BAR
#undef PG8_SCHED
}

struct GridOrder {
    int nM, nN, nwg, G, c;
    __device__ __forceinline__ void init(int nM_, int nN_, int G_, int c_) { nM = nM_; nN = nN_; nwg = nM * nN; G = G_; c = c_; }
    __device__ __forceinline__ bool tile(int i, int& pm, int& pn) const {
        const long L = (long)i * G + c; if (L >= nwg) return false;
        int wgid = (int)L; { const int q = nwg / 8, r = nwg % 8, xcd = wgid % 8, off = wgid / 8; wgid = (xcd < r ? xcd * (q + 1) : r * (q + 1) + (xcd - r) * q) + off; }
        const int nig = 8 * nN, gid = wgid / nig, fm = gid * 8, gsz = (nM - fm) < 8 ? (nM - fm) : 8;
        pm = fm + ((wgid % nig) % gsz); pn = (wgid % nig) / gsz; return true;
    }
};
}

__device__ __forceinline__ int uni(int v) { return __builtin_amdgcn_readfirstlane(v); }
__device__ __forceinline__ const char* uniptr(const char* p) { const unsigned long long v = (unsigned long long)p; const unsigned lo = __builtin_amdgcn_readfirstlane((unsigned)v), hi = __builtin_amdgcn_readfirstlane((unsigned)(v >> 32)); return (const char*)(((unsigned long long)hi << 32) | lo); }
struct DenseSched {
    pg8::GridOrder o; const char* A; size_t a_sel_stride; int pn_per_a; const char* B; size_t tstepA, tstepB;
    __device__ __forceinline__ bool next(int i, pg8::Unit& u) const {
        if (!o.tile(i, u.pm, u.pn)) return false;
        u.pm = uni(u.pm); u.pn = uni(u.pn);
        u.a = uniptr(A + (size_t)(u.pn / pn_per_a) * a_sel_stride + (size_t)u.pm * tstepA); u.b = uniptr(B + (size_t)u.pn * tstepB); return true;
    }
};
struct MoeSched {
    const int* tileE; int ntiles, npn, G, c; const char* A; const char* B; size_t tstepA, tstepB, estride;
    __device__ __forceinline__ bool next(int i, pg8::Unit& u) const {
        const int L = i * G + c; if (L >= ntiles * npn) return false;
        u.pm = uni(L / npn); u.pn = uni(L % npn);
        const int e = __builtin_amdgcn_readfirstlane(tileE[u.pm]);
        u.a = uniptr(A + (size_t)u.pm * tstepA); u.b = uniptr(B + (size_t)e * estride + (size_t)u.pn * tstepB); return true;
    }
};

using pg8::Unit; using pg8::cvt_pk_bf16;
__device__ __forceinline__ void st8(bf16* p, const f32x4& v0, const f32x4& v1) {
    u32x4 w; w.x = cvt_pk_bf16(v0[0], v0[1]); w.y = cvt_pk_bf16(v0[2], v0[3]); w.z = cvt_pk_bf16(v1[0], v1[1]); w.w = cvt_pk_bf16(v1[2], v1[3]);
    *(u32x4*)p = w;
}
struct EpiSplit {
    static constexpr bool PERM = true;
    bf16* O; size_t split_stride; float scale;
    __device__ __forceinline__ void operator()(const f32x4 (&acc)[2][2][4][2], const Unit& u, int wr, int wc, int fr, int fq) const {
        const int row0 = u.pm * 256 + wr * 64 + fr; const int colt = u.pn * 256; const int t = colt >> 10;
        bf16* base = O + (size_t)t * split_stride; const int col0 = (colt & 1023) + wc * 32 + 8 * fq;
#pragma unroll
        for (int ai = 0; ai < 2; ++ai)
#pragma unroll
            for (int m = 0; m < 4; ++m) { bf16* rowp = base + (size_t)(row0 + ai * 128 + m * 16) * 1024 + col0;
#pragma unroll
                for (int bj = 0; bj < 2; ++bj) st8(rowp + bj * 128, acc[ai][bj][m][0] * scale, acc[ai][bj][m][1] * scale); }
    }
};
struct EpiLoraDn {
    static constexpr bool PERM = true;
    bf16* O;
    __device__ __forceinline__ void operator()(const f32x4 (&acc)[2][2][4][2], const Unit& u, int wr, int wc, int fr, int fq) const {
        const int row0 = u.pm * 256 + wr * 64 + fr; const int col0 = u.pn * 256 + wc * 32 + 8 * fq;
#pragma unroll
        for (int ai = 0; ai < 2; ++ai)
#pragma unroll
            for (int m = 0; m < 4; ++m) { bf16* rowp = O + (size_t)(row0 + ai * 128 + m * 16) * 512 + col0;
#pragma unroll
                for (int bj = 0; bj < 2; ++bj) { f32x4 v0 = acc[ai][bj][m][0], v1 = acc[ai][bj][m][1];
                    const int mode = (u.pn == 1) ? 2 : bj;
                    if (mode == 0) {
#pragma unroll
                        for (int j = 0; j < 4; ++j) { v0[j] = tanhf(v0[j]); v1[j] = tanhf(v1[j]); } }
                    else if (mode == 2) {
#pragma unroll
                        for (int j = 0; j < 4; ++j) { v0[j] = sigmoidf_(v0[j]); v1[j] = sigmoidf_(v1[j]); } }
                    st8(rowp + bj * 128, v0, v1); } }
    }
};
struct EpiLoraUpWA {
    static constexpr bool PERM = true;
    bf16* LD; bf16* AS; const float* w0; const float* a0;
    __device__ __forceinline__ void operator()(const f32x4 (&acc)[2][2][4][2], const Unit& u, int wr, int wc, int fr, int fq) const {
        const int kind = u.pn >> 3, z = (u.pn >> 2) & 1;
        const int row0 = u.pm * 256 + wr * 64 + fr; const int col0 = (u.pn & 3) * 256 + wc * 32 + 8 * fq;
        bf16* base = (kind ? AS : LD) + (size_t)z * T * D; const float* bias = (kind ? a0 : w0) + z * 1024;
        f32x4 bv[2][2];
#pragma unroll
        for (int bj = 0; bj < 2; ++bj)
#pragma unroll
            for (int n = 0; n < 2; ++n) bv[bj][n] = *(const f32x4*)(bias + col0 + bj * 128 + 4 * n);
#pragma unroll
        for (int ai = 0; ai < 2; ++ai)
#pragma unroll
            for (int m = 0; m < 4; ++m) { bf16* rowp = base + (size_t)(row0 + ai * 128 + m * 16) * 1024 + col0;
#pragma unroll
                for (int bj = 0; bj < 2; ++bj) { f32x4 v[2];
#pragma unroll
                    for (int n = 0; n < 2; ++n) { v[n] = acc[ai][bj][m][n] + bv[bj][n];
#pragma unroll
                        for (int j = 0; j < 4; ++j) { const float x = v[n][j];
                            if (kind == 0) { const float zz = -x; const float sp = fmaxf(zz, 0.f) + __logf(1.f + __expf(-fabsf(zz))); v[n][j] = -__expf(-sp - 0.5f) * LOG2E; }
                            else v[n][j] = sigmoidf_(x); } }
                    st8(rowp + bj * 128, v[0], v[1]); } }
    }
};
struct EpiResid {
    static constexpr bool PERM = false;
    const float* xin; float* out; const float* gate;
    __device__ __forceinline__ void operator()(const f32x4 (&acc)[2][2][4][2], const Unit& u, int wr, int wc, int fr, int fq) const {
        const int row0 = u.pm * 256 + wr * 64 + fr, col0 = u.pn * 256 + wc * 32 + 4 * fq; const int b = u.pm >> 3;
        f32x4 gv[2][2];
#pragma unroll
        for (int bj = 0; bj < 2; ++bj)
#pragma unroll
            for (int n = 0; n < 2; ++n) gv[bj][n] = *(const f32x4*)(gate + (size_t)b * 6144 + col0 + bj * 128 + n * 16);
#pragma unroll
        for (int ai = 0; ai < 2; ++ai)
#pragma unroll
            for (int m = 0; m < 4; ++m) { const size_t off = (size_t)(row0 + ai * 128 + m * 16) * D + col0;
#pragma unroll
                for (int bj = 0; bj < 2; ++bj)
#pragma unroll
                    for (int n = 0; n < 2; ++n) { const f32x4 xv = *(const f32x4*)(xin + off + bj * 128 + n * 16);
                        *(f32x4*)(out + off + bj * 128 + n * 16) = xv + gv[bj][n] * acc[ai][bj][m][n]; } }
    }
};
struct EpiQKV {
    static constexpr bool PERM = true;
    bf16* Q; bf16* Kb; bf16* Vb; float qscale;
    __device__ __forceinline__ void operator()(const f32x4 (&acc)[2][2][4][2], const Unit& u, int wr, int wc, int fr, int fq) const {
        const int g = u.pn / 12, which = (u.pn % 12) >> 2, hp = u.pn & 3;
        const int row0 = u.pm * 256 + wr * 64 + fr;
        bf16* base = Q + (size_t)which * ((A_K - A_Q) / 2) + (size_t)g * T * D; const float sc = which ? 1.0f : qscale; const int col0 = hp * 256 + wc * 32 + 8 * fq;
#pragma unroll
        for (int ai = 0; ai < 2; ++ai)
#pragma unroll
            for (int m = 0; m < 4; ++m) { bf16* rowp = base + (size_t)(row0 + ai * 128 + m * 16) * 1024 + col0;
#pragma unroll
                for (int bj = 0; bj < 2; ++bj) st8(rowp + bj * 128, acc[ai][bj][m][0] * sc, acc[ai][bj][m][1] * sc); }
    }
};
struct EpiGateUp {
    static constexpr bool PERM = true;
    bf16* H; const float* roww;
    __device__ __forceinline__ void operator()(const f32x4 (&acc)[2][2][4][2], const Unit& u, int wr, int wc, int fr, int fq) const {
        const int row0 = u.pm * 256 + wr * 64 + fr; const int col0 = u.pn * 128 + wc * 32 + 8 * fq;
#pragma unroll
        for (int ai = 0; ai < 2; ++ai)
#pragma unroll
            for (int m = 0; m < 4; ++m) { const int row = row0 + ai * 128 + m * 16; const float rw = roww[row]; f32x4 v[2];
#pragma unroll
                for (int n = 0; n < 2; ++n)
#pragma unroll
                    for (int j = 0; j < 4; ++j) { const float gg = acc[ai][0][m][n][j], uu = acc[ai][1][m][n][j]; v[n][j] = gg * sigmoidf_(gg) * uu * rw; }
                st8(H + (size_t)row * FEXP + col0, v[0], v[1]); }
    }
};
struct EpiPlain {
    static constexpr bool PERM = true;
    bf16* O;
    __device__ __forceinline__ void operator()(const f32x4 (&acc)[2][2][4][2], const Unit& u, int wr, int wc, int fr, int fq) const {
        const int row0 = u.pm * 256 + wr * 64 + fr; const int col0 = u.pn * 256 + wc * 32 + 8 * fq;
#pragma unroll
        for (int ai = 0; ai < 2; ++ai)
#pragma unroll
            for (int m = 0; m < 4; ++m) { bf16* rowp = O + (size_t)(row0 + ai * 128 + m * 16) * 1024 + col0;
#pragma unroll
                for (int bj = 0; bj < 2; ++bj) st8(rowp + bj * 128, acc[ai][bj][m][0], acc[ai][bj][m][1]); }
    }
};

struct Args {
    const float* in[32]; float* out; unsigned char* ws; int ph_lo, ph_hi;
};
enum { I_X = 0, I_C, I_ADAW, I_ADAB, I_NTM, I_NCM, I_MU, I_WRKV, I_W0, I_W1, I_W2, I_A0, I_A1, I_A2, I_G1, I_G2, I_KK, I_KA, I_RK, I_LNW, I_LNB, I_RWO,
       I_AQKV, I_AWO, I_RG, I_RGB, I_RE, I_REB, I_WG, I_WU, I_WD, I_FG };

struct Frame {
    LAS unsigned char* lds; int tid, lane, wave, G, gw, NGW;
    unsigned char* ws; const float* const* in; float* out;
};

__device__ __forceinline__ void row_load(const float* p, int lane, f32x4 (&v)[4]) {
#pragma unroll
    for (int j = 0; j < 4; ++j) v[j] = *(const f32x4*)(p + 4 * lane + 256 * j);
}
__device__ __forceinline__ void row_store(float* p, int lane, const f32x4 (&v)[4]) {
#pragma unroll
    for (int j = 0; j < 4; ++j) *(f32x4*)(p + 4 * lane + 256 * j) = v[j];
}
__device__ __forceinline__ void row_store_bf16(bf16* p, int lane, const f32x4 (&v)[4]) {
#pragma unroll
    for (int j = 0; j < 4; ++j) { u32x2 w; w.x = pk2(v[j][0], v[j][1]); w.y = pk2(v[j][2], v[j][3]); *(u32x2*)(p + 4 * lane + 256 * j) = w; }
}
__device__ __forceinline__ void row_combine(f32x4 (&v)[4], const bf16* ys, const int* tokp, int row, const float* gac, int lane) {
    const int p0 = tokp[2 * row], p1 = tokp[2 * row + 1];
    const bf16* y0 = ys + (size_t)p0 * D; const bf16* y1 = ys + (size_t)p1 * D;
#pragma unroll
    for (int j = 0; j < 4; ++j) { const u32x2 a = *(const u32x2*)(y0 + 4 * lane + 256 * j), b = *(const u32x2*)(y1 + 4 * lane + 256 * j); const f32x4 g = *(const f32x4*)(gac + 4 * lane + 256 * j);
        v[j][0] += g[0] * (bf_lo(a.x) + bf_lo(b.x)); v[j][1] += g[1] * (bf_hi(a.x) + bf_hi(b.x)); v[j][2] += g[2] * (bf_lo(a.y) + bf_lo(b.y)); v[j][3] += g[3] * (bf_hi(a.y) + bf_hi(b.y)); }
}
__device__ __forceinline__ void row_norm_mod(const f32x4 (&x)[4], const float* gain, const float* sc, const float* sh, int lane, f32x4 (&h)[4]) {
    float s = 0.f;
#pragma unroll
    for (int j = 0; j < 4; ++j) s += (x[j][0] * x[j][0] + x[j][1] * x[j][1]) + (x[j][2] * x[j][2] + x[j][3] * x[j][3]);
    const float rstd = rsqrtf(wave_sum(s, lane) * (1.0f / D) + RMS_EPS);
#pragma unroll
    for (int j = 0; j < 4; ++j) { const f32x4 g = *(const f32x4*)(gain + 4 * lane + 256 * j), c = *(const f32x4*)(sc + 4 * lane + 256 * j), b = *(const f32x4*)(sh + 4 * lane + 256 * j);
        h[j] = x[j] * rstd * g * (1.0f + c) + b; }
}
__device__ __forceinline__ void transpose_item(const float* W, int ldw, bf16* dst, int ldd, LAS float* scr, int lane) {
#pragma unroll 8
    for (int i = 0; i < 32; ++i) { const int kk = 2 * i + (lane >> 5); scr[kk * 33 + (lane & 31)] = W[(size_t)kk * ldw + (lane & 31)]; }
    LDS_WAIT(); asm volatile("" ::: "memory");
    const int c = lane & 7;
#pragma unroll
    for (int j = 0; j < 4; ++j) { const int n = (lane >> 3) + 8 * j; const LAS float* s = scr + (8 * c) * 33 + n;
        u32x4 o; o.x = pk2(s[0 * 33], s[1 * 33]); o.y = pk2(s[2 * 33], s[3 * 33]); o.z = pk2(s[4 * 33], s[5 * 33]); o.w = pk2(s[6 * 33], s[7 * 33]);
        *(u32x4*)(dst + (size_t)n * ldd + 8 * c) = o; }
    LDS_WAIT(); asm volatile("" ::: "memory");
}

__device__ __forceinline__ void phase_prologue(Frame& F) {
    const float* c = F.in[I_C]; const float* adaw = F.in[I_ADAW]; const float* adab = F.in[I_ADAB];
    float* mod = (float*)(F.ws + WS_MOD);
    LAS float* sc = (LAS float*)F.lds;
    LAS float* part = (LAS float*)(F.lds + 32768);
    for (int i = F.tid; i < NB * D; i += NTHREADS) { const float v = c[i]; sc[i] = v / (1.0f + __expf(-v)); }
    __syncthreads();
    for (int u = blockIdx.x; u < DEPTH * 96; u += F.G) {
        const int l = u / 96, n0 = (u % 96) * 64, col = n0 + F.lane;
        const float* W = adaw + (size_t)l * D * 6144 + col;
        float acc[8];
#pragma unroll
        for (int b = 0; b < 8; ++b) acc[b] = 0.f;
        const int kbeg = F.wave * 128;
#pragma unroll 8
        for (int k = kbeg; k < kbeg + 128; ++k) { const float w = W[(size_t)k * 6144];
#pragma unroll
            for (int b = 0; b < 8; ++b) acc[b] += sc[b * D + k] * w; }
#pragma unroll
        for (int b = 0; b < 8; ++b) part[(F.wave * 8 + b) * 64 + F.lane] = acc[b];
        __syncthreads();
        { const int b = F.tid >> 6; float s = adab[l * 6144 + col];
#pragma unroll
          for (int w = 0; w < 8; ++w) s += part[(w * 8 + b) * 64 + F.lane];
          mod[(size_t)(l * 8 + b) * 6144 + col] = s; }
        __syncthreads();
    }
    LAS float* scr = (LAS float*)(F.lds + 49152 + F.wave * 8704);
    constexpr int I_SQ = 16 * 32;
    constexpr int I_QKV = 16 * 288;
    constexpr int PER_RW = 4 * I_SQ, PER_AT = I_QKV + I_SQ, NIT = 2 * PER_RW + 2 * PER_AT;
    for (int it = F.gw; it < NIT; it += F.NGW) {
        int r = it;
        if (r < 2 * PER_RW) { const int j = r / PER_RW; r %= PER_RW; const int mi = r / I_SQ; r %= I_SQ; const int kb = r / 32, nb = r % 32;
            if (mi < 3) transpose_item(F.in[I_WRKV] + ((size_t)(j * 3 + mi) * D + kb * 64) * D + nb * 32, D, (bf16*)(F.ws + WS_W + j * W_RW_STRIDE + W_RKV) + (size_t)(mi * D + nb * 32) * D + kb * 64, D, scr, F.lane);
            else transpose_item(F.in[I_RWO] + ((size_t)j * D + kb * 64) * D + nb * 32, D, (bf16*)(F.ws + WS_W + j * W_RW_STRIDE + W_RWO) + (size_t)(nb * 32) * D + kb * 64, D, scr, F.lane);
        } else { r -= 2 * PER_RW; const int j = r / PER_AT; r %= PER_AT;
            if (r < I_QKV) { const int kb = r / 288, nb = r % 288;
                transpose_item(F.in[I_AQKV] + ((size_t)j * D + kb * 64) * QKVW + nb * 32, QKVW, (bf16*)(F.ws + WS_WA + j * W_AT_STRIDE + W_QKV) + (size_t)(nb * 32) * D + kb * 64, D, scr, F.lane); }
            else { r -= I_QKV; const int kb = r / 32, nb = r % 32;
                transpose_item(F.in[I_AWO] + ((size_t)j * D + kb * 64) * D + nb * 32, D, (bf16*)(F.ws + WS_WA + j * W_AT_STRIDE + W_AWO) + (size_t)(nb * 32) * D + kb * 64, D, scr, F.lane); }
        }
    }
    const int gt = blockIdx.x * NTHREADS + F.tid, NGT = F.G * NTHREADS;
    for (int j = 0; j < 2; ++j) {
        bf16* ldn = (bf16*)(F.ws + WS_W + j * W_RW_STRIDE + W_LDN);
        const float* mu = F.in[I_MU] + (size_t)j * 6 * D;
        for (int i = gt; i < 512 * 2048; i += NGT) { const int n = i >> 11, k = i & 2047, kk = k & 1023;
            float v; int mi;
            if (n < 128) { const int z = n >> 6, nn = n & 63; v = F.in[I_W1][((size_t)(j * 2 + z) * D + kk) * 64 + nn]; mi = 3; }
            else if (n < 256) { const int z = (n - 128) >> 6, nn = n & 63; v = F.in[I_A1][((size_t)(j * 2 + z) * D + kk) * 64 + nn]; mi = 4; }
            else { const int z = (n - 256) >> 7, nn = n & 127; v = F.in[I_G1][((size_t)(j * 2 + z) * D + kk) * 128 + nn]; mi = 5; }
            if (k >= 1024) v *= mu[mi * D + kk];
            ldn[i] = (bf16)f2bf(v); }
        bf16* lwa = (bf16*)(F.ws + WS_W + j * W_RW_STRIDE + W_LUPWA);
        for (int i = gt; i < 4096 * 256; i += NGT) { const int n = i >> 8, k = i & 255; const int kind = n >> 11, z = (n >> 10) & 1, col = n & 1023;
            float v = 0.f;
            if ((k >> 6) == kind * 2 + z) v = (kind ? F.in[I_A2] : F.in[I_W2])[((size_t)(j * 2 + z) * 64 + (k & 63)) * D + col];
            lwa[i] = (bf16)f2bf(v); }
        bf16* lg = (bf16*)(F.ws + WS_W + j * W_RW_STRIDE + W_LUPG);
        for (int i = gt; i < 2048 * 256; i += NGT) { const int n = i >> 8, k = i & 255; const int z = n >> 10, col = n & 1023;
            float v = 0.f;
            if ((k >> 7) == z) v = F.in[I_G2][((size_t)(j * 2 + z) * 128 + (k & 127)) * D + col];
            lg[i] = (bf16)f2bf(v); }
    }
}

__device__ __forceinline__ void rw_hrow(Frame& F, int l, bool combine, const float* xsrc, float* xdst, bool own, int row, f32x4 (&h)[4]) {
    const int b = row >> 11; const float* mod = (const float*)(F.ws + WS_MOD);
    f32x4 x[4]; row_load(xsrc + (size_t)row * D, F.lane, x);
    if (combine) { row_combine(x, (const bf16*)(F.ws + WS_ACT + A_YS), (const int*)(F.ws + WS_TOKP), row, mod + (size_t)((l - 1) * 8 + b) * 6144 + 5 * D, F.lane);
        if (own) row_store(xdst + (size_t)row * D, F.lane, x); }
    const float* mp = mod + (size_t)(l * 8 + b) * 6144;
    row_norm_mod(x, F.in[I_NTM] + l * D, mp + 1 * D, mp + 0 * D, F.lane, h);
}
__device__ __forceinline__ void phase_rw_norm(Frame& F, int l, bool combine, const float* xsrc, float* xdst) {
    const int j = l >> 1; const float* mu = F.in[I_MU] + (size_t)j * 6 * D;
    bf16* xs = (bf16*)(F.ws + WS_ACT + A_XS); bf16* hx = (bf16*)(F.ws + WS_ACT + A_HX);
    for (int ch = F.gw; ch < T / 8; ch += F.NGW) {
        const int row0 = ch * 8, t0 = row0 & (SEQ - 1);
        f32x4 prev[4], cur[4], nxt[4];
        if (t0 > 0) rw_hrow(F, l, combine, xsrc, xdst, false, row0 - 1, prev);
        else {
#pragma unroll
            for (int q = 0; q < 4; ++q) prev[q] = (f32x4){0.f, 0.f, 0.f, 0.f}; }
        rw_hrow(F, l, combine, xsrc, xdst, true, row0, cur);
        for (int i = 0; i < 8; ++i) {
            const int row = row0 + i;
            if (t0 + i + 1 < SEQ) rw_hrow(F, l, combine, xsrc, xdst, i < 7, row + 1, nxt);
            else {
#pragma unroll
                for (int q = 0; q < 4; ++q) nxt[q] = (f32x4){0.f, 0.f, 0.f, 0.f}; }
            f32x4 xx[4];
#pragma unroll
            for (int q = 0; q < 4; ++q) xx[q] = 0.5f * (prev[q] + nxt[q]) - cur[q];
#pragma unroll
            for (int mi = 0; mi < 3; ++mi) { f32x4 o[4];
#pragma unroll
                for (int q = 0; q < 4; ++q) { const f32x4 m = *(const f32x4*)(mu + mi * D + 4 * F.lane + 256 * q); o[q] = cur[q] + xx[q] * m; }
                row_store_bf16(xs + ((size_t)mi * T + row) * D, F.lane, o); }
            row_store_bf16(hx + (size_t)row * 2048, F.lane, cur);
            row_store_bf16(hx + (size_t)row * 2048 + D, F.lane, xx);
#pragma unroll
            for (int q = 0; q < 4; ++q) { prev[q] = cur[q]; cur[q] = nxt[q]; }
        }
    }
}

__device__ __forceinline__ void phase_at_norm(Frame& F, int l, const float* xsrc, float* xdst) {
    const float* mod = (const float*)(F.ws + WS_MOD); bf16* H = (bf16*)(F.ws + WS_ACT + A_H);
    for (int row = F.gw; row < T; row += F.NGW) {
        const int b = row >> 11; f32x4 x[4], h[4]; row_load(xsrc + (size_t)row * D, F.lane, x);
        row_combine(x, (const bf16*)(F.ws + WS_ACT + A_YS), (const int*)(F.ws + WS_TOKP), row, mod + (size_t)((l - 1) * 8 + b) * 6144 + 5 * D, F.lane);
        row_store(xdst + (size_t)row * D, F.lane, x);
        const float* mp = mod + (size_t)(l * 8 + b) * 6144;
        row_norm_mod(x, F.in[I_NTM] + l * D, mp + 1 * D, mp + 0 * D, F.lane, h);
        row_store_bf16(H + (size_t)row * D, F.lane, h);
    }
}
__device__ __forceinline__ void phase_final(Frame& F, const float* xsrc) {
    const float* mod = (const float*)(F.ws + WS_MOD); const float* fg = F.in[I_FG];
    for (int row = F.gw; row < T; row += F.NGW) {
        const int b = row >> 11; f32x4 x[4]; row_load(xsrc + (size_t)row * D, F.lane, x);
        row_combine(x, (const bf16*)(F.ws + WS_ACT + A_YS), (const int*)(F.ws + WS_TOKP), row, mod + (size_t)(3 * 8 + b) * 6144 + 5 * D, F.lane);
        float s = 0.f;
#pragma unroll
        for (int j = 0; j < 4; ++j) s += (x[j][0] * x[j][0] + x[j][1] * x[j][1]) + (x[j][2] * x[j][2] + x[j][3] * x[j][3]);
        const float rstd = rsqrtf(wave_sum(s, F.lane) * (1.0f / D) + RMS_EPS);
#pragma unroll
        for (int j = 0; j < 4; ++j) { const f32x4 g = *(const f32x4*)(fg + 4 * F.lane + 256 * j); x[j] = x[j] * rstd * g; }
        row_store(F.out + (size_t)row * D, F.lane, x);
    }
}

__device__ __forceinline__ void phase_moe_route(Frame& F, int l, const float* xsrc, int cnt_shift = 0) {
    const float* mod = (const float*)(F.ws + WS_MOD); bf16* HN = (bf16*)(F.ws + WS_ACT + A_HN2);
    LAS int* lcnt = (LAS int*)F.lds; LAS int* gbase = lcnt + 32; LAS int* inf_e = lcnt + 64; LAS int* inf_r = inf_e + 128; LAS float* inf_w = (LAS float*)(inf_r + 128);
    unsigned* cnt = (unsigned*)(F.ws + WS_CTL) + CW_CNT + (l + cnt_shift) * 32;
    int* toke = (int*)(F.ws + WS_TOKE); int* tokr = (int*)(F.ws + WS_TOKR); float* tokw = (float*)(F.ws + WS_TOKW);
    const float* rg = F.in[I_RG] + (size_t)l * D * 4; const float* rgb = F.in[I_RGB] + l * 4;
    for (int cb = blockIdx.x; cb < T / 64; cb += F.G) {
        if (F.tid < 32) lcnt[F.tid] = 0;
        __syncthreads();
        for (int i = 0; i < 8; ++i) {
            const int lr = F.wave * 8 + i, row = cb * 64 + lr, b = row >> 11;
            f32x4 x[4], h[4]; row_load(xsrc + (size_t)row * D, F.lane, x);
            const float* mp = mod + (size_t)(l * 8 + b) * 6144;
            row_norm_mod(x, F.in[I_NCM] + l * D, mp + 4 * D, mp + 3 * D, F.lane, h);
            row_store_bf16(HN + (size_t)row * D, F.lane, h);
            float gl[4] = {0.f, 0.f, 0.f, 0.f};
#pragma unroll
            for (int j = 0; j < 4; ++j)
#pragma unroll
                for (int q = 0; q < 4; ++q) { const f32x4 w = *(const f32x4*)(rg + (size_t)(4 * F.lane + 256 * j + q) * 4);
#pragma unroll
                    for (int e = 0; e < 4; ++e) gl[e] += h[j][q] * w[e]; }
#pragma unroll
            for (int e = 0; e < 4; ++e) gl[e] = wave_sum(gl[e], F.lane) + rgb[e];
            const float gm = fmaxf(fmaxf(gl[0], gl[1]), fmaxf(gl[2], gl[3]));
            const int gtop = (gl[0] == gm) ? 0 : (gl[1] == gm) ? 1 : (gl[2] == gm) ? 2 : 3;
            const float pg = 1.0f / (__expf(gl[0] - gm) + __expf(gl[1] - gm) + __expf(gl[2] - gm) + __expf(gl[3] - gm));
            const float* re = F.in[I_RE] + (size_t)(l * 4 + gtop) * D * 8; const float* reb = F.in[I_REB] + (l * 4 + gtop) * 8;
            float el[8];
#pragma unroll
            for (int e = 0; e < 8; ++e) el[e] = 0.f;
#pragma unroll
            for (int j = 0; j < 4; ++j)
#pragma unroll
                for (int q = 0; q < 4; ++q) { const float* wp = re + (size_t)(4 * F.lane + 256 * j + q) * 8; const f32x4 w0 = *(const f32x4*)wp, w1 = *(const f32x4*)(wp + 4);
#pragma unroll
                    for (int e = 0; e < 4; ++e) { el[e] += h[j][q] * w0[e]; el[4 + e] += h[j][q] * w1[e]; } }
#pragma unroll
            for (int e = 0; e < 8; ++e) el[e] = wave_sum(el[e], F.lane) + reb[e];
            float v0 = el[0]; int i0 = 0;
#pragma unroll
            for (int e = 1; e < 8; ++e) if (el[e] > v0) { v0 = el[e]; i0 = e; }
            float v1 = -3.0e38f; int i1 = 0;
#pragma unroll
            for (int e = 0; e < 8; ++e) if (e != i0 && el[e] > v1) { v1 = el[e]; i1 = e; }
            const float ex = __expf(v1 - v0); const float w0 = pg / (1.0f + ex), w1 = pg * ex / (1.0f + ex);
            if (F.lane == 0) {
                const int e0 = gtop * 8 + i0, e1 = gtop * 8 + i1;
                const int r0 = __hip_atomic_fetch_add(lcnt + e0, 1, __ATOMIC_RELAXED, __HIP_MEMORY_SCOPE_WORKGROUP);
                const int r1 = __hip_atomic_fetch_add(lcnt + e1, 1, __ATOMIC_RELAXED, __HIP_MEMORY_SCOPE_WORKGROUP);
                inf_e[lr * 2] = e0; inf_e[lr * 2 + 1] = e1; inf_r[lr * 2] = r0; inf_r[lr * 2 + 1] = r1; inf_w[lr * 2] = w0; inf_w[lr * 2 + 1] = w1;
            }
        }
        __syncthreads();
        if (F.tid < 32) gbase[F.tid] = (int)__hip_atomic_fetch_add(cnt + F.tid, (unsigned)lcnt[F.tid], __ATOMIC_RELAXED, __HIP_MEMORY_SCOPE_AGENT);
        __syncthreads();
        if (F.tid < 128) { const int idx = cb * 128 + F.tid; const int e = inf_e[F.tid]; toke[idx] = e; tokr[idx] = gbase[e] + inf_r[F.tid]; tokw[idx] = inf_w[F.tid]; }
        __syncthreads();
    }
}
__device__ __forceinline__ void moe_tables(Frame& F, int l) {
    LAS int* tileE = (LAS int*)(F.lds + TILEE_OFF); LAS int* offs = (LAS int*)(F.lds + OFFS_OFF);
    const unsigned* cnt = (const unsigned*)(F.ws + WS_CTL) + CW_CNT + l * 32;
    if (F.tid == 0) { int o = 0, nt = 0;
#pragma clang loop unroll(disable)
        for (int e = 0; e < 32; ++e) { const int c = (int)__hip_atomic_load(cnt + e, __ATOMIC_RELAXED, __HIP_MEMORY_SCOPE_AGENT); offs[e] = o; const int ne = (c + 255) >> 8;
#pragma clang loop unroll(disable)
            for (int k = 0; k < ne && nt < 160; ++k) tileE[nt++] = e;
            o += ne * 256; }
        tileE[160] = nt; offs[32] = o; }
    __syncthreads();
}
__device__ __forceinline__ void phase_moe_gather(Frame& F, int l) {
    moe_tables(F, l);
    const LAS int* offs = (const LAS int*)(F.lds + OFFS_OFF);
    if (blockIdx.x == 0 && F.tid < 161) ((int*)(F.ws + WS_TILEE))[F.tid] = ((const LAS int*)(F.lds + TILEE_OFF))[F.tid];
    const int* toke = (const int*)(F.ws + WS_TOKE); const int* tokr = (const int*)(F.ws + WS_TOKR); const float* tokw = (const float*)(F.ws + WS_TOKW);
    int* tokp = (int*)(F.ws + WS_TOKP); float* roww = (float*)(F.ws + WS_ROWW);
    const bf16* HN = (const bf16*)(F.ws + WS_ACT + A_HN2); bf16* AS = (bf16*)(F.ws + WS_ACT + A_ASORT);
    for (int idx = F.gw; idx < 2 * T; idx += F.NGW) {
        const int e = toke[idx]; const int pos = offs[e] + tokr[idx];
        if (F.lane == 0) { tokp[idx] = pos; roww[pos] = tokw[idx]; }
        const bf16* src = HN + (size_t)(idx >> 1) * D; bf16* dst = AS + (size_t)pos * D;
        const u32x4 a = *(const u32x4*)(src + 8 * F.lane), b = *(const u32x4*)(src + 512 + 8 * F.lane);
        *(u32x4*)(dst + 8 * F.lane) = a; *(u32x4*)(dst + 512 + 8 * F.lane) = b;
    }
    LAS float* scr = (LAS float*)(F.lds + 49152 + F.wave * 8704);
    bf16* WGU = (bf16*)(F.ws + WS_WM + W_GU); bf16* WDN = (bf16*)(F.ws + WS_WM + W_DN);
    constexpr int I_GATE = 16 * 8, I_DOWN = 4 * 32;
    for (int it = F.gw; it < NEXP * (2 * I_GATE + I_DOWN); it += F.NGW) {
        const int e = it / (2 * I_GATE + I_DOWN); int r = it % (2 * I_GATE + I_DOWN);
        if (r < 2 * I_GATE) { const int up = r / I_GATE; r %= I_GATE; const int kb = r / 8, nb = r % 8, n0 = nb * 32;
            const float* src = (up ? F.in[I_WU] : F.in[I_WG]) + ((size_t)(l * 32 + e) * D + kb * 64) * FEXP + n0;
            const int drow = (n0 >> 7) * 256 + up * 128 + (n0 & 127);
            transpose_item(src, FEXP, WGU + ((size_t)e * 512 + drow) * D + kb * 64, D, scr, F.lane);
        } else { r -= 2 * I_GATE; const int kb = r / 32, nb = r % 32;
            const float* src = F.in[I_WD] + ((size_t)(l * 32 + e) * FEXP + kb * 64) * D + nb * 32;
            transpose_item(src, D, WDN + ((size_t)e * D + nb * 32) * FEXP + kb * 64, FEXP, scr, F.lane); }
    }
}

namespace wk {
constexpr int P = 72, PB = 144, MAT = 64 * PB;
constexpr int PF = 68;
constexpr int O_NAB = 0, O_GS = 17408, O_GC = 19456, O_M0 = 20480;
constexpr int O_AT = O_M0, O_RT = O_AT + MAT, O_BT = O_RT + MAT, O_KT = O_BT + MAT, O_VV = O_KT + MAT, O_LAK = O_VV + MAT, O_MRB = O_LAK + MAT, O_MRK = O_MRB + MAT,
              O_NB = O_MRK + MAT, O_TT = O_NB + MAT, O_XT = O_TT + MAT, O_UT = O_XT + MAT, O_MT = O_UT + MAT, O_H0 = O_MT + MAT, O_H1 = O_H0 + MAT, O_END = O_H1 + MAT;
static_assert(O_END <= LDS_MISC, "scan LDS map");
typedef union { u32x4 u; bf16x8 v; } frag_t;
__device__ __forceinline__ bf16x8 zfrag() { frag_t z; z.u = (u32x4){0u, 0u, 0u, 0u}; return z.v; }
__device__ __forceinline__ bf16x8 ldrow(const LAS unsigned char* M, int row, int col) { return *(const LAS bf16x8*)(M + row * PB + col * 2); }
__device__ __forceinline__ bf16x8 ldtr(unsigned base, int r0, int c0, int lane) {
    const int g = lane >> 4, i = lane & 15, qq = i >> 2, p = i & 3;
    const unsigned a0 = base + (unsigned)((r0 + 8 * g + qq) * PB + (c0 + 4 * p) * 2), a1 = a0 + 4u * PB;
    u32x2 lo, hi;
    asm volatile("ds_read_b64_tr_b16 %0, %2\n\tds_read_b64_tr_b16 %1, %3\n\ts_waitcnt lgkmcnt(0)" : "=&v"(lo), "=&v"(hi) : "v"(a0), "v"(a1) : "memory");
    frag_t f; f.u.x = lo.x; f.u.y = lo.y; f.u.z = hi.x; f.u.w = hi.y; return f.v;
}
__device__ __forceinline__ void st4bf(LAS unsigned char* M, int row, int col, const f32x4& v) { u32x2 w; w.x = pk2(v[0], v[1]); w.y = pk2(v[2], v[3]); *(LAS u32x2*)(M + row * PB + col * 2) = w; }
#define WK_MFMA(a, b, c) __builtin_amdgcn_mfma_f32_16x16x32_bf16(a, b, c, 0, 0, 0)
}

__device__ __forceinline__ void phase_scan(Frame& F, int l) {
    using namespace wk;
    const int j = l >> 1;
    const bf16* Rb = (const bf16*)(F.ws + WS_ACT + A_RKV); const bf16* Kb = Rb + (size_t)T * D; const bf16* Vb = Kb + (size_t)T * D;
    const bf16* LD = (const bf16*)(F.ws + WS_ACT + A_LDEC); const bf16* AS = (const bf16*)(F.ws + WS_ACT + A_ASIG);
    bf16* Y = (bf16*)(F.ws + WS_ACT + A_Y); float* SB = (float*)(F.ws + WS_SB);
    LAS unsigned char* L = F.lds; const unsigned La = (unsigned)(size_t)L;
    LAS float* NAB = (LAS float*)(L + O_NAB); LAS float* GS = (LAS float*)(L + O_GS); LAS float* GC = (LAS float*)(L + O_GC);
    const int tid0 = F.tid, wave = F.wave;
    for (int unit = blockIdx.x; unit < NB * NH_R * 2; unit += F.G) {
        const int b = unit >> 5, h = (unit >> 1) & 15, dir = unit & 1; const int col = h * 64 + 8 * (tid0 & 7);
        f32x4 kkc[2], kac[2], rkc[2];
#pragma unroll
        for (int e = 0; e < 2; ++e) { kkc[e] = *(const f32x4*)(F.in[I_KK] + j * D + col + 4 * e); kac[e] = *(const f32x4*)(F.in[I_KA] + j * D + col + 4 * e); rkc[e] = *(const f32x4*)(F.in[I_RK] + j * D + col + 4 * e); }
        for (int i = tid0; i < (O_END - O_LAK) / 16; i += NTHREADS) *(LAS u32x4*)(L + O_LAK + i * 16) = (u32x4){0u, 0u, 0u, 0u};
        f32x4 Hs[4];
#pragma unroll
        for (int vj = 0; vj < 4; ++vj) Hs[vj] = (f32x4){0.f, 0.f, 0.f, 0.f};
        u32x4 gr, gk, gv, gl, ga;
#define WK_LOAD(c) do { const int st = (c) * 64 + (tid0 >> 3); const int t = dir ? (SEQ - 1 - st) : st; const size_t ro = ((size_t)b * SEQ + t) * D + col; \
            gr = *(const u32x4*)(Rb + ro); gk = *(const u32x4*)(Kb + ro); gv = *(const u32x4*)(Vb + ro); gl = *(const u32x4*)(LD + (size_t)dir * T * D + ro); ga = *(const u32x4*)(AS + (size_t)dir * T * D + ro); } while (0)
        WK_LOAD(0);
        __syncthreads();
        for (int c = 0; c < SEQ / 64; ++c) {
            int tid = tid0; asm volatile("" : "+v"(tid));
            const int lane = tid & 63, qi = lane & 15, q4 = lane >> 4, pt = tid >> 3, c8 = tid & 7;
            LAS unsigned char* H0 = L + ((c & 1) ? O_H1 : O_H0); LAS unsigned char* H1 = L + ((c & 1) ? O_H0 : O_H1);
            float av[8], bv[8], kdv[8], rv[8], ldv[8];
            {
                const unsigned gku[4] = {gk.x, gk.y, gk.z, gk.w}, gru[4] = {gr.x, gr.y, gr.z, gr.w}, glu[4] = {gl.x, gl.y, gl.z, gl.w}, gau[4] = {ga.x, ga.y, ga.z, ga.w};
                float kf[8], af[8], kkv[8]; float ss = 0.f;
#pragma unroll
                for (int e = 0; e < 4; ++e) { kf[2 * e] = bf_lo(gku[e]); kf[2 * e + 1] = bf_hi(gku[e]); rv[2 * e] = bf_lo(gru[e]); rv[2 * e + 1] = bf_hi(gru[e]);
                    ldv[2 * e] = bf_lo(glu[e]); ldv[2 * e + 1] = bf_hi(glu[e]); af[2 * e] = bf_lo(gau[e]); af[2 * e + 1] = bf_hi(gau[e]); }
#pragma unroll
                for (int e = 0; e < 8; ++e) { kkv[e] = kf[e] * kkc[e >> 2][e & 3]; ss += kkv[e] * kkv[e]; }
                ss += lane_xor(ss, lane, 1); ss += lane_xor(ss, lane, 2); ss += lane_xor(ss, lane, 4);
                const float inv = 1.0f / fmaxf(sqrtf(ss), 1e-12f); float bo = 0.f;
#pragma unroll
                for (int e = 0; e < 8; ++e) { const float kn = kkv[e] * inv; kdv[e] = kf[e] * (1.0f + (af[e] - 1.0f) * kac[e >> 2][e & 3]); av[e] = -kn; bv[e] = kn * af[e]; bo += rv[e] * kdv[e] * rkc[e >> 2][e & 3]; }
                bo += lane_xor(bo, lane, 1); bo += lane_xor(bo, lane, 2); bo += lane_xor(bo, lane, 4);
                const int st = c * 64 + pt; const int t = dir ? (SEQ - 1 - st) : st;
                if (c8 == 0) SB[((size_t)dir * T + (size_t)b * SEQ + t) * 16 + h] = bo;
                *(LAS f32x4*)(NAB + pt * PF + 8 * c8) = (f32x4){ldv[0], ldv[1], ldv[2], ldv[3]}; *(LAS f32x4*)(NAB + pt * PF + 8 * c8 + 4) = (f32x4){ldv[4], ldv[5], ldv[6], ldv[7]};
                *(LAS u32x4*)(L + O_VV + pt * PB + 16 * c8) = gv;
            }
            if (c + 1 < SEQ / 64) WK_LOAD(c + 1);
            __syncthreads();
            { const int kc = tid & 63, g = tid >> 6; float pre[8]; float p = 0.f;
#pragma unroll
              for (int i = 0; i < 8; ++i) { p += NAB[(8 * g + i) * PF + kc]; pre[i] = p; }
              GS[g * 64 + kc] = p;
              __syncthreads();
              float off = 0.f;
#pragma unroll
              for (int gg = 0; gg < 7; ++gg) off += (gg < g) ? GS[gg * 64 + kc] : 0.f;
#pragma unroll
              for (int i = 0; i < 8; ++i) NAB[(8 * g + i) * PF + kc] = off + pre[i]; }
            __syncthreads();
            { f32x4 cl[2], cm[2];
#pragma unroll
              for (int e = 0; e < 2; ++e) { cl[e] = *(const LAS f32x4*)(NAB + pt * PF + 8 * c8 + 4 * e); cm[e] = (pt > 0) ? *(const LAS f32x4*)(NAB + (pt - 1) * PF + 8 * c8 + 4 * e) : (f32x4){0.f, 0.f, 0.f, 0.f}; }
              float oa[8], orr[8], ob[8], ok[8];
#pragma unroll
              for (int e = 0; e < 8; ++e) { const float c1 = cl[e >> 2][e & 3], c0 = cm[e >> 2][e & 3]; const float gp = __builtin_amdgcn_exp2f(c1), gn = __builtin_amdgcn_exp2f(-c1), g0 = __builtin_amdgcn_exp2f(c0);
                  oa[e] = av[e] * g0; orr[e] = rv[e] * gp; ob[e] = bv[e] * gn; ok[e] = kdv[e] * gn; if (pt == 63) GC[8 * c8 + e] = gp; }
              *(LAS u32x4*)(L + O_AT + pt * PB + 16 * c8) = (u32x4){pk2(oa[0], oa[1]), pk2(oa[2], oa[3]), pk2(oa[4], oa[5]), pk2(oa[6], oa[7])};
              *(LAS u32x4*)(L + O_RT + pt * PB + 16 * c8) = (u32x4){pk2(orr[0], orr[1]), pk2(orr[2], orr[3]), pk2(orr[4], orr[5]), pk2(orr[6], orr[7])};
              *(LAS u32x4*)(L + O_BT + pt * PB + 16 * c8) = (u32x4){pk2(ob[0], ob[1]), pk2(ob[2], ob[3]), pk2(ob[4], ob[5]), pk2(ob[6], ob[7])};
              *(LAS u32x4*)(L + O_KT + pt * PB + 16 * c8) = (u32x4){pk2(ok[0], ok[1]), pk2(ok[2], ok[3]), pk2(ok[4], ok[5]), pk2(ok[6], ok[7])}; }
            __syncthreads();
#pragma unroll 1
            for (int jj = 0; jj < 5; ++jj) {
                const int idx = wave * 5 + jj, blk = idx / 10, tri = idx % 10;
                const int ti = (tri >= 6) ? 3 : ((tri >= 3) ? 2 : ((tri >= 1) ? 1 : 0)); const int si = tri - (ti * (ti + 1)) / 2;
                const LAS unsigned char* Pm = L + ((blk < 2) ? O_AT : O_RT); const LAS unsigned char* Qm = L + ((blk & 1) ? O_KT : O_BT);
                f32x4 acc = {0.f, 0.f, 0.f, 0.f};
#pragma unroll
                for (int ks = 0; ks < 2; ++ks) acc = WK_MFMA(ldrow(Qm, 16 * si + qi, 32 * ks + 8 * q4), ldrow(Pm, 16 * ti + qi, 32 * ks + 8 * q4), acc);
                const int tt = 16 * ti + qi, s0 = 16 * si + 4 * q4;
#pragma unroll
                for (int r = 0; r < 4; ++r) { const int sidx = s0 + r; const bool keep = (blk < 2) ? (sidx < tt) : (sidx <= tt); acc[r] = keep ? acc[r] : 0.f; }
                if (blk == 0) { *(LAS f32x4*)(NAB + tt * PF + s0) = acc; st4bf(L + O_NB, tt, s0, acc); }
                else st4bf(L + (blk == 1 ? O_LAK : (blk == 2 ? O_MRB : O_MRK)), tt, s0, acc);
            }
            __syncthreads();
            f32x4 X0[4], Y0[4];
            if (wave >= 4) { const int vj = wave - 4;
#pragma unroll
                for (int ti = 0; ti < 4; ++ti) { X0[ti] = (f32x4){0.f, 0.f, 0.f, 0.f}; Y0[ti] = (f32x4){0.f, 0.f, 0.f, 0.f};
#pragma unroll
                    for (int ks = 0; ks < 2; ++ks) if (ks <= (ti >> 1)) { const bf16x8 vf = ldtr(La + O_VV, 32 * ks, 16 * vj, lane);
                        X0[ti] = WK_MFMA(ldrow(L + O_LAK, 16 * ti + qi, 32 * ks + 8 * q4), vf, X0[ti]); Y0[ti] = WK_MFMA(ldrow(L + O_MRK, 16 * ti + qi, 32 * ks + 8 * q4), vf, Y0[ti]); } } }
            if (wave == 0) {
                const int blk = q4, cj = qi; float x[16];
#pragma unroll
                for (int r = 0; r < 16; ++r) { f32x4 nr[4];
#pragma unroll
                    for (int e = 0; e < 4; ++e) nr[e] = *(const LAS f32x4*)(NAB + (16 * blk + r) * PF + 16 * blk + 4 * e);
                    float acc = (r == cj) ? 1.0f : 0.0f;
#pragma unroll
                    for (int m = 0; m < 16; ++m) if (m < r) acc += nr[m >> 2][m & 3] * x[m];
                    x[r] = acc; *(LAS bf16*)(L + O_TT + (16 * blk + r) * PB + (16 * blk + cj) * 2) = (bf16)f2bf(acc); }
            }
            __syncthreads();
            if (wave < 2) {
                const int i = 2 * wave + 1, jb = 2 * wave;
                bf16x8 a = ldrow(L + O_NB, 16 * i + qi, 16 * jb + 8 * (q4 & 1)), bfr = ldtr(La + O_TT, 16 * jb - 8 * (q4 & 2), 16 * jb, lane);
                if (q4 >= 2) { a = zfrag(); bfr = zfrag(); }
                f32x4 acc = {0.f, 0.f, 0.f, 0.f}; acc = WK_MFMA(a, bfr, acc);
                st4bf(L + O_MT, 16 * wave + qi, 4 * q4, acc);
            }
            __syncthreads();
            if (wave < 2) {
                const int i = 2 * wave + 1, jb = 2 * wave;
                bf16x8 a = ldrow(L + O_TT, 16 * i + qi, 16 * i + 8 * (q4 & 1)), bfr = ldrow(L + O_MT, 16 * wave + qi, 8 * (q4 & 1));
                if (q4 >= 2) { a = zfrag(); bfr = zfrag(); }
                f32x4 acc = {0.f, 0.f, 0.f, 0.f}; acc = WK_MFMA(a, bfr, acc);
#pragma unroll
                for (int r = 0; r < 4; ++r) *(LAS bf16*)(L + O_TT + (16 * i + 4 * q4 + r) * PB + (16 * jb + qi) * 2) = (bf16)f2bf(acc[r]);
            }
            __syncthreads();
            if (wave < 4) {
                const int ti2 = wave >> 1, tj2 = wave & 1;
                f32x4 acc = {0.f, 0.f, 0.f, 0.f}; acc = WK_MFMA(ldrow(L + O_NB, 32 + 16 * ti2 + qi, 8 * q4), ldtr(La + O_TT, 0, 16 * tj2, lane), acc);
                st4bf(L + O_MT, 32 + 16 * tj2 + qi, 16 * ti2 + 4 * q4, acc);
            }
            __syncthreads();
            if (wave < 4) {
                const int ti2 = wave >> 1, tj2 = wave & 1;
                f32x4 acc = {0.f, 0.f, 0.f, 0.f}; acc = WK_MFMA(ldrow(L + O_TT, 32 + 16 * ti2 + qi, 32 + 8 * q4), ldrow(L + O_MT, 32 + 16 * tj2 + qi, 8 * q4), acc);
#pragma unroll
                for (int r = 0; r < 4; ++r) *(LAS bf16*)(L + O_TT + (32 + 16 * ti2 + 4 * q4 + r) * PB + (16 * tj2 + qi) * 2) = (bf16)f2bf(acc[r]);
            }
            if (wave >= 4) { const int vj = wave - 4;
#pragma unroll
                for (int ti = 0; ti < 4; ++ti) { f32x4 acc = X0[ti];
#pragma unroll
                    for (int ks = 0; ks < 2; ++ks) acc = WK_MFMA(ldrow(L + O_AT, 16 * ti + qi, 32 * ks + 8 * q4), ldrow(H0, 16 * vj + qi, 32 * ks + 8 * q4), acc);
                    st4bf(L + O_XT, 16 * vj + qi, 16 * ti + 4 * q4, acc); } }
            __syncthreads();
#pragma unroll
            for (int e = 0; e < 2; ++e) { const int id = wave * 2 + e, ti = id >> 2, vj = id & 3; f32x4 acc = {0.f, 0.f, 0.f, 0.f};
#pragma unroll
                for (int ks = 0; ks < 2; ++ks) if (ks <= (ti >> 1)) acc = WK_MFMA(ldrow(L + O_TT, 16 * ti + qi, 32 * ks + 8 * q4), ldrow(L + O_XT, 16 * vj + qi, 32 * ks + 8 * q4), acc);
                st4bf(L + O_UT, 16 * vj + qi, 16 * ti + 4 * q4, acc); }
            __syncthreads();
            if (wave >= 4) { const int vj = wave - 4;
#pragma unroll
                for (int ti = 0; ti < 4; ++ti) { f32x4 acc = Y0[ti];
#pragma unroll
                    for (int ks = 0; ks < 2; ++ks) { acc = WK_MFMA(ldrow(L + O_RT, 16 * ti + qi, 32 * ks + 8 * q4), ldrow(H0, 16 * vj + qi, 32 * ks + 8 * q4), acc);
                        if (ks <= (ti >> 1)) acc = WK_MFMA(ldrow(L + O_MRB, 16 * ti + qi, 32 * ks + 8 * q4), ldrow(L + O_UT, 16 * vj + qi, 32 * ks + 8 * q4), acc); }
#pragma unroll
                    for (int r = 0; r < 4; ++r) { const int st = c * 64 + 16 * ti + 4 * q4 + r; const int t = dir ? (SEQ - 1 - st) : st;
                        Y[((size_t)dir * T + (size_t)b * SEQ + t) * D + h * 64 + 16 * vj + qi] = (bf16)f2bf(acc[r]); } } }
            else { const int kt = wave; const f32x4 gc = *(const LAS f32x4*)(GC + 16 * kt + 4 * q4);
#pragma unroll
                for (int ks = 0; ks < 2; ++ks) { const bf16x8 bt = ldtr(La + O_BT, 32 * ks, 16 * kt, lane), ktf = ldtr(La + O_KT, 32 * ks, 16 * kt, lane);
#pragma unroll
                    for (int vj = 0; vj < 4; ++vj) { Hs[vj] = WK_MFMA(bt, ldrow(L + O_UT, 16 * vj + qi, 32 * ks + 8 * q4), Hs[vj]); Hs[vj] = WK_MFMA(ktf, ldtr(La + O_VV, 32 * ks, 16 * vj, lane), Hs[vj]); } }
#pragma unroll
                for (int vj = 0; vj < 4; ++vj) { Hs[vj] = Hs[vj] * gc; st4bf(H1, 16 * vj + qi, 16 * kt + 4 * q4, Hs[vj]); } }
            __syncthreads();
        }
#undef WK_LOAD
    }
}

__device__ __forceinline__ void phase_rw_post(Frame& F, int l) {
    const int j = l >> 1; const float* lnw = F.in[I_LNW] + j * D; const float* lnb = F.in[I_LNB] + j * D;
    const bf16* Vb = (const bf16*)(F.ws + WS_ACT + A_RKV) + (size_t)2 * T * D; const bf16* Y = (const bf16*)(F.ws + WS_ACT + A_Y); const bf16* Gb = (const bf16*)(F.ws + WS_ACT + A_G);
    const float* SB = (const float*)(F.ws + WS_SB); bf16* O = (bf16*)(F.ws + WS_ACT + A_O);
    for (int row = F.gw; row < T; row += F.NGW) {
        f32x4 o[4];
#pragma unroll
        for (int q = 0; q < 4; ++q) {
            const int c = 4 * F.lane + 256 * q; const int head = 4 * q + (F.lane >> 4);
            const u32x2 vr = *(const u32x2*)(Vb + (size_t)row * D + c); const f32x4 vf = {bf_lo(vr.x), bf_hi(vr.x), bf_lo(vr.y), bf_hi(vr.y)};
            const f32x4 w = *(const f32x4*)(lnw + c), bb = *(const f32x4*)(lnb + c);
            f32x4 acc = {0.f, 0.f, 0.f, 0.f};
#pragma unroll
            for (int dir = 0; dir < 2; ++dir) {
                const size_t ro = ((size_t)dir * T + row) * D + c;
                const u32x2 yr = *(const u32x2*)(Y + ro), gr = *(const u32x2*)(Gb + ro);
                const f32x4 yf = {bf_lo(yr.x), bf_hi(yr.x), bf_lo(yr.y), bf_hi(yr.y)}; const f32x4 gf = {bf_lo(gr.x), bf_hi(gr.x), bf_lo(gr.y), bf_hi(gr.y)};
                const float sbv = SB[((size_t)dir * T + row) * 16 + head];
                const float mean = rowsum16((yf[0] + yf[1]) + (yf[2] + yf[3])) * (1.0f / 64.0f);
                const f32x4 d = yf - mean; const float var = rowsum16((d[0] * d[0] + d[1] * d[1]) + (d[2] * d[2] + d[3] * d[3])) * (1.0f / 64.0f);
                const float rs = rsqrtf(var + GN_EPS);
                acc += gf * (d * rs * w + bb + sbv * vf);
            }
            o[q] = acc;
        }
        row_store_bf16(O + (size_t)row * D, F.lane, o);
    }
}

__device__ __forceinline__ unsigned att_f(unsigned row) { return ((row & 3u) << 2) | ((row >> 2) & 3u); }
__device__ __forceinline__ unsigned att_off_b(unsigned row, unsigned ch) { return 256u * row + 16u * (ch ^ att_f(row)); }
__device__ __forceinline__ void phase_attn(Frame& F) {
    const bf16* Qb = (const bf16*)(F.ws + WS_ACT + A_Q); const bf16* Kb = (const bf16*)(F.ws + WS_ACT + A_K); const bf16* Vb = (const bf16*)(F.ws + WS_ACT + A_VT);
    bf16* AO = (bf16*)(F.ws + WS_ACT + A_AO);
    const int lane = F.lane, qi = lane & 15, q4 = lane >> 4;
    LAS unsigned char* kl = F.lds + F.wave * 16384; LAS unsigned char* vl = kl + 8192;
    const unsigned kl_a = (unsigned)(size_t)kl, vl_a = (unsigned)(size_t)vl;
    unsigned ka[2][4], va[8][2];
#pragma unroll
    for (int rb = 0; rb < 2; ++rb)
#pragma unroll
        for (int s = 0; s < 4; ++s) ka[rb][s] = att_off_b((unsigned)(qi + 16 * rb), (unsigned)(4 * s + q4));
    { const unsigned q = (unsigned)qi >> 2, p = (unsigned)lane & 3u;
#pragma unroll
      for (int c = 0; c < 8; ++c)
#pragma unroll
          for (int t = 0; t < 2; ++t) va[c][t] = vl_a + att_off_b(8u * q4 + 4u * t + q, 2u * c + (p >> 1)) + 8u * (p & 1u); }
    unsigned fk[8];
#pragma unroll
    for (int i = 0; i < 8; ++i) { const unsigned rho = 4u * i + (unsigned)q4, m = rho & 15u, rb = rho >> 4; const unsigned kidx = 8u * (m >> 2) + (m & 3u) + 4u * rb;
        fk[i] = kidx | ((16u * ((unsigned)qi ^ att_f(rho))) << 8); }
    for (int u = blockIdx.x; u < NB * 8 * 8; u += F.G) {
        const int b = u >> 6, hs = (u >> 3) & 7, p0 = (u & 7) * 16;
        const int rX = F.wave, rY = F.wave + 8;
        const int tqX = rX + 16 * (p0 + qi), tqY = rY + 16 * (p0 + qi);
        float m_run[2] = {-1e30f, -1e30f}, l_run[2] = {0.f, 0.f}; f32x4 O[2][8];
#pragma unroll
        for (int qt = 0; qt < 2; ++qt)
#pragma unroll
            for (int dt = 0; dt < 8; ++dt) O[qt][dt] = (f32x4){0.f, 0.f, 0.f, 0.f};
        bf16x8 Qf[2][4];
#define ATT_PARAMS(vs, g_, s_, act_) const int g_ = (vs) < 12 ? 0 : ((vs) < 18 ? 1 : 2); const int s_ = (vs) < 12 ? (vs) : ((vs) < 18 ? (vs) - 12 : ((vs) < 23 ? (vs) - 18 : (vs) - 23)); const int act_ = (vs) < 18 ? 3 : ((vs) < 23 ? 1 : 2);
#define ATT_FILL(vs, WHICH) do { ATT_PARAMS(vs, g_, s_, act_) const int dsh_ = 2 * g_, Lg_ = SEQ >> dsh_; const int rg_ = ((act_ == 2) ? rY : rX) & ((1 << dsh_) - 1); \
            const int base_ = ((16 * p0) >> dsh_) - 64 + 32 * s_; const bf16* src_ = ((WHICH) ? Vb : Kb) + ((size_t)g_ * T + (size_t)b * SEQ) * D + hs * 128; \
            _Pragma("unroll") for (int i_ = 0; i_ < 8; ++i_) { const int kidx_ = (WHICH) ? (4 * i_ + q4) : (int)(fk[i_] & 255u); const int p_ = min(max(base_ + kidx_, 0), Lg_ - 1); \
                const char* gp_ = (const char*)(src_ + (size_t)(rg_ + (p_ << dsh_)) * D) + (fk[i_] >> 8); \
                __builtin_amdgcn_global_load_lds((const unsigned*)gp_, (LAS unsigned*)(((WHICH) ? vl : kl) + i_ * 1024), 16, 0, 0); } } while (0)
        ATT_FILL(0, 0); ATT_FILL(0, 1);
        for (int vs = 0; vs < 28; ++vs) {
            ATT_PARAMS(vs, g, s, act)
            const int dsh = 2 * g, Lg = SEQ >> dsh;
            if (vs == 0 || vs == 12 || vs == 18) {
                const bf16* qx = Qb + ((size_t)g * T + (size_t)b * SEQ + tqX) * D + hs * 128 + 8 * q4; const bf16* qy = Qb + ((size_t)g * T + (size_t)b * SEQ + tqY) * D + hs * 128 + 8 * q4;
#pragma unroll
                for (int kt = 0; kt < 4; ++kt) { Qf[0][kt] = *(const bf16x8*)(qx + 32 * kt); Qf[1][kt] = *(const bf16x8*)(qy + 32 * kt); }
            }
            const float slope2 = exp2f(-8.0f * (float)(g * 8 + hs + 1) / 24.0f) * LOG2E * (float)(1 << dsh);
            const int base = ((16 * p0) >> dsh) - 64 + 32 * s;
            asm volatile("s_waitcnt vmcnt(8)" ::: "memory");
            bf16x8 KA[4], KB[4];
#pragma unroll
            for (int kt = 0; kt < 4; ++kt) { KA[kt] = *(const LAS bf16x8*)(kl + ka[0][kt]); KB[kt] = *(const LAS bf16x8*)(kl + ka[1][kt]); }
            asm volatile("s_waitcnt lgkmcnt(0)" ::: "memory");
            if (vs + 1 < 28) ATT_FILL(vs + 1, 0);
            f32x4 SA[2], SBt[2];
#pragma unroll
            for (int qt = 0; qt < 2; ++qt) { SA[qt] = (f32x4){0.f, 0.f, 0.f, 0.f}; SBt[qt] = (f32x4){0.f, 0.f, 0.f, 0.f};
                if ((act >> qt) & 1) {
#pragma unroll
                    for (int kt = 0; kt < 4; ++kt) { SA[qt] = __builtin_amdgcn_mfma_f32_16x16x32_bf16(KA[kt], Qf[qt][kt], SA[qt], 0, 0, 0); SBt[qt] = __builtin_amdgcn_mfma_f32_16x16x32_bf16(KB[kt], Qf[qt][kt], SBt[qt], 0, 0, 0); } } }
            bf16x8 pf[2]; float alpha[2];
#pragma unroll
            for (int qt = 0; qt < 2; ++qt) {
                alpha[qt] = 1.0f; { union { u32x4 u; bf16x8 v; } z; z.u = (u32x4){0u, 0u, 0u, 0u}; pf[qt] = z.v; }
                if ((act >> qt) & 1) {
                    const int Pq = (qt ? tqY : tqX) >> dsh; const int cb = base + 8 * q4;
                    float sv[8]; bool ok[8]; float mx = -1e30f;
#pragma unroll
                    for (int r = 0; r < 8; ++r) { const int p = cb + r; const int rel = abs(p - Pq); ok[r] = (p >= 0) && (p < Lg) && (rel <= 64);
                        const float sc = (r < 4 ? SA[qt][r & 3] : SBt[qt][r & 3]) - slope2 * (float)rel; sv[r] = ok[r] ? sc : -1e30f; mx = fmaxf(mx, sv[r]); }
                    mx = fmaxf(mx, lane_xor(mx, lane, 16)); mx = fmaxf(mx, lane_xor(mx, lane, 32));
                    const float m_new = fmaxf(m_run[qt], mx); alpha[qt] = __builtin_amdgcn_exp2f(m_run[qt] - m_new); m_run[qt] = m_new;
                    float pe[8]; float rs = 0.f;
#pragma unroll
                    for (int r = 0; r < 8; ++r) { pe[r] = ok[r] ? __builtin_amdgcn_exp2f(sv[r] - m_new) : 0.f; rs += pe[r]; }
                    rs += lane_xor(rs, lane, 16); rs += lane_xor(rs, lane, 32);
                    l_run[qt] = l_run[qt] * alpha[qt] + rs;
                    union { u32x4 u; bf16x8 v; } z; z.u.x = pk2(pe[0], pe[1]); z.u.y = pk2(pe[2], pe[3]); z.u.z = pk2(pe[4], pe[5]); z.u.w = pk2(pe[6], pe[7]); pf[qt] = z.v;
                }
            }
            if (vs + 1 < 28) asm volatile("s_waitcnt vmcnt(8)" ::: "memory"); else asm volatile("s_waitcnt vmcnt(0)" ::: "memory");
#pragma unroll
            for (int hf = 0; hf < 2; ++hf) {
                u32x2 vr[4][2];
                asm volatile("ds_read_b64_tr_b16 %0, %8\n\tds_read_b64_tr_b16 %1, %9\n\tds_read_b64_tr_b16 %2, %10\n\tds_read_b64_tr_b16 %3, %11\n\t"
                             "ds_read_b64_tr_b16 %4, %12\n\tds_read_b64_tr_b16 %5, %13\n\tds_read_b64_tr_b16 %6, %14\n\tds_read_b64_tr_b16 %7, %15\n\ts_waitcnt lgkmcnt(0)"
                             : "=&v"(vr[0][0]), "=&v"(vr[0][1]), "=&v"(vr[1][0]), "=&v"(vr[1][1]), "=&v"(vr[2][0]), "=&v"(vr[2][1]), "=&v"(vr[3][0]), "=&v"(vr[3][1])
                             : "v"(va[4 * hf + 0][0]), "v"(va[4 * hf + 0][1]), "v"(va[4 * hf + 1][0]), "v"(va[4 * hf + 1][1]), "v"(va[4 * hf + 2][0]), "v"(va[4 * hf + 2][1]), "v"(va[4 * hf + 3][0]), "v"(va[4 * hf + 3][1])
                             : "memory");
                if (hf == 1 && vs + 1 < 28) ATT_FILL(vs + 1, 1);
#pragma unroll
                for (int c = 0; c < 4; ++c) { const int dt = 4 * hf + c; union { u32x4 u; bf16x8 v; } vf; vf.u.x = vr[c][0].x; vf.u.y = vr[c][0].y; vf.u.z = vr[c][1].x; vf.u.w = vr[c][1].y;
#pragma unroll
                    for (int qt = 0; qt < 2; ++qt) if ((act >> qt) & 1) { O[qt][dt] = O[qt][dt] * alpha[qt]; O[qt][dt] = __builtin_amdgcn_mfma_f32_16x16x32_bf16(vf.v, pf[qt], O[qt][dt], 0, 0, 0); } }
            }
        }
#pragma unroll
        for (int qt = 0; qt < 2; ++qt) { const float inv = 1.0f / l_run[qt];
            bf16* op = AO + ((size_t)b * SEQ + (qt ? tqY : tqX)) * D + hs * 128 + 4 * q4;
#pragma unroll
            for (int dt = 0; dt < 8; ++dt) { u32x2 o; o.x = pk2(O[qt][dt][0] * inv, O[qt][dt][1] * inv); o.y = pk2(O[qt][dt][2] * inv, O[qt][dt][3] * inv); *(u32x2*)(op + 16 * dt) = o; } }
#undef ATT_PARAMS
#undef ATT_FILL
    }
}

constexpr int PH_PER_LAYER = 10, N_PHASES = 1 + DEPTH * PH_PER_LAYER + 1;
template <int MASK> __global__ void __launch_bounds__(NTHREADS, 2) mk_fwd(Args args) {
    extern __shared__ __attribute__((aligned(16))) unsigned char lds_raw[];
#define PHASE_FRAME() Frame F; { int t_ = wave0 * 64 + lane_id_nh(); asm volatile("" : "+v"(t_)); unsigned char* w_ = args.ws; asm volatile("" : "+s"(w_)); \
        unsigned lb_ = 0; asm volatile("" : "+s"(lb_)); F.lds = (LAS unsigned char*)lds_raw + lb_; F.tid = t_; F.lane = t_ & 63; F.wave = __builtin_amdgcn_readfirstlane(t_ >> 6); \
        F.G = gridDim.x; F.gw = blockIdx.x * NWAVES + F.wave; F.NGW = F.G * NWAVES; F.ws = w_; F.in = args.in; F.out = args.out; }
    LAS unsigned char* lds0 = (LAS unsigned char*)lds_raw;
    const int wave0 = __builtin_amdgcn_readfirstlane((int)threadIdx.x >> 6);
    volatile LAS unsigned* MISC = (volatile LAS unsigned*)(lds0 + MISC_OFF);
    if (wave0 == 0) ((LAS unsigned*)(lds0 + LDS_MISC))[lane_id_nh() + 64] = 0u;
    __syncthreads();
    unsigned* ctl = (unsigned*)(args.ws + WS_CTL);
    XcdBarrier bar; bar.bar = ctl + CW_BAR; bar.x = 0; bar.st = nullptr;
#if ONE_LAUNCH
    bar = xcd_barrier_post(ctl + CW_BAR, MISC + 8, wave0 == 0 && lane_id_nh() == 0);
#endif
    const int lo = args.ph_lo, hi = args.ph_hi;
#define EN(b) ((MASK >> (b)) & 1)
#ifndef DUP_MASK
#define DUP_MASK 0
#endif
#define REP(b) for (int rep_ = 0; rep_ < 1 + ((DUP_MASK >> (b)) & 1); ++rep_)
#define IN(k) (lo <= (k) && (k) < hi)
#if ONE_LAUNCH
#ifndef BAR_REP
#define BAR_REP 1
#endif
#define SEAM(k) do { if (IN((k) + 1) || (k) + 1 < hi) { for (int br_ = 0; br_ < BAR_REP; ++br_) xcd_barrier(bar, wave0 == 0 && lane_id_nh() == 0); } } while (0)
#else
#define SEAM(k) do { } while (0)
#endif
    float* X0 = args.out; float* X1 = (float*)(args.ws + WS_X1);
    if (EN(0) && IN(0)) { PHASE_FRAME(); REP(0) phase_prologue(F); SEAM(0); }
    for (int l = 0; l < DEPTH; ++l) {
        const int pb = 1 + l * PH_PER_LAYER; const int j = l >> 1;
        const float* xin = (l == 0) ? args.in[I_X] : ((l & 1) ? X0 : X1);
        float* xcur = (l == 0) ? X0 : ((l & 1) ? X1 : X0);
        if ((l & 1) == 0) {
            if (EN(1) && IN(pb + 0)) { PHASE_FRAME(); REP(1) phase_rw_norm(F, l, l > 0, xin, xcur); SEAM(pb + 0); }
            if (EN(2) && IN(pb + 1)) { PHASE_FRAME(); REP(2) {
                { DenseSched S; S.o.init(T / 256, 12, F.G, blockIdx.x); S.A = (const char*)(F.ws + WS_ACT + A_XS); S.a_sel_stride = (size_t)T * D * 2; S.pn_per_a = 4;
                  S.B = (const char*)(F.ws + WS_W + j * W_RW_STRIDE + W_RKV); S.tstepA = (size_t)256 * D * 2; S.tstepB = (size_t)256 * D * 2;
                  EpiSplit E{(bf16*)(F.ws + WS_ACT + A_RKV), (size_t)T * D, 1.0f};
                  pg8::gemm_phase(F.lds, F.tid, D, D, D, S, E); }
                { DenseSched S; S.o.init(T / 256, 2, F.G, blockIdx.x); S.A = (const char*)(F.ws + WS_ACT + A_HX); S.a_sel_stride = 0; S.pn_per_a = 1 << 20;
                  S.B = (const char*)(F.ws + WS_W + j * W_RW_STRIDE + W_LDN); S.tstepA = (size_t)256 * 2048 * 2; S.tstepB = (size_t)256 * 2048 * 2;
                  EpiLoraDn E{(bf16*)(F.ws + WS_ACT + A_LORAH)};
                  pg8::gemm_phase(F.lds, F.tid, 2048, 2048, 2048, S, E); }
                }
                SEAM(pb + 1);
            }
            if (EN(3) && IN(pb + 2)) { PHASE_FRAME(); REP(3) {
                { DenseSched S; S.o.init(T / 256, 16, F.G, blockIdx.x); S.A = (const char*)(F.ws + WS_ACT + A_LORAH); S.a_sel_stride = 0; S.pn_per_a = 1 << 20;
                  S.B = (const char*)(F.ws + WS_W + j * W_RW_STRIDE + W_LUPWA); S.tstepA = (size_t)256 * 512 * 2; S.tstepB = (size_t)256 * 256 * 2;
                  EpiLoraUpWA E{(bf16*)(F.ws + WS_ACT + A_LDEC), (bf16*)(F.ws + WS_ACT + A_ASIG), F.in[I_W0] + j * 2 * D, F.in[I_A0] + j * 2 * D};
                  pg8::gemm_phase(F.lds, F.tid, 256, 512, 256, S, E); }
                { DenseSched S; S.o.init(T / 256, 8, F.G, blockIdx.x); S.A = (const char*)(F.ws + WS_ACT + A_LORAH) + 512; S.a_sel_stride = 0; S.pn_per_a = 1 << 20;
                  S.B = (const char*)(F.ws + WS_W + j * W_RW_STRIDE + W_LUPG); S.tstepA = (size_t)256 * 512 * 2; S.tstepB = (size_t)256 * 256 * 2;
                  EpiSplit E{(bf16*)(F.ws + WS_ACT + A_G), (size_t)T * D, 1.0f};
                  pg8::gemm_phase(F.lds, F.tid, 256, 512, 256, S, E); }
                }
                SEAM(pb + 2);
            }
            if (EN(4) && IN(pb + 3)) { PHASE_FRAME(); REP(4) phase_scan(F, l); SEAM(pb + 3); }
            if (EN(5) && IN(pb + 4)) { PHASE_FRAME(); REP(5) phase_rw_post(F, l); SEAM(pb + 4); }
            if (EN(6) && IN(pb + 5)) { PHASE_FRAME();
                DenseSched S; S.o.init(T / 256, 4, F.G, blockIdx.x); S.A = (const char*)(F.ws + WS_ACT + A_O); S.a_sel_stride = 0; S.pn_per_a = 1 << 20;
                S.B = (const char*)(F.ws + WS_W + j * W_RW_STRIDE + W_RWO); S.tstepA = (size_t)256 * D * 2; S.tstepB = (size_t)256 * D * 2;
                EpiResid E{(l == 0) ? F.in[I_X] : (const float*)xcur, xcur, (const float*)(F.ws + WS_MOD) + (size_t)l * 8 * 6144 + 2 * D};
                pg8::gemm_phase(F.lds, F.tid, D, D, D, S, E);
                SEAM(pb + 5);
            }
        } else {
            if (EN(7) && IN(pb + 0)) { PHASE_FRAME(); REP(7) phase_at_norm(F, l, xin, xcur); SEAM(pb + 0); }
            if (EN(8) && IN(pb + 1)) { PHASE_FRAME(); REP(8) {
                DenseSched S; S.o.init(T / 256, 36, F.G, blockIdx.x); S.A = (const char*)(F.ws + WS_ACT + A_H); S.a_sel_stride = 0; S.pn_per_a = 1 << 20;
                S.B = (const char*)(F.ws + WS_WA + j * W_AT_STRIDE + W_QKV); S.tstepA = (size_t)256 * D * 2; S.tstepB = (size_t)256 * D * 2;
                EpiQKV E{(bf16*)(F.ws + WS_ACT + A_Q), (bf16*)(F.ws + WS_ACT + A_K), (bf16*)(F.ws + WS_ACT + A_VT), 0.08838834764831845f * LOG2E};
                pg8::gemm_phase(F.lds, F.tid, D, D, D, S, E);
                }
                SEAM(pb + 1);
            }
            if (EN(9) && IN(pb + 2)) { PHASE_FRAME(); REP(9) phase_attn(F); SEAM(pb + 2); }
            if (EN(10) && IN(pb + 3)) { PHASE_FRAME();
                DenseSched S; S.o.init(T / 256, 4, F.G, blockIdx.x); S.A = (const char*)(F.ws + WS_ACT + A_AO); S.a_sel_stride = 0; S.pn_per_a = 1 << 20;
                S.B = (const char*)(F.ws + WS_WA + j * W_AT_STRIDE + W_AWO); S.tstepA = (size_t)256 * D * 2; S.tstepB = (size_t)256 * D * 2;
                EpiResid E{(const float*)xcur, xcur, (const float*)(F.ws + WS_MOD) + (size_t)l * 8 * 6144 + 2 * D};
                pg8::gemm_phase(F.lds, F.tid, D, D, D, S, E);
                SEAM(pb + 3);
            }
        }
        if (EN(11) && IN(pb + 6)) { PHASE_FRAME(); if ((DUP_MASK >> 11) & 1) phase_moe_route(F, l, xcur, 4); phase_moe_route(F, l, xcur); SEAM(pb + 6); }
        if (EN(12) && IN(pb + 7)) { PHASE_FRAME(); REP(12) phase_moe_gather(F, l); SEAM(pb + 7); }
        if (EN(13) && IN(pb + 8)) { PHASE_FRAME(); REP(13) {
            MoeSched S; S.tileE = (const int*)(F.ws + WS_TILEE); S.ntiles = uni(S.tileE[160]); S.npn = 2; S.G = F.G; S.c = blockIdx.x;
            S.A = (const char*)(F.ws + WS_ACT + A_ASORT); S.B = (const char*)(F.ws + WS_WM + W_GU); S.tstepA = (size_t)256 * D * 2; S.tstepB = (size_t)256 * D * 2; S.estride = (size_t)512 * D * 2;
            EpiGateUp E{(bf16*)(F.ws + WS_ACT + A_HID), (const float*)(F.ws + WS_ROWW)};
            pg8::gemm_phase(F.lds, F.tid, D, D, D, S, E);
            }
                SEAM(pb + 8);
        }
        if (EN(14) && IN(pb + 9)) { PHASE_FRAME(); REP(14) {
            MoeSched S; S.tileE = (const int*)(F.ws + WS_TILEE); S.ntiles = uni(S.tileE[160]); S.npn = 4; S.G = F.G; S.c = blockIdx.x;
            S.A = (const char*)(F.ws + WS_ACT + A_HID); S.B = (const char*)(F.ws + WS_WM + W_DN); S.tstepA = (size_t)256 * FEXP * 2; S.tstepB = (size_t)256 * FEXP * 2; S.estride = (size_t)D * FEXP * 2;
            EpiPlain E{(bf16*)(F.ws + WS_ACT + A_YS)};
            pg8::gemm_phase(F.lds, F.tid, FEXP, FEXP, FEXP, S, E);
            }
                SEAM(pb + 9);
        }
    }
    if (EN(15) && IN(N_PHASES - 1)) { PHASE_FRAME(); phase_final(F, X1); }
#undef IN
#undef SEAM
}

typedef void (*kern_t)(Args);
template <int B> static kern_t kern_of_bit(int b) { if (b == B) return mk_fwd<(1 << B)>; if constexpr (B > 0) return kern_of_bit<B - 1>(b); else return nullptr; }
static int kind_of_phase(int p) {
    if (p == 0) return 0; if (p == N_PHASES - 1) return 15;
    const int l = (p - 1) / PH_PER_LAYER, k = (p - 1) % PH_PER_LAYER;
    if (k >= 6) return 11 + (k - 6);
    if ((l & 1) == 0) return 1 + k;
    return (k < 4) ? 7 + k : -1;
}
extern "C" void kernel_launch(void* const* d_in, const int* in_sizes, int n_in, void* d_out, int out_size, void* d_ws, size_t ws_size, hipStream_t stream) {
    static int grid = 0;
    if (grid == 0) {
        if (n_in != 32 || out_size != T * D || ws_size < WS_END) { fprintf(stderr, "kernel_launch: unexpected shapes (n_in %d out %d ws %zu need %zu)\n", n_in, out_size, ws_size, (size_t)WS_END); grid = -1; return; }
        int dev = 0, cus = 0;
        if (hipGetDevice(&dev) != hipSuccess || hipDeviceGetAttribute(&cus, hipDeviceAttributeMultiprocessorCount, dev) != hipSuccess) { grid = -1; return; }
#if ONE_LAUNCH
        if (hipFuncSetAttribute((const void*)mk_fwd<0xffff>, hipFuncAttributeMaxDynamicSharedMemorySize, LDS_BYTES) != hipSuccess) { fprintf(stderr, "kernel_launch: hipFuncSetAttribute failed\n"); grid = -1; return; }
#else
        for (int b = 0; b < 16; ++b) if (hipFuncSetAttribute((const void*)kern_of_bit<15>(b), hipFuncAttributeMaxDynamicSharedMemorySize, LDS_BYTES) != hipSuccess) { fprintf(stderr, "kernel_launch: hipFuncSetAttribute failed\n"); grid = -1; return; }
#endif
        (void)hipGetLastError();
        grid = cus;
    }
    if (grid < 0) return;
    (void)hipMemsetAsync((char*)d_ws + WS_CTL, 0, CTL_ZERO_BYTES, stream);
    Args a{};
    for (int i = 0; i < 32; ++i) a.in[i] = (const float*)d_in[i];
    a.out = (float*)d_out; a.ws = (unsigned char*)d_ws;
#if ONE_LAUNCH
#ifndef SPLIT_EVERY
#define SPLIT_EVERY N_PHASES
#endif
    for (int p = 0; p < N_PHASES; p += SPLIT_EVERY) {
        a.ph_lo = p; a.ph_hi = (p + SPLIT_EVERY < N_PHASES) ? p + SPLIT_EVERY : N_PHASES;
        hipLaunchKernelGGL(mk_fwd<0xffff>, dim3(grid), dim3(NTHREADS), LDS_BYTES, stream, a);
    }
#else
    for (int p = 0; p < N_PHASES; ++p) {
        const int kind = kind_of_phase(p); if (kind < 0) continue;
        a.ph_lo = p; a.ph_hi = p + 1;
        hipLaunchKernelGGL(kern_of_bit<15>(kind), dim3(grid), dim3(NTHREADS), LDS_BYTES, stream, a);
    }
#endif
}
```

```cpp
#include <hip/hip_runtime.h>
#include <cstdio>
#include <cstdint>

#ifndef ONE_LAUNCH
#define ONE_LAUNCH 1
#endif


#define LAS __attribute__((address_space(3)))
typedef unsigned short bf16;
typedef short bf16x8 __attribute__((ext_vector_type(8)));
typedef float f32x4 __attribute__((ext_vector_type(4)));
typedef float f32x2 __attribute__((ext_vector_type(2)));
typedef unsigned u32x4 __attribute__((ext_vector_type(4)));
typedef unsigned u32x2 __attribute__((ext_vector_type(2)));

constexpr int NB = 8, SEQ = 2048, D = 1024, T = NB * SEQ, DEPTH = 4;
constexpr int NH_R = 16, HD_R = 64;
constexpr int QKVW = 9216;
constexpr int NEXP = 32, FEXP = 256;
constexpr int MAXROWS = 40960;
constexpr int NWAVES = 8, NTHREADS = 512;
constexpr float RMS_EPS = 1e-6f, GN_EPS = 64e-5f;
constexpr float LOG2E = 1.4426950408889634f;

constexpr size_t MiB = 1u << 20;
constexpr size_t WS_CTL = 0, CTL_ZERO_BYTES = 64 * 1024;
constexpr size_t WS_MOD = 1 * MiB;
constexpr size_t WS_TOKE = 2 * MiB;
constexpr size_t WS_TOKR = WS_TOKE + 128 * 1024;
constexpr size_t WS_TOKW = WS_TOKR + 128 * 1024;
constexpr size_t WS_TOKP = WS_TOKW + 128 * 1024;
constexpr size_t WS_ROWW = WS_TOKP + 128 * 1024;
constexpr size_t WS_TILEE = WS_ROWW + 192 * 1024;
constexpr size_t WS_SB = 4 * MiB;
constexpr size_t WS_W = 8 * MiB;
constexpr size_t W_RKV = 0, W_LDN = 6 * MiB, W_LUPWA = 8 * MiB, W_LUPG = 10 * MiB, W_RWO = 11 * MiB, W_RW_STRIDE = 13 * MiB;
constexpr size_t WS_WA = WS_W + 2 * W_RW_STRIDE;
constexpr size_t W_QKV = 0, W_AWO = 18 * MiB, W_AT_STRIDE = 20 * MiB;
constexpr size_t WS_WM = WS_WA + 2 * W_AT_STRIDE;
constexpr size_t W_GU = 0, W_DN = 32 * MiB;
constexpr size_t WS_X1 = 128 * MiB;
constexpr size_t WS_ACT = 192 * MiB;
constexpr size_t A_XS = 0, A_HX = 96 * MiB;
constexpr size_t A_LDEC = 0, A_ASIG = 64 * MiB, A_G = 128 * MiB;
constexpr size_t A_RKV = 192 * MiB;
constexpr size_t A_O = 192 * MiB;
constexpr size_t A_LORAH = 288 * MiB;
constexpr size_t A_Y = 304 * MiB;
constexpr size_t A_H = 0;
constexpr size_t A_Q = 32 * MiB, A_K = 128 * MiB, A_VT = 224 * MiB;
constexpr size_t A_AO = 320 * MiB;
constexpr size_t A_HN2 = 0, A_ASORT = 32 * MiB, A_HID = 112 * MiB, A_YS = 288 * MiB;
static_assert(A_K - A_Q == A_VT - A_K, "q/k/v spacing");
constexpr size_t WS_END = WS_ACT + 368 * MiB;

constexpr int CW_BAR = 4096;
constexpr int CW_CNT = 8192;

constexpr int LDS_BYTES = 163840;
constexpr int LDS_MISC = 159744;
constexpr int MISC_OFF = LDS_MISC + 320;
constexpr int TILEE_OFF = LDS_MISC + 1024;
constexpr int OFFS_OFF = LDS_MISC + 2048;

__device__ __forceinline__ float bf_lo(unsigned u) { return __uint_as_float(u << 16); }
__device__ __forceinline__ float bf_hi(unsigned u) { return __uint_as_float(u & 0xffff0000u); }
__device__ __forceinline__ float bf2f(bf16 v) { return __uint_as_float(((unsigned)v) << 16); }
__device__ __forceinline__ unsigned f2bf(float f) { __bf16 r = (__bf16)f; return (unsigned)__builtin_bit_cast(unsigned short, r); }
__device__ __forceinline__ unsigned pk2(float lo, float hi) { typedef __bf16 b2_t __attribute__((ext_vector_type(2))); typedef float f2_t __attribute__((ext_vector_type(2))); f2_t v = {lo, hi}; b2_t r = __builtin_convertvector(v, b2_t); return __builtin_bit_cast(unsigned, r); }
__device__ __forceinline__ float dpp_ror(float x, const int ctrl_sel) {
    int r;
    if (ctrl_sel == 8) r = __builtin_amdgcn_update_dpp(0, __float_as_int(x), 0x128, 0xf, 0xf, false);
    else if (ctrl_sel == 4) r = __builtin_amdgcn_update_dpp(0, __float_as_int(x), 0x124, 0xf, 0xf, false);
    else if (ctrl_sel == 2) r = __builtin_amdgcn_update_dpp(0, __float_as_int(x), 0x122, 0xf, 0xf, false);
    else r = __builtin_amdgcn_update_dpp(0, __float_as_int(x), 0x121, 0xf, 0xf, false);
    return __int_as_float(r);
}
__device__ __forceinline__ float rowsum16(float x) { x += dpp_ror(x, 8); x += dpp_ror(x, 4); x += dpp_ror(x, 2); x += dpp_ror(x, 1); return x; }
__device__ __forceinline__ float sum8(float x) {
    x += __int_as_float(__builtin_amdgcn_update_dpp(0, __float_as_int(x), 0x141, 0xf, 0xf, false));
    x += __int_as_float(__builtin_amdgcn_update_dpp(0, __float_as_int(x), 0xB1, 0xf, 0xf, false));
    x += __int_as_float(__builtin_amdgcn_update_dpp(0, __float_as_int(x), 0x4E, 0xf, 0xf, false));
    return x;
}
__device__ __forceinline__ float lane_xor(float v, int lane, int o) { return __int_as_float(__builtin_amdgcn_ds_bpermute((lane ^ o) << 2, __float_as_int(v))); }
__device__ __forceinline__ float wave_sum(float v, int lane) { v = rowsum16(v); v += lane_xor(v, lane, 16); v += lane_xor(v, lane, 32); return v; }
__device__ __forceinline__ int lane_id_nh() { int lid; asm volatile("v_mbcnt_lo_u32_b32 %0, -1, 0\n\tv_mbcnt_hi_u32_b32 %0, -1, %0" : "=v"(lid)); return lid; }
__device__ __forceinline__ float sigmoidf_(float x) { return 1.0f / (1.0f + __expf(-x)); }
#define LDS_WAIT() asm volatile("s_waitcnt lgkmcnt(0)" ::: "memory")
#define VM_WAIT() asm volatile("s_waitcnt vmcnt(0)" ::: "memory")

#define XB_TMO      128
#define XB_XCNT(j)  (256  + 64 * (j))
#define XB_XSUB(j)  (1280 + 64 * (j))
#define XB_XGEN(j)  (2304 + 64 * (j))
#define XB_TOP      3328
#define XB_TOPGEN   3392
#define XCD_BAR_WORDS 3456
#define XB_SPIN_CAP (1u << 18)
__device__ __forceinline__ unsigned xb_ld(unsigned* p)              { return __hip_atomic_load(p, __ATOMIC_RELAXED, __HIP_MEMORY_SCOPE_AGENT); }
__device__ __forceinline__ unsigned xb_add(unsigned* p, unsigned v) { return __hip_atomic_fetch_add(p, v, __ATOMIC_RELAXED, __HIP_MEMORY_SCOPE_AGENT); }
__device__ __forceinline__ unsigned xb_xcc_id() { return (unsigned)__builtin_amdgcn_s_getreg((3 << 11) | 20) & 0xFu; }
#define XB_SPIN(cond, bar) do { unsigned _sp = 0; while (cond) { __builtin_amdgcn_s_sleep(1); \
    if ((++_sp & 255u) == 0u) { if (xb_ld(&(bar)[XB_TMO])) break; if (_sp > XB_SPIN_CAP) { atomicAdd(&(bar)[XB_TMO], 1u); break; } } } } while (0)
struct XcdBarrier { unsigned* bar; unsigned x; volatile LAS unsigned* st; };
__device__ __forceinline__ XcdBarrier xcd_barrier_post(unsigned* bar, volatile LAS unsigned* st, bool t0) {
    XcdBarrier b; b.bar = bar; b.x = xb_xcc_id(); b.st = st;
    if (t0) (void)xb_add(&bar[XB_XCNT(b.x)], 1u);
    return b;
}
__device__ __forceinline__ void xcd_barrier_complete(unsigned* bar, unsigned x, unsigned& nloc, unsigned& nx) {
    const unsigned G = gridDim.x * gridDim.y * gridDim.z;
    unsigned sum, cnt, mine, sp = 0u;
    for (;;) {
        sum = 0u; cnt = 0u; mine = 0u;
#pragma clang loop unroll(disable)
        for (unsigned j = 0; j < 16; ++j) { const unsigned c = xb_ld(&bar[XB_XCNT(j)]); sum += c; cnt += (c > 0u) ? 1u : 0u; mine = (j == x) ? c : mine; }
        if (sum == G) break;
        __builtin_amdgcn_s_sleep(1);
        if ((++sp & 255u) == 0u) { if (xb_ld(&bar[XB_TMO])) break; if (sp > XB_SPIN_CAP) { atomicAdd(&bar[XB_TMO], 1u); break; } }
    }
    nloc = mine > 0u ? mine : 1u; nx = cnt > 0u ? cnt : 1u;
}
__device__ __forceinline__ void xcd_barrier(const XcdBarrier& b, bool t0) {
    asm volatile("s_waitcnt vmcnt(0)" ::: "memory");
    __syncthreads();
    if (t0) {
        unsigned* bar = b.bar;
        __builtin_amdgcn_s_waitcnt(0);
        unsigned nloc = b.st[0], nx = b.st[1];
        if (nloc == 0u) { xcd_barrier_complete(bar, b.x, nloc, nx); b.st[0] = nloc; b.st[1] = nx; }
        const unsigned old = xb_add(&bar[XB_XSUB(b.x)], 1u);
        const unsigned gen = old / nloc;
        if (old + 1u == (gen + 1u) * nloc) {
            __builtin_amdgcn_fence(__ATOMIC_RELEASE, "agent");
            asm volatile("s_waitcnt vmcnt(0)" ::: "memory");
            const unsigned og = xb_add(&bar[XB_TOP], 1u);
            const unsigned tg = og / nx;
            if (og + 1u == (tg + 1u) * nx) xb_add(&bar[XB_TOPGEN], 1u);
            else XB_SPIN(xb_ld(&bar[XB_TOPGEN]) == tg, bar);
            __builtin_amdgcn_fence(__ATOMIC_ACQUIRE, "agent");
            xb_add(&bar[XB_XGEN(b.x)], 1u);
            asm volatile("s_waitcnt vmcnt(0)" ::: "memory");
        } else {
            XB_SPIN(xb_ld(&bar[XB_XGEN(b.x)]) == gen, bar);
            __builtin_amdgcn_fence(__ATOMIC_ACQUIRE, "agent");
            asm volatile("s_waitcnt vmcnt(0)" ::: "memory");
        }
    }
    __syncthreads();
}

namespace pg8 {
constexpr int BM = 256, BK = 64, HALF = 128, HTB = HALF * BK * 2, STAGE_BYTES = 8 * HTB;
__device__ __forceinline__ int lds_byte(int r, int c) { const int st = (r >> 4) * 2 + (c >> 5), rr = r & 15, cc = c & 31, ob = rr * 64 + cc * 2; return st * 1024 + (ob ^ (((ob >> 9) & 1) << 5)); }
__device__ __forceinline__ void stage_rc(int b, int& R, int& C) { const int st = b / 1024, sb = b % 1024, swz = sb ^ (((sb >> 9) & 1) << 5); R = (st >> 1) * 16 + swz / 64; C = (st & 1) * 32 + (swz % 64) / 2; }
__device__ __forceinline__ int perm32(int rho) { const int n = rho >> 4, i = rho & 15; return 8 * (i >> 2) + 4 * n + (i & 3); }
struct Unit { int pm, pn; const char* a; const char* b; };
__device__ __forceinline__ unsigned cvt_pk_bf16(float lo, float hi) { unsigned r; asm volatile("v_cvt_pk_bf16_f32 %0, %1, %2" : "=v"(r) : "v"(lo), "v"(hi)); return r; }

template <class Epi, class Sched>
__device__ __forceinline__ void gemm_phase(LAS unsigned char* lds, const int tid, const int K, const int lda, const int ldb, const Sched& S, const Epi& E) {
    const int wid = __builtin_amdgcn_readfirstlane(tid >> 6), lane = tid & 63, wr = wid >> 2, wc = wid & 3, fr = lane & 15, fq = lane >> 4;
    int Kq = K; asm volatile("" : "+s"(Kq));
    const int nt = Kq / BK;
    unsigned voffA[2], voffB[2];
#pragma unroll
    for (int i = 0; i < 2; ++i) { int R, C; stage_rc(tid * 16 + i * 8192, R, C); const int Rb = Epi::PERM ? ((R & ~31) + perm32(R & 31)) : R;
        voffA[i] = (unsigned)(R * lda + C) * 2u; voffB[i] = (unsigned)(Rb * ldb + C) * 2u; }
    const size_t kstep = (size_t)(BK * 2);
    const size_t hstepA = (size_t)HALF * lda * 2, hstepB = (size_t)HALF * ldb * 2;
    const unsigned ldsw = (unsigned)wid * 1024u;
    const int aoff = lds_byte(wr * 64 + fr, fq * 8), boff = lds_byte(wc * 32 + fr, fq * 8);
#define PG8_SA(b, h) (((b) * 2 + (h)) * HTB)
#define PG8_SB(b, h) ((4 + (b) * 2 + (h)) * HTB)
#define PG8_STAGE(bufoff, gbase, voff) do { _Pragma("unroll") for (int _i = 0; _i < 2; ++_i) \
        __builtin_amdgcn_global_load_lds((const unsigned*)((const char*)(gbase) + (voff)[_i]), (LAS unsigned*)(lds + (bufoff) + ldsw + _i * 8192), 16, 0, 0); } while (0)
#define PG8_LDA(dst, b, h) do { _Pragma("unroll") for (int m = 0; m < 4; ++m) _Pragma("unroll") for (int k = 0; k < 2; ++k) dst[m][k] = *(const LAS bf16x8*)(lds + PG8_SA(b, h) + aoff + m * 2048 + k * 1024); } while (0)
#define PG8_LDB(dst, b, h) do { _Pragma("unroll") for (int n = 0; n < 2; ++n) _Pragma("unroll") for (int k = 0; k < 2; ++k) dst[n][k] = *(const LAS bf16x8*)(lds + PG8_SB(b, h) + boff + n * 2048 + k * 1024); } while (0)
#define PG8_MMA(ai, bj, At, Bt) do { __builtin_amdgcn_s_setprio(1); _Pragma("unroll") for (int m = 0; m < 4; ++m) _Pragma("unroll") for (int n = 0; n < 2; ++n) _Pragma("unroll") for (int k = 0; k < 2; ++k) \
        acc[ai][bj][m][n] = __builtin_amdgcn_mfma_f32_16x16x32_bf16(Bt[n][k], At[m][k], acc[ai][bj][m][n], 0, 0, 0); __builtin_amdgcn_s_setprio(0); } while (0)
#define PG8_WAIT_V(n) asm volatile("s_waitcnt vmcnt(" #n ")" ::: "memory")
#define PG8_WAIT_L(n) asm volatile("s_waitcnt lgkmcnt(" #n ")" ::: "memory")
#define PG8_BAR __builtin_amdgcn_s_barrier()
#define PG8_SCHED __builtin_amdgcn_sched_barrier(0)
    Unit cur, nxt; int ui = 0;
    if (!S.next(0, cur)) return;
    f32x4 acc[2][2][4][2];
#pragma unroll
    for (int a = 0; a < 2; ++a)
#pragma unroll
        for (int b = 0; b < 2; ++b)
#pragma unroll
            for (int m = 0; m < 4; ++m)
#pragma unroll
                for (int n = 0; n < 2; ++n) acc[a][b][m][n] = (f32x4){0.f, 0.f, 0.f, 0.f};
    bf16x8 At[4][2], B0[2][2], B1[2][2];
    const char* cA = cur.a; const char* cB = cur.b;
    PG8_STAGE(PG8_SB(0, 0), cB, voffB); PG8_STAGE(PG8_SB(0, 1), cB + hstepB, voffB); PG8_STAGE(PG8_SA(0, 0), cA, voffA); PG8_STAGE(PG8_SA(0, 1), cA + hstepA, voffA);
    if (wr == 1) PG8_BAR;
    PG8_WAIT_V(2); PG8_BAR;
    PG8_STAGE(PG8_SB(1, 0), cB + kstep, voffB); PG8_STAGE(PG8_SA(1, 0), cA + kstep, voffA); PG8_STAGE(PG8_SB(1, 1), cB + hstepB + kstep, voffB);
    PG8_WAIT_V(6); PG8_BAR;
    for (;;) {
        const bool has_next = S.next(ui + 1, nxt);
        const char* nA = has_next ? nxt.a : cA; const char* nB = has_next ? nxt.b : cB;
#pragma clang loop unroll(disable)
        for (int t = 0; t < nt; t += 2) {
            const bool last = (t == nt - 2);
            const char* a1 = cA + (size_t)(t + 1) * kstep;
            const char* a2 = last ? nA : cA + (size_t)(t + 2) * kstep; const char* b2 = last ? nB : cB + (size_t)(t + 2) * kstep;
            const char* a3 = a2 + kstep; const char* b3 = b2 + kstep;
            PG8_LDB(B0, 0, 0); PG8_LDB(B1, 0, 1); PG8_SCHED; PG8_LDA(At, 0, 0); PG8_STAGE(PG8_SA(1, 1), a1 + hstepA, voffA);
            PG8_WAIT_V(8); PG8_WAIT_L(0); PG8_BAR; PG8_MMA(0, 0, At, B0); PG8_MMA(0, 1, At, B1); PG8_BAR; PG8_SCHED;
            PG8_LDA(At, 0, 1); PG8_STAGE(PG8_SB(0, 0), b2, voffB); PG8_STAGE(PG8_SB(0, 1), b2 + hstepB, voffB); PG8_STAGE(PG8_SA(0, 0), a2, voffA);
            PG8_WAIT_V(8); PG8_WAIT_L(0); PG8_BAR; PG8_MMA(1, 0, At, B0); PG8_MMA(1, 1, At, B1); PG8_BAR; PG8_SCHED;
            PG8_LDB(B0, 1, 0); PG8_LDB(B1, 1, 1); PG8_SCHED; PG8_LDA(At, 1, 0); PG8_STAGE(PG8_SA(0, 1), a2 + hstepA, voffA);
            PG8_WAIT_V(8); PG8_WAIT_L(0); PG8_BAR; PG8_MMA(0, 0, At, B0); PG8_MMA(0, 1, At, B1); PG8_BAR; PG8_SCHED;
            PG8_LDA(At, 1, 1); PG8_STAGE(PG8_SB(1, 0), b3, voffB); PG8_STAGE(PG8_SB(1, 1), b3 + hstepB, voffB); PG8_STAGE(PG8_SA(1, 0), a3, voffA);
            PG8_WAIT_V(8); PG8_WAIT_L(0); PG8_BAR; PG8_MMA(1, 0, At, B0); PG8_MMA(1, 1, At, B1); PG8_BAR; PG8_SCHED;
        }
        if (wr == 0) PG8_BAR;
        { int te = tid; asm volatile("" : "+v"(te));
          const int we = __builtin_amdgcn_readfirstlane(te >> 6), le = te & 63;
          E(acc, cur, we >> 2, we & 3, le & 15, le >> 4); }
        if (!has_next) break;
#pragma unroll
        for (int a = 0; a < 2; ++a)
#pragma unroll
            for (int b = 0; b < 2; ++b)
#pragma unroll
                for (int m = 0; m < 4; ++m)
#pragma unroll
                    for (int n = 0; n < 2; ++n) acc[a][b][m][n] = (f32x4){0.f, 0.f, 0.f, 0.f};
        cur = nxt; cA = nA; cB = nB; ++ui;
        if (wr == 1) PG8_BAR;
    }
    PG8_WAIT_V(0);
    PG8_BAR;
#undef PG8_SA
#undef PG8_SB
#undef PG8_STAGE
#undef PG8_LDA
#undef PG8_LDB
#undef PG8_MMA
#undef PG8_WAIT_V
#undef PG8_WAIT_L
#undef PG8_BAR
#undef PG8_SCHED
}

struct GridOrder {
    int nM, nN, nwg, G, c, uneven;
    __device__ __forceinline__ void init(int nM_, int nN_, int G_, int c_) { nM = nM_; nN = nN_; nwg = nM * nN; G = G_; c = c_; uneven = 0; }
    __device__ __forceinline__ bool tile(int i, int& pm, int& pn) const {
        long L = (long)i * G + c;
        if (uneven) {
            if (c < 128) { if (i >= 2) return false; L = i * 128 + c; } else { if (i >= 4) return false; L = 256 + (c - 128) + 128 * i; } }
        if (L >= nwg) return false;
        int wgid = (int)L; { const int q = nwg / 8, r = nwg % 8, xcd = wgid % 8, off = wgid / 8; wgid = (xcd < r ? xcd * (q + 1) : r * (q + 1) + (xcd - r) * q) + off; }
        const int nig = 8 * nN, gid = wgid / nig, fm = gid * 8, gsz = (nM - fm) < 8 ? (nM - fm) : 8;
        pm = fm + ((wgid % nig) % gsz); pn = (wgid % nig) / gsz; return true;
    }
};
}

__device__ __forceinline__ int uni(int v) { return __builtin_amdgcn_readfirstlane(v); }
__device__ __forceinline__ const char* uniptr(const char* p) { const unsigned long long v = (unsigned long long)p; const unsigned lo = __builtin_amdgcn_readfirstlane((unsigned)v), hi = __builtin_amdgcn_readfirstlane((unsigned)(v >> 32)); return (const char*)(((unsigned long long)hi << 32) | lo); }
struct DenseSched {
    pg8::GridOrder o; const char* A; size_t a_sel_stride; int pn_per_a; const char* B; size_t tstepA, tstepB;
    __device__ __forceinline__ bool next(int i, pg8::Unit& u) const {
        if (!o.tile(i, u.pm, u.pn)) return false;
        u.pm = uni(u.pm); u.pn = uni(u.pn);
        u.a = uniptr(A + (size_t)(u.pn / pn_per_a) * a_sel_stride + (size_t)u.pm * tstepA); u.b = uniptr(B + (size_t)u.pn * tstepB); return true;
    }
};
struct MoeSched {
    const int* tileE; int ntiles, npn, G, c; const char* A; const char* B; size_t tstepA, tstepB, estride;
    __device__ __forceinline__ bool next(int i, pg8::Unit& u) const {
        const int L = i * G + c; if (L >= ntiles * npn) return false;
        u.pm = uni(L / npn); u.pn = uni(L % npn);
        const int e = __builtin_amdgcn_readfirstlane(tileE[u.pm]);
        u.a = uniptr(A + (size_t)u.pm * tstepA); u.b = uniptr(B + (size_t)e * estride + (size_t)u.pn * tstepB); return true;
    }
};

using pg8::Unit; using pg8::cvt_pk_bf16;
__device__ __forceinline__ void st8(bf16* p, const f32x4& v0, const f32x4& v1) {
    u32x4 w; w.x = cvt_pk_bf16(v0[0], v0[1]); w.y = cvt_pk_bf16(v0[2], v0[3]); w.z = cvt_pk_bf16(v1[0], v1[1]); w.w = cvt_pk_bf16(v1[2], v1[3]);
    *(u32x4*)p = w;
}
struct EpiSplit {
    static constexpr bool PERM = true;
    bf16* O; size_t split_stride; float scale;
    __device__ __forceinline__ void operator()(const f32x4 (&acc)[2][2][4][2], const Unit& u, int wr, int wc, int fr, int fq) const {
        const int row0 = u.pm * 256 + wr * 64 + fr; const int colt = u.pn * 256; const int t = colt >> 10;
        bf16* base = O + (size_t)t * split_stride; const int col0 = (colt & 1023) + wc * 32 + 8 * fq;
#pragma unroll
        for (int ai = 0; ai < 2; ++ai)
#pragma unroll
            for (int m = 0; m < 4; ++m) { bf16* rowp = base + (size_t)(row0 + ai * 128 + m * 16) * 1024 + col0;
#pragma unroll
                for (int bj = 0; bj < 2; ++bj) st8(rowp + bj * 128, acc[ai][bj][m][0] * scale, acc[ai][bj][m][1] * scale); }
    }
};
struct EpiLoraDn {
    static constexpr bool PERM = true;
    bf16* O;
    __device__ __forceinline__ void operator()(const f32x4 (&acc)[2][2][4][2], const Unit& u, int wr, int wc, int fr, int fq) const {
        const int row0 = u.pm * 256 + wr * 64 + fr; const int col0 = u.pn * 256 + wc * 32 + 8 * fq;
#pragma unroll
        for (int ai = 0; ai < 2; ++ai)
#pragma unroll
            for (int m = 0; m < 4; ++m) { bf16* rowp = O + (size_t)(row0 + ai * 128 + m * 16) * 512 + col0;
#pragma unroll
                for (int bj = 0; bj < 2; ++bj) { f32x4 v0 = acc[ai][bj][m][0], v1 = acc[ai][bj][m][1];
                    const int mode = (u.pn == 1) ? 2 : bj;
                    if (mode == 0) {
#pragma unroll
                        for (int j = 0; j < 4; ++j) { v0[j] = tanhf(v0[j]); v1[j] = tanhf(v1[j]); } }
                    else if (mode == 2) {
#pragma unroll
                        for (int j = 0; j < 4; ++j) { v0[j] = sigmoidf_(v0[j]); v1[j] = sigmoidf_(v1[j]); } }
                    st8(rowp + bj * 128, v0, v1); } }
    }
};
struct EpiLoraUpWA {
    static constexpr bool PERM = true;
    bf16* LD; bf16* AS; const float* w0; const float* a0;
    __device__ __forceinline__ void operator()(const f32x4 (&acc)[2][2][4][2], const Unit& u, int wr, int wc, int fr, int fq) const {
        const int kind = u.pn >> 3, z = (u.pn >> 2) & 1;
        const int row0 = u.pm * 256 + wr * 64 + fr; const int col0 = (u.pn & 3) * 256 + wc * 32 + 8 * fq;
        bf16* base = (kind ? AS : LD) + (size_t)z * T * D; const float* bias = (kind ? a0 : w0) + z * 1024;
        f32x4 bv[2][2];
#pragma unroll
        for (int bj = 0; bj < 2; ++bj)
#pragma unroll
            for (int n = 0; n < 2; ++n) bv[bj][n] = *(const f32x4*)(bias + col0 + bj * 128 + 4 * n);
#pragma unroll
        for (int ai = 0; ai < 2; ++ai)
#pragma unroll
            for (int m = 0; m < 4; ++m) { bf16* rowp = base + (size_t)(row0 + ai * 128 + m * 16) * 1024 + col0;
#pragma unroll
                for (int bj = 0; bj < 2; ++bj) { f32x4 v[2];
#pragma unroll
                    for (int n = 0; n < 2; ++n) { v[n] = acc[ai][bj][m][n] + bv[bj][n];
#pragma unroll
                        for (int j = 0; j < 4; ++j) { const float x = v[n][j];
                            if (kind == 0) { const float zz = -x; const float sp = fmaxf(zz, 0.f) + __logf(1.f + __expf(-fabsf(zz))); v[n][j] = -__expf(-sp - 0.5f) * LOG2E; }
                            else v[n][j] = sigmoidf_(x); } }
                    st8(rowp + bj * 128, v[0], v[1]); } }
    }
};
struct EpiResid {
    static constexpr bool PERM = false;
    const float* xin; float* out; const float* gate;
    __device__ __forceinline__ void operator()(const f32x4 (&acc)[2][2][4][2], const Unit& u, int wr, int wc, int fr, int fq) const {
        const int row0 = u.pm * 256 + wr * 64 + fr, col0 = u.pn * 256 + wc * 32 + 4 * fq; const int b = u.pm >> 3;
        f32x4 gv[2][2];
#pragma unroll
        for (int bj = 0; bj < 2; ++bj)
#pragma unroll
            for (int n = 0; n < 2; ++n) gv[bj][n] = *(const f32x4*)(gate + (size_t)b * 6144 + col0 + bj * 128 + n * 16);
#pragma unroll
        for (int ai = 0; ai < 2; ++ai)
#pragma unroll
            for (int m = 0; m < 4; ++m) { const size_t off = (size_t)(row0 + ai * 128 + m * 16) * D + col0;
#pragma unroll
                for (int bj = 0; bj < 2; ++bj)
#pragma unroll
                    for (int n = 0; n < 2; ++n) { const f32x4 xv = *(const f32x4*)(xin + off + bj * 128 + n * 16);
                        *(f32x4*)(out + off + bj * 128 + n * 16) = xv + gv[bj][n] * acc[ai][bj][m][n]; } }
    }
};
struct EpiQKV {
    static constexpr bool PERM = true;
    bf16* Q; bf16* Kb; bf16* Vb; float qscale;
    __device__ __forceinline__ void operator()(const f32x4 (&acc)[2][2][4][2], const Unit& u, int wr, int wc, int fr, int fq) const {
        const int g = u.pn / 12, which = (u.pn % 12) >> 2, hp = u.pn & 3;
        const int row0 = u.pm * 256 + wr * 64 + fr;
        bf16* base = Q + (size_t)which * ((A_K - A_Q) / 2) + (size_t)g * T * D; const float sc = which ? 1.0f : qscale; const int col0 = hp * 256 + wc * 32 + 8 * fq;
#pragma unroll
        for (int ai = 0; ai < 2; ++ai)
#pragma unroll
            for (int m = 0; m < 4; ++m) { bf16* rowp = base + (size_t)(row0 + ai * 128 + m * 16) * 1024 + col0;
#pragma unroll
                for (int bj = 0; bj < 2; ++bj) st8(rowp + bj * 128, acc[ai][bj][m][0] * sc, acc[ai][bj][m][1] * sc); }
    }
};
struct EpiGateUp {
    static constexpr bool PERM = true;
    bf16* H; const float* roww;
    __device__ __forceinline__ void operator()(const f32x4 (&acc)[2][2][4][2], const Unit& u, int wr, int wc, int fr, int fq) const {
        const int row0 = u.pm * 256 + wr * 64 + fr; const int col0 = u.pn * 128 + wc * 32 + 8 * fq;
#pragma unroll
        for (int ai = 0; ai < 2; ++ai)
#pragma unroll
            for (int m = 0; m < 4; ++m) { const int row = row0 + ai * 128 + m * 16; const float rw = roww[row]; f32x4 v[2];
#pragma unroll
                for (int n = 0; n < 2; ++n)
#pragma unroll
                    for (int j = 0; j < 4; ++j) { const float gg = acc[ai][0][m][n][j], uu = acc[ai][1][m][n][j]; v[n][j] = gg * sigmoidf_(gg) * uu * rw; }
                st8(H + (size_t)row * FEXP + col0, v[0], v[1]); }
    }
};
struct EpiPlain {
    static constexpr bool PERM = true;
    bf16* O;
    __device__ __forceinline__ void operator()(const f32x4 (&acc)[2][2][4][2], const Unit& u, int wr, int wc, int fr, int fq) const {
        const int row0 = u.pm * 256 + wr * 64 + fr; const int col0 = u.pn * 256 + wc * 32 + 8 * fq;
#pragma unroll
        for (int ai = 0; ai < 2; ++ai)
#pragma unroll
            for (int m = 0; m < 4; ++m) { bf16* rowp = O + (size_t)(row0 + ai * 128 + m * 16) * 1024 + col0;
#pragma unroll
                for (int bj = 0; bj < 2; ++bj) st8(rowp + bj * 128, acc[ai][bj][m][0], acc[ai][bj][m][1]); }
    }
};

struct Args {
    const float* in[32]; float* out; unsigned char* ws; int ph_lo, ph_hi;
};
enum { I_X = 0, I_C, I_ADAW, I_ADAB, I_NTM, I_NCM, I_MU, I_WRKV, I_W0, I_W1, I_W2, I_A0, I_A1, I_A2, I_G1, I_G2, I_KK, I_KA, I_RK, I_LNW, I_LNB, I_RWO,
       I_AQKV, I_AWO, I_RG, I_RGB, I_RE, I_REB, I_WG, I_WU, I_WD, I_FG };

struct Frame {
    LAS unsigned char* lds; int tid, lane, wave, G, gw, NGW;
    unsigned char* ws; const float* const* in; float* out;
};

__device__ __forceinline__ void row_load(const float* p, int lane, f32x4 (&v)[4]) {
#pragma unroll
    for (int j = 0; j < 4; ++j) v[j] = *(const f32x4*)(p + 4 * lane + 256 * j);
}
__device__ __forceinline__ void row_store(float* p, int lane, const f32x4 (&v)[4]) {
#pragma unroll
    for (int j = 0; j < 4; ++j) *(f32x4*)(p + 4 * lane + 256 * j) = v[j];
}
__device__ __forceinline__ void row_store_bf16(bf16* p, int lane, const f32x4 (&v)[4]) {
#pragma unroll
    for (int j = 0; j < 4; ++j) { u32x2 w; w.x = pk2(v[j][0], v[j][1]); w.y = pk2(v[j][2], v[j][3]); *(u32x2*)(p + 4 * lane + 256 * j) = w; }
}
__device__ __forceinline__ void row_combine(f32x4 (&v)[4], const bf16* ys, const int* tokp, int row, const float* gac, int lane) {
    const int p0 = tokp[2 * row], p1 = tokp[2 * row + 1];
    const bf16* y0 = ys + (size_t)p0 * D; const bf16* y1 = ys + (size_t)p1 * D;
#pragma unroll
    for (int j = 0; j < 4; ++j) { const u32x2 a = *(const u32x2*)(y0 + 4 * lane + 256 * j), b = *(const u32x2*)(y1 + 4 * lane + 256 * j); const f32x4 g = *(const f32x4*)(gac + 4 * lane + 256 * j);
        v[j][0] += g[0] * (bf_lo(a.x) + bf_lo(b.x)); v[j][1] += g[1] * (bf_hi(a.x) + bf_hi(b.x)); v[j][2] += g[2] * (bf_lo(a.y) + bf_lo(b.y)); v[j][3] += g[3] * (bf_hi(a.y) + bf_hi(b.y)); }
}
__device__ __forceinline__ void row_norm_mod(const f32x4 (&x)[4], const float* gain, const float* sc, const float* sh, int lane, f32x4 (&h)[4]) {
    float s = 0.f;
#pragma unroll
    for (int j = 0; j < 4; ++j) s += (x[j][0] * x[j][0] + x[j][1] * x[j][1]) + (x[j][2] * x[j][2] + x[j][3] * x[j][3]);
    const float rstd = rsqrtf(wave_sum(s, lane) * (1.0f / D) + RMS_EPS);
#pragma unroll
    for (int j = 0; j < 4; ++j) { const f32x4 g = *(const f32x4*)(gain + 4 * lane + 256 * j), c = *(const f32x4*)(sc + 4 * lane + 256 * j), b = *(const f32x4*)(sh + 4 * lane + 256 * j);
        h[j] = x[j] * rstd * g * (1.0f + c) + b; }
}
__device__ __forceinline__ void transpose_item(const float* W, int ldw, bf16* dst, int ldd, LAS float* scr, int lane) {
    { const int r8 = lane >> 3, c4 = (lane & 7) * 4;
      f32x4 v[8];
#pragma unroll
      for (int i = 0; i < 8; ++i) v[i] = *(const f32x4*)(W + (size_t)(8 * i + r8) * ldw + c4);
#pragma unroll
      for (int i = 0; i < 8; ++i) { LAS float* p = scr + (8 * i + r8) * 33 + c4; p[0] = v[i][0]; p[1] = v[i][1]; p[2] = v[i][2]; p[3] = v[i][3]; } }
    LDS_WAIT(); asm volatile("" ::: "memory");
    const int c = lane & 7;
#pragma unroll
    for (int j = 0; j < 4; ++j) { const int n = (lane >> 3) + 8 * j; const LAS float* s = scr + (8 * c) * 33 + n;
        u32x4 o; o.x = pk2(s[0 * 33], s[1 * 33]); o.y = pk2(s[2 * 33], s[3 * 33]); o.z = pk2(s[4 * 33], s[5 * 33]); o.w = pk2(s[6 * 33], s[7 * 33]);
        *(u32x4*)(dst + (size_t)n * ldd + 8 * c) = o; }
    LDS_WAIT(); asm volatile("" ::: "memory");
}

__device__ __forceinline__ void phase_prologue(Frame& F) {
    const float* c = F.in[I_C]; const float* adaw = F.in[I_ADAW]; const float* adab = F.in[I_ADAB];
    float* mod = (float*)(F.ws + WS_MOD);
    LAS float* sc = (LAS float*)F.lds;
    LAS float* part = (LAS float*)(F.lds + 32768);
    for (int i = F.tid; i < NB * D; i += NTHREADS) { const float v = c[i]; sc[i] = v / (1.0f + __expf(-v)); }
    __syncthreads();
    for (int u = blockIdx.x; u < DEPTH * 96; u += F.G) {
        const int l = u / 96, n0 = (u % 96) * 64, col = n0 + F.lane;
        const float* W = adaw + (size_t)l * D * 6144 + col;
        float acc[8];
#pragma unroll
        for (int b = 0; b < 8; ++b) acc[b] = 0.f;
        const int kbeg = F.wave * 128;
#pragma unroll 8
        for (int k = kbeg; k < kbeg + 128; ++k) { const float w = W[(size_t)k * 6144];
#pragma unroll
            for (int b = 0; b < 8; ++b) acc[b] += sc[b * D + k] * w; }
#pragma unroll
        for (int b = 0; b < 8; ++b) part[(F.wave * 8 + b) * 64 + F.lane] = acc[b];
        __syncthreads();
        { const int b = F.tid >> 6; float s = adab[l * 6144 + col];
#pragma unroll
          for (int w = 0; w < 8; ++w) s += part[(w * 8 + b) * 64 + F.lane];
          mod[(size_t)(l * 8 + b) * 6144 + col] = s; }
        __syncthreads();
    }
    LAS float* scr = (LAS float*)(F.lds + 49152 + F.wave * 8704);
    constexpr int I_SQ = 16 * 32;
    constexpr int I_QKV = 16 * 288;
    constexpr int PER_RW = 4 * I_SQ, PER_AT = I_QKV + I_SQ, NIT = 2 * PER_RW + 2 * PER_AT;
    for (int it = F.gw; it < NIT; it += F.NGW) {
        int r = it;
        if (r < 2 * PER_RW) { const int j = r / PER_RW; r %= PER_RW; const int mi = r / I_SQ; r %= I_SQ; const int kb = r / 32, nb = r % 32;
            if (mi < 3) transpose_item(F.in[I_WRKV] + ((size_t)(j * 3 + mi) * D + kb * 64) * D + nb * 32, D, (bf16*)(F.ws + WS_W + j * W_RW_STRIDE + W_RKV) + (size_t)(mi * D + nb * 32) * D + kb * 64, D, scr, F.lane);
            else transpose_item(F.in[I_RWO] + ((size_t)j * D + kb * 64) * D + nb * 32, D, (bf16*)(F.ws + WS_W + j * W_RW_STRIDE + W_RWO) + (size_t)(nb * 32) * D + kb * 64, D, scr, F.lane);
        } else { r -= 2 * PER_RW; const int j = r / PER_AT; r %= PER_AT;
            if (r < I_QKV) { const int kb = r / 288, nb = r % 288;
                transpose_item(F.in[I_AQKV] + ((size_t)j * D + kb * 64) * QKVW + nb * 32, QKVW, (bf16*)(F.ws + WS_WA + j * W_AT_STRIDE + W_QKV) + (size_t)(nb * 32) * D + kb * 64, D, scr, F.lane); }
            else { r -= I_QKV; const int kb = r / 32, nb = r % 32;
                transpose_item(F.in[I_AWO] + ((size_t)j * D + kb * 64) * D + nb * 32, D, (bf16*)(F.ws + WS_WA + j * W_AT_STRIDE + W_AWO) + (size_t)(nb * 32) * D + kb * 64, D, scr, F.lane); }
        }
    }
    const int gt = blockIdx.x * NTHREADS + F.tid, NGT = F.G * NTHREADS;
    for (int j = 0; j < 2; ++j) {
        bf16* ldn = (bf16*)(F.ws + WS_W + j * W_RW_STRIDE + W_LDN);
        const float* mu = F.in[I_MU] + (size_t)j * 6 * D;
        for (int i = gt; i < 512 * 2048; i += NGT) { const int n = i >> 11, k = i & 2047, kk = k & 1023;
            float v; int mi;
            if (n < 128) { const int z = n >> 6, nn = n & 63; v = F.in[I_W1][((size_t)(j * 2 + z) * D + kk) * 64 + nn]; mi = 3; }
            else if (n < 256) { const int z = (n - 128) >> 6, nn = n & 63; v = F.in[I_A1][((size_t)(j * 2 + z) * D + kk) * 64 + nn]; mi = 4; }
            else { const int z = (n - 256) >> 7, nn = n & 127; v = F.in[I_G1][((size_t)(j * 2 + z) * D + kk) * 128 + nn]; mi = 5; }
            if (k >= 1024) v *= mu[mi * D + kk];
            ldn[i] = (bf16)f2bf(v); }
        bf16* lwa = (bf16*)(F.ws + WS_W + j * W_RW_STRIDE + W_LUPWA);
        for (int i = gt; i < 4096 * 256; i += NGT) { const int n = i >> 8, k = i & 255; const int kind = n >> 11, z = (n >> 10) & 1, col = n & 1023;
            float v = 0.f;
            if ((k >> 6) == kind * 2 + z) v = (kind ? F.in[I_A2] : F.in[I_W2])[((size_t)(j * 2 + z) * 64 + (k & 63)) * D + col];
            lwa[i] = (bf16)f2bf(v); }
        bf16* lg = (bf16*)(F.ws + WS_W + j * W_RW_STRIDE + W_LUPG);
        for (int i = gt; i < 2048 * 256; i += NGT) { const int n = i >> 8, k = i & 255; const int z = n >> 10, col = n & 1023;
            float v = 0.f;
            if ((k >> 7) == z) v = F.in[I_G2][((size_t)(j * 2 + z) * 128 + (k & 127)) * D + col];
            lg[i] = (bf16)f2bf(v); }
    }
}

__device__ __forceinline__ void rw_hrow(Frame& F, int l, bool combine, const float* xsrc, float* xdst, bool own, int row, f32x4 (&h)[4]) {
    const int b = row >> 11; const float* mod = (const float*)(F.ws + WS_MOD);
    f32x4 x[4]; row_load(xsrc + (size_t)row * D, F.lane, x);
    if (combine) { row_combine(x, (const bf16*)(F.ws + WS_ACT + A_YS), (const int*)(F.ws + WS_TOKP), row, mod + (size_t)((l - 1) * 8 + b) * 6144 + 5 * D, F.lane);
        if (own) row_store(xdst + (size_t)row * D, F.lane, x); }
    const float* mp = mod + (size_t)(l * 8 + b) * 6144;
    row_norm_mod(x, F.in[I_NTM] + l * D, mp + 1 * D, mp + 0 * D, F.lane, h);
}
__device__ __forceinline__ void phase_rw_norm(Frame& F, int l, bool combine, const float* xsrc, float* xdst) {
    const int j = l >> 1; const float* mu = F.in[I_MU] + (size_t)j * 6 * D;
    bf16* xs = (bf16*)(F.ws + WS_ACT + A_XS); bf16* hx = (bf16*)(F.ws + WS_ACT + A_HX);
    for (int ch = F.gw; ch < T / 8; ch += F.NGW) {
        const int row0 = ch * 8, t0 = row0 & (SEQ - 1);
        f32x4 prev[4], cur[4], nxt[4];
        if (t0 > 0) rw_hrow(F, l, combine, xsrc, xdst, false, row0 - 1, prev);
        else {
#pragma unroll
            for (int q = 0; q < 4; ++q) prev[q] = (f32x4){0.f, 0.f, 0.f, 0.f}; }
        rw_hrow(F, l, combine, xsrc, xdst, true, row0, cur);
        for (int i = 0; i < 8; ++i) {
            const int row = row0 + i;
            if (t0 + i + 1 < SEQ) rw_hrow(F, l, combine, xsrc, xdst, i < 7, row + 1, nxt);
            else {
#pragma unroll
                for (int q = 0; q < 4; ++q) nxt[q] = (f32x4){0.f, 0.f, 0.f, 0.f}; }
            f32x4 xx[4];
#pragma unroll
            for (int q = 0; q < 4; ++q) xx[q] = 0.5f * (prev[q] + nxt[q]) - cur[q];
#pragma unroll
            for (int mi = 0; mi < 3; ++mi) { f32x4 o[4];
#pragma unroll
                for (int q = 0; q < 4; ++q) { const f32x4 m = *(const f32x4*)(mu + mi * D + 4 * F.lane + 256 * q); o[q] = cur[q] + xx[q] * m; }
                row_store_bf16(xs + ((size_t)mi * T + row) * D, F.lane, o); }
            row_store_bf16(hx + (size_t)row * 2048, F.lane, cur);
            row_store_bf16(hx + (size_t)row * 2048 + D, F.lane, xx);
#pragma unroll
            for (int q = 0; q < 4; ++q) { prev[q] = cur[q]; cur[q] = nxt[q]; }
        }
    }
}

__device__ __forceinline__ void phase_at_norm(Frame& F, int l, const float* xsrc, float* xdst) {
    const float* mod = (const float*)(F.ws + WS_MOD); bf16* H = (bf16*)(F.ws + WS_ACT + A_H);
    for (int row = F.gw; row < T; row += F.NGW) {
        const int b = row >> 11; f32x4 x[4], h[4]; row_load(xsrc + (size_t)row * D, F.lane, x);
        row_combine(x, (const bf16*)(F.ws + WS_ACT + A_YS), (const int*)(F.ws + WS_TOKP), row, mod + (size_t)((l - 1) * 8 + b) * 6144 + 5 * D, F.lane);
        row_store(xdst + (size_t)row * D, F.lane, x);
        const float* mp = mod + (size_t)(l * 8 + b) * 6144;
        row_norm_mod(x, F.in[I_NTM] + l * D, mp + 1 * D, mp + 0 * D, F.lane, h);
        row_store_bf16(H + (size_t)row * D, F.lane, h);
    }
}
__device__ __forceinline__ void phase_final(Frame& F, const float* xsrc) {
    const float* mod = (const float*)(F.ws + WS_MOD); const float* fg = F.in[I_FG];
    for (int row = F.gw; row < T; row += F.NGW) {
        const int b = row >> 11; f32x4 x[4]; row_load(xsrc + (size_t)row * D, F.lane, x);
        row_combine(x, (const bf16*)(F.ws + WS_ACT + A_YS), (const int*)(F.ws + WS_TOKP), row, mod + (size_t)(3 * 8 + b) * 6144 + 5 * D, F.lane);
        float s = 0.f;
#pragma unroll
        for (int j = 0; j < 4; ++j) s += (x[j][0] * x[j][0] + x[j][1] * x[j][1]) + (x[j][2] * x[j][2] + x[j][3] * x[j][3]);
        const float rstd = rsqrtf(wave_sum(s, F.lane) * (1.0f / D) + RMS_EPS);
#pragma unroll
        for (int j = 0; j < 4; ++j) { const f32x4 g = *(const f32x4*)(fg + 4 * F.lane + 256 * j); x[j] = x[j] * rstd * g; }
        row_store(F.out + (size_t)row * D, F.lane, x);
    }
}

__device__ __forceinline__ void phase_moe_route(Frame& F, int l, const float* xsrc, int cnt_shift = 0) {
    const float* mod = (const float*)(F.ws + WS_MOD); bf16* HN = (bf16*)(F.ws + WS_ACT + A_HN2);
    LAS int* lcnt = (LAS int*)F.lds; LAS int* gbase = lcnt + 32; LAS int* inf_e = lcnt + 64; LAS int* inf_r = inf_e + 128; LAS float* inf_w = (LAS float*)(inf_r + 128);
    unsigned* cnt = (unsigned*)(F.ws + WS_CTL) + CW_CNT + (l + cnt_shift) * 32;
    int* toke = (int*)(F.ws + WS_TOKE); int* tokr = (int*)(F.ws + WS_TOKR); float* tokw = (float*)(F.ws + WS_TOKW);
    const float* rg = F.in[I_RG] + (size_t)l * D * 4; const float* rgb = F.in[I_RGB] + l * 4;
    LAS float* RW = (LAS float*)(F.lds + 4096);
    for (int i = F.tid; i < D * 4; i += NTHREADS) RW[(i & 3) * D + (i >> 2)] = rg[i];
    { const float* rea = F.in[I_RE] + (size_t)l * 4 * D * 8;
      for (int i = F.tid; i < 4 * D * 8; i += NTHREADS) RW[(4 + (i >> 13) * 8 + (i & 7)) * D + ((i >> 3) & 1023)] = rea[i]; }
    for (int cb = blockIdx.x; cb < T / 64; cb += F.G) {
        if (F.tid < 32) lcnt[F.tid] = 0;
        __syncthreads();
        for (int i = 0; i < 8; ++i) {
            const int lr = F.wave * 8 + i, row = cb * 64 + lr, b = row >> 11;
            f32x4 x[4], h[4]; row_load(xsrc + (size_t)row * D, F.lane, x);
            const float* mp = mod + (size_t)(l * 8 + b) * 6144;
            row_norm_mod(x, F.in[I_NCM] + l * D, mp + 4 * D, mp + 3 * D, F.lane, h);
            row_store_bf16(HN + (size_t)row * D, F.lane, h);
            float gl[4] = {0.f, 0.f, 0.f, 0.f};
#pragma unroll
            for (int e = 0; e < 4; ++e)
#pragma unroll
                for (int j = 0; j < 4; ++j) { const f32x4 w = *(const LAS f32x4*)(RW + e * D + 4 * F.lane + 256 * j); gl[e] += (h[j][0] * w[0] + h[j][1] * w[1]) + (h[j][2] * w[2] + h[j][3] * w[3]); }
#pragma unroll
            for (int e = 0; e < 4; ++e) gl[e] = wave_sum(gl[e], F.lane) + rgb[e];
            const float gm = fmaxf(fmaxf(gl[0], gl[1]), fmaxf(gl[2], gl[3]));
            const int gtop = (gl[0] == gm) ? 0 : (gl[1] == gm) ? 1 : (gl[2] == gm) ? 2 : 3;
            const float pg = 1.0f / (__expf(gl[0] - gm) + __expf(gl[1] - gm) + __expf(gl[2] - gm) + __expf(gl[3] - gm));
            const float* reb = F.in[I_REB] + (l * 4 + gtop) * 8; const LAS float* rwe = RW + (4 + gtop * 8) * D + 4 * F.lane;
            float el[8];
#pragma unroll
            for (int e = 0; e < 8; ++e) { el[e] = 0.f;
#pragma unroll
                for (int j = 0; j < 4; ++j) { const f32x4 w = *(const LAS f32x4*)(rwe + e * D + 256 * j); el[e] += (h[j][0] * w[0] + h[j][1] * w[1]) + (h[j][2] * w[2] + h[j][3] * w[3]); } }
#pragma unroll
            for (int e = 0; e < 8; ++e) el[e] = wave_sum(el[e], F.lane) + reb[e];
            float v0 = el[0]; int i0 = 0;
#pragma unroll
            for (int e = 1; e < 8; ++e) if (el[e] > v0) { v0 = el[e]; i0 = e; }
            float v1 = -3.0e38f; int i1 = 0;
#pragma unroll
            for (int e = 0; e < 8; ++e) if (e != i0 && el[e] > v1) { v1 = el[e]; i1 = e; }
            const float ex = __expf(v1 - v0); const float w0 = pg / (1.0f + ex), w1 = pg * ex / (1.0f + ex);
            if (F.lane == 0) {
                const int e0 = gtop * 8 + i0, e1 = gtop * 8 + i1;
                const int r0 = __hip_atomic_fetch_add(lcnt + e0, 1, __ATOMIC_RELAXED, __HIP_MEMORY_SCOPE_WORKGROUP);
                const int r1 = __hip_atomic_fetch_add(lcnt + e1, 1, __ATOMIC_RELAXED, __HIP_MEMORY_SCOPE_WORKGROUP);
                inf_e[lr * 2] = e0; inf_e[lr * 2 + 1] = e1; inf_r[lr * 2] = r0; inf_r[lr * 2 + 1] = r1; inf_w[lr * 2] = w0; inf_w[lr * 2 + 1] = w1;
            }
        }
        __syncthreads();
        if (F.tid < 32) gbase[F.tid] = (int)__hip_atomic_fetch_add(cnt + F.tid, (unsigned)lcnt[F.tid], __ATOMIC_RELAXED, __HIP_MEMORY_SCOPE_AGENT);
        __syncthreads();
        if (F.tid < 128) { const int idx = cb * 128 + F.tid; const int e = inf_e[F.tid]; toke[idx] = e; tokr[idx] = gbase[e] + inf_r[F.tid]; tokw[idx] = inf_w[F.tid]; }
        __syncthreads();
    }
}
__device__ __forceinline__ void moe_tables(Frame& F, int l) {
    LAS int* tileE = (LAS int*)(F.lds + TILEE_OFF); LAS int* offs = (LAS int*)(F.lds + OFFS_OFF);
    const unsigned* cnt = (const unsigned*)(F.ws + WS_CTL) + CW_CNT + l * 32;
    if (F.tid == 0) { int o = 0, nt = 0;
#pragma clang loop unroll(disable)
        for (int e = 0; e < 32; ++e) { const int c = (int)__hip_atomic_load(cnt + e, __ATOMIC_RELAXED, __HIP_MEMORY_SCOPE_AGENT); offs[e] = o; const int ne = (c + 255) >> 8;
#pragma clang loop unroll(disable)
            for (int k = 0; k < ne && nt < 160; ++k) tileE[nt++] = e;
            o += ne * 256; }
        tileE[160] = nt; offs[32] = o; }
    __syncthreads();
}
__device__ __forceinline__ void phase_moe_gather(Frame& F, int l) {
    moe_tables(F, l);
    const LAS int* offs = (const LAS int*)(F.lds + OFFS_OFF);
    if (blockIdx.x == 0 && F.tid < 161) ((int*)(F.ws + WS_TILEE))[F.tid] = ((const LAS int*)(F.lds + TILEE_OFF))[F.tid];
    const int* toke = (const int*)(F.ws + WS_TOKE); const int* tokr = (const int*)(F.ws + WS_TOKR); const float* tokw = (const float*)(F.ws + WS_TOKW);
    int* tokp = (int*)(F.ws + WS_TOKP); float* roww = (float*)(F.ws + WS_ROWW);
    const bf16* HN = (const bf16*)(F.ws + WS_ACT + A_HN2); bf16* AS = (bf16*)(F.ws + WS_ACT + A_ASORT);
    for (int idx = F.gw; idx < 2 * T; idx += F.NGW) {
        const int e = toke[idx]; const int pos = offs[e] + tokr[idx];
        if (F.lane == 0) { tokp[idx] = pos; roww[pos] = tokw[idx]; }
        const bf16* src = HN + (size_t)(idx >> 1) * D; bf16* dst = AS + (size_t)pos * D;
        const u32x4 a = *(const u32x4*)(src + 8 * F.lane), b = *(const u32x4*)(src + 512 + 8 * F.lane);
        *(u32x4*)(dst + 8 * F.lane) = a; *(u32x4*)(dst + 512 + 8 * F.lane) = b;
    }
    LAS float* scr = (LAS float*)(F.lds + 49152 + F.wave * 8704);
    bf16* WGU = (bf16*)(F.ws + WS_WM + W_GU); bf16* WDN = (bf16*)(F.ws + WS_WM + W_DN);
    constexpr int I_GATE = 16 * 8, I_DOWN = 4 * 32;
    for (int it = F.gw; it < NEXP * (2 * I_GATE + I_DOWN); it += F.NGW) {
        const int e = it / (2 * I_GATE + I_DOWN); int r = it % (2 * I_GATE + I_DOWN);
        if (r < 2 * I_GATE) { const int up = r / I_GATE; r %= I_GATE; const int kb = r / 8, nb = r % 8, n0 = nb * 32;
            const float* src = (up ? F.in[I_WU] : F.in[I_WG]) + ((size_t)(l * 32 + e) * D + kb * 64) * FEXP + n0;
            const int drow = (n0 >> 7) * 256 + up * 128 + (n0 & 127);
            transpose_item(src, FEXP, WGU + ((size_t)e * 512 + drow) * D + kb * 64, D, scr, F.lane);
        } else { r -= 2 * I_GATE; const int kb = r / 32, nb = r % 32;
            const float* src = F.in[I_WD] + ((size_t)(l * 32 + e) * FEXP + kb * 64) * D + nb * 32;
            transpose_item(src, D, WDN + ((size_t)e * D + nb * 32) * FEXP + kb * 64, FEXP, scr, F.lane); }
    }
}

#ifndef SCAN_DUP
#define SCAN_DUP 0
#endif
namespace wk {
constexpr int P = 72, PB = 144, MAT = 64 * PB;
constexpr int PF = 68;
constexpr int O_NAB = 0, O_GS = 17408, O_GC = 19456, O_M0 = 20480;
constexpr int O_AT = O_M0, O_RT = O_AT + MAT, O_BT = O_RT + MAT, O_KT = O_BT + MAT, O_VV = O_KT + MAT, O_LAK = O_VV + MAT, O_MRB = O_LAK + MAT, O_MRK = O_MRB + MAT,
              O_NB = O_MRK + MAT, O_TT = O_NB + MAT, O_XT = O_TT + MAT, O_UT = O_XT + MAT, O_MT = O_UT + MAT, O_H0 = O_MT + MAT, O_H1 = O_H0 + MAT, O_END = O_H1 + MAT;
static_assert(O_END <= LDS_MISC, "scan LDS map");
typedef union { u32x4 u; bf16x8 v; } frag_t;
__device__ __forceinline__ bf16x8 zfrag() { frag_t z; z.u = (u32x4){0u, 0u, 0u, 0u}; return z.v; }
__device__ __forceinline__ bf16x8 ldrow(const LAS unsigned char* M, int row, int col) { return *(const LAS bf16x8*)(M + row * PB + col * 2); }
__device__ __forceinline__ bf16x8 ldtr(unsigned base, int r0, int c0, int lane) {
    const int g = lane >> 4, i = lane & 15, qq = i >> 2, p = i & 3;
    const unsigned a0 = base + (unsigned)((r0 + 8 * g + qq) * PB + (c0 + 4 * p) * 2), a1 = a0 + 4u * PB;
    u32x2 lo, hi;
    asm volatile("ds_read_b64_tr_b16 %0, %2\n\tds_read_b64_tr_b16 %1, %3\n\ts_waitcnt lgkmcnt(0)" : "=&v"(lo), "=&v"(hi) : "v"(a0), "v"(a1) : "memory");
    frag_t f; f.u.x = lo.x; f.u.y = lo.y; f.u.z = hi.x; f.u.w = hi.y; return f.v;
}
__device__ __forceinline__ void st4bf(LAS unsigned char* M, int row, int col, const f32x4& v) { u32x2 w; w.x = pk2(v[0], v[1]); w.y = pk2(v[2], v[3]); *(LAS u32x2*)(M + row * PB + col * 2) = w; }
#define WK_MFMA(a, b, c) __builtin_amdgcn_mfma_f32_16x16x32_bf16(a, b, c, 0, 0, 0)
template <int M> __device__ __forceinline__ float rshare(float v) { return __int_as_float(__builtin_amdgcn_update_dpp(0, __float_as_int(v), 0x150 + M, 0xf, 0xf, false)); }
#define WK_BAR() do { asm volatile("s_waitcnt lgkmcnt(0)" ::: "memory"); __builtin_amdgcn_s_barrier(); asm volatile("" ::: "memory"); } while (0)
}

__device__ __forceinline__ void phase_scan(Frame& F, int l) {
    using namespace wk;
    const int j = l >> 1;
    const bf16* Rb = (const bf16*)(F.ws + WS_ACT + A_RKV); const bf16* Kb = Rb + (size_t)T * D; const bf16* Vb = Kb + (size_t)T * D;
    const bf16* LD = (const bf16*)(F.ws + WS_ACT + A_LDEC); const bf16* AS = (const bf16*)(F.ws + WS_ACT + A_ASIG);
    bf16* Y = (bf16*)(F.ws + WS_ACT + A_Y); float* SB = (float*)(F.ws + WS_SB);
    LAS unsigned char* L = F.lds; const unsigned La = (unsigned)(size_t)L;
    LAS float* NAB = (LAS float*)(L + O_NAB); LAS float* GS = (LAS float*)(L + O_GS); LAS float* GC = (LAS float*)(L + O_GC);
    const int tid0 = F.tid, wave = F.wave;
    for (int unit = blockIdx.x; unit < NB * NH_R * 2; unit += F.G) {
        const int b = unit >> 5, h = (unit >> 1) & 15, dir = unit & 1; const int col = h * 64 + 8 * (tid0 & 7);
        f32x4 kkc[2], kac[2], rkc[2];
#pragma unroll
        for (int e = 0; e < 2; ++e) { kkc[e] = *(const f32x4*)(F.in[I_KK] + j * D + col + 4 * e); kac[e] = *(const f32x4*)(F.in[I_KA] + j * D + col + 4 * e); rkc[e] = *(const f32x4*)(F.in[I_RK] + j * D + col + 4 * e); }
        for (int i = tid0; i < (O_END - O_LAK) / 16; i += NTHREADS) *(LAS u32x4*)(L + O_LAK + i * 16) = (u32x4){0u, 0u, 0u, 0u};
        f32x4 Hs[4];
        f32x4 Yh[4];
#define WK_YFLUSH(cc) do { if (wave >= 4) { const int lane_ = tid0 & 63, qi_ = lane_ & 15, q4_ = lane_ >> 4, vj_ = wave - 4; \
            _Pragma("unroll") for (int ti_ = 0; ti_ < 4; ++ti_) _Pragma("unroll") for (int r_ = 0; r_ < 4; ++r_) { const int st_ = (cc) * 64 + 16 * ti_ + 4 * q4_ + r_; const int t_ = dir ? (SEQ - 1 - st_) : st_; \
                Y[((size_t)dir * T + (size_t)b * SEQ + t_) * D + h * 64 + 16 * vj_ + qi_] = (bf16)f2bf(Yh[ti_][r_]); } } } while (0)
#pragma unroll
        for (int vj = 0; vj < 4; ++vj) Hs[vj] = (f32x4){0.f, 0.f, 0.f, 0.f};
        u32x4 gr, gk, gv, gl, ga;
#define WK_LOAD(c) do { const int st = (c) * 64 + (tid0 >> 3); const int t = dir ? (SEQ - 1 - st) : st; const size_t ro = ((size_t)b * SEQ + t) * D + col; \
            gr = *(const u32x4*)(Rb + ro); gk = *(const u32x4*)(Kb + ro); gv = *(const u32x4*)(Vb + ro); gl = *(const u32x4*)(LD + (size_t)dir * T * D + ro); ga = *(const u32x4*)(AS + (size_t)dir * T * D + ro); } while (0)
        WK_LOAD(0);
        WK_BAR();
        for (int c = 0; c < SEQ / 64; ++c) {
            int tid = tid0; asm volatile("" : "+v"(tid));
            const int lane = tid & 63, qi = lane & 15, q4 = lane >> 4, pt = tid >> 3, c8 = tid & 7;
            LAS unsigned char* H0 = L + ((c & 1) ? O_H1 : O_H0); LAS unsigned char* H1 = L + ((c & 1) ? O_H0 : O_H1);
            for (int sd0_ = 0; sd0_ < 1 + ((SCAN_DUP >> 0) & 1); ++sd0_) {
            float av[8], bv[8], kdv[8], rv[8], ldv[8];
            {
                const unsigned gku[4] = {gk.x, gk.y, gk.z, gk.w}, gru[4] = {gr.x, gr.y, gr.z, gr.w}, glu[4] = {gl.x, gl.y, gl.z, gl.w}, gau[4] = {ga.x, ga.y, ga.z, ga.w};
                float kf[8], af[8], kkv[8]; float ss = 0.f;
#pragma unroll
                for (int e = 0; e < 4; ++e) { kf[2 * e] = bf_lo(gku[e]); kf[2 * e + 1] = bf_hi(gku[e]); rv[2 * e] = bf_lo(gru[e]); rv[2 * e + 1] = bf_hi(gru[e]);
                    ldv[2 * e] = bf_lo(glu[e]); ldv[2 * e + 1] = bf_hi(glu[e]); af[2 * e] = bf_lo(gau[e]); af[2 * e + 1] = bf_hi(gau[e]); }
#pragma unroll
                for (int e = 0; e < 8; ++e) { kkv[e] = kf[e] * kkc[e >> 2][e & 3]; ss += kkv[e] * kkv[e]; }
                ss = sum8(ss);
                const float inv = 1.0f / fmaxf(sqrtf(ss), 1e-12f); float bo = 0.f;
#pragma unroll
                for (int e = 0; e < 8; ++e) { const float kn = kkv[e] * inv; kdv[e] = kf[e] * (1.0f + (af[e] - 1.0f) * kac[e >> 2][e & 3]); av[e] = -kn; bv[e] = kn * af[e]; bo += rv[e] * kdv[e] * rkc[e >> 2][e & 3]; }
                bo = sum8(bo);
                const int st = c * 64 + pt; const int t = dir ? (SEQ - 1 - st) : st;
                if (c8 == 0) SB[((size_t)dir * T + (size_t)b * SEQ + t) * 16 + h] = bo;
                *(LAS f32x4*)(NAB + pt * PF + 8 * c8) = (f32x4){ldv[0], ldv[1], ldv[2], ldv[3]}; *(LAS f32x4*)(NAB + pt * PF + 8 * c8 + 4) = (f32x4){ldv[4], ldv[5], ldv[6], ldv[7]};
                *(LAS u32x4*)(L + O_VV + pt * PB + 16 * c8) = gv;
            }
            if (sd0_ == ((SCAN_DUP >> 0) & 1)) { if (c > 0) WK_YFLUSH(c - 1); if (c + 1 < SEQ / 64) WK_LOAD(c + 1); }
            WK_BAR();
            { const int kc = tid & 63, g = tid >> 6; float pre[8]; float p = 0.f;
#pragma unroll
              for (int i = 0; i < 8; ++i) { p += NAB[(8 * g + i) * PF + kc]; pre[i] = p; }
              GS[g * 64 + kc] = p;
              WK_BAR();
              float off = 0.f;
#pragma unroll
              for (int gg = 0; gg < 7; ++gg) off += (gg < g) ? GS[gg * 64 + kc] : 0.f;
#pragma unroll
              for (int i = 0; i < 8; ++i) NAB[(8 * g + i) * PF + kc] = off + pre[i]; }
            WK_BAR();
            { f32x4 cl[2], cm[2];
#pragma unroll
              for (int e = 0; e < 2; ++e) { cl[e] = *(const LAS f32x4*)(NAB + pt * PF + 8 * c8 + 4 * e); cm[e] = (pt > 0) ? *(const LAS f32x4*)(NAB + (pt - 1) * PF + 8 * c8 + 4 * e) : (f32x4){0.f, 0.f, 0.f, 0.f}; }
              float oa[8], orr[8], ob[8], ok[8];
#pragma unroll
              for (int e = 0; e < 8; ++e) { const float c1 = cl[e >> 2][e & 3], c0 = cm[e >> 2][e & 3]; const float gp = __builtin_amdgcn_exp2f(c1), gn = __builtin_amdgcn_exp2f(-c1), g0 = __builtin_amdgcn_exp2f(c0);
                  oa[e] = av[e] * g0; orr[e] = rv[e] * gp; ob[e] = bv[e] * gn; ok[e] = kdv[e] * gn; if (pt == 63) GC[8 * c8 + e] = gp; }
              *(LAS u32x4*)(L + O_AT + pt * PB + 16 * c8) = (u32x4){pk2(oa[0], oa[1]), pk2(oa[2], oa[3]), pk2(oa[4], oa[5]), pk2(oa[6], oa[7])};
              *(LAS u32x4*)(L + O_RT + pt * PB + 16 * c8) = (u32x4){pk2(orr[0], orr[1]), pk2(orr[2], orr[3]), pk2(orr[4], orr[5]), pk2(orr[6], orr[7])};
              *(LAS u32x4*)(L + O_BT + pt * PB + 16 * c8) = (u32x4){pk2(ob[0], ob[1]), pk2(ob[2], ob[3]), pk2(ob[4], ob[5]), pk2(ob[6], ob[7])};
              *(LAS u32x4*)(L + O_KT + pt * PB + 16 * c8) = (u32x4){pk2(ok[0], ok[1]), pk2(ok[2], ok[3]), pk2(ok[4], ok[5]), pk2(ok[6], ok[7])}; }
            WK_BAR();
            }
            f32x4 X0[4], Y0[4];
            for (int sd1_ = 0; sd1_ < 1 + ((SCAN_DUP >> 1) & 1); ++sd1_) {
#pragma unroll
            for (int jj = 0; jj < 5; ++jj) {
                const int idx = wave * 5 + jj, blk = idx / 10, tri = idx % 10;
                const int ti = (tri >= 6) ? 3 : ((tri >= 3) ? 2 : ((tri >= 1) ? 1 : 0)); const int si = tri - (ti * (ti + 1)) / 2;
                const LAS unsigned char* Pm = L + ((blk < 2) ? O_AT : O_RT); const LAS unsigned char* Qm = L + ((blk & 1) ? O_KT : O_BT);
                f32x4 acc = {0.f, 0.f, 0.f, 0.f};
#pragma unroll
                for (int ks = 0; ks < 2; ++ks) acc = WK_MFMA(ldrow(Qm, 16 * si + qi, 32 * ks + 8 * q4), ldrow(Pm, 16 * ti + qi, 32 * ks + 8 * q4), acc);
                const int tt = 16 * ti + qi, s0 = 16 * si + 4 * q4;
#pragma unroll
                for (int r = 0; r < 4; ++r) { const int sidx = s0 + r; const bool keep = (blk < 2) ? (sidx < tt) : (sidx <= tt); acc[r] = keep ? acc[r] : 0.f; }
                if (blk == 0) { *(LAS f32x4*)(NAB + tt * PF + s0) = acc; st4bf(L + O_NB, tt, s0, acc); }
                else st4bf(L + (blk == 1 ? O_LAK : (blk == 2 ? O_MRB : O_MRK)), tt, s0, acc);
            }
            WK_BAR();
            }
            for (int sd2_ = 0; sd2_ < 1 + ((SCAN_DUP >> 2) & 1); ++sd2_) {
            if (wave >= 4) { const int vj = wave - 4;
#pragma unroll
                for (int ti = 0; ti < 4; ++ti) { X0[ti] = (f32x4){0.f, 0.f, 0.f, 0.f}; Y0[ti] = (f32x4){0.f, 0.f, 0.f, 0.f};
#pragma unroll
                    for (int ks = 0; ks < 2; ++ks) if (ks <= (ti >> 1)) { const bf16x8 vf = ldtr(La + O_VV, 32 * ks, 16 * vj, lane);
                        X0[ti] = WK_MFMA(ldrow(L + O_LAK, 16 * ti + qi, 32 * ks + 8 * q4), vf, X0[ti]); Y0[ti] = WK_MFMA(ldrow(L + O_MRK, 16 * ti + qi, 32 * ks + 8 * q4), vf, Y0[ti]); } } }
            if (wave == 0) {
                const int blk = q4, cj = qi; float nrow[16], x[16];
#pragma unroll
                for (int r = 0; r < 16; ++r) nrow[r] = NAB[(16 * blk + r) * PF + 16 * blk + cj];
#pragma unroll
                for (int r = 0; r < 16; ++r) { float acc = (r == cj) ? 1.0f : 0.0f;
#define WK_SUBM(m) if (m < r) acc += wk::rshare<m>(nrow[r]) * x[m];
                    WK_SUBM(0) WK_SUBM(1) WK_SUBM(2) WK_SUBM(3) WK_SUBM(4) WK_SUBM(5) WK_SUBM(6) WK_SUBM(7) WK_SUBM(8) WK_SUBM(9) WK_SUBM(10) WK_SUBM(11) WK_SUBM(12) WK_SUBM(13) WK_SUBM(14)
#undef WK_SUBM
                    x[r] = acc; *(LAS bf16*)(L + O_TT + (16 * blk + r) * PB + (16 * blk + cj) * 2) = (bf16)f2bf(acc); }
            }
            WK_BAR();
            if (wave < 2) {
                const int i = 2 * wave + 1, jb = 2 * wave;
                bf16x8 a = ldrow(L + O_NB, 16 * i + qi, 16 * jb + 8 * (q4 & 1)), bfr = ldtr(La + O_TT, 16 * jb - 8 * (q4 & 2), 16 * jb, lane);
                if (q4 >= 2) { a = zfrag(); bfr = zfrag(); }
                f32x4 acc = {0.f, 0.f, 0.f, 0.f}; acc = WK_MFMA(a, bfr, acc);
                st4bf(L + O_MT, 16 * wave + qi, 4 * q4, acc);
            }
            WK_BAR();
            if (wave < 2) {
                const int i = 2 * wave + 1, jb = 2 * wave;
                bf16x8 a = ldrow(L + O_TT, 16 * i + qi, 16 * i + 8 * (q4 & 1)), bfr = ldrow(L + O_MT, 16 * wave + qi, 8 * (q4 & 1));
                if (q4 >= 2) { a = zfrag(); bfr = zfrag(); }
                f32x4 acc = {0.f, 0.f, 0.f, 0.f}; acc = WK_MFMA(a, bfr, acc);
#pragma unroll
                for (int r = 0; r < 4; ++r) *(LAS bf16*)(L + O_TT + (16 * i + 4 * q4 + r) * PB + (16 * jb + qi) * 2) = (bf16)f2bf(acc[r]);
            }
            WK_BAR();
            if (wave < 4) {
                const int ti2 = wave >> 1, tj2 = wave & 1;
                f32x4 acc = {0.f, 0.f, 0.f, 0.f}; acc = WK_MFMA(ldrow(L + O_NB, 32 + 16 * ti2 + qi, 8 * q4), ldtr(La + O_TT, 0, 16 * tj2, lane), acc);
                st4bf(L + O_MT, 32 + 16 * tj2 + qi, 16 * ti2 + 4 * q4, acc);
            }
            WK_BAR();
            if (wave < 4) {
                const int ti2 = wave >> 1, tj2 = wave & 1;
                f32x4 acc = {0.f, 0.f, 0.f, 0.f}; acc = WK_MFMA(ldrow(L + O_TT, 32 + 16 * ti2 + qi, 32 + 8 * q4), ldrow(L + O_MT, 32 + 16 * tj2 + qi, 8 * q4), acc);
#pragma unroll
                for (int r = 0; r < 4; ++r) *(LAS bf16*)(L + O_TT + (32 + 16 * ti2 + 4 * q4 + r) * PB + (16 * tj2 + qi) * 2) = (bf16)f2bf(acc[r]);
            }
            }
            for (int sd3_ = 0; sd3_ < 1 + ((SCAN_DUP >> 3) & 1); ++sd3_) {
            if (wave >= 4) { const int vj = wave - 4;
#pragma unroll
                for (int ti = 0; ti < 4; ++ti) { f32x4 acc = X0[ti];
#pragma unroll
                    for (int ks = 0; ks < 2; ++ks) acc = WK_MFMA(ldrow(L + O_AT, 16 * ti + qi, 32 * ks + 8 * q4), ldrow(H0, 16 * vj + qi, 32 * ks + 8 * q4), acc);
                    st4bf(L + O_XT, 16 * vj + qi, 16 * ti + 4 * q4, acc); } }
            WK_BAR();
#pragma unroll
            for (int e = 0; e < 2; ++e) { const int id = wave * 2 + e, ti = id >> 2, vj = id & 3; f32x4 acc = {0.f, 0.f, 0.f, 0.f};
#pragma unroll
                for (int ks = 0; ks < 2; ++ks) if (ks <= (ti >> 1)) acc = WK_MFMA(ldrow(L + O_TT, 16 * ti + qi, 32 * ks + 8 * q4), ldrow(L + O_XT, 16 * vj + qi, 32 * ks + 8 * q4), acc);
                st4bf(L + O_UT, 16 * vj + qi, 16 * ti + 4 * q4, acc); }
            WK_BAR();
            }
            f32x4 Hsave[4]; for (int vj_ = 0; vj_ < 4; ++vj_) Hsave[vj_] = Hs[vj_];
            for (int sd5_ = 0; sd5_ < 1 + ((SCAN_DUP >> 4) & 1); ++sd5_) {
            for (int vj_ = 0; vj_ < 4; ++vj_) Hs[vj_] = Hsave[vj_];
            if (wave >= 4) { const int vj = wave - 4;
#pragma unroll
                for (int ti = 0; ti < 4; ++ti) { f32x4 acc = Y0[ti];
#pragma unroll
                    for (int ks = 0; ks < 2; ++ks) { acc = WK_MFMA(ldrow(L + O_RT, 16 * ti + qi, 32 * ks + 8 * q4), ldrow(H0, 16 * vj + qi, 32 * ks + 8 * q4), acc);
                        if (ks <= (ti >> 1)) acc = WK_MFMA(ldrow(L + O_MRB, 16 * ti + qi, 32 * ks + 8 * q4), ldrow(L + O_UT, 16 * vj + qi, 32 * ks + 8 * q4), acc); }
                    Yh[ti] = acc; } }
            else { const int kt = wave; const f32x4 gc = *(const LAS f32x4*)(GC + 16 * kt + 4 * q4);
#pragma unroll
                for (int ks = 0; ks < 2; ++ks) { const bf16x8 bt = ldtr(La + O_BT, 32 * ks, 16 * kt, lane), ktf = ldtr(La + O_KT, 32 * ks, 16 * kt, lane);
#pragma unroll
                    for (int vj = 0; vj < 4; ++vj) { Hs[vj] = WK_MFMA(bt, ldrow(L + O_UT, 16 * vj + qi, 32 * ks + 8 * q4), Hs[vj]); Hs[vj] = WK_MFMA(ktf, ldtr(La + O_VV, 32 * ks, 16 * vj, lane), Hs[vj]); } }
#pragma unroll
                for (int vj = 0; vj < 4; ++vj) { Hs[vj] = Hs[vj] * gc; st4bf(H1, 16 * vj + qi, 16 * kt + 4 * q4, Hs[vj]); } }
            WK_BAR();
            }
        }
        WK_YFLUSH(SEQ / 64 - 1);
#undef WK_LOAD
#undef WK_YFLUSH
    }
}

__device__ __forceinline__ void phase_rw_post(Frame& F, int l) {
    const int j = l >> 1; const float* lnw = F.in[I_LNW] + j * D; const float* lnb = F.in[I_LNB] + j * D;
    const bf16* Vb = (const bf16*)(F.ws + WS_ACT + A_RKV) + (size_t)2 * T * D; const bf16* Y = (const bf16*)(F.ws + WS_ACT + A_Y); const bf16* Gb = (const bf16*)(F.ws + WS_ACT + A_G);
    const float* SB = (const float*)(F.ws + WS_SB); bf16* O = (bf16*)(F.ws + WS_ACT + A_O);
    for (int row = F.gw; row < T; row += F.NGW) {
        f32x4 o[4];
#pragma unroll
        for (int q = 0; q < 4; ++q) {
            const int c = 4 * F.lane + 256 * q; const int head = 4 * q + (F.lane >> 4);
            const u32x2 vr = *(const u32x2*)(Vb + (size_t)row * D + c); const f32x4 vf = {bf_lo(vr.x), bf_hi(vr.x), bf_lo(vr.y), bf_hi(vr.y)};
            const f32x4 w = *(const f32x4*)(lnw + c), bb = *(const f32x4*)(lnb + c);
            f32x4 acc = {0.f, 0.f, 0.f, 0.f};
#pragma unroll
            for (int dir = 0; dir < 2; ++dir) {
                const size_t ro = ((size_t)dir * T + row) * D + c;
                const u32x2 yr = *(const u32x2*)(Y + ro), gr = *(const u32x2*)(Gb + ro);
                const f32x4 yf = {bf_lo(yr.x), bf_hi(yr.x), bf_lo(yr.y), bf_hi(yr.y)}; const f32x4 gf = {bf_lo(gr.x), bf_hi(gr.x), bf_lo(gr.y), bf_hi(gr.y)};
                const float sbv = SB[((size_t)dir * T + row) * 16 + head];
                const float mean = rowsum16((yf[0] + yf[1]) + (yf[2] + yf[3])) * (1.0f / 64.0f);
                const f32x4 d = yf - mean; const float var = rowsum16((d[0] * d[0] + d[1] * d[1]) + (d[2] * d[2] + d[3] * d[3])) * (1.0f / 64.0f);
                const float rs = rsqrtf(var + GN_EPS);
                acc += gf * (d * rs * w + bb + sbv * vf);
            }
            o[q] = acc;
        }
        row_store_bf16(O + (size_t)row * D, F.lane, o);
    }
}

__device__ __forceinline__ unsigned att_f(unsigned row) { return ((row & 3u) << 2) | ((row >> 2) & 3u); }
__device__ __forceinline__ unsigned att_off_b(unsigned row, unsigned ch) { return 256u * row + 16u * (ch ^ att_f(row)); }
__device__ __forceinline__ void phase_attn(Frame& F, bool dry = false) {
    bf16* Qb = (bf16*)(F.ws + WS_ACT + A_Q); const bf16* Kb = (const bf16*)(F.ws + WS_ACT + A_K); const bf16* Vb = (const bf16*)(F.ws + WS_ACT + A_VT);
    float* LSE = (float*)(F.ws + WS_SB);
    const int lane = F.lane, qi = lane & 15, q4 = lane >> 4, wave = F.wave;
    LAS unsigned char* KW = F.lds; LAS unsigned char* VW = F.lds + 65536;
    const unsigned vw_a = (unsigned)(size_t)VW;
    unsigned ka[2][4], va[8][2];
#pragma unroll
    for (int rb = 0; rb < 2; ++rb)
#pragma unroll
        for (int s = 0; s < 4; ++s) ka[rb][s] = att_off_b((unsigned)(qi + 16 * rb), (unsigned)(4 * s + q4));
    { const unsigned q = (unsigned)qi >> 2, p = (unsigned)lane & 3u;
#pragma unroll
      for (int c = 0; c < 8; ++c)
#pragma unroll
          for (int t = 0; t < 2; ++t) va[c][t] = vw_a + att_off_b(8u * q4 + 4u * t + q, 2u * c + (p >> 1)) + 8u * (p & 1u); }
    unsigned fk[8];
#pragma unroll
    for (int i = 0; i < 8; ++i) { const unsigned rho = 4u * i + (unsigned)q4, m = rho & 15u, rb = rho >> 4; const unsigned kidx = 8u * (m >> 2) + (m & 3u) + 4u * rb;
        fk[i] = kidx | ((16u * ((unsigned)qi ^ att_f(rho))) << 8); }
    const int nper = (F.G >= 8) ? (F.G >> 3) : 1;
    for (int k = (F.G >= 8 && (F.G & 7) == 0) ? (int)(blockIdx.x >> 3) : (int)blockIdx.x; k < ((F.G >= 8 && (F.G & 7) == 0) ? 3 * NB * 16 : 3 * NB * 8 * 16); k += ((F.G >= 8 && (F.G & 7) == 0) ? nper : F.G)) {
        int g, b, hs, cc;
        if (F.G >= 8 && (F.G & 7) == 0) { hs = blockIdx.x & 7; cc = k & 15; b = (k >> 4) & 7; g = k >> 7; }
        else { g = k >> 10; b = (k >> 7) & 7; hs = (k >> 4) & 7; cc = k & 15; }
        const int dsh = 2 * g, Lg = SEQ >> dsh; const int cls = (g == 0) ? 0 : ((g == 1) ? (cc >> 2) : cc); const int chunk = (g == 0) ? cc : ((g == 1) ? (cc & 3) : 0);
        const int P0 = 128 * chunk;
        asm volatile("s_waitcnt lgkmcnt(0)" ::: "memory"); __builtin_amdgcn_s_barrier(); asm volatile("" ::: "memory");
        { const int base_ = P0 - 64 + 32 * wave;
          const bf16* ksrc = Kb + ((size_t)g * T + (size_t)b * SEQ) * D + hs * 128; const bf16* vsrc = Vb + ((size_t)g * T + (size_t)b * SEQ) * D + hs * 128;
#pragma unroll
          for (int i = 0; i < 8; ++i) { const int pk = min(max(base_ + (int)(fk[i] & 255u), 0), Lg - 1), pv = min(max(base_ + 4 * i + q4, 0), Lg - 1);
              __builtin_amdgcn_global_load_lds((const unsigned*)((const char*)(ksrc + (size_t)(cls + (pk << dsh)) * D) + (fk[i] >> 8)), (LAS unsigned*)(KW + wave * 8192 + i * 1024), 16, 0, 0);
              __builtin_amdgcn_global_load_lds((const unsigned*)((const char*)(vsrc + (size_t)(cls + (pv << dsh)) * D) + (fk[i] >> 8)), (LAS unsigned*)(VW + wave * 8192 + i * 1024), 16, 0, 0); } }
        const int Pq = P0 + 16 * wave + qi; const size_t qrow = (size_t)g * T + (size_t)b * SEQ + (size_t)(cls + (Pq << dsh));
        bf16* qp = Qb + qrow * D + hs * 128;
        bf16x8 Qf[4];
#pragma unroll
        for (int kt = 0; kt < 4; ++kt) Qf[kt] = *(const bf16x8*)(qp + 8 * q4 + 32 * kt);
        const float slope2 = exp2f(-8.0f * (float)(g * 8 + hs + 1) / 24.0f) * LOG2E * (float)(1 << dsh);
        float m_run = -1e30f, l_run = 0.f; f32x4 O[8];
#pragma unroll
        for (int dt = 0; dt < 8; ++dt) O[dt] = (f32x4){0.f, 0.f, 0.f, 0.f};
        asm volatile("s_waitcnt vmcnt(0)" ::: "memory"); __builtin_amdgcn_s_barrier(); asm volatile("" ::: "memory");
#pragma unroll
        for (int s = 0; s < 5; ++s) {
            const int tb = (wave >> 1) + s; const LAS unsigned char* kl = KW + tb * 8192; const unsigned voff = (unsigned)tb * 8192u;
            bf16x8 KA[4], KB[4];
#pragma unroll
            for (int kt = 0; kt < 4; ++kt) { KA[kt] = *(const LAS bf16x8*)(kl + ka[0][kt]); KB[kt] = *(const LAS bf16x8*)(kl + ka[1][kt]); }
            f32x4 SA = {0.f, 0.f, 0.f, 0.f}, SBt = {0.f, 0.f, 0.f, 0.f};
#pragma unroll
            for (int kt = 0; kt < 4; ++kt) { SA = __builtin_amdgcn_mfma_f32_16x16x32_bf16(KA[kt], Qf[kt], SA, 0, 0, 0); SBt = __builtin_amdgcn_mfma_f32_16x16x32_bf16(KB[kt], Qf[kt], SBt, 0, 0, 0); }
            const int cb = P0 - 64 + 32 * tb + 8 * q4;
            float sv[8]; bool ok[8]; float mx = -1e30f;
#pragma unroll
            for (int r = 0; r < 8; ++r) { const int p = cb + r; const int rel = abs(p - Pq); ok[r] = (p >= 0) && (p < Lg) && (rel <= 64);
                const float sc = (r < 4 ? SA[r & 3] : SBt[r & 3]) - slope2 * (float)rel; sv[r] = ok[r] ? sc : -1e30f; mx = fmaxf(mx, sv[r]); }
            mx = fmaxf(mx, lane_xor(mx, lane, 16)); mx = fmaxf(mx, lane_xor(mx, lane, 32));
            const float m_new = fmaxf(m_run, mx); const float alpha = __builtin_amdgcn_exp2f(m_run - m_new); m_run = m_new;
            float pe[8]; float rs = 0.f;
#pragma unroll
            for (int r = 0; r < 8; ++r) { pe[r] = ok[r] ? __builtin_amdgcn_exp2f(sv[r] - m_new) : 0.f; rs += pe[r]; }
            rs += lane_xor(rs, lane, 16); rs += lane_xor(rs, lane, 32);
            l_run = l_run * alpha + rs;
            union { u32x4 u; bf16x8 v; } pf; pf.u.x = pk2(pe[0], pe[1]); pf.u.y = pk2(pe[2], pe[3]); pf.u.z = pk2(pe[4], pe[5]); pf.u.w = pk2(pe[6], pe[7]);
#pragma unroll
            for (int hf = 0; hf < 2; ++hf) {
                u32x2 vr[4][2];
                asm volatile("ds_read_b64_tr_b16 %0, %8\n\tds_read_b64_tr_b16 %1, %9\n\tds_read_b64_tr_b16 %2, %10\n\tds_read_b64_tr_b16 %3, %11\n\t"
                             "ds_read_b64_tr_b16 %4, %12\n\tds_read_b64_tr_b16 %5, %13\n\tds_read_b64_tr_b16 %6, %14\n\tds_read_b64_tr_b16 %7, %15\n\ts_waitcnt lgkmcnt(0)"
                             : "=&v"(vr[0][0]), "=&v"(vr[0][1]), "=&v"(vr[1][0]), "=&v"(vr[1][1]), "=&v"(vr[2][0]), "=&v"(vr[2][1]), "=&v"(vr[3][0]), "=&v"(vr[3][1])
                             : "v"(va[4 * hf + 0][0] + voff), "v"(va[4 * hf + 0][1] + voff), "v"(va[4 * hf + 1][0] + voff), "v"(va[4 * hf + 1][1] + voff), "v"(va[4 * hf + 2][0] + voff), "v"(va[4 * hf + 2][1] + voff), "v"(va[4 * hf + 3][0] + voff), "v"(va[4 * hf + 3][1] + voff)
                             : "memory");
#pragma unroll
                for (int c = 0; c < 4; ++c) { const int dt = 4 * hf + c; union { u32x4 u; bf16x8 v; } vf; vf.u.x = vr[c][0].x; vf.u.y = vr[c][0].y; vf.u.z = vr[c][1].x; vf.u.w = vr[c][1].y;
                    O[dt] = O[dt] * alpha; O[dt] = __builtin_amdgcn_mfma_f32_16x16x32_bf16(vf.v, pf.v, O[dt], 0, 0, 0); }
            }
        }
        const float inv = 1.0f / l_run;
#pragma unroll
        for (int dt = 0; dt < 8; ++dt) { u32x2 o; o.x = pk2(O[dt][0] * inv, O[dt][1] * inv); o.y = pk2(O[dt][2] * inv, O[dt][3] * inv); if (!dry) *(u32x2*)(qp + 4 * q4 + 16 * dt) = o; else asm volatile("" :: "v"(o.x), "v"(o.y)); }
        if (q4 == 0 && !dry) LSE[qrow * 8 + hs] = m_run + __builtin_amdgcn_logf(l_run);
    }
}
__device__ __forceinline__ void phase_attn_merge(Frame& F) {
    const bf16* Ob = (const bf16*)(F.ws + WS_ACT + A_Q); const float* LSE = (const float*)(F.ws + WS_SB); bf16* AO = (bf16*)(F.ws + WS_ACT + A_AO);
    for (int row = F.gw; row < T; row += F.NGW) {
        f32x4 o[4];
#pragma unroll
        for (int q = 0; q < 4; ++q) { const int c = 4 * F.lane + 256 * q; const int head = 2 * q + (F.lane >> 5);
            float ls[3];
#pragma unroll
            for (int g = 0; g < 3; ++g) ls[g] = LSE[((size_t)g * T + row) * 8 + head];
            const float mx = fmaxf(ls[0], fmaxf(ls[1], ls[2]));
            float w[3]; float sum = 0.f;
#pragma unroll
            for (int g = 0; g < 3; ++g) { w[g] = __builtin_amdgcn_exp2f(ls[g] - mx); sum += w[g]; }
            const float inv = 1.0f / sum; f32x4 acc = {0.f, 0.f, 0.f, 0.f};
#pragma unroll
            for (int g = 0; g < 3; ++g) { const u32x2 r = *(const u32x2*)(Ob + ((size_t)g * T + row) * D + c); const float a = w[g] * inv;
                acc[0] += a * bf_lo(r.x); acc[1] += a * bf_hi(r.x); acc[2] += a * bf_lo(r.y); acc[3] += a * bf_hi(r.y); }
            o[q] = acc; }
        row_store_bf16(AO + (size_t)row * D, F.lane, o);
    }
}

constexpr int PH_PER_LAYER = 10, N_PHASES = 1 + DEPTH * PH_PER_LAYER + 1;
template <int MASK> __global__ void __launch_bounds__(NTHREADS, 2) mk_fwd(Args args) {
    extern __shared__ __attribute__((aligned(16))) unsigned char lds_raw[];
#define PHASE_FRAME() Frame F; { int t_ = wave0 * 64 + lane_id_nh(); asm volatile("" : "+v"(t_)); size_t z_ = 0; asm volatile("" : "+s"(z_)); unsigned char* w_ = args.ws + z_;     \
        unsigned lb_ = 0; asm volatile("" : "+s"(lb_)); F.lds = (LAS unsigned char*)lds_raw + lb_; F.tid = t_; F.lane = t_ & 63; F.wave = __builtin_amdgcn_readfirstlane(t_ >> 6); \
        F.G = gridDim.x; F.gw = blockIdx.x * NWAVES + F.wave; F.NGW = F.G * NWAVES; F.ws = w_; F.in = args.in; F.out = args.out; }
    LAS unsigned char* lds0 = (LAS unsigned char*)lds_raw;
    const int wave0 = __builtin_amdgcn_readfirstlane((int)threadIdx.x >> 6);
    volatile LAS unsigned* MISC = (volatile LAS unsigned*)(lds0 + MISC_OFF);
    if (wave0 == 0) ((LAS unsigned*)(lds0 + LDS_MISC))[lane_id_nh() + 64] = 0u;
    __syncthreads();
    unsigned* ctl = (unsigned*)(args.ws + WS_CTL);
    XcdBarrier bar; bar.bar = ctl + CW_BAR; bar.x = 0; bar.st = nullptr;
#if ONE_LAUNCH
    bar = xcd_barrier_post(ctl + CW_BAR, MISC + 8, wave0 == 0 && lane_id_nh() == 0);
#endif
    const int lo = args.ph_lo, hi = args.ph_hi;
#define EN(b) ((MASK >> (b)) & 1)
#ifndef DUP_MASK
#define DUP_MASK 0
#endif
#define REP(b) for (int rep_ = 0; rep_ < 1 + ((DUP_MASK >> (b)) & 1); ++rep_)
#define IN(k) (lo <= (k) && (k) < hi)
#if ONE_LAUNCH
#ifndef BAR_REP
#define BAR_REP 1
#endif
#define SEAM(k) do { if (IN((k) + 1) || (k) + 1 < hi) { for (int br_ = 0; br_ < BAR_REP; ++br_) xcd_barrier(bar, wave0 == 0 && lane_id_nh() == 0); } } while (0)
#else
#define SEAM(k) do { } while (0)
#endif
    float* X0 = args.out; float* X1 = (float*)(args.ws + WS_X1);
    if (EN(0) && IN(0)) { PHASE_FRAME(); REP(0) phase_prologue(F); SEAM(0); }
    for (int l = 0; l < DEPTH; ++l) {
        const int pb = 1 + l * PH_PER_LAYER; const int j = l >> 1;
        const float* xin = (l == 0) ? args.in[I_X] : ((l & 1) ? X0 : X1);
        float* xcur = (l == 0) ? X0 : ((l & 1) ? X1 : X0);
        if ((l & 1) == 0) {
            if (EN(1) && IN(pb + 0)) { PHASE_FRAME(); REP(1) phase_rw_norm(F, l, l > 0, xin, xcur); SEAM(pb + 0); }
            if (EN(2) && IN(pb + 1)) { PHASE_FRAME(); REP(2) {
                { DenseSched S; S.o.init(T / 256, 2, F.G, blockIdx.x); S.A = (const char*)(F.ws + WS_ACT + A_HX); S.a_sel_stride = 0; S.pn_per_a = 1 << 20;
                  S.B = (const char*)(F.ws + WS_W + j * W_RW_STRIDE + W_LDN); S.tstepA = (size_t)256 * 2048 * 2; S.tstepB = (size_t)256 * 2048 * 2;
                  EpiLoraDn E{(bf16*)(F.ws + WS_ACT + A_LORAH)};
                  pg8::gemm_phase(F.lds, F.tid, 2048, 2048, 2048, S, E); }
                { DenseSched S; S.o.init(T / 256, 12, F.G, blockIdx.x); S.o.uneven = (F.G == 256); S.A = (const char*)(F.ws + WS_ACT + A_XS); S.a_sel_stride = (size_t)T * D * 2; S.pn_per_a = 4;
                  S.B = (const char*)(F.ws + WS_W + j * W_RW_STRIDE + W_RKV); S.tstepA = (size_t)256 * D * 2; S.tstepB = (size_t)256 * D * 2;
                  EpiSplit E{(bf16*)(F.ws + WS_ACT + A_RKV), (size_t)T * D, 1.0f};
                  pg8::gemm_phase(F.lds, F.tid, D, D, D, S, E); }
                }
                SEAM(pb + 1);
            }
            if (EN(3) && IN(pb + 2)) { PHASE_FRAME(); REP(3) {
                { DenseSched S; S.o.init(T / 256, 16, F.G, blockIdx.x); S.A = (const char*)(F.ws + WS_ACT + A_LORAH); S.a_sel_stride = 0; S.pn_per_a = 1 << 20;
                  S.B = (const char*)(F.ws + WS_W + j * W_RW_STRIDE + W_LUPWA); S.tstepA = (size_t)256 * 512 * 2; S.tstepB = (size_t)256 * 256 * 2;
                  EpiLoraUpWA E{(bf16*)(F.ws + WS_ACT + A_LDEC), (bf16*)(F.ws + WS_ACT + A_ASIG), F.in[I_W0] + j * 2 * D, F.in[I_A0] + j * 2 * D};
                  pg8::gemm_phase(F.lds, F.tid, 256, 512, 256, S, E); }
                { DenseSched S; S.o.init(T / 256, 8, F.G, blockIdx.x); S.A = (const char*)(F.ws + WS_ACT + A_LORAH) + 512; S.a_sel_stride = 0; S.pn_per_a = 1 << 20;
                  S.B = (const char*)(F.ws + WS_W + j * W_RW_STRIDE + W_LUPG); S.tstepA = (size_t)256 * 512 * 2; S.tstepB = (size_t)256 * 256 * 2;
                  EpiSplit E{(bf16*)(F.ws + WS_ACT + A_G), (size_t)T * D, 1.0f};
                  pg8::gemm_phase(F.lds, F.tid, 256, 512, 256, S, E); }
                }
                SEAM(pb + 2);
            }
            if (EN(4) && IN(pb + 3)) { PHASE_FRAME(); REP(4) phase_scan(F, l); SEAM(pb + 3); }
            if (EN(5) && IN(pb + 4)) { PHASE_FRAME(); REP(5) phase_rw_post(F, l); SEAM(pb + 4); }
            if (EN(6) && IN(pb + 5)) { PHASE_FRAME();
                DenseSched S; S.o.init(T / 256, 4, F.G, blockIdx.x); S.A = (const char*)(F.ws + WS_ACT + A_O); S.a_sel_stride = 0; S.pn_per_a = 1 << 20;
                S.B = (const char*)(F.ws + WS_W + j * W_RW_STRIDE + W_RWO); S.tstepA = (size_t)256 * D * 2; S.tstepB = (size_t)256 * D * 2;
                EpiResid E{(l == 0) ? F.in[I_X] : (const float*)xcur, xcur, (const float*)(F.ws + WS_MOD) + (size_t)l * 8 * 6144 + 2 * D};
                pg8::gemm_phase(F.lds, F.tid, D, D, D, S, E);
                SEAM(pb + 5);
            }
        } else {
            if (EN(7) && IN(pb + 0)) { PHASE_FRAME(); REP(7) phase_at_norm(F, l, xin, xcur); SEAM(pb + 0); }
            if (EN(8) && IN(pb + 1)) { PHASE_FRAME(); REP(8) {
                DenseSched S; S.o.init(T / 256, 36, F.G, blockIdx.x); S.A = (const char*)(F.ws + WS_ACT + A_H); S.a_sel_stride = 0; S.pn_per_a = 1 << 20;
                S.B = (const char*)(F.ws + WS_WA + j * W_AT_STRIDE + W_QKV); S.tstepA = (size_t)256 * D * 2; S.tstepB = (size_t)256 * D * 2;
                EpiQKV E{(bf16*)(F.ws + WS_ACT + A_Q), (bf16*)(F.ws + WS_ACT + A_K), (bf16*)(F.ws + WS_ACT + A_VT), 0.08838834764831845f * LOG2E};
                pg8::gemm_phase(F.lds, F.tid, D, D, D, S, E);
                }
                SEAM(pb + 1);
            }
            if (EN(9) && IN(pb + 2)) { PHASE_FRAME(); if ((DUP_MASK >> 9) & 1) phase_attn(F, true); phase_attn(F); SEAM(pb + 2); }
            if (EN(16) && IN(pb + 3)) { PHASE_FRAME(); REP(16) phase_attn_merge(F); SEAM(pb + 3); }
            if (EN(10) && IN(pb + 4)) { PHASE_FRAME();
                DenseSched S; S.o.init(T / 256, 4, F.G, blockIdx.x); S.A = (const char*)(F.ws + WS_ACT + A_AO); S.a_sel_stride = 0; S.pn_per_a = 1 << 20;
                S.B = (const char*)(F.ws + WS_WA + j * W_AT_STRIDE + W_AWO); S.tstepA = (size_t)256 * D * 2; S.tstepB = (size_t)256 * D * 2;
                EpiResid E{(const float*)xcur, xcur, (const float*)(F.ws + WS_MOD) + (size_t)l * 8 * 6144 + 2 * D};
                pg8::gemm_phase(F.lds, F.tid, D, D, D, S, E);
                SEAM(pb + 4);
            }
        }
        if (EN(11) && IN(pb + 6)) { PHASE_FRAME(); if ((DUP_MASK >> 11) & 1) phase_moe_route(F, l, xcur, 4); phase_moe_route(F, l, xcur); SEAM(pb + 6); }
        if (EN(12) && IN(pb + 7)) { PHASE_FRAME(); REP(12) phase_moe_gather(F, l); SEAM(pb + 7); }
        if (EN(13) && IN(pb + 8)) { PHASE_FRAME(); REP(13) {
            MoeSched S; S.tileE = (const int*)(F.ws + WS_TILEE); S.ntiles = uni(S.tileE[160]); S.npn = 2; S.G = F.G; S.c = blockIdx.x;
            S.A = (const char*)(F.ws + WS_ACT + A_ASORT); S.B = (const char*)(F.ws + WS_WM + W_GU); S.tstepA = (size_t)256 * D * 2; S.tstepB = (size_t)256 * D * 2; S.estride = (size_t)512 * D * 2;
            EpiGateUp E{(bf16*)(F.ws + WS_ACT + A_HID), (const float*)(F.ws + WS_ROWW)};
            pg8::gemm_phase(F.lds, F.tid, D, D, D, S, E);
            }
                SEAM(pb + 8);
        }
        if (EN(14) && IN(pb + 9)) { PHASE_FRAME(); REP(14) {
            MoeSched S; S.tileE = (const int*)(F.ws + WS_TILEE); S.ntiles = uni(S.tileE[160]); S.npn = 4; S.G = F.G; S.c = blockIdx.x;
            S.A = (const char*)(F.ws + WS_ACT + A_HID); S.B = (const char*)(F.ws + WS_WM + W_DN); S.tstepA = (size_t)256 * FEXP * 2; S.tstepB = (size_t)256 * FEXP * 2; S.estride = (size_t)D * FEXP * 2;
            EpiPlain E{(bf16*)(F.ws + WS_ACT + A_YS)};
            pg8::gemm_phase(F.lds, F.tid, FEXP, FEXP, FEXP, S, E);
            }
                SEAM(pb + 9);
        }
    }
    if (EN(15) && IN(N_PHASES - 1)) { PHASE_FRAME(); phase_final(F, X1); }
#undef IN
#undef SEAM
}

typedef void (*kern_t)(Args);
template <int B> static kern_t kern_of_bit(int b) { if (b == B) return mk_fwd<(1 << B)>; if constexpr (B > 0) return kern_of_bit<B - 1>(b); else return nullptr; }
static int kind_of_phase(int p) {
    if (p == 0) return 0; if (p == N_PHASES - 1) return 15;
    const int l = (p - 1) / PH_PER_LAYER, k = (p - 1) % PH_PER_LAYER;
    if (k >= 6) return 11 + (k - 6);
    if ((l & 1) == 0) return 1 + k;
    return (k < 3) ? 7 + k : (k == 3 ? 16 : (k == 4 ? 10 : -1));
}
extern "C" void kernel_launch(void* const* d_in, const int* in_sizes, int n_in, void* d_out, int out_size, void* d_ws, size_t ws_size, hipStream_t stream) {
    static int grid = 0;
    if (grid == 0) {
        if (n_in != 32 || out_size != T * D || ws_size < WS_END) { fprintf(stderr, "kernel_launch: unexpected shapes (n_in %d out %d ws %zu need %zu)\n", n_in, out_size, ws_size, (size_t)WS_END); grid = -1; return; }
        int dev = 0, cus = 0;
        if (hipGetDevice(&dev) != hipSuccess || hipDeviceGetAttribute(&cus, hipDeviceAttributeMultiprocessorCount, dev) != hipSuccess) { grid = -1; return; }
#if ONE_LAUNCH
        if (hipFuncSetAttribute((const void*)mk_fwd<0x1ffff>, hipFuncAttributeMaxDynamicSharedMemorySize, LDS_BYTES) != hipSuccess) { fprintf(stderr, "kernel_launch: hipFuncSetAttribute failed\n"); grid = -1; return; }
#else
        for (int b = 0; b < 17; ++b) if (hipFuncSetAttribute((const void*)kern_of_bit<16>(b), hipFuncAttributeMaxDynamicSharedMemorySize, LDS_BYTES) != hipSuccess) { fprintf(stderr, "kernel_launch: hipFuncSetAttribute failed\n"); grid = -1; return; }
#endif
        (void)hipGetLastError();
        grid = cus;
    }
    if (grid < 0) return;
    (void)hipMemsetAsync((char*)d_ws + WS_CTL, 0, CTL_ZERO_BYTES, stream);
    Args a{};
    for (int i = 0; i < 32; ++i) a.in[i] = (const float*)d_in[i];
    a.out = (float*)d_out; a.ws = (unsigned char*)d_ws;
#if ONE_LAUNCH
#ifndef SPLIT_EVERY
#define SPLIT_EVERY N_PHASES
#endif
    for (int p = 0; p < N_PHASES; p += SPLIT_EVERY) {
        a.ph_lo = p; a.ph_hi = (p + SPLIT_EVERY < N_PHASES) ? p + SPLIT_EVERY : N_PHASES;
        hipLaunchKernelGGL(mk_fwd<0x1ffff>, dim3(grid), dim3(NTHREADS), LDS_BYTES, stream, a);
    }
#else
    for (int p = 0; p < N_PHASES; ++p) {
        const int kind = kind_of_phase(p); if (kind < 0) continue;
        a.ph_lo = p; a.ph_hi = p + 1;
        hipLaunchKernelGGL(kern_of_bit<16>(kind), dim3(grid), dim3(NTHREADS), LDS_BYTES, stream, a);
    }
#endif
}
```

```cpp
#include <hip/hip_runtime.h>
#include <cstdio>
#include <cstdint>

#ifndef ONE_LAUNCH
#define ONE_LAUNCH 1
#endif


#define LAS __attribute__((address_space(3)))
typedef unsigned short bf16;
typedef short bf16x8 __attribute__((ext_vector_type(8)));
typedef float f32x4 __attribute__((ext_vector_type(4)));
typedef float f32x2 __attribute__((ext_vector_type(2)));
typedef unsigned u32x4 __attribute__((ext_vector_type(4)));
typedef unsigned u32x2 __attribute__((ext_vector_type(2)));

constexpr int NB = 8, SEQ = 2048, D = 1024, T = NB * SEQ, DEPTH = 4;
constexpr int NH_R = 16, HD_R = 64;
constexpr int QKVW = 9216;
constexpr int NEXP = 32, FEXP = 256;
constexpr int MAXROWS = 40960;
constexpr int NWAVES = 8, NTHREADS = 512;
constexpr float RMS_EPS = 1e-6f, GN_EPS = 64e-5f;
constexpr float LOG2E = 1.4426950408889634f;

constexpr size_t MiB = 1u << 20;
constexpr size_t WS_CTL = 0, CTL_ZERO_BYTES = 64 * 1024;
constexpr size_t WS_MOD = 1 * MiB;
constexpr size_t WS_TOKE = 2 * MiB;
constexpr size_t WS_TOKR = WS_TOKE + 128 * 1024;
constexpr size_t WS_TOKW = WS_TOKR + 128 * 1024;
constexpr size_t WS_TOKP = WS_TOKW + 128 * 1024;
constexpr size_t WS_ROWW = WS_TOKP + 128 * 1024;
constexpr size_t WS_TILEE = WS_ROWW + 192 * 1024;
constexpr size_t WS_SB = 4 * MiB;
constexpr size_t WS_W = 8 * MiB;
constexpr size_t W_RKV = 0, W_LDN = 6 * MiB, W_LUPWA = 8 * MiB, W_LUPG = 10 * MiB, W_RWO = 11 * MiB, W_RW_STRIDE = 13 * MiB;
constexpr size_t WS_WA = WS_W + 2 * W_RW_STRIDE;
constexpr size_t W_QKV = 0, W_AWO = 18 * MiB, W_AT_STRIDE = 20 * MiB;
constexpr size_t WS_WM = WS_WA + 2 * W_AT_STRIDE;
constexpr size_t W_GU = 0, W_DN = 32 * MiB;
__host__ __device__ constexpr size_t ws_wm_of(int l);
constexpr size_t WS_X1 = 128 * MiB;
constexpr size_t WS_ACT = 192 * MiB;
constexpr size_t A_XS = 0, A_HX = 96 * MiB;
constexpr size_t A_LDEC = 0, A_ASIG = 64 * MiB, A_G = 128 * MiB;
constexpr size_t A_RKV = 192 * MiB;
constexpr size_t A_O = 192 * MiB;
constexpr size_t A_LORAH = 288 * MiB;
constexpr size_t A_Y = 304 * MiB;
constexpr size_t A_H = 0;
constexpr size_t A_Q = 32 * MiB, A_K = 128 * MiB, A_VT = 224 * MiB;
constexpr size_t A_AO = 320 * MiB;
constexpr size_t A_HN2 = 0, A_ASORT = 32 * MiB, A_HID = 112 * MiB, A_YS = 288 * MiB;
static_assert(A_K - A_Q == A_VT - A_K, "q/k/v spacing");
constexpr size_t WS_WM2 = WS_ACT + 368 * MiB;
constexpr size_t WS_END = WS_WM2 + 48 * MiB;

constexpr int CW_BAR = 4096;
constexpr int CW_CNT = 8192;

__host__ __device__ constexpr size_t ws_wm_of(int l) { return (l & 1) ? WS_WM2 : WS_WM; }
constexpr int LDS_BYTES = 163840;
constexpr int LDS_MISC = 159744;
constexpr int MISC_OFF = LDS_MISC + 320;
constexpr int TILEE_OFF = LDS_MISC + 1024;
constexpr int OFFS_OFF = LDS_MISC + 2048;

__device__ __forceinline__ float bf_lo(unsigned u) { return __uint_as_float(u << 16); }
__device__ __forceinline__ float bf_hi(unsigned u) { return __uint_as_float(u & 0xffff0000u); }
__device__ __forceinline__ float bf2f(bf16 v) { return __uint_as_float(((unsigned)v) << 16); }
__device__ __forceinline__ unsigned f2bf(float f) { __bf16 r = (__bf16)f; return (unsigned)__builtin_bit_cast(unsigned short, r); }
__device__ __forceinline__ unsigned pk2(float lo, float hi) { typedef __bf16 b2_t __attribute__((ext_vector_type(2))); typedef float f2_t __attribute__((ext_vector_type(2))); f2_t v = {lo, hi}; b2_t r = __builtin_convertvector(v, b2_t); return __builtin_bit_cast(unsigned, r); }
__device__ __forceinline__ float dpp_ror(float x, const int ctrl_sel) {
    int r;
    if (ctrl_sel == 8) r = __builtin_amdgcn_update_dpp(0, __float_as_int(x), 0x128, 0xf, 0xf, false);
    else if (ctrl_sel == 4) r = __builtin_amdgcn_update_dpp(0, __float_as_int(x), 0x124, 0xf, 0xf, false);
    else if (ctrl_sel == 2) r = __builtin_amdgcn_update_dpp(0, __float_as_int(x), 0x122, 0xf, 0xf, false);
    else r = __builtin_amdgcn_update_dpp(0, __float_as_int(x), 0x121, 0xf, 0xf, false);
    return __int_as_float(r);
}
__device__ __forceinline__ float rowsum16(float x) { x += dpp_ror(x, 8); x += dpp_ror(x, 4); x += dpp_ror(x, 2); x += dpp_ror(x, 1); return x; }
__device__ __forceinline__ float sum8(float x) {
    x += __int_as_float(__builtin_amdgcn_update_dpp(0, __float_as_int(x), 0x141, 0xf, 0xf, false));
    x += __int_as_float(__builtin_amdgcn_update_dpp(0, __float_as_int(x), 0xB1, 0xf, 0xf, false));
    x += __int_as_float(__builtin_amdgcn_update_dpp(0, __float_as_int(x), 0x4E, 0xf, 0xf, false));
    return x;
}
__device__ __forceinline__ float lane_xor(float v, int lane, int o) { return __int_as_float(__builtin_amdgcn_ds_bpermute((lane ^ o) << 2, __float_as_int(v))); }
typedef unsigned v2u_t __attribute__((ext_vector_type(2)));
__device__ __forceinline__ float bfly16_sum(float x) { const v2u_t r = __builtin_amdgcn_permlane16_swap(__float_as_uint(x), __float_as_uint(x), false, false); return __uint_as_float(r[0]) + __uint_as_float(r[1]); }
__device__ __forceinline__ float bfly32_sum(float x) { const v2u_t r = __builtin_amdgcn_permlane32_swap(__float_as_uint(x), __float_as_uint(x), false, false); return __uint_as_float(r[0]) + __uint_as_float(r[1]); }
__device__ __forceinline__ float bfly16_max(float x) { const v2u_t r = __builtin_amdgcn_permlane16_swap(__float_as_uint(x), __float_as_uint(x), false, false); return fmaxf(__uint_as_float(r[0]), __uint_as_float(r[1])); }
__device__ __forceinline__ float bfly32_max(float x) { const v2u_t r = __builtin_amdgcn_permlane32_swap(__float_as_uint(x), __float_as_uint(x), false, false); return fmaxf(__uint_as_float(r[0]), __uint_as_float(r[1])); }
__device__ __forceinline__ float wave_sum(float v, int lane) { (void)lane; v = rowsum16(v); v = bfly16_sum(v); v = bfly32_sum(v); return v; }
__device__ __forceinline__ int lane_id_nh() { int lid; asm volatile("v_mbcnt_lo_u32_b32 %0, -1, 0\n\tv_mbcnt_hi_u32_b32 %0, -1, %0" : "=v"(lid)); return lid; }
__device__ __forceinline__ float sigmoidf_(float x) { return 1.0f / (1.0f + __expf(-x)); }
#define LDS_WAIT() asm volatile("s_waitcnt lgkmcnt(0)" ::: "memory")
#define VM_WAIT() asm volatile("s_waitcnt vmcnt(0)" ::: "memory")

#define XB_TMO      128
#define XB_XCNT(j)  (256  + 64 * (j))
#define XB_XSUB(j)  (1280 + 64 * (j))
#define XB_XGEN(j)  (2304 + 64 * (j))
#define XB_TOP      3328
#define XB_TOPGEN   3392
#define XCD_BAR_WORDS 3456
#define XB_SPIN_CAP (1u << 18)
__device__ __forceinline__ unsigned xb_ld(unsigned* p)              { return __hip_atomic_load(p, __ATOMIC_RELAXED, __HIP_MEMORY_SCOPE_AGENT); }
__device__ __forceinline__ unsigned xb_add(unsigned* p, unsigned v) { return __hip_atomic_fetch_add(p, v, __ATOMIC_RELAXED, __HIP_MEMORY_SCOPE_AGENT); }
__device__ __forceinline__ unsigned xb_xcc_id() { return (unsigned)__builtin_amdgcn_s_getreg((3 << 11) | 20) & 0xFu; }
#define XB_SPIN(cond, bar) do { unsigned _sp = 0; while (cond) { __builtin_amdgcn_s_sleep(1); \
    if ((++_sp & 255u) == 0u) { if (xb_ld(&(bar)[XB_TMO])) break; if (_sp > XB_SPIN_CAP) { atomicAdd(&(bar)[XB_TMO], 1u); break; } } } } while (0)
struct XcdBarrier { unsigned* bar; unsigned x; volatile LAS unsigned* st; };
__device__ __forceinline__ XcdBarrier xcd_barrier_post(unsigned* bar, volatile LAS unsigned* st, bool t0) {
    XcdBarrier b; b.bar = bar; b.x = xb_xcc_id(); b.st = st;
    if (t0) (void)xb_add(&bar[XB_XCNT(b.x)], 1u);
    return b;
}
__device__ __forceinline__ void xcd_barrier_complete(unsigned* bar, unsigned x, unsigned& nloc, unsigned& nx) {
    const unsigned G = gridDim.x * gridDim.y * gridDim.z;
    unsigned sum, cnt, mine, sp = 0u;
    for (;;) {
        sum = 0u; cnt = 0u; mine = 0u;
#pragma clang loop unroll(disable)
        for (unsigned j = 0; j < 16; ++j) { const unsigned c = xb_ld(&bar[XB_XCNT(j)]); sum += c; cnt += (c > 0u) ? 1u : 0u; mine = (j == x) ? c : mine; }
        if (sum == G) break;
        __builtin_amdgcn_s_sleep(1);
        if ((++sp & 255u) == 0u) { if (xb_ld(&bar[XB_TMO])) break; if (sp > XB_SPIN_CAP) { atomicAdd(&bar[XB_TMO], 1u); break; } }
    }
    nloc = mine > 0u ? mine : 1u; nx = cnt > 0u ? cnt : 1u;
}
__device__ __forceinline__ void xcd_barrier(const XcdBarrier& b, bool t0) {
    asm volatile("s_waitcnt vmcnt(0)" ::: "memory");
    __syncthreads();
    if (t0) {
        unsigned* bar = b.bar;
        __builtin_amdgcn_s_waitcnt(0);
        unsigned nloc = b.st[0], nx = b.st[1];
        if (nloc == 0u) { xcd_barrier_complete(bar, b.x, nloc, nx); b.st[0] = nloc; b.st[1] = nx; }
        const unsigned old = xb_add(&bar[XB_XSUB(b.x)], 1u);
        const unsigned gen = old / nloc;
        if (old + 1u == (gen + 1u) * nloc) {
            __builtin_amdgcn_fence(__ATOMIC_RELEASE, "agent");
            asm volatile("s_waitcnt vmcnt(0)" ::: "memory");
            const unsigned og = xb_add(&bar[XB_TOP], 1u);
            const unsigned tg = og / nx;
            if (og + 1u == (tg + 1u) * nx) xb_add(&bar[XB_TOPGEN], 1u);
            else XB_SPIN(xb_ld(&bar[XB_TOPGEN]) == tg, bar);
            __builtin_amdgcn_fence(__ATOMIC_ACQUIRE, "agent");
            xb_add(&bar[XB_XGEN(b.x)], 1u);
            asm volatile("s_waitcnt vmcnt(0)" ::: "memory");
        } else {
            XB_SPIN(xb_ld(&bar[XB_XGEN(b.x)]) == gen, bar);
            __builtin_amdgcn_fence(__ATOMIC_ACQUIRE, "agent");
            asm volatile("s_waitcnt vmcnt(0)" ::: "memory");
        }
    }
    __syncthreads();
}

namespace pg8 {
constexpr int BM = 256, BK = 64, HALF = 128, HTB = HALF * BK * 2, STAGE_BYTES = 8 * HTB;
__device__ __forceinline__ int lds_byte(int r, int c) { const int st = (r >> 4) * 2 + (c >> 5), rr = r & 15, cc = c & 31, ob = rr * 64 + cc * 2; return st * 1024 + (ob ^ (((ob >> 9) & 1) << 5)); }
__device__ __forceinline__ void stage_rc(int b, int& R, int& C) { const int st = b / 1024, sb = b % 1024, swz = sb ^ (((sb >> 9) & 1) << 5); R = (st >> 1) * 16 + swz / 64; C = (st & 1) * 32 + (swz % 64) / 2; }
__device__ __forceinline__ int perm32(int rho) { const int n = rho >> 4, i = rho & 15; return 8 * (i >> 2) + 4 * n + (i & 3); }
struct Unit { int pm, pn; const char* a; const char* b; };
__device__ __forceinline__ unsigned cvt_pk_bf16(float lo, float hi) { unsigned r; asm volatile("v_cvt_pk_bf16_f32 %0, %1, %2" : "=v"(r) : "v"(lo), "v"(hi)); return r; }

template <class Epi, class Sched>
__device__ __forceinline__ void gemm_phase(LAS unsigned char* lds, const int tid, const int K, const int lda, const int ldb, const Sched& S, const Epi& E) {
    const int wid = __builtin_amdgcn_readfirstlane(tid >> 6), lane = tid & 63, wr = wid >> 2, wc = wid & 3, fr = lane & 15, fq = lane >> 4;
    int Kq = K; asm volatile("" : "+s"(Kq));
    const int nt = Kq / BK;
    unsigned voffA[2], voffB[2];
#pragma unroll
    for (int i = 0; i < 2; ++i) { int R, C; stage_rc(tid * 16 + i * 8192, R, C); const int Rb = Epi::PERM ? ((R & ~31) + perm32(R & 31)) : R;
        voffA[i] = (unsigned)(R * lda + C) * 2u; voffB[i] = (unsigned)(Rb * ldb + C) * 2u; }
    const size_t kstep = (size_t)(BK * 2);
    const size_t hstepA = (size_t)HALF * lda * 2, hstepB = (size_t)HALF * ldb * 2;
    const unsigned ldsw = (unsigned)wid * 1024u;
    const int aoff = lds_byte(wr * 64 + fr, fq * 8), boff = lds_byte(wc * 32 + fr, fq * 8);
#define PG8_SA(b, h) (((b) * 2 + (h)) * HTB)
#define PG8_SB(b, h) ((4 + (b) * 2 + (h)) * HTB)
#define PG8_STAGE(bufoff, gbase, voff) do { _Pragma("unroll") for (int _i = 0; _i < 2; ++_i) \
        __builtin_amdgcn_global_load_lds((const unsigned*)((const char*)(gbase) + (voff)[_i]), (LAS unsigned*)(lds + (bufoff) + ldsw + _i * 8192), 16, 0, 0); } while (0)
#define PG8_LDA(dst, b, h) do { _Pragma("unroll") for (int m = 0; m < 4; ++m) _Pragma("unroll") for (int k = 0; k < 2; ++k) dst[m][k] = *(const LAS bf16x8*)(lds + PG8_SA(b, h) + aoff + m * 2048 + k * 1024); } while (0)
#define PG8_LDB(dst, b, h) do { _Pragma("unroll") for (int n = 0; n < 2; ++n) _Pragma("unroll") for (int k = 0; k < 2; ++k) dst[n][k] = *(const LAS bf16x8*)(lds + PG8_SB(b, h) + boff + n * 2048 + k * 1024); } while (0)
#define PG8_MMA(ai, bj, At, Bt) do { __builtin_amdgcn_s_setprio(1); _Pragma("unroll") for (int m = 0; m < 4; ++m) _Pragma("unroll") for (int n = 0; n < 2; ++n) _Pragma("unroll") for (int k = 0; k < 2; ++k) \
        acc[ai][bj][m][n] = __builtin_amdgcn_mfma_f32_16x16x32_bf16(Bt[n][k], At[m][k], acc[ai][bj][m][n], 0, 0, 0); __builtin_amdgcn_s_setprio(0); } while (0)
#define PG8_WAIT_V(n) asm volatile("s_waitcnt vmcnt(" #n ")" ::: "memory")
#define PG8_WAIT_L(n) asm volatile("s_waitcnt lgkmcnt(" #n ")" ::: "memory")
#define PG8_BAR __builtin_amdgcn_s_barrier()
#define PG8_SCHED __builtin_amdgcn_sched_barrier(0)
    Unit cur, nxt; int ui = 0;
    if (!S.next(0, cur)) return;
    f32x4 acc[2][2][4][2];
#pragma unroll
    for (int a = 0; a < 2; ++a)
#pragma unroll
        for (int b = 0; b < 2; ++b)
#pragma unroll
            for (int m = 0; m < 4; ++m)
#pragma unroll
                for (int n = 0; n < 2; ++n) acc[a][b][m][n] = (f32x4){0.f, 0.f, 0.f, 0.f};
    bf16x8 At[4][2], B0[2][2], B1[2][2];
    const char* cA = cur.a; const char* cB = cur.b;
    PG8_STAGE(PG8_SB(0, 0), cB, voffB); PG8_STAGE(PG8_SB(0, 1), cB + hstepB, voffB); PG8_STAGE(PG8_SA(0, 0), cA, voffA); PG8_STAGE(PG8_SA(0, 1), cA + hstepA, voffA);
    if (wr == 1) PG8_BAR;
    PG8_WAIT_V(2); PG8_BAR;
    PG8_STAGE(PG8_SB(1, 0), cB + kstep, voffB); PG8_STAGE(PG8_SA(1, 0), cA + kstep, voffA); PG8_STAGE(PG8_SB(1, 1), cB + hstepB + kstep, voffB);
    PG8_WAIT_V(6); PG8_BAR;
    for (;;) {
        const bool has_next = S.next(ui + 1, nxt);
        const char* nA = has_next ? nxt.a : cA; const char* nB = has_next ? nxt.b : cB;
#pragma clang loop unroll(disable)
        for (int t = 0; t < nt; t += 2) {
            const bool last = (t == nt - 2);
            const char* a1 = cA + (size_t)(t + 1) * kstep;
            const char* a2 = last ? nA : cA + (size_t)(t + 2) * kstep; const char* b2 = last ? nB : cB + (size_t)(t + 2) * kstep;
            const char* a3 = a2 + kstep; const char* b3 = b2 + kstep;
            PG8_LDB(B0, 0, 0); PG8_LDB(B1, 0, 1); PG8_SCHED; PG8_LDA(At, 0, 0); PG8_STAGE(PG8_SA(1, 1), a1 + hstepA, voffA);
            PG8_WAIT_V(8); PG8_WAIT_L(0); PG8_BAR; PG8_MMA(0, 0, At, B0); PG8_MMA(0, 1, At, B1); PG8_BAR; PG8_SCHED;
            PG8_LDA(At, 0, 1); PG8_STAGE(PG8_SB(0, 0), b2, voffB); PG8_STAGE(PG8_SB(0, 1), b2 + hstepB, voffB); PG8_STAGE(PG8_SA(0, 0), a2, voffA);
            PG8_WAIT_V(8); PG8_WAIT_L(0); PG8_BAR; PG8_MMA(1, 0, At, B0); PG8_MMA(1, 1, At, B1); PG8_BAR; PG8_SCHED;
            PG8_LDB(B0, 1, 0); PG8_LDB(B1, 1, 1); PG8_SCHED; PG8_LDA(At, 1, 0); PG8_STAGE(PG8_SA(0, 1), a2 + hstepA, voffA);
            PG8_WAIT_V(8); PG8_WAIT_L(0); PG8_BAR; PG8_MMA(0, 0, At, B0); PG8_MMA(0, 1, At, B1); PG8_BAR; PG8_SCHED;
            PG8_LDA(At, 1, 1); PG8_STAGE(PG8_SB(1, 0), b3, voffB); PG8_STAGE(PG8_SB(1, 1), b3 + hstepB, voffB); PG8_STAGE(PG8_SA(1, 0), a3, voffA);
            PG8_WAIT_V(8); PG8_WAIT_L(0); PG8_BAR; PG8_MMA(1, 0, At, B0); PG8_MMA(1, 1, At, B1); PG8_BAR; PG8_SCHED;
        }
        if (wr == 0) PG8_BAR;
        { int te = tid; asm volatile("" : "+v"(te));
          const int we = __builtin_amdgcn_readfirstlane(te >> 6), le = te & 63;
          E(acc, cur, we >> 2, we & 3, le & 15, le >> 4); }
        if (!has_next) break;
#pragma unroll
        for (int a = 0; a < 2; ++a)
#pragma unroll
            for (int b = 0; b < 2; ++b)
#pragma unroll
                for (int m = 0; m < 4; ++m)
#pragma unroll
                    for (int n = 0; n < 2; ++n) acc[a][b][m][n] = (f32x4){0.f, 0.f, 0.f, 0.f};
        cur = nxt; cA = nA; cB = nB; ++ui;
        if (wr == 1) PG8_BAR;
    }
    PG8_WAIT_V(0);
    PG8_BAR;
#undef PG8_SA
#undef PG8_SB
#undef PG8_STAGE
#undef PG8_LDA
#undef PG8_LDB
#undef PG8_MMA
#undef PG8_WAIT_V
#undef PG8_WAIT_L
#undef PG8_BAR
#undef PG8_SCHED
}

struct GridOrder {
    int nM, nN, nwg, G, c, uneven;
    __device__ __forceinline__ void init(int nM_, int nN_, int G_, int c_) { nM = nM_; nN = nN_; nwg = nM * nN; G = G_; c = c_; uneven = 0; }
    __device__ __forceinline__ bool tile(int i, int& pm, int& pn) const {
        long L = (long)i * G + c;
        if (uneven) {
            if (c < 128) { if (i >= 2) return false; L = i * 128 + c; } else { if (i >= 4) return false; L = 256 + (c - 128) + 128 * i; } }
        if (L >= nwg) return false;
        int wgid = (int)L; { const int q = nwg / 8, r = nwg % 8, xcd = wgid % 8, off = wgid / 8; wgid = (xcd < r ? xcd * (q + 1) : r * (q + 1) + (xcd - r) * q) + off; }
        const int nig = 8 * nN, gid = wgid / nig, fm = gid * 8, gsz = (nM - fm) < 8 ? (nM - fm) : 8;
        pm = fm + ((wgid % nig) % gsz); pn = (wgid % nig) / gsz; return true;
    }
};
}

__device__ __forceinline__ int uni(int v) { return __builtin_amdgcn_readfirstlane(v); }
__device__ __forceinline__ const char* uniptr(const char* p) { const unsigned long long v = (unsigned long long)p; const unsigned lo = __builtin_amdgcn_readfirstlane((unsigned)v), hi = __builtin_amdgcn_readfirstlane((unsigned)(v >> 32)); return (const char*)(((unsigned long long)hi << 32) | lo); }
struct DenseSched {
    pg8::GridOrder o; const char* A; size_t a_sel_stride; int pn_per_a; const char* B; size_t tstepA, tstepB;
    __device__ __forceinline__ bool next(int i, pg8::Unit& u) const {
        if (!o.tile(i, u.pm, u.pn)) return false;
        u.pm = uni(u.pm); u.pn = uni(u.pn);
        u.a = uniptr(A + (size_t)(u.pn / pn_per_a) * a_sel_stride + (size_t)u.pm * tstepA); u.b = uniptr(B + (size_t)u.pn * tstepB); return true;
    }
};
struct MoeSched {
    const int* tileE; int ntiles, npn, G, c; const char* A; const char* B; size_t tstepA, tstepB, estride;
    __device__ __forceinline__ bool next(int i, pg8::Unit& u) const {
        const int L = i * G + c; if (L >= ntiles * npn) return false;
        u.pm = uni(L / npn); u.pn = uni(L % npn);
        const int e = __builtin_amdgcn_readfirstlane(tileE[u.pm]);
        u.a = uniptr(A + (size_t)u.pm * tstepA); u.b = uniptr(B + (size_t)e * estride + (size_t)u.pn * tstepB); return true;
    }
};

using pg8::Unit; using pg8::cvt_pk_bf16;
__device__ __forceinline__ void st8(bf16* p, const f32x4& v0, const f32x4& v1) {
    u32x4 w; w.x = cvt_pk_bf16(v0[0], v0[1]); w.y = cvt_pk_bf16(v0[2], v0[3]); w.z = cvt_pk_bf16(v1[0], v1[1]); w.w = cvt_pk_bf16(v1[2], v1[3]);
    *(u32x4*)p = w;
}
struct EpiSplit {
    static constexpr bool PERM = true;
    bf16* O; size_t split_stride; float scale;
    __device__ __forceinline__ void operator()(const f32x4 (&acc)[2][2][4][2], const Unit& u, int wr, int wc, int fr, int fq) const {
        const int row0 = u.pm * 256 + wr * 64 + fr; const int colt = u.pn * 256; const int t = colt >> 10;
        bf16* base = O + (size_t)t * split_stride; const int col0 = (colt & 1023) + wc * 32 + 8 * fq;
#pragma unroll
        for (int ai = 0; ai < 2; ++ai)
#pragma unroll
            for (int m = 0; m < 4; ++m) { bf16* rowp = base + (size_t)(row0 + ai * 128 + m * 16) * 1024 + col0;
#pragma unroll
                for (int bj = 0; bj < 2; ++bj) st8(rowp + bj * 128, acc[ai][bj][m][0] * scale, acc[ai][bj][m][1] * scale); }
    }
};
struct EpiLoraDn {
    static constexpr bool PERM = true;
    bf16* O;
    __device__ __forceinline__ void operator()(const f32x4 (&acc)[2][2][4][2], const Unit& u, int wr, int wc, int fr, int fq) const {
        const int row0 = u.pm * 256 + wr * 64 + fr; const int col0 = u.pn * 256 + wc * 32 + 8 * fq;
#pragma unroll
        for (int ai = 0; ai < 2; ++ai)
#pragma unroll
            for (int m = 0; m < 4; ++m) { bf16* rowp = O + (size_t)(row0 + ai * 128 + m * 16) * 512 + col0;
#pragma unroll
                for (int bj = 0; bj < 2; ++bj) { f32x4 v0 = acc[ai][bj][m][0], v1 = acc[ai][bj][m][1];
                    const int mode = (u.pn == 1) ? 2 : bj;
                    if (mode == 0) {
#pragma unroll
                        for (int j = 0; j < 4; ++j) { v0[j] = tanhf(v0[j]); v1[j] = tanhf(v1[j]); } }
                    else if (mode == 2) {
#pragma unroll
                        for (int j = 0; j < 4; ++j) { v0[j] = sigmoidf_(v0[j]); v1[j] = sigmoidf_(v1[j]); } }
                    st8(rowp + bj * 128, v0, v1); } }
    }
};
struct EpiLoraUpWA {
    static constexpr bool PERM = true;
    bf16* LD; bf16* AS; const float* w0; const float* a0;
    __device__ __forceinline__ void operator()(const f32x4 (&acc)[2][2][4][2], const Unit& u, int wr, int wc, int fr, int fq) const {
        const int kind = u.pn >> 3, z = (u.pn >> 2) & 1;
        const int row0 = u.pm * 256 + wr * 64 + fr; const int col0 = (u.pn & 3) * 256 + wc * 32 + 8 * fq;
        bf16* base = (kind ? AS : LD) + (size_t)z * T * D; const float* bias = (kind ? a0 : w0) + z * 1024;
        f32x4 bv[2][2];
#pragma unroll
        for (int bj = 0; bj < 2; ++bj)
#pragma unroll
            for (int n = 0; n < 2; ++n) bv[bj][n] = *(const f32x4*)(bias + col0 + bj * 128 + 4 * n);
#pragma unroll
        for (int ai = 0; ai < 2; ++ai)
#pragma unroll
            for (int m = 0; m < 4; ++m) { bf16* rowp = base + (size_t)(row0 + ai * 128 + m * 16) * 1024 + col0;
#pragma unroll
                for (int bj = 0; bj < 2; ++bj) { f32x4 v[2];
#pragma unroll
                    for (int n = 0; n < 2; ++n) { v[n] = acc[ai][bj][m][n] + bv[bj][n];
#pragma unroll
                        for (int j = 0; j < 4; ++j) { const float x = v[n][j];
                            if (kind == 0) v[n][j] = -0.8750612633917001f * sigmoidf_(x);
                            else v[n][j] = sigmoidf_(x); } }
                    st8(rowp + bj * 128, v[0], v[1]); } }
    }
};
struct EpiResid {
    static constexpr bool PERM = true;
    const void* xin; int xin_f32; bf16* out; const float* gate;
    __device__ __forceinline__ void operator()(const f32x4 (&acc)[2][2][4][2], const Unit& u, int wr, int wc, int fr, int fq) const {
        const int row0 = u.pm * 256 + wr * 64 + fr, col0 = u.pn * 256 + wc * 32 + 8 * fq; const int b = u.pm >> 3;
        f32x4 gv[2][2];
#pragma unroll
        for (int bj = 0; bj < 2; ++bj)
#pragma unroll
            for (int n = 0; n < 2; ++n) gv[bj][n] = *(const f32x4*)(gate + (size_t)b * 6144 + col0 + bj * 128 + 4 * n);
#pragma unroll
        for (int ai = 0; ai < 2; ++ai)
#pragma unroll
            for (int m = 0; m < 4; ++m) { const size_t off = (size_t)(row0 + ai * 128 + m * 16) * D + col0;
#pragma unroll
                for (int bj = 0; bj < 2; ++bj) { f32x4 x0, x1;
                    if (xin_f32) { x0 = *(const f32x4*)((const float*)xin + off + bj * 128); x1 = *(const f32x4*)((const float*)xin + off + bj * 128 + 4); }
                    else { const u32x4 r = *(const u32x4*)((const bf16*)xin + off + bj * 128); x0 = (f32x4){bf_lo(r.x), bf_hi(r.x), bf_lo(r.y), bf_hi(r.y)}; x1 = (f32x4){bf_lo(r.z), bf_hi(r.z), bf_lo(r.w), bf_hi(r.w)}; }
                    st8(out + off + bj * 128, x0 + gv[bj][0] * acc[ai][bj][m][0], x1 + gv[bj][1] * acc[ai][bj][m][1]); } }
    }
};
struct EpiQKV {
    static constexpr bool PERM = true;
    bf16* Q; bf16* Kb; bf16* Vb; float qscale;
    __device__ __forceinline__ void operator()(const f32x4 (&acc)[2][2][4][2], const Unit& u, int wr, int wc, int fr, int fq) const {
        const int g = u.pn / 12, which = (u.pn % 12) >> 2, hp = u.pn & 3;
        const int row0 = u.pm * 256 + wr * 64 + fr;
        bf16* base = Q + (size_t)which * ((A_K - A_Q) / 2) + (size_t)g * T * D; const float sc = which ? 1.0f : qscale; const int col0 = hp * 256 + wc * 32 + 8 * fq;
#pragma unroll
        for (int ai = 0; ai < 2; ++ai)
#pragma unroll
            for (int m = 0; m < 4; ++m) { bf16* rowp = base + (size_t)(row0 + ai * 128 + m * 16) * 1024 + col0;
#pragma unroll
                for (int bj = 0; bj < 2; ++bj) st8(rowp + bj * 128, acc[ai][bj][m][0] * sc, acc[ai][bj][m][1] * sc); }
    }
};
struct EpiGateUp {
    static constexpr bool PERM = true;
    bf16* H; const float* roww;
    __device__ __forceinline__ void operator()(const f32x4 (&acc)[2][2][4][2], const Unit& u, int wr, int wc, int fr, int fq) const {
        const int row0 = u.pm * 256 + wr * 64 + fr; const int col0 = u.pn * 128 + wc * 32 + 8 * fq;
#pragma unroll
        for (int ai = 0; ai < 2; ++ai)
#pragma unroll
            for (int m = 0; m < 4; ++m) { const int row = row0 + ai * 128 + m * 16; const float rw = roww[row]; f32x4 v[2];
#pragma unroll
                for (int n = 0; n < 2; ++n)
#pragma unroll
                    for (int j = 0; j < 4; ++j) { const float gg = acc[ai][0][m][n][j], uu = acc[ai][1][m][n][j]; v[n][j] = gg * sigmoidf_(gg) * uu * rw; }
                st8(H + (size_t)row * FEXP + col0, v[0], v[1]); }
    }
};
struct EpiPlain {
    static constexpr bool PERM = true;
    bf16* O;
    __device__ __forceinline__ void operator()(const f32x4 (&acc)[2][2][4][2], const Unit& u, int wr, int wc, int fr, int fq) const {
        const int row0 = u.pm * 256 + wr * 64 + fr; const int col0 = u.pn * 256 + wc * 32 + 8 * fq;
#pragma unroll
        for (int ai = 0; ai < 2; ++ai)
#pragma unroll
            for (int m = 0; m < 4; ++m) { bf16* rowp = O + (size_t)(row0 + ai * 128 + m * 16) * 1024 + col0;
#pragma unroll
                for (int bj = 0; bj < 2; ++bj) st8(rowp + bj * 128, acc[ai][bj][m][0], acc[ai][bj][m][1]); }
    }
};

struct Args {
    const float* in[32]; float* out; unsigned char* ws; int ph_lo, ph_hi;
};
enum { I_X = 0, I_C, I_ADAW, I_ADAB, I_NTM, I_NCM, I_MU, I_WRKV, I_W0, I_W1, I_W2, I_A0, I_A1, I_A2, I_G1, I_G2, I_KK, I_KA, I_RK, I_LNW, I_LNB, I_RWO,
       I_AQKV, I_AWO, I_RG, I_RGB, I_RE, I_REB, I_WG, I_WU, I_WD, I_FG };

struct Frame {
    LAS unsigned char* lds; int tid, lane, wave, G, gw, NGW;
    unsigned char* ws; const float* const* in; float* out;
};

__device__ __forceinline__ void row_load(const float* p, int lane, f32x4 (&v)[4]) {
#pragma unroll
    for (int j = 0; j < 4; ++j) v[j] = *(const f32x4*)(p + 4 * lane + 256 * j);
}
__device__ __forceinline__ void row_load_bf16(const bf16* p, int lane, f32x4 (&v)[4]) {
#pragma unroll
    for (int j = 0; j < 4; ++j) { const u32x2 r = *(const u32x2*)(p + 4 * lane + 256 * j); v[j] = (f32x4){bf_lo(r.x), bf_hi(r.x), bf_lo(r.y), bf_hi(r.y)}; }
}
__device__ __forceinline__ void row_store(float* p, int lane, const f32x4 (&v)[4]) {
#pragma unroll
    for (int j = 0; j < 4; ++j) *(f32x4*)(p + 4 * lane + 256 * j) = v[j];
}
__device__ __forceinline__ void row_store_bf16(bf16* p, int lane, const f32x4 (&v)[4]) {
#pragma unroll
    for (int j = 0; j < 4; ++j) { u32x2 w; w.x = pk2(v[j][0], v[j][1]); w.y = pk2(v[j][2], v[j][3]); *(u32x2*)(p + 4 * lane + 256 * j) = w; }
}
__device__ __forceinline__ void row_combine(f32x4 (&v)[4], const bf16* ys, const int* tokp, int row, const float* gac, int lane) {
    const int p0 = tokp[2 * row], p1 = tokp[2 * row + 1];
    const bf16* y0 = ys + (size_t)p0 * D; const bf16* y1 = ys + (size_t)p1 * D;
#pragma unroll
    for (int j = 0; j < 4; ++j) { const u32x2 a = *(const u32x2*)(y0 + 4 * lane + 256 * j), b = *(const u32x2*)(y1 + 4 * lane + 256 * j); const f32x4 g = *(const f32x4*)(gac + 4 * lane + 256 * j);
        v[j][0] += g[0] * (bf_lo(a.x) + bf_lo(b.x)); v[j][1] += g[1] * (bf_hi(a.x) + bf_hi(b.x)); v[j][2] += g[2] * (bf_lo(a.y) + bf_lo(b.y)); v[j][3] += g[3] * (bf_hi(a.y) + bf_hi(b.y)); }
}
__device__ __forceinline__ void row_norm_mod(const f32x4 (&x)[4], const float* gain, const float* sc, const float* sh, int lane, f32x4 (&h)[4]) {
    float s = 0.f;
#pragma unroll
    for (int j = 0; j < 4; ++j) s += (x[j][0] * x[j][0] + x[j][1] * x[j][1]) + (x[j][2] * x[j][2] + x[j][3] * x[j][3]);
    const float rstd = rsqrtf(wave_sum(s, lane) * (1.0f / D) + RMS_EPS);
#pragma unroll
    for (int j = 0; j < 4; ++j) { const f32x4 g = *(const f32x4*)(gain + 4 * lane + 256 * j), c = *(const f32x4*)(sc + 4 * lane + 256 * j), b = *(const f32x4*)(sh + 4 * lane + 256 * j);
        h[j] = x[j] * rstd * g * (1.0f + c) + b; }
}
__device__ __forceinline__ void transpose_item(const float* W, int ldw, bf16* dst, int ldd, LAS float* scr, int lane) {
    { const int r8 = lane >> 3, c4 = (lane & 7) * 4;
      f32x4 v[8];
#pragma unroll
      for (int i = 0; i < 8; ++i) v[i] = *(const f32x4*)(W + (size_t)(8 * i + r8) * ldw + c4);
#pragma unroll
      for (int i = 0; i < 8; ++i) { LAS float* p = scr + (8 * i + r8) * 33 + c4; p[0] = v[i][0]; p[1] = v[i][1]; p[2] = v[i][2]; p[3] = v[i][3]; } }
    LDS_WAIT(); asm volatile("" ::: "memory");
    const int c = lane & 7;
#pragma unroll
    for (int j = 0; j < 4; ++j) { const int n = (lane >> 3) + 8 * j; const LAS float* s = scr + (8 * c) * 33 + n;
        u32x4 o; o.x = pk2(s[0 * 33], s[1 * 33]); o.y = pk2(s[2 * 33], s[3 * 33]); o.z = pk2(s[4 * 33], s[5 * 33]); o.w = pk2(s[6 * 33], s[7 * 33]);
        *(u32x4*)(dst + (size_t)n * ldd + 8 * c) = o; }
    LDS_WAIT(); asm volatile("" ::: "memory");
}

__device__ __forceinline__ void phase_prologue(Frame& F) {
    const float* c = F.in[I_C]; const float* adaw = F.in[I_ADAW]; const float* adab = F.in[I_ADAB];
    float* mod = (float*)(F.ws + WS_MOD);
    LAS float* sc = (LAS float*)F.lds;
    LAS float* part = (LAS float*)(F.lds + 32768);
    for (int i = F.tid; i < NB * D; i += NTHREADS) { const float v = c[i]; sc[i] = v / (1.0f + __expf(-v)); }
    __syncthreads();
    for (int u = blockIdx.x; u < DEPTH * 96; u += F.G) {
        const int l = u / 96, n0 = (u % 96) * 64, col = n0 + F.lane;
        const float* W = adaw + (size_t)l * D * 6144 + col;
        float acc[8];
#pragma unroll
        for (int b = 0; b < 8; ++b) acc[b] = 0.f;
        const int kbeg = F.wave * 128;
#pragma unroll 8
        for (int k = kbeg; k < kbeg + 128; ++k) { const float w = W[(size_t)k * 6144];
#pragma unroll
            for (int b = 0; b < 8; ++b) acc[b] += sc[b * D + k] * w; }
#pragma unroll
        for (int b = 0; b < 8; ++b) part[(F.wave * 8 + b) * 64 + F.lane] = acc[b];
        __syncthreads();
        { const int b = F.tid >> 6; float s = adab[l * 6144 + col];
#pragma unroll
          for (int w = 0; w < 8; ++w) s += part[(w * 8 + b) * 64 + F.lane];
          mod[(size_t)(l * 8 + b) * 6144 + col] = s; }
        __syncthreads();
    }
    LAS float* scr = (LAS float*)(F.lds + 49152 + F.wave * 8704);
    constexpr int I_SQ = 16 * 32;
    constexpr int I_QKV = 16 * 288;
    constexpr int PER_RW = 4 * I_SQ, PER_AT = I_QKV + I_SQ, NIT = 2 * PER_RW + 2 * PER_AT;
    for (int it = F.gw; it < NIT; it += F.NGW) {
        int r = it;
        if (r < 2 * PER_RW) { const int j = r / PER_RW; r %= PER_RW; const int mi = r / I_SQ; r %= I_SQ; const int kb = r / 32, nb = r % 32;
            if (mi < 3) transpose_item(F.in[I_WRKV] + ((size_t)(j * 3 + mi) * D + kb * 64) * D + nb * 32, D, (bf16*)(F.ws + WS_W + j * W_RW_STRIDE + W_RKV) + (size_t)(mi * D + nb * 32) * D + kb * 64, D, scr, F.lane);
            else transpose_item(F.in[I_RWO] + ((size_t)j * D + kb * 64) * D + nb * 32, D, (bf16*)(F.ws + WS_W + j * W_RW_STRIDE + W_RWO) + (size_t)(nb * 32) * D + kb * 64, D, scr, F.lane);
        } else { r -= 2 * PER_RW; const int j = r / PER_AT; r %= PER_AT;
            if (r < I_QKV) { const int kb = r / 288, nb = r % 288;
                transpose_item(F.in[I_AQKV] + ((size_t)j * D + kb * 64) * QKVW + nb * 32, QKVW, (bf16*)(F.ws + WS_WA + j * W_AT_STRIDE + W_QKV) + (size_t)(nb * 32) * D + kb * 64, D, scr, F.lane); }
            else { r -= I_QKV; const int kb = r / 32, nb = r % 32;
                transpose_item(F.in[I_AWO] + ((size_t)j * D + kb * 64) * D + nb * 32, D, (bf16*)(F.ws + WS_WA + j * W_AT_STRIDE + W_AWO) + (size_t)(nb * 32) * D + kb * 64, D, scr, F.lane); }
        }
    }
    const int gt = blockIdx.x * NTHREADS + F.tid, NGT = F.G * NTHREADS;
    for (int j = 0; j < 2; ++j) {
        bf16* ldn = (bf16*)(F.ws + WS_W + j * W_RW_STRIDE + W_LDN);
        const float* mu = F.in[I_MU] + (size_t)j * 6 * D;
        for (int i = gt; i < 512 * 2048; i += NGT) { const int n = i >> 11, k = i & 2047, kk = k & 1023;
            float v; int mi;
            if (n < 128) { const int z = n >> 6, nn = n & 63; v = F.in[I_W1][((size_t)(j * 2 + z) * D + kk) * 64 + nn]; mi = 3; }
            else if (n < 256) { const int z = (n - 128) >> 6, nn = n & 63; v = F.in[I_A1][((size_t)(j * 2 + z) * D + kk) * 64 + nn]; mi = 4; }
            else { const int z = (n - 256) >> 7, nn = n & 127; v = F.in[I_G1][((size_t)(j * 2 + z) * D + kk) * 128 + nn]; mi = 5; }
            if (k >= 1024) v *= mu[mi * D + kk];
            ldn[i] = (bf16)f2bf(v); }
        bf16* lwa = (bf16*)(F.ws + WS_W + j * W_RW_STRIDE + W_LUPWA);
        for (int i = gt; i < 4096 * 256; i += NGT) { const int n = i >> 8, k = i & 255; const int kind = n >> 11, z = (n >> 10) & 1, col = n & 1023;
            float v = 0.f;
            if ((k >> 6) == kind * 2 + z) v = (kind ? F.in[I_A2] : F.in[I_W2])[((size_t)(j * 2 + z) * 64 + (k & 63)) * D + col];
            lwa[i] = (bf16)f2bf(v); }
        bf16* lg = (bf16*)(F.ws + WS_W + j * W_RW_STRIDE + W_LUPG);
        for (int i = gt; i < 2048 * 256; i += NGT) { const int n = i >> 8, k = i & 255; const int z = n >> 10, col = n & 1023;
            float v = 0.f;
            if ((k >> 7) == z) v = F.in[I_G2][((size_t)(j * 2 + z) * 128 + (k & 127)) * D + col];
            lg[i] = (bf16)f2bf(v); }
    }
}

__device__ __forceinline__ void rw_hrow(Frame& F, int l, bool combine, const void* xsrc, bf16* xdst, bool own, int row, f32x4 (&h)[4]) {
    const int b = row >> 11; const float* mod = (const float*)(F.ws + WS_MOD);
    f32x4 x[4]; if (l == 0) row_load((const float*)xsrc + (size_t)row * D, F.lane, x); else row_load_bf16((const bf16*)xsrc + (size_t)row * D, F.lane, x);
    if (combine) { row_combine(x, (const bf16*)(F.ws + WS_ACT + A_YS), (const int*)(F.ws + WS_TOKP), row, mod + (size_t)((l - 1) * 8 + b) * 6144 + 5 * D, F.lane);
        if (own) row_store_bf16(xdst + (size_t)row * D, F.lane, x); }
    const float* mp = mod + (size_t)(l * 8 + b) * 6144;
    row_norm_mod(x, F.in[I_NTM] + l * D, mp + 1 * D, mp + 0 * D, F.lane, h);
}
__device__ __forceinline__ void phase_rw_norm(Frame& F, int l, bool combine, const void* xsrc, bf16* xdst) {
    const int j = l >> 1; const float* mu = F.in[I_MU] + (size_t)j * 6 * D;
    bf16* xs = (bf16*)(F.ws + WS_ACT + A_XS); bf16* hx = (bf16*)(F.ws + WS_ACT + A_HX);
    for (int ch = F.gw; ch < T / 8; ch += F.NGW) {
        const int row0 = ch * 8, t0 = row0 & (SEQ - 1);
        f32x4 prev[4], cur[4], nxt[4];
        if (t0 > 0) rw_hrow(F, l, combine, xsrc, xdst, false, row0 - 1, prev);
        else {
#pragma unroll
            for (int q = 0; q < 4; ++q) prev[q] = (f32x4){0.f, 0.f, 0.f, 0.f}; }
        rw_hrow(F, l, combine, xsrc, xdst, true, row0, cur);
        for (int i = 0; i < 8; ++i) {
            const int row = row0 + i;
            if (t0 + i + 1 < SEQ) rw_hrow(F, l, combine, xsrc, xdst, i < 7, row + 1, nxt);
            else {
#pragma unroll
                for (int q = 0; q < 4; ++q) nxt[q] = (f32x4){0.f, 0.f, 0.f, 0.f}; }
            f32x4 xx[4];
#pragma unroll
            for (int q = 0; q < 4; ++q) xx[q] = 0.5f * (prev[q] + nxt[q]) - cur[q];
#pragma unroll
            for (int mi = 0; mi < 3; ++mi) { f32x4 o[4];
#pragma unroll
                for (int q = 0; q < 4; ++q) { const f32x4 m = *(const f32x4*)(mu + mi * D + 4 * F.lane + 256 * q); o[q] = cur[q] + xx[q] * m; }
                row_store_bf16(xs + ((size_t)mi * T + row) * D, F.lane, o); }
            row_store_bf16(hx + (size_t)row * 2048, F.lane, cur);
            row_store_bf16(hx + (size_t)row * 2048 + D, F.lane, xx);
#pragma unroll
            for (int q = 0; q < 4; ++q) { prev[q] = cur[q]; cur[q] = nxt[q]; }
        }
    }
}

__device__ __forceinline__ void phase_at_norm(Frame& F, int l, const bf16* xsrc, bf16* xdst) {
    const float* mod = (const float*)(F.ws + WS_MOD); bf16* H = (bf16*)(F.ws + WS_ACT + A_H);
    for (int row = F.gw; row < T; row += F.NGW) {
        const int b = row >> 11; f32x4 x[4], h[4]; row_load_bf16(xsrc + (size_t)row * D, F.lane, x);
        row_combine(x, (const bf16*)(F.ws + WS_ACT + A_YS), (const int*)(F.ws + WS_TOKP), row, mod + (size_t)((l - 1) * 8 + b) * 6144 + 5 * D, F.lane);
        row_store_bf16(xdst + (size_t)row * D, F.lane, x);
        const float* mp = mod + (size_t)(l * 8 + b) * 6144;
        row_norm_mod(x, F.in[I_NTM] + l * D, mp + 1 * D, mp + 0 * D, F.lane, h);
        row_store_bf16(H + (size_t)row * D, F.lane, h);
    }
}
__device__ __forceinline__ void phase_final(Frame& F, const bf16* xsrc) {
    const float* mod = (const float*)(F.ws + WS_MOD); const float* fg = F.in[I_FG];
    for (int row = F.gw; row < T; row += F.NGW) {
        const int b = row >> 11; f32x4 x[4]; row_load_bf16(xsrc + (size_t)row * D, F.lane, x);
        row_combine(x, (const bf16*)(F.ws + WS_ACT + A_YS), (const int*)(F.ws + WS_TOKP), row, mod + (size_t)(3 * 8 + b) * 6144 + 5 * D, F.lane);
        float s = 0.f;
#pragma unroll
        for (int j = 0; j < 4; ++j) s += (x[j][0] * x[j][0] + x[j][1] * x[j][1]) + (x[j][2] * x[j][2] + x[j][3] * x[j][3]);
        const float rstd = rsqrtf(wave_sum(s, F.lane) * (1.0f / D) + RMS_EPS);
#pragma unroll
        for (int j = 0; j < 4; ++j) { const f32x4 g = *(const f32x4*)(fg + 4 * F.lane + 256 * j); x[j] = x[j] * rstd * g; }
        row_store(F.out + (size_t)row * D, F.lane, x);
    }
}

__device__ __forceinline__ void phase_moe_route(Frame& F, int l, const bf16* xsrc, int cnt_shift = 0) {
    const float* mod = (const float*)(F.ws + WS_MOD); bf16* HN = (bf16*)(F.ws + WS_ACT + A_HN2);
    LAS int* lcnt = (LAS int*)F.lds; LAS int* gbase = lcnt + 32; LAS int* inf_e = lcnt + 64; LAS int* inf_r = inf_e + 128; LAS float* inf_w = (LAS float*)(inf_r + 128);
    unsigned* cnt = (unsigned*)(F.ws + WS_CTL) + CW_CNT + (l + cnt_shift) * 32;
    int* toke = (int*)(F.ws + WS_TOKE); int* tokr = (int*)(F.ws + WS_TOKR); float* tokw = (float*)(F.ws + WS_TOKW);
    const float* rg = F.in[I_RG] + (size_t)l * D * 4; const float* rgb = F.in[I_RGB] + l * 4;
    LAS float* RW = (LAS float*)(F.lds + 4096);
    for (int i = F.tid; i < D * 4; i += NTHREADS) RW[(i & 3) * D + (i >> 2)] = rg[i];
    { const float* rea = F.in[I_RE] + (size_t)l * 4 * D * 8;
      for (int i = F.tid; i < 4 * D * 8; i += NTHREADS) RW[(4 + (i >> 13) * 8 + (i & 7)) * D + ((i >> 3) & 1023)] = rea[i]; }
    for (int cb = blockIdx.x; cb < T / 64; cb += F.G) {
        if (F.tid < 32) lcnt[F.tid] = 0;
        __syncthreads();
        for (int i = 0; i < 8; ++i) {
            const int lr = F.wave * 8 + i, row = cb * 64 + lr, b = row >> 11;
            f32x4 x[4], h[4]; row_load_bf16(xsrc + (size_t)row * D, F.lane, x);
            const float* mp = mod + (size_t)(l * 8 + b) * 6144;
            row_norm_mod(x, F.in[I_NCM] + l * D, mp + 4 * D, mp + 3 * D, F.lane, h);
            row_store_bf16(HN + (size_t)row * D, F.lane, h);
            float gl[4] = {0.f, 0.f, 0.f, 0.f};
#pragma unroll
            for (int e = 0; e < 4; ++e)
#pragma unroll
                for (int j = 0; j < 4; ++j) { const f32x4 w = *(const LAS f32x4*)(RW + e * D + 4 * F.lane + 256 * j); gl[e] += (h[j][0] * w[0] + h[j][1] * w[1]) + (h[j][2] * w[2] + h[j][3] * w[3]); }
#pragma unroll
            for (int e = 0; e < 4; ++e) gl[e] = wave_sum(gl[e], F.lane) + rgb[e];
            const float gm = fmaxf(fmaxf(gl[0], gl[1]), fmaxf(gl[2], gl[3]));
            const int gtop = (gl[0] == gm) ? 0 : (gl[1] == gm) ? 1 : (gl[2] == gm) ? 2 : 3;
            const float pg = 1.0f / (__expf(gl[0] - gm) + __expf(gl[1] - gm) + __expf(gl[2] - gm) + __expf(gl[3] - gm));
            const float* reb = F.in[I_REB] + (l * 4 + gtop) * 8; const LAS float* rwe = RW + (4 + gtop * 8) * D + 4 * F.lane;
            float el[8];
#pragma unroll
            for (int e = 0; e < 8; ++e) { el[e] = 0.f;
#pragma unroll
                for (int j = 0; j < 4; ++j) { const f32x4 w = *(const LAS f32x4*)(rwe + e * D + 256 * j); el[e] += (h[j][0] * w[0] + h[j][1] * w[1]) + (h[j][2] * w[2] + h[j][3] * w[3]); } }
#pragma unroll
            for (int e = 0; e < 8; ++e) el[e] = wave_sum(el[e], F.lane) + reb[e];
            float v0 = el[0]; int i0 = 0;
#pragma unroll
            for (int e = 1; e < 8; ++e) if (el[e] > v0) { v0 = el[e]; i0 = e; }
            float v1 = -3.0e38f; int i1 = 0;
#pragma unroll
            for (int e = 0; e < 8; ++e) if (e != i0 && el[e] > v1) { v1 = el[e]; i1 = e; }
            const float ex = __expf(v1 - v0); const float w0 = pg / (1.0f + ex), w1 = pg * ex / (1.0f + ex);
            if (F.lane == 0) {
                const int e0 = gtop * 8 + i0, e1 = gtop * 8 + i1;
                const int r0 = __hip_atomic_fetch_add(lcnt + e0, 1, __ATOMIC_RELAXED, __HIP_MEMORY_SCOPE_WORKGROUP);
                const int r1 = __hip_atomic_fetch_add(lcnt + e1, 1, __ATOMIC_RELAXED, __HIP_MEMORY_SCOPE_WORKGROUP);
                inf_e[lr * 2] = e0; inf_e[lr * 2 + 1] = e1; inf_r[lr * 2] = r0; inf_r[lr * 2 + 1] = r1; inf_w[lr * 2] = w0; inf_w[lr * 2 + 1] = w1;
            }
        }
        __syncthreads();
        if (F.tid < 32) gbase[F.tid] = (int)__hip_atomic_fetch_add(cnt + F.tid, (unsigned)lcnt[F.tid], __ATOMIC_RELAXED, __HIP_MEMORY_SCOPE_AGENT);
        __syncthreads();
        if (F.tid < 128) { const int idx = cb * 128 + F.tid; const int e = inf_e[F.tid]; toke[idx] = e; tokr[idx] = gbase[e] + inf_r[F.tid]; tokw[idx] = inf_w[F.tid]; }
        __syncthreads();
    }
}
__device__ __forceinline__ void moe_tables(Frame& F, int l) {
    LAS int* tileE = (LAS int*)(F.lds + TILEE_OFF); LAS int* offs = (LAS int*)(F.lds + OFFS_OFF);
    const unsigned* cnt = (const unsigned*)(F.ws + WS_CTL) + CW_CNT + l * 32;
    if (F.tid == 0) { int o = 0, nt = 0;
#pragma clang loop unroll(disable)
        for (int e = 0; e < 32; ++e) { const int c = (int)__hip_atomic_load(cnt + e, __ATOMIC_RELAXED, __HIP_MEMORY_SCOPE_AGENT); offs[e] = o; const int ne = (c + 255) >> 8;
#pragma clang loop unroll(disable)
            for (int k = 0; k < ne && nt < 160; ++k) tileE[nt++] = e;
            o += ne * 256; }
        tileE[160] = nt; offs[32] = o; }
    __syncthreads();
}
__device__ __forceinline__ void moe_convert(Frame& F, int l, int first, int stride) {
    LAS float* scr = (LAS float*)(F.lds + 49152 + F.wave * 8704);
    bf16* WGU = (bf16*)(F.ws + ws_wm_of(l) + W_GU); bf16* WDN = (bf16*)(F.ws + ws_wm_of(l) + W_DN);
    constexpr int I_GATE = 16 * 8, I_DOWN = 4 * 32;
    for (int it = first; it < NEXP * (2 * I_GATE + I_DOWN); it += stride) {
        const int e = it / (2 * I_GATE + I_DOWN); int r = it % (2 * I_GATE + I_DOWN);
        if (r < 2 * I_GATE) { const int up = r / I_GATE; r %= I_GATE; const int kb = r / 8, nb = r % 8, n0 = nb * 32;
            const float* src = (up ? F.in[I_WU] : F.in[I_WG]) + ((size_t)(l * 32 + e) * D + kb * 64) * FEXP + n0;
            const int drow = (n0 >> 7) * 256 + up * 128 + (n0 & 127);
            transpose_item(src, FEXP, WGU + ((size_t)e * 512 + drow) * D + kb * 64, D, scr, F.lane);
        } else { r -= 2 * I_GATE; const int kb = r / 32, nb = r % 32;
            const float* src = F.in[I_WD] + ((size_t)(l * 32 + e) * FEXP + kb * 64) * D + nb * 32;
            transpose_item(src, D, WDN + ((size_t)e * D + nb * 32) * FEXP + kb * 64, FEXP, scr, F.lane); }
    }
}
__device__ __forceinline__ void phase_moe_gather(Frame& F, int l) {
    moe_tables(F, l);
    const LAS int* offs = (const LAS int*)(F.lds + OFFS_OFF);
    if (blockIdx.x == 0 && F.tid < 161) ((int*)(F.ws + WS_TILEE))[F.tid] = ((const LAS int*)(F.lds + TILEE_OFF))[F.tid];
    const int* toke = (const int*)(F.ws + WS_TOKE); const int* tokr = (const int*)(F.ws + WS_TOKR); const float* tokw = (const float*)(F.ws + WS_TOKW);
    int* tokp = (int*)(F.ws + WS_TOKP); float* roww = (float*)(F.ws + WS_ROWW);
    const bf16* HN = (const bf16*)(F.ws + WS_ACT + A_HN2); bf16* AS = (bf16*)(F.ws + WS_ACT + A_ASORT);
    for (int idx = F.gw; idx < 2 * T; idx += F.NGW) {
        const int e = toke[idx]; const int pos = offs[e] + tokr[idx];
        if (F.lane == 0) { tokp[idx] = pos; roww[pos] = tokw[idx]; }
        const bf16* src = HN + (size_t)(idx >> 1) * D; bf16* dst = AS + (size_t)pos * D;
        const u32x4 a = *(const u32x4*)(src + 8 * F.lane), b = *(const u32x4*)(src + 512 + 8 * F.lane);
        *(u32x4*)(dst + 8 * F.lane) = a; *(u32x4*)(dst + 512 + 8 * F.lane) = b;
    }
    if (l == 0) moe_convert(F, 0, F.gw, F.NGW);
}

#ifndef SCAN_DUP
#define SCAN_DUP 0
#endif
namespace wk {
constexpr int P = 72, PB = 144, MAT = 64 * PB;
constexpr int PF = 68;
constexpr int O_NAB = 0, O_GS = 17408, O_GC = 19456, O_M0 = 20480;
constexpr int O_AT = O_M0, O_RT = O_AT + MAT, O_BT = O_RT + MAT, O_KT = O_BT + MAT, O_VV = O_KT + MAT, O_LAK = O_VV + MAT, O_MRB = O_LAK + MAT, O_MRK = O_MRB + MAT,
              O_NB = O_MRK + MAT, O_TT = O_NB + MAT, O_XT = O_TT + MAT, O_UT = O_XT + MAT, O_MT = O_UT + MAT, O_H0 = O_MT + MAT, O_H1 = O_H0 + MAT, O_END = O_H1 + MAT;
static_assert(O_END <= LDS_MISC, "scan LDS map");
typedef union { u32x4 u; bf16x8 v; } frag_t;
__device__ __forceinline__ bf16x8 zfrag() { frag_t z; z.u = (u32x4){0u, 0u, 0u, 0u}; return z.v; }
__device__ __forceinline__ bf16x8 ldrow(const LAS unsigned char* M, int row, int col) { return *(const LAS bf16x8*)(M + row * PB + col * 2); }
__device__ __forceinline__ bf16x8 ldtr(unsigned base, int r0, int c0, int lane) {
    const int g = lane >> 4, i = lane & 15, qq = i >> 2, p = i & 3;
    const unsigned a0 = base + (unsigned)((r0 + 8 * g + qq) * PB + (c0 + 4 * p) * 2), a1 = a0 + 4u * PB;
    u32x2 lo, hi;
    asm volatile("ds_read_b64_tr_b16 %0, %2\n\tds_read_b64_tr_b16 %1, %3\n\ts_waitcnt lgkmcnt(0)" : "=&v"(lo), "=&v"(hi) : "v"(a0), "v"(a1) : "memory");
    frag_t f; f.u.x = lo.x; f.u.y = lo.y; f.u.z = hi.x; f.u.w = hi.y; return f.v;
}
__device__ __forceinline__ void st4bf(LAS unsigned char* M, int row, int col, const f32x4& v) { u32x2 w; w.x = pk2(v[0], v[1]); w.y = pk2(v[2], v[3]); *(LAS u32x2*)(M + row * PB + col * 2) = w; }
#define WK_MFMA(a, b, c) __builtin_amdgcn_mfma_f32_16x16x32_bf16(a, b, c, 0, 0, 0)
template <int M> __device__ __forceinline__ float rshare(float v) { return __int_as_float(__builtin_amdgcn_update_dpp(0, __float_as_int(v), 0x150 + M, 0xf, 0xf, false)); }
#define WK_BAR() do { asm volatile("s_waitcnt lgkmcnt(0)" ::: "memory"); __builtin_amdgcn_s_barrier(); asm volatile("" ::: "memory"); } while (0)
}

__device__ __forceinline__ void phase_scan(Frame& F, int l) {
    using namespace wk;
    const int j = l >> 1;
    const bf16* Rb = (const bf16*)(F.ws + WS_ACT + A_RKV); const bf16* Kb = Rb + (size_t)T * D; const bf16* Vb = Kb + (size_t)T * D;
    const bf16* LD = (const bf16*)(F.ws + WS_ACT + A_LDEC); const bf16* AS = (const bf16*)(F.ws + WS_ACT + A_ASIG);
    bf16* Y = (bf16*)(F.ws + WS_ACT + A_Y); float* SB = (float*)(F.ws + WS_SB);
    LAS unsigned char* L = F.lds; const unsigned La = (unsigned)(size_t)L;
    LAS float* NAB = (LAS float*)(L + O_NAB); LAS float* GS = (LAS float*)(L + O_GS); LAS float* GC = (LAS float*)(L + O_GC);
    const int tid0 = F.tid, wave = F.wave;
    for (int unit = blockIdx.x; unit < NB * NH_R * 2; unit += F.G) {
        const int b = unit >> 5, h = (unit >> 1) & 15, dir = unit & 1; const int col = h * 64 + 8 * (tid0 & 7);
        f32x4 kkc[2], kac[2], rkc[2];
#pragma unroll
        for (int e = 0; e < 2; ++e) { kkc[e] = *(const f32x4*)(F.in[I_KK] + j * D + col + 4 * e); kac[e] = *(const f32x4*)(F.in[I_KA] + j * D + col + 4 * e); rkc[e] = *(const f32x4*)(F.in[I_RK] + j * D + col + 4 * e); }
        for (int i = tid0; i < (O_END - O_LAK) / 16; i += NTHREADS) *(LAS u32x4*)(L + O_LAK + i * 16) = (u32x4){0u, 0u, 0u, 0u};
        f32x4 Hs[4];
        f32x4 Yh[4];
#define WK_YFLUSH(cc) do { if (wave >= 4) { const int lane_ = tid0 & 63, qi_ = lane_ & 15, q4_ = lane_ >> 4, vj_ = wave - 4; \
            _Pragma("unroll") for (int ti_ = 0; ti_ < 4; ++ti_) _Pragma("unroll") for (int r_ = 0; r_ < 4; ++r_) { const int st_ = (cc) * 64 + 16 * ti_ + 4 * q4_ + r_; const int t_ = dir ? (SEQ - 1 - st_) : st_; \
                Y[((size_t)dir * T + (size_t)b * SEQ + t_) * D + h * 64 + 16 * vj_ + qi_] = (bf16)f2bf(Yh[ti_][r_]); } } } while (0)
#pragma unroll
        for (int vj = 0; vj < 4; ++vj) Hs[vj] = (f32x4){0.f, 0.f, 0.f, 0.f};
        u32x4 gr, gk, gv, gl, ga;
#define WK_LOAD(c) do { const int st = (c) * 64 + (tid0 >> 3); const int t = dir ? (SEQ - 1 - st) : st; const size_t ro = ((size_t)b * SEQ + t) * D + col; \
            gr = *(const u32x4*)(Rb + ro); gk = *(const u32x4*)(Kb + ro); gv = *(const u32x4*)(Vb + ro); gl = *(const u32x4*)(LD + (size_t)dir * T * D + ro); ga = *(const u32x4*)(AS + (size_t)dir * T * D + ro); } while (0)
        WK_LOAD(0);
        WK_BAR();
        for (int c = 0; c < SEQ / 64; ++c) {
            int tid = tid0; asm volatile("" : "+v"(tid));
            const int lane = tid & 63, qi = lane & 15, q4 = lane >> 4, pt = tid >> 3, c8 = tid & 7;
            LAS unsigned char* H0 = L + ((c & 1) ? O_H1 : O_H0); LAS unsigned char* H1 = L + ((c & 1) ? O_H0 : O_H1);
            for (int sd0_ = 0; sd0_ < 1 + ((SCAN_DUP >> 0) & 1); ++sd0_) {
            float av[8], bv[8], kdv[8], rv[8], ldv[8];
            {
                const unsigned gku[4] = {gk.x, gk.y, gk.z, gk.w}, gru[4] = {gr.x, gr.y, gr.z, gr.w}, glu[4] = {gl.x, gl.y, gl.z, gl.w}, gau[4] = {ga.x, ga.y, ga.z, ga.w};
                float kf[8], af[8], kkv[8]; float ss = 0.f;
#pragma unroll
                for (int e = 0; e < 4; ++e) { kf[2 * e] = bf_lo(gku[e]); kf[2 * e + 1] = bf_hi(gku[e]); rv[2 * e] = bf_lo(gru[e]); rv[2 * e + 1] = bf_hi(gru[e]);
                    ldv[2 * e] = bf_lo(glu[e]); ldv[2 * e + 1] = bf_hi(glu[e]); af[2 * e] = bf_lo(gau[e]); af[2 * e + 1] = bf_hi(gau[e]); }
#pragma unroll
                for (int e = 0; e < 8; ++e) { kkv[e] = kf[e] * kkc[e >> 2][e & 3]; ss += kkv[e] * kkv[e]; }
                ss = sum8(ss);
                const float inv = 1.0f / fmaxf(sqrtf(ss), 1e-12f); float bo = 0.f;
#pragma unroll
                for (int e = 0; e < 8; ++e) { const float kn = kkv[e] * inv; kdv[e] = kf[e] * (1.0f + (af[e] - 1.0f) * kac[e >> 2][e & 3]); av[e] = -kn; bv[e] = kn * af[e]; bo += rv[e] * kdv[e] * rkc[e >> 2][e & 3]; }
                bo = sum8(bo);
                const int st = c * 64 + pt; const int t = dir ? (SEQ - 1 - st) : st;
                if (c8 == 0) SB[((size_t)dir * T + (size_t)b * SEQ + t) * 16 + h] = bo;
                *(LAS f32x4*)(NAB + pt * PF + 8 * c8) = (f32x4){ldv[0], ldv[1], ldv[2], ldv[3]}; *(LAS f32x4*)(NAB + pt * PF + 8 * c8 + 4) = (f32x4){ldv[4], ldv[5], ldv[6], ldv[7]};
                *(LAS u32x4*)(L + O_VV + pt * PB + 16 * c8) = gv;
            }
            if (sd0_ == ((SCAN_DUP >> 0) & 1)) { if (c > 0) WK_YFLUSH(c - 1); if (c + 1 < SEQ / 64) WK_LOAD(c + 1); }
            WK_BAR();
            { const int kc = tid & 63, g = tid >> 6; float pre[8]; float p = 0.f;
#pragma unroll
              for (int i = 0; i < 8; ++i) { p += NAB[(8 * g + i) * PF + kc]; pre[i] = p; }
              GS[g * 64 + kc] = p;
              WK_BAR();
              float off = 0.f;
#pragma unroll
              for (int gg = 0; gg < 7; ++gg) off += (gg < g) ? GS[gg * 64 + kc] : 0.f;
#pragma unroll
              for (int i = 0; i < 8; ++i) NAB[(8 * g + i) * PF + kc] = off + pre[i]; }
            WK_BAR();
            { f32x4 cl[2], cm[2];
#pragma unroll
              for (int e = 0; e < 2; ++e) { cl[e] = *(const LAS f32x4*)(NAB + pt * PF + 8 * c8 + 4 * e); cm[e] = (pt > 0) ? *(const LAS f32x4*)(NAB + (pt - 1) * PF + 8 * c8 + 4 * e) : (f32x4){0.f, 0.f, 0.f, 0.f}; }
              float oa[8], orr[8], ob[8], ok[8];
#pragma unroll
              for (int e = 0; e < 8; ++e) { const float c1 = cl[e >> 2][e & 3], c0 = cm[e >> 2][e & 3]; const float gp = __builtin_amdgcn_exp2f(c1), gn = __builtin_amdgcn_exp2f(-c1), g0 = __builtin_amdgcn_exp2f(c0);
                  oa[e] = av[e] * g0; orr[e] = rv[e] * gp; ob[e] = bv[e] * gn; ok[e] = kdv[e] * gn; if (pt == 63) GC[8 * c8 + e] = gp; }
              *(LAS u32x4*)(L + O_AT + pt * PB + 16 * c8) = (u32x4){pk2(oa[0], oa[1]), pk2(oa[2], oa[3]), pk2(oa[4], oa[5]), pk2(oa[6], oa[7])};
              *(LAS u32x4*)(L + O_RT + pt * PB + 16 * c8) = (u32x4){pk2(orr[0], orr[1]), pk2(orr[2], orr[3]), pk2(orr[4], orr[5]), pk2(orr[6], orr[7])};
              *(LAS u32x4*)(L + O_BT + pt * PB + 16 * c8) = (u32x4){pk2(ob[0], ob[1]), pk2(ob[2], ob[3]), pk2(ob[4], ob[5]), pk2(ob[6], ob[7])};
              *(LAS u32x4*)(L + O_KT + pt * PB + 16 * c8) = (u32x4){pk2(ok[0], ok[1]), pk2(ok[2], ok[3]), pk2(ok[4], ok[5]), pk2(ok[6], ok[7])}; }
            WK_BAR();
            }
            f32x4 X0[4], Y0[4];
            for (int sd1_ = 0; sd1_ < 1 + ((SCAN_DUP >> 1) & 1); ++sd1_) {
#pragma unroll
            for (int jj = 0; jj < 5; ++jj) {
                const int idx = wave * 5 + jj, blk = idx / 10, tri = idx % 10;
                const int ti = (tri >= 6) ? 3 : ((tri >= 3) ? 2 : ((tri >= 1) ? 1 : 0)); const int si = tri - (ti * (ti + 1)) / 2;
                const LAS unsigned char* Pm = L + ((blk < 2) ? O_AT : O_RT); const LAS unsigned char* Qm = L + ((blk & 1) ? O_KT : O_BT);
                f32x4 acc = {0.f, 0.f, 0.f, 0.f};
#pragma unroll
                for (int ks = 0; ks < 2; ++ks) acc = WK_MFMA(ldrow(Qm, 16 * si + qi, 32 * ks + 8 * q4), ldrow(Pm, 16 * ti + qi, 32 * ks + 8 * q4), acc);
                const int tt = 16 * ti + qi, s0 = 16 * si + 4 * q4;
#pragma unroll
                for (int r = 0; r < 4; ++r) { const int sidx = s0 + r; const bool keep = (blk < 2) ? (sidx < tt) : (sidx <= tt); acc[r] = keep ? acc[r] : 0.f; }
                if (blk == 0) { *(LAS f32x4*)(NAB + tt * PF + s0) = acc; st4bf(L + O_NB, tt, s0, acc); }
                else st4bf(L + (blk == 1 ? O_LAK : (blk == 2 ? O_MRB : O_MRK)), tt, s0, acc);
            }
            WK_BAR();
            }
            for (int sd2_ = 0; sd2_ < 1 + ((SCAN_DUP >> 2) & 1); ++sd2_) {
            if (wave >= 4) { const int vj = wave - 4;
#pragma unroll
                for (int ti = 0; ti < 4; ++ti) { X0[ti] = (f32x4){0.f, 0.f, 0.f, 0.f}; Y0[ti] = (f32x4){0.f, 0.f, 0.f, 0.f};
#pragma unroll
                    for (int ks = 0; ks < 2; ++ks) if (ks <= (ti >> 1)) { const bf16x8 vf = ldtr(La + O_VV, 32 * ks, 16 * vj, lane);
                        X0[ti] = WK_MFMA(ldrow(L + O_LAK, 16 * ti + qi, 32 * ks + 8 * q4), vf, X0[ti]); Y0[ti] = WK_MFMA(ldrow(L + O_MRK, 16 * ti + qi, 32 * ks + 8 * q4), vf, Y0[ti]); } } }
            if (wave == 0) {
                const int blk = q4, cj = qi; float nrow[16], x[16];
#pragma unroll
                for (int r = 0; r < 16; ++r) nrow[r] = NAB[(16 * blk + r) * PF + 16 * blk + cj];
#pragma unroll
                for (int r = 0; r < 16; ++r) { float acc = (r == cj) ? 1.0f : 0.0f;
#define WK_SUBM(m) if (m < r) acc += wk::rshare<m>(nrow[r]) * x[m];
                    WK_SUBM(0) WK_SUBM(1) WK_SUBM(2) WK_SUBM(3) WK_SUBM(4) WK_SUBM(5) WK_SUBM(6) WK_SUBM(7) WK_SUBM(8) WK_SUBM(9) WK_SUBM(10) WK_SUBM(11) WK_SUBM(12) WK_SUBM(13) WK_SUBM(14)
#undef WK_SUBM
                    x[r] = acc; *(LAS bf16*)(L + O_TT + (16 * blk + r) * PB + (16 * blk + cj) * 2) = (bf16)f2bf(acc); }
            }
            WK_BAR();
            if (wave < 2) {
                const int i = 2 * wave + 1, jb = 2 * wave;
                bf16x8 a = ldrow(L + O_NB, 16 * i + qi, 16 * jb + 8 * (q4 & 1)), bfr = ldtr(La + O_TT, 16 * jb - 8 * (q4 & 2), 16 * jb, lane);
                if (q4 >= 2) { a = zfrag(); bfr = zfrag(); }
                f32x4 acc = {0.f, 0.f, 0.f, 0.f}; acc = WK_MFMA(a, bfr, acc);
                st4bf(L + O_MT, 16 * wave + qi, 4 * q4, acc);
            }
            WK_BAR();
            if (wave < 2) {
                const int i = 2 * wave + 1, jb = 2 * wave;
                bf16x8 a = ldrow(L + O_TT, 16 * i + qi, 16 * i + 8 * (q4 & 1)), bfr = ldrow(L + O_MT, 16 * wave + qi, 8 * (q4 & 1));
                if (q4 >= 2) { a = zfrag(); bfr = zfrag(); }
                f32x4 acc = {0.f, 0.f, 0.f, 0.f}; acc = WK_MFMA(a, bfr, acc);
#pragma unroll
                for (int r = 0; r < 4; ++r) *(LAS bf16*)(L + O_TT + (16 * i + 4 * q4 + r) * PB + (16 * jb + qi) * 2) = (bf16)f2bf(acc[r]);
            }
            WK_BAR();
            if (wave < 4) {
                const int ti2 = wave >> 1, tj2 = wave & 1;
                f32x4 acc = {0.f, 0.f, 0.f, 0.f}; acc = WK_MFMA(ldrow(L + O_NB, 32 + 16 * ti2 + qi, 8 * q4), ldtr(La + O_TT, 0, 16 * tj2, lane), acc);
                st4bf(L + O_MT, 32 + 16 * tj2 + qi, 16 * ti2 + 4 * q4, acc);
            }
            WK_BAR();
            if (wave < 4) {
                const int ti2 = wave >> 1, tj2 = wave & 1;
                f32x4 acc = {0.f, 0.f, 0.f, 0.f}; acc = WK_MFMA(ldrow(L + O_TT, 32 + 16 * ti2 + qi, 32 + 8 * q4), ldrow(L + O_MT, 32 + 16 * tj2 + qi, 8 * q4), acc);
#pragma unroll
                for (int r = 0; r < 4; ++r) *(LAS bf16*)(L + O_TT + (32 + 16 * ti2 + 4 * q4 + r) * PB + (16 * tj2 + qi) * 2) = (bf16)f2bf(acc[r]);
            }
            }
            for (int sd3_ = 0; sd3_ < 1 + ((SCAN_DUP >> 3) & 1); ++sd3_) {
            if (wave >= 4) { const int vj = wave - 4;
#pragma unroll
                for (int ti = 0; ti < 4; ++ti) { f32x4 acc = X0[ti];
#pragma unroll
                    for (int ks = 0; ks < 2; ++ks) acc = WK_MFMA(ldrow(L + O_AT, 16 * ti + qi, 32 * ks + 8 * q4), ldrow(H0, 16 * vj + qi, 32 * ks + 8 * q4), acc);
                    st4bf(L + O_XT, 16 * vj + qi, 16 * ti + 4 * q4, acc); } }
            WK_BAR();
#pragma unroll
            for (int e = 0; e < 2; ++e) { const int id = wave * 2 + e, ti = id >> 2, vj = id & 3; f32x4 acc = {0.f, 0.f, 0.f, 0.f};
#pragma unroll
                for (int ks = 0; ks < 2; ++ks) if (ks <= (ti >> 1)) acc = WK_MFMA(ldrow(L + O_TT, 16 * ti + qi, 32 * ks + 8 * q4), ldrow(L + O_XT, 16 * vj + qi, 32 * ks + 8 * q4), acc);
                st4bf(L + O_UT, 16 * vj + qi, 16 * ti + 4 * q4, acc); }
            WK_BAR();
            }
            f32x4 Hsave[4]; for (int vj_ = 0; vj_ < 4; ++vj_) Hsave[vj_] = Hs[vj_];
            for (int sd5_ = 0; sd5_ < 1 + ((SCAN_DUP >> 4) & 1); ++sd5_) {
            for (int vj_ = 0; vj_ < 4; ++vj_) Hs[vj_] = Hsave[vj_];
            if (wave >= 4) { const int vj = wave - 4;
#pragma unroll
                for (int ti = 0; ti < 4; ++ti) { f32x4 acc = Y0[ti];
#pragma unroll
                    for (int ks = 0; ks < 2; ++ks) { acc = WK_MFMA(ldrow(L + O_RT, 16 * ti + qi, 32 * ks + 8 * q4), ldrow(H0, 16 * vj + qi, 32 * ks + 8 * q4), acc);
                        if (ks <= (ti >> 1)) acc = WK_MFMA(ldrow(L + O_MRB, 16 * ti + qi, 32 * ks + 8 * q4), ldrow(L + O_UT, 16 * vj + qi, 32 * ks + 8 * q4), acc); }
                    Yh[ti] = acc; } }
            else { const int kt = wave; const f32x4 gc = *(const LAS f32x4*)(GC + 16 * kt + 4 * q4);
#pragma unroll
                for (int ks = 0; ks < 2; ++ks) { const bf16x8 bt = ldtr(La + O_BT, 32 * ks, 16 * kt, lane), ktf = ldtr(La + O_KT, 32 * ks, 16 * kt, lane);
#pragma unroll
                    for (int vj = 0; vj < 4; ++vj) { Hs[vj] = WK_MFMA(bt, ldrow(L + O_UT, 16 * vj + qi, 32 * ks + 8 * q4), Hs[vj]); Hs[vj] = WK_MFMA(ktf, ldtr(La + O_VV, 32 * ks, 16 * vj, lane), Hs[vj]); } }
#pragma unroll
                for (int vj = 0; vj < 4; ++vj) { Hs[vj] = Hs[vj] * gc; st4bf(H1, 16 * vj + qi, 16 * kt + 4 * q4, Hs[vj]); } }
            WK_BAR();
            }
        }
        WK_YFLUSH(SEQ / 64 - 1);
#undef WK_LOAD
#undef WK_YFLUSH
    }
}

__device__ __forceinline__ void phase_rw_post(Frame& F, int l) {
    const int j = l >> 1; const float* lnw = F.in[I_LNW] + j * D; const float* lnb = F.in[I_LNB] + j * D;
    const bf16* Vb = (const bf16*)(F.ws + WS_ACT + A_RKV) + (size_t)2 * T * D; const bf16* Y = (const bf16*)(F.ws + WS_ACT + A_Y); const bf16* Gb = (const bf16*)(F.ws + WS_ACT + A_G);
    const float* SB = (const float*)(F.ws + WS_SB); bf16* O = (bf16*)(F.ws + WS_ACT + A_O);
    for (int row = F.gw; row < T; row += F.NGW) {
        f32x4 o[4];
#pragma unroll
        for (int q = 0; q < 4; ++q) {
            const int c = 4 * F.lane + 256 * q; const int head = 4 * q + (F.lane >> 4);
            const u32x2 vr = *(const u32x2*)(Vb + (size_t)row * D + c); const f32x4 vf = {bf_lo(vr.x), bf_hi(vr.x), bf_lo(vr.y), bf_hi(vr.y)};
            const f32x4 w = *(const f32x4*)(lnw + c), bb = *(const f32x4*)(lnb + c);
            f32x4 acc = {0.f, 0.f, 0.f, 0.f};
#pragma unroll
            for (int dir = 0; dir < 2; ++dir) {
                const size_t ro = ((size_t)dir * T + row) * D + c;
                const u32x2 yr = *(const u32x2*)(Y + ro), gr = *(const u32x2*)(Gb + ro);
                const f32x4 yf = {bf_lo(yr.x), bf_hi(yr.x), bf_lo(yr.y), bf_hi(yr.y)}; const f32x4 gf = {bf_lo(gr.x), bf_hi(gr.x), bf_lo(gr.y), bf_hi(gr.y)};
                const float sbv = SB[((size_t)dir * T + row) * 16 + head];
                const float mean = rowsum16((yf[0] + yf[1]) + (yf[2] + yf[3])) * (1.0f / 64.0f);
                const f32x4 d = yf - mean; const float var = rowsum16((d[0] * d[0] + d[1] * d[1]) + (d[2] * d[2] + d[3] * d[3])) * (1.0f / 64.0f);
                const float rs = rsqrtf(var + GN_EPS);
                acc += gf * (d * rs * w + bb + sbv * vf);
            }
            o[q] = acc;
        }
        row_store_bf16(O + (size_t)row * D, F.lane, o);
    }
}

__device__ __forceinline__ unsigned att_f(unsigned row) { return ((row & 3u) << 2) | ((row >> 2) & 3u); }
__device__ __forceinline__ unsigned att_off_b(unsigned row, unsigned ch) { return 256u * row + 16u * (ch ^ att_f(row)); }
__device__ __forceinline__ void phase_attn(Frame& F, bool dry = false) {
    bf16* Qb = (bf16*)(F.ws + WS_ACT + A_Q); const bf16* Kb = (const bf16*)(F.ws + WS_ACT + A_K); const bf16* Vb = (const bf16*)(F.ws + WS_ACT + A_VT);
    float* LSE = (float*)(F.ws + WS_SB);
    const int lane = F.lane, qi = lane & 15, q4 = lane >> 4, wave = F.wave;
    LAS unsigned char* KW = F.lds; LAS unsigned char* VW = F.lds + 65536;
    const unsigned vw_a = (unsigned)(size_t)VW;
    unsigned ka[2][4], va[8][2];
#pragma unroll
    for (int rb = 0; rb < 2; ++rb)
#pragma unroll
        for (int s = 0; s < 4; ++s) ka[rb][s] = att_off_b((unsigned)(qi + 16 * rb), (unsigned)(4 * s + q4));
    { const unsigned q = (unsigned)qi >> 2, p = (unsigned)lane & 3u;
#pragma unroll
      for (int c = 0; c < 8; ++c)
#pragma unroll
          for (int t = 0; t < 2; ++t) va[c][t] = vw_a + att_off_b(8u * q4 + 4u * t + q, 2u * c + (p >> 1)) + 8u * (p & 1u); }
    unsigned fk[8];
#pragma unroll
    for (int i = 0; i < 8; ++i) { const unsigned rho = 4u * i + (unsigned)q4, m = rho & 15u, rb = rho >> 4; const unsigned kidx = 8u * (m >> 2) + (m & 3u) + 4u * rb;
        fk[i] = kidx | ((16u * ((unsigned)qi ^ att_f(rho))) << 8); }
    const int nper = (F.G >= 8) ? (F.G >> 3) : 1;
    for (int k = (F.G >= 8 && (F.G & 7) == 0) ? (int)(blockIdx.x >> 3) : (int)blockIdx.x; k < ((F.G >= 8 && (F.G & 7) == 0) ? 3 * NB * 16 : 3 * NB * 8 * 16); k += ((F.G >= 8 && (F.G & 7) == 0) ? nper : F.G)) {
        int g, b, hs, cc;
        if (F.G >= 8 && (F.G & 7) == 0) { hs = blockIdx.x & 7; cc = k & 15; b = (k >> 4) & 7; g = k >> 7; }
        else { g = k >> 10; b = (k >> 7) & 7; hs = (k >> 4) & 7; cc = k & 15; }
        const int dsh = 2 * g, Lg = SEQ >> dsh; const int cls = (g == 0) ? 0 : ((g == 1) ? (cc >> 2) : cc); const int chunk = (g == 0) ? cc : ((g == 1) ? (cc & 3) : 0);
        const int P0 = 128 * chunk;
        asm volatile("s_waitcnt lgkmcnt(0)" ::: "memory"); __builtin_amdgcn_s_barrier(); asm volatile("" ::: "memory");
        { const int base_ = P0 - 64 + 32 * wave;
          const bf16* ksrc = Kb + ((size_t)g * T + (size_t)b * SEQ) * D + hs * 128; const bf16* vsrc = Vb + ((size_t)g * T + (size_t)b * SEQ) * D + hs * 128;
#pragma unroll
          for (int i = 0; i < 8; ++i) { const int pk = min(max(base_ + (int)(fk[i] & 255u), 0), Lg - 1), pv = min(max(base_ + 4 * i + q4, 0), Lg - 1);
              __builtin_amdgcn_global_load_lds((const unsigned*)((const char*)(ksrc + (size_t)(cls + (pk << dsh)) * D) + (fk[i] >> 8)), (LAS unsigned*)(KW + wave * 8192 + i * 1024), 16, 0, 0);
              __builtin_amdgcn_global_load_lds((const unsigned*)((const char*)(vsrc + (size_t)(cls + (pv << dsh)) * D) + (fk[i] >> 8)), (LAS unsigned*)(VW + wave * 8192 + i * 1024), 16, 0, 0); } }
        const int Pq = P0 + 16 * wave + qi; const size_t qrow = (size_t)g * T + (size_t)b * SEQ + (size_t)(cls + (Pq << dsh));
        bf16* qp = Qb + qrow * D + hs * 128;
        bf16x8 Qf[4];
#pragma unroll
        for (int kt = 0; kt < 4; ++kt) Qf[kt] = *(const bf16x8*)(qp + 8 * q4 + 32 * kt);
        const float slope2 = exp2f(-8.0f * (float)(g * 8 + hs + 1) / 24.0f) * LOG2E * (float)(1 << dsh);
        float m_run = -1e30f, l_run = 0.f; f32x4 O[8];
#pragma unroll
        for (int dt = 0; dt < 8; ++dt) O[dt] = (f32x4){0.f, 0.f, 0.f, 0.f};
        asm volatile("s_waitcnt vmcnt(0)" ::: "memory"); __builtin_amdgcn_s_barrier(); asm volatile("" ::: "memory");
#pragma unroll
        for (int s = 0; s < 5; ++s) {
            const int tb = (wave >> 1) + s; const LAS unsigned char* kl = KW + tb * 8192; const unsigned voff = (unsigned)tb * 8192u;
            bf16x8 KA[4], KB[4];
#pragma unroll
            for (int kt = 0; kt < 4; ++kt) { KA[kt] = *(const LAS bf16x8*)(kl + ka[0][kt]); KB[kt] = *(const LAS bf16x8*)(kl + ka[1][kt]); }
            f32x4 SA = {0.f, 0.f, 0.f, 0.f}, SBt = {0.f, 0.f, 0.f, 0.f};
#pragma unroll
            for (int kt = 0; kt < 4; ++kt) { SA = __builtin_amdgcn_mfma_f32_16x16x32_bf16(KA[kt], Qf[kt], SA, 0, 0, 0); SBt = __builtin_amdgcn_mfma_f32_16x16x32_bf16(KB[kt], Qf[kt], SBt, 0, 0, 0); }
            const int cb = P0 - 64 + 32 * tb + 8 * q4;
            float sv[8]; bool ok[8]; float mx = -1e30f;
#pragma unroll
            for (int r = 0; r < 8; ++r) { const int p = cb + r; const int rel = abs(p - Pq); ok[r] = (p >= 0) && (p < Lg) && (rel <= 64);
                const float sc = (r < 4 ? SA[r & 3] : SBt[r & 3]) - slope2 * (float)rel; sv[r] = ok[r] ? sc : -1e30f; mx = fmaxf(mx, sv[r]); }
            mx = bfly16_max(mx); mx = bfly32_max(mx);
            const float m_new = fmaxf(m_run, mx); const float alpha = __builtin_amdgcn_exp2f(m_run - m_new); m_run = m_new;
            float pe[8]; float rs = 0.f;
#pragma unroll
            for (int r = 0; r < 8; ++r) { pe[r] = ok[r] ? __builtin_amdgcn_exp2f(sv[r] - m_new) : 0.f; rs += pe[r]; }
            rs = bfly16_sum(rs); rs = bfly32_sum(rs);
            l_run = l_run * alpha + rs;
            union { u32x4 u; bf16x8 v; } pf; pf.u.x = pk2(pe[0], pe[1]); pf.u.y = pk2(pe[2], pe[3]); pf.u.z = pk2(pe[4], pe[5]); pf.u.w = pk2(pe[6], pe[7]);
#pragma unroll
            for (int hf = 0; hf < 2; ++hf) {
                u32x2 vr[4][2];
                asm volatile("ds_read_b64_tr_b16 %0, %8\n\tds_read_b64_tr_b16 %1, %9\n\tds_read_b64_tr_b16 %2, %10\n\tds_read_b64_tr_b16 %3, %11\n\t"
                             "ds_read_b64_tr_b16 %4, %12\n\tds_read_b64_tr_b16 %5, %13\n\tds_read_b64_tr_b16 %6, %14\n\tds_read_b64_tr_b16 %7, %15\n\ts_waitcnt lgkmcnt(0)"
                             : "=&v"(vr[0][0]), "=&v"(vr[0][1]), "=&v"(vr[1][0]), "=&v"(vr[1][1]), "=&v"(vr[2][0]), "=&v"(vr[2][1]), "=&v"(vr[3][0]), "=&v"(vr[3][1])
                             : "v"(va[4 * hf + 0][0] + voff), "v"(va[4 * hf + 0][1] + voff), "v"(va[4 * hf + 1][0] + voff), "v"(va[4 * hf + 1][1] + voff), "v"(va[4 * hf + 2][0] + voff), "v"(va[4 * hf + 2][1] + voff), "v"(va[4 * hf + 3][0] + voff), "v"(va[4 * hf + 3][1] + voff)
                             : "memory");
#pragma unroll
                for (int c = 0; c < 4; ++c) { const int dt = 4 * hf + c; union { u32x4 u; bf16x8 v; } vf; vf.u.x = vr[c][0].x; vf.u.y = vr[c][0].y; vf.u.z = vr[c][1].x; vf.u.w = vr[c][1].y;
                    O[dt] = O[dt] * alpha; O[dt] = __builtin_amdgcn_mfma_f32_16x16x32_bf16(vf.v, pf.v, O[dt], 0, 0, 0); }
            }
        }
        const float inv = 1.0f / l_run;
#pragma unroll
        for (int dt = 0; dt < 8; ++dt) { u32x2 o; o.x = pk2(O[dt][0] * inv, O[dt][1] * inv); o.y = pk2(O[dt][2] * inv, O[dt][3] * inv); if (!dry) *(u32x2*)(qp + 4 * q4 + 16 * dt) = o; else asm volatile("" :: "v"(o.x), "v"(o.y)); }
        if (q4 == 0 && !dry) LSE[qrow * 8 + hs] = m_run + __builtin_amdgcn_logf(l_run);
    }
}
__device__ __forceinline__ void phase_attn_merge(Frame& F) {
    const bf16* Ob = (const bf16*)(F.ws + WS_ACT + A_Q); const float* LSE = (const float*)(F.ws + WS_SB); bf16* AO = (bf16*)(F.ws + WS_ACT + A_AO);
    for (int row = F.gw; row < T; row += F.NGW) {
        f32x4 o[4];
#pragma unroll
        for (int q = 0; q < 4; ++q) { const int c = 4 * F.lane + 256 * q; const int head = 2 * q + (F.lane >> 5);
            float ls[3];
#pragma unroll
            for (int g = 0; g < 3; ++g) ls[g] = LSE[((size_t)g * T + row) * 8 + head];
            const float mx = fmaxf(ls[0], fmaxf(ls[1], ls[2]));
            float w[3]; float sum = 0.f;
#pragma unroll
            for (int g = 0; g < 3; ++g) { w[g] = __builtin_amdgcn_exp2f(ls[g] - mx); sum += w[g]; }
            const float inv = 1.0f / sum; f32x4 acc = {0.f, 0.f, 0.f, 0.f};
#pragma unroll
            for (int g = 0; g < 3; ++g) { const u32x2 r = *(const u32x2*)(Ob + ((size_t)g * T + row) * D + c); const float a = w[g] * inv;
                acc[0] += a * bf_lo(r.x); acc[1] += a * bf_hi(r.x); acc[2] += a * bf_lo(r.y); acc[3] += a * bf_hi(r.y); }
            o[q] = acc; }
        row_store_bf16(AO + (size_t)row * D, F.lane, o);
    }
}

constexpr int PH_PER_LAYER = 10, N_PHASES = 1 + DEPTH * PH_PER_LAYER + 1;
template <int MASK> __global__ void __launch_bounds__(NTHREADS, 2) mk_fwd(Args args) {
    extern __shared__ __attribute__((aligned(16))) unsigned char lds_raw[];
#define PHASE_FRAME() Frame F; { int t_ = wave0 * 64 + lane_id_nh(); asm volatile("" : "+v"(t_)); size_t z_ = 0; asm volatile("" : "+s"(z_)); unsigned char* w_ = args.ws + z_;     \
        unsigned lb_ = 0; asm volatile("" : "+s"(lb_)); F.lds = (LAS unsigned char*)lds_raw + lb_; F.tid = t_; F.lane = t_ & 63; F.wave = __builtin_amdgcn_readfirstlane(t_ >> 6); \
        F.G = gridDim.x; F.gw = blockIdx.x * NWAVES + F.wave; F.NGW = F.G * NWAVES; F.ws = w_; F.in = args.in; F.out = args.out; }
    LAS unsigned char* lds0 = (LAS unsigned char*)lds_raw;
    const int wave0 = __builtin_amdgcn_readfirstlane((int)threadIdx.x >> 6);
    volatile LAS unsigned* MISC = (volatile LAS unsigned*)(lds0 + MISC_OFF);
    if (wave0 == 0) ((LAS unsigned*)(lds0 + LDS_MISC))[lane_id_nh() + 64] = 0u;
    __syncthreads();
    unsigned* ctl = (unsigned*)(args.ws + WS_CTL);
    XcdBarrier bar; bar.bar = ctl + CW_BAR; bar.x = 0; bar.st = nullptr;
#if ONE_LAUNCH
    bar = xcd_barrier_post(ctl + CW_BAR, MISC + 8, wave0 == 0 && lane_id_nh() == 0);
#endif
    const int lo = args.ph_lo, hi = args.ph_hi;
#define EN(b) ((MASK >> (b)) & 1)
#ifndef DUP_MASK
#define DUP_MASK 0
#endif
#define REP(b) for (int rep_ = 0; rep_ < 1 + ((DUP_MASK >> (b)) & 1); ++rep_)
#define IN(k) (lo <= (k) && (k) < hi)
#if ONE_LAUNCH
#ifndef BAR_REP
#define BAR_REP 1
#endif
#define SEAM(k) do { if (IN((k) + 1) || (k) + 1 < hi) { for (int br_ = 0; br_ < BAR_REP; ++br_) xcd_barrier(bar, wave0 == 0 && lane_id_nh() == 0); } } while (0)
#else
#define SEAM(k) do { } while (0)
#endif
    bf16* X0 = (bf16*)(args.ws + WS_X1); bf16* X1 = X0 + (size_t)T * D;
    if (EN(0) && IN(0)) { PHASE_FRAME(); REP(0) phase_prologue(F); SEAM(0); }
    for (int l = 0; l < DEPTH; ++l) {
        const int pb = 1 + l * PH_PER_LAYER; const int j = l >> 1;
        const void* xin = (l == 0) ? (const void*)args.in[I_X] : (const void*)((l & 1) ? X0 : X1);
        bf16* xcur = (l == 0) ? X0 : ((l & 1) ? X1 : X0);
        if ((l & 1) == 0) {
            if (EN(1) && IN(pb + 0)) { PHASE_FRAME(); REP(1) phase_rw_norm(F, l, l > 0, xin, xcur); SEAM(pb + 0); }
            if (EN(2) && IN(pb + 1)) { PHASE_FRAME(); REP(2) {
                { DenseSched S; S.o.init(T / 256, 2, F.G, blockIdx.x); S.A = (const char*)(F.ws + WS_ACT + A_HX); S.a_sel_stride = 0; S.pn_per_a = 1 << 20;
                  S.B = (const char*)(F.ws + WS_W + j * W_RW_STRIDE + W_LDN); S.tstepA = (size_t)256 * 2048 * 2; S.tstepB = (size_t)256 * 2048 * 2;
                  EpiLoraDn E{(bf16*)(F.ws + WS_ACT + A_LORAH)};
                  pg8::gemm_phase(F.lds, F.tid, 2048, 2048, 2048, S, E); }
                { DenseSched S; S.o.init(T / 256, 12, F.G, blockIdx.x); S.o.uneven = (F.G == 256); S.A = (const char*)(F.ws + WS_ACT + A_XS); S.a_sel_stride = (size_t)T * D * 2; S.pn_per_a = 4;
                  S.B = (const char*)(F.ws + WS_W + j * W_RW_STRIDE + W_RKV); S.tstepA = (size_t)256 * D * 2; S.tstepB = (size_t)256 * D * 2;
                  EpiSplit E{(bf16*)(F.ws + WS_ACT + A_RKV), (size_t)T * D, 1.0f};
                  pg8::gemm_phase(F.lds, F.tid, D, D, D, S, E); }
                }
                SEAM(pb + 1);
            }
            if (EN(3) && IN(pb + 2)) { PHASE_FRAME(); REP(3) {
                { DenseSched S; S.o.init(T / 256, 16, F.G, blockIdx.x); S.A = (const char*)(F.ws + WS_ACT + A_LORAH); S.a_sel_stride = 0; S.pn_per_a = 1 << 20;
                  S.B = (const char*)(F.ws + WS_W + j * W_RW_STRIDE + W_LUPWA); S.tstepA = (size_t)256 * 512 * 2; S.tstepB = (size_t)256 * 256 * 2;
                  EpiLoraUpWA E{(bf16*)(F.ws + WS_ACT + A_LDEC), (bf16*)(F.ws + WS_ACT + A_ASIG), F.in[I_W0] + j * 2 * D, F.in[I_A0] + j * 2 * D};
                  pg8::gemm_phase(F.lds, F.tid, 256, 512, 256, S, E); }
                { DenseSched S; S.o.init(T / 256, 8, F.G, blockIdx.x); S.A = (const char*)(F.ws + WS_ACT + A_LORAH) + 512; S.a_sel_stride = 0; S.pn_per_a = 1 << 20;
                  S.B = (const char*)(F.ws + WS_W + j * W_RW_STRIDE + W_LUPG); S.tstepA = (size_t)256 * 512 * 2; S.tstepB = (size_t)256 * 256 * 2;
                  EpiSplit E{(bf16*)(F.ws + WS_ACT + A_G), (size_t)T * D, 1.0f};
                  pg8::gemm_phase(F.lds, F.tid, 256, 512, 256, S, E); }
                }
                SEAM(pb + 2);
            }
            if (EN(4) && IN(pb + 3)) { PHASE_FRAME(); REP(4) phase_scan(F, l); SEAM(pb + 3); }
            if (EN(5) && IN(pb + 4)) { PHASE_FRAME(); REP(5) phase_rw_post(F, l); SEAM(pb + 4); }
            if (EN(6) && IN(pb + 5)) { PHASE_FRAME();
                DenseSched S; S.o.init(T / 256, 4, F.G, blockIdx.x); S.A = (const char*)(F.ws + WS_ACT + A_O); S.a_sel_stride = 0; S.pn_per_a = 1 << 20;
                S.B = (const char*)(F.ws + WS_W + j * W_RW_STRIDE + W_RWO); S.tstepA = (size_t)256 * D * 2; S.tstepB = (size_t)256 * D * 2;
                EpiResid E{(l == 0) ? (const void*)F.in[I_X] : (const void*)xcur, (l == 0) ? 1 : 0, xcur, (const float*)(F.ws + WS_MOD) + (size_t)l * 8 * 6144 + 2 * D};
                pg8::gemm_phase(F.lds, F.tid, D, D, D, S, E);
                SEAM(pb + 5);
            }
        } else {
            if (EN(7) && IN(pb + 0)) { PHASE_FRAME(); REP(7) phase_at_norm(F, l, (const bf16*)xin, xcur); SEAM(pb + 0); }
            if (EN(8) && IN(pb + 1)) { PHASE_FRAME(); REP(8) {
                DenseSched S; S.o.init(T / 256, 36, F.G, blockIdx.x); S.A = (const char*)(F.ws + WS_ACT + A_H); S.a_sel_stride = 0; S.pn_per_a = 1 << 20;
                S.B = (const char*)(F.ws + WS_WA + j * W_AT_STRIDE + W_QKV); S.tstepA = (size_t)256 * D * 2; S.tstepB = (size_t)256 * D * 2;
                EpiQKV E{(bf16*)(F.ws + WS_ACT + A_Q), (bf16*)(F.ws + WS_ACT + A_K), (bf16*)(F.ws + WS_ACT + A_VT), 0.08838834764831845f * LOG2E};
                pg8::gemm_phase(F.lds, F.tid, D, D, D, S, E);
                }
                SEAM(pb + 1);
            }
            if (EN(9) && IN(pb + 2)) { PHASE_FRAME(); if ((DUP_MASK >> 9) & 1) phase_attn(F, true); phase_attn(F); SEAM(pb + 2); }
            if (EN(16) && IN(pb + 3)) { PHASE_FRAME(); REP(16) phase_attn_merge(F); SEAM(pb + 3); }
            if (EN(10) && IN(pb + 4)) { PHASE_FRAME();
                DenseSched S; S.o.init(T / 256, 4, F.G, blockIdx.x); S.A = (const char*)(F.ws + WS_ACT + A_AO); S.a_sel_stride = 0; S.pn_per_a = 1 << 20;
                S.B = (const char*)(F.ws + WS_WA + j * W_AT_STRIDE + W_AWO); S.tstepA = (size_t)256 * D * 2; S.tstepB = (size_t)256 * D * 2;
                EpiResid E{(const void*)xcur, 0, xcur, (const float*)(F.ws + WS_MOD) + (size_t)l * 8 * 6144 + 2 * D};
                pg8::gemm_phase(F.lds, F.tid, D, D, D, S, E);
                SEAM(pb + 4);
            }
        }
        if (EN(11) && IN(pb + 6)) { PHASE_FRAME(); if ((DUP_MASK >> 11) & 1) phase_moe_route(F, l, xcur, 4); phase_moe_route(F, l, xcur); SEAM(pb + 6); }
        if (EN(12) && IN(pb + 7)) { PHASE_FRAME(); REP(12) phase_moe_gather(F, l); SEAM(pb + 7); }
        if (EN(13) && IN(pb + 8)) { PHASE_FRAME(); REP(13) {
            MoeSched S; S.tileE = (const int*)(F.ws + WS_TILEE); S.ntiles = uni(S.tileE[160]); S.npn = 2; S.G = F.G; S.c = blockIdx.x;
            S.A = (const char*)(F.ws + WS_ACT + A_ASORT); S.B = (const char*)(F.ws + ws_wm_of(l) + W_GU); S.tstepA = (size_t)256 * D * 2; S.tstepB = (size_t)256 * D * 2; S.estride = (size_t)512 * D * 2;
            EpiGateUp E{(bf16*)(F.ws + WS_ACT + A_HID), (const float*)(F.ws + WS_ROWW)};
            pg8::gemm_phase(F.lds, F.tid, D, D, D, S, E);
            if (l + 1 < DEPTH) {
                const int nun = S.ntiles * 2, firstb = (nun > F.G) ? (nun - F.G) : 0;
                if ((int)blockIdx.x >= firstb) moe_convert(F, l + 1, ((int)blockIdx.x - firstb) * NWAVES + F.wave, (F.G - firstb) * NWAVES);
            }
            }
                SEAM(pb + 8);
        }
        if (EN(14) && IN(pb + 9)) { PHASE_FRAME(); REP(14) {
            MoeSched S; S.tileE = (const int*)(F.ws + WS_TILEE); S.ntiles = uni(S.tileE[160]); S.npn = 4; S.G = F.G; S.c = blockIdx.x;
            S.A = (const char*)(F.ws + WS_ACT + A_HID); S.B = (const char*)(F.ws + ws_wm_of(l) + W_DN); S.tstepA = (size_t)256 * FEXP * 2; S.tstepB = (size_t)256 * FEXP * 2; S.estride = (size_t)D * FEXP * 2;
            EpiPlain E{(bf16*)(F.ws + WS_ACT + A_YS)};
            pg8::gemm_phase(F.lds, F.tid, FEXP, FEXP, FEXP, S, E);
            }
                SEAM(pb + 9);
        }
    }
    if (EN(15) && IN(N_PHASES - 1)) { PHASE_FRAME(); phase_final(F, X1); }
#undef IN
#undef SEAM
}

typedef void (*kern_t)(Args);
template <int B> static kern_t kern_of_bit(int b) { if (b == B) return mk_fwd<(1 << B)>; if constexpr (B > 0) return kern_of_bit<B - 1>(b); else return nullptr; }
static int kind_of_phase(int p) {
    if (p == 0) return 0; if (p == N_PHASES - 1) return 15;
    const int l = (p - 1) / PH_PER_LAYER, k = (p - 1) % PH_PER_LAYER;
    if (k >= 6) return 11 + (k - 6);
    if ((l & 1) == 0) return 1 + k;
    return (k < 3) ? 7 + k : (k == 3 ? 16 : (k == 4 ? 10 : -1));
}
extern "C" void kernel_launch(void* const* d_in, const int* in_sizes, int n_in, void* d_out, int out_size, void* d_ws, size_t ws_size, hipStream_t stream) {
    static int grid = 0;
    if (grid == 0) {
        if (n_in != 32 || out_size != T * D || ws_size < WS_END) { fprintf(stderr, "kernel_launch: unexpected shapes (n_in %d out %d ws %zu need %zu)\n", n_in, out_size, ws_size, (size_t)WS_END); grid = -1; return; }
        int dev = 0, cus = 0;
        if (hipGetDevice(&dev) != hipSuccess || hipDeviceGetAttribute(&cus, hipDeviceAttributeMultiprocessorCount, dev) != hipSuccess) { grid = -1; return; }
#if ONE_LAUNCH
        if (hipFuncSetAttribute((const void*)mk_fwd<0x1ffff>, hipFuncAttributeMaxDynamicSharedMemorySize, LDS_BYTES) != hipSuccess) { fprintf(stderr, "kernel_launch: hipFuncSetAttribute failed\n"); grid = -1; return; }
#else
        for (int b = 0; b < 17; ++b) if (hipFuncSetAttribute((const void*)kern_of_bit<16>(b), hipFuncAttributeMaxDynamicSharedMemorySize, LDS_BYTES) != hipSuccess) { fprintf(stderr, "kernel_launch: hipFuncSetAttribute failed\n"); grid = -1; return; }
#endif
        (void)hipGetLastError();
        grid = cus;
    }
    if (grid < 0) return;
    (void)hipMemsetAsync((char*)d_ws + WS_CTL, 0, CTL_ZERO_BYTES, stream);
    Args a{};
    for (int i = 0; i < 32; ++i) a.in[i] = (const float*)d_in[i];
    a.out = (float*)d_out; a.ws = (unsigned char*)d_ws;
#if ONE_LAUNCH
#ifndef SPLIT_EVERY
#define SPLIT_EVERY N_PHASES
#endif
    for (int p = 0; p < N_PHASES; p += SPLIT_EVERY) {
        a.ph_lo = p; a.ph_hi = (p + SPLIT_EVERY < N_PHASES) ? p + SPLIT_EVERY : N_PHASES;
        hipLaunchKernelGGL(mk_fwd<0x1ffff>, dim3(grid), dim3(NTHREADS), LDS_BYTES, stream, a);
    }
#else
    for (int p = 0; p < N_PHASES; ++p) {
        const int kind = kind_of_phase(p); if (kind < 0) continue;
        a.ph_lo = p; a.ph_hi = p + 1;
        hipLaunchKernelGGL(kern_of_bit<16>(kind), dim3(grid), dim3(NTHREADS), LDS_BYTES, stream, a);
    }
#endif
}
```

```cpp
#include <hip/hip_runtime.h>
#include <cstdio>
#include <cstdint>

#ifndef ONE_LAUNCH
#define ONE_LAUNCH 1
#endif


#define LAS __attribute__((address_space(3)))
typedef unsigned short bf16;
typedef short bf16x8 __attribute__((ext_vector_type(8)));
typedef float f32x4 __attribute__((ext_vector_type(4)));
typedef float f32x2 __attribute__((ext_vector_type(2)));
typedef unsigned u32x4 __attribute__((ext_vector_type(4)));
typedef unsigned u32x2 __attribute__((ext_vector_type(2)));

constexpr int NB = 8, SEQ = 2048, D = 1024, T = NB * SEQ, DEPTH = 4;
constexpr int NH_R = 16, HD_R = 64;
constexpr int QKVW = 9216;
constexpr int NEXP = 32, FEXP = 256;
constexpr int MAXROWS = 40960;
constexpr int NWAVES = 8, NTHREADS = 512;
constexpr float RMS_EPS = 1e-6f, GN_EPS = 64e-5f;
constexpr float LOG2E = 1.4426950408889634f;

constexpr size_t MiB = 1u << 20;
constexpr size_t WS_CTL = 0, CTL_ZERO_BYTES = 64 * 1024;
constexpr size_t WS_MOD = 1 * MiB;
constexpr size_t WS_TOKE = 2 * MiB;
constexpr size_t WS_TOKR = WS_TOKE + 128 * 1024;
constexpr size_t WS_TOKW = WS_TOKR + 128 * 1024;
constexpr size_t WS_TOKP = WS_TOKW + 128 * 1024;
constexpr size_t WS_ROWW = WS_TOKP + 128 * 1024;
constexpr size_t WS_TILEE = WS_ROWW + 192 * 1024;
constexpr size_t WS_ROWT = WS_TILEE + 4096;
constexpr size_t WS_SB = 4 * MiB;
constexpr size_t WS_SA = WS_SB + 1536 * 1024;
constexpr size_t WS_W = 8 * MiB;
constexpr size_t W_RKV = 0, W_LDN = 6 * MiB, W_LUPWA = 8 * MiB, W_LUPG = 10 * MiB, W_RWO = 11 * MiB, W_RW_STRIDE = 13 * MiB;
constexpr size_t WS_WA = WS_W + 2 * W_RW_STRIDE;
constexpr size_t W_QKV = 0, W_QKVS = 9 * MiB, W_AWO = 18 * MiB, W_AT_STRIDE = 20 * MiB;
constexpr size_t WS_WM = WS_WA + 2 * W_AT_STRIDE;
constexpr size_t W_GU = 0, W_DN = 32 * MiB;
__host__ __device__ constexpr size_t ws_wm_of(int l);
constexpr size_t WS_X1 = 128 * MiB;
constexpr size_t WS_ACT = 192 * MiB;
constexpr size_t A_XS = 0, A_HX = 96 * MiB;
constexpr size_t A_LDEC = 0, A_ASIG = 64 * MiB, A_G = 128 * MiB;
constexpr size_t A_RKV = 192 * MiB;
constexpr size_t A_O = 192 * MiB;
constexpr size_t A_LORAH = 288 * MiB;
constexpr size_t A_Y = 304 * MiB;
constexpr size_t A_H = 0;
constexpr size_t A_Q = 32 * MiB, A_K = 128 * MiB, A_VT = 224 * MiB;
constexpr size_t A_AO = 320 * MiB;
constexpr size_t A_HN2 = 0, A_ASORT = 32 * MiB, A_HID = 112 * MiB, A_YS = 288 * MiB;
static_assert(A_K - A_Q == A_VT - A_K, "q/k/v spacing");
constexpr size_t WS_WM2 = WS_ACT + 368 * MiB;
constexpr size_t WS_END = WS_WM2 + 48 * MiB;

constexpr int CW_BAR = 4096;
constexpr int CW_CNT = 8192;

__host__ __device__ constexpr size_t ws_wm_of(int l) { return (l & 1) ? WS_WM2 : WS_WM; }
constexpr int LDS_BYTES = 163840;
constexpr int LDS_MISC = 159744;
constexpr int MISC_OFF = LDS_MISC + 320;
constexpr int TILEE_OFF = LDS_MISC + 1024;
constexpr int OFFS_OFF = LDS_MISC + 2048;

__device__ __forceinline__ float bf_lo(unsigned u) { return __uint_as_float(u << 16); }
__device__ __forceinline__ float bf_hi(unsigned u) { return __uint_as_float(u & 0xffff0000u); }
__device__ __forceinline__ float bf2f(bf16 v) { return __uint_as_float(((unsigned)v) << 16); }
__device__ __forceinline__ unsigned f2bf(float f) { __bf16 r = (__bf16)f; return (unsigned)__builtin_bit_cast(unsigned short, r); }
__device__ __forceinline__ unsigned pk2(float lo, float hi) { typedef __bf16 b2_t __attribute__((ext_vector_type(2))); typedef float f2_t __attribute__((ext_vector_type(2))); f2_t v = {lo, hi}; b2_t r = __builtin_convertvector(v, b2_t); return __builtin_bit_cast(unsigned, r); }
__device__ __forceinline__ float dpp_ror(float x, const int ctrl_sel) {
    int r;
    if (ctrl_sel == 8) r = __builtin_amdgcn_update_dpp(0, __float_as_int(x), 0x128, 0xf, 0xf, false);
    else if (ctrl_sel == 4) r = __builtin_amdgcn_update_dpp(0, __float_as_int(x), 0x124, 0xf, 0xf, false);
    else if (ctrl_sel == 2) r = __builtin_amdgcn_update_dpp(0, __float_as_int(x), 0x122, 0xf, 0xf, false);
    else r = __builtin_amdgcn_update_dpp(0, __float_as_int(x), 0x121, 0xf, 0xf, false);
    return __int_as_float(r);
}
__device__ __forceinline__ float rowsum16(float x) { x += dpp_ror(x, 8); x += dpp_ror(x, 4); x += dpp_ror(x, 2); x += dpp_ror(x, 1); return x; }
__device__ __forceinline__ float sum8(float x) {
    x += __int_as_float(__builtin_amdgcn_update_dpp(0, __float_as_int(x), 0x141, 0xf, 0xf, false));
    x += __int_as_float(__builtin_amdgcn_update_dpp(0, __float_as_int(x), 0xB1, 0xf, 0xf, false));
    x += __int_as_float(__builtin_amdgcn_update_dpp(0, __float_as_int(x), 0x4E, 0xf, 0xf, false));
    return x;
}
__device__ __forceinline__ float lane_xor(float v, int lane, int o) { return __int_as_float(__builtin_amdgcn_ds_bpermute((lane ^ o) << 2, __float_as_int(v))); }
typedef unsigned v2u_t __attribute__((ext_vector_type(2)));
__device__ __forceinline__ float bfly16_sum(float x) { const v2u_t r = __builtin_amdgcn_permlane16_swap(__float_as_uint(x), __float_as_uint(x), false, false); return __uint_as_float(r[0]) + __uint_as_float(r[1]); }
__device__ __forceinline__ float bfly32_sum(float x) { const v2u_t r = __builtin_amdgcn_permlane32_swap(__float_as_uint(x), __float_as_uint(x), false, false); return __uint_as_float(r[0]) + __uint_as_float(r[1]); }
__device__ __forceinline__ float bfly16_max(float x) { const v2u_t r = __builtin_amdgcn_permlane16_swap(__float_as_uint(x), __float_as_uint(x), false, false); return fmaxf(__uint_as_float(r[0]), __uint_as_float(r[1])); }
__device__ __forceinline__ float bfly32_max(float x) { const v2u_t r = __builtin_amdgcn_permlane32_swap(__float_as_uint(x), __float_as_uint(x), false, false); return fmaxf(__uint_as_float(r[0]), __uint_as_float(r[1])); }
__device__ __forceinline__ float wave_max(float x) {
    x = fmaxf(x, dpp_ror(x, 8)); x = fmaxf(x, dpp_ror(x, 4)); x = fmaxf(x, dpp_ror(x, 2)); x = fmaxf(x, dpp_ror(x, 1)); x = bfly16_max(x); return bfly32_max(x);
}
__device__ __forceinline__ unsigned pack_i8x4(const f32x4& v, float inv) {
    const int q0 = (int)__builtin_rintf(fminf(fmaxf(v[0] * inv, -127.f), 127.f)), q1 = (int)__builtin_rintf(fminf(fmaxf(v[1] * inv, -127.f), 127.f));
    const int q2 = (int)__builtin_rintf(fminf(fmaxf(v[2] * inv, -127.f), 127.f)), q3 = (int)__builtin_rintf(fminf(fmaxf(v[3] * inv, -127.f), 127.f));
    return (unsigned)(q0 & 255) | ((unsigned)(q1 & 255) << 8) | ((unsigned)(q2 & 255) << 16) | ((unsigned)q3 << 24);
}
__device__ __forceinline__ float wave_sum(float v, int lane) { (void)lane; v = rowsum16(v); v = bfly16_sum(v); v = bfly32_sum(v); return v; }
__device__ __forceinline__ int lane_id_nh() { int lid; asm volatile("v_mbcnt_lo_u32_b32 %0, -1, 0\n\tv_mbcnt_hi_u32_b32 %0, -1, %0" : "=v"(lid)); return lid; }
__device__ __forceinline__ float sigmoidf_(float x) { return 1.0f / (1.0f + __expf(-x)); }
#define LDS_WAIT() asm volatile("s_waitcnt lgkmcnt(0)" ::: "memory")
#define VM_WAIT() asm volatile("s_waitcnt vmcnt(0)" ::: "memory")

#define XB_TMO      128
#define XB_XCNT(j)  (256  + 64 * (j))
#define XB_XSUB(j)  (1280 + 64 * (j))
#define XB_XGEN(j)  (2304 + 64 * (j))
#define XB_TOP      3328
#define XB_TOPGEN   3392
#define XCD_BAR_WORDS 3456
#define XB_SPIN_CAP (1u << 18)
__device__ __forceinline__ unsigned xb_ld(unsigned* p)              { return __hip_atomic_load(p, __ATOMIC_RELAXED, __HIP_MEMORY_SCOPE_AGENT); }
__device__ __forceinline__ unsigned xb_add(unsigned* p, unsigned v) { return __hip_atomic_fetch_add(p, v, __ATOMIC_RELAXED, __HIP_MEMORY_SCOPE_AGENT); }
__device__ __forceinline__ unsigned xb_xcc_id() { return (unsigned)__builtin_amdgcn_s_getreg((3 << 11) | 20) & 0xFu; }
#define XB_SPIN(cond, bar) do { unsigned _sp = 0; while (cond) { __builtin_amdgcn_s_sleep(1); \
    if ((++_sp & 255u) == 0u) { if (xb_ld(&(bar)[XB_TMO])) break; if (_sp > XB_SPIN_CAP) { atomicAdd(&(bar)[XB_TMO], 1u); break; } } } } while (0)
struct XcdBarrier { unsigned* bar; unsigned x; volatile LAS unsigned* st; };
__device__ __forceinline__ XcdBarrier xcd_barrier_post(unsigned* bar, volatile LAS unsigned* st, bool t0) {
    XcdBarrier b; b.bar = bar; b.x = xb_xcc_id(); b.st = st;
    if (t0) (void)xb_add(&bar[XB_XCNT(b.x)], 1u);
    return b;
}
__device__ __forceinline__ void xcd_barrier_complete(unsigned* bar, unsigned x, unsigned& nloc, unsigned& nx) {
    const unsigned G = gridDim.x * gridDim.y * gridDim.z;
    unsigned sum, cnt, mine, sp = 0u;
    for (;;) {
        sum = 0u; cnt = 0u; mine = 0u;
#pragma clang loop unroll(disable)
        for (unsigned j = 0; j < 16; ++j) { const unsigned c = xb_ld(&bar[XB_XCNT(j)]); sum += c; cnt += (c > 0u) ? 1u : 0u; mine = (j == x) ? c : mine; }
        if (sum == G) break;
        __builtin_amdgcn_s_sleep(1);
        if ((++sp & 255u) == 0u) { if (xb_ld(&bar[XB_TMO])) break; if (sp > XB_SPIN_CAP) { atomicAdd(&bar[XB_TMO], 1u); break; } }
    }
    nloc = mine > 0u ? mine : 1u; nx = cnt > 0u ? cnt : 1u;
}
__device__ __forceinline__ void xcd_barrier(const XcdBarrier& b, bool t0) {
    asm volatile("s_waitcnt vmcnt(0)" ::: "memory");
    __syncthreads();
    if (t0) {
        unsigned* bar = b.bar;
        __builtin_amdgcn_s_waitcnt(0);
        unsigned nloc = b.st[0], nx = b.st[1];
        if (nloc == 0u) { xcd_barrier_complete(bar, b.x, nloc, nx); b.st[0] = nloc; b.st[1] = nx; }
        const unsigned old = xb_add(&bar[XB_XSUB(b.x)], 1u);
        const unsigned gen = old / nloc;
        if (old + 1u == (gen + 1u) * nloc) {
            __builtin_amdgcn_fence(__ATOMIC_RELEASE, "agent");
            asm volatile("s_waitcnt vmcnt(0)" ::: "memory");
            const unsigned og = xb_add(&bar[XB_TOP], 1u);
            const unsigned tg = og / nx;
            if (og + 1u == (tg + 1u) * nx) xb_add(&bar[XB_TOPGEN], 1u);
            else XB_SPIN(xb_ld(&bar[XB_TOPGEN]) == tg, bar);
            __builtin_amdgcn_fence(__ATOMIC_ACQUIRE, "agent");
            xb_add(&bar[XB_XGEN(b.x)], 1u);
            asm volatile("s_waitcnt vmcnt(0)" ::: "memory");
        } else {
            XB_SPIN(xb_ld(&bar[XB_XGEN(b.x)]) == gen, bar);
            __builtin_amdgcn_fence(__ATOMIC_ACQUIRE, "agent");
            asm volatile("s_waitcnt vmcnt(0)" ::: "memory");
        }
    }
    __syncthreads();
}

namespace pg8 {
constexpr int BM = 256, BK = 64, HALF = 128, HTB = HALF * BK * 2, STAGE_BYTES = 8 * HTB;
__device__ __forceinline__ int lds_byte(int r, int c) { const int st = (r >> 4) * 2 + (c >> 5), rr = r & 15, cc = c & 31, ob = rr * 64 + cc * 2; return st * 1024 + (ob ^ (((ob >> 9) & 1) << 5)); }
__device__ __forceinline__ void stage_rc(int b, int& R, int& C) { const int st = b / 1024, sb = b % 1024, swz = sb ^ (((sb >> 9) & 1) << 5); R = (st >> 1) * 16 + swz / 64; C = (st & 1) * 32 + (swz % 64) / 2; }
__device__ __forceinline__ int perm32(int rho) { const int n = rho >> 4, i = rho & 15; return 8 * (i >> 2) + 4 * n + (i & 3); }
struct Unit { int pm, pn; const char* a; const char* b; };
__device__ __forceinline__ unsigned cvt_pk_bf16(float lo, float hi) { unsigned r; asm volatile("v_cvt_pk_bf16_f32 %0, %1, %2" : "=v"(r) : "v"(lo), "v"(hi)); return r; }

typedef int i32x4 __attribute__((ext_vector_type(4)));
template <bool I8> struct OpT { typedef bf16x8 frag; typedef f32x4 acc; };
template <> struct OpT<true> { typedef i32x4 frag; typedef i32x4 acc; };
__device__ __forceinline__ f32x4 mma16(const bf16x8& a, const bf16x8& b, const f32x4& c) { return __builtin_amdgcn_mfma_f32_16x16x32_bf16(a, b, c, 0, 0, 0); }
__device__ __forceinline__ i32x4 mma16(const i32x4& a, const i32x4& b, const i32x4& c) { return __builtin_amdgcn_mfma_i32_16x16x64_i8(a, b, c, 0, 0, 0); }
template <class Epi, class Sched>
__device__ __forceinline__ void gemm_phase(LAS unsigned char* lds, const int tid, const int K, const int lda, const int ldb, const Sched& S, const Epi& E) {
    const int wid = __builtin_amdgcn_readfirstlane(tid >> 6), lane = tid & 63, wr = wid >> 2, wc = wid & 3, fr = lane & 15, fq = lane >> 4;
    int Kq = K; asm volatile("" : "+s"(Kq));
    constexpr bool I8 = Epi::I8; constexpr int EB = I8 ? 1 : 2;
    typedef typename OpT<I8>::frag frag_t; typedef typename OpT<I8>::acc acc_t;
    const int nt = Kq * EB / (BK * 2);
    unsigned voffC[2][2], voffN[2][2], voffB[2]; int RA[2], CA[2];
#pragma unroll
    for (int i = 0; i < 2; ++i) { int R, C; stage_rc(tid * 16 + i * 8192, R, C); const int Rb = Epi::PERM ? ((R & ~31) + perm32(R & 31)) : R; RA[i] = R; CA[i] = C;
        voffB[i] = (unsigned)(Rb * ldb * EB + C * 2); }
#define PG8_AOFF(dst, ui_) do { _Pragma("unroll") for (int h_ = 0; h_ < 2; ++h_) _Pragma("unroll") for (int i_ = 0; i_ < 2; ++i_) { \
        if constexpr (Sched::GATHER) dst[h_][i_] = (unsigned)(S.row_of(ui_, h_ * HALF + RA[i_]) * lda * EB + CA[i_] * 2); else dst[h_][i_] = (unsigned)((h_ * HALF + RA[i_]) * lda * EB + CA[i_] * 2); } } while (0)
    const size_t kstep = (size_t)(BK * 2);
    const size_t hstepB = (size_t)HALF * ldb * EB;
    const unsigned ldsw = (unsigned)wid * 1024u;
    const int aoff = lds_byte(wr * 64 + fr, fq * 8), boff = lds_byte(wc * 32 + fr, fq * 8);
#define PG8_SA(b, h) (((b) * 2 + (h)) * HTB)
#define PG8_SB(b, h) ((4 + (b) * 2 + (h)) * HTB)
#define PG8_STAGE(bufoff, gbase, voff) do { _Pragma("unroll") for (int _i = 0; _i < 2; ++_i) \
        __builtin_amdgcn_global_load_lds((const unsigned*)((const char*)(gbase) + (voff)[_i]), (LAS unsigned*)(lds + (bufoff) + ldsw + _i * 8192), 16, 0, 0); } while (0)
#define PG8_LDA(dst, b, h) do { _Pragma("unroll") for (int m = 0; m < 4; ++m) _Pragma("unroll") for (int k = 0; k < 2; ++k) dst[m][k] = *(const LAS frag_t*)(lds + PG8_SA(b, h) + aoff + m * 2048 + k * 1024); } while (0)
#define PG8_LDB(dst, b, h) do { _Pragma("unroll") for (int n = 0; n < 2; ++n) _Pragma("unroll") for (int k = 0; k < 2; ++k) dst[n][k] = *(const LAS frag_t*)(lds + PG8_SB(b, h) + boff + n * 2048 + k * 1024); } while (0)
#define PG8_MMA(ai, bj, At, Bt) do { __builtin_amdgcn_s_setprio(1); _Pragma("unroll") for (int m = 0; m < 4; ++m) _Pragma("unroll") for (int n = 0; n < 2; ++n) _Pragma("unroll") for (int k = 0; k < 2; ++k) \
        acc[ai][bj][m][n] = mma16(Bt[n][k], At[m][k], acc[ai][bj][m][n]); __builtin_amdgcn_s_setprio(0); } while (0)
#define PG8_WAIT_V(n) asm volatile("s_waitcnt vmcnt(" #n ")" ::: "memory")
#define PG8_WAIT_L(n) asm volatile("s_waitcnt lgkmcnt(" #n ")" ::: "memory")
#define PG8_BAR __builtin_amdgcn_s_barrier()
#define PG8_SCHED __builtin_amdgcn_sched_barrier(0)
    Unit cur, nxt; int ui = 0;
    if (!S.next(0, cur)) return;
    acc_t acc[2][2][4][2];
#pragma unroll
    for (int a = 0; a < 2; ++a)
#pragma unroll
        for (int b = 0; b < 2; ++b)
#pragma unroll
            for (int m = 0; m < 4; ++m)
#pragma unroll
                for (int n = 0; n < 2; ++n) acc[a][b][m][n] = (acc_t){0, 0, 0, 0};
    frag_t At[4][2], B0[2][2], B1[2][2];
    const char* cA = cur.a; const char* cB = cur.b;
    PG8_AOFF(voffC, 0); PG8_AOFF(voffN, 0);
    PG8_STAGE(PG8_SB(0, 0), cB, voffB); PG8_STAGE(PG8_SB(0, 1), cB + hstepB, voffB); PG8_STAGE(PG8_SA(0, 0), cA, voffC[0]); PG8_STAGE(PG8_SA(0, 1), cA, voffC[1]);
    if (wr == 1) PG8_BAR;
    PG8_WAIT_V(2); PG8_BAR;
    PG8_STAGE(PG8_SB(1, 0), cB + kstep, voffB); PG8_STAGE(PG8_SA(1, 0), cA + kstep, voffC[0]); PG8_STAGE(PG8_SB(1, 1), cB + hstepB + kstep, voffB);
    PG8_WAIT_V(6); PG8_BAR;
    for (;;) {
        const bool has_next = S.next(ui + 1, nxt);
        const char* nA = has_next ? nxt.a : cA; const char* nB = has_next ? nxt.b : cB;
        if constexpr (Sched::GATHER) { if (has_next) PG8_AOFF(voffN, ui + 1); }
#pragma clang loop unroll(disable)
        for (int t = 0; t < nt; t += 2) {
            const bool last = (t == nt - 2);
            const char* a1 = cA + (size_t)(t + 1) * kstep;
            const char* a2 = last ? nA : cA + (size_t)(t + 2) * kstep; const char* b2 = last ? nB : cB + (size_t)(t + 2) * kstep;
            const char* a3 = a2 + kstep; const char* b3 = b2 + kstep;
            unsigned vA0[2], vA1[2];
            if constexpr (Sched::GATHER) { vA0[0] = last ? voffN[0][0] : voffC[0][0]; vA0[1] = last ? voffN[0][1] : voffC[0][1]; vA1[0] = last ? voffN[1][0] : voffC[1][0]; vA1[1] = last ? voffN[1][1] : voffC[1][1]; }
            else { vA0[0] = voffC[0][0]; vA0[1] = voffC[0][1]; vA1[0] = voffC[1][0]; vA1[1] = voffC[1][1]; }
            PG8_LDB(B0, 0, 0); PG8_LDB(B1, 0, 1); PG8_SCHED; PG8_LDA(At, 0, 0); PG8_STAGE(PG8_SA(1, 1), a1, voffC[1]);
            PG8_WAIT_V(8); PG8_WAIT_L(0); PG8_BAR; PG8_MMA(0, 0, At, B0); PG8_MMA(0, 1, At, B1); PG8_BAR; PG8_SCHED;
            PG8_LDA(At, 0, 1); PG8_STAGE(PG8_SB(0, 0), b2, voffB); PG8_STAGE(PG8_SB(0, 1), b2 + hstepB, voffB); PG8_STAGE(PG8_SA(0, 0), a2, vA0);
            PG8_WAIT_V(8); PG8_WAIT_L(0); PG8_BAR; PG8_MMA(1, 0, At, B0); PG8_MMA(1, 1, At, B1); PG8_BAR; PG8_SCHED;
            PG8_LDB(B0, 1, 0); PG8_LDB(B1, 1, 1); PG8_SCHED; PG8_LDA(At, 1, 0); PG8_STAGE(PG8_SA(0, 1), a2, vA1);
            PG8_WAIT_V(8); PG8_WAIT_L(0); PG8_BAR; PG8_MMA(0, 0, At, B0); PG8_MMA(0, 1, At, B1); PG8_BAR; PG8_SCHED;
            PG8_LDA(At, 1, 1); PG8_STAGE(PG8_SB(1, 0), b3, voffB); PG8_STAGE(PG8_SB(1, 1), b3 + hstepB, voffB); PG8_STAGE(PG8_SA(1, 0), a3, vA0);
            PG8_WAIT_V(8); PG8_WAIT_L(0); PG8_BAR; PG8_MMA(1, 0, At, B0); PG8_MMA(1, 1, At, B1); PG8_BAR; PG8_SCHED;
        }
        if (wr == 0) PG8_BAR;
        { int te = tid; asm volatile("" : "+v"(te));
          const int we = __builtin_amdgcn_readfirstlane(te >> 6), le = te & 63;
          E(acc, cur, we >> 2, we & 3, le & 15, le >> 4); }
        if (!has_next) break;
#pragma unroll
        for (int a = 0; a < 2; ++a)
#pragma unroll
            for (int b = 0; b < 2; ++b)
#pragma unroll
                for (int m = 0; m < 4; ++m)
#pragma unroll
                    for (int n = 0; n < 2; ++n) acc[a][b][m][n] = (acc_t){0, 0, 0, 0};
        cur = nxt; cA = nA; cB = nB; ++ui;
        if constexpr (Sched::GATHER) {
#pragma unroll
            for (int h_ = 0; h_ < 2; ++h_) { voffC[h_][0] = voffN[h_][0]; voffC[h_][1] = voffN[h_][1]; } }
        if (wr == 1) PG8_BAR;
    }
    PG8_WAIT_V(0);
    PG8_BAR;
#undef PG8_AOFF
#undef PG8_SA
#undef PG8_SB
#undef PG8_STAGE
#undef PG8_LDA
#undef PG8_LDB
#undef PG8_MMA
#undef PG8_WAIT_V
#undef PG8_WAIT_L
#undef PG8_BAR
#undef PG8_SCHED
}

struct GridOrder {
    int nM, nN, nwg, G, c, uneven;
    __device__ __forceinline__ void init(int nM_, int nN_, int G_, int c_) { nM = nM_; nN = nN_; nwg = nM * nN; G = G_; c = c_; uneven = 0; }
    __device__ __forceinline__ bool tile(int i, int& pm, int& pn) const {
        long L = (long)i * G + c;
        if (uneven) {
            if (c < 128) { if (i >= 2) return false; L = i * 128 + c; } else { if (i >= 4) return false; L = 256 + (c - 128) + 128 * i; } }
        if (L >= nwg) return false;
        int wgid = (int)L; { const int q = nwg / 8, r = nwg % 8, xcd = wgid % 8, off = wgid / 8; wgid = (xcd < r ? xcd * (q + 1) : r * (q + 1) + (xcd - r) * q) + off; }
        const int nig = 8 * nN, gid = wgid / nig, fm = gid * 8, gsz = (nM - fm) < 8 ? (nM - fm) : 8;
        pm = fm + ((wgid % nig) % gsz); pn = (wgid % nig) / gsz; return true;
    }
};
}

__device__ __forceinline__ int uni(int v) { return __builtin_amdgcn_readfirstlane(v); }
__device__ __forceinline__ const char* uniptr(const char* p) { const unsigned long long v = (unsigned long long)p; const unsigned lo = __builtin_amdgcn_readfirstlane((unsigned)v), hi = __builtin_amdgcn_readfirstlane((unsigned)(v >> 32)); return (const char*)(((unsigned long long)hi << 32) | lo); }
struct DenseSched {
    static constexpr bool GATHER = false;
    pg8::GridOrder o; const char* A; size_t a_sel_stride; int pn_per_a; const char* B; size_t tstepA, tstepB;
    __device__ __forceinline__ bool next(int i, pg8::Unit& u) const {
        if (!o.tile(i, u.pm, u.pn)) return false;
        u.pm = uni(u.pm); u.pn = uni(u.pn);
        u.a = uniptr(A + (size_t)(u.pn / pn_per_a) * a_sel_stride + (size_t)u.pm * tstepA); u.b = uniptr(B + (size_t)u.pn * tstepB); return true;
    }
};
struct MoeSched {
    static constexpr bool GATHER = false;
    const int* tileE; int ntiles, npn, G, c; const char* A; const char* B; size_t tstepA, tstepB, estride;
    __device__ __forceinline__ bool next(int i, pg8::Unit& u) const {
        const int L = i * G + c; if (L >= ntiles * npn) return false;
        u.pm = uni(L / npn); u.pn = uni(L % npn);
        const int e = __builtin_amdgcn_readfirstlane(tileE[u.pm]);
        u.a = uniptr(A + (size_t)u.pm * tstepA); u.b = uniptr(B + (size_t)e * estride + (size_t)u.pn * tstepB); return true;
    }
};

struct MoeGatherSched {
    static constexpr bool GATHER = true;
    const int* tileE; const LAS int* rowtab; int ntiles, G, c; const char* A; const char* B; size_t tstepB, estride;
    __device__ __forceinline__ bool next(int i, pg8::Unit& u) const {
        const int L = i * G + c; if (L >= ntiles * 2) return false;
        u.pm = uni(L >> 1); u.pn = uni(L & 1);
        const int e = __builtin_amdgcn_readfirstlane(tileE[u.pm]);
        u.a = A; u.b = uniptr(B + (size_t)e * estride + (size_t)u.pn * tstepB); return true;
    }
    __device__ __forceinline__ int row_of(int i, int r) const { return rowtab[i * 256 + r]; }
};
using pg8::Unit; using pg8::cvt_pk_bf16;
__device__ __forceinline__ void st8(bf16* p, const f32x4& v0, const f32x4& v1) {
    u32x4 w; w.x = cvt_pk_bf16(v0[0], v0[1]); w.y = cvt_pk_bf16(v0[2], v0[3]); w.z = cvt_pk_bf16(v1[0], v1[1]); w.w = cvt_pk_bf16(v1[2], v1[3]);
    *(u32x4*)p = w;
}
struct EpiSplit {
    static constexpr bool PERM = true, I8 = false;
    bf16* O; size_t split_stride; float scale;
    __device__ __forceinline__ void operator()(const f32x4 (&acc)[2][2][4][2], const Unit& u, int wr, int wc, int fr, int fq) const {
        const int row0 = u.pm * 256 + wr * 64 + fr; const int colt = u.pn * 256; const int t = colt >> 10;
        bf16* base = O + (size_t)t * split_stride; const int col0 = (colt & 1023) + wc * 32 + 8 * fq;
#pragma unroll
        for (int ai = 0; ai < 2; ++ai)
#pragma unroll
            for (int m = 0; m < 4; ++m) { bf16* rowp = base + (size_t)(row0 + ai * 128 + m * 16) * 1024 + col0;
#pragma unroll
                for (int bj = 0; bj < 2; ++bj) st8(rowp + bj * 128, acc[ai][bj][m][0] * scale, acc[ai][bj][m][1] * scale); }
    }
};
struct EpiLoraDn {
    static constexpr bool PERM = true, I8 = false;
    bf16* O;
    __device__ __forceinline__ void operator()(const f32x4 (&acc)[2][2][4][2], const Unit& u, int wr, int wc, int fr, int fq) const {
        const int row0 = u.pm * 256 + wr * 64 + fr; const int col0 = u.pn * 256 + wc * 32 + 8 * fq;
#pragma unroll
        for (int ai = 0; ai < 2; ++ai)
#pragma unroll
            for (int m = 0; m < 4; ++m) { bf16* rowp = O + (size_t)(row0 + ai * 128 + m * 16) * 512 + col0;
#pragma unroll
                for (int bj = 0; bj < 2; ++bj) { f32x4 v0 = acc[ai][bj][m][0], v1 = acc[ai][bj][m][1];
                    const int mode = (u.pn == 1) ? 2 : bj;
                    if (mode == 0) {
#pragma unroll
                        for (int j = 0; j < 4; ++j) { v0[j] = 1.0f - 2.0f / (__expf(2.0f * v0[j]) + 1.0f); v1[j] = 1.0f - 2.0f / (__expf(2.0f * v1[j]) + 1.0f); } }
                    else if (mode == 2) {
#pragma unroll
                        for (int j = 0; j < 4; ++j) { v0[j] = sigmoidf_(v0[j]); v1[j] = sigmoidf_(v1[j]); } }
                    st8(rowp + bj * 128, v0, v1); } }
    }
};
struct EpiLoraUpWA {
    static constexpr bool PERM = true, I8 = false;
    bf16* LD; bf16* AS; const float* w0; const float* a0;
    __device__ __forceinline__ void operator()(const f32x4 (&acc)[2][2][4][2], const Unit& u, int wr, int wc, int fr, int fq) const {
        const int kind = u.pn >> 3, z = (u.pn >> 2) & 1;
        const int row0 = u.pm * 256 + wr * 64 + fr; const int col0 = (u.pn & 3) * 256 + wc * 32 + 8 * fq;
        bf16* base = (kind ? AS : LD) + (size_t)z * T * D; const float* bias = (kind ? a0 : w0) + z * 1024;
        f32x4 bv[2][2];
#pragma unroll
        for (int bj = 0; bj < 2; ++bj)
#pragma unroll
            for (int n = 0; n < 2; ++n) bv[bj][n] = *(const f32x4*)(bias + col0 + bj * 128 + 4 * n);
#pragma unroll
        for (int ai = 0; ai < 2; ++ai)
#pragma unroll
            for (int m = 0; m < 4; ++m) { bf16* rowp = base + (size_t)(row0 + ai * 128 + m * 16) * 1024 + col0;
#pragma unroll
                for (int bj = 0; bj < 2; ++bj) { f32x4 v[2];
#pragma unroll
                    for (int n = 0; n < 2; ++n) { v[n] = acc[ai][bj][m][n] + bv[bj][n];
#pragma unroll
                        for (int j = 0; j < 4; ++j) { const float x = v[n][j];
                            if (kind == 0) v[n][j] = -0.8750612633917001f * sigmoidf_(x);
                            else v[n][j] = sigmoidf_(x); } }
                    st8(rowp + bj * 128, v[0], v[1]); } }
    }
};
struct EpiResid {
    static constexpr bool PERM = true, I8 = false;
    const void* xin; int xin_f32; bf16* out; const float* gate;
    __device__ __forceinline__ void operator()(const f32x4 (&acc)[2][2][4][2], const Unit& u, int wr, int wc, int fr, int fq) const {
        const int row0 = u.pm * 256 + wr * 64 + fr, col0 = u.pn * 256 + wc * 32 + 8 * fq; const int b = u.pm >> 3;
        f32x4 gv[2][2];
#pragma unroll
        for (int bj = 0; bj < 2; ++bj)
#pragma unroll
            for (int n = 0; n < 2; ++n) gv[bj][n] = *(const f32x4*)(gate + (size_t)b * 6144 + col0 + bj * 128 + 4 * n);
#pragma unroll
        for (int ai = 0; ai < 2; ++ai)
#pragma unroll
            for (int m = 0; m < 4; ++m) { const size_t off = (size_t)(row0 + ai * 128 + m * 16) * D + col0;
#pragma unroll
                for (int bj = 0; bj < 2; ++bj) { f32x4 x0, x1;
                    if (xin_f32) { x0 = *(const f32x4*)((const float*)xin + off + bj * 128); x1 = *(const f32x4*)((const float*)xin + off + bj * 128 + 4); }
                    else { const u32x4 r = *(const u32x4*)((const bf16*)xin + off + bj * 128); x0 = (f32x4){bf_lo(r.x), bf_hi(r.x), bf_lo(r.y), bf_hi(r.y)}; x1 = (f32x4){bf_lo(r.z), bf_hi(r.z), bf_lo(r.w), bf_hi(r.w)}; }
                    st8(out + off + bj * 128, x0 + gv[bj][0] * acc[ai][bj][m][0], x1 + gv[bj][1] * acc[ai][bj][m][1]); } }
    }
};
struct EpiQKV {
    static constexpr bool PERM = true, I8 = false;
    bf16* Q; bf16* Kb; bf16* Vb; float qscale;
    __device__ __forceinline__ void operator()(const f32x4 (&acc)[2][2][4][2], const Unit& u, int wr, int wc, int fr, int fq) const {
        const int g = u.pn / 12, which = (u.pn % 12) >> 2, hp = u.pn & 3;
        const int row0 = u.pm * 256 + wr * 64 + fr;
        bf16* base = Q + (size_t)which * ((A_K - A_Q) / 2) + (size_t)g * T * D; const float sc = which ? 1.0f : qscale; const int col0 = hp * 256 + wc * 32 + 8 * fq;
#pragma unroll
        for (int ai = 0; ai < 2; ++ai)
#pragma unroll
            for (int m = 0; m < 4; ++m) { bf16* rowp = base + (size_t)(row0 + ai * 128 + m * 16) * 1024 + col0;
#pragma unroll
                for (int bj = 0; bj < 2; ++bj) st8(rowp + bj * 128, acc[ai][bj][m][0] * sc, acc[ai][bj][m][1] * sc); }
    }
};
struct EpiQKV8 {
    static constexpr bool PERM = true, I8 = true;
    bf16* Q; const float* SA; const float* SBq; float qscale;
    __device__ __forceinline__ void operator()(const pg8::i32x4 (&acc)[2][2][4][2], const Unit& u, int wr, int wc, int fr, int fq) const {
        const int g = u.pn / 12, which = (u.pn % 12) >> 2, hp = u.pn & 3;
        const int row0 = u.pm * 256 + wr * 64 + fr;
        bf16* base = Q + (size_t)which * ((A_K - A_Q) / 2) + (size_t)g * T * D; const float sc = which ? 1.0f : qscale; const int col0 = hp * 256 + wc * 32 + 8 * fq;
        const int colb = u.pn * 256 + wc * 32 + 8 * fq;
        f32x4 sbv[2][2];
#pragma unroll
        for (int bj = 0; bj < 2; ++bj)
#pragma unroll
            for (int n = 0; n < 2; ++n) sbv[bj][n] = *(const f32x4*)(SBq + colb + bj * 128 + 4 * n) * sc;
#pragma unroll
        for (int ai = 0; ai < 2; ++ai)
#pragma unroll
            for (int m = 0; m < 4; ++m) { const int row = row0 + ai * 128 + m * 16; const float sa = SA[row]; bf16* rowp = base + (size_t)row * 1024 + col0;
#pragma unroll
                for (int bj = 0; bj < 2; ++bj) st8(rowp + bj * 128, __builtin_convertvector(acc[ai][bj][m][0], f32x4) * (sbv[bj][0] * sa), __builtin_convertvector(acc[ai][bj][m][1], f32x4) * (sbv[bj][1] * sa)); }
    }
};
struct EpiGateUp {
    static constexpr bool PERM = true, I8 = false;
    bf16* H; const float* roww;
    __device__ __forceinline__ void operator()(const f32x4 (&acc)[2][2][4][2], const Unit& u, int wr, int wc, int fr, int fq) const {
        const int row0 = u.pm * 256 + wr * 64 + fr; const int col0 = u.pn * 128 + wc * 32 + 8 * fq;
#pragma unroll
        for (int ai = 0; ai < 2; ++ai)
#pragma unroll
            for (int m = 0; m < 4; ++m) { const int row = row0 + ai * 128 + m * 16; const float rw = roww[row]; f32x4 v[2];
#pragma unroll
                for (int n = 0; n < 2; ++n)
#pragma unroll
                    for (int j = 0; j < 4; ++j) { const float gg = acc[ai][0][m][n][j], uu = acc[ai][1][m][n][j]; v[n][j] = gg * sigmoidf_(gg) * uu * rw; }
                st8(H + (size_t)row * FEXP + col0, v[0], v[1]); }
    }
};
struct EpiPlain {
    static constexpr bool PERM = true, I8 = false;
    bf16* O;
    __device__ __forceinline__ void operator()(const f32x4 (&acc)[2][2][4][2], const Unit& u, int wr, int wc, int fr, int fq) const {
        const int row0 = u.pm * 256 + wr * 64 + fr; const int col0 = u.pn * 256 + wc * 32 + 8 * fq;
#pragma unroll
        for (int ai = 0; ai < 2; ++ai)
#pragma unroll
            for (int m = 0; m < 4; ++m) { bf16* rowp = O + (size_t)(row0 + ai * 128 + m * 16) * 1024 + col0;
#pragma unroll
                for (int bj = 0; bj < 2; ++bj) st8(rowp + bj * 128, acc[ai][bj][m][0], acc[ai][bj][m][1]); }
    }
};

struct Args {
    const float* in[32]; float* out; unsigned char* ws; int ph_lo, ph_hi;
};
enum { I_X = 0, I_C, I_ADAW, I_ADAB, I_NTM, I_NCM, I_MU, I_WRKV, I_W0, I_W1, I_W2, I_A0, I_A1, I_A2, I_G1, I_G2, I_KK, I_KA, I_RK, I_LNW, I_LNB, I_RWO,
       I_AQKV, I_AWO, I_RG, I_RGB, I_RE, I_REB, I_WG, I_WU, I_WD, I_FG };

struct Frame {
    LAS unsigned char* lds; int tid, lane, wave, G, gw, NGW;
    unsigned char* ws; const float* const* in; float* out;
};

__device__ __forceinline__ void row_load(const float* p, int lane, f32x4 (&v)[4]) {
#pragma unroll
    for (int j = 0; j < 4; ++j) v[j] = *(const f32x4*)(p + 4 * lane + 256 * j);
}
__device__ __forceinline__ void row_load_bf16(const bf16* p, int lane, f32x4 (&v)[4]) {
#pragma unroll
    for (int j = 0; j < 4; ++j) { const u32x2 r = *(const u32x2*)(p + 4 * lane + 256 * j); v[j] = (f32x4){bf_lo(r.x), bf_hi(r.x), bf_lo(r.y), bf_hi(r.y)}; }
}
__device__ __forceinline__ void row_store(float* p, int lane, const f32x4 (&v)[4]) {
#pragma unroll
    for (int j = 0; j < 4; ++j) *(f32x4*)(p + 4 * lane + 256 * j) = v[j];
}
__device__ __forceinline__ void row_store_bf16(bf16* p, int lane, const f32x4 (&v)[4]) {
#pragma unroll
    for (int j = 0; j < 4; ++j) { u32x2 w; w.x = pk2(v[j][0], v[j][1]); w.y = pk2(v[j][2], v[j][3]); *(u32x2*)(p + 4 * lane + 256 * j) = w; }
}
__device__ __forceinline__ void row_combine(f32x4 (&v)[4], const bf16* ys, const int* tokp, int row, const float* gac, int lane) {
    const int p0 = tokp[2 * row], p1 = tokp[2 * row + 1];
    const bf16* y0 = ys + (size_t)p0 * D; const bf16* y1 = ys + (size_t)p1 * D;
#pragma unroll
    for (int j = 0; j < 4; ++j) { const u32x2 a = *(const u32x2*)(y0 + 4 * lane + 256 * j), b = *(const u32x2*)(y1 + 4 * lane + 256 * j); const f32x4 g = *(const f32x4*)(gac + 4 * lane + 256 * j);
        v[j][0] += g[0] * (bf_lo(a.x) + bf_lo(b.x)); v[j][1] += g[1] * (bf_hi(a.x) + bf_hi(b.x)); v[j][2] += g[2] * (bf_lo(a.y) + bf_lo(b.y)); v[j][3] += g[3] * (bf_hi(a.y) + bf_hi(b.y)); }
}
__device__ __forceinline__ void row_norm_mod(const f32x4 (&x)[4], const float* gain, const float* sc, const float* sh, int lane, f32x4 (&h)[4]) {
    float s = 0.f;
#pragma unroll
    for (int j = 0; j < 4; ++j) s += (x[j][0] * x[j][0] + x[j][1] * x[j][1]) + (x[j][2] * x[j][2] + x[j][3] * x[j][3]);
    const float rstd = rsqrtf(wave_sum(s, lane) * (1.0f / D) + RMS_EPS);
#pragma unroll
    for (int j = 0; j < 4; ++j) { const f32x4 g = *(const f32x4*)(gain + 4 * lane + 256 * j), c = *(const f32x4*)(sc + 4 * lane + 256 * j), b = *(const f32x4*)(sh + 4 * lane + 256 * j);
        h[j] = x[j] * rstd * g * (1.0f + c) + b; }
}
__device__ __forceinline__ void transpose_item(const float* W, int ldw, bf16* dst, int ldd, LAS float* scr, int lane) {
    { const int r8 = lane >> 3, c4 = (lane & 7) * 4;
      f32x4 v[8];
#pragma unroll
      for (int i = 0; i < 8; ++i) v[i] = *(const f32x4*)(W + (size_t)(8 * i + r8) * ldw + c4);
#pragma unroll
      for (int i = 0; i < 8; ++i) { LAS float* p = scr + (8 * i + r8) * 33 + c4; p[0] = v[i][0]; p[1] = v[i][1]; p[2] = v[i][2]; p[3] = v[i][3]; } }
    LDS_WAIT(); asm volatile("" ::: "memory");
    const int c = lane & 7;
#pragma unroll
    for (int j = 0; j < 4; ++j) { const int n = (lane >> 3) + 8 * j; const LAS float* s = scr + (8 * c) * 33 + n;
        u32x4 o; o.x = pk2(s[0 * 33], s[1 * 33]); o.y = pk2(s[2 * 33], s[3 * 33]); o.z = pk2(s[4 * 33], s[5 * 33]); o.w = pk2(s[6 * 33], s[7 * 33]);
        *(u32x4*)(dst + (size_t)n * ldd + 8 * c) = o; }
    LDS_WAIT(); asm volatile("" ::: "memory");
}

__device__ __forceinline__ void phase_prologue(Frame& F) {
    const float* c = F.in[I_C]; const float* adaw = F.in[I_ADAW]; const float* adab = F.in[I_ADAB];
    float* mod = (float*)(F.ws + WS_MOD);
    LAS float* sc = (LAS float*)F.lds;
    LAS float* part = (LAS float*)(F.lds + 32768);
    for (int i = F.tid; i < NB * D; i += NTHREADS) { const float v = c[i]; sc[i] = v / (1.0f + __expf(-v)); }
    __syncthreads();
    for (int u = blockIdx.x; u < DEPTH * 96; u += F.G) {
        const int l = u / 96, n0 = (u % 96) * 64, col = n0 + F.lane;
        const float* W = adaw + (size_t)l * D * 6144 + col;
        float acc[8];
#pragma unroll
        for (int b = 0; b < 8; ++b) acc[b] = 0.f;
        const int kbeg = F.wave * 128;
#pragma unroll 8
        for (int k = kbeg; k < kbeg + 128; ++k) { const float w = W[(size_t)k * 6144];
#pragma unroll
            for (int b = 0; b < 8; ++b) acc[b] += sc[b * D + k] * w; }
#pragma unroll
        for (int b = 0; b < 8; ++b) part[(F.wave * 8 + b) * 64 + F.lane] = acc[b];
        __syncthreads();
        { const int b = F.tid >> 6; float s = adab[l * 6144 + col];
#pragma unroll
          for (int w = 0; w < 8; ++w) s += part[(w * 8 + b) * 64 + F.lane];
          mod[(size_t)(l * 8 + b) * 6144 + col] = s; }
        __syncthreads();
    }
    LAS float* scr = (LAS float*)(F.lds + 49152 + F.wave * 8704);
    constexpr int I_SQ = 16 * 32;
    constexpr int I_QKV = 16 * 288;
    constexpr int PER_RW = 4 * I_SQ, PER_AT = I_QKV + I_SQ, NIT = 2 * PER_RW + 2 * PER_AT;
    for (int it = F.gw; it < NIT; it += F.NGW) {
        int r = it;
        if (r < 2 * PER_RW) { const int j = r / PER_RW; r %= PER_RW; const int mi = r / I_SQ; r %= I_SQ; const int kb = r / 32, nb = r % 32;
            if (mi < 3) transpose_item(F.in[I_WRKV] + ((size_t)(j * 3 + mi) * D + kb * 64) * D + nb * 32, D, (bf16*)(F.ws + WS_W + j * W_RW_STRIDE + W_RKV) + (size_t)(mi * D + nb * 32) * D + kb * 64, D, scr, F.lane);
            else transpose_item(F.in[I_RWO] + ((size_t)j * D + kb * 64) * D + nb * 32, D, (bf16*)(F.ws + WS_W + j * W_RW_STRIDE + W_RWO) + (size_t)(nb * 32) * D + kb * 64, D, scr, F.lane);
        } else { r -= 2 * PER_RW; const int j = r / PER_AT; r %= PER_AT;
            if (r < I_QKV) { }
            else { r -= I_QKV; const int kb = r / 32, nb = r % 32;
                transpose_item(F.in[I_AWO] + ((size_t)j * D + kb * 64) * D + nb * 32, D, (bf16*)(F.ws + WS_WA + j * W_AT_STRIDE + W_AWO) + (size_t)(nb * 32) * D + kb * 64, D, scr, F.lane); }
        }
    }
    {
        LAS float* pm = (LAS float*)(F.lds + 118784); LAS float* invs = (LAS float*)(F.lds + 120832);
        for (int u = blockIdx.x; u < 2 * 144; u += F.G) {
            const int j = u / 144, n0 = (u % 144) * 64;
            const float* W = F.in[I_AQKV] + (size_t)j * D * QKVW + n0;
            signed char* Bq = (signed char*)(F.ws + WS_WA + j * W_AT_STRIDE + W_QKV); float* SBq = (float*)(F.ws + WS_WA + j * W_AT_STRIDE + W_QKVS);
            float m = 0.f;
#pragma unroll 16
            for (int k = F.wave * 128; k < F.wave * 128 + 128; ++k) m = fmaxf(m, fabsf(W[(size_t)k * QKVW + F.lane]));
            pm[F.wave * 64 + F.lane] = m;
            __syncthreads();
            if (F.tid < 64) { float a = pm[F.tid];
#pragma unroll
                for (int w = 1; w < 8; ++w) a = fmaxf(a, pm[w * 64 + F.tid]);
                a = fmaxf(a, 1e-20f); invs[F.tid] = 127.0f / a; SBq[n0 + F.tid] = a * (1.0f / 127.0f); }
            __syncthreads();
            for (int tile = F.wave; tile < 32; tile += NWAVES) { const int kb = tile >> 1, nh = tile & 1;
                const float* src = W + (size_t)(kb * 64) * QKVW + nh * 32;
                { const int r8 = F.lane >> 3, c4 = (F.lane & 7) * 4; f32x4 v[8];
#pragma unroll
                  for (int i = 0; i < 8; ++i) v[i] = *(const f32x4*)(src + (size_t)(8 * i + r8) * QKVW + c4);
#pragma unroll
                  for (int i = 0; i < 8; ++i) { LAS float* p = scr + (8 * i + r8) * 33 + c4; p[0] = v[i][0]; p[1] = v[i][1]; p[2] = v[i][2]; p[3] = v[i][3]; } }
                LDS_WAIT(); asm volatile("" ::: "memory");
                const int c = F.lane & 7;
#pragma unroll
                for (int jj = 0; jj < 4; ++jj) { const int n = (F.lane >> 3) + 8 * jj; const LAS float* sp = scr + (8 * c) * 33 + n; const float inv = invs[nh * 32 + n];
                    u32x2 o; o.x = pack_i8x4((f32x4){sp[0 * 33], sp[1 * 33], sp[2 * 33], sp[3 * 33]}, inv); o.y = pack_i8x4((f32x4){sp[4 * 33], sp[5 * 33], sp[6 * 33], sp[7 * 33]}, inv);
                    *(u32x2*)(Bq + (size_t)(n0 + nh * 32 + n) * D + kb * 64 + 8 * c) = o; }
                LDS_WAIT(); asm volatile("" ::: "memory");
            }
            __syncthreads();
        }
    }
    const int gt = blockIdx.x * NTHREADS + F.tid, NGT = F.G * NTHREADS;
    for (int j = 0; j < 2; ++j) {
        bf16* ldn = (bf16*)(F.ws + WS_W + j * W_RW_STRIDE + W_LDN);
        const float* mu = F.in[I_MU] + (size_t)j * 6 * D;
        for (int i = gt; i < 512 * 2048; i += NGT) { const int n = i >> 11, k = i & 2047, kk = k & 1023;
            float v; int mi;
            if (n < 128) { const int z = n >> 6, nn = n & 63; v = F.in[I_W1][((size_t)(j * 2 + z) * D + kk) * 64 + nn]; mi = 3; }
            else if (n < 256) { const int z = (n - 128) >> 6, nn = n & 63; v = F.in[I_A1][((size_t)(j * 2 + z) * D + kk) * 64 + nn]; mi = 4; }
            else { const int z = (n - 256) >> 7, nn = n & 127; v = F.in[I_G1][((size_t)(j * 2 + z) * D + kk) * 128 + nn]; mi = 5; }
            if (k >= 1024) v *= mu[mi * D + kk];
            ldn[i] = (bf16)f2bf(v); }
        bf16* lwa = (bf16*)(F.ws + WS_W + j * W_RW_STRIDE + W_LUPWA);
        for (int i = gt; i < 4096 * 256; i += NGT) { const int n = i >> 8, k = i & 255; const int kind = n >> 11, z = (n >> 10) & 1, col = n & 1023;
            float v = 0.f;
            if ((k >> 6) == kind * 2 + z) v = (kind ? F.in[I_A2] : F.in[I_W2])[((size_t)(j * 2 + z) * 64 + (k & 63)) * D + col];
            lwa[i] = (bf16)f2bf(v); }
        bf16* lg = (bf16*)(F.ws + WS_W + j * W_RW_STRIDE + W_LUPG);
        for (int i = gt; i < 2048 * 256; i += NGT) { const int n = i >> 8, k = i & 255; const int z = n >> 10, col = n & 1023;
            float v = 0.f;
            if ((k >> 7) == z) v = F.in[I_G2][((size_t)(j * 2 + z) * 128 + (k & 127)) * D + col];
            lg[i] = (bf16)f2bf(v); }
    }
}

__device__ __forceinline__ void rw_hrow(Frame& F, int l, bool combine, const void* xsrc, bf16* xdst, bool own, int row, f32x4 (&h)[4]) {
    const int b = row >> 11; const float* mod = (const float*)(F.ws + WS_MOD);
    f32x4 x[4]; if (l == 0) row_load((const float*)xsrc + (size_t)row * D, F.lane, x); else row_load_bf16((const bf16*)xsrc + (size_t)row * D, F.lane, x);
    if (combine) { row_combine(x, (const bf16*)(F.ws + WS_ACT + A_YS), (const int*)(F.ws + WS_TOKP), row, mod + (size_t)((l - 1) * 8 + b) * 6144 + 5 * D, F.lane);
        if (own) row_store_bf16(xdst + (size_t)row * D, F.lane, x); }
    const float* mp = mod + (size_t)(l * 8 + b) * 6144;
    row_norm_mod(x, F.in[I_NTM] + l * D, mp + 1 * D, mp + 0 * D, F.lane, h);
}
__device__ __forceinline__ void phase_rw_norm(Frame& F, int l, bool combine, const void* xsrc, bf16* xdst) {
    const int j = l >> 1; const float* mu = F.in[I_MU] + (size_t)j * 6 * D;
    bf16* xs = (bf16*)(F.ws + WS_ACT + A_XS); bf16* hx = (bf16*)(F.ws + WS_ACT + A_HX);
    for (int ch = F.gw; ch < T / 8; ch += F.NGW) {
        const int row0 = ch * 8, t0 = row0 & (SEQ - 1);
        f32x4 prev[4], cur[4], nxt[4];
        if (t0 > 0) rw_hrow(F, l, combine, xsrc, xdst, false, row0 - 1, prev);
        else {
#pragma unroll
            for (int q = 0; q < 4; ++q) prev[q] = (f32x4){0.f, 0.f, 0.f, 0.f}; }
        rw_hrow(F, l, combine, xsrc, xdst, true, row0, cur);
        for (int i = 0; i < 8; ++i) {
            const int row = row0 + i;
            if (t0 + i + 1 < SEQ) rw_hrow(F, l, combine, xsrc, xdst, i < 7, row + 1, nxt);
            else {
#pragma unroll
                for (int q = 0; q < 4; ++q) nxt[q] = (f32x4){0.f, 0.f, 0.f, 0.f}; }
            f32x4 xx[4];
#pragma unroll
            for (int q = 0; q < 4; ++q) xx[q] = 0.5f * (prev[q] + nxt[q]) - cur[q];
#pragma unroll
            for (int mi = 0; mi < 3; ++mi) { f32x4 o[4];
#pragma unroll
                for (int q = 0; q < 4; ++q) { const f32x4 m = *(const f32x4*)(mu + mi * D + 4 * F.lane + 256 * q); o[q] = cur[q] + xx[q] * m; }
                row_store_bf16(xs + ((size_t)mi * T + row) * D, F.lane, o); }
            row_store_bf16(hx + (size_t)row * 2048, F.lane, cur);
            row_store_bf16(hx + (size_t)row * 2048 + D, F.lane, xx);
#pragma unroll
            for (int q = 0; q < 4; ++q) { prev[q] = cur[q]; cur[q] = nxt[q]; }
        }
    }
}

__device__ __forceinline__ void phase_at_norm(Frame& F, int l, const bf16* xsrc, bf16* xdst) {
    const float* mod = (const float*)(F.ws + WS_MOD); signed char* H8 = (signed char*)(F.ws + WS_ACT + A_H); float* SA = (float*)(F.ws + WS_SA);
    for (int row = F.gw; row < T; row += F.NGW) {
        const int b = row >> 11; f32x4 x[4], h[4]; row_load_bf16(xsrc + (size_t)row * D, F.lane, x);
        row_combine(x, (const bf16*)(F.ws + WS_ACT + A_YS), (const int*)(F.ws + WS_TOKP), row, mod + (size_t)((l - 1) * 8 + b) * 6144 + 5 * D, F.lane);
        row_store_bf16(xdst + (size_t)row * D, F.lane, x);
        const float* mp = mod + (size_t)(l * 8 + b) * 6144;
        row_norm_mod(x, F.in[I_NTM] + l * D, mp + 1 * D, mp + 0 * D, F.lane, h);
        float am = 0.f;
#pragma unroll
        for (int j = 0; j < 4; ++j) am = fmaxf(am, fmaxf(fmaxf(fabsf(h[j][0]), fabsf(h[j][1])), fmaxf(fabsf(h[j][2]), fabsf(h[j][3]))));
        am = fmaxf(wave_max(am), 1e-20f); const float inv = 127.0f / am;
        if (F.lane == 0) SA[row] = am * (1.0f / 127.0f);
#pragma unroll
        for (int j = 0; j < 4; ++j) *(unsigned*)(H8 + (size_t)row * D + 4 * F.lane + 256 * j) = pack_i8x4(h[j], inv);
    }
}
__device__ __forceinline__ void phase_final(Frame& F, const bf16* xsrc) {
    const float* mod = (const float*)(F.ws + WS_MOD); const float* fg = F.in[I_FG];
    for (int row = F.gw; row < T; row += F.NGW) {
        const int b = row >> 11; f32x4 x[4]; row_load_bf16(xsrc + (size_t)row * D, F.lane, x);
        row_combine(x, (const bf16*)(F.ws + WS_ACT + A_YS), (const int*)(F.ws + WS_TOKP), row, mod + (size_t)(3 * 8 + b) * 6144 + 5 * D, F.lane);
        float s = 0.f;
#pragma unroll
        for (int j = 0; j < 4; ++j) s += (x[j][0] * x[j][0] + x[j][1] * x[j][1]) + (x[j][2] * x[j][2] + x[j][3] * x[j][3]);
        const float rstd = rsqrtf(wave_sum(s, F.lane) * (1.0f / D) + RMS_EPS);
#pragma unroll
        for (int j = 0; j < 4; ++j) { const f32x4 g = *(const f32x4*)(fg + 4 * F.lane + 256 * j); x[j] = x[j] * rstd * g; }
        row_store(F.out + (size_t)row * D, F.lane, x);
    }
}

__device__ __forceinline__ void phase_moe_route(Frame& F, int l, const bf16* xsrc, int cnt_shift = 0) {
    const float* mod = (const float*)(F.ws + WS_MOD); bf16* HN = (bf16*)(F.ws + WS_ACT + A_HN2);
    LAS int* lcnt = (LAS int*)F.lds; LAS int* gbase = lcnt + 32; LAS int* inf_e = lcnt + 64; LAS int* inf_r = inf_e + 128; LAS float* inf_w = (LAS float*)(inf_r + 128);
    unsigned* cnt = (unsigned*)(F.ws + WS_CTL) + CW_CNT + (l + cnt_shift) * 32;
    int* toke = (int*)(F.ws + WS_TOKE); int* tokr = (int*)(F.ws + WS_TOKR); float* tokw = (float*)(F.ws + WS_TOKW);
    { int* rowt = (int*)(F.ws + WS_ROWT); for (int i = blockIdx.x * NTHREADS + F.tid; i < MAXROWS; i += F.G * NTHREADS) rowt[i] = 0; }
    const float* rg = F.in[I_RG] + (size_t)l * D * 4; const float* rgb = F.in[I_RGB] + l * 4;
    LAS float* RW = (LAS float*)(F.lds + 4096);
    for (int i = F.tid; i < D * 4; i += NTHREADS) RW[(i & 3) * D + (i >> 2)] = rg[i];
    { const float* rea = F.in[I_RE] + (size_t)l * 4 * D * 8;
      for (int i = F.tid; i < 4 * D * 8; i += NTHREADS) RW[(4 + (i >> 13) * 8 + (i & 7)) * D + ((i >> 3) & 1023)] = rea[i]; }
    for (int cb = blockIdx.x; cb < T / 64; cb += F.G) {
        if (F.tid < 32) lcnt[F.tid] = 0;
        __syncthreads();
        for (int i = 0; i < 8; ++i) {
            const int lr = F.wave * 8 + i, row = cb * 64 + lr, b = row >> 11;
            f32x4 x[4], h[4]; row_load_bf16(xsrc + (size_t)row * D, F.lane, x);
            const float* mp = mod + (size_t)(l * 8 + b) * 6144;
            row_norm_mod(x, F.in[I_NCM] + l * D, mp + 4 * D, mp + 3 * D, F.lane, h);
            row_store_bf16(HN + (size_t)row * D, F.lane, h);
            float gl[4] = {0.f, 0.f, 0.f, 0.f};
#pragma unroll
            for (int e = 0; e < 4; ++e)
#pragma unroll
                for (int j = 0; j < 4; ++j) { const f32x4 w = *(const LAS f32x4*)(RW + e * D + 4 * F.lane + 256 * j); gl[e] += (h[j][0] * w[0] + h[j][1] * w[1]) + (h[j][2] * w[2] + h[j][3] * w[3]); }
#pragma unroll
            for (int e = 0; e < 4; ++e) gl[e] = wave_sum(gl[e], F.lane) + rgb[e];
            const float gm = fmaxf(fmaxf(gl[0], gl[1]), fmaxf(gl[2], gl[3]));
            const int gtop = (gl[0] == gm) ? 0 : (gl[1] == gm) ? 1 : (gl[2] == gm) ? 2 : 3;
            const float pg = 1.0f / (__expf(gl[0] - gm) + __expf(gl[1] - gm) + __expf(gl[2] - gm) + __expf(gl[3] - gm));
            const float* reb = F.in[I_REB] + (l * 4 + gtop) * 8; const LAS float* rwe = RW + (4 + gtop * 8) * D + 4 * F.lane;
            float el[8];
#pragma unroll
            for (int e = 0; e < 8; ++e) { el[e] = 0.f;
#pragma unroll
                for (int j = 0; j < 4; ++j) { const f32x4 w = *(const LAS f32x4*)(rwe + e * D + 256 * j); el[e] += (h[j][0] * w[0] + h[j][1] * w[1]) + (h[j][2] * w[2] + h[j][3] * w[3]); } }
#pragma unroll
            for (int e = 0; e < 8; ++e) el[e] = wave_sum(el[e], F.lane) + reb[e];
            float v0 = el[0]; int i0 = 0;
#pragma unroll
            for (int e = 1; e < 8; ++e) if (el[e] > v0) { v0 = el[e]; i0 = e; }
            float v1 = -3.0e38f; int i1 = 0;
#pragma unroll
            for (int e = 0; e < 8; ++e) if (e != i0 && el[e] > v1) { v1 = el[e]; i1 = e; }
            const float ex = __expf(v1 - v0); const float w0 = pg / (1.0f + ex), w1 = pg * ex / (1.0f + ex);
            if (F.lane == 0) {
                const int e0 = gtop * 8 + i0, e1 = gtop * 8 + i1;
                const int r0 = __hip_atomic_fetch_add(lcnt + e0, 1, __ATOMIC_RELAXED, __HIP_MEMORY_SCOPE_WORKGROUP);
                const int r1 = __hip_atomic_fetch_add(lcnt + e1, 1, __ATOMIC_RELAXED, __HIP_MEMORY_SCOPE_WORKGROUP);
                inf_e[lr * 2] = e0; inf_e[lr * 2 + 1] = e1; inf_r[lr * 2] = r0; inf_r[lr * 2 + 1] = r1; inf_w[lr * 2] = w0; inf_w[lr * 2 + 1] = w1;
            }
        }
        __syncthreads();
        if (F.tid < 32) gbase[F.tid] = (int)__hip_atomic_fetch_add(cnt + F.tid, (unsigned)lcnt[F.tid], __ATOMIC_RELAXED, __HIP_MEMORY_SCOPE_AGENT);
        __syncthreads();
        if (F.tid < 128) { const int idx = cb * 128 + F.tid; const int e = inf_e[F.tid]; toke[idx] = e; tokr[idx] = gbase[e] + inf_r[F.tid]; tokw[idx] = inf_w[F.tid]; }
        __syncthreads();
    }
}
__device__ __forceinline__ void moe_tables(Frame& F, int l) {
    LAS int* tileE = (LAS int*)(F.lds + TILEE_OFF); LAS int* offs = (LAS int*)(F.lds + OFFS_OFF);
    const unsigned* cnt = (const unsigned*)(F.ws + WS_CTL) + CW_CNT + l * 32;
    if (F.tid == 0) { int o = 0, nt = 0;
#pragma clang loop unroll(disable)
        for (int e = 0; e < 32; ++e) { const int c = (int)__hip_atomic_load(cnt + e, __ATOMIC_RELAXED, __HIP_MEMORY_SCOPE_AGENT); offs[e] = o; const int ne = (c + 255) >> 8;
#pragma clang loop unroll(disable)
            for (int k = 0; k < ne && nt < 160; ++k) tileE[nt++] = e;
            o += ne * 256; }
        tileE[160] = nt; offs[32] = o; }
    __syncthreads();
}
__device__ __forceinline__ void moe_convert(Frame& F, int l, int first, int stride) {
    LAS float* scr = (LAS float*)(F.lds + 49152 + F.wave * 8704);
    bf16* WGU = (bf16*)(F.ws + ws_wm_of(l) + W_GU); bf16* WDN = (bf16*)(F.ws + ws_wm_of(l) + W_DN);
    constexpr int I_GATE = 16 * 8, I_DOWN = 4 * 32;
    for (int it = first; it < NEXP * (2 * I_GATE + I_DOWN); it += stride) {
        const int e = it / (2 * I_GATE + I_DOWN); int r = it % (2 * I_GATE + I_DOWN);
        if (r < 2 * I_GATE) { const int up = r / I_GATE; r %= I_GATE; const int kb = r / 8, nb = r % 8, n0 = nb * 32;
            const float* src = (up ? F.in[I_WU] : F.in[I_WG]) + ((size_t)(l * 32 + e) * D + kb * 64) * FEXP + n0;
            const int drow = (n0 >> 7) * 256 + up * 128 + (n0 & 127);
            transpose_item(src, FEXP, WGU + ((size_t)e * 512 + drow) * D + kb * 64, D, scr, F.lane);
        } else { r -= 2 * I_GATE; const int kb = r / 32, nb = r % 32;
            const float* src = F.in[I_WD] + ((size_t)(l * 32 + e) * FEXP + kb * 64) * D + nb * 32;
            transpose_item(src, D, WDN + ((size_t)e * D + nb * 32) * FEXP + kb * 64, FEXP, scr, F.lane); }
    }
}
__device__ __forceinline__ void phase_moe_gather(Frame& F, int l) {
    moe_tables(F, l);
    const LAS int* offs = (const LAS int*)(F.lds + OFFS_OFF);
    if (blockIdx.x == 0 && F.tid < 161) ((int*)(F.ws + WS_TILEE))[F.tid] = ((const LAS int*)(F.lds + TILEE_OFF))[F.tid];
    const int* toke = (const int*)(F.ws + WS_TOKE); const int* tokr = (const int*)(F.ws + WS_TOKR); const float* tokw = (const float*)(F.ws + WS_TOKW);
    int* tokp = (int*)(F.ws + WS_TOKP); float* roww = (float*)(F.ws + WS_ROWW);
    int* rowt = (int*)(F.ws + WS_ROWT);
    for (int idx = blockIdx.x * NTHREADS + F.tid; idx < 2 * T; idx += F.G * NTHREADS) {
        const int e = toke[idx]; const int pos = offs[e] + tokr[idx];
        tokp[idx] = pos; roww[pos] = tokw[idx]; rowt[pos] = idx >> 1;
    }
    if (l == 0) moe_convert(F, 0, F.gw, F.NGW);
}

#ifndef SCAN_DUP
#define SCAN_DUP 0
#endif
namespace wk {
constexpr int P = 72, PB = 144, MAT = 64 * PB;
constexpr int PF = 68;
constexpr int O_NAB = 0, O_GS = 17408, O_GC = 19456, O_M0 = 20480;
constexpr int O_AT = O_M0, O_RT = O_AT + MAT, O_BT = O_RT + MAT, O_KT = O_BT + MAT, O_VV = O_KT + MAT, O_LAK = O_VV + MAT, O_MRB = O_LAK + MAT, O_MRK = O_MRB + MAT,
              O_NB = O_MRK + MAT, O_TT = O_NB + MAT, O_XT = O_TT + MAT, O_UT = O_XT + MAT, O_MT = O_UT + MAT, O_H0 = O_MT + MAT, O_H1 = O_H0 + MAT, O_END = O_H1 + MAT;
static_assert(O_END <= LDS_MISC, "scan LDS map");
typedef union { u32x4 u; bf16x8 v; } frag_t;
__device__ __forceinline__ bf16x8 zfrag() { frag_t z; z.u = (u32x4){0u, 0u, 0u, 0u}; return z.v; }
__device__ __forceinline__ bf16x8 ldrow(const LAS unsigned char* M, int row, int col) { return *(const LAS bf16x8*)(M + row * PB + col * 2); }
__device__ __forceinline__ bf16x8 ldtr(unsigned base, int r0, int c0, int lane) {
    const int g = lane >> 4, i = lane & 15, qq = i >> 2, p = i & 3;
    const unsigned a0 = base + (unsigned)((r0 + 8 * g + qq) * PB + (c0 + 4 * p) * 2), a1 = a0 + 4u * PB;
    u32x2 lo, hi;
    asm volatile("ds_read_b64_tr_b16 %0, %2\n\tds_read_b64_tr_b16 %1, %3\n\ts_waitcnt lgkmcnt(0)" : "=&v"(lo), "=&v"(hi) : "v"(a0), "v"(a1) : "memory");
    frag_t f; f.u.x = lo.x; f.u.y = lo.y; f.u.z = hi.x; f.u.w = hi.y; return f.v;
}
__device__ __forceinline__ void st4bf(LAS unsigned char* M, int row, int col, const f32x4& v) { u32x2 w; w.x = pk2(v[0], v[1]); w.y = pk2(v[2], v[3]); *(LAS u32x2*)(M + row * PB + col * 2) = w; }
#define WK_MFMA(a, b, c) __builtin_amdgcn_mfma_f32_16x16x32_bf16(a, b, c, 0, 0, 0)
template <int M> __device__ __forceinline__ float rshare(float v) { return __int_as_float(__builtin_amdgcn_update_dpp(0, __float_as_int(v), 0x150 + M, 0xf, 0xf, false)); }
#define WK_BAR() do { asm volatile("s_waitcnt lgkmcnt(0)" ::: "memory"); __builtin_amdgcn_s_barrier(); asm volatile("" ::: "memory"); } while (0)
}

__device__ __forceinline__ void phase_scan(Frame& F, int l) {
    using namespace wk;
    const int j = l >> 1;
    const bf16* Rb = (const bf16*)(F.ws + WS_ACT + A_RKV); const bf16* Kb = Rb + (size_t)T * D; const bf16* Vb = Kb + (size_t)T * D;
    const bf16* LD = (const bf16*)(F.ws + WS_ACT + A_LDEC); const bf16* AS = (const bf16*)(F.ws + WS_ACT + A_ASIG);
    bf16* Y = (bf16*)(F.ws + WS_ACT + A_Y); float* SB = (float*)(F.ws + WS_SB);
    LAS unsigned char* L = F.lds; const unsigned La = (unsigned)(size_t)L;
    LAS float* NAB = (LAS float*)(L + O_NAB); LAS float* GS = (LAS float*)(L + O_GS); LAS float* GC = (LAS float*)(L + O_GC);
    const int tid0 = F.tid, wave = F.wave;
    for (int unit = blockIdx.x; unit < NB * NH_R * 2; unit += F.G) {
        const int b = unit >> 5, h = (unit >> 1) & 15, dir = unit & 1; const int col = h * 64 + 8 * (tid0 & 7);
        f32x4 kkc[2], kac[2], rkc[2];
#pragma unroll
        for (int e = 0; e < 2; ++e) { kkc[e] = *(const f32x4*)(F.in[I_KK] + j * D + col + 4 * e); kac[e] = *(const f32x4*)(F.in[I_KA] + j * D + col + 4 * e); rkc[e] = *(const f32x4*)(F.in[I_RK] + j * D + col + 4 * e); }
        for (int i = tid0; i < (O_END - O_LAK) / 16; i += NTHREADS) *(LAS u32x4*)(L + O_LAK + i * 16) = (u32x4){0u, 0u, 0u, 0u};
        f32x4 Hs[4];
        f32x4 Yh[4];
#define WK_YFLUSH(cc) do { if (wave >= 4) { const int lane_ = tid0 & 63, qi_ = lane_ & 15, q4_ = lane_ >> 4, vj_ = wave - 4; \
            _Pragma("unroll") for (int ti_ = 0; ti_ < 4; ++ti_) _Pragma("unroll") for (int r_ = 0; r_ < 4; ++r_) { const int st_ = (cc) * 64 + 16 * ti_ + 4 * q4_ + r_; const int t_ = dir ? (SEQ - 1 - st_) : st_; \
                Y[((size_t)dir * T + (size_t)b * SEQ + t_) * D + h * 64 + 16 * vj_ + qi_] = (bf16)f2bf(Yh[ti_][r_]); } } } while (0)
#pragma unroll
        for (int vj = 0; vj < 4; ++vj) Hs[vj] = (f32x4){0.f, 0.f, 0.f, 0.f};
        u32x4 gr, gk, gv, gl, ga;
#define WK_LOAD(c) do { const int st = (c) * 64 + (tid0 >> 3); const int t = dir ? (SEQ - 1 - st) : st; const size_t ro = ((size_t)b * SEQ + t) * D + col; \
            gr = *(const u32x4*)(Rb + ro); gk = *(const u32x4*)(Kb + ro); gv = *(const u32x4*)(Vb + ro); gl = *(const u32x4*)(LD + (size_t)dir * T * D + ro); ga = *(const u32x4*)(AS + (size_t)dir * T * D + ro); } while (0)
        WK_LOAD(0);
        WK_BAR();
        for (int c = 0; c < SEQ / 64; ++c) {
            int tid = tid0; asm volatile("" : "+v"(tid));
            const int lane = tid & 63, qi = lane & 15, q4 = lane >> 4, pt = tid >> 3, c8 = tid & 7;
            LAS unsigned char* H0 = L + ((c & 1) ? O_H1 : O_H0); LAS unsigned char* H1 = L + ((c & 1) ? O_H0 : O_H1);
            for (int sd0_ = 0; sd0_ < 1 + ((SCAN_DUP >> 0) & 1); ++sd0_) {
            float av[8], bv[8], kdv[8], rv[8], ldv[8];
            {
                const unsigned gku[4] = {gk.x, gk.y, gk.z, gk.w}, gru[4] = {gr.x, gr.y, gr.z, gr.w}, glu[4] = {gl.x, gl.y, gl.z, gl.w}, gau[4] = {ga.x, ga.y, ga.z, ga.w};
                float kf[8], af[8], kkv[8]; float ss = 0.f;
#pragma unroll
                for (int e = 0; e < 4; ++e) { kf[2 * e] = bf_lo(gku[e]); kf[2 * e + 1] = bf_hi(gku[e]); rv[2 * e] = bf_lo(gru[e]); rv[2 * e + 1] = bf_hi(gru[e]);
                    ldv[2 * e] = bf_lo(glu[e]); ldv[2 * e + 1] = bf_hi(glu[e]); af[2 * e] = bf_lo(gau[e]); af[2 * e + 1] = bf_hi(gau[e]); }
#pragma unroll
                for (int e = 0; e < 8; ++e) { kkv[e] = kf[e] * kkc[e >> 2][e & 3]; ss += kkv[e] * kkv[e]; }
                ss = sum8(ss);
                const float inv = 1.0f / fmaxf(sqrtf(ss), 1e-12f); float bo = 0.f;
#pragma unroll
                for (int e = 0; e < 8; ++e) { const float kn = kkv[e] * inv; kdv[e] = kf[e] * (1.0f + (af[e] - 1.0f) * kac[e >> 2][e & 3]); av[e] = -kn; bv[e] = kn * af[e]; bo += rv[e] * kdv[e] * rkc[e >> 2][e & 3]; }
                bo = sum8(bo);
                const int st = c * 64 + pt; const int t = dir ? (SEQ - 1 - st) : st;
                if (c8 == 0) SB[((size_t)dir * T + (size_t)b * SEQ + t) * 16 + h] = bo;
                *(LAS f32x4*)(NAB + pt * PF + 8 * c8) = (f32x4){ldv[0], ldv[1], ldv[2], ldv[3]}; *(LAS f32x4*)(NAB + pt * PF + 8 * c8 + 4) = (f32x4){ldv[4], ldv[5], ldv[6], ldv[7]};
                *(LAS u32x4*)(L + O_VV + pt * PB + 16 * c8) = gv;
            }
            if (sd0_ == ((SCAN_DUP >> 0) & 1)) { if (c > 0) WK_YFLUSH(c - 1); if (c + 1 < SEQ / 64) WK_LOAD(c + 1); }
            WK_BAR();
            { const int kc = tid & 63, g = tid >> 6; float pre[8]; float p = 0.f;
#pragma unroll
              for (int i = 0; i < 8; ++i) { p += NAB[(8 * g + i) * PF + kc]; pre[i] = p; }
              GS[g * 64 + kc] = p;
              WK_BAR();
              float off = 0.f;
#pragma unroll
              for (int gg = 0; gg < 7; ++gg) off += (gg < g) ? GS[gg * 64 + kc] : 0.f;
#pragma unroll
              for (int i = 0; i < 8; ++i) NAB[(8 * g + i) * PF + kc] = off + pre[i]; }
            WK_BAR();
            { f32x4 cl[2], cm[2];
#pragma unroll
              for (int e = 0; e < 2; ++e) { cl[e] = *(const LAS f32x4*)(NAB + pt * PF + 8 * c8 + 4 * e); cm[e] = (pt > 0) ? *(const LAS f32x4*)(NAB + (pt - 1) * PF + 8 * c8 + 4 * e) : (f32x4){0.f, 0.f, 0.f, 0.f}; }
              float oa[8], orr[8], ob[8], ok[8];
#pragma unroll
              for (int e = 0; e < 8; ++e) { const float c1 = cl[e >> 2][e & 3], c0 = cm[e >> 2][e & 3]; const float gp = __builtin_amdgcn_exp2f(c1), gn = __builtin_amdgcn_exp2f(-c1), g0 = __builtin_amdgcn_exp2f(c0);
                  oa[e] = av[e] * g0; orr[e] = rv[e] * gp; ob[e] = bv[e] * gn; ok[e] = kdv[e] * gn; if (pt == 63) GC[8 * c8 + e] = gp; }
              *(LAS u32x4*)(L + O_AT + pt * PB + 16 * c8) = (u32x4){pk2(oa[0], oa[1]), pk2(oa[2], oa[3]), pk2(oa[4], oa[5]), pk2(oa[6], oa[7])};
              *(LAS u32x4*)(L + O_RT + pt * PB + 16 * c8) = (u32x4){pk2(orr[0], orr[1]), pk2(orr[2], orr[3]), pk2(orr[4], orr[5]), pk2(orr[6], orr[7])};
              *(LAS u32x4*)(L + O_BT + pt * PB + 16 * c8) = (u32x4){pk2(ob[0], ob[1]), pk2(ob[2], ob[3]), pk2(ob[4], ob[5]), pk2(ob[6], ob[7])};
              *(LAS u32x4*)(L + O_KT + pt * PB + 16 * c8) = (u32x4){pk2(ok[0], ok[1]), pk2(ok[2], ok[3]), pk2(ok[4], ok[5]), pk2(ok[6], ok[7])}; }
            WK_BAR();
            }
            f32x4 X0[4], Y0[4];
            for (int sd1_ = 0; sd1_ < 1 + ((SCAN_DUP >> 1) & 1); ++sd1_) {
#pragma unroll
            for (int jj = 0; jj < 5; ++jj) {
                const int idx = wave * 5 + jj, blk = idx / 10, tri = idx % 10;
                const int ti = (tri >= 6) ? 3 : ((tri >= 3) ? 2 : ((tri >= 1) ? 1 : 0)); const int si = tri - (ti * (ti + 1)) / 2;
                const LAS unsigned char* Pm = L + ((blk < 2) ? O_AT : O_RT); const LAS unsigned char* Qm = L + ((blk & 1) ? O_KT : O_BT);
                f32x4 acc = {0.f, 0.f, 0.f, 0.f};
#pragma unroll
                for (int ks = 0; ks < 2; ++ks) acc = WK_MFMA(ldrow(Qm, 16 * si + qi, 32 * ks + 8 * q4), ldrow(Pm, 16 * ti + qi, 32 * ks + 8 * q4), acc);
                const int tt = 16 * ti + qi, s0 = 16 * si + 4 * q4;
#pragma unroll
                for (int r = 0; r < 4; ++r) { const int sidx = s0 + r; const bool keep = (blk < 2) ? (sidx < tt) : (sidx <= tt); acc[r] = keep ? acc[r] : 0.f; }
                if (blk == 0) { *(LAS f32x4*)(NAB + tt * PF + s0) = acc; st4bf(L + O_NB, tt, s0, acc); }
                else st4bf(L + (blk == 1 ? O_LAK : (blk == 2 ? O_MRB : O_MRK)), tt, s0, acc);
            }
            WK_BAR();
            }
            for (int sd2_ = 0; sd2_ < 1 + ((SCAN_DUP >> 2) & 1); ++sd2_) {
            if (wave >= 4) { const int vj = wave - 4;
#pragma unroll
                for (int ti = 0; ti < 4; ++ti) { X0[ti] = (f32x4){0.f, 0.f, 0.f, 0.f}; Y0[ti] = (f32x4){0.f, 0.f, 0.f, 0.f};
#pragma unroll
                    for (int ks = 0; ks < 2; ++ks) if (ks <= (ti >> 1)) { const bf16x8 vf = ldtr(La + O_VV, 32 * ks, 16 * vj, lane);
                        X0[ti] = WK_MFMA(ldrow(L + O_LAK, 16 * ti + qi, 32 * ks + 8 * q4), vf, X0[ti]); Y0[ti] = WK_MFMA(ldrow(L + O_MRK, 16 * ti + qi, 32 * ks + 8 * q4), vf, Y0[ti]); } } }
            if (wave == 0) {
                const int blk = q4, cj = qi; float nrow[16], x[16];
#pragma unroll
                for (int r = 0; r < 16; ++r) nrow[r] = NAB[(16 * blk + r) * PF + 16 * blk + cj];
#pragma unroll
                for (int r = 0; r < 16; ++r) { float acc = (r == cj) ? 1.0f : 0.0f;
#define WK_SUBM(m) if (m < r) acc += wk::rshare<m>(nrow[r]) * x[m];
                    WK_SUBM(0) WK_SUBM(1) WK_SUBM(2) WK_SUBM(3) WK_SUBM(4) WK_SUBM(5) WK_SUBM(6) WK_SUBM(7) WK_SUBM(8) WK_SUBM(9) WK_SUBM(10) WK_SUBM(11) WK_SUBM(12) WK_SUBM(13) WK_SUBM(14)
#undef WK_SUBM
                    x[r] = acc; *(LAS bf16*)(L + O_TT + (16 * blk + r) * PB + (16 * blk + cj) * 2) = (bf16)f2bf(acc); }
            }
            WK_BAR();
            if (wave < 2) {
                const int i = 2 * wave + 1, jb = 2 * wave;
                bf16x8 a = ldrow(L + O_NB, 16 * i + qi, 16 * jb + 8 * (q4 & 1)), bfr = ldtr(La + O_TT, 16 * jb - 8 * (q4 & 2), 16 * jb, lane);
                if (q4 >= 2) { a = zfrag(); bfr = zfrag(); }
                f32x4 acc = {0.f, 0.f, 0.f, 0.f}; acc = WK_MFMA(a, bfr, acc);
                st4bf(L + O_MT, 16 * wave + qi, 4 * q4, acc);
            }
            WK_BAR();
            if (wave < 2) {
                const int i = 2 * wave + 1, jb = 2 * wave;
                bf16x8 a = ldrow(L + O_TT, 16 * i + qi, 16 * i + 8 * (q4 & 1)), bfr = ldrow(L + O_MT, 16 * wave + qi, 8 * (q4 & 1));
                if (q4 >= 2) { a = zfrag(); bfr = zfrag(); }
                f32x4 acc = {0.f, 0.f, 0.f, 0.f}; acc = WK_MFMA(a, bfr, acc);
#pragma unroll
                for (int r = 0; r < 4; ++r) *(LAS bf16*)(L + O_TT + (16 * i + 4 * q4 + r) * PB + (16 * jb + qi) * 2) = (bf16)f2bf(acc[r]);
            }
            WK_BAR();
            if (wave < 4) {
                const int ti2 = wave >> 1, tj2 = wave & 1;
                f32x4 acc = {0.f, 0.f, 0.f, 0.f}; acc = WK_MFMA(ldrow(L + O_NB, 32 + 16 * ti2 + qi, 8 * q4), ldtr(La + O_TT, 0, 16 * tj2, lane), acc);
                st4bf(L + O_MT, 32 + 16 * tj2 + qi, 16 * ti2 + 4 * q4, acc);
            }
            WK_BAR();
            if (wave < 4) {
                const int ti2 = wave >> 1, tj2 = wave & 1;
                f32x4 acc = {0.f, 0.f, 0.f, 0.f}; acc = WK_MFMA(ldrow(L + O_TT, 32 + 16 * ti2 + qi, 32 + 8 * q4), ldrow(L + O_MT, 32 + 16 * tj2 + qi, 8 * q4), acc);
#pragma unroll
                for (int r = 0; r < 4; ++r) *(LAS bf16*)(L + O_TT + (32 + 16 * ti2 + 4 * q4 + r) * PB + (16 * tj2 + qi) * 2) = (bf16)f2bf(acc[r]);
            }
            }
            for (int sd3_ = 0; sd3_ < 1 + ((SCAN_DUP >> 3) & 1); ++sd3_) {
            if (wave >= 4) { const int vj = wave - 4;
#pragma unroll
                for (int ti = 0; ti < 4; ++ti) { f32x4 acc = X0[ti];
#pragma unroll
                    for (int ks = 0; ks < 2; ++ks) acc = WK_MFMA(ldrow(L + O_AT, 16 * ti + qi, 32 * ks + 8 * q4), ldrow(H0, 16 * vj + qi, 32 * ks + 8 * q4), acc);
                    st4bf(L + O_XT, 16 * vj + qi, 16 * ti + 4 * q4, acc); } }
            WK_BAR();
#pragma unroll
            for (int e = 0; e < 2; ++e) { const int id = wave * 2 + e, ti = id >> 2, vj = id & 3; f32x4 acc = {0.f, 0.f, 0.f, 0.f};
#pragma unroll
                for (int ks = 0; ks < 2; ++ks) if (ks <= (ti >> 1)) acc = WK_MFMA(ldrow(L + O_TT, 16 * ti + qi, 32 * ks + 8 * q4), ldrow(L + O_XT, 16 * vj + qi, 32 * ks + 8 * q4), acc);
                st4bf(L + O_UT, 16 * vj + qi, 16 * ti + 4 * q4, acc); }
            WK_BAR();
            }
            f32x4 Hsave[4]; for (int vj_ = 0; vj_ < 4; ++vj_) Hsave[vj_] = Hs[vj_];
            for (int sd5_ = 0; sd5_ < 1 + ((SCAN_DUP >> 4) & 1); ++sd5_) {
            for (int vj_ = 0; vj_ < 4; ++vj_) Hs[vj_] = Hsave[vj_];
            if (wave >= 4) { const int vj = wave - 4;
#pragma unroll
                for (int ti = 0; ti < 4; ++ti) { f32x4 acc = Y0[ti];
#pragma unroll
                    for (int ks = 0; ks < 2; ++ks) { acc = WK_MFMA(ldrow(L + O_RT, 16 * ti + qi, 32 * ks + 8 * q4), ldrow(H0, 16 * vj + qi, 32 * ks + 8 * q4), acc);
                        if (ks <= (ti >> 1)) acc = WK_MFMA(ldrow(L + O_MRB, 16 * ti + qi, 32 * ks + 8 * q4), ldrow(L + O_UT, 16 * vj + qi, 32 * ks + 8 * q4), acc); }
                    Yh[ti] = acc; } }
            else { const int kt = wave; const f32x4 gc = *(const LAS f32x4*)(GC + 16 * kt + 4 * q4);
#pragma unroll
                for (int ks = 0; ks < 2; ++ks) { const bf16x8 bt = ldtr(La + O_BT, 32 * ks, 16 * kt, lane), ktf = ldtr(La + O_KT, 32 * ks, 16 * kt, lane);
#pragma unroll
                    for (int vj = 0; vj < 4; ++vj) { Hs[vj] = WK_MFMA(bt, ldrow(L + O_UT, 16 * vj + qi, 32 * ks + 8 * q4), Hs[vj]); Hs[vj] = WK_MFMA(ktf, ldtr(La + O_VV, 32 * ks, 16 * vj, lane), Hs[vj]); } }
#pragma unroll
                for (int vj = 0; vj < 4; ++vj) { Hs[vj] = Hs[vj] * gc; st4bf(H1, 16 * vj + qi, 16 * kt + 4 * q4, Hs[vj]); } }
            WK_BAR();
            }
        }
        WK_YFLUSH(SEQ / 64 - 1);
#undef WK_LOAD
#undef WK_YFLUSH
    }
}

__device__ __forceinline__ void phase_rw_post(Frame& F, int l) {
    const int j = l >> 1; const float* lnw = F.in[I_LNW] + j * D; const float* lnb = F.in[I_LNB] + j * D;
    const bf16* Vb = (const bf16*)(F.ws + WS_ACT + A_RKV) + (size_t)2 * T * D; const bf16* Y = (const bf16*)(F.ws + WS_ACT + A_Y); const bf16* Gb = (const bf16*)(F.ws + WS_ACT + A_G);
    const float* SB = (const float*)(F.ws + WS_SB); bf16* O = (bf16*)(F.ws + WS_ACT + A_O);
    for (int row = F.gw; row < T; row += F.NGW) {
        f32x4 o[4];
#pragma unroll
        for (int q = 0; q < 4; ++q) {
            const int c = 4 * F.lane + 256 * q; const int head = 4 * q + (F.lane >> 4);
            const u32x2 vr = *(const u32x2*)(Vb + (size_t)row * D + c); const f32x4 vf = {bf_lo(vr.x), bf_hi(vr.x), bf_lo(vr.y), bf_hi(vr.y)};
            const f32x4 w = *(const f32x4*)(lnw + c), bb = *(const f32x4*)(lnb + c);
            f32x4 acc = {0.f, 0.f, 0.f, 0.f};
#pragma unroll
            for (int dir = 0; dir < 2; ++dir) {
                const size_t ro = ((size_t)dir * T + row) * D + c;
                const u32x2 yr = *(const u32x2*)(Y + ro), gr = *(const u32x2*)(Gb + ro);
                const f32x4 yf = {bf_lo(yr.x), bf_hi(yr.x), bf_lo(yr.y), bf_hi(yr.y)}; const f32x4 gf = {bf_lo(gr.x), bf_hi(gr.x), bf_lo(gr.y), bf_hi(gr.y)};
                const float sbv = SB[((size_t)dir * T + row) * 16 + head];
                const float mean = rowsum16((yf[0] + yf[1]) + (yf[2] + yf[3])) * (1.0f / 64.0f);
                const f32x4 d = yf - mean; const float var = rowsum16((d[0] * d[0] + d[1] * d[1]) + (d[2] * d[2] + d[3] * d[3])) * (1.0f / 64.0f);
                const float rs = rsqrtf(var + GN_EPS);
                acc += gf * (d * rs * w + bb + sbv * vf);
            }
            o[q] = acc;
        }
        row_store_bf16(O + (size_t)row * D, F.lane, o);
    }
}

__device__ __forceinline__ unsigned att_f(unsigned row) { return ((row & 3u) << 2) | ((row >> 2) & 3u); }
__device__ __forceinline__ unsigned att_off_b(unsigned row, unsigned ch) { return 256u * row + 16u * (ch ^ att_f(row)); }
__device__ __forceinline__ void phase_attn(Frame& F, bool dry = false) {
    bf16* Qb = (bf16*)(F.ws + WS_ACT + A_Q); const bf16* Kb = (const bf16*)(F.ws + WS_ACT + A_K); const bf16* Vb = (const bf16*)(F.ws + WS_ACT + A_VT);
    float* LSE = (float*)(F.ws + WS_SB);
    const int lane = F.lane, qi = lane & 15, q4 = lane >> 4, wave = F.wave;
    LAS unsigned char* KW = F.lds; LAS unsigned char* VW = F.lds + 65536;
    const unsigned vw_a = (unsigned)(size_t)VW;
    unsigned ka[2][4], va[8][2];
#pragma unroll
    for (int rb = 0; rb < 2; ++rb)
#pragma unroll
        for (int s = 0; s < 4; ++s) ka[rb][s] = att_off_b((unsigned)(qi + 16 * rb), (unsigned)(4 * s + q4));
    { const unsigned q = (unsigned)qi >> 2, p = (unsigned)lane & 3u;
#pragma unroll
      for (int c = 0; c < 8; ++c)
#pragma unroll
          for (int t = 0; t < 2; ++t) va[c][t] = vw_a + att_off_b(8u * q4 + 4u * t + q, 2u * c + (p >> 1)) + 8u * (p & 1u); }
    unsigned fk[8];
#pragma unroll
    for (int i = 0; i < 8; ++i) { const unsigned rho = 4u * i + (unsigned)q4, m = rho & 15u, rb = rho >> 4; const unsigned kidx = 8u * (m >> 2) + (m & 3u) + 4u * rb;
        fk[i] = kidx | ((16u * ((unsigned)qi ^ att_f(rho))) << 8); }
    const int nper = (F.G >= 8) ? (F.G >> 3) : 1;
    for (int k = (F.G >= 8 && (F.G & 7) == 0) ? (int)(blockIdx.x >> 3) : (int)blockIdx.x; k < ((F.G >= 8 && (F.G & 7) == 0) ? 3 * NB * 16 : 3 * NB * 8 * 16); k += ((F.G >= 8 && (F.G & 7) == 0) ? nper : F.G)) {
        int g, b, hs, cc;
        if (F.G >= 8 && (F.G & 7) == 0) { hs = blockIdx.x & 7; cc = k & 15; b = (k >> 4) & 7; g = k >> 7; }
        else { g = k >> 10; b = (k >> 7) & 7; hs = (k >> 4) & 7; cc = k & 15; }
        const int dsh = 2 * g, Lg = SEQ >> dsh; const int cls = (g == 0) ? 0 : ((g == 1) ? (cc >> 2) : cc); const int chunk = (g == 0) ? cc : ((g == 1) ? (cc & 3) : 0);
        const int P0 = 128 * chunk;
        asm volatile("s_waitcnt lgkmcnt(0)" ::: "memory"); __builtin_amdgcn_s_barrier(); asm volatile("" ::: "memory");
        { const int base_ = P0 - 64 + 32 * wave;
          const bf16* ksrc = Kb + ((size_t)g * T + (size_t)b * SEQ) * D + hs * 128; const bf16* vsrc = Vb + ((size_t)g * T + (size_t)b * SEQ) * D + hs * 128;
#pragma unroll
          for (int i = 0; i < 8; ++i) { const int pk = min(max(base_ + (int)(fk[i] & 255u), 0), Lg - 1), pv = min(max(base_ + 4 * i + q4, 0), Lg - 1);
              __builtin_amdgcn_global_load_lds((const unsigned*)((const char*)(ksrc + (size_t)(cls + (pk << dsh)) * D) + (fk[i] >> 8)), (LAS unsigned*)(KW + wave * 8192 + i * 1024), 16, 0, 0);
              __builtin_amdgcn_global_load_lds((const unsigned*)((const char*)(vsrc + (size_t)(cls + (pv << dsh)) * D) + (fk[i] >> 8)), (LAS unsigned*)(VW + wave * 8192 + i * 1024), 16, 0, 0); } }
        const int Pq = P0 + 16 * wave + qi; const size_t qrow = (size_t)g * T + (size_t)b * SEQ + (size_t)(cls + (Pq << dsh));
        bf16* qp = Qb + qrow * D + hs * 128;
        bf16x8 Qf[4];
#pragma unroll
        for (int kt = 0; kt < 4; ++kt) Qf[kt] = *(const bf16x8*)(qp + 8 * q4 + 32 * kt);
        const float slope2 = exp2f(-8.0f * (float)(g * 8 + hs + 1) / 24.0f) * LOG2E * (float)(1 << dsh);
        float m_run = -1e30f, l_run = 0.f; f32x4 O[8];
#pragma unroll
        for (int dt = 0; dt < 8; ++dt) O[dt] = (f32x4){0.f, 0.f, 0.f, 0.f};
        asm volatile("s_waitcnt vmcnt(0)" ::: "memory"); __builtin_amdgcn_s_barrier(); asm volatile("" ::: "memory");
#pragma unroll
        for (int s = 0; s < 5; ++s) {
            const int tb = (wave >> 1) + s; const LAS unsigned char* kl = KW + tb * 8192; const unsigned voff = (unsigned)tb * 8192u;
            bf16x8 KA[4], KB[4];
#pragma unroll
            for (int kt = 0; kt < 4; ++kt) { KA[kt] = *(const LAS bf16x8*)(kl + ka[0][kt]); KB[kt] = *(const LAS bf16x8*)(kl + ka[1][kt]); }
            f32x4 SA = {0.f, 0.f, 0.f, 0.f}, SBt = {0.f, 0.f, 0.f, 0.f};
#pragma unroll
            for (int kt = 0; kt < 4; ++kt) { SA = __builtin_amdgcn_mfma_f32_16x16x32_bf16(KA[kt], Qf[kt], SA, 0, 0, 0); SBt = __builtin_amdgcn_mfma_f32_16x16x32_bf16(KB[kt], Qf[kt], SBt, 0, 0, 0); }
            const int cb = P0 - 64 + 32 * tb + 8 * q4;
            float sv[8]; bool ok[8]; float mx = -1e30f;
#pragma unroll
            for (int r = 0; r < 8; ++r) { const int p = cb + r; const int rel = abs(p - Pq); ok[r] = (p >= 0) && (p < Lg) && (rel <= 64);
                const float sc = (r < 4 ? SA[r & 3] : SBt[r & 3]) - slope2 * (float)rel; sv[r] = ok[r] ? sc : -1e30f; mx = fmaxf(mx, sv[r]); }
            mx = bfly16_max(mx); mx = bfly32_max(mx);
            const float m_new = fmaxf(m_run, mx); const float alpha = __builtin_amdgcn_exp2f(m_run - m_new); m_run = m_new;
            float pe[8]; float rs = 0.f;
#pragma unroll
            for (int r = 0; r < 8; ++r) { pe[r] = ok[r] ? __builtin_amdgcn_exp2f(sv[r] - m_new) : 0.f; rs += pe[r]; }
            rs = bfly16_sum(rs); rs = bfly32_sum(rs);
            l_run = l_run * alpha + rs;
            union { u32x4 u; bf16x8 v; } pf; pf.u.x = pk2(pe[0], pe[1]); pf.u.y = pk2(pe[2], pe[3]); pf.u.z = pk2(pe[4], pe[5]); pf.u.w = pk2(pe[6], pe[7]);
#pragma unroll
            for (int hf = 0; hf < 2; ++hf) {
                u32x2 vr[4][2];
                asm volatile("ds_read_b64_tr_b16 %0, %8\n\tds_read_b64_tr_b16 %1, %9\n\tds_read_b64_tr_b16 %2, %10\n\tds_read_b64_tr_b16 %3, %11\n\t"
                             "ds_read_b64_tr_b16 %4, %12\n\tds_read_b64_tr_b16 %5, %13\n\tds_read_b64_tr_b16 %6, %14\n\tds_read_b64_tr_b16 %7, %15\n\ts_waitcnt lgkmcnt(0)"
                             : "=&v"(vr[0][0]), "=&v"(vr[0][1]), "=&v"(vr[1][0]), "=&v"(vr[1][1]), "=&v"(vr[2][0]), "=&v"(vr[2][1]), "=&v"(vr[3][0]), "=&v"(vr[3][1])
                             : "v"(va[4 * hf + 0][0] + voff), "v"(va[4 * hf + 0][1] + voff), "v"(va[4 * hf + 1][0] + voff), "v"(va[4 * hf + 1][1] + voff), "v"(va[4 * hf + 2][0] + voff), "v"(va[4 * hf + 2][1] + voff), "v"(va[4 * hf + 3][0] + voff), "v"(va[4 * hf + 3][1] + voff)
                             : "memory");
#pragma unroll
                for (int c = 0; c < 4; ++c) { const int dt = 4 * hf + c; union { u32x4 u; bf16x8 v; } vf; vf.u.x = vr[c][0].x; vf.u.y = vr[c][0].y; vf.u.z = vr[c][1].x; vf.u.w = vr[c][1].y;
                    O[dt] = O[dt] * alpha; O[dt] = __builtin_amdgcn_mfma_f32_16x16x32_bf16(vf.v, pf.v, O[dt], 0, 0, 0); }
            }
        }
        const float inv = 1.0f / l_run;
#pragma unroll
        for (int dt = 0; dt < 8; ++dt) { u32x2 o; o.x = pk2(O[dt][0] * inv, O[dt][1] * inv); o.y = pk2(O[dt][2] * inv, O[dt][3] * inv); if (!dry) *(u32x2*)(qp + 4 * q4 + 16 * dt) = o; else asm volatile("" :: "v"(o.x), "v"(o.y)); }
        if (q4 == 0 && !dry) LSE[qrow * 8 + hs] = m_run + __builtin_amdgcn_logf(l_run);
    }
}
__device__ __forceinline__ void phase_attn_merge(Frame& F) {
    const bf16* Ob = (const bf16*)(F.ws + WS_ACT + A_Q); const float* LSE = (const float*)(F.ws + WS_SB); bf16* AO = (bf16*)(F.ws + WS_ACT + A_AO);
    for (int row = F.gw; row < T; row += F.NGW) {
        f32x4 o[4];
#pragma unroll
        for (int q = 0; q < 4; ++q) { const int c = 4 * F.lane + 256 * q; const int head = 2 * q + (F.lane >> 5);
            float ls[3];
#pragma unroll
            for (int g = 0; g < 3; ++g) ls[g] = LSE[((size_t)g * T + row) * 8 + head];
            const float mx = fmaxf(ls[0], fmaxf(ls[1], ls[2]));
            float w[3]; float sum = 0.f;
#pragma unroll
            for (int g = 0; g < 3; ++g) { w[g] = __builtin_amdgcn_exp2f(ls[g] - mx); sum += w[g]; }
            const float inv = 1.0f / sum; f32x4 acc = {0.f, 0.f, 0.f, 0.f};
#pragma unroll
            for (int g = 0; g < 3; ++g) { const u32x2 r = *(const u32x2*)(Ob + ((size_t)g * T + row) * D + c); const float a = w[g] * inv;
                acc[0] += a * bf_lo(r.x); acc[1] += a * bf_hi(r.x); acc[2] += a * bf_lo(r.y); acc[3] += a * bf_hi(r.y); }
            o[q] = acc; }
        row_store_bf16(AO + (size_t)row * D, F.lane, o);
    }
}

constexpr int PH_PER_LAYER = 10, N_PHASES = 1 + DEPTH * PH_PER_LAYER + 1;
template <int MASK> __global__ void __launch_bounds__(NTHREADS, 2) mk_fwd(Args args) {
    extern __shared__ __attribute__((aligned(16))) unsigned char lds_raw[];
#define PHASE_FRAME() Frame F; { int t_ = wave0 * 64 + lane_id_nh(); asm volatile("" : "+v"(t_)); size_t z_ = 0; asm volatile("" : "+s"(z_)); unsigned char* w_ = args.ws + z_;     \
        unsigned lb_ = 0; asm volatile("" : "+s"(lb_)); F.lds = (LAS unsigned char*)lds_raw + lb_; F.tid = t_; F.lane = t_ & 63; F.wave = __builtin_amdgcn_readfirstlane(t_ >> 6); \
        F.G = gridDim.x; F.gw = blockIdx.x * NWAVES + F.wave; F.NGW = F.G * NWAVES; F.ws = w_; F.in = args.in; F.out = args.out; }
    LAS unsigned char* lds0 = (LAS unsigned char*)lds_raw;
    const int wave0 = __builtin_amdgcn_readfirstlane((int)threadIdx.x >> 6);
    volatile LAS unsigned* MISC = (volatile LAS unsigned*)(lds0 + MISC_OFF);
    if (wave0 == 0) ((LAS unsigned*)(lds0 + LDS_MISC))[lane_id_nh() + 64] = 0u;
    __syncthreads();
    unsigned* ctl = (unsigned*)(args.ws + WS_CTL);
    XcdBarrier bar; bar.bar = ctl + CW_BAR; bar.x = 0; bar.st = nullptr;
#if ONE_LAUNCH
    bar = xcd_barrier_post(ctl + CW_BAR, MISC + 8, wave0 == 0 && lane_id_nh() == 0);
#endif
    const int lo = args.ph_lo, hi = args.ph_hi;
#define EN(b) ((MASK >> (b)) & 1)
#ifndef DUP_MASK
#define DUP_MASK 0
#endif
#define REP(b) for (int rep_ = 0; rep_ < 1 + ((DUP_MASK >> (b)) & 1); ++rep_)
#define IN(k) (lo <= (k) && (k) < hi)
#if ONE_LAUNCH
#ifndef BAR_REP
#define BAR_REP 1
#endif
#define SEAM(k) do { if (IN((k) + 1) || (k) + 1 < hi) { for (int br_ = 0; br_ < BAR_REP; ++br_) xcd_barrier(bar, wave0 == 0 && lane_id_nh() == 0); } } while (0)
#else
#define SEAM(k) do { } while (0)
#endif
    bf16* X0 = (bf16*)(args.ws + WS_X1); bf16* X1 = X0 + (size_t)T * D;
    if (EN(0) && IN(0)) { PHASE_FRAME(); REP(0) phase_prologue(F); SEAM(0); }
    for (int l = 0; l < DEPTH; ++l) {
        const int pb = 1 + l * PH_PER_LAYER; const int j = l >> 1;
        const void* xin = (l == 0) ? (const void*)args.in[I_X] : (const void*)((l & 1) ? X0 : X1);
        bf16* xcur = (l == 0) ? X0 : ((l & 1) ? X1 : X0);
        if ((l & 1) == 0) {
            if (EN(1) && IN(pb + 0)) { PHASE_FRAME(); REP(1) phase_rw_norm(F, l, l > 0, xin, xcur); SEAM(pb + 0); }
            if (EN(2) && IN(pb + 1)) { PHASE_FRAME(); REP(2) {
                { DenseSched S; S.o.init(T / 256, 2, F.G, blockIdx.x); S.A = (const char*)(F.ws + WS_ACT + A_HX); S.a_sel_stride = 0; S.pn_per_a = 1 << 20;
                  S.B = (const char*)(F.ws + WS_W + j * W_RW_STRIDE + W_LDN); S.tstepA = (size_t)256 * 2048 * 2; S.tstepB = (size_t)256 * 2048 * 2;
                  EpiLoraDn E{(bf16*)(F.ws + WS_ACT + A_LORAH)};
                  pg8::gemm_phase(F.lds, F.tid, 2048, 2048, 2048, S, E); }
                { DenseSched S; S.o.init(T / 256, 12, F.G, blockIdx.x); S.o.uneven = (F.G == 256); S.A = (const char*)(F.ws + WS_ACT + A_XS); S.a_sel_stride = (size_t)T * D * 2; S.pn_per_a = 4;
                  S.B = (const char*)(F.ws + WS_W + j * W_RW_STRIDE + W_RKV); S.tstepA = (size_t)256 * D * 2; S.tstepB = (size_t)256 * D * 2;
                  EpiSplit E{(bf16*)(F.ws + WS_ACT + A_RKV), (size_t)T * D, 1.0f};
                  pg8::gemm_phase(F.lds, F.tid, D, D, D, S, E); }
                }
                SEAM(pb + 1);
            }
            if (EN(3) && IN(pb + 2)) { PHASE_FRAME(); REP(3) {
                { DenseSched S; S.o.init(T / 256, 16, F.G, blockIdx.x); S.A = (const char*)(F.ws + WS_ACT + A_LORAH); S.a_sel_stride = 0; S.pn_per_a = 1 << 20;
                  S.B = (const char*)(F.ws + WS_W + j * W_RW_STRIDE + W_LUPWA); S.tstepA = (size_t)256 * 512 * 2; S.tstepB = (size_t)256 * 256 * 2;
                  EpiLoraUpWA E{(bf16*)(F.ws + WS_ACT + A_LDEC), (bf16*)(F.ws + WS_ACT + A_ASIG), F.in[I_W0] + j * 2 * D, F.in[I_A0] + j * 2 * D};
                  pg8::gemm_phase(F.lds, F.tid, 256, 512, 256, S, E); }
                { DenseSched S; S.o.init(T / 256, 8, F.G, blockIdx.x); S.A = (const char*)(F.ws + WS_ACT + A_LORAH) + 512; S.a_sel_stride = 0; S.pn_per_a = 1 << 20;
                  S.B = (const char*)(F.ws + WS_W + j * W_RW_STRIDE + W_LUPG); S.tstepA = (size_t)256 * 512 * 2; S.tstepB = (size_t)256 * 256 * 2;
                  EpiSplit E{(bf16*)(F.ws + WS_ACT + A_G), (size_t)T * D, 1.0f};
                  pg8::gemm_phase(F.lds, F.tid, 256, 512, 256, S, E); }
                }
                SEAM(pb + 2);
            }
            if (EN(4) && IN(pb + 3)) { PHASE_FRAME(); REP(4) phase_scan(F, l); SEAM(pb + 3); }
            if (EN(5) && IN(pb + 4)) { PHASE_FRAME(); REP(5) phase_rw_post(F, l); SEAM(pb + 4); }
            if (EN(6) && IN(pb + 5)) { PHASE_FRAME();
                DenseSched S; S.o.init(T / 256, 4, F.G, blockIdx.x); S.A = (const char*)(F.ws + WS_ACT + A_O); S.a_sel_stride = 0; S.pn_per_a = 1 << 20;
                S.B = (const char*)(F.ws + WS_W + j * W_RW_STRIDE + W_RWO); S.tstepA = (size_t)256 * D * 2; S.tstepB = (size_t)256 * D * 2;
                EpiResid E{(l == 0) ? (const void*)F.in[I_X] : (const void*)xcur, (l == 0) ? 1 : 0, xcur, (const float*)(F.ws + WS_MOD) + (size_t)l * 8 * 6144 + 2 * D};
                pg8::gemm_phase(F.lds, F.tid, D, D, D, S, E);
                SEAM(pb + 5);
            }
        } else {
            if (EN(7) && IN(pb + 0)) { PHASE_FRAME(); REP(7) phase_at_norm(F, l, (const bf16*)xin, xcur); SEAM(pb + 0); }
            if (EN(8) && IN(pb + 1)) { PHASE_FRAME(); REP(8) {
                DenseSched S; S.o.init(T / 256, 36, F.G, blockIdx.x); S.A = (const char*)(F.ws + WS_ACT + A_H); S.a_sel_stride = 0; S.pn_per_a = 1 << 20;
                S.B = (const char*)(F.ws + WS_WA + j * W_AT_STRIDE + W_QKV); S.tstepA = (size_t)256 * D; S.tstepB = (size_t)256 * D;
                EpiQKV8 E{(bf16*)(F.ws + WS_ACT + A_Q), (const float*)(F.ws + WS_SA), (const float*)(F.ws + WS_WA + j * W_AT_STRIDE + W_QKVS), 0.08838834764831845f * LOG2E};
                pg8::gemm_phase(F.lds, F.tid, D, D, D, S, E);
                }
                SEAM(pb + 1);
            }
            if (EN(9) && IN(pb + 2)) { PHASE_FRAME(); if ((DUP_MASK >> 9) & 1) phase_attn(F, true); phase_attn(F); SEAM(pb + 2); }
            if (EN(16) && IN(pb + 3)) { PHASE_FRAME(); REP(16) phase_attn_merge(F); SEAM(pb + 3); }
            if (EN(10) && IN(pb + 4)) { PHASE_FRAME();
                DenseSched S; S.o.init(T / 256, 4, F.G, blockIdx.x); S.A = (const char*)(F.ws + WS_ACT + A_AO); S.a_sel_stride = 0; S.pn_per_a = 1 << 20;
                S.B = (const char*)(F.ws + WS_WA + j * W_AT_STRIDE + W_AWO); S.tstepA = (size_t)256 * D * 2; S.tstepB = (size_t)256 * D * 2;
                EpiResid E{(const void*)xcur, 0, xcur, (const float*)(F.ws + WS_MOD) + (size_t)l * 8 * 6144 + 2 * D};
                pg8::gemm_phase(F.lds, F.tid, D, D, D, S, E);
                SEAM(pb + 4);
            }
        }
        if (EN(11) && IN(pb + 6)) { PHASE_FRAME(); if ((DUP_MASK >> 11) & 1) phase_moe_route(F, l, xcur, 4); phase_moe_route(F, l, xcur); SEAM(pb + 6); }
        if (EN(12) && IN(pb + 7)) { PHASE_FRAME(); REP(12) phase_moe_gather(F, l); SEAM(pb + 7); }
        if (EN(13) && IN(pb + 8)) { PHASE_FRAME(); REP(13) {
            MoeGatherSched S; S.tileE = (const int*)(F.ws + WS_TILEE); S.ntiles = uni(S.tileE[160]); S.G = F.G; S.c = blockIdx.x;
            S.A = (const char*)(F.ws + WS_ACT + A_HN2); S.B = (const char*)(F.ws + ws_wm_of(l) + W_GU); S.tstepB = (size_t)256 * D * 2; S.estride = (size_t)512 * D * 2;
            { LAS int* rt = (LAS int*)(F.lds + LDS_MISC + 1024); S.rowtab = rt; const int* rowt = (const int*)(F.ws + WS_ROWT);
              for (int i = F.tid; i < 3 * 256; i += NTHREADS) { const int L = (i >> 8) * F.G + (int)blockIdx.x; rt[i] = (L < S.ntiles * 2) ? rowt[(L >> 1) * 256 + (i & 255)] : 0; }
              __syncthreads(); }
            EpiGateUp E{(bf16*)(F.ws + WS_ACT + A_HID), (const float*)(F.ws + WS_ROWW)};
            pg8::gemm_phase(F.lds, F.tid, D, D, D, S, E);
            if (l + 1 < DEPTH) {
                const int nun = S.ntiles * 2, firstb = (nun > F.G) ? (nun - F.G) : 0;
                if ((int)blockIdx.x >= firstb) moe_convert(F, l + 1, ((int)blockIdx.x - firstb) * NWAVES + F.wave, (F.G - firstb) * NWAVES);
            }
            }
                SEAM(pb + 8);
        }
        if (EN(14) && IN(pb + 9)) { PHASE_FRAME(); REP(14) {
            MoeSched S; S.tileE = (const int*)(F.ws + WS_TILEE); S.ntiles = uni(S.tileE[160]); S.npn = 4; S.G = F.G; S.c = blockIdx.x;
            S.A = (const char*)(F.ws + WS_ACT + A_HID); S.B = (const char*)(F.ws + ws_wm_of(l) + W_DN); S.tstepA = (size_t)256 * FEXP * 2; S.tstepB = (size_t)256 * FEXP * 2; S.estride = (size_t)D * FEXP * 2;
            EpiPlain E{(bf16*)(F.ws + WS_ACT + A_YS)};
            pg8::gemm_phase(F.lds, F.tid, FEXP, FEXP, FEXP, S, E);
            }
                SEAM(pb + 9);
        }
    }
    if (EN(15) && IN(N_PHASES - 1)) { PHASE_FRAME(); phase_final(F, X1); }
#undef IN
#undef SEAM
}

typedef void (*kern_t)(Args);
template <int B> static kern_t kern_of_bit(int b) { if (b == B) return mk_fwd<(1 << B)>; if constexpr (B > 0) return kern_of_bit<B - 1>(b); else return nullptr; }
static int kind_of_phase(int p) {
    if (p == 0) return 0; if (p == N_PHASES - 1) return 15;
    const int l = (p - 1) / PH_PER_LAYER, k = (p - 1) % PH_PER_LAYER;
    if (k >= 6) return 11 + (k - 6);
    if ((l & 1) == 0) return 1 + k;
    return (k < 3) ? 7 + k : (k == 3 ? 16 : (k == 4 ? 10 : -1));
}
extern "C" void kernel_launch(void* const* d_in, const int* in_sizes, int n_in, void* d_out, int out_size, void* d_ws, size_t ws_size, hipStream_t stream) {
    static int grid = 0;
    if (grid == 0) {
        if (n_in != 32 || out_size != T * D || ws_size < WS_END) { fprintf(stderr, "kernel_launch: unexpected shapes (n_in %d out %d ws %zu need %zu)\n", n_in, out_size, ws_size, (size_t)WS_END); grid = -1; return; }
        int dev = 0, cus = 0;
        if (hipGetDevice(&dev) != hipSuccess || hipDeviceGetAttribute(&cus, hipDeviceAttributeMultiprocessorCount, dev) != hipSuccess) { grid = -1; return; }
#if ONE_LAUNCH
        if (hipFuncSetAttribute((const void*)mk_fwd<0x1ffff>, hipFuncAttributeMaxDynamicSharedMemorySize, LDS_BYTES) != hipSuccess) { fprintf(stderr, "kernel_launch: hipFuncSetAttribute failed\n"); grid = -1; return; }
#else
        for (int b = 0; b < 17; ++b) if (hipFuncSetAttribute((const void*)kern_of_bit<16>(b), hipFuncAttributeMaxDynamicSharedMemorySize, LDS_BYTES) != hipSuccess) { fprintf(stderr, "kernel_launch: hipFuncSetAttribute failed\n"); grid = -1; return; }
#endif
        (void)hipGetLastError();
        grid = cus;
    }
    if (grid < 0) return;
    (void)hipMemsetAsync((char*)d_ws + WS_CTL, 0, CTL_ZERO_BYTES, stream);
    Args a{};
    for (int i = 0; i < 32; ++i) a.in[i] = (const float*)d_in[i];
    a.out = (float*)d_out; a.ws = (unsigned char*)d_ws;
#if ONE_LAUNCH
#ifndef SPLIT_EVERY
#define SPLIT_EVERY N_PHASES
#endif
    for (int p = 0; p < N_PHASES; p += SPLIT_EVERY) {
        a.ph_lo = p; a.ph_hi = (p + SPLIT_EVERY < N_PHASES) ? p + SPLIT_EVERY : N_PHASES;
        hipLaunchKernelGGL(mk_fwd<0x1ffff>, dim3(grid), dim3(NTHREADS), LDS_BYTES, stream, a);
    }
#else
    for (int p = 0; p < N_PHASES; ++p) {
        const int kind = kind_of_phase(p); if (kind < 0) continue;
        a.ph_lo = p; a.ph_hi = p + 1;
        hipLaunchKernelGGL(kern_of_bit<16>(kind), dim3(grid), dim3(NTHREADS), LDS_BYTES, stream, a);
    }
#endif
}
```

```cpp
#include <hip/hip_runtime.h>
#include <cstdio>
#include <cstdint>

#ifndef ONE_LAUNCH
#define ONE_LAUNCH 1
#endif


#define LAS __attribute__((address_space(3)))
typedef unsigned short bf16;
typedef short bf16x8 __attribute__((ext_vector_type(8)));
typedef float f32x4 __attribute__((ext_vector_type(4)));
typedef float f32x2 __attribute__((ext_vector_type(2)));
typedef unsigned u32x4 __attribute__((ext_vector_type(4)));
typedef unsigned u32x2 __attribute__((ext_vector_type(2)));

constexpr int NB = 8, SEQ = 2048, D = 1024, T = NB * SEQ, DEPTH = 4;
constexpr int NH_R = 16, HD_R = 64;
constexpr int QKVW = 9216;
constexpr int NEXP = 32, FEXP = 256;
constexpr int MAXROWS = 40960;
constexpr int NWAVES = 8, NTHREADS = 512;
constexpr float RMS_EPS = 1e-6f, GN_EPS = 64e-5f;
constexpr float LOG2E = 1.4426950408889634f;

constexpr size_t MiB = 1u << 20;
constexpr size_t WS_CTL = 0, CTL_ZERO_BYTES = 64 * 1024;
constexpr size_t WS_MOD = 1 * MiB;
constexpr size_t WS_TOKE = 2 * MiB;
constexpr size_t WS_TOKR = WS_TOKE + 128 * 1024;
constexpr size_t WS_TOKW = WS_TOKR + 128 * 1024;
constexpr size_t WS_TOKP = WS_TOKW + 128 * 1024;
constexpr size_t WS_ROWW = WS_TOKP + 128 * 1024;
constexpr size_t WS_TILEE = WS_ROWW + 192 * 1024;
constexpr size_t WS_ROWT = WS_TILEE + 4096;
constexpr size_t WS_SB = 4 * MiB;
constexpr size_t WS_SA = WS_SB + 1536 * 1024;
constexpr size_t WS_W = 8 * MiB;
constexpr size_t W_RKV = 0, W_LDN = 6 * MiB, W_LUPWA = 8 * MiB, W_LUPG = 10 * MiB, W_RWO = 11 * MiB, W_RW_STRIDE = 13 * MiB;
constexpr size_t WS_WA = WS_W + 2 * W_RW_STRIDE;
constexpr size_t W_QKV = 0, W_QKVS = 9 * MiB, W_AWO = 18 * MiB, W_AT_STRIDE = 20 * MiB;
constexpr size_t WS_WM = WS_WA + 2 * W_AT_STRIDE;
constexpr size_t W_GU = 0, W_DN = 32 * MiB;
__host__ __device__ constexpr size_t ws_wm_of(int l);
constexpr size_t WS_X1 = 128 * MiB;
constexpr size_t WS_ACT = 192 * MiB;
constexpr size_t A_XS = 0, A_HX = 96 * MiB;
constexpr size_t A_LDEC = 0, A_ASIG = 64 * MiB, A_G = 128 * MiB;
constexpr size_t A_RKV = 192 * MiB;
constexpr size_t A_O = 192 * MiB;
constexpr size_t A_LORAH = 288 * MiB;
constexpr size_t A_Y = 304 * MiB;
constexpr size_t A_H = 0;
constexpr size_t A_Q = 32 * MiB, A_K = 128 * MiB, A_VT = 224 * MiB;
constexpr size_t A_AO = 320 * MiB;
constexpr size_t A_HN2 = 0, A_ASORT = 32 * MiB, A_HID = 112 * MiB, A_YS = 288 * MiB;
static_assert(A_K - A_Q == A_VT - A_K, "q/k/v spacing");
constexpr size_t WS_WM2 = WS_ACT + 368 * MiB;
constexpr size_t WS_END = WS_WM2 + 48 * MiB;

constexpr int CW_BAR = 4096;
constexpr int CW_CNT = 8192;

__host__ __device__ constexpr size_t ws_wm_of(int l) { return (l & 1) ? WS_WM2 : WS_WM; }
constexpr int LDS_BYTES = 163840;
constexpr int LDS_MISC = 159744;
constexpr int MISC_OFF = LDS_MISC + 320;
constexpr int TILEE_OFF = LDS_MISC + 1024;
constexpr int OFFS_OFF = LDS_MISC + 2048;

__device__ __forceinline__ float bf_lo(unsigned u) { return __uint_as_float(u << 16); }
__device__ __forceinline__ float bf_hi(unsigned u) { return __uint_as_float(u & 0xffff0000u); }
__device__ __forceinline__ float bf2f(bf16 v) { return __uint_as_float(((unsigned)v) << 16); }
__device__ __forceinline__ unsigned f2bf(float f) { __bf16 r = (__bf16)f; return (unsigned)__builtin_bit_cast(unsigned short, r); }
__device__ __forceinline__ unsigned pk2(float lo, float hi) { typedef __bf16 b2_t __attribute__((ext_vector_type(2))); typedef float f2_t __attribute__((ext_vector_type(2))); f2_t v = {lo, hi}; b2_t r = __builtin_convertvector(v, b2_t); return __builtin_bit_cast(unsigned, r); }
__device__ __forceinline__ float dpp_ror(float x, const int ctrl_sel) {
    int r;
    if (ctrl_sel == 8) r = __builtin_amdgcn_update_dpp(0, __float_as_int(x), 0x128, 0xf, 0xf, false);
    else if (ctrl_sel == 4) r = __builtin_amdgcn_update_dpp(0, __float_as_int(x), 0x124, 0xf, 0xf, false);
    else if (ctrl_sel == 2) r = __builtin_amdgcn_update_dpp(0, __float_as_int(x), 0x122, 0xf, 0xf, false);
    else r = __builtin_amdgcn_update_dpp(0, __float_as_int(x), 0x121, 0xf, 0xf, false);
    return __int_as_float(r);
}
__device__ __forceinline__ float rowsum16(float x) { x += dpp_ror(x, 8); x += dpp_ror(x, 4); x += dpp_ror(x, 2); x += dpp_ror(x, 1); return x; }
__device__ __forceinline__ float sum8(float x) {
    x += __int_as_float(__builtin_amdgcn_update_dpp(0, __float_as_int(x), 0x141, 0xf, 0xf, false));
    x += __int_as_float(__builtin_amdgcn_update_dpp(0, __float_as_int(x), 0xB1, 0xf, 0xf, false));
    x += __int_as_float(__builtin_amdgcn_update_dpp(0, __float_as_int(x), 0x4E, 0xf, 0xf, false));
    return x;
}
__device__ __forceinline__ float lane_xor(float v, int lane, int o) { return __int_as_float(__builtin_amdgcn_ds_bpermute((lane ^ o) << 2, __float_as_int(v))); }
typedef unsigned v2u_t __attribute__((ext_vector_type(2)));
__device__ __forceinline__ float bfly16_sum(float x) { const v2u_t r = __builtin_amdgcn_permlane16_swap(__float_as_uint(x), __float_as_uint(x), false, false); return __uint_as_float(r[0]) + __uint_as_float(r[1]); }
__device__ __forceinline__ float bfly32_sum(float x) { const v2u_t r = __builtin_amdgcn_permlane32_swap(__float_as_uint(x), __float_as_uint(x), false, false); return __uint_as_float(r[0]) + __uint_as_float(r[1]); }
__device__ __forceinline__ float bfly16_max(float x) { const v2u_t r = __builtin_amdgcn_permlane16_swap(__float_as_uint(x), __float_as_uint(x), false, false); return fmaxf(__uint_as_float(r[0]), __uint_as_float(r[1])); }
__device__ __forceinline__ float bfly32_max(float x) { const v2u_t r = __builtin_amdgcn_permlane32_swap(__float_as_uint(x), __float_as_uint(x), false, false); return fmaxf(__uint_as_float(r[0]), __uint_as_float(r[1])); }
__device__ __forceinline__ float wave_max(float x) {
    x = fmaxf(x, dpp_ror(x, 8)); x = fmaxf(x, dpp_ror(x, 4)); x = fmaxf(x, dpp_ror(x, 2)); x = fmaxf(x, dpp_ror(x, 1)); x = bfly16_max(x); return bfly32_max(x);
}
__device__ __forceinline__ unsigned pack_i8x4(const f32x4& v, float inv) {
    const int q0 = (int)__builtin_rintf(fminf(fmaxf(v[0] * inv, -127.f), 127.f)), q1 = (int)__builtin_rintf(fminf(fmaxf(v[1] * inv, -127.f), 127.f));
    const int q2 = (int)__builtin_rintf(fminf(fmaxf(v[2] * inv, -127.f), 127.f)), q3 = (int)__builtin_rintf(fminf(fmaxf(v[3] * inv, -127.f), 127.f));
    return (unsigned)(q0 & 255) | ((unsigned)(q1 & 255) << 8) | ((unsigned)(q2 & 255) << 16) | ((unsigned)q3 << 24);
}
__device__ __forceinline__ float wave_sum(float v, int lane) { (void)lane; v = rowsum16(v); v = bfly16_sum(v); v = bfly32_sum(v); return v; }
__device__ __forceinline__ int lane_id_nh() { int lid; asm volatile("v_mbcnt_lo_u32_b32 %0, -1, 0\n\tv_mbcnt_hi_u32_b32 %0, -1, %0" : "=v"(lid)); return lid; }
__device__ __forceinline__ float sigmoidf_(float x) { return 1.0f / (1.0f + __expf(-x)); }
#define LDS_WAIT() asm volatile("s_waitcnt lgkmcnt(0)" ::: "memory")
#define VM_WAIT() asm volatile("s_waitcnt vmcnt(0)" ::: "memory")

#define XB_TMO      128
#define XB_XCNT(j)  (256  + 64 * (j))
#define XB_XSUB(j)  (1280 + 64 * (j))
#define XB_XGEN(j)  (2304 + 64 * (j))
#define XB_TOP      3328
#define XB_TOPGEN   3392
#define XCD_BAR_WORDS 3456
#define XB_SPIN_CAP (1u << 18)
__device__ __forceinline__ unsigned xb_ld(unsigned* p)              { return __hip_atomic_load(p, __ATOMIC_RELAXED, __HIP_MEMORY_SCOPE_AGENT); }
__device__ __forceinline__ unsigned xb_add(unsigned* p, unsigned v) { return __hip_atomic_fetch_add(p, v, __ATOMIC_RELAXED, __HIP_MEMORY_SCOPE_AGENT); }
__device__ __forceinline__ unsigned xb_xcc_id() { return (unsigned)__builtin_amdgcn_s_getreg((3 << 11) | 20) & 0xFu; }
#define XB_SPIN(cond, bar) do { unsigned _sp = 0; while (cond) { __builtin_amdgcn_s_sleep(1); \
    if ((++_sp & 255u) == 0u) { if (xb_ld(&(bar)[XB_TMO])) break; if (_sp > XB_SPIN_CAP) { atomicAdd(&(bar)[XB_TMO], 1u); break; } } } } while (0)
struct XcdBarrier { unsigned* bar; unsigned x; volatile LAS unsigned* st; };
__device__ __forceinline__ XcdBarrier xcd_barrier_post(unsigned* bar, volatile LAS unsigned* st, bool t0) {
    XcdBarrier b; b.bar = bar; b.x = xb_xcc_id(); b.st = st;
    if (t0) (void)xb_add(&bar[XB_XCNT(b.x)], 1u);
    return b;
}
__device__ __forceinline__ void xcd_barrier_complete(unsigned* bar, unsigned x, unsigned& nloc, unsigned& nx) {
    const unsigned G = gridDim.x * gridDim.y * gridDim.z;
    unsigned sum, cnt, mine, sp = 0u;
    for (;;) {
        sum = 0u; cnt = 0u; mine = 0u;
#pragma clang loop unroll(disable)
        for (unsigned j = 0; j < 16; ++j) { const unsigned c = xb_ld(&bar[XB_XCNT(j)]); sum += c; cnt += (c > 0u) ? 1u : 0u; mine = (j == x) ? c : mine; }
        if (sum == G) break;
        __builtin_amdgcn_s_sleep(1);
        if ((++sp & 255u) == 0u) { if (xb_ld(&bar[XB_TMO])) break; if (sp > XB_SPIN_CAP) { atomicAdd(&bar[XB_TMO], 1u); break; } }
    }
    nloc = mine > 0u ? mine : 1u; nx = cnt > 0u ? cnt : 1u;
}
__device__ __forceinline__ void xcd_barrier(const XcdBarrier& b, bool t0) {
    asm volatile("s_waitcnt vmcnt(0)" ::: "memory");
    __syncthreads();
    if (t0) {
        unsigned* bar = b.bar;
        __builtin_amdgcn_s_waitcnt(0);
        unsigned nloc = b.st[0], nx = b.st[1];
        if (nloc == 0u) { xcd_barrier_complete(bar, b.x, nloc, nx); b.st[0] = nloc; b.st[1] = nx; }
        const unsigned old = xb_add(&bar[XB_XSUB(b.x)], 1u);
        const unsigned gen = old / nloc;
        if (old + 1u == (gen + 1u) * nloc) {
            __builtin_amdgcn_fence(__ATOMIC_RELEASE, "agent");
            asm volatile("s_waitcnt vmcnt(0)" ::: "memory");
            const unsigned og = xb_add(&bar[XB_TOP], 1u);
            const unsigned tg = og / nx;
            if (og + 1u == (tg + 1u) * nx) xb_add(&bar[XB_TOPGEN], 1u);
            else XB_SPIN(xb_ld(&bar[XB_TOPGEN]) == tg, bar);
            __builtin_amdgcn_fence(__ATOMIC_ACQUIRE, "agent");
            xb_add(&bar[XB_XGEN(b.x)], 1u);
            asm volatile("s_waitcnt vmcnt(0)" ::: "memory");
        } else {
            XB_SPIN(xb_ld(&bar[XB_XGEN(b.x)]) == gen, bar);
            __builtin_amdgcn_fence(__ATOMIC_ACQUIRE, "agent");
            asm volatile("s_waitcnt vmcnt(0)" ::: "memory");
        }
    }
    __syncthreads();
}

namespace pg8 {
constexpr int BM = 256, BK = 64, HALF = 128, HTB = HALF * BK * 2, STAGE_BYTES = 8 * HTB;
__device__ __forceinline__ int lds_byte(int r, int c) { const int st = (r >> 4) * 2 + (c >> 5), rr = r & 15, cc = c & 31, ob = rr * 64 + cc * 2; return st * 1024 + (ob ^ (((ob >> 9) & 1) << 5)); }
__device__ __forceinline__ void stage_rc(int b, int& R, int& C) { const int st = b / 1024, sb = b % 1024, swz = sb ^ (((sb >> 9) & 1) << 5); R = (st >> 1) * 16 + swz / 64; C = (st & 1) * 32 + (swz % 64) / 2; }
__device__ __forceinline__ int perm32(int rho) { const int n = rho >> 4, i = rho & 15; return 8 * (i >> 2) + 4 * n + (i & 3); }
struct Unit { int pm, pn; const char* a; const char* b; };
__device__ __forceinline__ unsigned cvt_pk_bf16(float lo, float hi) { unsigned r; asm volatile("v_cvt_pk_bf16_f32 %0, %1, %2" : "=v"(r) : "v"(lo), "v"(hi)); return r; }

typedef int i32x4 __attribute__((ext_vector_type(4)));
template <bool I8> struct OpT { typedef bf16x8 frag; typedef f32x4 acc; };
template <> struct OpT<true> { typedef i32x4 frag; typedef i32x4 acc; };
__device__ __forceinline__ f32x4 mma16(const bf16x8& a, const bf16x8& b, const f32x4& c) { return __builtin_amdgcn_mfma_f32_16x16x32_bf16(a, b, c, 0, 0, 0); }
__device__ __forceinline__ i32x4 mma16(const i32x4& a, const i32x4& b, const i32x4& c) { return __builtin_amdgcn_mfma_i32_16x16x64_i8(a, b, c, 0, 0, 0); }
template <class Epi, class Sched>
__device__ __forceinline__ void gemm_phase(LAS unsigned char* lds, const int tid, const int K, const int lda, const int ldb, const Sched& S, const Epi& E) {
    const int wid = __builtin_amdgcn_readfirstlane(tid >> 6), lane = tid & 63, wr = wid >> 2, wc = wid & 3, fr = lane & 15, fq = lane >> 4;
    int Kq = K; asm volatile("" : "+s"(Kq));
    constexpr bool I8 = Epi::I8; constexpr int EB = I8 ? 1 : 2;
    typedef typename OpT<I8>::frag frag_t; typedef typename OpT<I8>::acc acc_t;
    const int nt = Kq * EB / (BK * 2);
    unsigned voffC[2][2], voffN[2][2], voffB[2]; int RA[2], CA[2];
#pragma unroll
    for (int i = 0; i < 2; ++i) { int R, C; stage_rc(tid * 16 + i * 8192, R, C); const int Rb = Epi::PERM ? ((R & ~31) + perm32(R & 31)) : R; RA[i] = R; CA[i] = C;
        voffB[i] = (unsigned)(Rb * ldb * EB + C * 2); }
#define PG8_AOFF(dst, ui_) do { _Pragma("unroll") for (int h_ = 0; h_ < 2; ++h_) _Pragma("unroll") for (int i_ = 0; i_ < 2; ++i_) { \
        if constexpr (Sched::GATHER) dst[h_][i_] = (unsigned)(S.row_of(ui_, h_ * HALF + RA[i_]) * lda * EB + CA[i_] * 2); else dst[h_][i_] = (unsigned)((h_ * HALF + RA[i_]) * lda * EB + CA[i_] * 2); } } while (0)
    const size_t kstep = (size_t)(BK * 2);
    const size_t hstepB = (size_t)HALF * ldb * EB;
    const unsigned ldsw = (unsigned)wid * 1024u;
    const int aoff = lds_byte(wr * 64 + fr, fq * 8), boff = lds_byte(wc * 32 + fr, fq * 8);
#define PG8_SA(b, h) (((b) * 2 + (h)) * HTB)
#define PG8_SB(b, h) ((4 + (b) * 2 + (h)) * HTB)
#define PG8_STAGE(bufoff, gbase, voff) do { _Pragma("unroll") for (int _i = 0; _i < 2; ++_i) \
        __builtin_amdgcn_global_load_lds((const unsigned*)((const char*)(gbase) + (voff)[_i]), (LAS unsigned*)(lds + (bufoff) + ldsw + _i * 8192), 16, 0, 0); } while (0)
#define PG8_LDA(dst, b, h) do { _Pragma("unroll") for (int m = 0; m < 4; ++m) _Pragma("unroll") for (int k = 0; k < 2; ++k) dst[m][k] = *(const LAS frag_t*)(lds + PG8_SA(b, h) + aoff + m * 2048 + k * 1024); } while (0)
#define PG8_LDB(dst, b, h) do { _Pragma("unroll") for (int n = 0; n < 2; ++n) _Pragma("unroll") for (int k = 0; k < 2; ++k) dst[n][k] = *(const LAS frag_t*)(lds + PG8_SB(b, h) + boff + n * 2048 + k * 1024); } while (0)
#define PG8_MMA(ai, bj, At, Bt) do { __builtin_amdgcn_s_setprio(1); _Pragma("unroll") for (int m = 0; m < 4; ++m) _Pragma("unroll") for (int n = 0; n < 2; ++n) _Pragma("unroll") for (int k = 0; k < 2; ++k) \
        acc[ai][bj][m][n] = mma16(Bt[n][k], At[m][k], acc[ai][bj][m][n]); __builtin_amdgcn_s_setprio(0); } while (0)
#define PG8_WAIT_V(n) asm volatile("s_waitcnt vmcnt(" #n ")" ::: "memory")
#define PG8_WAIT_L(n) asm volatile("s_waitcnt lgkmcnt(" #n ")" ::: "memory")
#define PG8_BAR __builtin_amdgcn_s_barrier()
#define PG8_SCHED __builtin_amdgcn_sched_barrier(0)
    Unit cur, nxt; int ui = 0;
    if (!S.next(0, cur)) return;
    acc_t acc[2][2][4][2];
#pragma unroll
    for (int a = 0; a < 2; ++a)
#pragma unroll
        for (int b = 0; b < 2; ++b)
#pragma unroll
            for (int m = 0; m < 4; ++m)
#pragma unroll
                for (int n = 0; n < 2; ++n) acc[a][b][m][n] = (acc_t){0, 0, 0, 0};
    frag_t At[4][2], B0[2][2], B1[2][2];
    const char* cA = cur.a; const char* cB = cur.b;
    PG8_AOFF(voffC, 0); PG8_AOFF(voffN, 0);
    PG8_STAGE(PG8_SB(0, 0), cB, voffB); PG8_STAGE(PG8_SB(0, 1), cB + hstepB, voffB); PG8_STAGE(PG8_SA(0, 0), cA, voffC[0]); PG8_STAGE(PG8_SA(0, 1), cA, voffC[1]);
    if (wr == 1) PG8_BAR;
    PG8_WAIT_V(2); PG8_BAR;
    PG8_STAGE(PG8_SB(1, 0), cB + kstep, voffB); PG8_STAGE(PG8_SA(1, 0), cA + kstep, voffC[0]); PG8_STAGE(PG8_SB(1, 1), cB + hstepB + kstep, voffB);
    PG8_WAIT_V(6); PG8_BAR;
    for (;;) {
        const bool has_next = S.next(ui + 1, nxt);
        const char* nA = has_next ? nxt.a : cA; const char* nB = has_next ? nxt.b : cB;
        if constexpr (Sched::GATHER) { if (has_next) PG8_AOFF(voffN, ui + 1); }
#pragma clang loop unroll(disable)
        for (int t = 0; t < nt; t += 2) {
            const bool last = (t == nt - 2);
            const char* a1 = cA + (size_t)(t + 1) * kstep;
            const char* a2 = last ? nA : cA + (size_t)(t + 2) * kstep; const char* b2 = last ? nB : cB + (size_t)(t + 2) * kstep;
            const char* a3 = a2 + kstep; const char* b3 = b2 + kstep;
            unsigned vA0[2], vA1[2];
            if constexpr (Sched::GATHER) { vA0[0] = last ? voffN[0][0] : voffC[0][0]; vA0[1] = last ? voffN[0][1] : voffC[0][1]; vA1[0] = last ? voffN[1][0] : voffC[1][0]; vA1[1] = last ? voffN[1][1] : voffC[1][1]; }
            else { vA0[0] = voffC[0][0]; vA0[1] = voffC[0][1]; vA1[0] = voffC[1][0]; vA1[1] = voffC[1][1]; }
            PG8_LDB(B0, 0, 0); PG8_LDB(B1, 0, 1); PG8_SCHED; PG8_LDA(At, 0, 0); PG8_STAGE(PG8_SA(1, 1), a1, voffC[1]);
            PG8_WAIT_V(8); PG8_WAIT_L(0); PG8_BAR; PG8_MMA(0, 0, At, B0); PG8_MMA(0, 1, At, B1); PG8_BAR; PG8_SCHED;
            PG8_LDA(At, 0, 1); PG8_STAGE(PG8_SB(0, 0), b2, voffB); PG8_STAGE(PG8_SB(0, 1), b2 + hstepB, voffB); PG8_STAGE(PG8_SA(0, 0), a2, vA0);
            PG8_WAIT_V(8); PG8_WAIT_L(0); PG8_BAR; PG8_MMA(1, 0, At, B0); PG8_MMA(1, 1, At, B1); PG8_BAR; PG8_SCHED;
            PG8_LDB(B0, 1, 0); PG8_LDB(B1, 1, 1); PG8_SCHED; PG8_LDA(At, 1, 0); PG8_STAGE(PG8_SA(0, 1), a2, vA1);
            PG8_WAIT_V(8); PG8_WAIT_L(0); PG8_BAR; PG8_MMA(0, 0, At, B0); PG8_MMA(0, 1, At, B1); PG8_BAR; PG8_SCHED;
            PG8_LDA(At, 1, 1); PG8_STAGE(PG8_SB(1, 0), b3, voffB); PG8_STAGE(PG8_SB(1, 1), b3 + hstepB, voffB); PG8_STAGE(PG8_SA(1, 0), a3, vA0);
            PG8_WAIT_V(8); PG8_WAIT_L(0); PG8_BAR; PG8_MMA(1, 0, At, B0); PG8_MMA(1, 1, At, B1); PG8_BAR; PG8_SCHED;
        }
        if (wr == 0) PG8_BAR;
        { int te = tid; asm volatile("" : "+v"(te));
          const int we = __builtin_amdgcn_readfirstlane(te >> 6), le = te & 63;
          E(acc, cur, we >> 2, we & 3, le & 15, le >> 4); }
        if (!has_next) break;
#pragma unroll
        for (int a = 0; a < 2; ++a)
#pragma unroll
            for (int b = 0; b < 2; ++b)
#pragma unroll
                for (int m = 0; m < 4; ++m)
#pragma unroll
                    for (int n = 0; n < 2; ++n) acc[a][b][m][n] = (acc_t){0, 0, 0, 0};
        cur = nxt; cA = nA; cB = nB; ++ui;
        if constexpr (Sched::GATHER) {
#pragma unroll
            for (int h_ = 0; h_ < 2; ++h_) { voffC[h_][0] = voffN[h_][0]; voffC[h_][1] = voffN[h_][1]; } }
        if (wr == 1) PG8_BAR;
    }
    PG8_WAIT_V(0);
    PG8_BAR;
#undef PG8_AOFF
#undef PG8_SA
#undef PG8_SB
#undef PG8_STAGE
#undef PG8_LDA
#undef PG8_LDB
#undef PG8_MMA
#undef PG8_WAIT_V
#undef PG8_WAIT_L
#undef PG8_BAR
#undef PG8_SCHED
}

struct GridOrder {
    int nM, nN, nwg, G, c, uneven;
    __device__ __forceinline__ void init(int nM_, int nN_, int G_, int c_) { nM = nM_; nN = nN_; nwg = nM * nN; G = G_; c = c_; uneven = 0; }
    __device__ __forceinline__ bool tile(int i, int& pm, int& pn) const {
        long L = (long)i * G + c;
        if (uneven) {
            if (c < 128) { if (i >= 2) return false; L = i * 128 + c; } else { if (i >= 4) return false; L = 256 + (c - 128) + 128 * i; } }
        if (L >= nwg) return false;
        int wgid = (int)L; { const int q = nwg / 8, r = nwg % 8, xcd = wgid % 8, off = wgid / 8; wgid = (xcd < r ? xcd * (q + 1) : r * (q + 1) + (xcd - r) * q) + off; }
        const int nig = 8 * nN, gid = wgid / nig, fm = gid * 8, gsz = (nM - fm) < 8 ? (nM - fm) : 8;
        pm = fm + ((wgid % nig) % gsz); pn = (wgid % nig) / gsz; return true;
    }
};
}

__device__ __forceinline__ int uni(int v) { return __builtin_amdgcn_readfirstlane(v); }
__device__ __forceinline__ const char* uniptr(const char* p) { const unsigned long long v = (unsigned long long)p; const unsigned lo = __builtin_amdgcn_readfirstlane((unsigned)v), hi = __builtin_amdgcn_readfirstlane((unsigned)(v >> 32)); return (const char*)(((unsigned long long)hi << 32) | lo); }
struct DenseSched {
    static constexpr bool GATHER = false;
    pg8::GridOrder o; const char* A; size_t a_sel_stride; int pn_per_a; const char* B; size_t tstepA, tstepB;
    __device__ __forceinline__ bool next(int i, pg8::Unit& u) const {
        if (!o.tile(i, u.pm, u.pn)) return false;
        u.pm = uni(u.pm); u.pn = uni(u.pn);
        u.a = uniptr(A + (size_t)(u.pn / pn_per_a) * a_sel_stride + (size_t)u.pm * tstepA); u.b = uniptr(B + (size_t)u.pn * tstepB); return true;
    }
};
struct MoeSched {
    static constexpr bool GATHER = false;
    const int* tileE; int ntiles, npn, G, c; const char* A; const char* B; size_t tstepA, tstepB, estride;
    __device__ __forceinline__ bool next(int i, pg8::Unit& u) const {
        const int L = i * G + c; if (L >= ntiles * npn) return false;
        u.pm = uni(L / npn); u.pn = uni(L % npn);
        const int e = __builtin_amdgcn_readfirstlane(tileE[u.pm]);
        u.a = uniptr(A + (size_t)u.pm * tstepA); u.b = uniptr(B + (size_t)e * estride + (size_t)u.pn * tstepB); return true;
    }
};

struct MoeGatherSched {
    static constexpr bool GATHER = true;
    const int* tileE; const LAS int* rowtab; int ntiles, G, c; const char* A; const char* B; size_t tstepB, estride;
    __device__ __forceinline__ bool next(int i, pg8::Unit& u) const {
        const int L = i * G + c; if (L >= ntiles * 2) return false;
        u.pm = uni(L >> 1); u.pn = uni(L & 1);
        const int e = __builtin_amdgcn_readfirstlane(tileE[u.pm]);
        u.a = A; u.b = uniptr(B + (size_t)e * estride + (size_t)u.pn * tstepB); return true;
    }
    __device__ __forceinline__ int row_of(int i, int r) const { return rowtab[i * 256 + r]; }
};
using pg8::Unit; using pg8::cvt_pk_bf16;
__device__ __forceinline__ void st8(bf16* p, const f32x4& v0, const f32x4& v1) {
    u32x4 w; w.x = cvt_pk_bf16(v0[0], v0[1]); w.y = cvt_pk_bf16(v0[2], v0[3]); w.z = cvt_pk_bf16(v1[0], v1[1]); w.w = cvt_pk_bf16(v1[2], v1[3]);
    *(u32x4*)p = w;
}
struct EpiSplit {
    static constexpr bool PERM = true, I8 = false;
    bf16* O; size_t split_stride; float scale;
    __device__ __forceinline__ void operator()(const f32x4 (&acc)[2][2][4][2], const Unit& u, int wr, int wc, int fr, int fq) const {
        const int row0 = u.pm * 256 + wr * 64 + fr; const int colt = u.pn * 256; const int t = colt >> 10;
        bf16* base = O + (size_t)t * split_stride; const int col0 = (colt & 1023) + wc * 32 + 8 * fq;
#pragma unroll
        for (int ai = 0; ai < 2; ++ai)
#pragma unroll
            for (int m = 0; m < 4; ++m) { bf16* rowp = base + (size_t)(row0 + ai * 128 + m * 16) * 1024 + col0;
#pragma unroll
                for (int bj = 0; bj < 2; ++bj) st8(rowp + bj * 128, acc[ai][bj][m][0] * scale, acc[ai][bj][m][1] * scale); }
    }
};
struct EpiLoraDn {
    static constexpr bool PERM = true, I8 = false;
    bf16* O;
    __device__ __forceinline__ void operator()(const f32x4 (&acc)[2][2][4][2], const Unit& u, int wr, int wc, int fr, int fq) const {
        const int row0 = u.pm * 256 + wr * 64 + fr; const int col0 = u.pn * 256 + wc * 32 + 8 * fq;
#pragma unroll
        for (int ai = 0; ai < 2; ++ai)
#pragma unroll
            for (int m = 0; m < 4; ++m) { bf16* rowp = O + (size_t)(row0 + ai * 128 + m * 16) * 512 + col0;
#pragma unroll
                for (int bj = 0; bj < 2; ++bj) { f32x4 v0 = acc[ai][bj][m][0], v1 = acc[ai][bj][m][1];
                    const int mode = (u.pn == 1) ? 2 : ((wc >> 1) & 1);
                    if (mode == 0) {
#pragma unroll
                        for (int j = 0; j < 4; ++j) { v0[j] = 1.0f - 2.0f / (__expf(2.0f * v0[j]) + 1.0f); v1[j] = 1.0f - 2.0f / (__expf(2.0f * v1[j]) + 1.0f); } }
                    else if (mode == 2) {
#pragma unroll
                        for (int j = 0; j < 4; ++j) { v0[j] = sigmoidf_(v0[j]); v1[j] = sigmoidf_(v1[j]); } }
                    st8(rowp + bj * 128, v0, v1); } }
    }
};
struct EpiLoraUpWA {
    static constexpr bool PERM = true, I8 = false;
    bf16* LD; bf16* AS; const float* w0; const float* a0;
    __device__ __forceinline__ void operator()(const f32x4 (&acc)[2][2][4][2], const Unit& u, int wr, int wc, int fr, int fq) const {
        const int z = u.pn >> 3, kind = (u.pn >> 2) & 1;
        const int row0 = u.pm * 256 + wr * 64 + fr; const int col0 = (u.pn & 3) * 256 + wc * 32 + 8 * fq;
        bf16* base = (kind ? AS : LD) + (size_t)z * T * D; const float* bias = (kind ? a0 : w0) + z * 1024;
        f32x4 bv[2][2];
#pragma unroll
        for (int bj = 0; bj < 2; ++bj)
#pragma unroll
            for (int n = 0; n < 2; ++n) bv[bj][n] = *(const f32x4*)(bias + col0 + bj * 128 + 4 * n);
#pragma unroll
        for (int ai = 0; ai < 2; ++ai)
#pragma unroll
            for (int m = 0; m < 4; ++m) { bf16* rowp = base + (size_t)(row0 + ai * 128 + m * 16) * 1024 + col0;
#pragma unroll
                for (int bj = 0; bj < 2; ++bj) { f32x4 v[2];
#pragma unroll
                    for (int n = 0; n < 2; ++n) { v[n] = acc[ai][bj][m][n] + bv[bj][n];
#pragma unroll
                        for (int j = 0; j < 4; ++j) { const float x = v[n][j];
                            if (kind == 0) v[n][j] = -0.8750612633917001f * sigmoidf_(x);
                            else v[n][j] = sigmoidf_(x); } }
                    st8(rowp + bj * 128, v[0], v[1]); } }
    }
};
struct EpiResid {
    static constexpr bool PERM = true, I8 = false;
    const void* xin; int xin_f32; bf16* out; const float* gate;
    __device__ __forceinline__ void operator()(const f32x4 (&acc)[2][2][4][2], const Unit& u, int wr, int wc, int fr, int fq) const {
        const int row0 = u.pm * 256 + wr * 64 + fr, col0 = u.pn * 256 + wc * 32 + 8 * fq; const int b = u.pm >> 3;
        f32x4 gv[2][2];
#pragma unroll
        for (int bj = 0; bj < 2; ++bj)
#pragma unroll
            for (int n = 0; n < 2; ++n) gv[bj][n] = *(const f32x4*)(gate + (size_t)b * 6144 + col0 + bj * 128 + 4 * n);
        if (xin_f32) {
#pragma unroll
            for (int ai = 0; ai < 2; ++ai)
#pragma unroll
                for (int m = 0; m < 4; ++m) { const size_t off = (size_t)(row0 + ai * 128 + m * 16) * D + col0;
#pragma unroll
                    for (int bj = 0; bj < 2; ++bj) { const f32x4 x0 = *(const f32x4*)((const float*)xin + off + bj * 128), x1 = *(const f32x4*)((const float*)xin + off + bj * 128 + 4);
                        st8(out + off + bj * 128, x0 + gv[bj][0] * acc[ai][bj][m][0], x1 + gv[bj][1] * acc[ai][bj][m][1]); } }
        } else {
#pragma unroll
            for (int ai = 0; ai < 2; ++ai) { u32x4 xr[4][2];
#pragma unroll
                for (int m = 0; m < 4; ++m)
#pragma unroll
                    for (int bj = 0; bj < 2; ++bj) xr[m][bj] = *(const u32x4*)((const bf16*)xin + (size_t)(row0 + ai * 128 + m * 16) * D + col0 + bj * 128);
#pragma unroll
                for (int m = 0; m < 4; ++m) { const size_t off = (size_t)(row0 + ai * 128 + m * 16) * D + col0;
#pragma unroll
                    for (int bj = 0; bj < 2; ++bj) { const u32x4 r = xr[m][bj];
                        const f32x4 x0 = {bf_lo(r.x), bf_hi(r.x), bf_lo(r.y), bf_hi(r.y)}, x1 = {bf_lo(r.z), bf_hi(r.z), bf_lo(r.w), bf_hi(r.w)};
                        st8(out + off + bj * 128, x0 + gv[bj][0] * acc[ai][bj][m][0], x1 + gv[bj][1] * acc[ai][bj][m][1]); } } }
        }
    }
};
struct EpiQKV {
    static constexpr bool PERM = true, I8 = false;
    bf16* Q; bf16* Kb; bf16* Vb; float qscale;
    __device__ __forceinline__ void operator()(const f32x4 (&acc)[2][2][4][2], const Unit& u, int wr, int wc, int fr, int fq) const {
        const int g = u.pn / 12, which = (u.pn % 12) >> 2, hp = u.pn & 3;
        const int row0 = u.pm * 256 + wr * 64 + fr;
        bf16* base = Q + (size_t)which * ((A_K - A_Q) / 2) + (size_t)g * T * D; const float sc = which ? 1.0f : qscale; const int col0 = hp * 256 + wc * 32 + 8 * fq;
#pragma unroll
        for (int ai = 0; ai < 2; ++ai)
#pragma unroll
            for (int m = 0; m < 4; ++m) { bf16* rowp = base + (size_t)(row0 + ai * 128 + m * 16) * 1024 + col0;
#pragma unroll
                for (int bj = 0; bj < 2; ++bj) st8(rowp + bj * 128, acc[ai][bj][m][0] * sc, acc[ai][bj][m][1] * sc); }
    }
};
struct EpiQKV8 {
    static constexpr bool PERM = true, I8 = true;
    bf16* Q; const float* SA; const float* SBq; float qscale;
    __device__ __forceinline__ void operator()(const pg8::i32x4 (&acc)[2][2][4][2], const Unit& u, int wr, int wc, int fr, int fq) const {
        const int g = u.pn / 12, which = (u.pn % 12) >> 2, hp = u.pn & 3;
        const int row0 = u.pm * 256 + wr * 64 + fr;
        bf16* base = Q + (size_t)which * ((A_K - A_Q) / 2) + (size_t)g * T * D; const float sc = which ? 1.0f : qscale; const int col0 = hp * 256 + wc * 32 + 8 * fq;
        const int colb = u.pn * 256 + wc * 32 + 8 * fq;
        f32x4 sbv[2][2];
#pragma unroll
        for (int bj = 0; bj < 2; ++bj)
#pragma unroll
            for (int n = 0; n < 2; ++n) sbv[bj][n] = *(const f32x4*)(SBq + colb + bj * 128 + 4 * n) * sc;
#pragma unroll
        for (int ai = 0; ai < 2; ++ai)
#pragma unroll
            for (int m = 0; m < 4; ++m) { const int row = row0 + ai * 128 + m * 16; const float sa = SA[row]; bf16* rowp = base + (size_t)row * 1024 + col0;
#pragma unroll
                for (int bj = 0; bj < 2; ++bj) st8(rowp + bj * 128, __builtin_convertvector(acc[ai][bj][m][0], f32x4) * (sbv[bj][0] * sa), __builtin_convertvector(acc[ai][bj][m][1], f32x4) * (sbv[bj][1] * sa)); }
    }
};
struct EpiGateUp {
    static constexpr bool PERM = true, I8 = false;
    bf16* H; const float* roww;
    __device__ __forceinline__ void operator()(const f32x4 (&acc)[2][2][4][2], const Unit& u, int wr, int wc, int fr, int fq) const {
        const int row0 = u.pm * 256 + wr * 64 + fr; const int col0 = u.pn * 128 + wc * 32 + 8 * fq;
#pragma unroll
        for (int ai = 0; ai < 2; ++ai)
#pragma unroll
            for (int m = 0; m < 4; ++m) { const int row = row0 + ai * 128 + m * 16; const float rw = roww[row]; f32x4 v[2];
#pragma unroll
                for (int n = 0; n < 2; ++n)
#pragma unroll
                    for (int j = 0; j < 4; ++j) { const float gg = acc[ai][0][m][n][j], uu = acc[ai][1][m][n][j]; v[n][j] = gg * sigmoidf_(gg) * uu * rw; }
                st8(H + (size_t)row * FEXP + col0, v[0], v[1]); }
    }
};
struct EpiPlain {
    static constexpr bool PERM = true, I8 = false;
    bf16* O;
    __device__ __forceinline__ void operator()(const f32x4 (&acc)[2][2][4][2], const Unit& u, int wr, int wc, int fr, int fq) const {
        const int row0 = u.pm * 256 + wr * 64 + fr; const int col0 = u.pn * 256 + wc * 32 + 8 * fq;
#pragma unroll
        for (int ai = 0; ai < 2; ++ai)
#pragma unroll
            for (int m = 0; m < 4; ++m) { bf16* rowp = O + (size_t)(row0 + ai * 128 + m * 16) * 1024 + col0;
#pragma unroll
                for (int bj = 0; bj < 2; ++bj) st8(rowp + bj * 128, acc[ai][bj][m][0], acc[ai][bj][m][1]); }
    }
};

struct Args {
    const float* in[32]; float* out; unsigned char* ws; int ph_lo, ph_hi;
};
enum { I_X = 0, I_C, I_ADAW, I_ADAB, I_NTM, I_NCM, I_MU, I_WRKV, I_W0, I_W1, I_W2, I_A0, I_A1, I_A2, I_G1, I_G2, I_KK, I_KA, I_RK, I_LNW, I_LNB, I_RWO,
       I_AQKV, I_AWO, I_RG, I_RGB, I_RE, I_REB, I_WG, I_WU, I_WD, I_FG };

struct Frame {
    LAS unsigned char* lds; int tid, lane, wave, G, gw, NGW;
    unsigned char* ws; const float* const* in; float* out;
};

__device__ __forceinline__ void row_load(const float* p, int lane, f32x4 (&v)[4]) {
#pragma unroll
    for (int j = 0; j < 4; ++j) v[j] = *(const f32x4*)(p + 4 * lane + 256 * j);
}
__device__ __forceinline__ void row_load_bf16(const bf16* p, int lane, f32x4 (&v)[4]) {
#pragma unroll
    for (int j = 0; j < 4; ++j) { const u32x2 r = *(const u32x2*)(p + 4 * lane + 256 * j); v[j] = (f32x4){bf_lo(r.x), bf_hi(r.x), bf_lo(r.y), bf_hi(r.y)}; }
}
__device__ __forceinline__ void row_store(float* p, int lane, const f32x4 (&v)[4]) {
#pragma unroll
    for (int j = 0; j < 4; ++j) *(f32x4*)(p + 4 * lane + 256 * j) = v[j];
}
__device__ __forceinline__ void row_store_bf16(bf16* p, int lane, const f32x4 (&v)[4]) {
#pragma unroll
    for (int j = 0; j < 4; ++j) { u32x2 w; w.x = pk2(v[j][0], v[j][1]); w.y = pk2(v[j][2], v[j][3]); *(u32x2*)(p + 4 * lane + 256 * j) = w; }
}
__device__ __forceinline__ void row_combine(f32x4 (&v)[4], const bf16* ys, const int* tokp, int row, const float* gac, int lane) {
    const int p0 = tokp[2 * row], p1 = tokp[2 * row + 1];
    const bf16* y0 = ys + (size_t)p0 * D; const bf16* y1 = ys + (size_t)p1 * D;
#pragma unroll
    for (int j = 0; j < 4; ++j) { const u32x2 a = *(const u32x2*)(y0 + 4 * lane + 256 * j), b = *(const u32x2*)(y1 + 4 * lane + 256 * j); const f32x4 g = *(const f32x4*)(gac + 4 * lane + 256 * j);
        v[j][0] += g[0] * (bf_lo(a.x) + bf_lo(b.x)); v[j][1] += g[1] * (bf_hi(a.x) + bf_hi(b.x)); v[j][2] += g[2] * (bf_lo(a.y) + bf_lo(b.y)); v[j][3] += g[3] * (bf_hi(a.y) + bf_hi(b.y)); }
}
__device__ __forceinline__ void row_norm_mod(const f32x4 (&x)[4], const float* gain, const float* sc, const float* sh, int lane, f32x4 (&h)[4]) {
    float s = 0.f;
#pragma unroll
    for (int j = 0; j < 4; ++j) s += (x[j][0] * x[j][0] + x[j][1] * x[j][1]) + (x[j][2] * x[j][2] + x[j][3] * x[j][3]);
    const float rstd = rsqrtf(wave_sum(s, lane) * (1.0f / D) + RMS_EPS);
#pragma unroll
    for (int j = 0; j < 4; ++j) { const f32x4 g = *(const f32x4*)(gain + 4 * lane + 256 * j), c = *(const f32x4*)(sc + 4 * lane + 256 * j), b = *(const f32x4*)(sh + 4 * lane + 256 * j);
        h[j] = x[j] * rstd * g * (1.0f + c) + b; }
}
__device__ __forceinline__ void transpose_item(const float* W, int ldw, bf16* dst, int ldd, LAS float* scr, int lane) {
    { const int r8 = lane >> 3, c4 = (lane & 7) * 4;
      f32x4 v[8];
#pragma unroll
      for (int i = 0; i < 8; ++i) v[i] = *(const f32x4*)(W + (size_t)(8 * i + r8) * ldw + c4);
#pragma unroll
      for (int i = 0; i < 8; ++i) { LAS float* p = scr + (8 * i + r8) * 33 + c4; p[0] = v[i][0]; p[1] = v[i][1]; p[2] = v[i][2]; p[3] = v[i][3]; } }
    LDS_WAIT(); asm volatile("" ::: "memory");
    const int c = lane & 7;
#pragma unroll
    for (int j = 0; j < 4; ++j) { const int n = (lane >> 3) + 8 * j; const LAS float* s = scr + (8 * c) * 33 + n;
        u32x4 o; o.x = pk2(s[0 * 33], s[1 * 33]); o.y = pk2(s[2 * 33], s[3 * 33]); o.z = pk2(s[4 * 33], s[5 * 33]); o.w = pk2(s[6 * 33], s[7 * 33]);
        *(u32x4*)(dst + (size_t)n * ldd + 8 * c) = o; }
    LDS_WAIT(); asm volatile("" ::: "memory");
}

__device__ __forceinline__ void phase_prologue(Frame& F) {
    const float* c = F.in[I_C]; const float* adaw = F.in[I_ADAW]; const float* adab = F.in[I_ADAB];
    float* mod = (float*)(F.ws + WS_MOD);
    LAS float* sc = (LAS float*)F.lds;
    LAS float* part = (LAS float*)(F.lds + 32768);
    for (int i = F.tid; i < NB * D; i += NTHREADS) { const float v = c[i]; sc[i] = v / (1.0f + __expf(-v)); }
    __syncthreads();
    for (int u = blockIdx.x; u < DEPTH * 96; u += F.G) {
        const int l = u / 96, n0 = (u % 96) * 64, col = n0 + F.lane;
        const float* W = adaw + (size_t)l * D * 6144 + col;
        float acc[8];
#pragma unroll
        for (int b = 0; b < 8; ++b) acc[b] = 0.f;
        const int kbeg = F.wave * 128;
#pragma unroll 8
        for (int k = kbeg; k < kbeg + 128; ++k) { const float w = W[(size_t)k * 6144];
#pragma unroll
            for (int b = 0; b < 8; ++b) acc[b] += sc[b * D + k] * w; }
#pragma unroll
        for (int b = 0; b < 8; ++b) part[(F.wave * 8 + b) * 64 + F.lane] = acc[b];
        __syncthreads();
        { const int b = F.tid >> 6; float s = adab[l * 6144 + col];
#pragma unroll
          for (int w = 0; w < 8; ++w) s += part[(w * 8 + b) * 64 + F.lane];
          mod[(size_t)(l * 8 + b) * 6144 + col] = s; }
        __syncthreads();
    }
    LAS float* scr = (LAS float*)(F.lds + 49152 + F.wave * 8704);
    constexpr int I_SQ = 16 * 32;
    constexpr int I_QKV = 16 * 288;
    constexpr int PER_RW = 4 * I_SQ, PER_AT = I_QKV + I_SQ, NIT = 2 * PER_RW + 2 * PER_AT;
    for (int it = F.gw; it < NIT; it += F.NGW) {
        int r = it;
        if (r < 2 * PER_RW) { const int j = r / PER_RW; r %= PER_RW; const int mi = r / I_SQ; r %= I_SQ; const int kb = r / 32, nb = r % 32;
            if (mi < 3) transpose_item(F.in[I_WRKV] + ((size_t)(j * 3 + mi) * D + kb * 64) * D + nb * 32, D, (bf16*)(F.ws + WS_W + j * W_RW_STRIDE + W_RKV) + (size_t)(mi * D + nb * 32) * D + kb * 64, D, scr, F.lane);
            else transpose_item(F.in[I_RWO] + ((size_t)j * D + kb * 64) * D + nb * 32, D, (bf16*)(F.ws + WS_W + j * W_RW_STRIDE + W_RWO) + (size_t)(nb * 32) * D + kb * 64, D, scr, F.lane);
        } else { r -= 2 * PER_RW; const int j = r / PER_AT; r %= PER_AT;
            if (r < I_QKV) { }
            else { r -= I_QKV; const int kb = r / 32, nb = r % 32;
                transpose_item(F.in[I_AWO] + ((size_t)j * D + kb * 64) * D + nb * 32, D, (bf16*)(F.ws + WS_WA + j * W_AT_STRIDE + W_AWO) + (size_t)(nb * 32) * D + kb * 64, D, scr, F.lane); }
        }
    }
    {
        LAS float* pm = (LAS float*)(F.lds + 118784); LAS float* invs = (LAS float*)(F.lds + 120832);
        for (int u = blockIdx.x; u < 2 * 144; u += F.G) {
            const int j = u / 144, n0 = (u % 144) * 64;
            const float* W = F.in[I_AQKV] + (size_t)j * D * QKVW + n0;
            signed char* Bq = (signed char*)(F.ws + WS_WA + j * W_AT_STRIDE + W_QKV); float* SBq = (float*)(F.ws + WS_WA + j * W_AT_STRIDE + W_QKVS);
            float m = 0.f;
#pragma unroll 16
            for (int k = F.wave * 128; k < F.wave * 128 + 128; ++k) m = fmaxf(m, fabsf(W[(size_t)k * QKVW + F.lane]));
            pm[F.wave * 64 + F.lane] = m;
            __syncthreads();
            if (F.tid < 64) { float a = pm[F.tid];
#pragma unroll
                for (int w = 1; w < 8; ++w) a = fmaxf(a, pm[w * 64 + F.tid]);
                a = fmaxf(a, 1e-20f); invs[F.tid] = 127.0f / a; SBq[n0 + F.tid] = a * (1.0f / 127.0f); }
            __syncthreads();
            for (int tile = F.wave; tile < 32; tile += NWAVES) { const int kb = tile >> 1, nh = tile & 1;
                const float* src = W + (size_t)(kb * 64) * QKVW + nh * 32;
                { const int r8 = F.lane >> 3, c4 = (F.lane & 7) * 4; f32x4 v[8];
#pragma unroll
                  for (int i = 0; i < 8; ++i) v[i] = *(const f32x4*)(src + (size_t)(8 * i + r8) * QKVW + c4);
#pragma unroll
                  for (int i = 0; i < 8; ++i) { LAS float* p = scr + (8 * i + r8) * 33 + c4; p[0] = v[i][0]; p[1] = v[i][1]; p[2] = v[i][2]; p[3] = v[i][3]; } }
                LDS_WAIT(); asm volatile("" ::: "memory");
                const int c = F.lane & 7;
#pragma unroll
                for (int jj = 0; jj < 4; ++jj) { const int n = (F.lane >> 3) + 8 * jj; const LAS float* sp = scr + (8 * c) * 33 + n; const float inv = invs[nh * 32 + n];
                    u32x2 o; o.x = pack_i8x4((f32x4){sp[0 * 33], sp[1 * 33], sp[2 * 33], sp[3 * 33]}, inv); o.y = pack_i8x4((f32x4){sp[4 * 33], sp[5 * 33], sp[6 * 33], sp[7 * 33]}, inv);
                    *(u32x2*)(Bq + (size_t)(n0 + nh * 32 + n) * D + kb * 64 + 8 * c) = o; }
                LDS_WAIT(); asm volatile("" ::: "memory");
            }
            __syncthreads();
        }
    }
    const int gt = blockIdx.x * NTHREADS + F.tid, NGT = F.G * NTHREADS;
    for (int j = 0; j < 2; ++j) {
        bf16* ldn = (bf16*)(F.ws + WS_W + j * W_RW_STRIDE + W_LDN);
        const float* mu = F.in[I_MU] + (size_t)j * 6 * D;
        for (int i = gt; i < 512 * 2048; i += NGT) { const int n = i >> 11, k = i & 2047, kk = k & 1023;
            float v; int mi;
            if (n < 256) { const int blk = n >> 6, z = blk >> 1, isA = blk & 1, nn = n & 63;
                v = (isA ? F.in[I_A1] : F.in[I_W1])[((size_t)(j * 2 + z) * D + kk) * 64 + nn]; mi = isA ? 4 : 3; }
            else { const int z = (n - 256) >> 7, nn = n & 127; v = F.in[I_G1][((size_t)(j * 2 + z) * D + kk) * 128 + nn]; mi = 5; }
            if (k >= 1024) v *= mu[mi * D + kk];
            ldn[i] = (bf16)f2bf(v); }
        bf16* lwa = (bf16*)(F.ws + WS_W + j * W_RW_STRIDE + W_LUPWA);
        for (int i = gt; i < 4096 * 128; i += NGT) { const int n = i >> 7, k = i & 127; const int z = n >> 11, isA = (n >> 10) & 1, col = n & 1023;
            float v = 0.f;
            if ((k >> 6) == isA) v = (isA ? F.in[I_A2] : F.in[I_W2])[((size_t)(j * 2 + z) * 64 + (k & 63)) * D + col];
            lwa[i] = (bf16)f2bf(v); }
        bf16* lg = (bf16*)(F.ws + WS_W + j * W_RW_STRIDE + W_LUPG);
        for (int i = gt; i < 2048 * 128; i += NGT) { const int n = i >> 7, k = i & 127; const int z = n >> 10, col = n & 1023;
            lg[i] = (bf16)f2bf(F.in[I_G2][((size_t)(j * 2 + z) * 128 + k) * D + col]); }
    }
}

__device__ __forceinline__ void rw_hrow(Frame& F, int l, bool combine, const void* xsrc, bf16* xdst, bool own, int row, f32x4 (&h)[4]) {
    const int b = row >> 11; const float* mod = (const float*)(F.ws + WS_MOD);
    f32x4 x[4]; if (l == 0) row_load((const float*)xsrc + (size_t)row * D, F.lane, x); else row_load_bf16((const bf16*)xsrc + (size_t)row * D, F.lane, x);
    if (combine) { row_combine(x, (const bf16*)(F.ws + WS_ACT + A_YS), (const int*)(F.ws + WS_TOKP), row, mod + (size_t)((l - 1) * 8 + b) * 6144 + 5 * D, F.lane);
        if (own) row_store_bf16(xdst + (size_t)row * D, F.lane, x); }
    const float* mp = mod + (size_t)(l * 8 + b) * 6144;
    row_norm_mod(x, F.in[I_NTM] + l * D, mp + 1 * D, mp + 0 * D, F.lane, h);
}
__device__ __forceinline__ void phase_rw_norm(Frame& F, int l, bool combine, const void* xsrc, bf16* xdst) {
    const int j = l >> 1; const float* mu = F.in[I_MU] + (size_t)j * 6 * D;
    bf16* xs = (bf16*)(F.ws + WS_ACT + A_XS); bf16* hx = (bf16*)(F.ws + WS_ACT + A_HX);
    for (int ch = F.gw; ch < T / 8; ch += F.NGW) {
        const int row0 = ch * 8, t0 = row0 & (SEQ - 1);
        f32x4 prev[4], cur[4], nxt[4];
        if (t0 > 0) rw_hrow(F, l, combine, xsrc, xdst, false, row0 - 1, prev);
        else {
#pragma unroll
            for (int q = 0; q < 4; ++q) prev[q] = (f32x4){0.f, 0.f, 0.f, 0.f}; }
        rw_hrow(F, l, combine, xsrc, xdst, true, row0, cur);
        for (int i = 0; i < 8; ++i) {
            const int row = row0 + i;
            if (t0 + i + 1 < SEQ) rw_hrow(F, l, combine, xsrc, xdst, i < 7, row + 1, nxt);
            else {
#pragma unroll
                for (int q = 0; q < 4; ++q) nxt[q] = (f32x4){0.f, 0.f, 0.f, 0.f}; }
            f32x4 xx[4];
#pragma unroll
            for (int q = 0; q < 4; ++q) xx[q] = 0.5f * (prev[q] + nxt[q]) - cur[q];
#pragma unroll
            for (int mi = 0; mi < 3; ++mi) { f32x4 o[4];
#pragma unroll
                for (int q = 0; q < 4; ++q) { const f32x4 m = *(const f32x4*)(mu + mi * D + 4 * F.lane + 256 * q); o[q] = cur[q] + xx[q] * m; }
                row_store_bf16(xs + ((size_t)mi * T + row) * D, F.lane, o); }
            row_store_bf16(hx + (size_t)row * 2048, F.lane, cur);
            row_store_bf16(hx + (size_t)row * 2048 + D, F.lane, xx);
#pragma unroll
            for (int q = 0; q < 4; ++q) { prev[q] = cur[q]; cur[q] = nxt[q]; }
        }
    }
}

__device__ __forceinline__ void phase_at_norm(Frame& F, int l, const bf16* xsrc, bf16* xdst) {
    const float* mod = (const float*)(F.ws + WS_MOD); signed char* H8 = (signed char*)(F.ws + WS_ACT + A_H); float* SA = (float*)(F.ws + WS_SA);
    for (int row = F.gw; row < T; row += F.NGW) {
        const int b = row >> 11; f32x4 x[4], h[4]; row_load_bf16(xsrc + (size_t)row * D, F.lane, x);
        row_combine(x, (const bf16*)(F.ws + WS_ACT + A_YS), (const int*)(F.ws + WS_TOKP), row, mod + (size_t)((l - 1) * 8 + b) * 6144 + 5 * D, F.lane);
        row_store_bf16(xdst + (size_t)row * D, F.lane, x);
        const float* mp = mod + (size_t)(l * 8 + b) * 6144;
        row_norm_mod(x, F.in[I_NTM] + l * D, mp + 1 * D, mp + 0 * D, F.lane, h);
        float am = 0.f;
#pragma unroll
        for (int j = 0; j < 4; ++j) am = fmaxf(am, fmaxf(fmaxf(fabsf(h[j][0]), fabsf(h[j][1])), fmaxf(fabsf(h[j][2]), fabsf(h[j][3]))));
        am = fmaxf(wave_max(am), 1e-20f); const float inv = 127.0f / am;
        if (F.lane == 0) SA[row] = am * (1.0f / 127.0f);
#pragma unroll
        for (int j = 0; j < 4; ++j) *(unsigned*)(H8 + (size_t)row * D + 4 * F.lane + 256 * j) = pack_i8x4(h[j], inv);
    }
}
__device__ __forceinline__ void phase_final(Frame& F, const bf16* xsrc) {
    const float* mod = (const float*)(F.ws + WS_MOD); const float* fg = F.in[I_FG];
    for (int row = F.gw; row < T; row += F.NGW) {
        const int b = row >> 11; f32x4 x[4]; row_load_bf16(xsrc + (size_t)row * D, F.lane, x);
        row_combine(x, (const bf16*)(F.ws + WS_ACT + A_YS), (const int*)(F.ws + WS_TOKP), row, mod + (size_t)(3 * 8 + b) * 6144 + 5 * D, F.lane);
        float s = 0.f;
#pragma unroll
        for (int j = 0; j < 4; ++j) s += (x[j][0] * x[j][0] + x[j][1] * x[j][1]) + (x[j][2] * x[j][2] + x[j][3] * x[j][3]);
        const float rstd = rsqrtf(wave_sum(s, F.lane) * (1.0f / D) + RMS_EPS);
#pragma unroll
        for (int j = 0; j < 4; ++j) { const f32x4 g = *(const f32x4*)(fg + 4 * F.lane + 256 * j); x[j] = x[j] * rstd * g; }
        row_store(F.out + (size_t)row * D, F.lane, x);
    }
}

__device__ __forceinline__ void phase_moe_route(Frame& F, int l, const bf16* xsrc, int cnt_shift = 0) {
    const float* mod = (const float*)(F.ws + WS_MOD); bf16* HN = (bf16*)(F.ws + WS_ACT + A_HN2);
    LAS int* lcnt = (LAS int*)F.lds; LAS int* gbase = lcnt + 32; LAS int* inf_e = lcnt + 64; LAS int* inf_r = inf_e + 128; LAS float* inf_w = (LAS float*)(inf_r + 128);
    unsigned* cnt = (unsigned*)(F.ws + WS_CTL) + CW_CNT + (l + cnt_shift) * 32;
    int* toke = (int*)(F.ws + WS_TOKE); int* tokr = (int*)(F.ws + WS_TOKR); float* tokw = (float*)(F.ws + WS_TOKW);
    { int* rowt = (int*)(F.ws + WS_ROWT); for (int i = blockIdx.x * NTHREADS + F.tid; i < MAXROWS; i += F.G * NTHREADS) rowt[i] = 0; }
    const float* rg = F.in[I_RG] + (size_t)l * D * 4; const float* rgb = F.in[I_RGB] + l * 4;
    LAS float* RW = (LAS float*)(F.lds + 4096);
    for (int i = F.tid; i < D * 4; i += NTHREADS) RW[(i & 3) * D + (i >> 2)] = rg[i];
    { const float* rea = F.in[I_RE] + (size_t)l * 4 * D * 8;
      for (int i = F.tid; i < 4 * D * 8; i += NTHREADS) RW[(4 + (i >> 13) * 8 + (i & 7)) * D + ((i >> 3) & 1023)] = rea[i]; }
    for (int cb = blockIdx.x; cb < T / 64; cb += F.G) {
        if (F.tid < 32) lcnt[F.tid] = 0;
        __syncthreads();
        for (int i = 0; i < 8; ++i) {
            const int lr = F.wave * 8 + i, row = cb * 64 + lr, b = row >> 11;
            f32x4 x[4], h[4]; row_load_bf16(xsrc + (size_t)row * D, F.lane, x);
            const float* mp = mod + (size_t)(l * 8 + b) * 6144;
            row_norm_mod(x, F.in[I_NCM] + l * D, mp + 4 * D, mp + 3 * D, F.lane, h);
            row_store_bf16(HN + (size_t)row * D, F.lane, h);
            float gl[4] = {0.f, 0.f, 0.f, 0.f};
#pragma unroll
            for (int e = 0; e < 4; ++e)
#pragma unroll
                for (int j = 0; j < 4; ++j) { const f32x4 w = *(const LAS f32x4*)(RW + e * D + 4 * F.lane + 256 * j); gl[e] += (h[j][0] * w[0] + h[j][1] * w[1]) + (h[j][2] * w[2] + h[j][3] * w[3]); }
#pragma unroll
            for (int e = 0; e < 4; ++e) gl[e] = wave_sum(gl[e], F.lane) + rgb[e];
            const float gm = fmaxf(fmaxf(gl[0], gl[1]), fmaxf(gl[2], gl[3]));
            const int gtop = (gl[0] == gm) ? 0 : (gl[1] == gm) ? 1 : (gl[2] == gm) ? 2 : 3;
            const float pg = 1.0f / (__expf(gl[0] - gm) + __expf(gl[1] - gm) + __expf(gl[2] - gm) + __expf(gl[3] - gm));
            const float* reb = F.in[I_REB] + (l * 4 + gtop) * 8; const LAS float* rwe = RW + (4 + gtop * 8) * D + 4 * F.lane;
            float el[8];
#pragma unroll
            for (int e = 0; e < 8; ++e) { el[e] = 0.f;
#pragma unroll
                for (int j = 0; j < 4; ++j) { const f32x4 w = *(const LAS f32x4*)(rwe + e * D + 256 * j); el[e] += (h[j][0] * w[0] + h[j][1] * w[1]) + (h[j][2] * w[2] + h[j][3] * w[3]); } }
#pragma unroll
            for (int e = 0; e < 8; ++e) el[e] = wave_sum(el[e], F.lane) + reb[e];
            float v0 = el[0]; int i0 = 0;
#pragma unroll
            for (int e = 1; e < 8; ++e) if (el[e] > v0) { v0 = el[e]; i0 = e; }
            float v1 = -3.0e38f; int i1 = 0;
#pragma unroll
            for (int e = 0; e < 8; ++e) if (e != i0 && el[e] > v1) { v1 = el[e]; i1 = e; }
            const float ex = __expf(v1 - v0); const float w0 = pg / (1.0f + ex), w1 = pg * ex / (1.0f + ex);
            if (F.lane == 0) {
                const int e0 = gtop * 8 + i0, e1 = gtop * 8 + i1;
                const int r0 = __hip_atomic_fetch_add(lcnt + e0, 1, __ATOMIC_RELAXED, __HIP_MEMORY_SCOPE_WORKGROUP);
                const int r1 = __hip_atomic_fetch_add(lcnt + e1, 1, __ATOMIC_RELAXED, __HIP_MEMORY_SCOPE_WORKGROUP);
                inf_e[lr * 2] = e0; inf_e[lr * 2 + 1] = e1; inf_r[lr * 2] = r0; inf_r[lr * 2 + 1] = r1; inf_w[lr * 2] = w0; inf_w[lr * 2 + 1] = w1;
            }
        }
        __syncthreads();
        if (F.tid < 32) gbase[F.tid] = (int)__hip_atomic_fetch_add(cnt + F.tid, (unsigned)lcnt[F.tid], __ATOMIC_RELAXED, __HIP_MEMORY_SCOPE_AGENT);
        __syncthreads();
        if (F.tid < 128) { const int idx = cb * 128 + F.tid; const int e = inf_e[F.tid]; toke[idx] = e; tokr[idx] = gbase[e] + inf_r[F.tid]; tokw[idx] = inf_w[F.tid]; }
        __syncthreads();
    }
}
__device__ __forceinline__ void moe_tables(Frame& F, int l) {
    LAS int* tileE = (LAS int*)(F.lds + TILEE_OFF); LAS int* offs = (LAS int*)(F.lds + OFFS_OFF);
    const unsigned* cnt = (const unsigned*)(F.ws + WS_CTL) + CW_CNT + l * 32;
    if (F.tid == 0) { int o = 0, nt = 0;
#pragma clang loop unroll(disable)
        for (int e = 0; e < 32; ++e) { const int c = (int)__hip_atomic_load(cnt + e, __ATOMIC_RELAXED, __HIP_MEMORY_SCOPE_AGENT); offs[e] = o; const int ne = (c + 255) >> 8;
#pragma clang loop unroll(disable)
            for (int k = 0; k < ne && nt < 160; ++k) tileE[nt++] = e;
            o += ne * 256; }
        tileE[160] = nt; offs[32] = o; }
    __syncthreads();
}
__device__ __forceinline__ void moe_convert(Frame& F, int l, int first, int stride) {
    LAS float* scr = (LAS float*)(F.lds + 49152 + F.wave * 8704);
    bf16* WGU = (bf16*)(F.ws + ws_wm_of(l) + W_GU); bf16* WDN = (bf16*)(F.ws + ws_wm_of(l) + W_DN);
    constexpr int I_GATE = 16 * 8, I_DOWN = 4 * 32;
    for (int it = first; it < NEXP * (2 * I_GATE + I_DOWN); it += stride) {
        const int e = it / (2 * I_GATE + I_DOWN); int r = it % (2 * I_GATE + I_DOWN);
        if (r < 2 * I_GATE) { const int up = r / I_GATE; r %= I_GATE; const int kb = r / 8, nb = r % 8, n0 = nb * 32;
            const float* src = (up ? F.in[I_WU] : F.in[I_WG]) + ((size_t)(l * 32 + e) * D + kb * 64) * FEXP + n0;
            const int drow = (n0 >> 7) * 256 + up * 128 + (n0 & 127);
            transpose_item(src, FEXP, WGU + ((size_t)e * 512 + drow) * D + kb * 64, D, scr, F.lane);
        } else { r -= 2 * I_GATE; const int kb = r / 32, nb = r % 32;
            const float* src = F.in[I_WD] + ((size_t)(l * 32 + e) * FEXP + kb * 64) * D + nb * 32;
            transpose_item(src, D, WDN + ((size_t)e * D + nb * 32) * FEXP + kb * 64, FEXP, scr, F.lane); }
    }
}
__device__ __forceinline__ void phase_moe_gather(Frame& F, int l) {
    moe_tables(F, l);
    const LAS int* offs = (const LAS int*)(F.lds + OFFS_OFF);
    if (blockIdx.x == 0 && F.tid < 161) ((int*)(F.ws + WS_TILEE))[F.tid] = ((const LAS int*)(F.lds + TILEE_OFF))[F.tid];
    const int* toke = (const int*)(F.ws + WS_TOKE); const int* tokr = (const int*)(F.ws + WS_TOKR); const float* tokw = (const float*)(F.ws + WS_TOKW);
    int* tokp = (int*)(F.ws + WS_TOKP); float* roww = (float*)(F.ws + WS_ROWW);
    int* rowt = (int*)(F.ws + WS_ROWT);
    for (int idx = blockIdx.x * NTHREADS + F.tid; idx < 2 * T; idx += F.G * NTHREADS) {
        const int e = toke[idx]; const int pos = offs[e] + tokr[idx];
        tokp[idx] = pos; roww[pos] = tokw[idx]; rowt[pos] = idx >> 1;
    }
    if (l == 0) moe_convert(F, 0, F.gw, F.NGW);
}

#ifndef SCAN_DUP
#define SCAN_DUP 0
#endif
namespace wk {
constexpr int P = 72, PB = 144, MAT = 64 * PB;
constexpr int PF = 68;
constexpr int O_NAB = 0, O_GS = 17408, O_GC = 19456, O_M0 = 20480;
constexpr int O_AT = O_M0, O_RT = O_AT + MAT, O_BT = O_RT + MAT, O_KT = O_BT + MAT, O_VV = O_KT + MAT, O_LAK = O_VV + MAT, O_MRB = O_LAK + MAT, O_MRK = O_MRB + MAT,
              O_NB = O_MRK + MAT, O_TT = O_NB + MAT, O_XT = O_TT + MAT, O_UT = O_XT + MAT, O_MT = O_UT + MAT, O_H0 = O_MT + MAT, O_H1 = O_H0 + MAT, O_END = O_H1 + MAT;
static_assert(O_END <= LDS_MISC, "scan LDS map");
typedef union { u32x4 u; bf16x8 v; } frag_t;
__device__ __forceinline__ bf16x8 zfrag() { frag_t z; z.u = (u32x4){0u, 0u, 0u, 0u}; return z.v; }
__device__ __forceinline__ bf16x8 ldrow(const LAS unsigned char* M, int row, int col) { return *(const LAS bf16x8*)(M + row * PB + col * 2); }
__device__ __forceinline__ bf16x8 ldtr(unsigned base, int r0, int c0, int lane) {
    const int g = lane >> 4, i = lane & 15, qq = i >> 2, p = i & 3;
    const unsigned a0 = base + (unsigned)((r0 + 8 * g + qq) * PB + (c0 + 4 * p) * 2), a1 = a0 + 4u * PB;
    u32x2 lo, hi;
    asm volatile("ds_read_b64_tr_b16 %0, %2\n\tds_read_b64_tr_b16 %1, %3\n\ts_waitcnt lgkmcnt(0)" : "=&v"(lo), "=&v"(hi) : "v"(a0), "v"(a1) : "memory");
    frag_t f; f.u.x = lo.x; f.u.y = lo.y; f.u.z = hi.x; f.u.w = hi.y; return f.v;
}
__device__ __forceinline__ void st4bf(LAS unsigned char* M, int row, int col, const f32x4& v) { u32x2 w; w.x = pk2(v[0], v[1]); w.y = pk2(v[2], v[3]); *(LAS u32x2*)(M + row * PB + col * 2) = w; }
#define WK_MFMA(a, b, c) __builtin_amdgcn_mfma_f32_16x16x32_bf16(a, b, c, 0, 0, 0)
template <int M> __device__ __forceinline__ float rshare(float v) { return __int_as_float(__builtin_amdgcn_update_dpp(0, __float_as_int(v), 0x150 + M, 0xf, 0xf, false)); }
#define WK_BAR() do { asm volatile("s_waitcnt lgkmcnt(0)" ::: "memory"); __builtin_amdgcn_s_barrier(); asm volatile("" ::: "memory"); } while (0)
}

__device__ __forceinline__ void phase_scan(Frame& F, int l) {
    using namespace wk;
    const int j = l >> 1;
    const bf16* Rb = (const bf16*)(F.ws + WS_ACT + A_RKV); const bf16* Kb = Rb + (size_t)T * D; const bf16* Vb = Kb + (size_t)T * D;
    const bf16* LD = (const bf16*)(F.ws + WS_ACT + A_LDEC); const bf16* AS = (const bf16*)(F.ws + WS_ACT + A_ASIG);
    bf16* Y = (bf16*)(F.ws + WS_ACT + A_Y); float* SB = (float*)(F.ws + WS_SB);
    LAS unsigned char* L = F.lds; const unsigned La = (unsigned)(size_t)L;
    LAS float* NAB = (LAS float*)(L + O_NAB); LAS float* GS = (LAS float*)(L + O_GS); LAS float* GC = (LAS float*)(L + O_GC);
    const int tid0 = F.tid, wave = F.wave;
    for (int unit = blockIdx.x; unit < NB * NH_R * 2; unit += F.G) {
        const int b = unit >> 5, h = (unit >> 1) & 15, dir = unit & 1; const int col = h * 64 + 8 * (tid0 & 7);
        f32x4 kkc[2], kac[2], rkc[2];
#pragma unroll
        for (int e = 0; e < 2; ++e) { kkc[e] = *(const f32x4*)(F.in[I_KK] + j * D + col + 4 * e); kac[e] = *(const f32x4*)(F.in[I_KA] + j * D + col + 4 * e); rkc[e] = *(const f32x4*)(F.in[I_RK] + j * D + col + 4 * e); }
        for (int i = tid0; i < (O_END - O_LAK) / 16; i += NTHREADS) *(LAS u32x4*)(L + O_LAK + i * 16) = (u32x4){0u, 0u, 0u, 0u};
        f32x4 Hs[4];
        f32x4 Yh[4];
#define WK_YFLUSH(cc) do { if (wave >= 4) { const int lane_ = tid0 & 63, qi_ = lane_ & 15, q4_ = lane_ >> 4, vj_ = wave - 4; \
            _Pragma("unroll") for (int ti_ = 0; ti_ < 4; ++ti_) _Pragma("unroll") for (int r_ = 0; r_ < 4; ++r_) { const int st_ = (cc) * 64 + 16 * ti_ + 4 * q4_ + r_; const int t_ = dir ? (SEQ - 1 - st_) : st_; \
                Y[((size_t)dir * T + (size_t)b * SEQ + t_) * D + h * 64 + 16 * vj_ + qi_] = (bf16)f2bf(Yh[ti_][r_]); } } } while (0)
#pragma unroll
        for (int vj = 0; vj < 4; ++vj) Hs[vj] = (f32x4){0.f, 0.f, 0.f, 0.f};
        u32x4 gr, gk, gv, gl, ga;
#define WK_LOAD(c) do { const int st = (c) * 64 + (tid0 >> 3); const int t = dir ? (SEQ - 1 - st) : st; const size_t ro = ((size_t)b * SEQ + t) * D + col; \
            gr = *(const u32x4*)(Rb + ro); gk = *(const u32x4*)(Kb + ro); gv = *(const u32x4*)(Vb + ro); gl = *(const u32x4*)(LD + (size_t)dir * T * D + ro); ga = *(const u32x4*)(AS + (size_t)dir * T * D + ro); } while (0)
        WK_LOAD(0);
        WK_BAR();
        for (int c = 0; c < SEQ / 64; ++c) {
            int tid = tid0; asm volatile("" : "+v"(tid));
            const int lane = tid & 63, qi = lane & 15, q4 = lane >> 4, pt = tid >> 3, c8 = tid & 7;
            LAS unsigned char* H0 = L + ((c & 1) ? O_H1 : O_H0); LAS unsigned char* H1 = L + ((c & 1) ? O_H0 : O_H1);
            for (int sd0_ = 0; sd0_ < 1 + ((SCAN_DUP >> 0) & 1); ++sd0_) {
            float av[8], bv[8], kdv[8], rv[8], ldv[8];
            {
                const unsigned gku[4] = {gk.x, gk.y, gk.z, gk.w}, gru[4] = {gr.x, gr.y, gr.z, gr.w}, glu[4] = {gl.x, gl.y, gl.z, gl.w}, gau[4] = {ga.x, ga.y, ga.z, ga.w};
                float kf[8], af[8], kkv[8]; float ss = 0.f;
#pragma unroll
                for (int e = 0; e < 4; ++e) { kf[2 * e] = bf_lo(gku[e]); kf[2 * e + 1] = bf_hi(gku[e]); rv[2 * e] = bf_lo(gru[e]); rv[2 * e + 1] = bf_hi(gru[e]);
                    ldv[2 * e] = bf_lo(glu[e]); ldv[2 * e + 1] = bf_hi(glu[e]); af[2 * e] = bf_lo(gau[e]); af[2 * e + 1] = bf_hi(gau[e]); }
#pragma unroll
                for (int e = 0; e < 8; ++e) { kkv[e] = kf[e] * kkc[e >> 2][e & 3]; ss += kkv[e] * kkv[e]; }
                ss = sum8(ss);
                const float inv = 1.0f / fmaxf(sqrtf(ss), 1e-12f); float bo = 0.f;
#pragma unroll
                for (int e = 0; e < 8; ++e) { const float kn = kkv[e] * inv; kdv[e] = kf[e] * (1.0f + (af[e] - 1.0f) * kac[e >> 2][e & 3]); av[e] = -kn; bv[e] = kn * af[e]; bo += rv[e] * kdv[e] * rkc[e >> 2][e & 3]; }
                bo = sum8(bo);
                const int st = c * 64 + pt; const int t = dir ? (SEQ - 1 - st) : st;
                if (c8 == 0) SB[((size_t)dir * T + (size_t)b * SEQ + t) * 16 + h] = bo;
                *(LAS f32x4*)(NAB + pt * PF + 8 * c8) = (f32x4){ldv[0], ldv[1], ldv[2], ldv[3]}; *(LAS f32x4*)(NAB + pt * PF + 8 * c8 + 4) = (f32x4){ldv[4], ldv[5], ldv[6], ldv[7]};
                *(LAS u32x4*)(L + O_VV + pt * PB + 16 * c8) = gv;
            }
            if (sd0_ == ((SCAN_DUP >> 0) & 1)) { if (c > 0) WK_YFLUSH(c - 1); if (c + 1 < SEQ / 64) WK_LOAD(c + 1); }
            WK_BAR();
            { const int kc = tid & 63, g = tid >> 6; float pre[8]; float p = 0.f;
#pragma unroll
              for (int i = 0; i < 8; ++i) { p += NAB[(8 * g + i) * PF + kc]; pre[i] = p; }
              GS[g * 64 + kc] = p;
              WK_BAR();
              float off = 0.f;
#pragma unroll
              for (int gg = 0; gg < 7; ++gg) off += (gg < g) ? GS[gg * 64 + kc] : 0.f;
#pragma unroll
              for (int i = 0; i < 8; ++i) NAB[(8 * g + i) * PF + kc] = off + pre[i]; }
            WK_BAR();
            { f32x4 cl[2], cm[2];
#pragma unroll
              for (int e = 0; e < 2; ++e) { cl[e] = *(const LAS f32x4*)(NAB + pt * PF + 8 * c8 + 4 * e); cm[e] = (pt > 0) ? *(const LAS f32x4*)(NAB + (pt - 1) * PF + 8 * c8 + 4 * e) : (f32x4){0.f, 0.f, 0.f, 0.f}; }
              float oa[8], orr[8], ob[8], ok[8];
#pragma unroll
              for (int e = 0; e < 8; ++e) { const float c1 = cl[e >> 2][e & 3], c0 = cm[e >> 2][e & 3]; const float gp = __builtin_amdgcn_exp2f(c1), gn = __builtin_amdgcn_exp2f(-c1), g0 = __builtin_amdgcn_exp2f(c0);
                  oa[e] = av[e] * g0; orr[e] = rv[e] * gp; ob[e] = bv[e] * gn; ok[e] = kdv[e] * gn; if (pt == 63) GC[8 * c8 + e] = gp; }
              *(LAS u32x4*)(L + O_AT + pt * PB + 16 * c8) = (u32x4){pk2(oa[0], oa[1]), pk2(oa[2], oa[3]), pk2(oa[4], oa[5]), pk2(oa[6], oa[7])};
              *(LAS u32x4*)(L + O_RT + pt * PB + 16 * c8) = (u32x4){pk2(orr[0], orr[1]), pk2(orr[2], orr[3]), pk2(orr[4], orr[5]), pk2(orr[6], orr[7])};
              *(LAS u32x4*)(L + O_BT + pt * PB + 16 * c8) = (u32x4){pk2(ob[0], ob[1]), pk2(ob[2], ob[3]), pk2(ob[4], ob[5]), pk2(ob[6], ob[7])};
              *(LAS u32x4*)(L + O_KT + pt * PB + 16 * c8) = (u32x4){pk2(ok[0], ok[1]), pk2(ok[2], ok[3]), pk2(ok[4], ok[5]), pk2(ok[6], ok[7])}; }
            WK_BAR();
            }
            f32x4 X0[4], Y0[4];
            for (int sd1_ = 0; sd1_ < 1 + ((SCAN_DUP >> 1) & 1); ++sd1_) {
#pragma unroll
            for (int jj = 0; jj < 5; ++jj) {
                const int idx = wave * 5 + jj, blk = idx / 10, tri = idx % 10;
                const int ti = (tri >= 6) ? 3 : ((tri >= 3) ? 2 : ((tri >= 1) ? 1 : 0)); const int si = tri - (ti * (ti + 1)) / 2;
                const LAS unsigned char* Pm = L + ((blk < 2) ? O_AT : O_RT); const LAS unsigned char* Qm = L + ((blk & 1) ? O_KT : O_BT);
                f32x4 acc = {0.f, 0.f, 0.f, 0.f};
#pragma unroll
                for (int ks = 0; ks < 2; ++ks) acc = WK_MFMA(ldrow(Qm, 16 * si + qi, 32 * ks + 8 * q4), ldrow(Pm, 16 * ti + qi, 32 * ks + 8 * q4), acc);
                const int tt = 16 * ti + qi, s0 = 16 * si + 4 * q4;
#pragma unroll
                for (int r = 0; r < 4; ++r) { const int sidx = s0 + r; const bool keep = (blk < 2) ? (sidx < tt) : (sidx <= tt); acc[r] = keep ? acc[r] : 0.f; }
                if (blk == 0) { *(LAS f32x4*)(NAB + tt * PF + s0) = acc; st4bf(L + O_NB, tt, s0, acc); }
                else st4bf(L + (blk == 1 ? O_LAK : (blk == 2 ? O_MRB : O_MRK)), tt, s0, acc);
            }
            WK_BAR();
            }
            for (int sd2_ = 0; sd2_ < 1 + ((SCAN_DUP >> 2) & 1); ++sd2_) {
            if (wave >= 4) { const int vj = wave - 4;
#pragma unroll
                for (int ti = 0; ti < 4; ++ti) { X0[ti] = (f32x4){0.f, 0.f, 0.f, 0.f}; Y0[ti] = (f32x4){0.f, 0.f, 0.f, 0.f};
#pragma unroll
                    for (int ks = 0; ks < 2; ++ks) if (ks <= (ti >> 1)) { const bf16x8 vf = ldtr(La + O_VV, 32 * ks, 16 * vj, lane);
                        X0[ti] = WK_MFMA(ldrow(L + O_LAK, 16 * ti + qi, 32 * ks + 8 * q4), vf, X0[ti]); Y0[ti] = WK_MFMA(ldrow(L + O_MRK, 16 * ti + qi, 32 * ks + 8 * q4), vf, Y0[ti]); } } }
            if (wave == 0) {
                const int blk = q4, cj = qi; float nrow[16], x[16];
#pragma unroll
                for (int r = 0; r < 16; ++r) nrow[r] = NAB[(16 * blk + r) * PF + 16 * blk + cj];
#pragma unroll
                for (int r = 0; r < 16; ++r) { float acc = (r == cj) ? 1.0f : 0.0f;
#define WK_SUBM(m) if (m < r) acc += wk::rshare<m>(nrow[r]) * x[m];
                    WK_SUBM(0) WK_SUBM(1) WK_SUBM(2) WK_SUBM(3) WK_SUBM(4) WK_SUBM(5) WK_SUBM(6) WK_SUBM(7) WK_SUBM(8) WK_SUBM(9) WK_SUBM(10) WK_SUBM(11) WK_SUBM(12) WK_SUBM(13) WK_SUBM(14)
#undef WK_SUBM
                    x[r] = acc; *(LAS bf16*)(L + O_TT + (16 * blk + r) * PB + (16 * blk + cj) * 2) = (bf16)f2bf(acc); }
            }
            WK_BAR();
            if (wave < 2) {
                const int i = 2 * wave + 1, jb = 2 * wave;
                bf16x8 a = ldrow(L + O_NB, 16 * i + qi, 16 * jb + 8 * (q4 & 1)), bfr = ldtr(La + O_TT, 16 * jb - 8 * (q4 & 2), 16 * jb, lane);
                if (q4 >= 2) { a = zfrag(); bfr = zfrag(); }
                f32x4 acc = {0.f, 0.f, 0.f, 0.f}; acc = WK_MFMA(a, bfr, acc);
                st4bf(L + O_MT, 16 * wave + qi, 4 * q4, acc);
            }
            WK_BAR();
            if (wave < 2) {
                const int i = 2 * wave + 1, jb = 2 * wave;
                bf16x8 a = ldrow(L + O_TT, 16 * i + qi, 16 * i + 8 * (q4 & 1)), bfr = ldrow(L + O_MT, 16 * wave + qi, 8 * (q4 & 1));
                if (q4 >= 2) { a = zfrag(); bfr = zfrag(); }
                f32x4 acc = {0.f, 0.f, 0.f, 0.f}; acc = WK_MFMA(a, bfr, acc);
#pragma unroll
                for (int r = 0; r < 4; ++r) *(LAS bf16*)(L + O_TT + (16 * i + 4 * q4 + r) * PB + (16 * jb + qi) * 2) = (bf16)f2bf(acc[r]);
            }
            WK_BAR();
            if (wave < 4) {
                const int ti2 = wave >> 1, tj2 = wave & 1;
                f32x4 acc = {0.f, 0.f, 0.f, 0.f}; acc = WK_MFMA(ldrow(L + O_NB, 32 + 16 * ti2 + qi, 8 * q4), ldtr(La + O_TT, 0, 16 * tj2, lane), acc);
                st4bf(L + O_MT, 32 + 16 * tj2 + qi, 16 * ti2 + 4 * q4, acc);
            }
            WK_BAR();
            if (wave < 4) {
                const int ti2 = wave >> 1, tj2 = wave & 1;
                f32x4 acc = {0.f, 0.f, 0.f, 0.f}; acc = WK_MFMA(ldrow(L + O_TT, 32 + 16 * ti2 + qi, 32 + 8 * q4), ldrow(L + O_MT, 32 + 16 * tj2 + qi, 8 * q4), acc);
#pragma unroll
                for (int r = 0; r < 4; ++r) *(LAS bf16*)(L + O_TT + (32 + 16 * ti2 + 4 * q4 + r) * PB + (16 * tj2 + qi) * 2) = (bf16)f2bf(acc[r]);
            }
            }
            for (int sd3_ = 0; sd3_ < 1 + ((SCAN_DUP >> 3) & 1); ++sd3_) {
            if (wave >= 4) { const int vj = wave - 4;
#pragma unroll
                for (int ti = 0; ti < 4; ++ti) { f32x4 acc = X0[ti];
#pragma unroll
                    for (int ks = 0; ks < 2; ++ks) acc = WK_MFMA(ldrow(L + O_AT, 16 * ti + qi, 32 * ks + 8 * q4), ldrow(H0, 16 * vj + qi, 32 * ks + 8 * q4), acc);
                    st4bf(L + O_XT, 16 * vj + qi, 16 * ti + 4 * q4, acc); } }
            WK_BAR();
#pragma unroll
            for (int e = 0; e < 2; ++e) { const int id = wave * 2 + e, ti = id >> 2, vj = id & 3; f32x4 acc = {0.f, 0.f, 0.f, 0.f};
#pragma unroll
                for (int ks = 0; ks < 2; ++ks) if (ks <= (ti >> 1)) acc = WK_MFMA(ldrow(L + O_TT, 16 * ti + qi, 32 * ks + 8 * q4), ldrow(L + O_XT, 16 * vj + qi, 32 * ks + 8 * q4), acc);
                st4bf(L + O_UT, 16 * vj + qi, 16 * ti + 4 * q4, acc); }
            WK_BAR();
            }
            f32x4 Hsave[4]; for (int vj_ = 0; vj_ < 4; ++vj_) Hsave[vj_] = Hs[vj_];
            for (int sd5_ = 0; sd5_ < 1 + ((SCAN_DUP >> 4) & 1); ++sd5_) {
            for (int vj_ = 0; vj_ < 4; ++vj_) Hs[vj_] = Hsave[vj_];
            if (wave >= 4) { const int vj = wave - 4;
#pragma unroll
                for (int ti = 0; ti < 4; ++ti) { f32x4 acc = Y0[ti];
#pragma unroll
                    for (int ks = 0; ks < 2; ++ks) { acc = WK_MFMA(ldrow(L + O_RT, 16 * ti + qi, 32 * ks + 8 * q4), ldrow(H0, 16 * vj + qi, 32 * ks + 8 * q4), acc);
                        if (ks <= (ti >> 1)) acc = WK_MFMA(ldrow(L + O_MRB, 16 * ti + qi, 32 * ks + 8 * q4), ldrow(L + O_UT, 16 * vj + qi, 32 * ks + 8 * q4), acc); }
                    Yh[ti] = acc; } }
            else { const int kt = wave; const f32x4 gc = *(const LAS f32x4*)(GC + 16 * kt + 4 * q4);
#pragma unroll
                for (int ks = 0; ks < 2; ++ks) { const bf16x8 bt = ldtr(La + O_BT, 32 * ks, 16 * kt, lane), ktf = ldtr(La + O_KT, 32 * ks, 16 * kt, lane);
#pragma unroll
                    for (int vj = 0; vj < 4; ++vj) { Hs[vj] = WK_MFMA(bt, ldrow(L + O_UT, 16 * vj + qi, 32 * ks + 8 * q4), Hs[vj]); Hs[vj] = WK_MFMA(ktf, ldtr(La + O_VV, 32 * ks, 16 * vj, lane), Hs[vj]); } }
#pragma unroll
                for (int vj = 0; vj < 4; ++vj) { Hs[vj] = Hs[vj] * gc; st4bf(H1, 16 * vj + qi, 16 * kt + 4 * q4, Hs[vj]); } }
            WK_BAR();
            }
        }
        WK_YFLUSH(SEQ / 64 - 1);
#undef WK_LOAD
#undef WK_YFLUSH
    }
}

__device__ __forceinline__ void phase_rw_post(Frame& F, int l) {
    const int j = l >> 1; const float* lnw = F.in[I_LNW] + j * D; const float* lnb = F.in[I_LNB] + j * D;
    const bf16* Vb = (const bf16*)(F.ws + WS_ACT + A_RKV) + (size_t)2 * T * D; const bf16* Y = (const bf16*)(F.ws + WS_ACT + A_Y); const bf16* Gb = (const bf16*)(F.ws + WS_ACT + A_G);
    const float* SB = (const float*)(F.ws + WS_SB); bf16* O = (bf16*)(F.ws + WS_ACT + A_O);
    for (int row = F.gw; row < T; row += F.NGW) {
        f32x4 o[4];
#pragma unroll
        for (int q = 0; q < 4; ++q) {
            const int c = 4 * F.lane + 256 * q; const int head = 4 * q + (F.lane >> 4);
            const u32x2 vr = *(const u32x2*)(Vb + (size_t)row * D + c); const f32x4 vf = {bf_lo(vr.x), bf_hi(vr.x), bf_lo(vr.y), bf_hi(vr.y)};
            const f32x4 w = *(const f32x4*)(lnw + c), bb = *(const f32x4*)(lnb + c);
            f32x4 acc = {0.f, 0.f, 0.f, 0.f};
#pragma unroll
            for (int dir = 0; dir < 2; ++dir) {
                const size_t ro = ((size_t)dir * T + row) * D + c;
                const u32x2 yr = *(const u32x2*)(Y + ro), gr = *(const u32x2*)(Gb + ro);
                const f32x4 yf = {bf_lo(yr.x), bf_hi(yr.x), bf_lo(yr.y), bf_hi(yr.y)}; const f32x4 gf = {bf_lo(gr.x), bf_hi(gr.x), bf_lo(gr.y), bf_hi(gr.y)};
                const float sbv = SB[((size_t)dir * T + row) * 16 + head];
                const float mean = rowsum16((yf[0] + yf[1]) + (yf[2] + yf[3])) * (1.0f / 64.0f);
                const f32x4 d = yf - mean; const float var = rowsum16((d[0] * d[0] + d[1] * d[1]) + (d[2] * d[2] + d[3] * d[3])) * (1.0f / 64.0f);
                const float rs = rsqrtf(var + GN_EPS);
                acc += gf * (d * rs * w + bb + sbv * vf);
            }
            o[q] = acc;
        }
        row_store_bf16(O + (size_t)row * D, F.lane, o);
    }
}

__device__ __forceinline__ unsigned att_f(unsigned row) { return ((row & 3u) << 2) | ((row >> 2) & 3u); }
__device__ __forceinline__ unsigned att_off_b(unsigned row, unsigned ch) { return 256u * row + 16u * (ch ^ att_f(row)); }
__device__ __forceinline__ void phase_attn(Frame& F, bool dry = false) {
    bf16* Qb = (bf16*)(F.ws + WS_ACT + A_Q); const bf16* Kb = (const bf16*)(F.ws + WS_ACT + A_K); const bf16* Vb = (const bf16*)(F.ws + WS_ACT + A_VT);
    float* LSE = (float*)(F.ws + WS_SB);
    const int lane = F.lane, qi = lane & 15, q4 = lane >> 4, wave = F.wave;
    LAS unsigned char* KW = F.lds; LAS unsigned char* VW = F.lds + 65536;
    const unsigned vw_a = (unsigned)(size_t)VW;
    unsigned ka[2][4], va[8][2];
#pragma unroll
    for (int rb = 0; rb < 2; ++rb)
#pragma unroll
        for (int s = 0; s < 4; ++s) ka[rb][s] = att_off_b((unsigned)(qi + 16 * rb), (unsigned)(4 * s + q4));
    { const unsigned q = (unsigned)qi >> 2, p = (unsigned)lane & 3u;
#pragma unroll
      for (int c = 0; c < 8; ++c)
#pragma unroll
          for (int t = 0; t < 2; ++t) va[c][t] = vw_a + att_off_b(8u * q4 + 4u * t + q, 2u * c + (p >> 1)) + 8u * (p & 1u); }
    unsigned fk[8];
#pragma unroll
    for (int i = 0; i < 8; ++i) { const unsigned rho = 4u * i + (unsigned)q4, m = rho & 15u, rb = rho >> 4; const unsigned kidx = 8u * (m >> 2) + (m & 3u) + 4u * rb;
        fk[i] = kidx | ((16u * ((unsigned)qi ^ att_f(rho))) << 8); }
    const int nper = (F.G >= 8) ? (F.G >> 3) : 1;
    for (int k = (F.G >= 8 && (F.G & 7) == 0) ? (int)(blockIdx.x >> 3) : (int)blockIdx.x; k < ((F.G >= 8 && (F.G & 7) == 0) ? 3 * NB * 16 : 3 * NB * 8 * 16); k += ((F.G >= 8 && (F.G & 7) == 0) ? nper : F.G)) {
        int g, b, hs, cc;
        if (F.G >= 8 && (F.G & 7) == 0) { hs = blockIdx.x & 7; cc = k & 15; b = (k >> 4) & 7; g = k >> 7; }
        else { g = k >> 10; b = (k >> 7) & 7; hs = (k >> 4) & 7; cc = k & 15; }
        const int dsh = 2 * g, Lg = SEQ >> dsh; const int cls = (g == 0) ? 0 : ((g == 1) ? (cc >> 2) : cc); const int chunk = (g == 0) ? cc : ((g == 1) ? (cc & 3) : 0);
        const int P0 = 128 * chunk;
        asm volatile("s_waitcnt lgkmcnt(0)" ::: "memory"); __builtin_amdgcn_s_barrier(); asm volatile("" ::: "memory");
        { const int base_ = P0 - 64 + 32 * wave;
          const bf16* ksrc = Kb + ((size_t)g * T + (size_t)b * SEQ) * D + hs * 128; const bf16* vsrc = Vb + ((size_t)g * T + (size_t)b * SEQ) * D + hs * 128;
#pragma unroll
          for (int i = 0; i < 8; ++i) { const int pk = min(max(base_ + (int)(fk[i] & 255u), 0), Lg - 1), pv = min(max(base_ + 4 * i + q4, 0), Lg - 1);
              __builtin_amdgcn_global_load_lds((const unsigned*)((const char*)(ksrc + (size_t)(cls + (pk << dsh)) * D) + (fk[i] >> 8)), (LAS unsigned*)(KW + wave * 8192 + i * 1024), 16, 0, 0);
              __builtin_amdgcn_global_load_lds((const unsigned*)((const char*)(vsrc + (size_t)(cls + (pv << dsh)) * D) + (fk[i] >> 8)), (LAS unsigned*)(VW + wave * 8192 + i * 1024), 16, 0, 0); } }
        const int Pq = P0 + 16 * wave + qi; const size_t qrow = (size_t)g * T + (size_t)b * SEQ + (size_t)(cls + (Pq << dsh));
        bf16* qp = Qb + qrow * D + hs * 128;
        bf16x8 Qf[4];
#pragma unroll
        for (int kt = 0; kt < 4; ++kt) Qf[kt] = *(const bf16x8*)(qp + 8 * q4 + 32 * kt);
        const float slope2 = exp2f(-8.0f * (float)(g * 8 + hs + 1) / 24.0f) * LOG2E * (float)(1 << dsh);
        float m_run = -1e30f, l_run = 0.f; f32x4 O[8];
#pragma unroll
        for (int dt = 0; dt < 8; ++dt) O[dt] = (f32x4){0.f, 0.f, 0.f, 0.f};
        asm volatile("s_waitcnt vmcnt(0)" ::: "memory"); __builtin_amdgcn_s_barrier(); asm volatile("" ::: "memory");
#pragma unroll
        for (int s = 0; s < 5; ++s) {
            const int tb = (wave >> 1) + s; const LAS unsigned char* kl = KW + tb * 8192; const unsigned voff = (unsigned)tb * 8192u;
            bf16x8 KA[4], KB[4];
#pragma unroll
            for (int kt = 0; kt < 4; ++kt) { KA[kt] = *(const LAS bf16x8*)(kl + ka[0][kt]); KB[kt] = *(const LAS bf16x8*)(kl + ka[1][kt]); }
            f32x4 SA = {0.f, 0.f, 0.f, 0.f}, SBt = {0.f, 0.f, 0.f, 0.f};
#pragma unroll
            for (int kt = 0; kt < 4; ++kt) { SA = __builtin_amdgcn_mfma_f32_16x16x32_bf16(KA[kt], Qf[kt], SA, 0, 0, 0); SBt = __builtin_amdgcn_mfma_f32_16x16x32_bf16(KB[kt], Qf[kt], SBt, 0, 0, 0); }
            const int cb = P0 - 64 + 32 * tb + 8 * q4;
            float sv[8]; bool ok[8]; float mx = -1e30f;
#pragma unroll
            for (int r = 0; r < 8; ++r) { const int p = cb + r; const int rel = abs(p - Pq); ok[r] = (p >= 0) && (p < Lg) && (rel <= 64);
                const float sc = (r < 4 ? SA[r & 3] : SBt[r & 3]) - slope2 * (float)rel; sv[r] = ok[r] ? sc : -1e30f; mx = fmaxf(mx, sv[r]); }
            mx = bfly16_max(mx); mx = bfly32_max(mx);
            const float m_new = fmaxf(m_run, mx); const float alpha = __builtin_amdgcn_exp2f(m_run - m_new); m_run = m_new;
            float pe[8]; float rs = 0.f;
#pragma unroll
            for (int r = 0; r < 8; ++r) { pe[r] = ok[r] ? __builtin_amdgcn_exp2f(sv[r] - m_new) : 0.f; rs += pe[r]; }
            rs = bfly16_sum(rs); rs = bfly32_sum(rs);
            l_run = l_run * alpha + rs;
            union { u32x4 u; bf16x8 v; } pf; pf.u.x = pk2(pe[0], pe[1]); pf.u.y = pk2(pe[2], pe[3]); pf.u.z = pk2(pe[4], pe[5]); pf.u.w = pk2(pe[6], pe[7]);
#pragma unroll
            for (int hf = 0; hf < 2; ++hf) {
                u32x2 vr[4][2];
                asm volatile("ds_read_b64_tr_b16 %0, %8\n\tds_read_b64_tr_b16 %1, %9\n\tds_read_b64_tr_b16 %2, %10\n\tds_read_b64_tr_b16 %3, %11\n\t"
                             "ds_read_b64_tr_b16 %4, %12\n\tds_read_b64_tr_b16 %5, %13\n\tds_read_b64_tr_b16 %6, %14\n\tds_read_b64_tr_b16 %7, %15\n\ts_waitcnt lgkmcnt(0)"
                             : "=&v"(vr[0][0]), "=&v"(vr[0][1]), "=&v"(vr[1][0]), "=&v"(vr[1][1]), "=&v"(vr[2][0]), "=&v"(vr[2][1]), "=&v"(vr[3][0]), "=&v"(vr[3][1])
                             : "v"(va[4 * hf + 0][0] + voff), "v"(va[4 * hf + 0][1] + voff), "v"(va[4 * hf + 1][0] + voff), "v"(va[4 * hf + 1][1] + voff), "v"(va[4 * hf + 2][0] + voff), "v"(va[4 * hf + 2][1] + voff), "v"(va[4 * hf + 3][0] + voff), "v"(va[4 * hf + 3][1] + voff)
                             : "memory");
#pragma unroll
                for (int c = 0; c < 4; ++c) { const int dt = 4 * hf + c; union { u32x4 u; bf16x8 v; } vf; vf.u.x = vr[c][0].x; vf.u.y = vr[c][0].y; vf.u.z = vr[c][1].x; vf.u.w = vr[c][1].y;
                    O[dt] = O[dt] * alpha; O[dt] = __builtin_amdgcn_mfma_f32_16x16x32_bf16(vf.v, pf.v, O[dt], 0, 0, 0); }
            }
        }
        const float inv = 1.0f / l_run;
#pragma unroll
        for (int dt = 0; dt < 8; ++dt) { u32x2 o; o.x = pk2(O[dt][0] * inv, O[dt][1] * inv); o.y = pk2(O[dt][2] * inv, O[dt][3] * inv); if (!dry) *(u32x2*)(qp + 4 * q4 + 16 * dt) = o; else asm volatile("" :: "v"(o.x), "v"(o.y)); }
        if (q4 == 0 && !dry) LSE[qrow * 8 + hs] = m_run + __builtin_amdgcn_logf(l_run);
    }
}
__device__ __forceinline__ void phase_attn_merge(Frame& F) {
    const bf16* Ob = (const bf16*)(F.ws + WS_ACT + A_Q); const float* LSE = (const float*)(F.ws + WS_SB); bf16* AO = (bf16*)(F.ws + WS_ACT + A_AO);
    for (int row = F.gw; row < T; row += F.NGW) {
        f32x4 o[4];
#pragma unroll
        for (int q = 0; q < 4; ++q) { const int c = 4 * F.lane + 256 * q; const int head = 2 * q + (F.lane >> 5);
            float ls[3];
#pragma unroll
            for (int g = 0; g < 3; ++g) ls[g] = LSE[((size_t)g * T + row) * 8 + head];
            const float mx = fmaxf(ls[0], fmaxf(ls[1], ls[2]));
            float w[3]; float sum = 0.f;
#pragma unroll
            for (int g = 0; g < 3; ++g) { w[g] = __builtin_amdgcn_exp2f(ls[g] - mx); sum += w[g]; }
            const float inv = 1.0f / sum; f32x4 acc = {0.f, 0.f, 0.f, 0.f};
#pragma unroll
            for (int g = 0; g < 3; ++g) { const u32x2 r = *(const u32x2*)(Ob + ((size_t)g * T + row) * D + c); const float a = w[g] * inv;
                acc[0] += a * bf_lo(r.x); acc[1] += a * bf_hi(r.x); acc[2] += a * bf_lo(r.y); acc[3] += a * bf_hi(r.y); }
            o[q] = acc; }
        row_store_bf16(AO + (size_t)row * D, F.lane, o);
    }
}

constexpr int PH_PER_LAYER = 10, N_PHASES = 1 + DEPTH * PH_PER_LAYER + 1;
template <int MASK> __global__ void __launch_bounds__(NTHREADS, 2) mk_fwd(Args args) {
    extern __shared__ __attribute__((aligned(16))) unsigned char lds_raw[];
#define PHASE_FRAME() Frame F; { int t_ = wave0 * 64 + lane_id_nh(); asm volatile("" : "+v"(t_)); size_t z_ = 0; asm volatile("" : "+s"(z_)); unsigned char* w_ = args.ws + z_;     \
        unsigned lb_ = 0; asm volatile("" : "+s"(lb_)); F.lds = (LAS unsigned char*)lds_raw + lb_; F.tid = t_; F.lane = t_ & 63; F.wave = __builtin_amdgcn_readfirstlane(t_ >> 6); \
        F.G = gridDim.x; F.gw = blockIdx.x * NWAVES + F.wave; F.NGW = F.G * NWAVES; F.ws = w_; F.in = args.in; F.out = args.out; }
    LAS unsigned char* lds0 = (LAS unsigned char*)lds_raw;
    const int wave0 = __builtin_amdgcn_readfirstlane((int)threadIdx.x >> 6);
    volatile LAS unsigned* MISC = (volatile LAS unsigned*)(lds0 + MISC_OFF);
    if (wave0 == 0) ((LAS unsigned*)(lds0 + LDS_MISC))[lane_id_nh() + 64] = 0u;
    __syncthreads();
    unsigned* ctl = (unsigned*)(args.ws + WS_CTL);
    XcdBarrier bar; bar.bar = ctl + CW_BAR; bar.x = 0; bar.st = nullptr;
#if ONE_LAUNCH
    bar = xcd_barrier_post(ctl + CW_BAR, MISC + 8, wave0 == 0 && lane_id_nh() == 0);
#endif
    const int lo = args.ph_lo, hi = args.ph_hi;
#define EN(b) ((MASK >> (b)) & 1)
#ifndef DUP_MASK
#define DUP_MASK 0
#endif
#define REP(b) for (int rep_ = 0; rep_ < 1 + ((DUP_MASK >> (b)) & 1); ++rep_)
#define IN(k) (lo <= (k) && (k) < hi)
#if ONE_LAUNCH
#ifndef BAR_REP
#define BAR_REP 1
#endif
#define SEAM(k) do { if (IN((k) + 1) || (k) + 1 < hi) { for (int br_ = 0; br_ < BAR_REP; ++br_) xcd_barrier(bar, wave0 == 0 && lane_id_nh() == 0); } } while (0)
#else
#define SEAM(k) do { } while (0)
#endif
    bf16* X0 = (bf16*)(args.ws + WS_X1); bf16* X1 = X0 + (size_t)T * D;
    if (EN(0) && IN(0)) { PHASE_FRAME(); REP(0) phase_prologue(F); SEAM(0); }
    for (int l = 0; l < DEPTH; ++l) {
        const int pb = 1 + l * PH_PER_LAYER; const int j = l >> 1;
        const void* xin = (l == 0) ? (const void*)args.in[I_X] : (const void*)((l & 1) ? X0 : X1);
        bf16* xcur = (l == 0) ? X0 : ((l & 1) ? X1 : X0);
        if ((l & 1) == 0) {
            if (EN(1) && IN(pb + 0)) { PHASE_FRAME(); REP(1) phase_rw_norm(F, l, l > 0, xin, xcur); SEAM(pb + 0); }
            if (EN(2) && IN(pb + 1)) { REP(2) {
                { PHASE_FRAME(); DenseSched S; S.o.init(T / 256, 2, F.G, blockIdx.x); S.A = (const char*)(F.ws + WS_ACT + A_HX); S.a_sel_stride = 0; S.pn_per_a = 1 << 20;
                  S.B = (const char*)(F.ws + WS_W + j * W_RW_STRIDE + W_LDN); S.tstepA = (size_t)256 * 2048 * 2; S.tstepB = (size_t)256 * 2048 * 2;
                  EpiLoraDn E{(bf16*)(F.ws + WS_ACT + A_LORAH)};
                  pg8::gemm_phase(F.lds, F.tid, 2048, 2048, 2048, S, E); }
                { PHASE_FRAME(); DenseSched S; S.o.init(T / 256, 12, F.G, blockIdx.x); S.o.uneven = (F.G == 256); S.A = (const char*)(F.ws + WS_ACT + A_XS); S.a_sel_stride = (size_t)T * D * 2; S.pn_per_a = 4;
                  S.B = (const char*)(F.ws + WS_W + j * W_RW_STRIDE + W_RKV); S.tstepA = (size_t)256 * D * 2; S.tstepB = (size_t)256 * D * 2;
                  EpiSplit E{(bf16*)(F.ws + WS_ACT + A_RKV), (size_t)T * D, 1.0f};
                  pg8::gemm_phase(F.lds, F.tid, D, D, D, S, E); }
                }
                SEAM(pb + 1);
            }
            if (EN(3) && IN(pb + 2)) { REP(3) {
                { PHASE_FRAME(); DenseSched S; S.o.init(T / 256, 16, F.G, blockIdx.x); S.A = (const char*)(F.ws + WS_ACT + A_LORAH); S.a_sel_stride = 256; S.pn_per_a = 8;
                  S.B = (const char*)(F.ws + WS_W + j * W_RW_STRIDE + W_LUPWA); S.tstepA = (size_t)256 * 512 * 2; S.tstepB = (size_t)256 * 128 * 2;
                  EpiLoraUpWA E{(bf16*)(F.ws + WS_ACT + A_LDEC), (bf16*)(F.ws + WS_ACT + A_ASIG), F.in[I_W0] + j * 2 * D, F.in[I_A0] + j * 2 * D};
                  pg8::gemm_phase(F.lds, F.tid, 128, 512, 128, S, E); }
                { PHASE_FRAME(); DenseSched S; S.o.init(T / 256, 8, F.G, blockIdx.x); S.A = (const char*)(F.ws + WS_ACT + A_LORAH) + 512; S.a_sel_stride = 256; S.pn_per_a = 4;
                  S.B = (const char*)(F.ws + WS_W + j * W_RW_STRIDE + W_LUPG); S.tstepA = (size_t)256 * 512 * 2; S.tstepB = (size_t)256 * 128 * 2;
                  EpiSplit E{(bf16*)(F.ws + WS_ACT + A_G), (size_t)T * D, 1.0f};
                  pg8::gemm_phase(F.lds, F.tid, 128, 512, 128, S, E); }
                }
                SEAM(pb + 2);
            }
            if (EN(4) && IN(pb + 3)) { PHASE_FRAME(); REP(4) phase_scan(F, l); SEAM(pb + 3); }
            if (EN(5) && IN(pb + 4)) { PHASE_FRAME(); REP(5) phase_rw_post(F, l); SEAM(pb + 4); }
            if (EN(6) && IN(pb + 5)) { PHASE_FRAME();
                DenseSched S; S.o.init(T / 256, 4, F.G, blockIdx.x); S.A = (const char*)(F.ws + WS_ACT + A_O); S.a_sel_stride = 0; S.pn_per_a = 1 << 20;
                S.B = (const char*)(F.ws + WS_W + j * W_RW_STRIDE + W_RWO); S.tstepA = (size_t)256 * D * 2; S.tstepB = (size_t)256 * D * 2;
                EpiResid E{(l == 0) ? (const void*)F.in[I_X] : (const void*)xcur, (l == 0) ? 1 : 0, xcur, (const float*)(F.ws + WS_MOD) + (size_t)l * 8 * 6144 + 2 * D};
                pg8::gemm_phase(F.lds, F.tid, D, D, D, S, E);
                SEAM(pb + 5);
            }
        } else {
            if (EN(7) && IN(pb + 0)) { PHASE_FRAME(); REP(7) phase_at_norm(F, l, (const bf16*)xin, xcur); SEAM(pb + 0); }
            if (EN(8) && IN(pb + 1)) { PHASE_FRAME(); REP(8) {
                DenseSched S; S.o.init(T / 256, 36, F.G, blockIdx.x); S.A = (const char*)(F.ws + WS_ACT + A_H); S.a_sel_stride = 0; S.pn_per_a = 1 << 20;
                S.B = (const char*)(F.ws + WS_WA + j * W_AT_STRIDE + W_QKV); S.tstepA = (size_t)256 * D; S.tstepB = (size_t)256 * D;
                EpiQKV8 E{(bf16*)(F.ws + WS_ACT + A_Q), (const float*)(F.ws + WS_SA), (const float*)(F.ws + WS_WA + j * W_AT_STRIDE + W_QKVS), 0.08838834764831845f * LOG2E};
                pg8::gemm_phase(F.lds, F.tid, D, D, D, S, E);
                }
                SEAM(pb + 1);
            }
            if (EN(9) && IN(pb + 2)) { PHASE_FRAME(); if ((DUP_MASK >> 9) & 1) phase_attn(F, true); phase_attn(F); SEAM(pb + 2); }
            if (EN(16) && IN(pb + 3)) { PHASE_FRAME(); REP(16) phase_attn_merge(F); SEAM(pb + 3); }
            if (EN(10) && IN(pb + 4)) { PHASE_FRAME();
                DenseSched S; S.o.init(T / 256, 4, F.G, blockIdx.x); S.A = (const char*)(F.ws + WS_ACT + A_AO); S.a_sel_stride = 0; S.pn_per_a = 1 << 20;
                S.B = (const char*)(F.ws + WS_WA + j * W_AT_STRIDE + W_AWO); S.tstepA = (size_t)256 * D * 2; S.tstepB = (size_t)256 * D * 2;
                EpiResid E{(const void*)xcur, 0, xcur, (const float*)(F.ws + WS_MOD) + (size_t)l * 8 * 6144 + 2 * D};
                pg8::gemm_phase(F.lds, F.tid, D, D, D, S, E);
                SEAM(pb + 4);
            }
        }
        if (EN(11) && IN(pb + 6)) { PHASE_FRAME(); if ((DUP_MASK >> 11) & 1) phase_moe_route(F, l, xcur, 4); phase_moe_route(F, l, xcur); SEAM(pb + 6); }
        if (EN(12) && IN(pb + 7)) { PHASE_FRAME(); REP(12) phase_moe_gather(F, l); SEAM(pb + 7); }
        if (EN(13) && IN(pb + 8)) { PHASE_FRAME(); REP(13) {
            MoeGatherSched S; S.tileE = (const int*)(F.ws + WS_TILEE); S.ntiles = uni(S.tileE[160]); S.G = F.G; S.c = blockIdx.x;
            S.A = (const char*)(F.ws + WS_ACT + A_HN2); S.B = (const char*)(F.ws + ws_wm_of(l) + W_GU); S.tstepB = (size_t)256 * D * 2; S.estride = (size_t)512 * D * 2;
            { LAS int* rt = (LAS int*)(F.lds + LDS_MISC + 1024); S.rowtab = rt; const int* rowt = (const int*)(F.ws + WS_ROWT);
              for (int i = F.tid; i < 3 * 256; i += NTHREADS) { const int L = (i >> 8) * F.G + (int)blockIdx.x; rt[i] = (L < S.ntiles * 2) ? rowt[(L >> 1) * 256 + (i & 255)] : 0; }
              __syncthreads(); }
            EpiGateUp E{(bf16*)(F.ws + WS_ACT + A_HID), (const float*)(F.ws + WS_ROWW)};
            pg8::gemm_phase(F.lds, F.tid, D, D, D, S, E);
            if (l + 1 < DEPTH) {
                const int nun = S.ntiles * 2, firstb = (nun > F.G) ? (nun - F.G) : 0;
                if ((int)blockIdx.x >= firstb) moe_convert(F, l + 1, ((int)blockIdx.x - firstb) * NWAVES + F.wave, (F.G - firstb) * NWAVES);
            }
            }
                SEAM(pb + 8);
        }
        if (EN(14) && IN(pb + 9)) { PHASE_FRAME(); REP(14) {
            MoeSched S; S.tileE = (const int*)(F.ws + WS_TILEE); S.ntiles = uni(S.tileE[160]); S.npn = 4; S.G = F.G; S.c = blockIdx.x;
            S.A = (const char*)(F.ws + WS_ACT + A_HID); S.B = (const char*)(F.ws + ws_wm_of(l) + W_DN); S.tstepA = (size_t)256 * FEXP * 2; S.tstepB = (size_t)256 * FEXP * 2; S.estride = (size_t)D * FEXP * 2;
            EpiPlain E{(bf16*)(F.ws + WS_ACT + A_YS)};
            pg8::gemm_phase(F.lds, F.tid, FEXP, FEXP, FEXP, S, E);
            }
                SEAM(pb + 9);
        }
    }
    if (EN(15) && IN(N_PHASES - 1)) { PHASE_FRAME(); phase_final(F, X1); }
#undef IN
#undef SEAM
}

typedef void (*kern_t)(Args);
template <int B> static kern_t kern_of_bit(int b) { if (b == B) return mk_fwd<(1 << B)>; if constexpr (B > 0) return kern_of_bit<B - 1>(b); else return nullptr; }
static int kind_of_phase(int p) {
    if (p == 0) return 0; if (p == N_PHASES - 1) return 15;
    const int l = (p - 1) / PH_PER_LAYER, k = (p - 1) % PH_PER_LAYER;
    if (k >= 6) return 11 + (k - 6);
    if ((l & 1) == 0) return 1 + k;
    return (k < 3) ? 7 + k : (k == 3 ? 16 : (k == 4 ? 10 : -1));
}
extern "C" void kernel_launch(void* const* d_in, const int* in_sizes, int n_in, void* d_out, int out_size, void* d_ws, size_t ws_size, hipStream_t stream) {
    static int grid = 0;
    if (grid == 0) {
        if (n_in != 32 || out_size != T * D || ws_size < WS_END) { fprintf(stderr, "kernel_launch: unexpected shapes (n_in %d out %d ws %zu need %zu)\n", n_in, out_size, ws_size, (size_t)WS_END); grid = -1; return; }
        int dev = 0, cus = 0;
        if (hipGetDevice(&dev) != hipSuccess || hipDeviceGetAttribute(&cus, hipDeviceAttributeMultiprocessorCount, dev) != hipSuccess) { grid = -1; return; }
#if ONE_LAUNCH
        if (hipFuncSetAttribute((const void*)mk_fwd<0x1ffff>, hipFuncAttributeMaxDynamicSharedMemorySize, LDS_BYTES) != hipSuccess) { fprintf(stderr, "kernel_launch: hipFuncSetAttribute failed\n"); grid = -1; return; }
#else
        for (int b = 0; b < 17; ++b) if (hipFuncSetAttribute((const void*)kern_of_bit<16>(b), hipFuncAttributeMaxDynamicSharedMemorySize, LDS_BYTES) != hipSuccess) { fprintf(stderr, "kernel_launch: hipFuncSetAttribute failed\n"); grid = -1; return; }
#endif
        (void)hipGetLastError();
        grid = cus;
    }
    if (grid < 0) return;
    (void)hipMemsetAsync((char*)d_ws + WS_CTL, 0, CTL_ZERO_BYTES, stream);
    Args a{};
    for (int i = 0; i < 32; ++i) a.in[i] = (const float*)d_in[i];
    a.out = (float*)d_out; a.ws = (unsigned char*)d_ws;
#if ONE_LAUNCH
#ifndef SPLIT_EVERY
#define SPLIT_EVERY N_PHASES
#endif
    for (int p = 0; p < N_PHASES; p += SPLIT_EVERY) {
        a.ph_lo = p; a.ph_hi = (p + SPLIT_EVERY < N_PHASES) ? p + SPLIT_EVERY : N_PHASES;
        hipLaunchKernelGGL(mk_fwd<0x1ffff>, dim3(grid), dim3(NTHREADS), LDS_BYTES, stream, a);
    }
#else
    for (int p = 0; p < N_PHASES; ++p) {
        const int kind = kind_of_phase(p); if (kind < 0) continue;
        a.ph_lo = p; a.ph_hi = p + 1;
        hipLaunchKernelGGL(kern_of_bit<16>(kind), dim3(grid), dim3(NTHREADS), LDS_BYTES, stream, a);
    }
#endif
}
```

```cpp
#include <hip/hip_runtime.h>
#include <cstdio>
#include <cstdint>

#ifndef ONE_LAUNCH
#define ONE_LAUNCH 1
#endif


#define LAS __attribute__((address_space(3)))
typedef unsigned short bf16;
typedef short bf16x8 __attribute__((ext_vector_type(8)));
typedef float f32x4 __attribute__((ext_vector_type(4)));
typedef float f32x2 __attribute__((ext_vector_type(2)));
typedef unsigned u32x4 __attribute__((ext_vector_type(4)));
typedef unsigned u32x2 __attribute__((ext_vector_type(2)));

constexpr int NB = 8, SEQ = 2048, D = 1024, T = NB * SEQ, DEPTH = 4;
constexpr int NH_R = 16, HD_R = 64;
constexpr int QKVW = 9216;
constexpr int NEXP = 32, FEXP = 256;
constexpr int MAXROWS = 40960;
constexpr int NWAVES = 8, NTHREADS = 512;
constexpr float RMS_EPS = 1e-6f, GN_EPS = 64e-5f;
constexpr float LOG2E = 1.4426950408889634f;

constexpr size_t MiB = 1u << 20;
constexpr size_t WS_CTL = 0, CTL_ZERO_BYTES = 64 * 1024;
constexpr size_t WS_MOD = 1 * MiB;
constexpr size_t WS_TOKE = 2 * MiB;
constexpr size_t WS_TOKR = WS_TOKE + 128 * 1024;
constexpr size_t WS_TOKW = WS_TOKR + 128 * 1024;
constexpr size_t WS_TOKP = WS_TOKW + 128 * 1024;
constexpr size_t WS_ROWW = WS_TOKP + 128 * 1024;
constexpr size_t WS_TILEE = WS_ROWW + 192 * 1024;
constexpr size_t WS_ROWT = WS_TILEE + 4096;
constexpr size_t WS_SB = 4 * MiB;
constexpr size_t WS_SA = WS_SB + 1536 * 1024;
constexpr size_t WS_SCL = 6 * MiB;
constexpr size_t SCL_XS = 0, SCL_HN = 4 * 65536;
constexpr size_t WS_W = 8 * MiB;
constexpr size_t W_RKV = 0, W_RKVS = 3 * MiB, W_LDN = 6 * MiB, W_LUPWA = 8 * MiB, W_LUPG = 10 * MiB, W_RWO = 11 * MiB, W_RW_STRIDE = 13 * MiB;
constexpr size_t WS_WA = WS_W + 2 * W_RW_STRIDE;
constexpr size_t W_QKV = 0, W_QKVS = 9 * MiB, W_AWO = 18 * MiB, W_AT_STRIDE = 20 * MiB;
constexpr size_t WS_WM = WS_WA + 2 * W_AT_STRIDE;
constexpr size_t W_GU = 0, W_GUS = 16 * MiB, W_DN = 32 * MiB;
__host__ __device__ constexpr size_t ws_wm_of(int l);
constexpr size_t WS_X1 = 128 * MiB;
constexpr size_t WS_ACT = 192 * MiB;
constexpr size_t A_XS = 0, A_HX = 96 * MiB;
constexpr size_t A_LDEC = 0, A_ASIG = 64 * MiB, A_G = 128 * MiB;
constexpr size_t A_RKV = 192 * MiB;
constexpr size_t A_O = 192 * MiB;
constexpr size_t A_LORAH = 288 * MiB;
constexpr size_t A_Y = 304 * MiB;
constexpr size_t A_H = 0;
constexpr size_t A_Q = 32 * MiB, A_K = 128 * MiB, A_VT = 224 * MiB;
constexpr size_t A_AO = 320 * MiB;
constexpr size_t A_HN2 = 0, A_ASORT = 32 * MiB, A_HID = 112 * MiB, A_YS = 288 * MiB;
static_assert(A_K - A_Q == A_VT - A_K, "q/k/v spacing");
constexpr size_t WS_WM2 = WS_ACT + 368 * MiB;
constexpr size_t WS_END = WS_WM2 + 48 * MiB;

constexpr int CW_BAR = 4096;
constexpr int CW_CNT = 8192;

__host__ __device__ constexpr size_t ws_wm_of(int l) { return (l & 1) ? WS_WM2 : WS_WM; }
constexpr int LDS_BYTES = 163840;
constexpr int LDS_MISC = 159744;
constexpr int MISC_OFF = LDS_MISC + 320;
constexpr int TILEE_OFF = LDS_MISC + 1024;
constexpr int OFFS_OFF = LDS_MISC + 2048;

__device__ __forceinline__ float bf_lo(unsigned u) { return __uint_as_float(u << 16); }
__device__ __forceinline__ float bf_hi(unsigned u) { return __uint_as_float(u & 0xffff0000u); }
__device__ __forceinline__ float bf2f(bf16 v) { return __uint_as_float(((unsigned)v) << 16); }
__device__ __forceinline__ unsigned f2bf(float f) { __bf16 r = (__bf16)f; return (unsigned)__builtin_bit_cast(unsigned short, r); }
__device__ __forceinline__ unsigned pk2(float lo, float hi) { typedef __bf16 b2_t __attribute__((ext_vector_type(2))); typedef float f2_t __attribute__((ext_vector_type(2))); f2_t v = {lo, hi}; b2_t r = __builtin_convertvector(v, b2_t); return __builtin_bit_cast(unsigned, r); }
__device__ __forceinline__ float dpp_ror(float x, const int ctrl_sel) {
    int r;
    if (ctrl_sel == 8) r = __builtin_amdgcn_update_dpp(0, __float_as_int(x), 0x128, 0xf, 0xf, false);
    else if (ctrl_sel == 4) r = __builtin_amdgcn_update_dpp(0, __float_as_int(x), 0x124, 0xf, 0xf, false);
    else if (ctrl_sel == 2) r = __builtin_amdgcn_update_dpp(0, __float_as_int(x), 0x122, 0xf, 0xf, false);
    else r = __builtin_amdgcn_update_dpp(0, __float_as_int(x), 0x121, 0xf, 0xf, false);
    return __int_as_float(r);
}
__device__ __forceinline__ float rowsum16(float x) { x += dpp_ror(x, 8); x += dpp_ror(x, 4); x += dpp_ror(x, 2); x += dpp_ror(x, 1); return x; }
__device__ __forceinline__ float sum8(float x) {
    x += __int_as_float(__builtin_amdgcn_update_dpp(0, __float_as_int(x), 0x141, 0xf, 0xf, false));
    x += __int_as_float(__builtin_amdgcn_update_dpp(0, __float_as_int(x), 0xB1, 0xf, 0xf, false));
    x += __int_as_float(__builtin_amdgcn_update_dpp(0, __float_as_int(x), 0x4E, 0xf, 0xf, false));
    return x;
}
__device__ __forceinline__ float lane_xor(float v, int lane, int o) { return __int_as_float(__builtin_amdgcn_ds_bpermute((lane ^ o) << 2, __float_as_int(v))); }
typedef unsigned v2u_t __attribute__((ext_vector_type(2)));
__device__ __forceinline__ float bfly16_sum(float x) { const v2u_t r = __builtin_amdgcn_permlane16_swap(__float_as_uint(x), __float_as_uint(x), false, false); return __uint_as_float(r[0]) + __uint_as_float(r[1]); }
__device__ __forceinline__ float bfly32_sum(float x) { const v2u_t r = __builtin_amdgcn_permlane32_swap(__float_as_uint(x), __float_as_uint(x), false, false); return __uint_as_float(r[0]) + __uint_as_float(r[1]); }
__device__ __forceinline__ float bfly16_max(float x) { const v2u_t r = __builtin_amdgcn_permlane16_swap(__float_as_uint(x), __float_as_uint(x), false, false); return fmaxf(__uint_as_float(r[0]), __uint_as_float(r[1])); }
__device__ __forceinline__ float bfly32_max(float x) { const v2u_t r = __builtin_amdgcn_permlane32_swap(__float_as_uint(x), __float_as_uint(x), false, false); return fmaxf(__uint_as_float(r[0]), __uint_as_float(r[1])); }
__device__ __forceinline__ float wave_max(float x) {
    x = fmaxf(x, dpp_ror(x, 8)); x = fmaxf(x, dpp_ror(x, 4)); x = fmaxf(x, dpp_ror(x, 2)); x = fmaxf(x, dpp_ror(x, 1)); x = bfly16_max(x); return bfly32_max(x);
}
__device__ __forceinline__ unsigned pack_i8x4(const f32x4& v, float inv) {
    const int q0 = (int)__builtin_rintf(fminf(fmaxf(v[0] * inv, -127.f), 127.f)), q1 = (int)__builtin_rintf(fminf(fmaxf(v[1] * inv, -127.f), 127.f));
    const int q2 = (int)__builtin_rintf(fminf(fmaxf(v[2] * inv, -127.f), 127.f)), q3 = (int)__builtin_rintf(fminf(fmaxf(v[3] * inv, -127.f), 127.f));
    return (unsigned)(q0 & 255) | ((unsigned)(q1 & 255) << 8) | ((unsigned)(q2 & 255) << 16) | ((unsigned)q3 << 24);
}
__device__ __forceinline__ float wave_sum(float v, int lane) { (void)lane; v = rowsum16(v); v = bfly16_sum(v); v = bfly32_sum(v); return v; }
__device__ __forceinline__ int lane_id_nh() { int lid; asm volatile("v_mbcnt_lo_u32_b32 %0, -1, 0\n\tv_mbcnt_hi_u32_b32 %0, -1, %0" : "=v"(lid)); return lid; }
__device__ __forceinline__ float sigmoidf_(float x) { return 1.0f / (1.0f + __expf(-x)); }
#define LDS_WAIT() asm volatile("s_waitcnt lgkmcnt(0)" ::: "memory")
#define VM_WAIT() asm volatile("s_waitcnt vmcnt(0)" ::: "memory")

#define XB_TMO      128
#define XB_XCNT(j)  (256  + 64 * (j))
#define XB_XSUB(j)  (1280 + 64 * (j))
#define XB_XGEN(j)  (2304 + 64 * (j))
#define XB_TOP      3328
#define XB_TOPGEN   3392
#define XCD_BAR_WORDS 3456
#define XB_SPIN_CAP (1u << 18)
__device__ __forceinline__ unsigned xb_ld(unsigned* p)              { return __hip_atomic_load(p, __ATOMIC_RELAXED, __HIP_MEMORY_SCOPE_AGENT); }
__device__ __forceinline__ unsigned xb_add(unsigned* p, unsigned v) { return __hip_atomic_fetch_add(p, v, __ATOMIC_RELAXED, __HIP_MEMORY_SCOPE_AGENT); }
__device__ __forceinline__ unsigned xb_xcc_id() { return (unsigned)__builtin_amdgcn_s_getreg((3 << 11) | 20) & 0xFu; }
#define XB_SPIN(cond, bar) do { unsigned _sp = 0; while (cond) { __builtin_amdgcn_s_sleep(1); \
    if ((++_sp & 255u) == 0u) { if (xb_ld(&(bar)[XB_TMO])) break; if (_sp > XB_SPIN_CAP) { atomicAdd(&(bar)[XB_TMO], 1u); break; } } } } while (0)
struct XcdBarrier { unsigned* bar; unsigned x; volatile LAS unsigned* st; };
__device__ __forceinline__ XcdBarrier xcd_barrier_post(unsigned* bar, volatile LAS unsigned* st, bool t0) {
    XcdBarrier b; b.bar = bar; b.x = xb_xcc_id(); b.st = st;
    if (t0) (void)xb_add(&bar[XB_XCNT(b.x)], 1u);
    return b;
}
__device__ __forceinline__ void xcd_barrier_complete(unsigned* bar, unsigned x, unsigned& nloc, unsigned& nx) {
    const unsigned G = gridDim.x * gridDim.y * gridDim.z;
    unsigned sum, cnt, mine, sp = 0u;
    for (;;) {
        sum = 0u; cnt = 0u; mine = 0u;
#pragma clang loop unroll(disable)
        for (unsigned j = 0; j < 16; ++j) { const unsigned c = xb_ld(&bar[XB_XCNT(j)]); sum += c; cnt += (c > 0u) ? 1u : 0u; mine = (j == x) ? c : mine; }
        if (sum == G) break;
        __builtin_amdgcn_s_sleep(1);
        if ((++sp & 255u) == 0u) { if (xb_ld(&bar[XB_TMO])) break; if (sp > XB_SPIN_CAP) { atomicAdd(&bar[XB_TMO], 1u); break; } }
    }
    nloc = mine > 0u ? mine : 1u; nx = cnt > 0u ? cnt : 1u;
}
__device__ __forceinline__ void xcd_barrier(const XcdBarrier& b, bool t0) {
    asm volatile("s_waitcnt vmcnt(0)" ::: "memory");
    __syncthreads();
    if (t0) {
        unsigned* bar = b.bar;
        __builtin_amdgcn_s_waitcnt(0);
        unsigned nloc = b.st[0], nx = b.st[1];
        if (nloc == 0u) { xcd_barrier_complete(bar, b.x, nloc, nx); b.st[0] = nloc; b.st[1] = nx; }
        const unsigned old = xb_add(&bar[XB_XSUB(b.x)], 1u);
        const unsigned gen = old / nloc;
        if (old + 1u == (gen + 1u) * nloc) {
            __builtin_amdgcn_fence(__ATOMIC_RELEASE, "agent");
            asm volatile("s_waitcnt vmcnt(0)" ::: "memory");
            const unsigned og = xb_add(&bar[XB_TOP], 1u);
            const unsigned tg = og / nx;
            if (og + 1u == (tg + 1u) * nx) xb_add(&bar[XB_TOPGEN], 1u);
            else XB_SPIN(xb_ld(&bar[XB_TOPGEN]) == tg, bar);
            __builtin_amdgcn_fence(__ATOMIC_ACQUIRE, "agent");
            xb_add(&bar[XB_XGEN(b.x)], 1u);
            asm volatile("s_waitcnt vmcnt(0)" ::: "memory");
        } else {
            XB_SPIN(xb_ld(&bar[XB_XGEN(b.x)]) == gen, bar);
            __builtin_amdgcn_fence(__ATOMIC_ACQUIRE, "agent");
            asm volatile("s_waitcnt vmcnt(0)" ::: "memory");
        }
    }
    __syncthreads();
}

namespace pg8 {
constexpr int BM = 256, BK = 64, HALF = 128, HTB = HALF * BK * 2, STAGE_BYTES = 8 * HTB;
__device__ __forceinline__ int lds_byte(int r, int c) { const int st = (r >> 4) * 2 + (c >> 5), rr = r & 15, cc = c & 31, ob = rr * 64 + cc * 2; return st * 1024 + (ob ^ (((ob >> 9) & 1) << 5)); }
__device__ __forceinline__ void stage_rc(int b, int& R, int& C) { const int st = b / 1024, sb = b % 1024, swz = sb ^ (((sb >> 9) & 1) << 5); R = (st >> 1) * 16 + swz / 64; C = (st & 1) * 32 + (swz % 64) / 2; }
__device__ __forceinline__ int perm32(int rho) { const int n = rho >> 4, i = rho & 15; return 8 * (i >> 2) + 4 * n + (i & 3); }
struct Unit { int pm, pn; const char* a; const char* b; };
__device__ __forceinline__ unsigned cvt_pk_bf16(float lo, float hi) { unsigned r; asm volatile("v_cvt_pk_bf16_f32 %0, %1, %2" : "=v"(r) : "v"(lo), "v"(hi)); return r; }

typedef int i32x4 __attribute__((ext_vector_type(4)));
template <bool I8> struct OpT { typedef bf16x8 frag; typedef f32x4 acc; };
template <> struct OpT<true> { typedef i32x4 frag; typedef i32x4 acc; };
__device__ __forceinline__ f32x4 mma16(const bf16x8& a, const bf16x8& b, const f32x4& c) { return __builtin_amdgcn_mfma_f32_16x16x32_bf16(a, b, c, 0, 0, 0); }
__device__ __forceinline__ i32x4 mma16(const i32x4& a, const i32x4& b, const i32x4& c) { return __builtin_amdgcn_mfma_i32_16x16x64_i8(a, b, c, 0, 0, 0); }
template <class Epi, class Sched>
__device__ __forceinline__ void gemm_phase(LAS unsigned char* lds, const int tid, const int K, const int lda, const int ldb, const Sched& S, const Epi& E) {
    const int wid = __builtin_amdgcn_readfirstlane(tid >> 6), lane = tid & 63, wr = wid >> 2, wc = wid & 3, fr = lane & 15, fq = lane >> 4;
    int Kq = K; asm volatile("" : "+s"(Kq));
    constexpr bool I8 = Epi::I8; constexpr int EB = I8 ? 1 : 2;
    typedef typename OpT<I8>::frag frag_t; typedef typename OpT<I8>::acc acc_t;
    const int nt = Kq * EB / (BK * 2);
    unsigned voffC[2][2], voffN[2][2], voffB[2]; int RA[2], CA[2];
#pragma unroll
    for (int i = 0; i < 2; ++i) { int R, C; stage_rc(tid * 16 + i * 8192, R, C); const int Rb = Epi::PERM ? ((R & ~31) + perm32(R & 31)) : R; RA[i] = R; CA[i] = C;
        voffB[i] = (unsigned)(Rb * ldb * EB + C * 2); }
#define PG8_AOFF(dst, ui_) do { _Pragma("unroll") for (int h_ = 0; h_ < 2; ++h_) _Pragma("unroll") for (int i_ = 0; i_ < 2; ++i_) { \
        if constexpr (Sched::GATHER) dst[h_][i_] = (unsigned)(S.row_of(ui_, h_ * HALF + RA[i_]) * lda * EB + CA[i_] * 2); else dst[h_][i_] = (unsigned)((h_ * HALF + RA[i_]) * lda * EB + CA[i_] * 2); } } while (0)
    const size_t kstep = (size_t)(BK * 2);
    const size_t hstepB = (size_t)HALF * ldb * EB;
    const unsigned ldsw = (unsigned)wid * 1024u;
    const int aoff = lds_byte(wr * 64 + fr, fq * 8), boff = lds_byte(wc * 32 + fr, fq * 8);
#define PG8_SA(b, h) (((b) * 2 + (h)) * HTB)
#define PG8_SB(b, h) ((4 + (b) * 2 + (h)) * HTB)
#define PG8_STAGE(bufoff, gbase, voff) do { _Pragma("unroll") for (int _i = 0; _i < 2; ++_i) \
        __builtin_amdgcn_global_load_lds((const unsigned*)((const char*)(gbase) + (voff)[_i]), (LAS unsigned*)(lds + (bufoff) + ldsw + _i * 8192), 16, 0, 0); } while (0)
#define PG8_LDA(dst, b, h) do { _Pragma("unroll") for (int m = 0; m < 4; ++m) _Pragma("unroll") for (int k = 0; k < 2; ++k) dst[m][k] = *(const LAS frag_t*)(lds + PG8_SA(b, h) + aoff + m * 2048 + k * 1024); } while (0)
#define PG8_LDB(dst, b, h) do { _Pragma("unroll") for (int n = 0; n < 2; ++n) _Pragma("unroll") for (int k = 0; k < 2; ++k) dst[n][k] = *(const LAS frag_t*)(lds + PG8_SB(b, h) + boff + n * 2048 + k * 1024); } while (0)
#define PG8_MMA(ai, bj, At, Bt) do { __builtin_amdgcn_s_setprio(1); _Pragma("unroll") for (int m = 0; m < 4; ++m) _Pragma("unroll") for (int n = 0; n < 2; ++n) _Pragma("unroll") for (int k = 0; k < 2; ++k) \
        acc[ai][bj][m][n] = mma16(Bt[n][k], At[m][k], acc[ai][bj][m][n]); __builtin_amdgcn_s_setprio(0); } while (0)
#define PG8_WAIT_V(n) asm volatile("s_waitcnt vmcnt(" #n ")" ::: "memory")
#define PG8_WAIT_L(n) asm volatile("s_waitcnt lgkmcnt(" #n ")" ::: "memory")
#define PG8_BAR __builtin_amdgcn_s_barrier()
#define PG8_SCHED __builtin_amdgcn_sched_barrier(0)
    Unit cur, nxt; int ui = 0;
    if (!S.next(0, cur)) return;
    acc_t acc[2][2][4][2];
#pragma unroll
    for (int a = 0; a < 2; ++a)
#pragma unroll
        for (int b = 0; b < 2; ++b)
#pragma unroll
            for (int m = 0; m < 4; ++m)
#pragma unroll
                for (int n = 0; n < 2; ++n) acc[a][b][m][n] = (acc_t){0, 0, 0, 0};
    frag_t At[4][2], B0[2][2], B1[2][2];
    const char* cA = cur.a; const char* cB = cur.b;
    PG8_AOFF(voffC, 0); PG8_AOFF(voffN, 0);
    PG8_STAGE(PG8_SB(0, 0), cB, voffB); PG8_STAGE(PG8_SB(0, 1), cB + hstepB, voffB); PG8_STAGE(PG8_SA(0, 0), cA, voffC[0]); PG8_STAGE(PG8_SA(0, 1), cA, voffC[1]);
    if (wr == 1) PG8_BAR;
    PG8_WAIT_V(2); PG8_BAR;
    PG8_STAGE(PG8_SB(1, 0), cB + kstep, voffB); PG8_STAGE(PG8_SA(1, 0), cA + kstep, voffC[0]); PG8_STAGE(PG8_SB(1, 1), cB + hstepB + kstep, voffB);
    PG8_WAIT_V(6); PG8_BAR;
    for (;;) {
        const bool has_next = S.next(ui + 1, nxt);
        const char* nA = has_next ? nxt.a : cA; const char* nB = has_next ? nxt.b : cB;
        if constexpr (Sched::GATHER) { if (has_next) PG8_AOFF(voffN, ui + 1); }
#pragma clang loop unroll(disable)
        for (int t = 0; t < nt; t += 2) {
            const bool last = (t == nt - 2);
            const char* a1 = cA + (size_t)(t + 1) * kstep;
            const char* a2 = last ? nA : cA + (size_t)(t + 2) * kstep; const char* b2 = last ? nB : cB + (size_t)(t + 2) * kstep;
            const char* a3 = a2 + kstep; const char* b3 = b2 + kstep;
            unsigned vA0[2], vA1[2];
            if constexpr (Sched::GATHER) { vA0[0] = last ? voffN[0][0] : voffC[0][0]; vA0[1] = last ? voffN[0][1] : voffC[0][1]; vA1[0] = last ? voffN[1][0] : voffC[1][0]; vA1[1] = last ? voffN[1][1] : voffC[1][1]; }
            else { vA0[0] = voffC[0][0]; vA0[1] = voffC[0][1]; vA1[0] = voffC[1][0]; vA1[1] = voffC[1][1]; }
            PG8_LDB(B0, 0, 0); PG8_LDB(B1, 0, 1); PG8_SCHED; PG8_LDA(At, 0, 0); PG8_STAGE(PG8_SA(1, 1), a1, voffC[1]);
            PG8_WAIT_V(8); PG8_WAIT_L(0); PG8_BAR; PG8_MMA(0, 0, At, B0); PG8_MMA(0, 1, At, B1); PG8_BAR; PG8_SCHED;
            PG8_LDA(At, 0, 1); PG8_STAGE(PG8_SB(0, 0), b2, voffB); PG8_STAGE(PG8_SB(0, 1), b2 + hstepB, voffB); PG8_STAGE(PG8_SA(0, 0), a2, vA0);
            PG8_WAIT_V(8); PG8_WAIT_L(0); PG8_BAR; PG8_MMA(1, 0, At, B0); PG8_MMA(1, 1, At, B1); PG8_BAR; PG8_SCHED;
            PG8_LDB(B0, 1, 0); PG8_LDB(B1, 1, 1); PG8_SCHED; PG8_LDA(At, 1, 0); PG8_STAGE(PG8_SA(0, 1), a2, vA1);
            PG8_WAIT_V(8); PG8_WAIT_L(0); PG8_BAR; PG8_MMA(0, 0, At, B0); PG8_MMA(0, 1, At, B1); PG8_BAR; PG8_SCHED;
            PG8_LDA(At, 1, 1); PG8_STAGE(PG8_SB(1, 0), b3, voffB); PG8_STAGE(PG8_SB(1, 1), b3 + hstepB, voffB); PG8_STAGE(PG8_SA(1, 0), a3, vA0);
            PG8_WAIT_V(8); PG8_WAIT_L(0); PG8_BAR; PG8_MMA(1, 0, At, B0); PG8_MMA(1, 1, At, B1); PG8_BAR; PG8_SCHED;
        }
        if (wr == 0) PG8_BAR;
        { int te = tid; asm volatile("" : "+v"(te));
          const int we = __builtin_amdgcn_readfirstlane(te >> 6), le = te & 63;
          E(acc, cur, we >> 2, we & 3, le & 15, le >> 4); }
        if (!has_next) break;
#pragma unroll
        for (int a = 0; a < 2; ++a)
#pragma unroll
            for (int b = 0; b < 2; ++b)
#pragma unroll
                for (int m = 0; m < 4; ++m)
#pragma unroll
                    for (int n = 0; n < 2; ++n) acc[a][b][m][n] = (acc_t){0, 0, 0, 0};
        cur = nxt; cA = nA; cB = nB; ++ui;
        if constexpr (Sched::GATHER) {
#pragma unroll
            for (int h_ = 0; h_ < 2; ++h_) { voffC[h_][0] = voffN[h_][0]; voffC[h_][1] = voffN[h_][1]; } }
        if (wr == 1) PG8_BAR;
    }
    PG8_WAIT_V(0);
    PG8_BAR;
#undef PG8_AOFF
#undef PG8_SA
#undef PG8_SB
#undef PG8_STAGE
#undef PG8_LDA
#undef PG8_LDB
#undef PG8_MMA
#undef PG8_WAIT_V
#undef PG8_WAIT_L
#undef PG8_BAR
#undef PG8_SCHED
}

struct GridOrder {
    int nM, nN, nwg, G, c, uneven;
    __device__ __forceinline__ void init(int nM_, int nN_, int G_, int c_) { nM = nM_; nN = nN_; nwg = nM * nN; G = G_; c = c_; uneven = 0; }
    __device__ __forceinline__ bool tile(int i, int& pm, int& pn) const {
        long L = (long)i * G + c;
        if (uneven) {
            if (c < 128) { if (i >= 2) return false; L = i * 128 + c; } else { if (i >= 4) return false; L = 256 + (c - 128) + 128 * i; } }
        if (L >= nwg) return false;
        int wgid = (int)L; { const int q = nwg / 8, r = nwg % 8, xcd = wgid % 8, off = wgid / 8; wgid = (xcd < r ? xcd * (q + 1) : r * (q + 1) + (xcd - r) * q) + off; }
        const int nig = 8 * nN, gid = wgid / nig, fm = gid * 8, gsz = (nM - fm) < 8 ? (nM - fm) : 8;
        pm = fm + ((wgid % nig) % gsz); pn = (wgid % nig) / gsz; return true;
    }
};
}

__device__ __forceinline__ int uni(int v) { return __builtin_amdgcn_readfirstlane(v); }
__device__ __forceinline__ const char* uniptr(const char* p) { const unsigned long long v = (unsigned long long)p; const unsigned lo = __builtin_amdgcn_readfirstlane((unsigned)v), hi = __builtin_amdgcn_readfirstlane((unsigned)(v >> 32)); return (const char*)(((unsigned long long)hi << 32) | lo); }
struct DenseSched {
    static constexpr bool GATHER = false;
    pg8::GridOrder o; const char* A; size_t a_sel_stride; int pn_per_a; const char* B; size_t tstepA, tstepB;
    __device__ __forceinline__ bool next(int i, pg8::Unit& u) const {
        if (!o.tile(i, u.pm, u.pn)) return false;
        u.pm = uni(u.pm); u.pn = uni(u.pn);
        u.a = uniptr(A + (size_t)(u.pn / pn_per_a) * a_sel_stride + (size_t)u.pm * tstepA); u.b = uniptr(B + (size_t)u.pn * tstepB); return true;
    }
};
struct MoeSched {
    static constexpr bool GATHER = false;
    const int* tileE; int ntiles, npn, G, c; const char* A; const char* B; size_t tstepA, tstepB, estride;
    __device__ __forceinline__ bool next(int i, pg8::Unit& u) const {
        const int L = i * G + c; if (L >= ntiles * npn) return false;
        u.pm = uni(L / npn); u.pn = uni(L % npn);
        const int e = __builtin_amdgcn_readfirstlane(tileE[u.pm]);
        u.a = uniptr(A + (size_t)u.pm * tstepA); u.b = uniptr(B + (size_t)e * estride + (size_t)u.pn * tstepB); return true;
    }
};

struct MoeGatherSched {
    static constexpr bool GATHER = true;
    const int* tileE; const LAS int* rowtab; int ntiles, G, c; const char* A; const char* B; size_t tstepB, estride;
    __device__ __forceinline__ bool next(int i, pg8::Unit& u) const {
        const int L = i * G + c; if (L >= ntiles * 2) return false;
        u.pm = uni(L >> 1); u.pn = uni(L & 1);
        const int e = __builtin_amdgcn_readfirstlane(tileE[u.pm]);
        u.a = A; u.b = uniptr(B + (size_t)e * estride + (size_t)u.pn * tstepB); return true;
    }
    __device__ __forceinline__ int row_of(int i, int r) const { return rowtab[i * 256 + r]; }
};
using pg8::Unit; using pg8::cvt_pk_bf16;
__device__ __forceinline__ void st8(bf16* p, const f32x4& v0, const f32x4& v1) {
    u32x4 w; w.x = cvt_pk_bf16(v0[0], v0[1]); w.y = cvt_pk_bf16(v0[2], v0[3]); w.z = cvt_pk_bf16(v1[0], v1[1]); w.w = cvt_pk_bf16(v1[2], v1[3]);
    *(u32x4*)p = w;
}
struct EpiSplit {
    static constexpr bool PERM = true, I8 = false;
    bf16* O; size_t split_stride; float scale;
    __device__ __forceinline__ void operator()(const f32x4 (&acc)[2][2][4][2], const Unit& u, int wr, int wc, int fr, int fq) const {
        const int row0 = u.pm * 256 + wr * 64 + fr; const int colt = u.pn * 256; const int t = colt >> 10;
        bf16* base = O + (size_t)t * split_stride; const int col0 = (colt & 1023) + wc * 32 + 8 * fq;
#pragma unroll
        for (int ai = 0; ai < 2; ++ai)
#pragma unroll
            for (int m = 0; m < 4; ++m) { bf16* rowp = base + (size_t)(row0 + ai * 128 + m * 16) * 1024 + col0;
#pragma unroll
                for (int bj = 0; bj < 2; ++bj) st8(rowp + bj * 128, acc[ai][bj][m][0] * scale, acc[ai][bj][m][1] * scale); }
    }
};
struct EpiLoraDn {
    static constexpr bool PERM = true, I8 = false;
    bf16* O;
    __device__ __forceinline__ void operator()(const f32x4 (&acc)[2][2][4][2], const Unit& u, int wr, int wc, int fr, int fq) const {
        const int row0 = u.pm * 256 + wr * 64 + fr; const int col0 = u.pn * 256 + wc * 32 + 8 * fq;
#pragma unroll
        for (int ai = 0; ai < 2; ++ai)
#pragma unroll
            for (int m = 0; m < 4; ++m) { bf16* rowp = O + (size_t)(row0 + ai * 128 + m * 16) * 512 + col0;
#pragma unroll
                for (int bj = 0; bj < 2; ++bj) { f32x4 v0 = acc[ai][bj][m][0], v1 = acc[ai][bj][m][1];
                    const int mode = (u.pn == 1) ? 2 : ((wc >> 1) & 1);
                    if (mode == 0) {
#pragma unroll
                        for (int j = 0; j < 4; ++j) { v0[j] = 1.0f - 2.0f / (__expf(2.0f * v0[j]) + 1.0f); v1[j] = 1.0f - 2.0f / (__expf(2.0f * v1[j]) + 1.0f); } }
                    else if (mode == 2) {
#pragma unroll
                        for (int j = 0; j < 4; ++j) { v0[j] = sigmoidf_(v0[j]); v1[j] = sigmoidf_(v1[j]); } }
                    st8(rowp + bj * 128, v0, v1); } }
    }
};
struct EpiLoraUpWA {
    static constexpr bool PERM = true, I8 = false;
    bf16* LD; bf16* AS; const float* w0; const float* a0;
    __device__ __forceinline__ void operator()(const f32x4 (&acc)[2][2][4][2], const Unit& u, int wr, int wc, int fr, int fq) const {
        const int z = u.pn >> 3, kind = (u.pn >> 2) & 1;
        const int row0 = u.pm * 256 + wr * 64 + fr; const int col0 = (u.pn & 3) * 256 + wc * 32 + 8 * fq;
        bf16* base = (kind ? AS : LD) + (size_t)z * T * D; const float* bias = (kind ? a0 : w0) + z * 1024;
        f32x4 bv[2][2];
#pragma unroll
        for (int bj = 0; bj < 2; ++bj)
#pragma unroll
            for (int n = 0; n < 2; ++n) bv[bj][n] = *(const f32x4*)(bias + col0 + bj * 128 + 4 * n);
#pragma unroll
        for (int ai = 0; ai < 2; ++ai)
#pragma unroll
            for (int m = 0; m < 4; ++m) { bf16* rowp = base + (size_t)(row0 + ai * 128 + m * 16) * 1024 + col0;
#pragma unroll
                for (int bj = 0; bj < 2; ++bj) { f32x4 v[2];
#pragma unroll
                    for (int n = 0; n < 2; ++n) { v[n] = acc[ai][bj][m][n] + bv[bj][n];
#pragma unroll
                        for (int j = 0; j < 4; ++j) { const float x = v[n][j];
                            if (kind == 0) v[n][j] = -0.8750612633917001f * sigmoidf_(x);
                            else v[n][j] = sigmoidf_(x); } }
                    st8(rowp + bj * 128, v[0], v[1]); } }
    }
};
struct EpiResid {
    static constexpr bool PERM = true, I8 = false;
    const void* xin; int xin_f32; bf16* out; const float* gate;
    __device__ __forceinline__ void operator()(const f32x4 (&acc)[2][2][4][2], const Unit& u, int wr, int wc, int fr, int fq) const {
        const int row0 = u.pm * 256 + wr * 64 + fr, col0 = u.pn * 256 + wc * 32 + 8 * fq; const int b = u.pm >> 3;
        f32x4 gv[2][2];
#pragma unroll
        for (int bj = 0; bj < 2; ++bj)
#pragma unroll
            for (int n = 0; n < 2; ++n) gv[bj][n] = *(const f32x4*)(gate + (size_t)b * 6144 + col0 + bj * 128 + 4 * n);
        if (xin_f32) {
#pragma unroll
            for (int ai = 0; ai < 2; ++ai)
#pragma unroll
                for (int m = 0; m < 4; ++m) { const size_t off = (size_t)(row0 + ai * 128 + m * 16) * D + col0;
#pragma unroll
                    for (int bj = 0; bj < 2; ++bj) { const f32x4 x0 = *(const f32x4*)((const float*)xin + off + bj * 128), x1 = *(const f32x4*)((const float*)xin + off + bj * 128 + 4);
                        st8(out + off + bj * 128, x0 + gv[bj][0] * acc[ai][bj][m][0], x1 + gv[bj][1] * acc[ai][bj][m][1]); } }
        } else {
#pragma unroll
            for (int ai = 0; ai < 2; ++ai) { u32x4 xr[4][2];
#pragma unroll
                for (int m = 0; m < 4; ++m)
#pragma unroll
                    for (int bj = 0; bj < 2; ++bj) xr[m][bj] = *(const u32x4*)((const bf16*)xin + (size_t)(row0 + ai * 128 + m * 16) * D + col0 + bj * 128);
#pragma unroll
                for (int m = 0; m < 4; ++m) { const size_t off = (size_t)(row0 + ai * 128 + m * 16) * D + col0;
#pragma unroll
                    for (int bj = 0; bj < 2; ++bj) { const u32x4 r = xr[m][bj];
                        const f32x4 x0 = {bf_lo(r.x), bf_hi(r.x), bf_lo(r.y), bf_hi(r.y)}, x1 = {bf_lo(r.z), bf_hi(r.z), bf_lo(r.w), bf_hi(r.w)};
                        st8(out + off + bj * 128, x0 + gv[bj][0] * acc[ai][bj][m][0], x1 + gv[bj][1] * acc[ai][bj][m][1]); } } }
        }
    }
};
struct EpiQKV {
    static constexpr bool PERM = true, I8 = false;
    bf16* Q; bf16* Kb; bf16* Vb; float qscale;
    __device__ __forceinline__ void operator()(const f32x4 (&acc)[2][2][4][2], const Unit& u, int wr, int wc, int fr, int fq) const {
        const int g = u.pn / 12, which = (u.pn % 12) >> 2, hp = u.pn & 3;
        const int row0 = u.pm * 256 + wr * 64 + fr;
        bf16* base = Q + (size_t)which * ((A_K - A_Q) / 2) + (size_t)g * T * D; const float sc = which ? 1.0f : qscale; const int col0 = hp * 256 + wc * 32 + 8 * fq;
#pragma unroll
        for (int ai = 0; ai < 2; ++ai)
#pragma unroll
            for (int m = 0; m < 4; ++m) { bf16* rowp = base + (size_t)(row0 + ai * 128 + m * 16) * 1024 + col0;
#pragma unroll
                for (int bj = 0; bj < 2; ++bj) st8(rowp + bj * 128, acc[ai][bj][m][0] * sc, acc[ai][bj][m][1] * sc); }
    }
};
template <class Inner> struct EpiI8 {
    static constexpr bool PERM = Inner::PERM, I8 = true;
    Inner in; const float* sa; size_t sa_sel; int pn_per_a; const float* sb;
    __device__ __forceinline__ void operator()(const pg8::i32x4 (&acc)[2][2][4][2], const Unit& u, int wr, int wc, int fr, int fq) const {
        const int row0 = u.pm * 256 + wr * 64 + fr; const float* sap = sa + (size_t)(u.pn / pn_per_a) * sa_sel;
        const int colb = u.pn * 256 + wc * 32 + (PERM ? 8 * fq : 4 * fq);
        f32x4 sbv[2][2]; f32x4 f[2][2][4][2];
#pragma unroll
        for (int bj = 0; bj < 2; ++bj)
#pragma unroll
            for (int n = 0; n < 2; ++n) sbv[bj][n] = *(const f32x4*)(sb + colb + bj * 128 + (PERM ? 4 * n : 16 * n));
#pragma unroll
        for (int ai = 0; ai < 2; ++ai)
#pragma unroll
            for (int m = 0; m < 4; ++m) { const float sr = sap[row0 + ai * 128 + m * 16];
#pragma unroll
                for (int bj = 0; bj < 2; ++bj)
#pragma unroll
                    for (int n = 0; n < 2; ++n) f[ai][bj][m][n] = __builtin_convertvector(acc[ai][bj][m][n], f32x4) * (sbv[bj][n] * sr); }
        in(f, u, wr, wc, fr, fq);
    }
};
struct EpiQKV8 {
    static constexpr bool PERM = true, I8 = true;
    bf16* Q; const float* SA; const float* SBq; float qscale;
    __device__ __forceinline__ void operator()(const pg8::i32x4 (&acc)[2][2][4][2], const Unit& u, int wr, int wc, int fr, int fq) const {
        const int g = u.pn / 12, which = (u.pn % 12) >> 2, hp = u.pn & 3;
        const int row0 = u.pm * 256 + wr * 64 + fr;
        bf16* base = Q + (size_t)which * ((A_K - A_Q) / 2) + (size_t)g * T * D; const float sc = which ? 1.0f : qscale; const int col0 = hp * 256 + wc * 32 + 8 * fq;
        const int colb = u.pn * 256 + wc * 32 + 8 * fq;
        f32x4 sbv[2][2];
#pragma unroll
        for (int bj = 0; bj < 2; ++bj)
#pragma unroll
            for (int n = 0; n < 2; ++n) sbv[bj][n] = *(const f32x4*)(SBq + colb + bj * 128 + 4 * n) * sc;
#pragma unroll
        for (int ai = 0; ai < 2; ++ai)
#pragma unroll
            for (int m = 0; m < 4; ++m) { const int row = row0 + ai * 128 + m * 16; const float sa = SA[row]; bf16* rowp = base + (size_t)row * 1024 + col0;
#pragma unroll
                for (int bj = 0; bj < 2; ++bj) st8(rowp + bj * 128, __builtin_convertvector(acc[ai][bj][m][0], f32x4) * (sbv[bj][0] * sa), __builtin_convertvector(acc[ai][bj][m][1], f32x4) * (sbv[bj][1] * sa)); }
    }
};
struct EpiGateUp {
    static constexpr bool PERM = true, I8 = false;
    bf16* H; const float* roww;
    __device__ __forceinline__ void operator()(const f32x4 (&acc)[2][2][4][2], const Unit& u, int wr, int wc, int fr, int fq) const {
        const int row0 = u.pm * 256 + wr * 64 + fr; const int col0 = u.pn * 128 + wc * 32 + 8 * fq;
#pragma unroll
        for (int ai = 0; ai < 2; ++ai)
#pragma unroll
            for (int m = 0; m < 4; ++m) { const int row = row0 + ai * 128 + m * 16; const float rw = roww[row]; f32x4 v[2];
#pragma unroll
                for (int n = 0; n < 2; ++n)
#pragma unroll
                    for (int j = 0; j < 4; ++j) { const float gg = acc[ai][0][m][n][j], uu = acc[ai][1][m][n][j]; v[n][j] = gg * sigmoidf_(gg) * uu * rw; }
                st8(H + (size_t)row * FEXP + col0, v[0], v[1]); }
    }
};
struct EpiGateUp8 {
    static constexpr bool PERM = true, I8 = true;
    bf16* H; const float* roww; const int* rowt; const float* satok; const float* sbe; const int* tileE;
    __device__ __forceinline__ void operator()(const pg8::i32x4 (&acc)[2][2][4][2], const Unit& u, int wr, int wc, int fr, int fq) const {
        const int row0 = u.pm * 256 + wr * 64 + fr; const int col0 = u.pn * 128 + wc * 32 + 8 * fq;
        const int e = __builtin_amdgcn_readfirstlane(tileE[u.pm]); const float* sbp = sbe + (size_t)e * 512 + u.pn * 256 + wc * 32 + 8 * fq;
        f32x4 sg[2], su[2];
#pragma unroll
        for (int n = 0; n < 2; ++n) { sg[n] = *(const f32x4*)(sbp + 4 * n); su[n] = *(const f32x4*)(sbp + 128 + 4 * n); }
#pragma unroll
        for (int ai = 0; ai < 2; ++ai)
#pragma unroll
            for (int m = 0; m < 4; ++m) { const int row = row0 + ai * 128 + m * 16; const float rw = roww[row]; const float sa = satok[rowt[row]]; f32x4 v[2];
#pragma unroll
                for (int n = 0; n < 2; ++n) { const f32x4 g4 = __builtin_convertvector(acc[ai][0][m][n], f32x4) * (sg[n] * sa), u4 = __builtin_convertvector(acc[ai][1][m][n], f32x4) * (su[n] * sa);
#pragma unroll
                    for (int j = 0; j < 4; ++j) { const float gg = g4[j], uu = u4[j]; v[n][j] = gg * sigmoidf_(gg) * uu * rw; } }
                st8(H + (size_t)row * FEXP + col0, v[0], v[1]); }
    }
};
struct EpiPlain {
    static constexpr bool PERM = true, I8 = false;
    bf16* O;
    __device__ __forceinline__ void operator()(const f32x4 (&acc)[2][2][4][2], const Unit& u, int wr, int wc, int fr, int fq) const {
        const int row0 = u.pm * 256 + wr * 64 + fr; const int col0 = u.pn * 256 + wc * 32 + 8 * fq;
#pragma unroll
        for (int ai = 0; ai < 2; ++ai)
#pragma unroll
            for (int m = 0; m < 4; ++m) { bf16* rowp = O + (size_t)(row0 + ai * 128 + m * 16) * 1024 + col0;
#pragma unroll
                for (int bj = 0; bj < 2; ++bj) st8(rowp + bj * 128, acc[ai][bj][m][0], acc[ai][bj][m][1]); }
    }
};

struct Args {
    const float* in[32]; float* out; unsigned char* ws; int ph_lo, ph_hi;
};
enum { I_X = 0, I_C, I_ADAW, I_ADAB, I_NTM, I_NCM, I_MU, I_WRKV, I_W0, I_W1, I_W2, I_A0, I_A1, I_A2, I_G1, I_G2, I_KK, I_KA, I_RK, I_LNW, I_LNB, I_RWO,
       I_AQKV, I_AWO, I_RG, I_RGB, I_RE, I_REB, I_WG, I_WU, I_WD, I_FG };

struct Frame {
    LAS unsigned char* lds; int tid, lane, wave, G, gw, NGW;
    unsigned char* ws; const float* const* in; float* out;
};

__device__ __forceinline__ void row_load(const float* p, int lane, f32x4 (&v)[4]) {
#pragma unroll
    for (int j = 0; j < 4; ++j) v[j] = *(const f32x4*)(p + 4 * lane + 256 * j);
}
__device__ __forceinline__ void row_load_bf16(const bf16* p, int lane, f32x4 (&v)[4]) {
#pragma unroll
    for (int j = 0; j < 4; ++j) { const u32x2 r = *(const u32x2*)(p + 4 * lane + 256 * j); v[j] = (f32x4){bf_lo(r.x), bf_hi(r.x), bf_lo(r.y), bf_hi(r.y)}; }
}
__device__ __forceinline__ void row_store(float* p, int lane, const f32x4 (&v)[4]) {
#pragma unroll
    for (int j = 0; j < 4; ++j) *(f32x4*)(p + 4 * lane + 256 * j) = v[j];
}
__device__ __forceinline__ void row_store_bf16(bf16* p, int lane, const f32x4 (&v)[4]) {
#pragma unroll
    for (int j = 0; j < 4; ++j) { u32x2 w; w.x = pk2(v[j][0], v[j][1]); w.y = pk2(v[j][2], v[j][3]); *(u32x2*)(p + 4 * lane + 256 * j) = w; }
}
__device__ __forceinline__ void row_store_i8(signed char* p, float* scl, int lane, const f32x4 (&v)[4]) {
    float am = 0.f;
#pragma unroll
    for (int j = 0; j < 4; ++j) am = fmaxf(am, fmaxf(fmaxf(fabsf(v[j][0]), fabsf(v[j][1])), fmaxf(fabsf(v[j][2]), fabsf(v[j][3]))));
    am = fmaxf(wave_max(am), 1e-20f); const float inv = 127.0f / am;
    if (lane == 0) *scl = am * (1.0f / 127.0f);
#pragma unroll
    for (int j = 0; j < 4; ++j) *(unsigned*)(p + 4 * lane + 256 * j) = pack_i8x4(v[j], inv);
}
__device__ __forceinline__ void row_combine(f32x4 (&v)[4], const bf16* ys, const int* tokp, int row, const float* gac, int lane) {
    const int p0 = tokp[2 * row], p1 = tokp[2 * row + 1];
    const bf16* y0 = ys + (size_t)p0 * D; const bf16* y1 = ys + (size_t)p1 * D;
#pragma unroll
    for (int j = 0; j < 4; ++j) { const u32x2 a = *(const u32x2*)(y0 + 4 * lane + 256 * j), b = *(const u32x2*)(y1 + 4 * lane + 256 * j); const f32x4 g = *(const f32x4*)(gac + 4 * lane + 256 * j);
        v[j][0] += g[0] * (bf_lo(a.x) + bf_lo(b.x)); v[j][1] += g[1] * (bf_hi(a.x) + bf_hi(b.x)); v[j][2] += g[2] * (bf_lo(a.y) + bf_lo(b.y)); v[j][3] += g[3] * (bf_hi(a.y) + bf_hi(b.y)); }
}
__device__ __forceinline__ void row_norm_mod(const f32x4 (&x)[4], const float* gain, const float* sc, const float* sh, int lane, f32x4 (&h)[4]) {
    float s = 0.f;
#pragma unroll
    for (int j = 0; j < 4; ++j) s += (x[j][0] * x[j][0] + x[j][1] * x[j][1]) + (x[j][2] * x[j][2] + x[j][3] * x[j][3]);
    const float rstd = rsqrtf(wave_sum(s, lane) * (1.0f / D) + RMS_EPS);
#pragma unroll
    for (int j = 0; j < 4; ++j) { const f32x4 g = *(const f32x4*)(gain + 4 * lane + 256 * j), c = *(const f32x4*)(sc + 4 * lane + 256 * j), b = *(const f32x4*)(sh + 4 * lane + 256 * j);
        h[j] = x[j] * rstd * g * (1.0f + c) + b; }
}
__device__ __forceinline__ void transpose_item(const float* W, int ldw, bf16* dst, int ldd, LAS float* scr, int lane) {
    { const int r8 = lane >> 3, c4 = (lane & 7) * 4;
      f32x4 v[8];
#pragma unroll
      for (int i = 0; i < 8; ++i) v[i] = *(const f32x4*)(W + (size_t)(8 * i + r8) * ldw + c4);
#pragma unroll
      for (int i = 0; i < 8; ++i) { LAS float* p = scr + (8 * i + r8) * 33 + c4; p[0] = v[i][0]; p[1] = v[i][1]; p[2] = v[i][2]; p[3] = v[i][3]; } }
    LDS_WAIT(); asm volatile("" ::: "memory");
    const int c = lane & 7;
#pragma unroll
    for (int j = 0; j < 4; ++j) { const int n = (lane >> 3) + 8 * j; const LAS float* s = scr + (8 * c) * 33 + n;
        u32x4 o; o.x = pk2(s[0 * 33], s[1 * 33]); o.y = pk2(s[2 * 33], s[3 * 33]); o.z = pk2(s[4 * 33], s[5 * 33]); o.w = pk2(s[6 * 33], s[7 * 33]);
        *(u32x4*)(dst + (size_t)n * ldd + 8 * c) = o; }
    LDS_WAIT(); asm volatile("" ::: "memory");
}

__device__ __forceinline__ void phase_prologue(Frame& F) {
    const float* c = F.in[I_C]; const float* adaw = F.in[I_ADAW]; const float* adab = F.in[I_ADAB];
    float* mod = (float*)(F.ws + WS_MOD);
    LAS float* sc = (LAS float*)F.lds;
    LAS float* part = (LAS float*)(F.lds + 32768);
    for (int i = F.tid; i < NB * D; i += NTHREADS) { const float v = c[i]; sc[i] = v / (1.0f + __expf(-v)); }
    __syncthreads();
    for (int u = blockIdx.x; u < DEPTH * 96; u += F.G) {
        const int l = u / 96, n0 = (u % 96) * 64, col = n0 + F.lane;
        const float* W = adaw + (size_t)l * D * 6144 + col;
        float acc[8];
#pragma unroll
        for (int b = 0; b < 8; ++b) acc[b] = 0.f;
        const int kbeg = F.wave * 128;
#pragma unroll 8
        for (int k = kbeg; k < kbeg + 128; ++k) { const float w = W[(size_t)k * 6144];
#pragma unroll
            for (int b = 0; b < 8; ++b) acc[b] += sc[b * D + k] * w; }
#pragma unroll
        for (int b = 0; b < 8; ++b) part[(F.wave * 8 + b) * 64 + F.lane] = acc[b];
        __syncthreads();
        { const int b = F.tid >> 6; float s = adab[l * 6144 + col];
#pragma unroll
          for (int w = 0; w < 8; ++w) s += part[(w * 8 + b) * 64 + F.lane];
          mod[(size_t)(l * 8 + b) * 6144 + col] = s; }
        __syncthreads();
    }
    LAS float* scr = (LAS float*)(F.lds + 49152 + F.wave * 8704);
    constexpr int I_SQ = 16 * 32;
    constexpr int I_QKV = 16 * 288;
    constexpr int PER_RW = 4 * I_SQ, PER_AT = I_QKV + I_SQ, NIT = 2 * PER_RW + 2 * PER_AT;
    for (int it = F.gw; it < NIT; it += F.NGW) {
        int r = it;
        if (r < 2 * PER_RW) { const int j = r / PER_RW; r %= PER_RW; const int mi = r / I_SQ; r %= I_SQ; const int kb = r / 32, nb = r % 32;
            if (mi < 3) { }
            else transpose_item(F.in[I_RWO] + ((size_t)j * D + kb * 64) * D + nb * 32, D, (bf16*)(F.ws + WS_W + j * W_RW_STRIDE + W_RWO) + (size_t)(nb * 32) * D + kb * 64, D, scr, F.lane);
        } else { r -= 2 * PER_RW; const int j = r / PER_AT; r %= PER_AT;
            if (r < I_QKV) { }
            else { r -= I_QKV; const int kb = r / 32, nb = r % 32;
                transpose_item(F.in[I_AWO] + ((size_t)j * D + kb * 64) * D + nb * 32, D, (bf16*)(F.ws + WS_WA + j * W_AT_STRIDE + W_AWO) + (size_t)(nb * 32) * D + kb * 64, D, scr, F.lane); }
        }
    }
    {
        LAS float* pm = (LAS float*)(F.lds + 118784); LAS float* invs = (LAS float*)(F.lds + 120832);
        for (int u = blockIdx.x; u < 2 * 144 + 2 * 48; u += F.G) {
            const float* W; int ldw; signed char* Bq; float* SBq; int n0;
            if (u < 2 * 144) { const int j = u / 144; n0 = (u % 144) * 64; W = F.in[I_AQKV] + (size_t)j * D * QKVW + n0; ldw = QKVW;
                Bq = (signed char*)(F.ws + WS_WA + j * W_AT_STRIDE + W_QKV); SBq = (float*)(F.ws + WS_WA + j * W_AT_STRIDE + W_QKVS); }
            else { const int r = u - 2 * 144, j = r / 48, mi = (r % 48) / 16; n0 = mi * D + (r % 16) * 64; W = F.in[I_WRKV] + (size_t)(j * 3 + mi) * D * D + (r % 16) * 64; ldw = D;
                Bq = (signed char*)(F.ws + WS_W + j * W_RW_STRIDE + W_RKV); SBq = (float*)(F.ws + WS_W + j * W_RW_STRIDE + W_RKVS); }
            float m = 0.f;
#pragma unroll 16
            for (int k = F.wave * 128; k < F.wave * 128 + 128; ++k) m = fmaxf(m, fabsf(W[(size_t)k * ldw + F.lane]));
            pm[F.wave * 64 + F.lane] = m;
            __syncthreads();
            if (F.tid < 64) { float a = pm[F.tid];
#pragma unroll
                for (int w = 1; w < 8; ++w) a = fmaxf(a, pm[w * 64 + F.tid]);
                a = fmaxf(a, 1e-20f); invs[F.tid] = 127.0f / a; SBq[n0 + F.tid] = a * (1.0f / 127.0f); }
            __syncthreads();
            for (int tile = F.wave; tile < 32; tile += NWAVES) { const int kb = tile >> 1, nh = tile & 1;
                const float* src = W + (size_t)(kb * 64) * ldw + nh * 32;
                { const int r8 = F.lane >> 3, c4 = (F.lane & 7) * 4; f32x4 v[8];
#pragma unroll
                  for (int i = 0; i < 8; ++i) v[i] = *(const f32x4*)(src + (size_t)(8 * i + r8) * ldw + c4);
#pragma unroll
                  for (int i = 0; i < 8; ++i) { LAS float* p = scr + (8 * i + r8) * 33 + c4; p[0] = v[i][0]; p[1] = v[i][1]; p[2] = v[i][2]; p[3] = v[i][3]; } }
                LDS_WAIT(); asm volatile("" ::: "memory");
                const int c = F.lane & 7;
#pragma unroll
                for (int jj = 0; jj < 4; ++jj) { const int n = (F.lane >> 3) + 8 * jj; const LAS float* sp = scr + (8 * c) * 33 + n; const float inv = invs[nh * 32 + n];
                    u32x2 o; o.x = pack_i8x4((f32x4){sp[0 * 33], sp[1 * 33], sp[2 * 33], sp[3 * 33]}, inv); o.y = pack_i8x4((f32x4){sp[4 * 33], sp[5 * 33], sp[6 * 33], sp[7 * 33]}, inv);
                    *(u32x2*)(Bq + (size_t)(n0 + nh * 32 + n) * D + kb * 64 + 8 * c) = o; }
                LDS_WAIT(); asm volatile("" ::: "memory");
            }
            __syncthreads();
        }
    }
    const int gt = blockIdx.x * NTHREADS + F.tid, NGT = F.G * NTHREADS;
    for (int j = 0; j < 2; ++j) {
        bf16* ldn = (bf16*)(F.ws + WS_W + j * W_RW_STRIDE + W_LDN);
        const float* mu = F.in[I_MU] + (size_t)j * 6 * D;
        for (int i = gt; i < 512 * 2048; i += NGT) { const int n = i >> 11, k = i & 2047, kk = k & 1023;
            float v; int mi;
            if (n < 256) { const int blk = n >> 6, z = blk >> 1, isA = blk & 1, nn = n & 63;
                v = (isA ? F.in[I_A1] : F.in[I_W1])[((size_t)(j * 2 + z) * D + kk) * 64 + nn]; mi = isA ? 4 : 3; }
            else { const int z = (n - 256) >> 7, nn = n & 127; v = F.in[I_G1][((size_t)(j * 2 + z) * D + kk) * 128 + nn]; mi = 5; }
            if (k >= 1024) v *= mu[mi * D + kk];
            ldn[i] = (bf16)f2bf(v); }
        bf16* lwa = (bf16*)(F.ws + WS_W + j * W_RW_STRIDE + W_LUPWA);
        for (int i = gt; i < 4096 * 128; i += NGT) { const int n = i >> 7, k = i & 127; const int z = n >> 11, isA = (n >> 10) & 1, col = n & 1023;
            float v = 0.f;
            if ((k >> 6) == isA) v = (isA ? F.in[I_A2] : F.in[I_W2])[((size_t)(j * 2 + z) * 64 + (k & 63)) * D + col];
            lwa[i] = (bf16)f2bf(v); }
        bf16* lg = (bf16*)(F.ws + WS_W + j * W_RW_STRIDE + W_LUPG);
        for (int i = gt; i < 2048 * 128; i += NGT) { const int n = i >> 7, k = i & 127; const int z = n >> 10, col = n & 1023;
            lg[i] = (bf16)f2bf(F.in[I_G2][((size_t)(j * 2 + z) * 128 + k) * D + col]); }
    }
}

__device__ __forceinline__ void rw_hrow(Frame& F, int l, bool combine, const void* xsrc, bf16* xdst, bool own, int row, f32x4 (&h)[4]) {
    const int b = row >> 11; const float* mod = (const float*)(F.ws + WS_MOD);
    f32x4 x[4]; if (l == 0) row_load((const float*)xsrc + (size_t)row * D, F.lane, x); else row_load_bf16((const bf16*)xsrc + (size_t)row * D, F.lane, x);
    if (combine) { row_combine(x, (const bf16*)(F.ws + WS_ACT + A_YS), (const int*)(F.ws + WS_TOKP), row, mod + (size_t)((l - 1) * 8 + b) * 6144 + 5 * D, F.lane);
        if (own) row_store_bf16(xdst + (size_t)row * D, F.lane, x); }
    const float* mp = mod + (size_t)(l * 8 + b) * 6144;
    row_norm_mod(x, F.in[I_NTM] + l * D, mp + 1 * D, mp + 0 * D, F.lane, h);
}
__device__ __forceinline__ void phase_rw_norm(Frame& F, int l, bool combine, const void* xsrc, bf16* xdst) {
    const int j = l >> 1; const float* mu = F.in[I_MU] + (size_t)j * 6 * D;
    signed char* xs = (signed char*)(F.ws + WS_ACT + A_XS); bf16* hx = (bf16*)(F.ws + WS_ACT + A_HX); float* sxs = (float*)(F.ws + WS_SCL + SCL_XS);
    for (int ch = F.gw; ch < T / 8; ch += F.NGW) {
        const int row0 = ch * 8, t0 = row0 & (SEQ - 1);
        f32x4 prev[4], cur[4], nxt[4];
        if (t0 > 0) rw_hrow(F, l, combine, xsrc, xdst, false, row0 - 1, prev);
        else {
#pragma unroll
            for (int q = 0; q < 4; ++q) prev[q] = (f32x4){0.f, 0.f, 0.f, 0.f}; }
        rw_hrow(F, l, combine, xsrc, xdst, true, row0, cur);
        for (int i = 0; i < 8; ++i) {
            const int row = row0 + i;
            if (t0 + i + 1 < SEQ) rw_hrow(F, l, combine, xsrc, xdst, i < 7, row + 1, nxt);
            else {
#pragma unroll
                for (int q = 0; q < 4; ++q) nxt[q] = (f32x4){0.f, 0.f, 0.f, 0.f}; }
            f32x4 xx[4];
#pragma unroll
            for (int q = 0; q < 4; ++q) xx[q] = 0.5f * (prev[q] + nxt[q]) - cur[q];
#pragma unroll
            for (int mi = 0; mi < 3; ++mi) { f32x4 o[4];
#pragma unroll
                for (int q = 0; q < 4; ++q) { const f32x4 m = *(const f32x4*)(mu + mi * D + 4 * F.lane + 256 * q); o[q] = cur[q] + xx[q] * m; }
                row_store_i8(xs + ((size_t)mi * T + row) * D, sxs + (size_t)mi * T + row, F.lane, o); }
            row_store_bf16(hx + (size_t)row * 2048, F.lane, cur);
            row_store_bf16(hx + (size_t)row * 2048 + D, F.lane, xx);
#pragma unroll
            for (int q = 0; q < 4; ++q) { prev[q] = cur[q]; cur[q] = nxt[q]; }
        }
    }
}

__device__ __forceinline__ void phase_at_norm(Frame& F, int l, const bf16* xsrc, bf16* xdst) {
    const float* mod = (const float*)(F.ws + WS_MOD); signed char* H8 = (signed char*)(F.ws + WS_ACT + A_H); float* SA = (float*)(F.ws + WS_SA);
    for (int row = F.gw; row < T; row += F.NGW) {
        const int b = row >> 11; f32x4 x[4], h[4]; row_load_bf16(xsrc + (size_t)row * D, F.lane, x);
        row_combine(x, (const bf16*)(F.ws + WS_ACT + A_YS), (const int*)(F.ws + WS_TOKP), row, mod + (size_t)((l - 1) * 8 + b) * 6144 + 5 * D, F.lane);
        row_store_bf16(xdst + (size_t)row * D, F.lane, x);
        const float* mp = mod + (size_t)(l * 8 + b) * 6144;
        row_norm_mod(x, F.in[I_NTM] + l * D, mp + 1 * D, mp + 0 * D, F.lane, h);
        float am = 0.f;
#pragma unroll
        for (int j = 0; j < 4; ++j) am = fmaxf(am, fmaxf(fmaxf(fabsf(h[j][0]), fabsf(h[j][1])), fmaxf(fabsf(h[j][2]), fabsf(h[j][3]))));
        am = fmaxf(wave_max(am), 1e-20f); const float inv = 127.0f / am;
        if (F.lane == 0) SA[row] = am * (1.0f / 127.0f);
#pragma unroll
        for (int j = 0; j < 4; ++j) *(unsigned*)(H8 + (size_t)row * D + 4 * F.lane + 256 * j) = pack_i8x4(h[j], inv);
    }
}
__device__ __forceinline__ void phase_final(Frame& F, const bf16* xsrc) {
    const float* mod = (const float*)(F.ws + WS_MOD); const float* fg = F.in[I_FG];
    for (int row = F.gw; row < T; row += F.NGW) {
        const int b = row >> 11; f32x4 x[4]; row_load_bf16(xsrc + (size_t)row * D, F.lane, x);
        row_combine(x, (const bf16*)(F.ws + WS_ACT + A_YS), (const int*)(F.ws + WS_TOKP), row, mod + (size_t)(3 * 8 + b) * 6144 + 5 * D, F.lane);
        float s = 0.f;
#pragma unroll
        for (int j = 0; j < 4; ++j) s += (x[j][0] * x[j][0] + x[j][1] * x[j][1]) + (x[j][2] * x[j][2] + x[j][3] * x[j][3]);
        const float rstd = rsqrtf(wave_sum(s, F.lane) * (1.0f / D) + RMS_EPS);
#pragma unroll
        for (int j = 0; j < 4; ++j) { const f32x4 g = *(const f32x4*)(fg + 4 * F.lane + 256 * j); x[j] = x[j] * rstd * g; }
        row_store(F.out + (size_t)row * D, F.lane, x);
    }
}

__device__ __forceinline__ void phase_moe_route(Frame& F, int l, const bf16* xsrc, int cnt_shift = 0) {
    const float* mod = (const float*)(F.ws + WS_MOD); bf16* HN = (bf16*)(F.ws + WS_ACT + A_HN2);
    LAS int* lcnt = (LAS int*)F.lds; LAS int* gbase = lcnt + 32; LAS int* inf_e = lcnt + 64; LAS int* inf_r = inf_e + 128; LAS float* inf_w = (LAS float*)(inf_r + 128);
    unsigned* cnt = (unsigned*)(F.ws + WS_CTL) + CW_CNT + (l + cnt_shift) * 32;
    int* toke = (int*)(F.ws + WS_TOKE); int* tokr = (int*)(F.ws + WS_TOKR); float* tokw = (float*)(F.ws + WS_TOKW);
    { int* rowt = (int*)(F.ws + WS_ROWT); for (int i = blockIdx.x * NTHREADS + F.tid; i < MAXROWS; i += F.G * NTHREADS) rowt[i] = 0; }
    const float* rg = F.in[I_RG] + (size_t)l * D * 4; const float* rgb = F.in[I_RGB] + l * 4;
    LAS float* RW = (LAS float*)(F.lds + 4096);
    for (int i = F.tid; i < D * 4; i += NTHREADS) RW[(i & 3) * D + (i >> 2)] = rg[i];
    { const float* rea = F.in[I_RE] + (size_t)l * 4 * D * 8;
      for (int i = F.tid; i < 4 * D * 8; i += NTHREADS) RW[(4 + (i >> 13) * 8 + (i & 7)) * D + ((i >> 3) & 1023)] = rea[i]; }
    for (int cb = blockIdx.x; cb < T / 64; cb += F.G) {
        if (F.tid < 32) lcnt[F.tid] = 0;
        __syncthreads();
        for (int i = 0; i < 8; ++i) {
            const int lr = F.wave * 8 + i, row = cb * 64 + lr, b = row >> 11;
            f32x4 x[4], h[4]; row_load_bf16(xsrc + (size_t)row * D, F.lane, x);
            const float* mp = mod + (size_t)(l * 8 + b) * 6144;
            row_norm_mod(x, F.in[I_NCM] + l * D, mp + 4 * D, mp + 3 * D, F.lane, h);
            row_store_i8((signed char*)HN + (size_t)row * D, (float*)(F.ws + WS_SCL + SCL_HN) + row, F.lane, h);
            float gl[4] = {0.f, 0.f, 0.f, 0.f};
#pragma unroll
            for (int e = 0; e < 4; ++e)
#pragma unroll
                for (int j = 0; j < 4; ++j) { const f32x4 w = *(const LAS f32x4*)(RW + e * D + 4 * F.lane + 256 * j); gl[e] += (h[j][0] * w[0] + h[j][1] * w[1]) + (h[j][2] * w[2] + h[j][3] * w[3]); }
#pragma unroll
            for (int e = 0; e < 4; ++e) gl[e] = wave_sum(gl[e], F.lane) + rgb[e];
            const float gm = fmaxf(fmaxf(gl[0], gl[1]), fmaxf(gl[2], gl[3]));
            const int gtop = (gl[0] == gm) ? 0 : (gl[1] == gm) ? 1 : (gl[2] == gm) ? 2 : 3;
            const float pg = 1.0f / (__expf(gl[0] - gm) + __expf(gl[1] - gm) + __expf(gl[2] - gm) + __expf(gl[3] - gm));
            const float* reb = F.in[I_REB] + (l * 4 + gtop) * 8; const LAS float* rwe = RW + (4 + gtop * 8) * D + 4 * F.lane;
            float el[8];
#pragma unroll
            for (int e = 0; e < 8; ++e) { el[e] = 0.f;
#pragma unroll
                for (int j = 0; j < 4; ++j) { const f32x4 w = *(const LAS f32x4*)(rwe + e * D + 256 * j); el[e] += (h[j][0] * w[0] + h[j][1] * w[1]) + (h[j][2] * w[2] + h[j][3] * w[3]); } }
#pragma unroll
            for (int e = 0; e < 8; ++e) el[e] = wave_sum(el[e], F.lane) + reb[e];
            float v0 = el[0]; int i0 = 0;
#pragma unroll
            for (int e = 1; e < 8; ++e) if (el[e] > v0) { v0 = el[e]; i0 = e; }
            float v1 = -3.0e38f; int i1 = 0;
#pragma unroll
            for (int e = 0; e < 8; ++e) if (e != i0 && el[e] > v1) { v1 = el[e]; i1 = e; }
            const float ex = __expf(v1 - v0); const float w0 = pg / (1.0f + ex), w1 = pg * ex / (1.0f + ex);
            if (F.lane == 0) {
                const int e0 = gtop * 8 + i0, e1 = gtop * 8 + i1;
                const int r0 = __hip_atomic_fetch_add(lcnt + e0, 1, __ATOMIC_RELAXED, __HIP_MEMORY_SCOPE_WORKGROUP);
                const int r1 = __hip_atomic_fetch_add(lcnt + e1, 1, __ATOMIC_RELAXED, __HIP_MEMORY_SCOPE_WORKGROUP);
                inf_e[lr * 2] = e0; inf_e[lr * 2 + 1] = e1; inf_r[lr * 2] = r0; inf_r[lr * 2 + 1] = r1; inf_w[lr * 2] = w0; inf_w[lr * 2 + 1] = w1;
            }
        }
        __syncthreads();
        if (F.tid < 32) gbase[F.tid] = (int)__hip_atomic_fetch_add(cnt + F.tid, (unsigned)lcnt[F.tid], __ATOMIC_RELAXED, __HIP_MEMORY_SCOPE_AGENT);
        __syncthreads();
        if (F.tid < 128) { const int idx = cb * 128 + F.tid; const int e = inf_e[F.tid]; toke[idx] = e; tokr[idx] = gbase[e] + inf_r[F.tid]; tokw[idx] = inf_w[F.tid]; }
        __syncthreads();
    }
}
__device__ __forceinline__ void moe_tables(Frame& F, int l) {
    LAS int* tileE = (LAS int*)(F.lds + TILEE_OFF); LAS int* offs = (LAS int*)(F.lds + OFFS_OFF);
    const unsigned* cnt = (const unsigned*)(F.ws + WS_CTL) + CW_CNT + l * 32;
    if (F.tid == 0) { int o = 0, nt = 0;
#pragma clang loop unroll(disable)
        for (int e = 0; e < 32; ++e) { const int c = (int)__hip_atomic_load(cnt + e, __ATOMIC_RELAXED, __HIP_MEMORY_SCOPE_AGENT); offs[e] = o; const int ne = (c + 255) >> 8;
#pragma clang loop unroll(disable)
            for (int k = 0; k < ne && nt < 160; ++k) tileE[nt++] = e;
            o += ne * 256; }
        tileE[160] = nt; offs[32] = o; }
    __syncthreads();
}
__device__ __forceinline__ void moe_convert(Frame& F, int l, int bfirst, int bstride) {
    LAS float* scr = (LAS float*)(F.lds + 49152 + F.wave * 8704); LAS float* pm = (LAS float*)(F.lds + 118784);
    signed char* WGU = (signed char*)(F.ws + ws_wm_of(l) + W_GU); float* SGU = (float*)(F.ws + ws_wm_of(l) + W_GUS); bf16* WDN = (bf16*)(F.ws + ws_wm_of(l) + W_DN);
    const int r8 = F.lane >> 3, c4 = (F.lane & 7) * 4;
    for (int it = bfirst; it < NEXP * 16; it += bstride) {
        const int e = it >> 4, up = (it >> 3) & 1, nb = it & 7, n0 = nb * 32;
        const float* src = (up ? F.in[I_WU] : F.in[I_WG]) + (size_t)(l * 32 + e) * D * FEXP + n0;
        const int drow = (n0 >> 7) * 256 + up * 128 + (n0 & 127);
        f32x4 v[16]; f32x4 mx = {0.f, 0.f, 0.f, 0.f};
#pragma unroll
        for (int i = 0; i < 16; ++i) { v[i] = *(const f32x4*)(src + (size_t)(F.wave * 128 + 8 * i + r8) * FEXP + c4);
            mx[0] = fmaxf(mx[0], fabsf(v[i][0])); mx[1] = fmaxf(mx[1], fabsf(v[i][1])); mx[2] = fmaxf(mx[2], fabsf(v[i][2])); mx[3] = fmaxf(mx[3], fabsf(v[i][3])); }
#pragma unroll
        for (int q = 0; q < 4; ++q) { float a = mx[q]; a = fmaxf(a, dpp_ror(a, 8)); a = bfly16_max(a); a = bfly32_max(a); mx[q] = a; }
        if (r8 == 0) *(LAS f32x4*)(pm + F.wave * 32 + c4) = mx;
        __syncthreads();
        f32x4 cm = *(const LAS f32x4*)(pm + c4);
#pragma unroll
        for (int w = 1; w < 8; ++w) { const f32x4 o = *(const LAS f32x4*)(pm + w * 32 + c4); cm[0] = fmaxf(cm[0], o[0]); cm[1] = fmaxf(cm[1], o[1]); cm[2] = fmaxf(cm[2], o[2]); cm[3] = fmaxf(cm[3], o[3]); }
#pragma unroll
        for (int q = 0; q < 4; ++q) cm[q] = fmaxf(cm[q], 1e-20f);
        if (F.wave == 0 && r8 == 0) *(f32x4*)(SGU + (size_t)e * 512 + drow + c4) = cm * (1.0f / 127.0f);
#pragma unroll
        for (int kh = 0; kh < 2; ++kh) {
#pragma unroll
            for (int i = 0; i < 8; ++i) { LAS float* p = scr + (8 * i + r8) * 33 + c4; const f32x4 x = v[8 * kh + i]; p[0] = x[0] * (127.0f / cm[0]); p[1] = x[1] * (127.0f / cm[1]); p[2] = x[2] * (127.0f / cm[2]); p[3] = x[3] * (127.0f / cm[3]); }
            LDS_WAIT(); asm volatile("" ::: "memory");
            const int c = F.lane & 7;
#pragma unroll
            for (int jj = 0; jj < 4; ++jj) { const int n = (F.lane >> 3) + 8 * jj; const LAS float* sp = scr + (8 * c) * 33 + n;
                u32x2 o; o.x = pack_i8x4((f32x4){sp[0 * 33], sp[1 * 33], sp[2 * 33], sp[3 * 33]}, 1.0f); o.y = pack_i8x4((f32x4){sp[4 * 33], sp[5 * 33], sp[6 * 33], sp[7 * 33]}, 1.0f);
                *(u32x2*)(WGU + ((size_t)e * 512 + drow + n) * D + (F.wave * 2 + kh) * 64 + 8 * c) = o; }
            LDS_WAIT(); asm volatile("" ::: "memory");
        }
        __syncthreads();
    }
    for (int it = bfirst * NWAVES + F.wave; it < NEXP * 128; it += bstride * NWAVES) {
        const int e = it >> 7, r = it & 127; const int kb = r / 32, nb = r % 32;
        const float* src = F.in[I_WD] + ((size_t)(l * 32 + e) * FEXP + kb * 64) * D + nb * 32;
        transpose_item(src, D, WDN + ((size_t)e * D + nb * 32) * FEXP + kb * 64, FEXP, scr, F.lane);
    }
}
__device__ __forceinline__ void phase_moe_gather(Frame& F, int l) {
    moe_tables(F, l);
    const LAS int* offs = (const LAS int*)(F.lds + OFFS_OFF);
    if (blockIdx.x == 0 && F.tid < 161) ((int*)(F.ws + WS_TILEE))[F.tid] = ((const LAS int*)(F.lds + TILEE_OFF))[F.tid];
    const int* toke = (const int*)(F.ws + WS_TOKE); const int* tokr = (const int*)(F.ws + WS_TOKR); const float* tokw = (const float*)(F.ws + WS_TOKW);
    int* tokp = (int*)(F.ws + WS_TOKP); float* roww = (float*)(F.ws + WS_ROWW);
    int* rowt = (int*)(F.ws + WS_ROWT);
    for (int idx = blockIdx.x * NTHREADS + F.tid; idx < 2 * T; idx += F.G * NTHREADS) {
        const int e = toke[idx]; const int pos = offs[e] + tokr[idx];
        tokp[idx] = pos; roww[pos] = tokw[idx]; rowt[pos] = idx >> 1;
    }
    if (l == 0) moe_convert(F, 0, (int)blockIdx.x, F.G);
}

#ifndef SCAN_DUP
#define SCAN_DUP 0
#endif
namespace wk {
constexpr int P = 72, PB = 144, MAT = 64 * PB;
constexpr int PF = 68;
constexpr int O_NAB = 0, O_GS = 17408, O_GC = 19456, O_M0 = 20480;
constexpr int O_AT = O_M0, O_RT = O_AT + MAT, O_BT = O_RT + MAT, O_KT = O_BT + MAT, O_VV = O_KT + MAT, O_LAK = O_VV + MAT, O_MRB = O_LAK + MAT, O_MRK = O_MRB + MAT,
              O_NB = O_MRK + MAT, O_TT = O_NB + MAT, O_XT = O_TT + MAT, O_UT = O_XT + MAT, O_MT = O_UT + MAT, O_H0 = O_MT + MAT, O_H1 = O_H0 + MAT, O_END = O_H1 + MAT;
static_assert(O_END <= LDS_MISC, "scan LDS map");
typedef union { u32x4 u; bf16x8 v; } frag_t;
__device__ __forceinline__ bf16x8 zfrag() { frag_t z; z.u = (u32x4){0u, 0u, 0u, 0u}; return z.v; }
__device__ __forceinline__ bf16x8 ldrow(const LAS unsigned char* M, int row, int col) { return *(const LAS bf16x8*)(M + row * PB + col * 2); }
__device__ __forceinline__ bf16x8 ldtr(unsigned base, int r0, int c0, int lane) {
    const int g = lane >> 4, i = lane & 15, qq = i >> 2, p = i & 3;
    const unsigned a0 = base + (unsigned)((r0 + 8 * g + qq) * PB + (c0 + 4 * p) * 2), a1 = a0 + 4u * PB;
    u32x2 lo, hi;
    asm volatile("ds_read_b64_tr_b16 %0, %2\n\tds_read_b64_tr_b16 %1, %3\n\ts_waitcnt lgkmcnt(0)" : "=&v"(lo), "=&v"(hi) : "v"(a0), "v"(a1) : "memory");
    frag_t f; f.u.x = lo.x; f.u.y = lo.y; f.u.z = hi.x; f.u.w = hi.y; return f.v;
}
__device__ __forceinline__ void st4bf(LAS unsigned char* M, int row, int col, const f32x4& v) { u32x2 w; w.x = pk2(v[0], v[1]); w.y = pk2(v[2], v[3]); *(LAS u32x2*)(M + row * PB + col * 2) = w; }
#define WK_MFMA(a, b, c) __builtin_amdgcn_mfma_f32_16x16x32_bf16(a, b, c, 0, 0, 0)
template <int M> __device__ __forceinline__ float rshare(float v) { return __int_as_float(__builtin_amdgcn_update_dpp(0, __float_as_int(v), 0x150 + M, 0xf, 0xf, false)); }
#define WK_BAR() do { asm volatile("s_waitcnt lgkmcnt(0)" ::: "memory"); __builtin_amdgcn_s_barrier(); asm volatile("" ::: "memory"); } while (0)
}

__device__ __forceinline__ void phase_scan(Frame& F, int l) {
    using namespace wk;
    const int j = l >> 1;
    const bf16* Rb = (const bf16*)(F.ws + WS_ACT + A_RKV); const bf16* Kb = Rb + (size_t)T * D; const bf16* Vb = Kb + (size_t)T * D;
    const bf16* LD = (const bf16*)(F.ws + WS_ACT + A_LDEC); const bf16* AS = (const bf16*)(F.ws + WS_ACT + A_ASIG);
    bf16* Y = (bf16*)(F.ws + WS_ACT + A_Y); float* SB = (float*)(F.ws + WS_SB);
    LAS unsigned char* L = F.lds; const unsigned La = (unsigned)(size_t)L;
    LAS float* NAB = (LAS float*)(L + O_NAB); LAS float* GS = (LAS float*)(L + O_GS); LAS float* GC = (LAS float*)(L + O_GC);
    const int tid0 = F.tid, wave = F.wave;
    for (int unit = blockIdx.x; unit < NB * NH_R * 2; unit += F.G) {
        const int b = unit >> 5, h = (unit >> 1) & 15, dir = unit & 1; const int col = h * 64 + 8 * (tid0 & 7);
        f32x4 kkc[2], kac[2], rkc[2];
#pragma unroll
        for (int e = 0; e < 2; ++e) { kkc[e] = *(const f32x4*)(F.in[I_KK] + j * D + col + 4 * e); kac[e] = *(const f32x4*)(F.in[I_KA] + j * D + col + 4 * e); rkc[e] = *(const f32x4*)(F.in[I_RK] + j * D + col + 4 * e); }
        for (int i = tid0; i < (O_END - O_LAK) / 16; i += NTHREADS) *(LAS u32x4*)(L + O_LAK + i * 16) = (u32x4){0u, 0u, 0u, 0u};
        f32x4 Hs[4];
        f32x4 Yh[4];
#define WK_YFLUSH(cc) do { if (wave >= 4) { const int lane_ = tid0 & 63, qi_ = lane_ & 15, q4_ = lane_ >> 4, vj_ = wave - 4; \
            _Pragma("unroll") for (int ti_ = 0; ti_ < 4; ++ti_) _Pragma("unroll") for (int r_ = 0; r_ < 4; ++r_) { const int st_ = (cc) * 64 + 16 * ti_ + 4 * q4_ + r_; const int t_ = dir ? (SEQ - 1 - st_) : st_; \
                Y[((size_t)dir * T + (size_t)b * SEQ + t_) * D + h * 64 + 16 * vj_ + qi_] = (bf16)f2bf(Yh[ti_][r_]); } } } while (0)
#pragma unroll
        for (int vj = 0; vj < 4; ++vj) Hs[vj] = (f32x4){0.f, 0.f, 0.f, 0.f};
        u32x4 gr, gk, gv, gl, ga;
#define WK_LOAD(c) do { const int st = (c) * 64 + (tid0 >> 3); const int t = dir ? (SEQ - 1 - st) : st; const size_t ro = ((size_t)b * SEQ + t) * D + col; \
            gr = *(const u32x4*)(Rb + ro); gk = *(const u32x4*)(Kb + ro); gv = *(const u32x4*)(Vb + ro); gl = *(const u32x4*)(LD + (size_t)dir * T * D + ro); ga = *(const u32x4*)(AS + (size_t)dir * T * D + ro); } while (0)
        WK_LOAD(0);
        WK_BAR();
        for (int c = 0; c < SEQ / 64; ++c) {
            int tid = tid0; asm volatile("" : "+v"(tid));
            const int lane = tid & 63, qi = lane & 15, q4 = lane >> 4, pt = tid >> 3, c8 = tid & 7;
            LAS unsigned char* H0 = L + ((c & 1) ? O_H1 : O_H0); LAS unsigned char* H1 = L + ((c & 1) ? O_H0 : O_H1);
            for (int sd0_ = 0; sd0_ < 1 + ((SCAN_DUP >> 0) & 1); ++sd0_) {
            float av[8], bv[8], kdv[8], rv[8], ldv[8];
            {
                const unsigned gku[4] = {gk.x, gk.y, gk.z, gk.w}, gru[4] = {gr.x, gr.y, gr.z, gr.w}, glu[4] = {gl.x, gl.y, gl.z, gl.w}, gau[4] = {ga.x, ga.y, ga.z, ga.w};
                float kf[8], af[8], kkv[8]; float ss = 0.f;
#pragma unroll
                for (int e = 0; e < 4; ++e) { kf[2 * e] = bf_lo(gku[e]); kf[2 * e + 1] = bf_hi(gku[e]); rv[2 * e] = bf_lo(gru[e]); rv[2 * e + 1] = bf_hi(gru[e]);
                    ldv[2 * e] = bf_lo(glu[e]); ldv[2 * e + 1] = bf_hi(glu[e]); af[2 * e] = bf_lo(gau[e]); af[2 * e + 1] = bf_hi(gau[e]); }
#pragma unroll
                for (int e = 0; e < 8; ++e) { kkv[e] = kf[e] * kkc[e >> 2][e & 3]; ss += kkv[e] * kkv[e]; }
                ss = sum8(ss);
                const float inv = 1.0f / fmaxf(sqrtf(ss), 1e-12f); float bo = 0.f;
#pragma unroll
                for (int e = 0; e < 8; ++e) { const float kn = kkv[e] * inv; kdv[e] = kf[e] * (1.0f + (af[e] - 1.0f) * kac[e >> 2][e & 3]); av[e] = -kn; bv[e] = kn * af[e]; bo += rv[e] * kdv[e] * rkc[e >> 2][e & 3]; }
                bo = sum8(bo);
                const int st = c * 64 + pt; const int t = dir ? (SEQ - 1 - st) : st;
                if (c8 == 0) SB[((size_t)dir * T + (size_t)b * SEQ + t) * 16 + h] = bo;
                *(LAS f32x4*)(NAB + pt * PF + 8 * c8) = (f32x4){ldv[0], ldv[1], ldv[2], ldv[3]}; *(LAS f32x4*)(NAB + pt * PF + 8 * c8 + 4) = (f32x4){ldv[4], ldv[5], ldv[6], ldv[7]};
                *(LAS u32x4*)(L + O_VV + pt * PB + 16 * c8) = gv;
            }
            if (sd0_ == ((SCAN_DUP >> 0) & 1)) { if (c > 0) WK_YFLUSH(c - 1); if (c + 1 < SEQ / 64) WK_LOAD(c + 1); }
            WK_BAR();
            { const int kc = tid & 63, g = tid >> 6; float pre[8]; float p = 0.f;
#pragma unroll
              for (int i = 0; i < 8; ++i) { p += NAB[(8 * g + i) * PF + kc]; pre[i] = p; }
              GS[g * 64 + kc] = p;
              WK_BAR();
              float off = 0.f;
#pragma unroll
              for (int gg = 0; gg < 7; ++gg) off += (gg < g) ? GS[gg * 64 + kc] : 0.f;
#pragma unroll
              for (int i = 0; i < 8; ++i) NAB[(8 * g + i) * PF + kc] = off + pre[i]; }
            WK_BAR();
            { f32x4 cl[2], cm[2];
#pragma unroll
              for (int e = 0; e < 2; ++e) { cl[e] = *(const LAS f32x4*)(NAB + pt * PF + 8 * c8 + 4 * e); cm[e] = (pt > 0) ? *(const LAS f32x4*)(NAB + (pt - 1) * PF + 8 * c8 + 4 * e) : (f32x4){0.f, 0.f, 0.f, 0.f}; }
              float oa[8], orr[8], ob[8], ok[8];
#pragma unroll
              for (int e = 0; e < 8; ++e) { const float c1 = cl[e >> 2][e & 3], c0 = cm[e >> 2][e & 3]; const float gp = __builtin_amdgcn_exp2f(c1), gn = __builtin_amdgcn_exp2f(-c1), g0 = __builtin_amdgcn_exp2f(c0);
                  oa[e] = av[e] * g0; orr[e] = rv[e] * gp; ob[e] = bv[e] * gn; ok[e] = kdv[e] * gn; if (pt == 63) GC[8 * c8 + e] = gp; }
              *(LAS u32x4*)(L + O_AT + pt * PB + 16 * c8) = (u32x4){pk2(oa[0], oa[1]), pk2(oa[2], oa[3]), pk2(oa[4], oa[5]), pk2(oa[6], oa[7])};
              *(LAS u32x4*)(L + O_RT + pt * PB + 16 * c8) = (u32x4){pk2(orr[0], orr[1]), pk2(orr[2], orr[3]), pk2(orr[4], orr[5]), pk2(orr[6], orr[7])};
              *(LAS u32x4*)(L + O_BT + pt * PB + 16 * c8) = (u32x4){pk2(ob[0], ob[1]), pk2(ob[2], ob[3]), pk2(ob[4], ob[5]), pk2(ob[6], ob[7])};
              *(LAS u32x4*)(L + O_KT + pt * PB + 16 * c8) = (u32x4){pk2(ok[0], ok[1]), pk2(ok[2], ok[3]), pk2(ok[4], ok[5]), pk2(ok[6], ok[7])}; }
            WK_BAR();
            }
            f32x4 X0[4], Y0[4];
            for (int sd1_ = 0; sd1_ < 1 + ((SCAN_DUP >> 1) & 1); ++sd1_) {
#pragma unroll
            for (int jj = 0; jj < 5; ++jj) {
                const int idx = wave * 5 + jj, blk = idx / 10, tri = idx % 10;
                const int ti = (tri >= 6) ? 3 : ((tri >= 3) ? 2 : ((tri >= 1) ? 1 : 0)); const int si = tri - (ti * (ti + 1)) / 2;
                const LAS unsigned char* Pm = L + ((blk < 2) ? O_AT : O_RT); const LAS unsigned char* Qm = L + ((blk & 1) ? O_KT : O_BT);
                f32x4 acc = {0.f, 0.f, 0.f, 0.f};
#pragma unroll
                for (int ks = 0; ks < 2; ++ks) acc = WK_MFMA(ldrow(Qm, 16 * si + qi, 32 * ks + 8 * q4), ldrow(Pm, 16 * ti + qi, 32 * ks + 8 * q4), acc);
                const int tt = 16 * ti + qi, s0 = 16 * si + 4 * q4;
#pragma unroll
                for (int r = 0; r < 4; ++r) { const int sidx = s0 + r; const bool keep = (blk < 2) ? (sidx < tt) : (sidx <= tt); acc[r] = keep ? acc[r] : 0.f; }
                if (blk == 0) { *(LAS f32x4*)(NAB + tt * PF + s0) = acc; st4bf(L + O_NB, tt, s0, acc); }
                else st4bf(L + (blk == 1 ? O_LAK : (blk == 2 ? O_MRB : O_MRK)), tt, s0, acc);
            }
            WK_BAR();
            }
            for (int sd2_ = 0; sd2_ < 1 + ((SCAN_DUP >> 2) & 1); ++sd2_) {
            if (wave >= 4) { const int vj = wave - 4;
#pragma unroll
                for (int ti = 0; ti < 4; ++ti) { X0[ti] = (f32x4){0.f, 0.f, 0.f, 0.f}; Y0[ti] = (f32x4){0.f, 0.f, 0.f, 0.f};
#pragma unroll
                    for (int ks = 0; ks < 2; ++ks) if (ks <= (ti >> 1)) { const bf16x8 vf = ldtr(La + O_VV, 32 * ks, 16 * vj, lane);
                        X0[ti] = WK_MFMA(ldrow(L + O_LAK, 16 * ti + qi, 32 * ks + 8 * q4), vf, X0[ti]); Y0[ti] = WK_MFMA(ldrow(L + O_MRK, 16 * ti + qi, 32 * ks + 8 * q4), vf, Y0[ti]); } } }
            if (wave == 0) {
                const int blk = q4, cj = qi; float nrow[16], x[16];
#pragma unroll
                for (int r = 0; r < 16; ++r) nrow[r] = NAB[(16 * blk + r) * PF + 16 * blk + cj];
#pragma unroll
                for (int r = 0; r < 16; ++r) { float acc = (r == cj) ? 1.0f : 0.0f;
#define WK_SUBM(m) if (m < r) acc += wk::rshare<m>(nrow[r]) * x[m];
                    WK_SUBM(0) WK_SUBM(1) WK_SUBM(2) WK_SUBM(3) WK_SUBM(4) WK_SUBM(5) WK_SUBM(6) WK_SUBM(7) WK_SUBM(8) WK_SUBM(9) WK_SUBM(10) WK_SUBM(11) WK_SUBM(12) WK_SUBM(13) WK_SUBM(14)
#undef WK_SUBM
                    x[r] = acc; *(LAS bf16*)(L + O_TT + (16 * blk + r) * PB + (16 * blk + cj) * 2) = (bf16)f2bf(acc); }
            }
            WK_BAR();
            if (wave < 2) {
                const int i = 2 * wave + 1, jb = 2 * wave;
                bf16x8 a = ldrow(L + O_NB, 16 * i + qi, 16 * jb + 8 * (q4 & 1)), bfr = ldtr(La + O_TT, 16 * jb - 8 * (q4 & 2), 16 * jb, lane);
                if (q4 >= 2) { a = zfrag(); bfr = zfrag(); }
                f32x4 acc = {0.f, 0.f, 0.f, 0.f}; acc = WK_MFMA(a, bfr, acc);
                st4bf(L + O_MT, 16 * wave + qi, 4 * q4, acc);
            }
            WK_BAR();
            if (wave < 2) {
                const int i = 2 * wave + 1, jb = 2 * wave;
                bf16x8 a = ldrow(L + O_TT, 16 * i + qi, 16 * i + 8 * (q4 & 1)), bfr = ldrow(L + O_MT, 16 * wave + qi, 8 * (q4 & 1));
                if (q4 >= 2) { a = zfrag(); bfr = zfrag(); }
                f32x4 acc = {0.f, 0.f, 0.f, 0.f}; acc = WK_MFMA(a, bfr, acc);
#pragma unroll
                for (int r = 0; r < 4; ++r) *(LAS bf16*)(L + O_TT + (16 * i + 4 * q4 + r) * PB + (16 * jb + qi) * 2) = (bf16)f2bf(acc[r]);
            }
            WK_BAR();
            if (wave < 4) {
                const int ti2 = wave >> 1, tj2 = wave & 1;
                f32x4 acc = {0.f, 0.f, 0.f, 0.f}; acc = WK_MFMA(ldrow(L + O_NB, 32 + 16 * ti2 + qi, 8 * q4), ldtr(La + O_TT, 0, 16 * tj2, lane), acc);
                st4bf(L + O_MT, 32 + 16 * tj2 + qi, 16 * ti2 + 4 * q4, acc);
            }
            WK_BAR();
            if (wave < 4) {
                const int ti2 = wave >> 1, tj2 = wave & 1;
                f32x4 acc = {0.f, 0.f, 0.f, 0.f}; acc = WK_MFMA(ldrow(L + O_TT, 32 + 16 * ti2 + qi, 32 + 8 * q4), ldrow(L + O_MT, 32 + 16 * tj2 + qi, 8 * q4), acc);
#pragma unroll
                for (int r = 0; r < 4; ++r) *(LAS bf16*)(L + O_TT + (32 + 16 * ti2 + 4 * q4 + r) * PB + (16 * tj2 + qi) * 2) = (bf16)f2bf(acc[r]);
            }
            }
            for (int sd3_ = 0; sd3_ < 1 + ((SCAN_DUP >> 3) & 1); ++sd3_) {
            if (wave >= 4) { const int vj = wave - 4;
#pragma unroll
                for (int ti = 0; ti < 4; ++ti) { f32x4 acc = X0[ti];
#pragma unroll
                    for (int ks = 0; ks < 2; ++ks) acc = WK_MFMA(ldrow(L + O_AT, 16 * ti + qi, 32 * ks + 8 * q4), ldrow(H0, 16 * vj + qi, 32 * ks + 8 * q4), acc);
                    st4bf(L + O_XT, 16 * vj + qi, 16 * ti + 4 * q4, acc); } }
            WK_BAR();
#pragma unroll
            for (int e = 0; e < 2; ++e) { const int id = wave * 2 + e, ti = id >> 2, vj = id & 3; f32x4 acc = {0.f, 0.f, 0.f, 0.f};
#pragma unroll
                for (int ks = 0; ks < 2; ++ks) if (ks <= (ti >> 1)) acc = WK_MFMA(ldrow(L + O_TT, 16 * ti + qi, 32 * ks + 8 * q4), ldrow(L + O_XT, 16 * vj + qi, 32 * ks + 8 * q4), acc);
                st4bf(L + O_UT, 16 * vj + qi, 16 * ti + 4 * q4, acc); }
            WK_BAR();
            }
            f32x4 Hsave[4]; for (int vj_ = 0; vj_ < 4; ++vj_) Hsave[vj_] = Hs[vj_];
            for (int sd5_ = 0; sd5_ < 1 + ((SCAN_DUP >> 4) & 1); ++sd5_) {
            for (int vj_ = 0; vj_ < 4; ++vj_) Hs[vj_] = Hsave[vj_];
            if (wave >= 4) { const int vj = wave - 4;
#pragma unroll
                for (int ti = 0; ti < 4; ++ti) { f32x4 acc = Y0[ti];
#pragma unroll
                    for (int ks = 0; ks < 2; ++ks) { acc = WK_MFMA(ldrow(L + O_RT, 16 * ti + qi, 32 * ks + 8 * q4), ldrow(H0, 16 * vj + qi, 32 * ks + 8 * q4), acc);
                        if (ks <= (ti >> 1)) acc = WK_MFMA(ldrow(L + O_MRB, 16 * ti + qi, 32 * ks + 8 * q4), ldrow(L + O_UT, 16 * vj + qi, 32 * ks + 8 * q4), acc); }
                    Yh[ti] = acc; } }
            else { const int kt = wave; const f32x4 gc = *(const LAS f32x4*)(GC + 16 * kt + 4 * q4);
#pragma unroll
                for (int ks = 0; ks < 2; ++ks) { const bf16x8 bt = ldtr(La + O_BT, 32 * ks, 16 * kt, lane), ktf = ldtr(La + O_KT, 32 * ks, 16 * kt, lane);
#pragma unroll
                    for (int vj = 0; vj < 4; ++vj) { Hs[vj] = WK_MFMA(bt, ldrow(L + O_UT, 16 * vj + qi, 32 * ks + 8 * q4), Hs[vj]); Hs[vj] = WK_MFMA(ktf, ldtr(La + O_VV, 32 * ks, 16 * vj, lane), Hs[vj]); } }
#pragma unroll
                for (int vj = 0; vj < 4; ++vj) { Hs[vj] = Hs[vj] * gc; st4bf(H1, 16 * vj + qi, 16 * kt + 4 * q4, Hs[vj]); } }
            WK_BAR();
            }
        }
        WK_YFLUSH(SEQ / 64 - 1);
#undef WK_LOAD
#undef WK_YFLUSH
    }
}

__device__ __forceinline__ void phase_rw_post(Frame& F, int l) {
    const int j = l >> 1; const float* lnw = F.in[I_LNW] + j * D; const float* lnb = F.in[I_LNB] + j * D;
    const bf16* Vb = (const bf16*)(F.ws + WS_ACT + A_RKV) + (size_t)2 * T * D; const bf16* Y = (const bf16*)(F.ws + WS_ACT + A_Y); const bf16* Gb = (const bf16*)(F.ws + WS_ACT + A_G);
    const float* SB = (const float*)(F.ws + WS_SB); bf16* O = (bf16*)(F.ws + WS_ACT + A_O);
    for (int row = F.gw; row < T; row += F.NGW) {
        f32x4 o[4];
#pragma unroll
        for (int q = 0; q < 4; ++q) {
            const int c = 4 * F.lane + 256 * q; const int head = 4 * q + (F.lane >> 4);
            const u32x2 vr = *(const u32x2*)(Vb + (size_t)row * D + c); const f32x4 vf = {bf_lo(vr.x), bf_hi(vr.x), bf_lo(vr.y), bf_hi(vr.y)};
            const f32x4 w = *(const f32x4*)(lnw + c), bb = *(const f32x4*)(lnb + c);
            f32x4 acc = {0.f, 0.f, 0.f, 0.f};
#pragma unroll
            for (int dir = 0; dir < 2; ++dir) {
                const size_t ro = ((size_t)dir * T + row) * D + c;
                const u32x2 yr = *(const u32x2*)(Y + ro), gr = *(const u32x2*)(Gb + ro);
                const f32x4 yf = {bf_lo(yr.x), bf_hi(yr.x), bf_lo(yr.y), bf_hi(yr.y)}; const f32x4 gf = {bf_lo(gr.x), bf_hi(gr.x), bf_lo(gr.y), bf_hi(gr.y)};
                const float sbv = SB[((size_t)dir * T + row) * 16 + head];
                const float mean = rowsum16((yf[0] + yf[1]) + (yf[2] + yf[3])) * (1.0f / 64.0f);
                const f32x4 d = yf - mean; const float var = rowsum16((d[0] * d[0] + d[1] * d[1]) + (d[2] * d[2] + d[3] * d[3])) * (1.0f / 64.0f);
                const float rs = rsqrtf(var + GN_EPS);
                acc += gf * (d * rs * w + bb + sbv * vf);
            }
            o[q] = acc;
        }
        row_store_bf16(O + (size_t)row * D, F.lane, o);
    }
}

__device__ __forceinline__ unsigned att_f(unsigned row) { return ((row & 3u) << 2) | ((row >> 2) & 3u); }
__device__ __forceinline__ unsigned att_off_b(unsigned row, unsigned ch) { return 256u * row + 16u * (ch ^ att_f(row)); }
__device__ __forceinline__ void phase_attn(Frame& F, bool dry = false) {
    bf16* Qb = (bf16*)(F.ws + WS_ACT + A_Q); const bf16* Kb = (const bf16*)(F.ws + WS_ACT + A_K); const bf16* Vb = (const bf16*)(F.ws + WS_ACT + A_VT);
    float* LSE = (float*)(F.ws + WS_SB);
    const int lane = F.lane, qi = lane & 15, q4 = lane >> 4, wave = F.wave;
    LAS unsigned char* KW = F.lds; LAS unsigned char* VW = F.lds + 65536;
    const unsigned vw_a = (unsigned)(size_t)VW;
    unsigned ka[2][4], va[8][2];
#pragma unroll
    for (int rb = 0; rb < 2; ++rb)
#pragma unroll
        for (int s = 0; s < 4; ++s) ka[rb][s] = att_off_b((unsigned)(qi + 16 * rb), (unsigned)(4 * s + q4));
    { const unsigned q = (unsigned)qi >> 2, p = (unsigned)lane & 3u;
#pragma unroll
      for (int c = 0; c < 8; ++c)
#pragma unroll
          for (int t = 0; t < 2; ++t) va[c][t] = vw_a + att_off_b(8u * q4 + 4u * t + q, 2u * c + (p >> 1)) + 8u * (p & 1u); }
    unsigned fk[8];
#pragma unroll
    for (int i = 0; i < 8; ++i) { const unsigned rho = 4u * i + (unsigned)q4, m = rho & 15u, rb = rho >> 4; const unsigned kidx = 8u * (m >> 2) + (m & 3u) + 4u * rb;
        fk[i] = kidx | ((16u * ((unsigned)qi ^ att_f(rho))) << 8); }
    const int nper = (F.G >= 8) ? (F.G >> 3) : 1;
    for (int k = (F.G >= 8 && (F.G & 7) == 0) ? (int)(blockIdx.x >> 3) : (int)blockIdx.x; k < ((F.G >= 8 && (F.G & 7) == 0) ? 3 * NB * 16 : 3 * NB * 8 * 16); k += ((F.G >= 8 && (F.G & 7) == 0) ? nper : F.G)) {
        int g, b, hs, cc;
        if (F.G >= 8 && (F.G & 7) == 0) { hs = blockIdx.x & 7; cc = k & 15; b = (k >> 4) & 7; g = k >> 7; }
        else { g = k >> 10; b = (k >> 7) & 7; hs = (k >> 4) & 7; cc = k & 15; }
        const int dsh = 2 * g, Lg = SEQ >> dsh; const int cls = (g == 0) ? 0 : ((g == 1) ? (cc >> 2) : cc); const int chunk = (g == 0) ? cc : ((g == 1) ? (cc & 3) : 0);
        const int P0 = 128 * chunk;
        asm volatile("s_waitcnt lgkmcnt(0)" ::: "memory"); __builtin_amdgcn_s_barrier(); asm volatile("" ::: "memory");
        { const int base_ = P0 - 64 + 32 * wave;
          const bf16* ksrc = Kb + ((size_t)g * T + (size_t)b * SEQ) * D + hs * 128; const bf16* vsrc = Vb + ((size_t)g * T + (size_t)b * SEQ) * D + hs * 128;
#pragma unroll
          for (int i = 0; i < 8; ++i) { const int pk = min(max(base_ + (int)(fk[i] & 255u), 0), Lg - 1), pv = min(max(base_ + 4 * i + q4, 0), Lg - 1);
              __builtin_amdgcn_global_load_lds((const unsigned*)((const char*)(ksrc + (size_t)(cls + (pk << dsh)) * D) + (fk[i] >> 8)), (LAS unsigned*)(KW + wave * 8192 + i * 1024), 16, 0, 0);
              __builtin_amdgcn_global_load_lds((const unsigned*)((const char*)(vsrc + (size_t)(cls + (pv << dsh)) * D) + (fk[i] >> 8)), (LAS unsigned*)(VW + wave * 8192 + i * 1024), 16, 0, 0); } }
        const int Pq = P0 + 16 * wave + qi; const size_t qrow = (size_t)g * T + (size_t)b * SEQ + (size_t)(cls + (Pq << dsh));
        bf16* qp = Qb + qrow * D + hs * 128;
        bf16x8 Qf[4];
#pragma unroll
        for (int kt = 0; kt < 4; ++kt) Qf[kt] = *(const bf16x8*)(qp + 8 * q4 + 32 * kt);
        const float slope2 = exp2f(-8.0f * (float)(g * 8 + hs + 1) / 24.0f) * LOG2E * (float)(1 << dsh);
        float m_run = -1e30f, l_run = 0.f; f32x4 O[8];
#pragma unroll
        for (int dt = 0; dt < 8; ++dt) O[dt] = (f32x4){0.f, 0.f, 0.f, 0.f};
        asm volatile("s_waitcnt vmcnt(0)" ::: "memory"); __builtin_amdgcn_s_barrier(); asm volatile("" ::: "memory");
#pragma unroll
        for (int s = 0; s < 5; ++s) {
            const int tb = (wave >> 1) + s; const LAS unsigned char* kl = KW + tb * 8192; const unsigned voff = (unsigned)tb * 8192u;
            bf16x8 KA[4], KB[4];
#pragma unroll
            for (int kt = 0; kt < 4; ++kt) { KA[kt] = *(const LAS bf16x8*)(kl + ka[0][kt]); KB[kt] = *(const LAS bf16x8*)(kl + ka[1][kt]); }
            f32x4 SA = {0.f, 0.f, 0.f, 0.f}, SBt = {0.f, 0.f, 0.f, 0.f};
#pragma unroll
            for (int kt = 0; kt < 4; ++kt) { SA = __builtin_amdgcn_mfma_f32_16x16x32_bf16(KA[kt], Qf[kt], SA, 0, 0, 0); SBt = __builtin_amdgcn_mfma_f32_16x16x32_bf16(KB[kt], Qf[kt], SBt, 0, 0, 0); }
            const int cb = P0 - 64 + 32 * tb + 8 * q4;
            float sv[8]; bool ok[8]; float mx = -1e30f;
#pragma unroll
            for (int r = 0; r < 8; ++r) { const int p = cb + r; const int rel = abs(p - Pq); ok[r] = (p >= 0) && (p < Lg) && (rel <= 64);
                const float sc = (r < 4 ? SA[r & 3] : SBt[r & 3]) - slope2 * (float)rel; sv[r] = ok[r] ? sc : -1e30f; mx = fmaxf(mx, sv[r]); }
            mx = bfly16_max(mx); mx = bfly32_max(mx);
            const float m_new = fmaxf(m_run, mx); const float alpha = __builtin_amdgcn_exp2f(m_run - m_new); m_run = m_new;
            float pe[8]; float rs = 0.f;
#pragma unroll
            for (int r = 0; r < 8; ++r) { pe[r] = ok[r] ? __builtin_amdgcn_exp2f(sv[r] - m_new) : 0.f; rs += pe[r]; }
            rs = bfly16_sum(rs); rs = bfly32_sum(rs);
            l_run = l_run * alpha + rs;
            union { u32x4 u; bf16x8 v; } pf; pf.u.x = pk2(pe[0], pe[1]); pf.u.y = pk2(pe[2], pe[3]); pf.u.z = pk2(pe[4], pe[5]); pf.u.w = pk2(pe[6], pe[7]);
#pragma unroll
            for (int hf = 0; hf < 2; ++hf) {
                u32x2 vr[4][2];
                asm volatile("ds_read_b64_tr_b16 %0, %8\n\tds_read_b64_tr_b16 %1, %9\n\tds_read_b64_tr_b16 %2, %10\n\tds_read_b64_tr_b16 %3, %11\n\t"
                             "ds_read_b64_tr_b16 %4, %12\n\tds_read_b64_tr_b16 %5, %13\n\tds_read_b64_tr_b16 %6, %14\n\tds_read_b64_tr_b16 %7, %15\n\ts_waitcnt lgkmcnt(0)"
                             : "=&v"(vr[0][0]), "=&v"(vr[0][1]), "=&v"(vr[1][0]), "=&v"(vr[1][1]), "=&v"(vr[2][0]), "=&v"(vr[2][1]), "=&v"(vr[3][0]), "=&v"(vr[3][1])
                             : "v"(va[4 * hf + 0][0] + voff), "v"(va[4 * hf + 0][1] + voff), "v"(va[4 * hf + 1][0] + voff), "v"(va[4 * hf + 1][1] + voff), "v"(va[4 * hf + 2][0] + voff), "v"(va[4 * hf + 2][1] + voff), "v"(va[4 * hf + 3][0] + voff), "v"(va[4 * hf + 3][1] + voff)
                             : "memory");
#pragma unroll
                for (int c = 0; c < 4; ++c) { const int dt = 4 * hf + c; union { u32x4 u; bf16x8 v; } vf; vf.u.x = vr[c][0].x; vf.u.y = vr[c][0].y; vf.u.z = vr[c][1].x; vf.u.w = vr[c][1].y;
                    O[dt] = O[dt] * alpha; O[dt] = __builtin_amdgcn_mfma_f32_16x16x32_bf16(vf.v, pf.v, O[dt], 0, 0, 0); }
            }
        }
        const float inv = 1.0f / l_run;
#pragma unroll
        for (int dt = 0; dt < 8; ++dt) { u32x2 o; o.x = pk2(O[dt][0] * inv, O[dt][1] * inv); o.y = pk2(O[dt][2] * inv, O[dt][3] * inv); if (!dry) *(u32x2*)(qp + 4 * q4 + 16 * dt) = o; else asm volatile("" :: "v"(o.x), "v"(o.y)); }
        if (q4 == 0 && !dry) LSE[qrow * 8 + hs] = m_run + __builtin_amdgcn_logf(l_run);
    }
}
__device__ __forceinline__ void phase_attn_merge(Frame& F) {
    const bf16* Ob = (const bf16*)(F.ws + WS_ACT + A_Q); const float* LSE = (const float*)(F.ws + WS_SB); bf16* AO = (bf16*)(F.ws + WS_ACT + A_AO);
    for (int row = F.gw; row < T; row += F.NGW) {
        f32x4 o[4];
#pragma unroll
        for (int q = 0; q < 4; ++q) { const int c = 4 * F.lane + 256 * q; const int head = 2 * q + (F.lane >> 5);
            float ls[3];
#pragma unroll
            for (int g = 0; g < 3; ++g) ls[g] = LSE[((size_t)g * T + row) * 8 + head];
            const float mx = fmaxf(ls[0], fmaxf(ls[1], ls[2]));
            float w[3]; float sum = 0.f;
#pragma unroll
            for (int g = 0; g < 3; ++g) { w[g] = __builtin_amdgcn_exp2f(ls[g] - mx); sum += w[g]; }
            const float inv = 1.0f / sum; f32x4 acc = {0.f, 0.f, 0.f, 0.f};
#pragma unroll
            for (int g = 0; g < 3; ++g) { const u32x2 r = *(const u32x2*)(Ob + ((size_t)g * T + row) * D + c); const float a = w[g] * inv;
                acc[0] += a * bf_lo(r.x); acc[1] += a * bf_hi(r.x); acc[2] += a * bf_lo(r.y); acc[3] += a * bf_hi(r.y); }
            o[q] = acc; }
        row_store_bf16(AO + (size_t)row * D, F.lane, o);
    }
}

constexpr int PH_PER_LAYER = 10, N_PHASES = 1 + DEPTH * PH_PER_LAYER + 1;
template <int MASK> __global__ void __launch_bounds__(NTHREADS, 2) mk_fwd(Args args) {
    extern __shared__ __attribute__((aligned(16))) unsigned char lds_raw[];
#define PHASE_FRAME() Frame F; { int t_ = wave0 * 64 + lane_id_nh(); asm volatile("" : "+v"(t_)); size_t z_ = 0; asm volatile("" : "+s"(z_)); unsigned char* w_ = args.ws + z_;     \
        unsigned lb_ = 0; asm volatile("" : "+s"(lb_)); F.lds = (LAS unsigned char*)lds_raw + lb_; F.tid = t_; F.lane = t_ & 63; F.wave = __builtin_amdgcn_readfirstlane(t_ >> 6); \
        F.G = gridDim.x; F.gw = blockIdx.x * NWAVES + F.wave; F.NGW = F.G * NWAVES; F.ws = w_; F.in = args.in; F.out = args.out; }
    LAS unsigned char* lds0 = (LAS unsigned char*)lds_raw;
    const int wave0 = __builtin_amdgcn_readfirstlane((int)threadIdx.x >> 6);
    volatile LAS unsigned* MISC = (volatile LAS unsigned*)(lds0 + MISC_OFF);
    if (wave0 == 0) ((LAS unsigned*)(lds0 + LDS_MISC))[lane_id_nh() + 64] = 0u;
    __syncthreads();
    unsigned* ctl = (unsigned*)(args.ws + WS_CTL);
    XcdBarrier bar; bar.bar = ctl + CW_BAR; bar.x = 0; bar.st = nullptr;
#if ONE_LAUNCH
    bar = xcd_barrier_post(ctl + CW_BAR, MISC + 8, wave0 == 0 && lane_id_nh() == 0);
#endif
    const int lo = args.ph_lo, hi = args.ph_hi;
#define EN(b) ((MASK >> (b)) & 1)
#ifndef DUP_MASK
#define DUP_MASK 0
#endif
#define REP(b) for (int rep_ = 0; rep_ < 1 + ((DUP_MASK >> (b)) & 1); ++rep_)
#define IN(k) (lo <= (k) && (k) < hi)
#if ONE_LAUNCH
#ifndef BAR_REP
#define BAR_REP 1
#endif
#define SEAM(k) do { if (IN((k) + 1) || (k) + 1 < hi) { for (int br_ = 0; br_ < BAR_REP; ++br_) xcd_barrier(bar, wave0 == 0 && lane_id_nh() == 0); } } while (0)
#else
#define SEAM(k) do { } while (0)
#endif
    bf16* X0 = (bf16*)(args.ws + WS_X1); bf16* X1 = X0 + (size_t)T * D;
    if (EN(0) && IN(0)) { PHASE_FRAME(); REP(0) phase_prologue(F); SEAM(0); }
    for (int l = 0; l < DEPTH; ++l) {
        const int pb = 1 + l * PH_PER_LAYER; const int j = l >> 1;
        const void* xin = (l == 0) ? (const void*)args.in[I_X] : (const void*)((l & 1) ? X0 : X1);
        bf16* xcur = (l == 0) ? X0 : ((l & 1) ? X1 : X0);
        if ((l & 1) == 0) {
            if (EN(1) && IN(pb + 0)) { PHASE_FRAME(); REP(1) phase_rw_norm(F, l, l > 0, xin, xcur); SEAM(pb + 0); }
            if (EN(2) && IN(pb + 1)) { REP(2) {
                { PHASE_FRAME(); DenseSched S; S.o.init(T / 256, 2, F.G, blockIdx.x); S.A = (const char*)(F.ws + WS_ACT + A_HX); S.a_sel_stride = 0; S.pn_per_a = 1 << 20;
                  S.B = (const char*)(F.ws + WS_W + j * W_RW_STRIDE + W_LDN); S.tstepA = (size_t)256 * 2048 * 2; S.tstepB = (size_t)256 * 2048 * 2;
                  EpiLoraDn E{(bf16*)(F.ws + WS_ACT + A_LORAH)};
                  pg8::gemm_phase(F.lds, F.tid, 2048, 2048, 2048, S, E); }
                { PHASE_FRAME(); DenseSched S; S.o.init(T / 256, 12, F.G, blockIdx.x); S.o.uneven = (F.G == 256); S.A = (const char*)(F.ws + WS_ACT + A_XS); S.a_sel_stride = (size_t)T * D; S.pn_per_a = 4;
                  S.B = (const char*)(F.ws + WS_W + j * W_RW_STRIDE + W_RKV); S.tstepA = (size_t)256 * D; S.tstepB = (size_t)256 * D;
                  EpiI8<EpiSplit> E{EpiSplit{(bf16*)(F.ws + WS_ACT + A_RKV), (size_t)T * D, 1.0f}, (const float*)(F.ws + WS_SCL + SCL_XS), (size_t)T, 4, (const float*)(F.ws + WS_W + j * W_RW_STRIDE + W_RKVS)};
                  pg8::gemm_phase(F.lds, F.tid, D, D, D, S, E); }
                }
                SEAM(pb + 1);
            }
            if (EN(3) && IN(pb + 2)) { REP(3) {
                { PHASE_FRAME(); DenseSched S; S.o.init(T / 256, 16, F.G, blockIdx.x); S.A = (const char*)(F.ws + WS_ACT + A_LORAH); S.a_sel_stride = 256; S.pn_per_a = 8;
                  S.B = (const char*)(F.ws + WS_W + j * W_RW_STRIDE + W_LUPWA); S.tstepA = (size_t)256 * 512 * 2; S.tstepB = (size_t)256 * 128 * 2;
                  EpiLoraUpWA E{(bf16*)(F.ws + WS_ACT + A_LDEC), (bf16*)(F.ws + WS_ACT + A_ASIG), F.in[I_W0] + j * 2 * D, F.in[I_A0] + j * 2 * D};
                  pg8::gemm_phase(F.lds, F.tid, 128, 512, 128, S, E); }
                { PHASE_FRAME(); DenseSched S; S.o.init(T / 256, 8, F.G, blockIdx.x); S.A = (const char*)(F.ws + WS_ACT + A_LORAH) + 512; S.a_sel_stride = 256; S.pn_per_a = 4;
                  S.B = (const char*)(F.ws + WS_W + j * W_RW_STRIDE + W_LUPG); S.tstepA = (size_t)256 * 512 * 2; S.tstepB = (size_t)256 * 128 * 2;
                  EpiSplit E{(bf16*)(F.ws + WS_ACT + A_G), (size_t)T * D, 1.0f};
                  pg8::gemm_phase(F.lds, F.tid, 128, 512, 128, S, E); }
                }
                SEAM(pb + 2);
            }
            if (EN(4) && IN(pb + 3)) { PHASE_FRAME(); REP(4) phase_scan(F, l); SEAM(pb + 3); }
            if (EN(5) && IN(pb + 4)) { PHASE_FRAME(); REP(5) phase_rw_post(F, l); SEAM(pb + 4); }
            if (EN(6) && IN(pb + 5)) { PHASE_FRAME();
                DenseSched S; S.o.init(T / 256, 4, F.G, blockIdx.x); S.A = (const char*)(F.ws + WS_ACT + A_O); S.a_sel_stride = 0; S.pn_per_a = 1 << 20;
                S.B = (const char*)(F.ws + WS_W + j * W_RW_STRIDE + W_RWO); S.tstepA = (size_t)256 * D * 2; S.tstepB = (size_t)256 * D * 2;
                EpiResid E{(l == 0) ? (const void*)F.in[I_X] : (const void*)xcur, (l == 0) ? 1 : 0, xcur, (const float*)(F.ws + WS_MOD) + (size_t)l * 8 * 6144 + 2 * D};
                pg8::gemm_phase(F.lds, F.tid, D, D, D, S, E);
                SEAM(pb + 5);
            }
        } else {
            if (EN(7) && IN(pb + 0)) { PHASE_FRAME(); REP(7) phase_at_norm(F, l, (const bf16*)xin, xcur); SEAM(pb + 0); }
            if (EN(8) && IN(pb + 1)) { PHASE_FRAME(); REP(8) {
                DenseSched S; S.o.init(T / 256, 36, F.G, blockIdx.x); S.A = (const char*)(F.ws + WS_ACT + A_H); S.a_sel_stride = 0; S.pn_per_a = 1 << 20;
                S.B = (const char*)(F.ws + WS_WA + j * W_AT_STRIDE + W_QKV); S.tstepA = (size_t)256 * D; S.tstepB = (size_t)256 * D;
                EpiQKV8 E{(bf16*)(F.ws + WS_ACT + A_Q), (const float*)(F.ws + WS_SA), (const float*)(F.ws + WS_WA + j * W_AT_STRIDE + W_QKVS), 0.08838834764831845f * LOG2E};
                pg8::gemm_phase(F.lds, F.tid, D, D, D, S, E);
                }
                SEAM(pb + 1);
            }
            if (EN(9) && IN(pb + 2)) { PHASE_FRAME(); if ((DUP_MASK >> 9) & 1) phase_attn(F, true); phase_attn(F); SEAM(pb + 2); }
            if (EN(16) && IN(pb + 3)) { PHASE_FRAME(); REP(16) phase_attn_merge(F); SEAM(pb + 3); }
            if (EN(10) && IN(pb + 4)) { PHASE_FRAME();
                DenseSched S; S.o.init(T / 256, 4, F.G, blockIdx.x); S.A = (const char*)(F.ws + WS_ACT + A_AO); S.a_sel_stride = 0; S.pn_per_a = 1 << 20;
                S.B = (const char*)(F.ws + WS_WA + j * W_AT_STRIDE + W_AWO); S.tstepA = (size_t)256 * D * 2; S.tstepB = (size_t)256 * D * 2;
                EpiResid E{(const void*)xcur, 0, xcur, (const float*)(F.ws + WS_MOD) + (size_t)l * 8 * 6144 + 2 * D};
                pg8::gemm_phase(F.lds, F.tid, D, D, D, S, E);
                SEAM(pb + 4);
            }
        }
        if (EN(11) && IN(pb + 6)) { PHASE_FRAME(); if ((DUP_MASK >> 11) & 1) phase_moe_route(F, l, xcur, 4); phase_moe_route(F, l, xcur); SEAM(pb + 6); }
        if (EN(12) && IN(pb + 7)) { PHASE_FRAME(); REP(12) phase_moe_gather(F, l); SEAM(pb + 7); }
        if (EN(13) && IN(pb + 8)) { PHASE_FRAME(); REP(13) {
            MoeGatherSched S; S.tileE = (const int*)(F.ws + WS_TILEE); S.ntiles = uni(S.tileE[160]); S.G = F.G; S.c = blockIdx.x;
            S.A = (const char*)(F.ws + WS_ACT + A_HN2); S.B = (const char*)(F.ws + ws_wm_of(l) + W_GU); S.tstepB = (size_t)256 * D; S.estride = (size_t)512 * D;
            { LAS int* rt = (LAS int*)(F.lds + LDS_MISC + 1024); S.rowtab = rt; const int* rowt = (const int*)(F.ws + WS_ROWT);
              for (int i = F.tid; i < 3 * 256; i += NTHREADS) { const int L = (i >> 8) * F.G + (int)blockIdx.x; rt[i] = (L < S.ntiles * 2) ? rowt[(L >> 1) * 256 + (i & 255)] : 0; }
              __syncthreads(); }
            EpiGateUp8 E{(bf16*)(F.ws + WS_ACT + A_HID), (const float*)(F.ws + WS_ROWW), (const int*)(F.ws + WS_ROWT), (const float*)(F.ws + WS_SCL + SCL_HN), (const float*)(F.ws + ws_wm_of(l) + W_GUS), (const int*)(F.ws + WS_TILEE)};
            pg8::gemm_phase(F.lds, F.tid, D, D, D, S, E);
            if (l + 1 < DEPTH) {
                const int nun = S.ntiles * 2, firstb = (nun > F.G) ? (nun - F.G) : 0;
                if ((int)blockIdx.x >= firstb) moe_convert(F, l + 1, (int)blockIdx.x - firstb, F.G - firstb);
            }
            }
                SEAM(pb + 8);
        }
        if (EN(14) && IN(pb + 9)) { PHASE_FRAME(); REP(14) {
            MoeSched S; S.tileE = (const int*)(F.ws + WS_TILEE); S.ntiles = uni(S.tileE[160]); S.npn = 4; S.G = F.G; S.c = blockIdx.x;
            S.A = (const char*)(F.ws + WS_ACT + A_HID); S.B = (const char*)(F.ws + ws_wm_of(l) + W_DN); S.tstepA = (size_t)256 * FEXP * 2; S.tstepB = (size_t)256 * FEXP * 2; S.estride = (size_t)D * FEXP * 2;
            EpiPlain E{(bf16*)(F.ws + WS_ACT + A_YS)};
            pg8::gemm_phase(F.lds, F.tid, FEXP, FEXP, FEXP, S, E);
            }
                SEAM(pb + 9);
        }
    }
    if (EN(15) && IN(N_PHASES - 1)) { PHASE_FRAME(); phase_final(F, X1); }
#undef IN
#undef SEAM
}

typedef void (*kern_t)(Args);
template <int B> static kern_t kern_of_bit(int b) { if (b == B) return mk_fwd<(1 << B)>; if constexpr (B > 0) return kern_of_bit<B - 1>(b); else return nullptr; }
static int kind_of_phase(int p) {
    if (p == 0) return 0; if (p == N_PHASES - 1) return 15;
    const int l = (p - 1) / PH_PER_LAYER, k = (p - 1) % PH_PER_LAYER;
    if (k >= 6) return 11 + (k - 6);
    if ((l & 1) == 0) return 1 + k;
    return (k < 3) ? 7 + k : (k == 3 ? 16 : (k == 4 ? 10 : -1));
}
extern "C" void kernel_launch(void* const* d_in, const int* in_sizes, int n_in, void* d_out, int out_size, void* d_ws, size_t ws_size, hipStream_t stream) {
    static int grid = 0;
    if (grid == 0) {
        if (n_in != 32 || out_size != T * D || ws_size < WS_END) { fprintf(stderr, "kernel_launch: unexpected shapes (n_in %d out %d ws %zu need %zu)\n", n_in, out_size, ws_size, (size_t)WS_END); grid = -1; return; }
        int dev = 0, cus = 0;
        if (hipGetDevice(&dev) != hipSuccess || hipDeviceGetAttribute(&cus, hipDeviceAttributeMultiprocessorCount, dev) != hipSuccess) { grid = -1; return; }
#if ONE_LAUNCH
        if (hipFuncSetAttribute((const void*)mk_fwd<0x1ffff>, hipFuncAttributeMaxDynamicSharedMemorySize, LDS_BYTES) != hipSuccess) { fprintf(stderr, "kernel_launch: hipFuncSetAttribute failed\n"); grid = -1; return; }
#else
        for (int b = 0; b < 17; ++b) if (hipFuncSetAttribute((const void*)kern_of_bit<16>(b), hipFuncAttributeMaxDynamicSharedMemorySize, LDS_BYTES) != hipSuccess) { fprintf(stderr, "kernel_launch: hipFuncSetAttribute failed\n"); grid = -1; return; }
#endif
        (void)hipGetLastError();
        grid = cus;
    }
    if (grid < 0) return;
    (void)hipMemsetAsync((char*)d_ws + WS_CTL, 0, CTL_ZERO_BYTES, stream);
    Args a{};
    for (int i = 0; i < 32; ++i) a.in[i] = (const float*)d_in[i];
    a.out = (float*)d_out; a.ws = (unsigned char*)d_ws;
#if ONE_LAUNCH
#ifndef SPLIT_EVERY
#define SPLIT_EVERY N_PHASES
#endif
    for (int p = 0; p < N_PHASES; p += SPLIT_EVERY) {
        a.ph_lo = p; a.ph_hi = (p + SPLIT_EVERY < N_PHASES) ? p + SPLIT_EVERY : N_PHASES;
        hipLaunchKernelGGL(mk_fwd<0x1ffff>, dim3(grid), dim3(NTHREADS), LDS_BYTES, stream, a);
    }
#else
    for (int p = 0; p < N_PHASES; ++p) {
        const int kind = kind_of_phase(p); if (kind < 0) continue;
        a.ph_lo = p; a.ph_hi = p + 1;
        hipLaunchKernelGGL(kern_of_bit<16>(kind), dim3(grid), dim3(NTHREADS), LDS_BYTES, stream, a);
    }
#endif
}
```

```cpp
#include <hip/hip_runtime.h>
#include <cstdio>
#include <cstdint>

#ifndef ONE_LAUNCH
#define ONE_LAUNCH 1
#endif


#define LAS __attribute__((address_space(3)))
typedef unsigned short bf16;
typedef short bf16x8 __attribute__((ext_vector_type(8)));
typedef float f32x4 __attribute__((ext_vector_type(4)));
typedef float f32x2 __attribute__((ext_vector_type(2)));
typedef unsigned u32x4 __attribute__((ext_vector_type(4)));
typedef unsigned u32x2 __attribute__((ext_vector_type(2)));

constexpr int NB = 8, SEQ = 2048, D = 1024, T = NB * SEQ, DEPTH = 4;
constexpr int NH_R = 16, HD_R = 64;
constexpr int QKVW = 9216;
constexpr int NEXP = 32, FEXP = 256;
constexpr int MAXROWS = 40960;
constexpr int NWAVES = 8, NTHREADS = 512;
constexpr float RMS_EPS = 1e-6f, GN_EPS = 64e-5f;
constexpr float LOG2E = 1.4426950408889634f;

constexpr size_t MiB = 1u << 20;
constexpr size_t WS_CTL = 0, CTL_ZERO_BYTES = 64 * 1024;
constexpr size_t WS_MOD = 1 * MiB;
constexpr size_t WS_TOKE = 2 * MiB;
constexpr size_t WS_TOKR = WS_TOKE + 128 * 1024;
constexpr size_t WS_TOKW = WS_TOKR + 128 * 1024;
constexpr size_t WS_TOKP = WS_TOKW + 128 * 1024;
constexpr size_t WS_ROWW = WS_TOKP + 128 * 1024;
constexpr size_t WS_TILEE = WS_ROWW + 192 * 1024;
constexpr size_t WS_ROWT = WS_TILEE + 4096;
constexpr size_t WS_SB = 4 * MiB;
constexpr size_t WS_SA = WS_SB + 1536 * 1024;
constexpr size_t WS_SCL = 6 * MiB;
constexpr size_t SCL_XS = 0, SCL_HN = 4 * 65536;
constexpr size_t WS_W = 8 * MiB;
constexpr size_t W_RKV = 0, W_RKVS = 3 * MiB, W_LDN = 6 * MiB, W_LUPWA = 8 * MiB, W_LUPG = 10 * MiB, W_RWO = 11 * MiB, W_RW_STRIDE = 13 * MiB;
constexpr size_t WS_WA = WS_W + 2 * W_RW_STRIDE;
constexpr size_t W_QKV = 0, W_QKVS = 9 * MiB, W_AWO = 18 * MiB, W_AT_STRIDE = 20 * MiB;
constexpr size_t WS_WM = WS_WA + 2 * W_AT_STRIDE;
constexpr size_t W_GU = 0, W_GUS = 16 * MiB, W_DN = 32 * MiB;
__host__ __device__ constexpr size_t ws_wm_of(int l);
constexpr size_t WS_X1 = 128 * MiB;
constexpr size_t WS_ACT = 192 * MiB;
constexpr size_t A_XS = 0, A_HX = 96 * MiB;
constexpr size_t A_LDEC = 0, A_ASIG = 64 * MiB, A_G = 128 * MiB;
constexpr size_t A_RKV = 192 * MiB;
constexpr size_t A_O = 192 * MiB;
constexpr size_t A_LORAH = 288 * MiB;
constexpr size_t A_Y = 304 * MiB;
constexpr size_t A_H = 0;
constexpr size_t A_Q = 32 * MiB, A_K = 128 * MiB, A_VT = 224 * MiB;
constexpr size_t A_AO = 320 * MiB;
constexpr size_t A_HN2 = 0, A_LSTT = 32 * MiB, A_LSTW = 34 * MiB, A_HID = 112 * MiB, A_YS = 288 * MiB;
constexpr int LCAP = 16384;
static_assert(A_K - A_Q == A_VT - A_K, "q/k/v spacing");
constexpr size_t WS_WM2 = WS_ACT + 368 * MiB;
constexpr size_t WS_END = WS_WM2 + 48 * MiB;

constexpr int CW_BAR = 4096;
constexpr int CW_CNT = 8192;

__host__ __device__ constexpr size_t ws_wm_of(int l) { return (l & 1) ? WS_WM2 : WS_WM; }
constexpr int LDS_BYTES = 163840;
constexpr int LDS_MISC = 159744;
constexpr int MISC_OFF = LDS_MISC + 320;
constexpr int MOE_TAB = 131072;
constexpr int TILEE_OFF = MOE_TAB + 9216, TILEJ_OFF = TILEE_OFF + 768, CNTL_OFF = TILEJ_OFF + 768;
constexpr int OFFS_OFF = CNTL_OFF + 256;

__device__ __forceinline__ float bf_lo(unsigned u) { return __uint_as_float(u << 16); }
__device__ __forceinline__ float bf_hi(unsigned u) { return __uint_as_float(u & 0xffff0000u); }
__device__ __forceinline__ float bf2f(bf16 v) { return __uint_as_float(((unsigned)v) << 16); }
__device__ __forceinline__ unsigned f2bf(float f) { __bf16 r = (__bf16)f; return (unsigned)__builtin_bit_cast(unsigned short, r); }
__device__ __forceinline__ unsigned pk2(float lo, float hi) { typedef __bf16 b2_t __attribute__((ext_vector_type(2))); typedef float f2_t __attribute__((ext_vector_type(2))); f2_t v = {lo, hi}; b2_t r = __builtin_convertvector(v, b2_t); return __builtin_bit_cast(unsigned, r); }
__device__ __forceinline__ float dpp_ror(float x, const int ctrl_sel) {
    int r;
    if (ctrl_sel == 8) r = __builtin_amdgcn_update_dpp(0, __float_as_int(x), 0x128, 0xf, 0xf, false);
    else if (ctrl_sel == 4) r = __builtin_amdgcn_update_dpp(0, __float_as_int(x), 0x124, 0xf, 0xf, false);
    else if (ctrl_sel == 2) r = __builtin_amdgcn_update_dpp(0, __float_as_int(x), 0x122, 0xf, 0xf, false);
    else r = __builtin_amdgcn_update_dpp(0, __float_as_int(x), 0x121, 0xf, 0xf, false);
    return __int_as_float(r);
}
__device__ __forceinline__ float rowsum16(float x) { x += dpp_ror(x, 8); x += dpp_ror(x, 4); x += dpp_ror(x, 2); x += dpp_ror(x, 1); return x; }
__device__ __forceinline__ float sum8(float x) {
    x += __int_as_float(__builtin_amdgcn_update_dpp(0, __float_as_int(x), 0x141, 0xf, 0xf, false));
    x += __int_as_float(__builtin_amdgcn_update_dpp(0, __float_as_int(x), 0xB1, 0xf, 0xf, false));
    x += __int_as_float(__builtin_amdgcn_update_dpp(0, __float_as_int(x), 0x4E, 0xf, 0xf, false));
    return x;
}
__device__ __forceinline__ float lane_xor(float v, int lane, int o) { return __int_as_float(__builtin_amdgcn_ds_bpermute((lane ^ o) << 2, __float_as_int(v))); }
typedef unsigned v2u_t __attribute__((ext_vector_type(2)));
__device__ __forceinline__ float bfly16_sum(float x) { const v2u_t r = __builtin_amdgcn_permlane16_swap(__float_as_uint(x), __float_as_uint(x), false, false); return __uint_as_float(r[0]) + __uint_as_float(r[1]); }
__device__ __forceinline__ float bfly32_sum(float x) { const v2u_t r = __builtin_amdgcn_permlane32_swap(__float_as_uint(x), __float_as_uint(x), false, false); return __uint_as_float(r[0]) + __uint_as_float(r[1]); }
__device__ __forceinline__ float bfly16_max(float x) { const v2u_t r = __builtin_amdgcn_permlane16_swap(__float_as_uint(x), __float_as_uint(x), false, false); return fmaxf(__uint_as_float(r[0]), __uint_as_float(r[1])); }
__device__ __forceinline__ float bfly32_max(float x) { const v2u_t r = __builtin_amdgcn_permlane32_swap(__float_as_uint(x), __float_as_uint(x), false, false); return fmaxf(__uint_as_float(r[0]), __uint_as_float(r[1])); }
__device__ __forceinline__ float wave_max(float x) {
    x = fmaxf(x, dpp_ror(x, 8)); x = fmaxf(x, dpp_ror(x, 4)); x = fmaxf(x, dpp_ror(x, 2)); x = fmaxf(x, dpp_ror(x, 1)); x = bfly16_max(x); return bfly32_max(x);
}
__device__ __forceinline__ unsigned pack_i8x4(const f32x4& v, float inv) {
    const int q0 = (int)__builtin_rintf(fminf(fmaxf(v[0] * inv, -127.f), 127.f)), q1 = (int)__builtin_rintf(fminf(fmaxf(v[1] * inv, -127.f), 127.f));
    const int q2 = (int)__builtin_rintf(fminf(fmaxf(v[2] * inv, -127.f), 127.f)), q3 = (int)__builtin_rintf(fminf(fmaxf(v[3] * inv, -127.f), 127.f));
    return (unsigned)(q0 & 255) | ((unsigned)(q1 & 255) << 8) | ((unsigned)(q2 & 255) << 16) | ((unsigned)q3 << 24);
}
__device__ __forceinline__ float wave_sum(float v, int lane) { (void)lane; v = rowsum16(v); v = bfly16_sum(v); v = bfly32_sum(v); return v; }
__device__ __forceinline__ int lane_id_nh() { int lid; asm volatile("v_mbcnt_lo_u32_b32 %0, -1, 0\n\tv_mbcnt_hi_u32_b32 %0, -1, %0" : "=v"(lid)); return lid; }
__device__ __forceinline__ float sigmoidf_(float x) { return 1.0f / (1.0f + __expf(-x)); }
#define LDS_WAIT() asm volatile("s_waitcnt lgkmcnt(0)" ::: "memory")
#define VM_WAIT() asm volatile("s_waitcnt vmcnt(0)" ::: "memory")

#define XB_TMO      128
#define XB_XCNT(j)  (256  + 64 * (j))
#define XB_XSUB(j)  (1280 + 64 * (j))
#define XB_XGEN(j)  (2304 + 64 * (j))
#define XB_TOP      3328
#define XB_TOPGEN   3392
#define XCD_BAR_WORDS 3456
#define XB_SPIN_CAP (1u << 18)
__device__ __forceinline__ unsigned xb_ld(unsigned* p)              { return __hip_atomic_load(p, __ATOMIC_RELAXED, __HIP_MEMORY_SCOPE_AGENT); }
__device__ __forceinline__ unsigned xb_add(unsigned* p, unsigned v) { return __hip_atomic_fetch_add(p, v, __ATOMIC_RELAXED, __HIP_MEMORY_SCOPE_AGENT); }
__device__ __forceinline__ unsigned xb_xcc_id() { return (unsigned)__builtin_amdgcn_s_getreg((3 << 11) | 20) & 0xFu; }
#define XB_SPIN(cond, bar) do { unsigned _sp = 0; while (cond) { __builtin_amdgcn_s_sleep(1); \
    if ((++_sp & 255u) == 0u) { if (xb_ld(&(bar)[XB_TMO])) break; if (_sp > XB_SPIN_CAP) { atomicAdd(&(bar)[XB_TMO], 1u); break; } } } } while (0)
struct XcdBarrier { unsigned* bar; unsigned x; volatile LAS unsigned* st; };
__device__ __forceinline__ XcdBarrier xcd_barrier_post(unsigned* bar, volatile LAS unsigned* st, bool t0) {
    XcdBarrier b; b.bar = bar; b.x = xb_xcc_id(); b.st = st;
    if (t0) (void)xb_add(&bar[XB_XCNT(b.x)], 1u);
    return b;
}
__device__ __forceinline__ void xcd_barrier_complete(unsigned* bar, unsigned x, unsigned& nloc, unsigned& nx) {
    const unsigned G = gridDim.x * gridDim.y * gridDim.z;
    unsigned sum, cnt, mine, sp = 0u;
    for (;;) {
        sum = 0u; cnt = 0u; mine = 0u;
#pragma clang loop unroll(disable)
        for (unsigned j = 0; j < 16; ++j) { const unsigned c = xb_ld(&bar[XB_XCNT(j)]); sum += c; cnt += (c > 0u) ? 1u : 0u; mine = (j == x) ? c : mine; }
        if (sum == G) break;
        __builtin_amdgcn_s_sleep(1);
        if ((++sp & 255u) == 0u) { if (xb_ld(&bar[XB_TMO])) break; if (sp > XB_SPIN_CAP) { atomicAdd(&bar[XB_TMO], 1u); break; } }
    }
    nloc = mine > 0u ? mine : 1u; nx = cnt > 0u ? cnt : 1u;
}
__device__ __forceinline__ void xcd_barrier(const XcdBarrier& b, bool t0) {
    asm volatile("s_waitcnt vmcnt(0)" ::: "memory");
    __syncthreads();
    if (t0) {
        unsigned* bar = b.bar;
        __builtin_amdgcn_s_waitcnt(0);
        unsigned nloc = b.st[0], nx = b.st[1];
        if (nloc == 0u) { xcd_barrier_complete(bar, b.x, nloc, nx); b.st[0] = nloc; b.st[1] = nx; }
        const unsigned old = xb_add(&bar[XB_XSUB(b.x)], 1u);
        const unsigned gen = old / nloc;
        if (old + 1u == (gen + 1u) * nloc) {
            __builtin_amdgcn_fence(__ATOMIC_RELEASE, "agent");
            asm volatile("s_waitcnt vmcnt(0)" ::: "memory");
            const unsigned og = xb_add(&bar[XB_TOP], 1u);
            const unsigned tg = og / nx;
            if (og + 1u == (tg + 1u) * nx) xb_add(&bar[XB_TOPGEN], 1u);
            else XB_SPIN(xb_ld(&bar[XB_TOPGEN]) == tg, bar);
            __builtin_amdgcn_fence(__ATOMIC_ACQUIRE, "agent");
            xb_add(&bar[XB_XGEN(b.x)], 1u);
            asm volatile("s_waitcnt vmcnt(0)" ::: "memory");
        } else {
            XB_SPIN(xb_ld(&bar[XB_XGEN(b.x)]) == gen, bar);
            __builtin_amdgcn_fence(__ATOMIC_ACQUIRE, "agent");
            asm volatile("s_waitcnt vmcnt(0)" ::: "memory");
        }
    }
    __syncthreads();
}

namespace pg8 {
constexpr int BM = 256, BK = 64, HALF = 128, HTB = HALF * BK * 2, STAGE_BYTES = 8 * HTB;
__device__ __forceinline__ int lds_byte(int r, int c) { const int st = (r >> 4) * 2 + (c >> 5), rr = r & 15, cc = c & 31, ob = rr * 64 + cc * 2; return st * 1024 + (ob ^ (((ob >> 9) & 1) << 5)); }
__device__ __forceinline__ void stage_rc(int b, int& R, int& C) { const int st = b / 1024, sb = b % 1024, swz = sb ^ (((sb >> 9) & 1) << 5); R = (st >> 1) * 16 + swz / 64; C = (st & 1) * 32 + (swz % 64) / 2; }
__device__ __forceinline__ int perm32(int rho) { const int n = rho >> 4, i = rho & 15; return 8 * (i >> 2) + 4 * n + (i & 3); }
struct Unit { int pm, pn, ui; const char* a; const char* b; };
__device__ __forceinline__ unsigned cvt_pk_bf16(float lo, float hi) { unsigned r; asm volatile("v_cvt_pk_bf16_f32 %0, %1, %2" : "=v"(r) : "v"(lo), "v"(hi)); return r; }

typedef int i32x4 __attribute__((ext_vector_type(4)));
template <bool I8> struct OpT { typedef bf16x8 frag; typedef f32x4 acc; };
template <> struct OpT<true> { typedef i32x4 frag; typedef i32x4 acc; };
__device__ __forceinline__ f32x4 mma16(const bf16x8& a, const bf16x8& b, const f32x4& c) { return __builtin_amdgcn_mfma_f32_16x16x32_bf16(a, b, c, 0, 0, 0); }
__device__ __forceinline__ i32x4 mma16(const i32x4& a, const i32x4& b, const i32x4& c) { return __builtin_amdgcn_mfma_i32_16x16x64_i8(a, b, c, 0, 0, 0); }
template <class Epi, class Sched>
__device__ __forceinline__ void gemm_phase(LAS unsigned char* lds, const int tid, const int K, const int lda, const int ldb, const Sched& S, const Epi& E) {
    const int wid = __builtin_amdgcn_readfirstlane(tid >> 6), lane = tid & 63, wr = wid >> 2, wc = wid & 3, fr = lane & 15, fq = lane >> 4;
    int Kq = K; asm volatile("" : "+s"(Kq));
    constexpr bool I8 = Epi::I8; constexpr int EB = I8 ? 1 : 2;
    typedef typename OpT<I8>::frag frag_t; typedef typename OpT<I8>::acc acc_t;
    const int nt = Kq * EB / (BK * 2);
    unsigned voffC[2][2], voffN[2][2], voffB[2]; int RA[2], CA[2];
#pragma unroll
    for (int i = 0; i < 2; ++i) { int R, C; stage_rc(tid * 16 + i * 8192, R, C); const int Rb = Epi::PERM ? ((R & ~31) + perm32(R & 31)) : R; RA[i] = R; CA[i] = C;
        voffB[i] = (unsigned)(Rb * ldb * EB + C * 2); }
#define PG8_AOFF(dst, ui_) do { _Pragma("unroll") for (int h_ = 0; h_ < 2; ++h_) _Pragma("unroll") for (int i_ = 0; i_ < 2; ++i_) { \
        if constexpr (Sched::GATHER) dst[h_][i_] = (unsigned)(S.row_of(ui_, h_ * HALF + RA[i_]) * lda * EB + CA[i_] * 2); else dst[h_][i_] = (unsigned)((h_ * HALF + RA[i_]) * lda * EB + CA[i_] * 2); } } while (0)
    const size_t kstep = (size_t)(BK * 2);
    const size_t hstepB = (size_t)HALF * ldb * EB;
    const unsigned ldsw = (unsigned)wid * 1024u;
    const int aoff = lds_byte(wr * 64 + fr, fq * 8), boff = lds_byte(wc * 32 + fr, fq * 8);
#define PG8_SA(b, h) (((b) * 2 + (h)) * HTB)
#define PG8_SB(b, h) ((4 + (b) * 2 + (h)) * HTB)
#define PG8_STAGE(bufoff, gbase, voff) do { _Pragma("unroll") for (int _i = 0; _i < 2; ++_i) \
        __builtin_amdgcn_global_load_lds((const unsigned*)((const char*)(gbase) + (voff)[_i]), (LAS unsigned*)(lds + (bufoff) + ldsw + _i * 8192), 16, 0, 0); } while (0)
#define PG8_LDA(dst, b, h) do { _Pragma("unroll") for (int m = 0; m < 4; ++m) _Pragma("unroll") for (int k = 0; k < 2; ++k) dst[m][k] = *(const LAS frag_t*)(lds + PG8_SA(b, h) + aoff + m * 2048 + k * 1024); } while (0)
#define PG8_LDB(dst, b, h) do { _Pragma("unroll") for (int n = 0; n < 2; ++n) _Pragma("unroll") for (int k = 0; k < 2; ++k) dst[n][k] = *(const LAS frag_t*)(lds + PG8_SB(b, h) + boff + n * 2048 + k * 1024); } while (0)
#define PG8_MMA(ai, bj, At, Bt) do { __builtin_amdgcn_s_setprio(1); _Pragma("unroll") for (int m = 0; m < 4; ++m) _Pragma("unroll") for (int n = 0; n < 2; ++n) _Pragma("unroll") for (int k = 0; k < 2; ++k) \
        acc[ai][bj][m][n] = mma16(Bt[n][k], At[m][k], acc[ai][bj][m][n]); __builtin_amdgcn_s_setprio(0); } while (0)
#define PG8_WAIT_V(n) asm volatile("s_waitcnt vmcnt(" #n ")" ::: "memory")
#define PG8_WAIT_L(n) asm volatile("s_waitcnt lgkmcnt(" #n ")" ::: "memory")
#define PG8_BAR __builtin_amdgcn_s_barrier()
#define PG8_SCHED __builtin_amdgcn_sched_barrier(0)
    Unit cur, nxt; int ui = 0;
    if (!S.next(0, cur)) return;
    acc_t acc[2][2][4][2];
#pragma unroll
    for (int a = 0; a < 2; ++a)
#pragma unroll
        for (int b = 0; b < 2; ++b)
#pragma unroll
            for (int m = 0; m < 4; ++m)
#pragma unroll
                for (int n = 0; n < 2; ++n) acc[a][b][m][n] = (acc_t){0, 0, 0, 0};
    frag_t At[4][2], B0[2][2], B1[2][2];
    const char* cA = cur.a; const char* cB = cur.b;
    PG8_AOFF(voffC, 0); PG8_AOFF(voffN, 0);
    PG8_STAGE(PG8_SB(0, 0), cB, voffB); PG8_STAGE(PG8_SB(0, 1), cB + hstepB, voffB); PG8_STAGE(PG8_SA(0, 0), cA, voffC[0]); PG8_STAGE(PG8_SA(0, 1), cA, voffC[1]);
    if (wr == 1) PG8_BAR;
    PG8_WAIT_V(2); PG8_BAR;
    PG8_STAGE(PG8_SB(1, 0), cB + kstep, voffB); PG8_STAGE(PG8_SA(1, 0), cA + kstep, voffC[0]); PG8_STAGE(PG8_SB(1, 1), cB + hstepB + kstep, voffB);
    PG8_WAIT_V(6); PG8_BAR;
    for (;;) {
        const bool has_next = S.next(ui + 1, nxt);
        const char* nA = has_next ? nxt.a : cA; const char* nB = has_next ? nxt.b : cB;
        if constexpr (Sched::GATHER) { if (has_next) PG8_AOFF(voffN, ui + 1); }
#pragma clang loop unroll(disable)
        for (int t = 0; t < nt; t += 2) {
            const bool last = (t == nt - 2);
            const char* a1 = cA + (size_t)(t + 1) * kstep;
            const char* a2 = last ? nA : cA + (size_t)(t + 2) * kstep; const char* b2 = last ? nB : cB + (size_t)(t + 2) * kstep;
            const char* a3 = a2 + kstep; const char* b3 = b2 + kstep;
            unsigned vA0[2], vA1[2];
            if constexpr (Sched::GATHER) { vA0[0] = last ? voffN[0][0] : voffC[0][0]; vA0[1] = last ? voffN[0][1] : voffC[0][1]; vA1[0] = last ? voffN[1][0] : voffC[1][0]; vA1[1] = last ? voffN[1][1] : voffC[1][1]; }
            else { vA0[0] = voffC[0][0]; vA0[1] = voffC[0][1]; vA1[0] = voffC[1][0]; vA1[1] = voffC[1][1]; }
            PG8_LDB(B0, 0, 0); PG8_LDB(B1, 0, 1); PG8_SCHED; PG8_LDA(At, 0, 0); PG8_STAGE(PG8_SA(1, 1), a1, voffC[1]);
            PG8_WAIT_V(8); PG8_WAIT_L(0); PG8_BAR; PG8_MMA(0, 0, At, B0); PG8_MMA(0, 1, At, B1); PG8_BAR; PG8_SCHED;
            PG8_LDA(At, 0, 1); PG8_STAGE(PG8_SB(0, 0), b2, voffB); PG8_STAGE(PG8_SB(0, 1), b2 + hstepB, voffB); PG8_STAGE(PG8_SA(0, 0), a2, vA0);
            PG8_WAIT_V(8); PG8_WAIT_L(0); PG8_BAR; PG8_MMA(1, 0, At, B0); PG8_MMA(1, 1, At, B1); PG8_BAR; PG8_SCHED;
            PG8_LDB(B0, 1, 0); PG8_LDB(B1, 1, 1); PG8_SCHED; PG8_LDA(At, 1, 0); PG8_STAGE(PG8_SA(0, 1), a2, vA1);
            PG8_WAIT_V(8); PG8_WAIT_L(0); PG8_BAR; PG8_MMA(0, 0, At, B0); PG8_MMA(0, 1, At, B1); PG8_BAR; PG8_SCHED;
            PG8_LDA(At, 1, 1); PG8_STAGE(PG8_SB(1, 0), b3, voffB); PG8_STAGE(PG8_SB(1, 1), b3 + hstepB, voffB); PG8_STAGE(PG8_SA(1, 0), a3, vA0);
            PG8_WAIT_V(8); PG8_WAIT_L(0); PG8_BAR; PG8_MMA(1, 0, At, B0); PG8_MMA(1, 1, At, B1); PG8_BAR; PG8_SCHED;
        }
        if (wr == 0) PG8_BAR;
        { int te = tid; asm volatile("" : "+v"(te));
          const int we = __builtin_amdgcn_readfirstlane(te >> 6), le = te & 63;
          E(acc, cur, we >> 2, we & 3, le & 15, le >> 4); }
        if (!has_next) break;
#pragma unroll
        for (int a = 0; a < 2; ++a)
#pragma unroll
            for (int b = 0; b < 2; ++b)
#pragma unroll
                for (int m = 0; m < 4; ++m)
#pragma unroll
                    for (int n = 0; n < 2; ++n) acc[a][b][m][n] = (acc_t){0, 0, 0, 0};
        cur = nxt; cA = nA; cB = nB; ++ui;
        if constexpr (Sched::GATHER) {
#pragma unroll
            for (int h_ = 0; h_ < 2; ++h_) { voffC[h_][0] = voffN[h_][0]; voffC[h_][1] = voffN[h_][1]; } }
        if (wr == 1) PG8_BAR;
    }
    PG8_WAIT_V(0);
    PG8_BAR;
#undef PG8_AOFF
#undef PG8_SA
#undef PG8_SB
#undef PG8_STAGE
#undef PG8_LDA
#undef PG8_LDB
#undef PG8_MMA
#undef PG8_WAIT_V
#undef PG8_WAIT_L
#undef PG8_BAR
#undef PG8_SCHED
}

struct GridOrder {
    int nM, nN, nwg, G, c, uneven;
    __device__ __forceinline__ void init(int nM_, int nN_, int G_, int c_) { nM = nM_; nN = nN_; nwg = nM * nN; G = G_; c = c_; uneven = 0; }
    __device__ __forceinline__ bool tile(int i, int& pm, int& pn) const {
        long L = (long)i * G + c;
        if (uneven) {
            if (c < 128) { if (i >= 2) return false; L = i * 128 + c; } else { if (i >= 4) return false; L = 256 + (c - 128) + 128 * i; } }
        if (L >= nwg) return false;
        int wgid = (int)L; { const int q = nwg / 8, r = nwg % 8, xcd = wgid % 8, off = wgid / 8; wgid = (xcd < r ? xcd * (q + 1) : r * (q + 1) + (xcd - r) * q) + off; }
        const int nig = 8 * nN, gid = wgid / nig, fm = gid * 8, gsz = (nM - fm) < 8 ? (nM - fm) : 8;
        pm = fm + ((wgid % nig) % gsz); pn = (wgid % nig) / gsz; return true;
    }
};
}

__device__ __forceinline__ int uni(int v) { return __builtin_amdgcn_readfirstlane(v); }
__device__ __forceinline__ const char* uniptr(const char* p) { const unsigned long long v = (unsigned long long)p; const unsigned lo = __builtin_amdgcn_readfirstlane((unsigned)v), hi = __builtin_amdgcn_readfirstlane((unsigned)(v >> 32)); return (const char*)(((unsigned long long)hi << 32) | lo); }
struct DenseSched {
    static constexpr bool GATHER = false;
    pg8::GridOrder o; const char* A; size_t a_sel_stride; int pn_per_a; const char* B; size_t tstepA, tstepB;
    __device__ __forceinline__ bool next(int i, pg8::Unit& u) const {
        if (!o.tile(i, u.pm, u.pn)) return false;
        u.pm = uni(u.pm); u.pn = uni(u.pn); u.ui = i;
        u.a = uniptr(A + (size_t)(u.pn / pn_per_a) * a_sel_stride + (size_t)u.pm * tstepA); u.b = uniptr(B + (size_t)u.pn * tstepB); return true;
    }
};
struct MoeSched {
    static constexpr bool GATHER = false;
    const LAS int* tileE; int ntiles, npn, G, c; const char* A; const char* B; size_t tstepA, tstepB, estride;
    __device__ __forceinline__ bool next(int i, pg8::Unit& u) const {
        const int L = i * G + c; if (L >= ntiles * npn) return false;
        u.pm = uni(L / npn); u.pn = uni(L % npn); u.ui = i;
        const int e = __builtin_amdgcn_readfirstlane(tileE[u.pm]);
        u.a = uniptr(A + (size_t)u.pm * tstepA); u.b = uniptr(B + (size_t)e * estride + (size_t)u.pn * tstepB); return true;
    }
};
struct MoeGatherSched {
    static constexpr bool GATHER = true;
    const LAS int* tileE; const LAS int* rowtab; int ntiles, G, c; const char* A; const char* B; size_t tstepB, estride;
    __device__ __forceinline__ bool next(int i, pg8::Unit& u) const {
        const int L = i * G + c; if (L >= ntiles * 2) return false;
        u.pm = uni(L >> 1); u.pn = uni(L & 1); u.ui = i;
        const int e = __builtin_amdgcn_readfirstlane(tileE[u.pm]);
        u.a = A; u.b = uniptr(B + (size_t)e * estride + (size_t)u.pn * tstepB); return true;
    }
    __device__ __forceinline__ int row_of(int i, int r) const { return rowtab[i * 256 + r]; }
};
using pg8::Unit; using pg8::cvt_pk_bf16;
__device__ __forceinline__ void st8(bf16* p, const f32x4& v0, const f32x4& v1) {
    u32x4 w; w.x = cvt_pk_bf16(v0[0], v0[1]); w.y = cvt_pk_bf16(v0[2], v0[3]); w.z = cvt_pk_bf16(v1[0], v1[1]); w.w = cvt_pk_bf16(v1[2], v1[3]);
    *(u32x4*)p = w;
}
struct EpiSplit {
    static constexpr bool PERM = true, I8 = false;
    bf16* O; size_t split_stride; float scale;
    __device__ __forceinline__ void operator()(const f32x4 (&acc)[2][2][4][2], const Unit& u, int wr, int wc, int fr, int fq) const {
        const int row0 = u.pm * 256 + wr * 64 + fr; const int colt = u.pn * 256; const int t = colt >> 10;
        bf16* base = O + (size_t)t * split_stride; const int col0 = (colt & 1023) + wc * 32 + 8 * fq;
#pragma unroll
        for (int ai = 0; ai < 2; ++ai)
#pragma unroll
            for (int m = 0; m < 4; ++m) { bf16* rowp = base + (size_t)(row0 + ai * 128 + m * 16) * 1024 + col0;
#pragma unroll
                for (int bj = 0; bj < 2; ++bj) st8(rowp + bj * 128, acc[ai][bj][m][0] * scale, acc[ai][bj][m][1] * scale); }
    }
};
struct EpiLoraDn {
    static constexpr bool PERM = true, I8 = false;
    bf16* O;
    __device__ __forceinline__ void operator()(const f32x4 (&acc)[2][2][4][2], const Unit& u, int wr, int wc, int fr, int fq) const {
        const int row0 = u.pm * 256 + wr * 64 + fr; const int col0 = u.pn * 256 + wc * 32 + 8 * fq;
#pragma unroll
        for (int ai = 0; ai < 2; ++ai)
#pragma unroll
            for (int m = 0; m < 4; ++m) { bf16* rowp = O + (size_t)(row0 + ai * 128 + m * 16) * 512 + col0;
#pragma unroll
                for (int bj = 0; bj < 2; ++bj) { f32x4 v0 = acc[ai][bj][m][0], v1 = acc[ai][bj][m][1];
                    const int mode = (u.pn == 1) ? 2 : ((wc >> 1) & 1);
                    if (mode == 0) {
#pragma unroll
                        for (int j = 0; j < 4; ++j) { v0[j] = 1.0f - 2.0f / (__expf(2.0f * v0[j]) + 1.0f); v1[j] = 1.0f - 2.0f / (__expf(2.0f * v1[j]) + 1.0f); } }
                    else if (mode == 2) {
#pragma unroll
                        for (int j = 0; j < 4; ++j) { v0[j] = sigmoidf_(v0[j]); v1[j] = sigmoidf_(v1[j]); } }
                    st8(rowp + bj * 128, v0, v1); } }
    }
};
struct EpiLoraUpWA {
    static constexpr bool PERM = true, I8 = false;
    bf16* LD; bf16* AS; const float* w0; const float* a0;
    __device__ __forceinline__ void operator()(const f32x4 (&acc)[2][2][4][2], const Unit& u, int wr, int wc, int fr, int fq) const {
        const int z = u.pn >> 3, kind = (u.pn >> 2) & 1;
        const int row0 = u.pm * 256 + wr * 64 + fr; const int col0 = (u.pn & 3) * 256 + wc * 32 + 8 * fq;
        bf16* base = (kind ? AS : LD) + (size_t)z * T * D; const float* bias = (kind ? a0 : w0) + z * 1024;
        f32x4 bv[2][2];
#pragma unroll
        for (int bj = 0; bj < 2; ++bj)
#pragma unroll
            for (int n = 0; n < 2; ++n) bv[bj][n] = *(const f32x4*)(bias + col0 + bj * 128 + 4 * n);
#pragma unroll
        for (int ai = 0; ai < 2; ++ai)
#pragma unroll
            for (int m = 0; m < 4; ++m) { bf16* rowp = base + (size_t)(row0 + ai * 128 + m * 16) * 1024 + col0;
#pragma unroll
                for (int bj = 0; bj < 2; ++bj) { f32x4 v[2];
#pragma unroll
                    for (int n = 0; n < 2; ++n) { v[n] = acc[ai][bj][m][n] + bv[bj][n];
#pragma unroll
                        for (int j = 0; j < 4; ++j) { const float x = v[n][j];
                            if (kind == 0) v[n][j] = -0.8750612633917001f * sigmoidf_(x);
                            else v[n][j] = sigmoidf_(x); } }
                    st8(rowp + bj * 128, v[0], v[1]); } }
    }
};
struct EpiResid {
    static constexpr bool PERM = true, I8 = false;
    const void* xin; int xin_f32; bf16* out; const float* gate;
    __device__ __forceinline__ void operator()(const f32x4 (&acc)[2][2][4][2], const Unit& u, int wr, int wc, int fr, int fq) const {
        const int row0 = u.pm * 256 + wr * 64 + fr, col0 = u.pn * 256 + wc * 32 + 8 * fq; const int b = u.pm >> 3;
        f32x4 gv[2][2];
#pragma unroll
        for (int bj = 0; bj < 2; ++bj)
#pragma unroll
            for (int n = 0; n < 2; ++n) gv[bj][n] = *(const f32x4*)(gate + (size_t)b * 6144 + col0 + bj * 128 + 4 * n);
        if (xin_f32) {
#pragma unroll
            for (int ai = 0; ai < 2; ++ai)
#pragma unroll
                for (int m = 0; m < 4; ++m) { const size_t off = (size_t)(row0 + ai * 128 + m * 16) * D + col0;
#pragma unroll
                    for (int bj = 0; bj < 2; ++bj) { const f32x4 x0 = *(const f32x4*)((const float*)xin + off + bj * 128), x1 = *(const f32x4*)((const float*)xin + off + bj * 128 + 4);
                        st8(out + off + bj * 128, x0 + gv[bj][0] * acc[ai][bj][m][0], x1 + gv[bj][1] * acc[ai][bj][m][1]); } }
        } else {
#pragma unroll
            for (int ai = 0; ai < 2; ++ai) { u32x4 xr[4][2];
#pragma unroll
                for (int m = 0; m < 4; ++m)
#pragma unroll
                    for (int bj = 0; bj < 2; ++bj) xr[m][bj] = *(const u32x4*)((const bf16*)xin + (size_t)(row0 + ai * 128 + m * 16) * D + col0 + bj * 128);
#pragma unroll
                for (int m = 0; m < 4; ++m) { const size_t off = (size_t)(row0 + ai * 128 + m * 16) * D + col0;
#pragma unroll
                    for (int bj = 0; bj < 2; ++bj) { const u32x4 r = xr[m][bj];
                        const f32x4 x0 = {bf_lo(r.x), bf_hi(r.x), bf_lo(r.y), bf_hi(r.y)}, x1 = {bf_lo(r.z), bf_hi(r.z), bf_lo(r.w), bf_hi(r.w)};
                        st8(out + off + bj * 128, x0 + gv[bj][0] * acc[ai][bj][m][0], x1 + gv[bj][1] * acc[ai][bj][m][1]); } } }
        }
    }
};
struct EpiQKV {
    static constexpr bool PERM = true, I8 = false;
    bf16* Q; bf16* Kb; bf16* Vb; float qscale;
    __device__ __forceinline__ void operator()(const f32x4 (&acc)[2][2][4][2], const Unit& u, int wr, int wc, int fr, int fq) const {
        const int g = u.pn / 12, which = (u.pn % 12) >> 2, hp = u.pn & 3;
        const int row0 = u.pm * 256 + wr * 64 + fr;
        bf16* base = Q + (size_t)which * ((A_K - A_Q) / 2) + (size_t)g * T * D; const float sc = which ? 1.0f : qscale; const int col0 = hp * 256 + wc * 32 + 8 * fq;
#pragma unroll
        for (int ai = 0; ai < 2; ++ai)
#pragma unroll
            for (int m = 0; m < 4; ++m) { bf16* rowp = base + (size_t)(row0 + ai * 128 + m * 16) * 1024 + col0;
#pragma unroll
                for (int bj = 0; bj < 2; ++bj) st8(rowp + bj * 128, acc[ai][bj][m][0] * sc, acc[ai][bj][m][1] * sc); }
    }
};
template <class Inner> struct EpiI8 {
    static constexpr bool PERM = Inner::PERM, I8 = true;
    Inner in; const float* sa; size_t sa_sel; int pn_per_a; const float* sb;
    __device__ __forceinline__ void operator()(const pg8::i32x4 (&acc)[2][2][4][2], const Unit& u, int wr, int wc, int fr, int fq) const {
        const int row0 = u.pm * 256 + wr * 64 + fr; const float* sap = sa + (size_t)(u.pn / pn_per_a) * sa_sel;
        const int colb = u.pn * 256 + wc * 32 + (PERM ? 8 * fq : 4 * fq);
        f32x4 sbv[2][2]; f32x4 f[2][2][4][2];
#pragma unroll
        for (int bj = 0; bj < 2; ++bj)
#pragma unroll
            for (int n = 0; n < 2; ++n) sbv[bj][n] = *(const f32x4*)(sb + colb + bj * 128 + (PERM ? 4 * n : 16 * n));
#pragma unroll
        for (int ai = 0; ai < 2; ++ai)
#pragma unroll
            for (int m = 0; m < 4; ++m) { const float sr = sap[row0 + ai * 128 + m * 16];
#pragma unroll
                for (int bj = 0; bj < 2; ++bj)
#pragma unroll
                    for (int n = 0; n < 2; ++n) f[ai][bj][m][n] = __builtin_convertvector(acc[ai][bj][m][n], f32x4) * (sbv[bj][n] * sr); }
        in(f, u, wr, wc, fr, fq);
    }
};
struct EpiQKV8 {
    static constexpr bool PERM = true, I8 = true;
    bf16* Q; const float* SA; const float* SBq; float qscale;
    __device__ __forceinline__ void operator()(const pg8::i32x4 (&acc)[2][2][4][2], const Unit& u, int wr, int wc, int fr, int fq) const {
        const int g = u.pn / 12, which = (u.pn % 12) >> 2, hp = u.pn & 3;
        const int row0 = u.pm * 256 + wr * 64 + fr;
        bf16* base = Q + (size_t)which * ((A_K - A_Q) / 2) + (size_t)g * T * D; const float sc = which ? 1.0f : qscale; const int col0 = hp * 256 + wc * 32 + 8 * fq;
        const int colb = u.pn * 256 + wc * 32 + 8 * fq;
        f32x4 sbv[2][2];
#pragma unroll
        for (int bj = 0; bj < 2; ++bj)
#pragma unroll
            for (int n = 0; n < 2; ++n) sbv[bj][n] = *(const f32x4*)(SBq + colb + bj * 128 + 4 * n) * sc;
#pragma unroll
        for (int ai = 0; ai < 2; ++ai)
#pragma unroll
            for (int m = 0; m < 4; ++m) { const int row = row0 + ai * 128 + m * 16; const float sa = SA[row]; bf16* rowp = base + (size_t)row * 1024 + col0;
#pragma unroll
                for (int bj = 0; bj < 2; ++bj) st8(rowp + bj * 128, __builtin_convertvector(acc[ai][bj][m][0], f32x4) * (sbv[bj][0] * sa), __builtin_convertvector(acc[ai][bj][m][1], f32x4) * (sbv[bj][1] * sa)); }
    }
};
struct EpiGateUp {
    static constexpr bool PERM = true, I8 = false;
    bf16* H; const float* roww;
    __device__ __forceinline__ void operator()(const f32x4 (&acc)[2][2][4][2], const Unit& u, int wr, int wc, int fr, int fq) const {
        const int row0 = u.pm * 256 + wr * 64 + fr; const int col0 = u.pn * 128 + wc * 32 + 8 * fq;
#pragma unroll
        for (int ai = 0; ai < 2; ++ai)
#pragma unroll
            for (int m = 0; m < 4; ++m) { const int row = row0 + ai * 128 + m * 16; const float rw = roww[row]; f32x4 v[2];
#pragma unroll
                for (int n = 0; n < 2; ++n)
#pragma unroll
                    for (int j = 0; j < 4; ++j) { const float gg = acc[ai][0][m][n][j], uu = acc[ai][1][m][n][j]; v[n][j] = gg * sigmoidf_(gg) * uu * rw; }
                st8(H + (size_t)row * FEXP + col0, v[0], v[1]); }
    }
};
struct EpiGateUp8 {
    static constexpr bool PERM = true, I8 = true;
    bf16* H; const LAS float* wtab; const LAS float* stab; const float* sbe; const LAS int* tileE;
    __device__ __forceinline__ void operator()(const pg8::i32x4 (&acc)[2][2][4][2], const Unit& u, int wr, int wc, int fr, int fq) const {
        const int rl0 = wr * 64 + fr; const int col0 = u.pn * 128 + wc * 32 + 8 * fq;
        const int e = __builtin_amdgcn_readfirstlane(tileE[u.pm]); const float* sbp = sbe + (size_t)e * 512 + u.pn * 256 + wc * 32 + 8 * fq;
        f32x4 sg[2], su[2];
#pragma unroll
        for (int n = 0; n < 2; ++n) { sg[n] = *(const f32x4*)(sbp + 4 * n); su[n] = *(const f32x4*)(sbp + 128 + 4 * n); }
#pragma unroll
        for (int ai = 0; ai < 2; ++ai)
#pragma unroll
            for (int m = 0; m < 4; ++m) { const int rl = rl0 + ai * 128 + m * 16; const float rw = wtab[u.ui * 256 + rl]; const float sa = stab[u.ui * 256 + rl]; f32x4 v[2];
#pragma unroll
                for (int n = 0; n < 2; ++n) { const f32x4 g4 = __builtin_convertvector(acc[ai][0][m][n], f32x4) * (sg[n] * sa), u4 = __builtin_convertvector(acc[ai][1][m][n], f32x4) * (su[n] * sa);
#pragma unroll
                    for (int j = 0; j < 4; ++j) { const float gg = g4[j], uu = u4[j]; v[n][j] = gg * sigmoidf_(gg) * uu * rw; } }
                st8(H + (size_t)(u.pm * 256 + rl) * FEXP + col0, v[0], v[1]); }
    }
};
struct EpiPlain {
    static constexpr bool PERM = true, I8 = false;
    bf16* O;
    __device__ __forceinline__ void operator()(const f32x4 (&acc)[2][2][4][2], const Unit& u, int wr, int wc, int fr, int fq) const {
        const int row0 = u.pm * 256 + wr * 64 + fr; const int col0 = u.pn * 256 + wc * 32 + 8 * fq;
#pragma unroll
        for (int ai = 0; ai < 2; ++ai)
#pragma unroll
            for (int m = 0; m < 4; ++m) { bf16* rowp = O + (size_t)(row0 + ai * 128 + m * 16) * 1024 + col0;
#pragma unroll
                for (int bj = 0; bj < 2; ++bj) st8(rowp + bj * 128, acc[ai][bj][m][0], acc[ai][bj][m][1]); }
    }
};

struct Args {
    const float* in[32]; float* out; unsigned char* ws; int ph_lo, ph_hi;
};
enum { I_X = 0, I_C, I_ADAW, I_ADAB, I_NTM, I_NCM, I_MU, I_WRKV, I_W0, I_W1, I_W2, I_A0, I_A1, I_A2, I_G1, I_G2, I_KK, I_KA, I_RK, I_LNW, I_LNB, I_RWO,
       I_AQKV, I_AWO, I_RG, I_RGB, I_RE, I_REB, I_WG, I_WU, I_WD, I_FG };

struct Frame {
    LAS unsigned char* lds; int tid, lane, wave, G, gw, NGW;
    unsigned char* ws; const float* const* in; float* out;
};

__device__ __forceinline__ void row_load(const float* p, int lane, f32x4 (&v)[4]) {
#pragma unroll
    for (int j = 0; j < 4; ++j) v[j] = *(const f32x4*)(p + 4 * lane + 256 * j);
}
__device__ __forceinline__ void row_load_bf16(const bf16* p, int lane, f32x4 (&v)[4]) {
#pragma unroll
    for (int j = 0; j < 4; ++j) { const u32x2 r = *(const u32x2*)(p + 4 * lane + 256 * j); v[j] = (f32x4){bf_lo(r.x), bf_hi(r.x), bf_lo(r.y), bf_hi(r.y)}; }
}
__device__ __forceinline__ void row_store(float* p, int lane, const f32x4 (&v)[4]) {
#pragma unroll
    for (int j = 0; j < 4; ++j) *(f32x4*)(p + 4 * lane + 256 * j) = v[j];
}
__device__ __forceinline__ void row_store_bf16(bf16* p, int lane, const f32x4 (&v)[4]) {
#pragma unroll
    for (int j = 0; j < 4; ++j) { u32x2 w; w.x = pk2(v[j][0], v[j][1]); w.y = pk2(v[j][2], v[j][3]); *(u32x2*)(p + 4 * lane + 256 * j) = w; }
}
__device__ __forceinline__ void row_store_i8(signed char* p, float* scl, int lane, const f32x4 (&v)[4]) {
    float am = 0.f;
#pragma unroll
    for (int j = 0; j < 4; ++j) am = fmaxf(am, fmaxf(fmaxf(fabsf(v[j][0]), fabsf(v[j][1])), fmaxf(fabsf(v[j][2]), fabsf(v[j][3]))));
    am = fmaxf(wave_max(am), 1e-20f); const float inv = 127.0f / am;
    if (lane == 0) *scl = am * (1.0f / 127.0f);
#pragma unroll
    for (int j = 0; j < 4; ++j) *(unsigned*)(p + 4 * lane + 256 * j) = pack_i8x4(v[j], inv);
}
struct TokTab { const int* toke; const int* tokr; const LAS int* offs; };
__device__ __forceinline__ void row_combine(f32x4 (&v)[4], const bf16* ys, const TokTab& tt, int row, const float* gac, int lane) {
    const int p0 = tt.offs[tt.toke[2 * row]] + tt.tokr[2 * row], p1 = tt.offs[tt.toke[2 * row + 1]] + tt.tokr[2 * row + 1];
    const bf16* y0 = ys + (size_t)p0 * D; const bf16* y1 = ys + (size_t)p1 * D;
#pragma unroll
    for (int j = 0; j < 4; ++j) { const u32x2 a = *(const u32x2*)(y0 + 4 * lane + 256 * j), b = *(const u32x2*)(y1 + 4 * lane + 256 * j); const f32x4 g = *(const f32x4*)(gac + 4 * lane + 256 * j);
        v[j][0] += g[0] * (bf_lo(a.x) + bf_lo(b.x)); v[j][1] += g[1] * (bf_hi(a.x) + bf_hi(b.x)); v[j][2] += g[2] * (bf_lo(a.y) + bf_lo(b.y)); v[j][3] += g[3] * (bf_hi(a.y) + bf_hi(b.y)); }
}
__device__ __forceinline__ void row_norm_mod(const f32x4 (&x)[4], const float* gain, const float* sc, const float* sh, int lane, f32x4 (&h)[4]) {
    float s = 0.f;
#pragma unroll
    for (int j = 0; j < 4; ++j) s += (x[j][0] * x[j][0] + x[j][1] * x[j][1]) + (x[j][2] * x[j][2] + x[j][3] * x[j][3]);
    const float rstd = rsqrtf(wave_sum(s, lane) * (1.0f / D) + RMS_EPS);
#pragma unroll
    for (int j = 0; j < 4; ++j) { const f32x4 g = *(const f32x4*)(gain + 4 * lane + 256 * j), c = *(const f32x4*)(sc + 4 * lane + 256 * j), b = *(const f32x4*)(sh + 4 * lane + 256 * j);
        h[j] = x[j] * rstd * g * (1.0f + c) + b; }
}
__device__ __forceinline__ void transpose_item(const float* W, int ldw, bf16* dst, int ldd, LAS float* scr, int lane) {
    { const int r8 = lane >> 3, c4 = (lane & 7) * 4;
      f32x4 v[8];
#pragma unroll
      for (int i = 0; i < 8; ++i) v[i] = *(const f32x4*)(W + (size_t)(8 * i + r8) * ldw + c4);
#pragma unroll
      for (int i = 0; i < 8; ++i) { LAS float* p = scr + (8 * i + r8) * 33 + c4; p[0] = v[i][0]; p[1] = v[i][1]; p[2] = v[i][2]; p[3] = v[i][3]; } }
    LDS_WAIT(); asm volatile("" ::: "memory");
    const int c = lane & 7;
#pragma unroll
    for (int j = 0; j < 4; ++j) { const int n = (lane >> 3) + 8 * j; const LAS float* s = scr + (8 * c) * 33 + n;
        u32x4 o; o.x = pk2(s[0 * 33], s[1 * 33]); o.y = pk2(s[2 * 33], s[3 * 33]); o.z = pk2(s[4 * 33], s[5 * 33]); o.w = pk2(s[6 * 33], s[7 * 33]);
        *(u32x4*)(dst + (size_t)n * ldd + 8 * c) = o; }
    LDS_WAIT(); asm volatile("" ::: "memory");
}

__device__ __forceinline__ void conv8_cols32(Frame& F, const float* src, int ldw, signed char* dst, float* scl) {
    LAS float* scr = (LAS float*)(F.lds + 49152 + F.wave * 8704); LAS float* pm = (LAS float*)(F.lds + 118784);
    const int r8 = F.lane >> 3, c4 = (F.lane & 7) * 4;
    f32x4 v[16]; f32x4 mx = {0.f, 0.f, 0.f, 0.f};
#pragma unroll
    for (int i = 0; i < 16; ++i) { v[i] = *(const f32x4*)(src + (size_t)(F.wave * 128 + 8 * i + r8) * ldw + c4);
        mx[0] = fmaxf(mx[0], fabsf(v[i][0])); mx[1] = fmaxf(mx[1], fabsf(v[i][1])); mx[2] = fmaxf(mx[2], fabsf(v[i][2])); mx[3] = fmaxf(mx[3], fabsf(v[i][3])); }
#pragma unroll
    for (int q = 0; q < 4; ++q) { float a = mx[q]; a = fmaxf(a, dpp_ror(a, 8)); a = bfly16_max(a); a = bfly32_max(a); mx[q] = a; }
    if (r8 == 0) *(LAS f32x4*)(pm + F.wave * 32 + c4) = mx;
    __syncthreads();
    f32x4 cm = *(const LAS f32x4*)(pm + c4);
#pragma unroll
    for (int w = 1; w < 8; ++w) { const f32x4 o = *(const LAS f32x4*)(pm + w * 32 + c4); cm[0] = fmaxf(cm[0], o[0]); cm[1] = fmaxf(cm[1], o[1]); cm[2] = fmaxf(cm[2], o[2]); cm[3] = fmaxf(cm[3], o[3]); }
#pragma unroll
    for (int q = 0; q < 4; ++q) cm[q] = fmaxf(cm[q], 1e-20f);
    if (F.wave == 0 && r8 == 0) *(f32x4*)(scl + c4) = cm * (1.0f / 127.0f);
#pragma unroll
    for (int kh = 0; kh < 2; ++kh) {
#pragma unroll
        for (int i = 0; i < 8; ++i) { LAS float* p = scr + (8 * i + r8) * 33 + c4; const f32x4 x = v[8 * kh + i]; p[0] = x[0] * (127.0f / cm[0]); p[1] = x[1] * (127.0f / cm[1]); p[2] = x[2] * (127.0f / cm[2]); p[3] = x[3] * (127.0f / cm[3]); }
        LDS_WAIT(); asm volatile("" ::: "memory");
        const int c = F.lane & 7;
#pragma unroll
        for (int jj = 0; jj < 4; ++jj) { const int n = (F.lane >> 3) + 8 * jj; const LAS float* sp = scr + (8 * c) * 33 + n;
            u32x2 o; o.x = pack_i8x4((f32x4){sp[0 * 33], sp[1 * 33], sp[2 * 33], sp[3 * 33]}, 1.0f); o.y = pack_i8x4((f32x4){sp[4 * 33], sp[5 * 33], sp[6 * 33], sp[7 * 33]}, 1.0f);
            *(u32x2*)(dst + (size_t)n * D + (F.wave * 2 + kh) * 64 + 8 * c) = o; }
        LDS_WAIT(); asm volatile("" ::: "memory");
    }
    __syncthreads();
}
__device__ __forceinline__ void phase_prologue(Frame& F) {
    const float* c = F.in[I_C]; const float* adaw = F.in[I_ADAW]; const float* adab = F.in[I_ADAB];
    float* mod = (float*)(F.ws + WS_MOD);
    LAS float* sc = (LAS float*)F.lds;
    LAS float* part = (LAS float*)(F.lds + 32768);
    for (int i = F.tid; i < NB * D; i += NTHREADS) { const float v = c[i]; sc[i] = v / (1.0f + __expf(-v)); }
    __syncthreads();
    for (int u = blockIdx.x; u < DEPTH * 192; u += F.G) {
        const int l = u / 192, n0 = (u % 192) * 32; const int r8 = F.lane >> 3, c4 = (F.lane & 7) * 4;
        const float* W = adaw + (size_t)l * D * 6144 + n0 + c4;
        f32x4 v[16];
#pragma unroll
        for (int i = 0; i < 16; ++i) v[i] = *(const f32x4*)(W + (size_t)(F.wave * 128 + 8 * i + r8) * 6144);
        f32x4 acc[8];
#pragma unroll
        for (int b = 0; b < 8; ++b) acc[b] = (f32x4){0.f, 0.f, 0.f, 0.f};
#pragma unroll
        for (int i = 0; i < 16; ++i) { const int k = F.wave * 128 + 8 * i + r8;
#pragma unroll
            for (int b = 0; b < 8; ++b) acc[b] += v[i] * sc[b * D + k]; }
#pragma unroll
        for (int b = 0; b < 8; ++b)
#pragma unroll
            for (int q = 0; q < 4; ++q) { float a = acc[b][q]; a += dpp_ror(a, 8); a = bfly16_sum(a); a = bfly32_sum(a); acc[b][q] = a; }
        if (r8 == 0) {
#pragma unroll
            for (int b = 0; b < 8; ++b) *(LAS f32x4*)(part + (F.wave * 8 + b) * 32 + c4) = acc[b]; }
        __syncthreads();
        if (F.tid < 256) { const int b = F.tid >> 5, cc = F.tid & 31; float sum = adab[l * 6144 + n0 + cc];
#pragma unroll
            for (int w = 0; w < 8; ++w) sum += part[(w * 8 + b) * 32 + cc];
            mod[(size_t)(l * 8 + b) * 6144 + n0 + cc] = sum; }
        __syncthreads();
    }
    LAS float* scr = (LAS float*)(F.lds + 49152 + F.wave * 8704);
    constexpr int I_SQ = 16 * 32;
    constexpr int I_QKV = 16 * 288;
    constexpr int PER_RW = 4 * I_SQ, PER_AT = I_QKV + I_SQ, NIT = 2 * PER_RW + 2 * PER_AT;
    for (int it = F.gw; it < NIT; it += F.NGW) {
        int r = it;
        if (r < 2 * PER_RW) { const int j = r / PER_RW; r %= PER_RW; const int mi = r / I_SQ; r %= I_SQ; const int kb = r / 32, nb = r % 32;
            if (mi < 3) { }
            else transpose_item(F.in[I_RWO] + ((size_t)j * D + kb * 64) * D + nb * 32, D, (bf16*)(F.ws + WS_W + j * W_RW_STRIDE + W_RWO) + (size_t)(nb * 32) * D + kb * 64, D, scr, F.lane);
        } else { r -= 2 * PER_RW; const int j = r / PER_AT; r %= PER_AT;
            if (r < I_QKV) { }
            else { r -= I_QKV; const int kb = r / 32, nb = r % 32;
                transpose_item(F.in[I_AWO] + ((size_t)j * D + kb * 64) * D + nb * 32, D, (bf16*)(F.ws + WS_WA + j * W_AT_STRIDE + W_AWO) + (size_t)(nb * 32) * D + kb * 64, D, scr, F.lane); }
        }
    }
    for (int u = blockIdx.x; u < 2 * 288 + 2 * 96; u += F.G) {
        if (u < 2 * 288) { const int j = u / 288, n0 = (u % 288) * 32;
            conv8_cols32(F, F.in[I_AQKV] + (size_t)j * D * QKVW + n0, QKVW, (signed char*)(F.ws + WS_WA + j * W_AT_STRIDE + W_QKV) + (size_t)n0 * D, (float*)(F.ws + WS_WA + j * W_AT_STRIDE + W_QKVS) + n0); }
        else { const int r = u - 2 * 288, j = r / 96, mi = (r % 96) / 32, n0 = (r % 32) * 32;
            conv8_cols32(F, F.in[I_WRKV] + (size_t)(j * 3 + mi) * D * D + n0, D, (signed char*)(F.ws + WS_W + j * W_RW_STRIDE + W_RKV) + (size_t)(mi * D + n0) * D, (float*)(F.ws + WS_W + j * W_RW_STRIDE + W_RKVS) + mi * D + n0); }
    }
    const int gt = blockIdx.x * NTHREADS + F.tid, NGT = F.G * NTHREADS;
    for (int j = 0; j < 2; ++j) {
        bf16* ldn = (bf16*)(F.ws + WS_W + j * W_RW_STRIDE + W_LDN);
        const float* mu = F.in[I_MU] + (size_t)j * 6 * D;
        for (int i0 = gt; i0 < 512 * 2048; i0 += 8 * NGT) { float t[8];
#pragma unroll
            for (int u = 0; u < 8; ++u) { const int i = i0 + u * NGT; float v = 0.f;
                if (i < 512 * 2048) { const int n = i >> 11, k = i & 2047, kk = k & 1023; int mi;
                    if (n < 256) { const int blk = n >> 6, z = blk >> 1, isA = blk & 1, nn = n & 63;
                        v = (isA ? F.in[I_A1] : F.in[I_W1])[((size_t)(j * 2 + z) * D + kk) * 64 + nn]; mi = isA ? 4 : 3; }
                    else { const int z = (n - 256) >> 7, nn = n & 127; v = F.in[I_G1][((size_t)(j * 2 + z) * D + kk) * 128 + nn]; mi = 5; }
                    if (k >= 1024) v *= mu[mi * D + kk]; }
                t[u] = v; }
#pragma unroll
            for (int u = 0; u < 8; ++u) { const int i = i0 + u * NGT; if (i < 512 * 2048) ldn[i] = (bf16)f2bf(t[u]); } }
        bf16* lwa = (bf16*)(F.ws + WS_W + j * W_RW_STRIDE + W_LUPWA);
        for (int i0 = gt; i0 < 4096 * 128; i0 += 8 * NGT) { float t[8];
#pragma unroll
            for (int u = 0; u < 8; ++u) { const int i = i0 + u * NGT; float v = 0.f;
                if (i < 4096 * 128) { const int n = i >> 7, k = i & 127; const int z = n >> 11, isA = (n >> 10) & 1, col = n & 1023;
                    if ((k >> 6) == isA) v = (isA ? F.in[I_A2] : F.in[I_W2])[((size_t)(j * 2 + z) * 64 + (k & 63)) * D + col]; }
                t[u] = v; }
#pragma unroll
            for (int u = 0; u < 8; ++u) { const int i = i0 + u * NGT; if (i < 4096 * 128) lwa[i] = (bf16)f2bf(t[u]); } }
        bf16* lg = (bf16*)(F.ws + WS_W + j * W_RW_STRIDE + W_LUPG);
        for (int i0 = gt; i0 < 2048 * 128; i0 += 8 * NGT) { float t[8];
#pragma unroll
            for (int u = 0; u < 8; ++u) { const int i = i0 + u * NGT; float v = 0.f;
                if (i < 2048 * 128) { const int n = i >> 7, k = i & 127; const int z = n >> 10, col = n & 1023; v = F.in[I_G2][((size_t)(j * 2 + z) * 128 + k) * D + col]; }
                t[u] = v; }
#pragma unroll
            for (int u = 0; u < 8; ++u) { const int i = i0 + u * NGT; if (i < 2048 * 128) lg[i] = (bf16)f2bf(t[u]); } }
    }
}

__device__ __forceinline__ void moe_tables(Frame& F, int l) {
    LAS int* tileE = (LAS int*)(F.lds + TILEE_OFF); LAS int* tileJ = (LAS int*)(F.lds + TILEJ_OFF); LAS int* offs = (LAS int*)(F.lds + OFFS_OFF); LAS int* cl = (LAS int*)(F.lds + CNTL_OFF);
    const unsigned* cnt = (const unsigned*)(F.ws + WS_CTL) + CW_CNT + l * 32;
    if (F.tid < 32) cl[F.tid] = (int)__hip_atomic_load(cnt + F.tid, __ATOMIC_RELAXED, __HIP_MEMORY_SCOPE_AGENT);
    __syncthreads();
    if (F.tid < 32) {
        int tb = 0;
#pragma clang loop unroll(disable)
        for (int e = 0; e < F.tid; ++e) tb += (cl[e] + 255) >> 8;
        const int ne = (cl[F.tid] + 255) >> 8; offs[F.tid] = tb * 256;
#pragma clang loop unroll(disable)
        for (int k = 0; k < ne; ++k) if (tb + k < 160) { tileE[tb + k] = F.tid; tileJ[tb + k] = k; }
        if (F.tid == 31) { const int nt = tb + ne; tileE[160] = nt < 160 ? nt : 160; offs[32] = nt * 256; }
    }
    __syncthreads();
}
__device__ __forceinline__ void rw_hrow(Frame& F, int l, bool combine, const void* xsrc, bf16* xdst, bool own, int row, f32x4 (&h)[4]) {
    const int b = row >> 11; const float* mod = (const float*)(F.ws + WS_MOD);
    f32x4 x[4]; if (l == 0) row_load((const float*)xsrc + (size_t)row * D, F.lane, x); else row_load_bf16((const bf16*)xsrc + (size_t)row * D, F.lane, x);
    if (combine) { row_combine(x, (const bf16*)(F.ws + WS_ACT + A_YS), TokTab{(const int*)(F.ws + WS_TOKE), (const int*)(F.ws + WS_TOKR), (const LAS int*)(F.lds + OFFS_OFF)}, row, mod + (size_t)((l - 1) * 8 + b) * 6144 + 5 * D, F.lane);
        if (own) row_store_bf16(xdst + (size_t)row * D, F.lane, x); }
    const float* mp = mod + (size_t)(l * 8 + b) * 6144;
    row_norm_mod(x, F.in[I_NTM] + l * D, mp + 1 * D, mp + 0 * D, F.lane, h);
}
__device__ __forceinline__ void phase_rw_norm(Frame& F, int l, bool combine, const void* xsrc, bf16* xdst) {
    if (combine) moe_tables(F, l - 1);
    const int j = l >> 1; const float* mu = F.in[I_MU] + (size_t)j * 6 * D;
    signed char* xs = (signed char*)(F.ws + WS_ACT + A_XS); bf16* hx = (bf16*)(F.ws + WS_ACT + A_HX); float* sxs = (float*)(F.ws + WS_SCL + SCL_XS);
    for (int ch = F.gw; ch < T / 8; ch += F.NGW) {
        const int row0 = ch * 8, t0 = row0 & (SEQ - 1);
        f32x4 prev[4], cur[4], nxt[4];
        if (t0 > 0) rw_hrow(F, l, combine, xsrc, xdst, false, row0 - 1, prev);
        else {
#pragma unroll
            for (int q = 0; q < 4; ++q) prev[q] = (f32x4){0.f, 0.f, 0.f, 0.f}; }
        rw_hrow(F, l, combine, xsrc, xdst, true, row0, cur);
        for (int i = 0; i < 8; ++i) {
            const int row = row0 + i;
            if (t0 + i + 1 < SEQ) rw_hrow(F, l, combine, xsrc, xdst, i < 7, row + 1, nxt);
            else {
#pragma unroll
                for (int q = 0; q < 4; ++q) nxt[q] = (f32x4){0.f, 0.f, 0.f, 0.f}; }
            f32x4 xx[4];
#pragma unroll
            for (int q = 0; q < 4; ++q) xx[q] = 0.5f * (prev[q] + nxt[q]) - cur[q];
#pragma unroll
            for (int mi = 0; mi < 3; ++mi) { f32x4 o[4];
#pragma unroll
                for (int q = 0; q < 4; ++q) { const f32x4 m = *(const f32x4*)(mu + mi * D + 4 * F.lane + 256 * q); o[q] = cur[q] + xx[q] * m; }
                row_store_i8(xs + ((size_t)mi * T + row) * D, sxs + (size_t)mi * T + row, F.lane, o); }
            row_store_bf16(hx + (size_t)row * 2048, F.lane, cur);
            row_store_bf16(hx + (size_t)row * 2048 + D, F.lane, xx);
#pragma unroll
            for (int q = 0; q < 4; ++q) { prev[q] = cur[q]; cur[q] = nxt[q]; }
        }
    }
}

__device__ __forceinline__ void phase_at_norm(Frame& F, int l, const bf16* xsrc, bf16* xdst) {
    moe_tables(F, l - 1);
    const float* mod = (const float*)(F.ws + WS_MOD); signed char* H8 = (signed char*)(F.ws + WS_ACT + A_H); float* SA = (float*)(F.ws + WS_SA);
    for (int row = F.gw; row < T; row += F.NGW) {
        const int b = row >> 11; f32x4 x[4], h[4]; row_load_bf16(xsrc + (size_t)row * D, F.lane, x);
        row_combine(x, (const bf16*)(F.ws + WS_ACT + A_YS), TokTab{(const int*)(F.ws + WS_TOKE), (const int*)(F.ws + WS_TOKR), (const LAS int*)(F.lds + OFFS_OFF)}, row, mod + (size_t)((l - 1) * 8 + b) * 6144 + 5 * D, F.lane);
        row_store_bf16(xdst + (size_t)row * D, F.lane, x);
        const float* mp = mod + (size_t)(l * 8 + b) * 6144;
        row_norm_mod(x, F.in[I_NTM] + l * D, mp + 1 * D, mp + 0 * D, F.lane, h);
        float am = 0.f;
#pragma unroll
        for (int j = 0; j < 4; ++j) am = fmaxf(am, fmaxf(fmaxf(fabsf(h[j][0]), fabsf(h[j][1])), fmaxf(fabsf(h[j][2]), fabsf(h[j][3]))));
        am = fmaxf(wave_max(am), 1e-20f); const float inv = 127.0f / am;
        if (F.lane == 0) SA[row] = am * (1.0f / 127.0f);
#pragma unroll
        for (int j = 0; j < 4; ++j) *(unsigned*)(H8 + (size_t)row * D + 4 * F.lane + 256 * j) = pack_i8x4(h[j], inv);
    }
}
__device__ __forceinline__ void phase_final(Frame& F, const bf16* xsrc) {
    moe_tables(F, DEPTH - 1);
    const float* mod = (const float*)(F.ws + WS_MOD); const float* fg = F.in[I_FG];
    for (int row = F.gw; row < T; row += F.NGW) {
        const int b = row >> 11; f32x4 x[4]; row_load_bf16(xsrc + (size_t)row * D, F.lane, x);
        row_combine(x, (const bf16*)(F.ws + WS_ACT + A_YS), TokTab{(const int*)(F.ws + WS_TOKE), (const int*)(F.ws + WS_TOKR), (const LAS int*)(F.lds + OFFS_OFF)}, row, mod + (size_t)(3 * 8 + b) * 6144 + 5 * D, F.lane);
        float s = 0.f;
#pragma unroll
        for (int j = 0; j < 4; ++j) s += (x[j][0] * x[j][0] + x[j][1] * x[j][1]) + (x[j][2] * x[j][2] + x[j][3] * x[j][3]);
        const float rstd = rsqrtf(wave_sum(s, F.lane) * (1.0f / D) + RMS_EPS);
#pragma unroll
        for (int j = 0; j < 4; ++j) { const f32x4 g = *(const f32x4*)(fg + 4 * F.lane + 256 * j); x[j] = x[j] * rstd * g; }
        row_store(F.out + (size_t)row * D, F.lane, x);
    }
}

__device__ __forceinline__ void moe_convert(Frame& F, int l, int bfirst, int bstride);
__device__ __forceinline__ void phase_moe_route(Frame& F, int l, const bf16* xsrc, int cnt_shift = 0) {
    const float* mod = (const float*)(F.ws + WS_MOD); bf16* HN = (bf16*)(F.ws + WS_ACT + A_HN2);
    LAS int* lcnt = (LAS int*)F.lds; LAS int* gbase = lcnt + 32; LAS int* inf_e = lcnt + 64; LAS int* inf_r = inf_e + 128; LAS float* inf_w = (LAS float*)(inf_r + 128);
    unsigned* cnt = (unsigned*)(F.ws + WS_CTL) + CW_CNT + (l + cnt_shift) * 32;
    int* toke = (int*)(F.ws + WS_TOKE); int* tokr = (int*)(F.ws + WS_TOKR); float* tokw = (float*)(F.ws + WS_TOKW);
    const float* rg = F.in[I_RG] + (size_t)l * D * 4; const float* rgb = F.in[I_RGB] + l * 4;
    LAS float* RW = (LAS float*)(F.lds + 4096);
    { float t[8];
#pragma unroll
      for (int u = 0; u < 8; ++u) t[u] = rg[F.tid + u * NTHREADS];
#pragma unroll
      for (int u = 0; u < 8; ++u) { const int i = F.tid + u * NTHREADS; RW[(i & 3) * D + (i >> 2)] = t[u]; }
      const float* rea = F.in[I_RE] + (size_t)l * 4 * D * 8;
      for (int i0 = F.tid; i0 < 4 * D * 8; i0 += 8 * NTHREADS) {
#pragma unroll
          for (int u = 0; u < 8; ++u) t[u] = rea[i0 + u * NTHREADS];
#pragma unroll
          for (int u = 0; u < 8; ++u) { const int i = i0 + u * NTHREADS; RW[(4 + (i >> 13) * 8 + (i & 7)) * D + ((i >> 3) & 1023)] = t[u]; } } }
    for (int cb = blockIdx.x; cb < T / 64; cb += F.G) {
        if (F.tid < 32) lcnt[F.tid] = 0;
        __syncthreads();
        for (int i = 0; i < 8; ++i) {
            const int lr = F.wave * 8 + i, row = cb * 64 + lr, b = row >> 11;
            f32x4 x[4], h[4]; row_load_bf16(xsrc + (size_t)row * D, F.lane, x);
            const float* mp = mod + (size_t)(l * 8 + b) * 6144;
            row_norm_mod(x, F.in[I_NCM] + l * D, mp + 4 * D, mp + 3 * D, F.lane, h);
            row_store_i8((signed char*)HN + (size_t)row * D, (float*)(F.ws + WS_SCL + SCL_HN) + row, F.lane, h);
            float gl[4] = {0.f, 0.f, 0.f, 0.f};
#pragma unroll
            for (int e = 0; e < 4; ++e)
#pragma unroll
                for (int j = 0; j < 4; ++j) { const f32x4 w = *(const LAS f32x4*)(RW + e * D + 4 * F.lane + 256 * j); gl[e] += (h[j][0] * w[0] + h[j][1] * w[1]) + (h[j][2] * w[2] + h[j][3] * w[3]); }
#pragma unroll
            for (int e = 0; e < 4; ++e) gl[e] = wave_sum(gl[e], F.lane) + rgb[e];
            const float gm = fmaxf(fmaxf(gl[0], gl[1]), fmaxf(gl[2], gl[3]));
            const int gtop = (gl[0] == gm) ? 0 : (gl[1] == gm) ? 1 : (gl[2] == gm) ? 2 : 3;
            const float pg = 1.0f / (__expf(gl[0] - gm) + __expf(gl[1] - gm) + __expf(gl[2] - gm) + __expf(gl[3] - gm));
            const float* reb = F.in[I_REB] + (l * 4 + gtop) * 8; const LAS float* rwe = RW + (4 + gtop * 8) * D + 4 * F.lane;
            float el[8];
#pragma unroll
            for (int e = 0; e < 8; ++e) { el[e] = 0.f;
#pragma unroll
                for (int j = 0; j < 4; ++j) { const f32x4 w = *(const LAS f32x4*)(rwe + e * D + 256 * j); el[e] += (h[j][0] * w[0] + h[j][1] * w[1]) + (h[j][2] * w[2] + h[j][3] * w[3]); } }
#pragma unroll
            for (int e = 0; e < 8; ++e) el[e] = wave_sum(el[e], F.lane) + reb[e];
            float v0 = el[0]; int i0 = 0;
#pragma unroll
            for (int e = 1; e < 8; ++e) if (el[e] > v0) { v0 = el[e]; i0 = e; }
            float v1 = -3.0e38f; int i1 = 0;
#pragma unroll
            for (int e = 0; e < 8; ++e) if (e != i0 && el[e] > v1) { v1 = el[e]; i1 = e; }
            const float ex = __expf(v1 - v0); const float w0 = pg / (1.0f + ex), w1 = pg * ex / (1.0f + ex);
            if (F.lane == 0) {
                const int e0 = gtop * 8 + i0, e1 = gtop * 8 + i1;
                const int r0 = __hip_atomic_fetch_add(lcnt + e0, 1, __ATOMIC_RELAXED, __HIP_MEMORY_SCOPE_WORKGROUP);
                const int r1 = __hip_atomic_fetch_add(lcnt + e1, 1, __ATOMIC_RELAXED, __HIP_MEMORY_SCOPE_WORKGROUP);
                inf_e[lr * 2] = e0; inf_e[lr * 2 + 1] = e1; inf_r[lr * 2] = r0; inf_r[lr * 2 + 1] = r1; inf_w[lr * 2] = w0; inf_w[lr * 2 + 1] = w1;
            }
        }
        __syncthreads();
        if (F.tid < 32) gbase[F.tid] = (int)__hip_atomic_fetch_add(cnt + F.tid, (unsigned)lcnt[F.tid], __ATOMIC_RELAXED, __HIP_MEMORY_SCOPE_AGENT);
        __syncthreads();
        if (F.tid < 128) { const int idx = cb * 128 + F.tid; const int e = inf_e[F.tid]; const int rk = gbase[e] + inf_r[F.tid]; toke[idx] = e; tokr[idx] = rk;
            ((int*)(F.ws + WS_ACT + A_LSTT))[(size_t)e * LCAP + rk] = idx >> 1; ((float*)(F.ws + WS_ACT + A_LSTW))[(size_t)e * LCAP + rk] = inf_w[F.tid]; }
        __syncthreads();
    }
    if (l == 0 && cnt_shift == 0) moe_convert(F, 0, (int)blockIdx.x, F.G);
}
__device__ __forceinline__ void moe_convert(Frame& F, int l, int bfirst, int bstride) {
    LAS float* scr = (LAS float*)(F.lds + 49152 + F.wave * 8704);
    signed char* WGU = (signed char*)(F.ws + ws_wm_of(l) + W_GU); float* SGU = (float*)(F.ws + ws_wm_of(l) + W_GUS); bf16* WDN = (bf16*)(F.ws + ws_wm_of(l) + W_DN);
    for (int it = bfirst; it < NEXP * 16; it += bstride) {
        const int e = it >> 4, up = (it >> 3) & 1, nb = it & 7, n0 = nb * 32;
        const int drow = (n0 >> 7) * 256 + up * 128 + (n0 & 127);
        conv8_cols32(F, (up ? F.in[I_WU] : F.in[I_WG]) + (size_t)(l * 32 + e) * D * FEXP + n0, FEXP, WGU + ((size_t)e * 512 + drow) * D, SGU + (size_t)e * 512 + drow);
    }
    for (int it = bfirst * NWAVES + F.wave; it < NEXP * 128; it += bstride * NWAVES) {
        const int e = it >> 7, r = it & 127; const int kb = r / 32, nb = r % 32;
        const float* src = F.in[I_WD] + ((size_t)(l * 32 + e) * FEXP + kb * 64) * D + nb * 32;
        transpose_item(src, D, WDN + ((size_t)e * D + nb * 32) * FEXP + kb * 64, FEXP, scr, F.lane);
    }
}

#ifndef SCAN_DUP
#define SCAN_DUP 0
#endif
namespace wk {
constexpr int P = 72, PB = 144, MAT = 64 * PB;
constexpr int PF = 68;
constexpr int O_NAB = 0, O_GS = 17408, O_GC = 19456, O_M0 = 20480;
constexpr int O_AT = O_M0, O_RT = O_AT + MAT, O_BT = O_RT + MAT, O_KT = O_BT + MAT, O_VV = O_KT + MAT, O_LAK = O_VV + MAT, O_MRB = O_LAK + MAT, O_MRK = O_MRB + MAT,
              O_NB = O_MRK + MAT, O_TT = O_NB + MAT, O_XT = O_TT + MAT, O_UT = O_XT + MAT, O_MT = O_UT + MAT, O_H0 = O_MT + MAT, O_H1 = O_H0 + MAT, O_END = O_H1 + MAT;
static_assert(O_END <= LDS_MISC, "scan LDS map");
typedef union { u32x4 u; bf16x8 v; } frag_t;
__device__ __forceinline__ bf16x8 zfrag() { frag_t z; z.u = (u32x4){0u, 0u, 0u, 0u}; return z.v; }
__device__ __forceinline__ bf16x8 ldrow(const LAS unsigned char* M, int row, int col) { return *(const LAS bf16x8*)(M + row * PB + col * 2); }
__device__ __forceinline__ bf16x8 ldtr(unsigned base, int r0, int c0, int lane) {
    const int g = lane >> 4, i = lane & 15, qq = i >> 2, p = i & 3;
    const unsigned a0 = base + (unsigned)((r0 + 8 * g + qq) * PB + (c0 + 4 * p) * 2), a1 = a0 + 4u * PB;
    u32x2 lo, hi;
    asm volatile("ds_read_b64_tr_b16 %0, %2\n\tds_read_b64_tr_b16 %1, %3\n\ts_waitcnt lgkmcnt(0)" : "=&v"(lo), "=&v"(hi) : "v"(a0), "v"(a1) : "memory");
    frag_t f; f.u.x = lo.x; f.u.y = lo.y; f.u.z = hi.x; f.u.w = hi.y; return f.v;
}
__device__ __forceinline__ void st4bf(LAS unsigned char* M, int row, int col, const f32x4& v) { u32x2 w; w.x = pk2(v[0], v[1]); w.y = pk2(v[2], v[3]); *(LAS u32x2*)(M + row * PB + col * 2) = w; }
#define WK_MFMA(a, b, c) __builtin_amdgcn_mfma_f32_16x16x32_bf16(a, b, c, 0, 0, 0)
template <int M> __device__ __forceinline__ float rshare(float v) { return __int_as_float(__builtin_amdgcn_update_dpp(0, __float_as_int(v), 0x150 + M, 0xf, 0xf, false)); }
#define WK_BAR() do { asm volatile("s_waitcnt lgkmcnt(0)" ::: "memory"); __builtin_amdgcn_s_barrier(); asm volatile("" ::: "memory"); } while (0)
}

__device__ __forceinline__ void phase_scan(Frame& F, int l) {
    using namespace wk;
    const int j = l >> 1;
    const bf16* Rb = (const bf16*)(F.ws + WS_ACT + A_RKV); const bf16* Kb = Rb + (size_t)T * D; const bf16* Vb = Kb + (size_t)T * D;
    const bf16* LD = (const bf16*)(F.ws + WS_ACT + A_LDEC); const bf16* AS = (const bf16*)(F.ws + WS_ACT + A_ASIG);
    bf16* Y = (bf16*)(F.ws + WS_ACT + A_Y); float* SB = (float*)(F.ws + WS_SB);
    LAS unsigned char* L = F.lds; const unsigned La = (unsigned)(size_t)L;
    LAS float* NAB = (LAS float*)(L + O_NAB); LAS float* GS = (LAS float*)(L + O_GS); LAS float* GC = (LAS float*)(L + O_GC);
    const int tid0 = F.tid, wave = F.wave;
    for (int unit = blockIdx.x; unit < NB * NH_R * 2; unit += F.G) {
        const int b = unit >> 5, h = (unit >> 1) & 15, dir = unit & 1; const int col = h * 64 + 8 * (tid0 & 7);
        f32x4 kkc[2], kac[2], rkc[2];
#pragma unroll
        for (int e = 0; e < 2; ++e) { kkc[e] = *(const f32x4*)(F.in[I_KK] + j * D + col + 4 * e); kac[e] = *(const f32x4*)(F.in[I_KA] + j * D + col + 4 * e); rkc[e] = *(const f32x4*)(F.in[I_RK] + j * D + col + 4 * e); }
        for (int i = tid0; i < (O_END - O_LAK) / 16; i += NTHREADS) *(LAS u32x4*)(L + O_LAK + i * 16) = (u32x4){0u, 0u, 0u, 0u};
        f32x4 Hs[4];
        f32x4 Yh[4];
#define WK_YFLUSH(cc) do { if (wave >= 4) { const int lane_ = tid0 & 63, qi_ = lane_ & 15, q4_ = lane_ >> 4, vj_ = wave - 4; \
            _Pragma("unroll") for (int ti_ = 0; ti_ < 4; ++ti_) _Pragma("unroll") for (int r_ = 0; r_ < 4; ++r_) { const int st_ = (cc) * 64 + 16 * ti_ + 4 * q4_ + r_; const int t_ = dir ? (SEQ - 1 - st_) : st_; \
                Y[((size_t)dir * T + (size_t)b * SEQ + t_) * D + h * 64 + 16 * vj_ + qi_] = (bf16)f2bf(Yh[ti_][r_]); } } } while (0)
#pragma unroll
        for (int vj = 0; vj < 4; ++vj) Hs[vj] = (f32x4){0.f, 0.f, 0.f, 0.f};
        u32x4 gr, gk, gv, gl, ga;
#define WK_LOAD(c) do { const int st = (c) * 64 + (tid0 >> 3); const int t = dir ? (SEQ - 1 - st) : st; const size_t ro = ((size_t)b * SEQ + t) * D + col; \
            gr = *(const u32x4*)(Rb + ro); gk = *(const u32x4*)(Kb + ro); gv = *(const u32x4*)(Vb + ro); gl = *(const u32x4*)(LD + (size_t)dir * T * D + ro); ga = *(const u32x4*)(AS + (size_t)dir * T * D + ro); } while (0)
        WK_LOAD(0);
        WK_BAR();
        for (int c = 0; c < SEQ / 64; ++c) {
            int tid = tid0; asm volatile("" : "+v"(tid));
            const int lane = tid & 63, qi = lane & 15, q4 = lane >> 4, pt = tid >> 3, c8 = tid & 7;
            LAS unsigned char* H0 = L + ((c & 1) ? O_H1 : O_H0); LAS unsigned char* H1 = L + ((c & 1) ? O_H0 : O_H1);
            for (int sd0_ = 0; sd0_ < 1 + ((SCAN_DUP >> 0) & 1); ++sd0_) {
            float av[8], bv[8], kdv[8], rv[8], ldv[8];
            {
                const unsigned gku[4] = {gk.x, gk.y, gk.z, gk.w}, gru[4] = {gr.x, gr.y, gr.z, gr.w}, glu[4] = {gl.x, gl.y, gl.z, gl.w}, gau[4] = {ga.x, ga.y, ga.z, ga.w};
                float kf[8], af[8], kkv[8]; float ss = 0.f;
#pragma unroll
                for (int e = 0; e < 4; ++e) { kf[2 * e] = bf_lo(gku[e]); kf[2 * e + 1] = bf_hi(gku[e]); rv[2 * e] = bf_lo(gru[e]); rv[2 * e + 1] = bf_hi(gru[e]);
                    ldv[2 * e] = bf_lo(glu[e]); ldv[2 * e + 1] = bf_hi(glu[e]); af[2 * e] = bf_lo(gau[e]); af[2 * e + 1] = bf_hi(gau[e]); }
#pragma unroll
                for (int e = 0; e < 8; ++e) { kkv[e] = kf[e] * kkc[e >> 2][e & 3]; ss += kkv[e] * kkv[e]; }
                ss = sum8(ss);
                const float inv = 1.0f / fmaxf(sqrtf(ss), 1e-12f); float bo = 0.f;
#pragma unroll
                for (int e = 0; e < 8; ++e) { const float kn = kkv[e] * inv; kdv[e] = kf[e] * (1.0f + (af[e] - 1.0f) * kac[e >> 2][e & 3]); av[e] = -kn; bv[e] = kn * af[e]; bo += rv[e] * kdv[e] * rkc[e >> 2][e & 3]; }
                bo = sum8(bo);
                const int st = c * 64 + pt; const int t = dir ? (SEQ - 1 - st) : st;
                if (c8 == 0) SB[((size_t)dir * T + (size_t)b * SEQ + t) * 16 + h] = bo;
                *(LAS f32x4*)(NAB + pt * PF + 8 * c8) = (f32x4){ldv[0], ldv[1], ldv[2], ldv[3]}; *(LAS f32x4*)(NAB + pt * PF + 8 * c8 + 4) = (f32x4){ldv[4], ldv[5], ldv[6], ldv[7]};
                *(LAS u32x4*)(L + O_VV + pt * PB + 16 * c8) = gv;
            }
            if (sd0_ == ((SCAN_DUP >> 0) & 1)) { if (c > 0) WK_YFLUSH(c - 1); if (c + 1 < SEQ / 64) WK_LOAD(c + 1); }
            WK_BAR();
            { const int kc = tid & 63, g = tid >> 6; float pre[8]; float p = 0.f;
#pragma unroll
              for (int i = 0; i < 8; ++i) { p += NAB[(8 * g + i) * PF + kc]; pre[i] = p; }
              GS[g * 64 + kc] = p;
              WK_BAR();
              float off = 0.f;
#pragma unroll
              for (int gg = 0; gg < 7; ++gg) off += (gg < g) ? GS[gg * 64 + kc] : 0.f;
#pragma unroll
              for (int i = 0; i < 8; ++i) NAB[(8 * g + i) * PF + kc] = off + pre[i]; }
            WK_BAR();
            { f32x4 cl[2], cm[2];
#pragma unroll
              for (int e = 0; e < 2; ++e) { cl[e] = *(const LAS f32x4*)(NAB + pt * PF + 8 * c8 + 4 * e); cm[e] = (pt > 0) ? *(const LAS f32x4*)(NAB + (pt - 1) * PF + 8 * c8 + 4 * e) : (f32x4){0.f, 0.f, 0.f, 0.f}; }
              float oa[8], orr[8], ob[8], ok[8];
#pragma unroll
              for (int e = 0; e < 8; ++e) { const float c1 = cl[e >> 2][e & 3], c0 = cm[e >> 2][e & 3]; const float gp = __builtin_amdgcn_exp2f(c1), gn = __builtin_amdgcn_exp2f(-c1), g0 = __builtin_amdgcn_exp2f(c0);
                  oa[e] = av[e] * g0; orr[e] = rv[e] * gp; ob[e] = bv[e] * gn; ok[e] = kdv[e] * gn; if (pt == 63) GC[8 * c8 + e] = gp; }
              *(LAS u32x4*)(L + O_AT + pt * PB + 16 * c8) = (u32x4){pk2(oa[0], oa[1]), pk2(oa[2], oa[3]), pk2(oa[4], oa[5]), pk2(oa[6], oa[7])};
              *(LAS u32x4*)(L + O_RT + pt * PB + 16 * c8) = (u32x4){pk2(orr[0], orr[1]), pk2(orr[2], orr[3]), pk2(orr[4], orr[5]), pk2(orr[6], orr[7])};
              *(LAS u32x4*)(L + O_BT + pt * PB + 16 * c8) = (u32x4){pk2(ob[0], ob[1]), pk2(ob[2], ob[3]), pk2(ob[4], ob[5]), pk2(ob[6], ob[7])};
              *(LAS u32x4*)(L + O_KT + pt * PB + 16 * c8) = (u32x4){pk2(ok[0], ok[1]), pk2(ok[2], ok[3]), pk2(ok[4], ok[5]), pk2(ok[6], ok[7])}; }
            WK_BAR();
            }
            f32x4 X0[4], Y0[4];
            for (int sd1_ = 0; sd1_ < 1 + ((SCAN_DUP >> 1) & 1); ++sd1_) {
#pragma unroll
            for (int jj = 0; jj < 5; ++jj) {
                const int idx = wave * 5 + jj, blk = idx / 10, tri = idx % 10;
                const int ti = (tri >= 6) ? 3 : ((tri >= 3) ? 2 : ((tri >= 1) ? 1 : 0)); const int si = tri - (ti * (ti + 1)) / 2;
                const LAS unsigned char* Pm = L + ((blk < 2) ? O_AT : O_RT); const LAS unsigned char* Qm = L + ((blk & 1) ? O_KT : O_BT);
                f32x4 acc = {0.f, 0.f, 0.f, 0.f};
#pragma unroll
                for (int ks = 0; ks < 2; ++ks) acc = WK_MFMA(ldrow(Qm, 16 * si + qi, 32 * ks + 8 * q4), ldrow(Pm, 16 * ti + qi, 32 * ks + 8 * q4), acc);
                const int tt = 16 * ti + qi, s0 = 16 * si + 4 * q4;
#pragma unroll
                for (int r = 0; r < 4; ++r) { const int sidx = s0 + r; const bool keep = (blk < 2) ? (sidx < tt) : (sidx <= tt); acc[r] = keep ? acc[r] : 0.f; }
                if (blk == 0) { *(LAS f32x4*)(NAB + tt * PF + s0) = acc; st4bf(L + O_NB, tt, s0, acc); }
                else st4bf(L + (blk == 1 ? O_LAK : (blk == 2 ? O_MRB : O_MRK)), tt, s0, acc);
            }
            WK_BAR();
            }
            for (int sd2_ = 0; sd2_ < 1 + ((SCAN_DUP >> 2) & 1); ++sd2_) {
            if (wave >= 4) { const int vj = wave - 4;
#pragma unroll
                for (int ti = 0; ti < 4; ++ti) { X0[ti] = (f32x4){0.f, 0.f, 0.f, 0.f}; Y0[ti] = (f32x4){0.f, 0.f, 0.f, 0.f};
#pragma unroll
                    for (int ks = 0; ks < 2; ++ks) if (ks <= (ti >> 1)) { const bf16x8 vf = ldtr(La + O_VV, 32 * ks, 16 * vj, lane);
                        X0[ti] = WK_MFMA(ldrow(L + O_LAK, 16 * ti + qi, 32 * ks + 8 * q4), vf, X0[ti]); Y0[ti] = WK_MFMA(ldrow(L + O_MRK, 16 * ti + qi, 32 * ks + 8 * q4), vf, Y0[ti]); } } }
            if (wave == 0) {
                const int blk = q4, cj = qi; float nrow[16], x[16];
#pragma unroll
                for (int r = 0; r < 16; ++r) nrow[r] = NAB[(16 * blk + r) * PF + 16 * blk + cj];
#pragma unroll
                for (int r = 0; r < 16; ++r) { float acc = (r == cj) ? 1.0f : 0.0f;
#define WK_SUBM(m) if (m < r) acc += wk::rshare<m>(nrow[r]) * x[m];
                    WK_SUBM(0) WK_SUBM(1) WK_SUBM(2) WK_SUBM(3) WK_SUBM(4) WK_SUBM(5) WK_SUBM(6) WK_SUBM(7) WK_SUBM(8) WK_SUBM(9) WK_SUBM(10) WK_SUBM(11) WK_SUBM(12) WK_SUBM(13) WK_SUBM(14)
#undef WK_SUBM
                    x[r] = acc; *(LAS bf16*)(L + O_TT + (16 * blk + r) * PB + (16 * blk + cj) * 2) = (bf16)f2bf(acc); }
            }
            WK_BAR();
            if (wave < 2) {
                const int i = 2 * wave + 1, jb = 2 * wave;
                { bf16x8 a = ldrow(L + O_NB, 16 * i + qi, 16 * jb + 8 * (q4 & 1)), bfr = ldtr(La + O_TT, 16 * jb - 8 * (q4 & 2), 16 * jb, lane);
                  if (q4 >= 2) { a = zfrag(); bfr = zfrag(); }
                  f32x4 acc = {0.f, 0.f, 0.f, 0.f}; acc = WK_MFMA(a, bfr, acc);
                  st4bf(L + O_MT, 16 * wave + qi, 4 * q4, acc); }
                asm volatile("s_waitcnt lgkmcnt(0)" ::: "memory");
                { bf16x8 a = ldrow(L + O_TT, 16 * i + qi, 16 * i + 8 * (q4 & 1)), bfr = ldrow(L + O_MT, 16 * wave + qi, 8 * (q4 & 1));
                  if (q4 >= 2) { a = zfrag(); bfr = zfrag(); }
                  f32x4 acc = {0.f, 0.f, 0.f, 0.f}; acc = WK_MFMA(a, bfr, acc);
#pragma unroll
                  for (int r = 0; r < 4; ++r) *(LAS bf16*)(L + O_TT + (16 * i + 4 * q4 + r) * PB + (16 * jb + qi) * 2) = (bf16)f2bf(acc[r]); }
            }
            WK_BAR();
            if (wave < 4) {
                const int ti2 = wave >> 1, tj2 = wave & 1;
                { const bf16x8 bfr = ldtr(La + O_TT, 0, 16 * tj2, lane);
#pragma unroll
                  for (int tt = 0; tt < 2; ++tt) { f32x4 acc = {0.f, 0.f, 0.f, 0.f}; acc = WK_MFMA(ldrow(L + O_NB, 32 + 16 * tt + qi, 8 * q4), bfr, acc); st4bf(L + O_MT, 32 + 16 * tj2 + qi, 16 * tt + 4 * q4, acc); } }
                asm volatile("s_waitcnt lgkmcnt(0)" ::: "memory");
                { f32x4 acc = {0.f, 0.f, 0.f, 0.f}; acc = WK_MFMA(ldrow(L + O_TT, 32 + 16 * ti2 + qi, 32 + 8 * q4), ldrow(L + O_MT, 32 + 16 * tj2 + qi, 8 * q4), acc);
#pragma unroll
                  for (int r = 0; r < 4; ++r) *(LAS bf16*)(L + O_TT + (32 + 16 * ti2 + 4 * q4 + r) * PB + (16 * tj2 + qi) * 2) = (bf16)f2bf(acc[r]); }
            }
            }
            for (int sd3_ = 0; sd3_ < 1 + ((SCAN_DUP >> 3) & 1); ++sd3_) {
            if (wave >= 4) { const int vj = wave - 4;
#pragma unroll
                for (int ti = 0; ti < 4; ++ti) { f32x4 acc = X0[ti];
#pragma unroll
                    for (int ks = 0; ks < 2; ++ks) acc = WK_MFMA(ldrow(L + O_AT, 16 * ti + qi, 32 * ks + 8 * q4), ldrow(H0, 16 * vj + qi, 32 * ks + 8 * q4), acc);
                    st4bf(L + O_XT, 16 * vj + qi, 16 * ti + 4 * q4, acc); } }
            WK_BAR();
#pragma unroll
            for (int e = 0; e < 2; ++e) { const int id = wave * 2 + e, ti = id >> 2, vj = id & 3; f32x4 acc = {0.f, 0.f, 0.f, 0.f};
#pragma unroll
                for (int ks = 0; ks < 2; ++ks) if (ks <= (ti >> 1)) acc = WK_MFMA(ldrow(L + O_TT, 16 * ti + qi, 32 * ks + 8 * q4), ldrow(L + O_XT, 16 * vj + qi, 32 * ks + 8 * q4), acc);
                st4bf(L + O_UT, 16 * vj + qi, 16 * ti + 4 * q4, acc); }
            WK_BAR();
            }
            f32x4 Hsave[4]; for (int vj_ = 0; vj_ < 4; ++vj_) Hsave[vj_] = Hs[vj_];
            for (int sd5_ = 0; sd5_ < 1 + ((SCAN_DUP >> 4) & 1); ++sd5_) {
            for (int vj_ = 0; vj_ < 4; ++vj_) Hs[vj_] = Hsave[vj_];
            if (wave >= 4) { const int vj = wave - 4;
#pragma unroll
                for (int ti = 0; ti < 4; ++ti) { f32x4 acc = Y0[ti];
#pragma unroll
                    for (int ks = 0; ks < 2; ++ks) { acc = WK_MFMA(ldrow(L + O_RT, 16 * ti + qi, 32 * ks + 8 * q4), ldrow(H0, 16 * vj + qi, 32 * ks + 8 * q4), acc);
                        if (ks <= (ti >> 1)) acc = WK_MFMA(ldrow(L + O_MRB, 16 * ti + qi, 32 * ks + 8 * q4), ldrow(L + O_UT, 16 * vj + qi, 32 * ks + 8 * q4), acc); }
                    Yh[ti] = acc; } }
            else { const int kt = wave; const f32x4 gc = *(const LAS f32x4*)(GC + 16 * kt + 4 * q4);
#pragma unroll
                for (int ks = 0; ks < 2; ++ks) { const bf16x8 bt = ldtr(La + O_BT, 32 * ks, 16 * kt, lane), ktf = ldtr(La + O_KT, 32 * ks, 16 * kt, lane);
#pragma unroll
                    for (int vj = 0; vj < 4; ++vj) { Hs[vj] = WK_MFMA(bt, ldrow(L + O_UT, 16 * vj + qi, 32 * ks + 8 * q4), Hs[vj]); Hs[vj] = WK_MFMA(ktf, ldtr(La + O_VV, 32 * ks, 16 * vj, lane), Hs[vj]); } }
#pragma unroll
                for (int vj = 0; vj < 4; ++vj) { Hs[vj] = Hs[vj] * gc; st4bf(H1, 16 * vj + qi, 16 * kt + 4 * q4, Hs[vj]); } }
            WK_BAR();
            }
        }
        WK_YFLUSH(SEQ / 64 - 1);
#undef WK_LOAD
#undef WK_YFLUSH
    }
}

__device__ __forceinline__ void phase_rw_post(Frame& F, int l) {
    const int j = l >> 1; const float* lnw = F.in[I_LNW] + j * D; const float* lnb = F.in[I_LNB] + j * D;
    const bf16* Vb = (const bf16*)(F.ws + WS_ACT + A_RKV) + (size_t)2 * T * D; const bf16* Y = (const bf16*)(F.ws + WS_ACT + A_Y); const bf16* Gb = (const bf16*)(F.ws + WS_ACT + A_G);
    const float* SB = (const float*)(F.ws + WS_SB); bf16* O = (bf16*)(F.ws + WS_ACT + A_O);
    for (int row = F.gw; row < T; row += F.NGW) {
        f32x4 o[4];
#pragma unroll
        for (int q = 0; q < 4; ++q) {
            const int c = 4 * F.lane + 256 * q; const int head = 4 * q + (F.lane >> 4);
            const u32x2 vr = *(const u32x2*)(Vb + (size_t)row * D + c); const f32x4 vf = {bf_lo(vr.x), bf_hi(vr.x), bf_lo(vr.y), bf_hi(vr.y)};
            const f32x4 w = *(const f32x4*)(lnw + c), bb = *(const f32x4*)(lnb + c);
            f32x4 acc = {0.f, 0.f, 0.f, 0.f};
#pragma unroll
            for (int dir = 0; dir < 2; ++dir) {
                const size_t ro = ((size_t)dir * T + row) * D + c;
                const u32x2 yr = *(const u32x2*)(Y + ro), gr = *(const u32x2*)(Gb + ro);
                const f32x4 yf = {bf_lo(yr.x), bf_hi(yr.x), bf_lo(yr.y), bf_hi(yr.y)}; const f32x4 gf = {bf_lo(gr.x), bf_hi(gr.x), bf_lo(gr.y), bf_hi(gr.y)};
                const float sbv = SB[((size_t)dir * T + row) * 16 + head];
                const float mean = rowsum16((yf[0] + yf[1]) + (yf[2] + yf[3])) * (1.0f / 64.0f);
                const f32x4 d = yf - mean; const float var = rowsum16((d[0] * d[0] + d[1] * d[1]) + (d[2] * d[2] + d[3] * d[3])) * (1.0f / 64.0f);
                const float rs = rsqrtf(var + GN_EPS);
                acc += gf * (d * rs * w + bb + sbv * vf);
            }
            o[q] = acc;
        }
        row_store_bf16(O + (size_t)row * D, F.lane, o);
    }
}

__device__ __forceinline__ unsigned att_f(unsigned row) { return ((row & 3u) << 2) | ((row >> 2) & 3u); }
__device__ __forceinline__ unsigned att_off_b(unsigned row, unsigned ch) { return 256u * row + 16u * (ch ^ att_f(row)); }
__device__ __forceinline__ void phase_attn(Frame& F, bool dry = false) {
    bf16* Qb = (bf16*)(F.ws + WS_ACT + A_Q); const bf16* Kb = (const bf16*)(F.ws + WS_ACT + A_K); const bf16* Vb = (const bf16*)(F.ws + WS_ACT + A_VT);
    float* LSE = (float*)(F.ws + WS_SB);
    const int lane = F.lane, qi = lane & 15, q4 = lane >> 4, wave = F.wave;
    LAS unsigned char* KW = F.lds; LAS unsigned char* VW = F.lds + 65536;
    const unsigned vw_a = (unsigned)(size_t)VW;
    unsigned ka[2][4], va[8][2];
#pragma unroll
    for (int rb = 0; rb < 2; ++rb)
#pragma unroll
        for (int s = 0; s < 4; ++s) ka[rb][s] = att_off_b((unsigned)(qi + 16 * rb), (unsigned)(4 * s + q4));
    { const unsigned q = (unsigned)qi >> 2, p = (unsigned)lane & 3u;
#pragma unroll
      for (int c = 0; c < 8; ++c)
#pragma unroll
          for (int t = 0; t < 2; ++t) va[c][t] = vw_a + att_off_b(8u * q4 + 4u * t + q, 2u * c + (p >> 1)) + 8u * (p & 1u); }
    unsigned fk[8];
#pragma unroll
    for (int i = 0; i < 8; ++i) { const unsigned rho = 4u * i + (unsigned)q4, m = rho & 15u, rb = rho >> 4; const unsigned kidx = 8u * (m >> 2) + (m & 3u) + 4u * rb;
        fk[i] = kidx | ((16u * ((unsigned)qi ^ att_f(rho))) << 8); }
    const int nper = (F.G >= 8) ? (F.G >> 3) : 1;
    for (int k = (F.G >= 8 && (F.G & 7) == 0) ? (int)(blockIdx.x >> 3) : (int)blockIdx.x; k < ((F.G >= 8 && (F.G & 7) == 0) ? 3 * NB * 16 : 3 * NB * 8 * 16); k += ((F.G >= 8 && (F.G & 7) == 0) ? nper : F.G)) {
        int g, b, hs, cc;
        if (F.G >= 8 && (F.G & 7) == 0) { hs = blockIdx.x & 7; cc = k & 15; b = (k >> 4) & 7; g = k >> 7; }
        else { g = k >> 10; b = (k >> 7) & 7; hs = (k >> 4) & 7; cc = k & 15; }
        const int dsh = 2 * g, Lg = SEQ >> dsh; const int cls = (g == 0) ? 0 : ((g == 1) ? (cc >> 2) : cc); const int chunk = (g == 0) ? cc : ((g == 1) ? (cc & 3) : 0);
        const int P0 = 128 * chunk;
        asm volatile("s_waitcnt lgkmcnt(0)" ::: "memory"); __builtin_amdgcn_s_barrier(); asm volatile("" ::: "memory");
        { const int base_ = P0 - 64 + 32 * wave;
          const bf16* ksrc = Kb + ((size_t)g * T + (size_t)b * SEQ) * D + hs * 128; const bf16* vsrc = Vb + ((size_t)g * T + (size_t)b * SEQ) * D + hs * 128;
#pragma unroll
          for (int i = 0; i < 8; ++i) { const int pk = min(max(base_ + (int)(fk[i] & 255u), 0), Lg - 1), pv = min(max(base_ + 4 * i + q4, 0), Lg - 1);
              __builtin_amdgcn_global_load_lds((const unsigned*)((const char*)(ksrc + (size_t)(cls + (pk << dsh)) * D) + (fk[i] >> 8)), (LAS unsigned*)(KW + wave * 8192 + i * 1024), 16, 0, 0);
              __builtin_amdgcn_global_load_lds((const unsigned*)((const char*)(vsrc + (size_t)(cls + (pv << dsh)) * D) + (fk[i] >> 8)), (LAS unsigned*)(VW + wave * 8192 + i * 1024), 16, 0, 0); } }
        const int Pq = P0 + 16 * wave + qi; const size_t qrow = (size_t)g * T + (size_t)b * SEQ + (size_t)(cls + (Pq << dsh));
        bf16* qp = Qb + qrow * D + hs * 128;
        bf16x8 Qf[4];
#pragma unroll
        for (int kt = 0; kt < 4; ++kt) Qf[kt] = *(const bf16x8*)(qp + 8 * q4 + 32 * kt);
        const float slope2 = exp2f(-8.0f * (float)(g * 8 + hs + 1) / 24.0f) * LOG2E * (float)(1 << dsh);
        float m_run = -1e30f, l_run = 0.f; f32x4 O[8];
#pragma unroll
        for (int dt = 0; dt < 8; ++dt) O[dt] = (f32x4){0.f, 0.f, 0.f, 0.f};
        asm volatile("s_waitcnt vmcnt(0)" ::: "memory"); __builtin_amdgcn_s_barrier(); asm volatile("" ::: "memory");
#pragma unroll
        for (int s = 0; s < 5; ++s) {
            const int tb = (wave >> 1) + s; const LAS unsigned char* kl = KW + tb * 8192; const unsigned voff = (unsigned)tb * 8192u;
            bf16x8 KA[4], KB[4];
#pragma unroll
            for (int kt = 0; kt < 4; ++kt) { KA[kt] = *(const LAS bf16x8*)(kl + ka[0][kt]); KB[kt] = *(const LAS bf16x8*)(kl + ka[1][kt]); }
            f32x4 SA = {0.f, 0.f, 0.f, 0.f}, SBt = {0.f, 0.f, 0.f, 0.f};
#pragma unroll
            for (int kt = 0; kt < 4; ++kt) { SA = __builtin_amdgcn_mfma_f32_16x16x32_bf16(KA[kt], Qf[kt], SA, 0, 0, 0); SBt = __builtin_amdgcn_mfma_f32_16x16x32_bf16(KB[kt], Qf[kt], SBt, 0, 0, 0); }
            const int cb = P0 - 64 + 32 * tb + 8 * q4;
            float sv[8]; bool ok[8]; float mx = -1e30f;
#pragma unroll
            for (int r = 0; r < 8; ++r) { const int p = cb + r; const int rel = abs(p - Pq); ok[r] = (p >= 0) && (p < Lg) && (rel <= 64);
                const float sc = (r < 4 ? SA[r & 3] : SBt[r & 3]) - slope2 * (float)rel; sv[r] = ok[r] ? sc : -1e30f; mx = fmaxf(mx, sv[r]); }
            mx = bfly16_max(mx); mx = bfly32_max(mx);
            const float m_new = fmaxf(m_run, mx); const float alpha = __builtin_amdgcn_exp2f(m_run - m_new); m_run = m_new;
            float pe[8]; float rs = 0.f;
#pragma unroll
            for (int r = 0; r < 8; ++r) { pe[r] = ok[r] ? __builtin_amdgcn_exp2f(sv[r] - m_new) : 0.f; rs += pe[r]; }
            rs = bfly16_sum(rs); rs = bfly32_sum(rs);
            l_run = l_run * alpha + rs;
            union { u32x4 u; bf16x8 v; } pf; pf.u.x = pk2(pe[0], pe[1]); pf.u.y = pk2(pe[2], pe[3]); pf.u.z = pk2(pe[4], pe[5]); pf.u.w = pk2(pe[6], pe[7]);
#pragma unroll
            for (int hf = 0; hf < 2; ++hf) {
                u32x2 vr[4][2];
                asm volatile("ds_read_b64_tr_b16 %0, %8\n\tds_read_b64_tr_b16 %1, %9\n\tds_read_b64_tr_b16 %2, %10\n\tds_read_b64_tr_b16 %3, %11\n\t"
                             "ds_read_b64_tr_b16 %4, %12\n\tds_read_b64_tr_b16 %5, %13\n\tds_read_b64_tr_b16 %6, %14\n\tds_read_b64_tr_b16 %7, %15\n\ts_waitcnt lgkmcnt(0)"
                             : "=&v"(vr[0][0]), "=&v"(vr[0][1]), "=&v"(vr[1][0]), "=&v"(vr[1][1]), "=&v"(vr[2][0]), "=&v"(vr[2][1]), "=&v"(vr[3][0]), "=&v"(vr[3][1])
                             : "v"(va[4 * hf + 0][0] + voff), "v"(va[4 * hf + 0][1] + voff), "v"(va[4 * hf + 1][0] + voff), "v"(va[4 * hf + 1][1] + voff), "v"(va[4 * hf + 2][0] + voff), "v"(va[4 * hf + 2][1] + voff), "v"(va[4 * hf + 3][0] + voff), "v"(va[4 * hf + 3][1] + voff)
                             : "memory");
#pragma unroll
                for (int c = 0; c < 4; ++c) { const int dt = 4 * hf + c; union { u32x4 u; bf16x8 v; } vf; vf.u.x = vr[c][0].x; vf.u.y = vr[c][0].y; vf.u.z = vr[c][1].x; vf.u.w = vr[c][1].y;
                    O[dt] = O[dt] * alpha; O[dt] = __builtin_amdgcn_mfma_f32_16x16x32_bf16(vf.v, pf.v, O[dt], 0, 0, 0); }
            }
        }
        const float inv = 1.0f / l_run;
#pragma unroll
        for (int dt = 0; dt < 8; ++dt) { u32x2 o; o.x = pk2(O[dt][0] * inv, O[dt][1] * inv); o.y = pk2(O[dt][2] * inv, O[dt][3] * inv); if (!dry) *(u32x2*)(qp + 4 * q4 + 16 * dt) = o; else asm volatile("" :: "v"(o.x), "v"(o.y)); }
        if (q4 == 0 && !dry) LSE[qrow * 8 + hs] = m_run + __builtin_amdgcn_logf(l_run);
    }
}
__device__ __forceinline__ void phase_attn_merge(Frame& F) {
    const bf16* Ob = (const bf16*)(F.ws + WS_ACT + A_Q); const float* LSE = (const float*)(F.ws + WS_SB); bf16* AO = (bf16*)(F.ws + WS_ACT + A_AO);
    for (int row = F.gw; row < T; row += F.NGW) {
        f32x4 o[4];
#pragma unroll
        for (int q = 0; q < 4; ++q) { const int c = 4 * F.lane + 256 * q; const int head = 2 * q + (F.lane >> 5);
            float ls[3];
#pragma unroll
            for (int g = 0; g < 3; ++g) ls[g] = LSE[((size_t)g * T + row) * 8 + head];
            const float mx = fmaxf(ls[0], fmaxf(ls[1], ls[2]));
            float w[3]; float sum = 0.f;
#pragma unroll
            for (int g = 0; g < 3; ++g) { w[g] = __builtin_amdgcn_exp2f(ls[g] - mx); sum += w[g]; }
            const float inv = 1.0f / sum; f32x4 acc = {0.f, 0.f, 0.f, 0.f};
#pragma unroll
            for (int g = 0; g < 3; ++g) { const u32x2 r = *(const u32x2*)(Ob + ((size_t)g * T + row) * D + c); const float a = w[g] * inv;
                acc[0] += a * bf_lo(r.x); acc[1] += a * bf_hi(r.x); acc[2] += a * bf_lo(r.y); acc[3] += a * bf_hi(r.y); }
            o[q] = acc; }
        row_store_bf16(AO + (size_t)row * D, F.lane, o);
    }
}

constexpr int PH_PER_LAYER = 10, N_PHASES = 1 + DEPTH * PH_PER_LAYER + 1;
template <int MASK> __global__ void __launch_bounds__(NTHREADS, 2) mk_fwd(Args args) {
    extern __shared__ __attribute__((aligned(16))) unsigned char lds_raw[];
#define PHASE_FRAME() Frame F; { int t_ = wave0 * 64 + lane_id_nh(); asm volatile("" : "+v"(t_)); size_t z_ = 0; asm volatile("" : "+s"(z_)); unsigned char* w_ = args.ws + z_;     \
        unsigned lb_ = 0; asm volatile("" : "+s"(lb_)); F.lds = (LAS unsigned char*)lds_raw + lb_; F.tid = t_; F.lane = t_ & 63; F.wave = __builtin_amdgcn_readfirstlane(t_ >> 6); \
        F.G = gridDim.x; F.gw = blockIdx.x * NWAVES + F.wave; F.NGW = F.G * NWAVES; F.ws = w_; F.in = args.in; F.out = args.out; }
    LAS unsigned char* lds0 = (LAS unsigned char*)lds_raw;
    const int wave0 = __builtin_amdgcn_readfirstlane((int)threadIdx.x >> 6);
    volatile LAS unsigned* MISC = (volatile LAS unsigned*)(lds0 + MISC_OFF);
    if (wave0 == 0) ((LAS unsigned*)(lds0 + LDS_MISC))[lane_id_nh() + 64] = 0u;
    __syncthreads();
    unsigned* ctl = (unsigned*)(args.ws + WS_CTL);
    XcdBarrier bar; bar.bar = ctl + CW_BAR; bar.x = 0; bar.st = nullptr;
#if ONE_LAUNCH
    bar = xcd_barrier_post(ctl + CW_BAR, MISC + 8, wave0 == 0 && lane_id_nh() == 0);
#endif
    const int lo = args.ph_lo, hi = args.ph_hi;
#define EN(b) ((MASK >> (b)) & 1)
#ifndef DUP_MASK
#define DUP_MASK 0
#endif
#define REP(b) for (int rep_ = 0; rep_ < 1 + ((DUP_MASK >> (b)) & 1); ++rep_)
#define IN(k) (lo <= (k) && (k) < hi)
#if ONE_LAUNCH
#ifndef BAR_REP
#define BAR_REP 1
#endif
#define SEAM(k) do { if (IN((k) + 1) || (k) + 1 < hi) { for (int br_ = 0; br_ < BAR_REP; ++br_) xcd_barrier(bar, wave0 == 0 && lane_id_nh() == 0); } } while (0)
#else
#define SEAM(k) do { } while (0)
#endif
    bf16* X0 = (bf16*)(args.ws + WS_X1); bf16* X1 = X0 + (size_t)T * D;
    if (EN(0) && IN(0)) { PHASE_FRAME(); REP(0) phase_prologue(F); SEAM(0); }
    for (int l = 0; l < DEPTH; ++l) {
        const int pb = 1 + l * PH_PER_LAYER; const int j = l >> 1;
        const void* xin = (l == 0) ? (const void*)args.in[I_X] : (const void*)((l & 1) ? X0 : X1);
        bf16* xcur = (l == 0) ? X0 : ((l & 1) ? X1 : X0);
        if ((l & 1) == 0) {
            if (EN(1) && IN(pb + 0)) { PHASE_FRAME(); REP(1) phase_rw_norm(F, l, l > 0, xin, xcur); SEAM(pb + 0); }
            if (EN(2) && IN(pb + 1)) { REP(2) {
                { PHASE_FRAME(); DenseSched S; S.o.init(T / 256, 2, F.G, blockIdx.x); S.A = (const char*)(F.ws + WS_ACT + A_HX); S.a_sel_stride = 0; S.pn_per_a = 1 << 20;
                  S.B = (const char*)(F.ws + WS_W + j * W_RW_STRIDE + W_LDN); S.tstepA = (size_t)256 * 2048 * 2; S.tstepB = (size_t)256 * 2048 * 2;
                  EpiLoraDn E{(bf16*)(F.ws + WS_ACT + A_LORAH)};
                  pg8::gemm_phase(F.lds, F.tid, 2048, 2048, 2048, S, E); }
                { PHASE_FRAME(); DenseSched S; S.o.init(T / 256, 12, F.G, blockIdx.x); S.o.uneven = (F.G == 256); S.A = (const char*)(F.ws + WS_ACT + A_XS); S.a_sel_stride = (size_t)T * D; S.pn_per_a = 4;
                  S.B = (const char*)(F.ws + WS_W + j * W_RW_STRIDE + W_RKV); S.tstepA = (size_t)256 * D; S.tstepB = (size_t)256 * D;
                  EpiI8<EpiSplit> E{EpiSplit{(bf16*)(F.ws + WS_ACT + A_RKV), (size_t)T * D, 1.0f}, (const float*)(F.ws + WS_SCL + SCL_XS), (size_t)T, 4, (const float*)(F.ws + WS_W + j * W_RW_STRIDE + W_RKVS)};
                  pg8::gemm_phase(F.lds, F.tid, D, D, D, S, E); }
                }
                SEAM(pb + 1);
            }
            if (EN(3) && IN(pb + 2)) { REP(3) {
                { PHASE_FRAME(); DenseSched S; S.o.init(T / 256, 16, F.G, blockIdx.x); S.A = (const char*)(F.ws + WS_ACT + A_LORAH); S.a_sel_stride = 256; S.pn_per_a = 8;
                  S.B = (const char*)(F.ws + WS_W + j * W_RW_STRIDE + W_LUPWA); S.tstepA = (size_t)256 * 512 * 2; S.tstepB = (size_t)256 * 128 * 2;
                  EpiLoraUpWA E{(bf16*)(F.ws + WS_ACT + A_LDEC), (bf16*)(F.ws + WS_ACT + A_ASIG), F.in[I_W0] + j * 2 * D, F.in[I_A0] + j * 2 * D};
                  pg8::gemm_phase(F.lds, F.tid, 128, 512, 128, S, E); }
                { PHASE_FRAME(); DenseSched S; S.o.init(T / 256, 8, F.G, blockIdx.x); S.A = (const char*)(F.ws + WS_ACT + A_LORAH) + 512; S.a_sel_stride = 256; S.pn_per_a = 4;
                  S.B = (const char*)(F.ws + WS_W + j * W_RW_STRIDE + W_LUPG); S.tstepA = (size_t)256 * 512 * 2; S.tstepB = (size_t)256 * 128 * 2;
                  EpiSplit E{(bf16*)(F.ws + WS_ACT + A_G), (size_t)T * D, 1.0f};
                  pg8::gemm_phase(F.lds, F.tid, 128, 512, 128, S, E); }
                }
                SEAM(pb + 2);
            }
            if (EN(4) && IN(pb + 3)) { PHASE_FRAME(); REP(4) phase_scan(F, l); SEAM(pb + 3); }
            if (EN(5) && IN(pb + 4)) { PHASE_FRAME(); REP(5) phase_rw_post(F, l); SEAM(pb + 4); }
            if (EN(6) && IN(pb + 5)) { PHASE_FRAME();
                DenseSched S; S.o.init(T / 256, 4, F.G, blockIdx.x); S.A = (const char*)(F.ws + WS_ACT + A_O); S.a_sel_stride = 0; S.pn_per_a = 1 << 20;
                S.B = (const char*)(F.ws + WS_W + j * W_RW_STRIDE + W_RWO); S.tstepA = (size_t)256 * D * 2; S.tstepB = (size_t)256 * D * 2;
                EpiResid E{(l == 0) ? (const void*)F.in[I_X] : (const void*)xcur, (l == 0) ? 1 : 0, xcur, (const float*)(F.ws + WS_MOD) + (size_t)l * 8 * 6144 + 2 * D};
                pg8::gemm_phase(F.lds, F.tid, D, D, D, S, E);
                SEAM(pb + 5);
            }
        } else {
            if (EN(7) && IN(pb + 0)) { PHASE_FRAME(); REP(7) phase_at_norm(F, l, (const bf16*)xin, xcur); SEAM(pb + 0); }
            if (EN(8) && IN(pb + 1)) { PHASE_FRAME(); REP(8) {
                DenseSched S; S.o.init(T / 256, 36, F.G, blockIdx.x); S.A = (const char*)(F.ws + WS_ACT + A_H); S.a_sel_stride = 0; S.pn_per_a = 1 << 20;
                S.B = (const char*)(F.ws + WS_WA + j * W_AT_STRIDE + W_QKV); S.tstepA = (size_t)256 * D; S.tstepB = (size_t)256 * D;
                EpiQKV8 E{(bf16*)(F.ws + WS_ACT + A_Q), (const float*)(F.ws + WS_SA), (const float*)(F.ws + WS_WA + j * W_AT_STRIDE + W_QKVS), 0.08838834764831845f * LOG2E};
                pg8::gemm_phase(F.lds, F.tid, D, D, D, S, E);
                }
                SEAM(pb + 1);
            }
            if (EN(9) && IN(pb + 2)) { PHASE_FRAME(); if ((DUP_MASK >> 9) & 1) phase_attn(F, true); phase_attn(F); SEAM(pb + 2); }
            if (EN(16) && IN(pb + 3)) { PHASE_FRAME(); REP(16) phase_attn_merge(F); SEAM(pb + 3); }
            if (EN(10) && IN(pb + 4)) { PHASE_FRAME();
                DenseSched S; S.o.init(T / 256, 4, F.G, blockIdx.x); S.A = (const char*)(F.ws + WS_ACT + A_AO); S.a_sel_stride = 0; S.pn_per_a = 1 << 20;
                S.B = (const char*)(F.ws + WS_WA + j * W_AT_STRIDE + W_AWO); S.tstepA = (size_t)256 * D * 2; S.tstepB = (size_t)256 * D * 2;
                EpiResid E{(const void*)xcur, 0, xcur, (const float*)(F.ws + WS_MOD) + (size_t)l * 8 * 6144 + 2 * D};
                pg8::gemm_phase(F.lds, F.tid, D, D, D, S, E);
                SEAM(pb + 4);
            }
        }
        if (EN(11) && IN(pb + 6)) { PHASE_FRAME(); if ((DUP_MASK >> 11) & 1) phase_moe_route(F, l, xcur, 4); phase_moe_route(F, l, xcur); SEAM(pb + 6); }
        if (EN(13) && IN(pb + 8)) { PHASE_FRAME();
            moe_tables(F, l);
            MoeGatherSched S; S.tileE = (const LAS int*)(F.lds + TILEE_OFF); S.ntiles = uni(S.tileE[160]); S.G = F.G; S.c = blockIdx.x;
            S.A = (const char*)(F.ws + WS_ACT + A_HN2); S.B = (const char*)(F.ws + ws_wm_of(l) + W_GU); S.tstepB = (size_t)256 * D; S.estride = (size_t)512 * D;
            LAS int* rt = (LAS int*)(F.lds + MOE_TAB); LAS float* wt = (LAS float*)(F.lds + MOE_TAB + 3072); LAS float* st = (LAS float*)(F.lds + MOE_TAB + 6144); S.rowtab = rt;
            { const LAS int* tileJ = (const LAS int*)(F.lds + TILEJ_OFF); const LAS int* cl = (const LAS int*)(F.lds + CNTL_OFF);
              const int* lstT = (const int*)(F.ws + WS_ACT + A_LSTT); const float* lstW = (const float*)(F.ws + WS_ACT + A_LSTW); const float* sat = (const float*)(F.ws + WS_SCL + SCL_HN);
              for (int i = F.tid; i < 3 * 256; i += NTHREADS) { const int L = (i >> 8) * F.G + (int)blockIdx.x; int tok = 0; float w = 0.f;
                  if (L < S.ntiles * 2) { const int m = L >> 1, e = S.tileE[m], rk = tileJ[m] * 256 + (i & 255); if (rk < cl[e]) { tok = lstT[(size_t)e * LCAP + rk]; w = lstW[(size_t)e * LCAP + rk]; } }
                  rt[i] = tok; wt[i] = w; st[i] = sat[tok]; }
              __syncthreads(); }
            EpiGateUp8 E{(bf16*)(F.ws + WS_ACT + A_HID), wt, st, (const float*)(F.ws + ws_wm_of(l) + W_GUS), (const LAS int*)(F.lds + TILEE_OFF)};
            pg8::gemm_phase(F.lds, F.tid, D, D, D, S, E);
            if (l + 1 < DEPTH) {
                const int nun = S.ntiles * 2, firstb = (nun > F.G) ? (nun - F.G) : 0;
                if ((int)blockIdx.x >= firstb) moe_convert(F, l + 1, (int)blockIdx.x - firstb, F.G - firstb);
            }
            SEAM(pb + 8);
        }
        if (EN(14) && IN(pb + 9)) { PHASE_FRAME(); REP(14) {
            moe_tables(F, l);
            MoeSched S; S.tileE = (const LAS int*)(F.lds + TILEE_OFF); S.ntiles = uni(S.tileE[160]); S.npn = 4; S.G = F.G; S.c = blockIdx.x;
            S.A = (const char*)(F.ws + WS_ACT + A_HID); S.B = (const char*)(F.ws + ws_wm_of(l) + W_DN); S.tstepA = (size_t)256 * FEXP * 2; S.tstepB = (size_t)256 * FEXP * 2; S.estride = (size_t)D * FEXP * 2;
            EpiPlain E{(bf16*)(F.ws + WS_ACT + A_YS)};
            pg8::gemm_phase(F.lds, F.tid, FEXP, FEXP, FEXP, S, E);
            }
            SEAM(pb + 9);
        }
    }
    if (EN(15) && IN(N_PHASES - 1)) { PHASE_FRAME(); phase_final(F, X1); }
#undef IN
#undef SEAM
}

typedef void (*kern_t)(Args);
template <int B> static kern_t kern_of_bit(int b) { if (b == B) return mk_fwd<(1 << B)>; if constexpr (B > 0) return kern_of_bit<B - 1>(b); else return nullptr; }
static int kind_of_phase(int p) {
    if (p == 0) return 0; if (p == N_PHASES - 1) return 15;
    const int l = (p - 1) / PH_PER_LAYER, k = (p - 1) % PH_PER_LAYER;
    if (k >= 6) return (k == 7) ? -1 : 11 + (k - 6);
    if ((l & 1) == 0) return 1 + k;
    return (k < 3) ? 7 + k : (k == 3 ? 16 : (k == 4 ? 10 : -1));
}
extern "C" void kernel_launch(void* const* d_in, const int* in_sizes, int n_in, void* d_out, int out_size, void* d_ws, size_t ws_size, hipStream_t stream) {
    static int grid = 0;
    if (grid == 0) {
        if (n_in != 32 || out_size != T * D || ws_size < WS_END) { fprintf(stderr, "kernel_launch: unexpected shapes (n_in %d out %d ws %zu need %zu)\n", n_in, out_size, ws_size, (size_t)WS_END); grid = -1; return; }
        int dev = 0, cus = 0;
        if (hipGetDevice(&dev) != hipSuccess || hipDeviceGetAttribute(&cus, hipDeviceAttributeMultiprocessorCount, dev) != hipSuccess) { grid = -1; return; }
#if ONE_LAUNCH
        if (hipFuncSetAttribute((const void*)mk_fwd<0x1ffff>, hipFuncAttributeMaxDynamicSharedMemorySize, LDS_BYTES) != hipSuccess) { fprintf(stderr, "kernel_launch: hipFuncSetAttribute failed\n"); grid = -1; return; }
#else
        for (int b = 0; b < 17; ++b) if (hipFuncSetAttribute((const void*)kern_of_bit<16>(b), hipFuncAttributeMaxDynamicSharedMemorySize, LDS_BYTES) != hipSuccess) { fprintf(stderr, "kernel_launch: hipFuncSetAttribute failed\n"); grid = -1; return; }
#endif
        (void)hipGetLastError();
        grid = cus;
    }
    if (grid < 0) return;
    (void)hipMemsetAsync((char*)d_ws + WS_CTL, 0, CTL_ZERO_BYTES, stream);
    Args a{};
    for (int i = 0; i < 32; ++i) a.in[i] = (const float*)d_in[i];
    a.out = (float*)d_out; a.ws = (unsigned char*)d_ws;
#if ONE_LAUNCH
#ifndef SPLIT_EVERY
#define SPLIT_EVERY N_PHASES
#endif
    for (int p = 0; p < N_PHASES; p += SPLIT_EVERY) {
        a.ph_lo = p; a.ph_hi = (p + SPLIT_EVERY < N_PHASES) ? p + SPLIT_EVERY : N_PHASES;
        hipLaunchKernelGGL(mk_fwd<0x1ffff>, dim3(grid), dim3(NTHREADS), LDS_BYTES, stream, a);
    }
#else
    for (int p = 0; p < N_PHASES; ++p) {
        const int kind = kind_of_phase(p); if (kind < 0) continue;
        a.ph_lo = p; a.ph_hi = p + 1;
        hipLaunchKernelGGL(kern_of_bit<16>(kind), dim3(grid), dim3(NTHREADS), LDS_BYTES, stream, a);
    }
#endif
}
```

```cpp
#include <hip/hip_runtime.h>
#include <cstdio>
#include <cstdint>

#ifndef ONE_LAUNCH
#define ONE_LAUNCH 1
#endif


#define LAS __attribute__((address_space(3)))
typedef unsigned short bf16;
typedef short bf16x8 __attribute__((ext_vector_type(8)));
typedef float f32x4 __attribute__((ext_vector_type(4)));
typedef float f32x2 __attribute__((ext_vector_type(2)));
typedef unsigned u32x4 __attribute__((ext_vector_type(4)));
typedef unsigned u32x2 __attribute__((ext_vector_type(2)));

constexpr int NB = 8, SEQ = 2048, D = 1024, T = NB * SEQ, DEPTH = 4;
constexpr int NH_R = 16, HD_R = 64;
constexpr int QKVW = 9216;
constexpr int NEXP = 32, FEXP = 256;
constexpr int MAXROWS = 40960;
constexpr int NWAVES = 8, NTHREADS = 512;
constexpr float RMS_EPS = 1e-6f, GN_EPS = 64e-5f;
constexpr float LOG2E = 1.4426950408889634f;

constexpr size_t MiB = 1u << 20;
constexpr size_t WS_CTL = 0, CTL_ZERO_BYTES = 64 * 1024;
constexpr size_t WS_MOD = 1 * MiB;
constexpr size_t WS_TOKE = 2 * MiB;
constexpr size_t WS_TOKR = WS_TOKE + 128 * 1024;
constexpr size_t WS_TOKW = WS_TOKR + 128 * 1024;
constexpr size_t WS_TOKP = WS_TOKW + 128 * 1024;
constexpr size_t WS_ROWW = WS_TOKP + 128 * 1024;
constexpr size_t WS_TILEE = WS_ROWW + 192 * 1024;
constexpr size_t WS_ROWT = WS_TILEE + 4096;
constexpr size_t WS_SB = 4 * MiB;
constexpr size_t WS_SA = WS_SB + 1536 * 1024;
constexpr size_t WS_SCL = 6 * MiB;
constexpr size_t SCL_XS = 0, SCL_HN = 4 * 65536;
constexpr size_t WS_W = 8 * MiB;
constexpr size_t W_RKV = 0, W_RKVS = 3 * MiB, W_LDN = 6 * MiB, W_LUPWA = 8 * MiB, W_LUPG = 10 * MiB, W_RWO = 11 * MiB, W_RW_STRIDE = 13 * MiB;
constexpr size_t WS_WA = WS_W + 2 * W_RW_STRIDE;
constexpr size_t W_QKV = 0, W_QKVS = 9 * MiB, W_AWO = 18 * MiB, W_AT_STRIDE = 20 * MiB;
constexpr size_t WS_WM = WS_WA + 2 * W_AT_STRIDE;
constexpr size_t W_GU = 0, W_GUS = 16 * MiB, W_DN = 32 * MiB;
__host__ __device__ constexpr size_t ws_wm_of(int l);
constexpr size_t WS_X1 = 128 * MiB;
constexpr size_t WS_ACT = 192 * MiB;
constexpr size_t A_XS = 0, A_HX = 96 * MiB;
constexpr size_t A_LDEC = 0, A_ASIG = 64 * MiB, A_G = 128 * MiB;
constexpr size_t A_RKV = 192 * MiB;
constexpr size_t A_O = 192 * MiB;
constexpr size_t A_LORAH = 288 * MiB;
constexpr size_t A_Y = 304 * MiB;
constexpr size_t A_H = 0;
constexpr size_t A_Q = 32 * MiB, A_K = 128 * MiB, A_VT = 224 * MiB;
constexpr size_t A_AO = 320 * MiB;
constexpr size_t A_HN2 = 0, A_LSTT = 32 * MiB, A_LSTW = 34 * MiB, A_HID = 112 * MiB, A_YS = 288 * MiB;
constexpr int LCAP = 16384;
static_assert(A_K - A_Q == A_VT - A_K, "q/k/v spacing");
constexpr size_t WS_WM2 = WS_ACT + 368 * MiB;
constexpr size_t WS_END = WS_WM2 + 48 * MiB;

constexpr int CW_BAR = 4096;
constexpr int CW_CNT = 8192;

__host__ __device__ constexpr size_t ws_wm_of(int l) { return (l & 1) ? WS_WM2 : WS_WM; }
constexpr int LDS_BYTES = 163840;
constexpr int LDS_MISC = 159744;
constexpr int MISC_OFF = LDS_MISC + 320;
constexpr int MOE_TAB = 131072;
constexpr int TILEE_OFF = MOE_TAB + 9216, TILEJ_OFF = TILEE_OFF + 768, CNTL_OFF = TILEJ_OFF + 768;
constexpr int OFFS_OFF = CNTL_OFF + 256;

__device__ __forceinline__ float bf_lo(unsigned u) { return __uint_as_float(u << 16); }
__device__ __forceinline__ float bf_hi(unsigned u) { return __uint_as_float(u & 0xffff0000u); }
__device__ __forceinline__ float bf2f(bf16 v) { return __uint_as_float(((unsigned)v) << 16); }
__device__ __forceinline__ unsigned f2bf(float f) { __bf16 r = (__bf16)f; return (unsigned)__builtin_bit_cast(unsigned short, r); }
__device__ __forceinline__ unsigned pk2(float lo, float hi) { typedef __bf16 b2_t __attribute__((ext_vector_type(2))); typedef float f2_t __attribute__((ext_vector_type(2))); f2_t v = {lo, hi}; b2_t r = __builtin_convertvector(v, b2_t); return __builtin_bit_cast(unsigned, r); }
__device__ __forceinline__ float dpp_ror(float x, const int ctrl_sel) {
    int r;
    if (ctrl_sel == 8) r = __builtin_amdgcn_update_dpp(0, __float_as_int(x), 0x128, 0xf, 0xf, false);
    else if (ctrl_sel == 4) r = __builtin_amdgcn_update_dpp(0, __float_as_int(x), 0x124, 0xf, 0xf, false);
    else if (ctrl_sel == 2) r = __builtin_amdgcn_update_dpp(0, __float_as_int(x), 0x122, 0xf, 0xf, false);
    else r = __builtin_amdgcn_update_dpp(0, __float_as_int(x), 0x121, 0xf, 0xf, false);
    return __int_as_float(r);
}
__device__ __forceinline__ float rowsum16(float x) { x += dpp_ror(x, 8); x += dpp_ror(x, 4); x += dpp_ror(x, 2); x += dpp_ror(x, 1); return x; }
__device__ __forceinline__ float sum8(float x) {
    x += __int_as_float(__builtin_amdgcn_update_dpp(0, __float_as_int(x), 0x141, 0xf, 0xf, false));
    x += __int_as_float(__builtin_amdgcn_update_dpp(0, __float_as_int(x), 0xB1, 0xf, 0xf, false));
    x += __int_as_float(__builtin_amdgcn_update_dpp(0, __float_as_int(x), 0x4E, 0xf, 0xf, false));
    return x;
}
__device__ __forceinline__ float lane_xor(float v, int lane, int o) { return __int_as_float(__builtin_amdgcn_ds_bpermute((lane ^ o) << 2, __float_as_int(v))); }
typedef unsigned v2u_t __attribute__((ext_vector_type(2)));
__device__ __forceinline__ float bfly16_sum(float x) { const v2u_t r = __builtin_amdgcn_permlane16_swap(__float_as_uint(x), __float_as_uint(x), false, false); return __uint_as_float(r[0]) + __uint_as_float(r[1]); }
__device__ __forceinline__ float bfly32_sum(float x) { const v2u_t r = __builtin_amdgcn_permlane32_swap(__float_as_uint(x), __float_as_uint(x), false, false); return __uint_as_float(r[0]) + __uint_as_float(r[1]); }
__device__ __forceinline__ float bfly16_max(float x) { const v2u_t r = __builtin_amdgcn_permlane16_swap(__float_as_uint(x), __float_as_uint(x), false, false); return fmaxf(__uint_as_float(r[0]), __uint_as_float(r[1])); }
__device__ __forceinline__ float bfly32_max(float x) { const v2u_t r = __builtin_amdgcn_permlane32_swap(__float_as_uint(x), __float_as_uint(x), false, false); return fmaxf(__uint_as_float(r[0]), __uint_as_float(r[1])); }
__device__ __forceinline__ float wave_max(float x) {
    x = fmaxf(x, dpp_ror(x, 8)); x = fmaxf(x, dpp_ror(x, 4)); x = fmaxf(x, dpp_ror(x, 2)); x = fmaxf(x, dpp_ror(x, 1)); x = bfly16_max(x); return bfly32_max(x);
}
__device__ __forceinline__ unsigned pack_i8x4(const f32x4& v, float inv) {
    const int q0 = (int)__builtin_rintf(fminf(fmaxf(v[0] * inv, -127.f), 127.f)), q1 = (int)__builtin_rintf(fminf(fmaxf(v[1] * inv, -127.f), 127.f));
    const int q2 = (int)__builtin_rintf(fminf(fmaxf(v[2] * inv, -127.f), 127.f)), q3 = (int)__builtin_rintf(fminf(fmaxf(v[3] * inv, -127.f), 127.f));
    return (unsigned)(q0 & 255) | ((unsigned)(q1 & 255) << 8) | ((unsigned)(q2 & 255) << 16) | ((unsigned)q3 << 24);
}
__device__ __forceinline__ float wave_sum(float v, int lane) { (void)lane; v = rowsum16(v); v = bfly16_sum(v); v = bfly32_sum(v); return v; }
__device__ __forceinline__ int lane_id_nh() { int lid; asm volatile("v_mbcnt_lo_u32_b32 %0, -1, 0\n\tv_mbcnt_hi_u32_b32 %0, -1, %0" : "=v"(lid)); return lid; }
__device__ __forceinline__ float sigmoidf_(float x) { return 1.0f / (1.0f + __expf(-x)); }
#define LDS_WAIT() asm volatile("s_waitcnt lgkmcnt(0)" ::: "memory")
#define VM_WAIT() asm volatile("s_waitcnt vmcnt(0)" ::: "memory")

#define XB_TMO      128
#define XB_XCNT(j)  (256  + 64 * (j))
#define XB_XSUB(j)  (1280 + 64 * (j))
#define XB_XGEN(j)  (2304 + 64 * (j))
#define XB_TOP      3328
#define XB_TOPGEN   3392
#define XCD_BAR_WORDS 3456
#define XB_SPIN_CAP (1u << 18)
__device__ __forceinline__ unsigned xb_ld(unsigned* p)              { return __hip_atomic_load(p, __ATOMIC_RELAXED, __HIP_MEMORY_SCOPE_AGENT); }
__device__ __forceinline__ unsigned xb_add(unsigned* p, unsigned v) { return __hip_atomic_fetch_add(p, v, __ATOMIC_RELAXED, __HIP_MEMORY_SCOPE_AGENT); }
__device__ __forceinline__ unsigned xb_xcc_id() { return (unsigned)__builtin_amdgcn_s_getreg((3 << 11) | 20) & 0xFu; }
#define XB_SPIN(cond, bar) do { unsigned _sp = 0; while (cond) { __builtin_amdgcn_s_sleep(1); \
    if ((++_sp & 255u) == 0u) { if (xb_ld(&(bar)[XB_TMO])) break; if (_sp > XB_SPIN_CAP) { atomicAdd(&(bar)[XB_TMO], 1u); break; } } } } while (0)
struct XcdBarrier { unsigned* bar; unsigned x; volatile LAS unsigned* st; };
__device__ __forceinline__ XcdBarrier xcd_barrier_post(unsigned* bar, volatile LAS unsigned* st, bool t0) {
    XcdBarrier b; b.bar = bar; b.x = xb_xcc_id(); b.st = st;
    if (t0) (void)xb_add(&bar[XB_XCNT(b.x)], 1u);
    return b;
}
__device__ __forceinline__ void xcd_barrier_complete(unsigned* bar, unsigned x, unsigned& nloc, unsigned& nx) {
    const unsigned G = gridDim.x * gridDim.y * gridDim.z;
    unsigned sum, cnt, mine, sp = 0u;
    for (;;) {
        sum = 0u; cnt = 0u; mine = 0u;
#pragma clang loop unroll(disable)
        for (unsigned j = 0; j < 16; ++j) { const unsigned c = xb_ld(&bar[XB_XCNT(j)]); sum += c; cnt += (c > 0u) ? 1u : 0u; mine = (j == x) ? c : mine; }
        if (sum == G) break;
        __builtin_amdgcn_s_sleep(1);
        if ((++sp & 255u) == 0u) { if (xb_ld(&bar[XB_TMO])) break; if (sp > XB_SPIN_CAP) { atomicAdd(&bar[XB_TMO], 1u); break; } }
    }
    nloc = mine > 0u ? mine : 1u; nx = cnt > 0u ? cnt : 1u;
}
__device__ __forceinline__ void xcd_barrier(const XcdBarrier& b, bool t0) {
    asm volatile("s_waitcnt vmcnt(0)" ::: "memory");
    __syncthreads();
    if (t0) {
        unsigned* bar = b.bar;
        __builtin_amdgcn_s_waitcnt(0);
        unsigned nloc = b.st[0], nx = b.st[1];
        if (nloc == 0u) { xcd_barrier_complete(bar, b.x, nloc, nx); b.st[0] = nloc; b.st[1] = nx; }
        const unsigned old = xb_add(&bar[XB_XSUB(b.x)], 1u);
        const unsigned gen = old / nloc;
        if (old + 1u == (gen + 1u) * nloc) {
            __builtin_amdgcn_fence(__ATOMIC_RELEASE, "agent");
            asm volatile("s_waitcnt vmcnt(0)" ::: "memory");
            const unsigned og = xb_add(&bar[XB_TOP], 1u);
            const unsigned tg = og / nx;
            if (og + 1u == (tg + 1u) * nx) xb_add(&bar[XB_TOPGEN], 1u);
            else XB_SPIN(xb_ld(&bar[XB_TOPGEN]) == tg, bar);
            __builtin_amdgcn_fence(__ATOMIC_ACQUIRE, "agent");
            xb_add(&bar[XB_XGEN(b.x)], 1u);
            asm volatile("s_waitcnt vmcnt(0)" ::: "memory");
        } else {
            XB_SPIN(xb_ld(&bar[XB_XGEN(b.x)]) == gen, bar);
            __builtin_amdgcn_fence(__ATOMIC_ACQUIRE, "agent");
            asm volatile("s_waitcnt vmcnt(0)" ::: "memory");
        }
    }
    __syncthreads();
}

namespace pg8 {
constexpr int BM = 256, BK = 64, HALF = 128, HTB = HALF * BK * 2, STAGE_BYTES = 8 * HTB;
__device__ __forceinline__ int lds_byte(int r, int c) { const int st = (r >> 4) * 2 + (c >> 5), rr = r & 15, cc = c & 31, ob = rr * 64 + cc * 2; return st * 1024 + (ob ^ (((ob >> 9) & 1) << 5)); }
__device__ __forceinline__ void stage_rc(int b, int& R, int& C) { const int st = b / 1024, sb = b % 1024, swz = sb ^ (((sb >> 9) & 1) << 5); R = (st >> 1) * 16 + swz / 64; C = (st & 1) * 32 + (swz % 64) / 2; }
__device__ __forceinline__ int perm32(int rho) { const int n = rho >> 4, i = rho & 15; return 8 * (i >> 2) + 4 * n + (i & 3); }
struct Unit { int pm, pn, ui; const char* a; const char* b; };
__device__ __forceinline__ unsigned cvt_pk_bf16(float lo, float hi) { unsigned r; asm volatile("v_cvt_pk_bf16_f32 %0, %1, %2" : "=v"(r) : "v"(lo), "v"(hi)); return r; }

typedef int i32x4 __attribute__((ext_vector_type(4)));
template <bool I8> struct OpT { typedef bf16x8 frag; typedef f32x4 acc; };
template <> struct OpT<true> { typedef i32x4 frag; typedef i32x4 acc; };
__device__ __forceinline__ f32x4 mma16(const bf16x8& a, const bf16x8& b, const f32x4& c) { return __builtin_amdgcn_mfma_f32_16x16x32_bf16(a, b, c, 0, 0, 0); }
__device__ __forceinline__ i32x4 mma16(const i32x4& a, const i32x4& b, const i32x4& c) { return __builtin_amdgcn_mfma_i32_16x16x64_i8(a, b, c, 0, 0, 0); }
template <class Epi, class Sched>
__device__ __forceinline__ void gemm_phase(LAS unsigned char* lds, const int tid, const int K, const int lda, const int ldb, const Sched& S, const Epi& E) {
    const int wid = __builtin_amdgcn_readfirstlane(tid >> 6), lane = tid & 63, wr = wid >> 2, wc = wid & 3, fr = lane & 15, fq = lane >> 4;
    int Kq = K; asm volatile("" : "+s"(Kq));
    constexpr bool I8 = Epi::I8; constexpr int EB = I8 ? 1 : 2;
    typedef typename OpT<I8>::frag frag_t; typedef typename OpT<I8>::acc acc_t;
    const int nt = Kq * EB / (BK * 2);
    unsigned voffC[2][2], voffN[2][2], voffB[2]; int RA[2], CA[2];
#pragma unroll
    for (int i = 0; i < 2; ++i) { int R, C; stage_rc(tid * 16 + i * 8192, R, C); const int Rb = Epi::PERM ? ((R & ~31) + perm32(R & 31)) : R; RA[i] = R; CA[i] = C;
        voffB[i] = (unsigned)(Rb * ldb * EB + C * 2); }
#define PG8_AOFF(dst, ui_) do { _Pragma("unroll") for (int h_ = 0; h_ < 2; ++h_) _Pragma("unroll") for (int i_ = 0; i_ < 2; ++i_) { \
        if constexpr (Sched::GATHER) dst[h_][i_] = (unsigned)(S.row_of(ui_, h_ * HALF + RA[i_]) * lda * EB + CA[i_] * 2); else dst[h_][i_] = (unsigned)((h_ * HALF + RA[i_]) * lda * EB + CA[i_] * 2); } } while (0)
    const size_t kstep = (size_t)(BK * 2);
    const size_t hstepB = (size_t)HALF * ldb * EB;
    const unsigned ldsw = (unsigned)wid * 1024u;
    const int aoff = lds_byte(wr * 64 + fr, fq * 8), boff = lds_byte(wc * 32 + fr, fq * 8);
#define PG8_SA(b, h) (((b) * 2 + (h)) * HTB)
#define PG8_SB(b, h) ((4 + (b) * 2 + (h)) * HTB)
#define PG8_STAGE(bufoff, gbase, voff) do { _Pragma("unroll") for (int _i = 0; _i < 2; ++_i) \
        __builtin_amdgcn_global_load_lds((const unsigned*)((const char*)(gbase) + (voff)[_i]), (LAS unsigned*)(lds + (bufoff) + ldsw + _i * 8192), 16, 0, 0); } while (0)
#define PG8_LDA(dst, b, h) do { _Pragma("unroll") for (int m = 0; m < 4; ++m) _Pragma("unroll") for (int k = 0; k < 2; ++k) dst[m][k] = *(const LAS frag_t*)(lds + PG8_SA(b, h) + aoff + m * 2048 + k * 1024); } while (0)
#define PG8_LDB(dst, b, h) do { _Pragma("unroll") for (int n = 0; n < 2; ++n) _Pragma("unroll") for (int k = 0; k < 2; ++k) dst[n][k] = *(const LAS frag_t*)(lds + PG8_SB(b, h) + boff + n * 2048 + k * 1024); } while (0)
#define PG8_MMA(ai, bj, At, Bt) do { __builtin_amdgcn_s_setprio(1); _Pragma("unroll") for (int m = 0; m < 4; ++m) _Pragma("unroll") for (int n = 0; n < 2; ++n) _Pragma("unroll") for (int k = 0; k < 2; ++k) \
        acc[ai][bj][m][n] = mma16(Bt[n][k], At[m][k], acc[ai][bj][m][n]); __builtin_amdgcn_s_setprio(0); } while (0)
#define PG8_WAIT_V(n) asm volatile("s_waitcnt vmcnt(" #n ")" ::: "memory")
#define PG8_WAIT_L(n) asm volatile("s_waitcnt lgkmcnt(" #n ")" ::: "memory")
#define PG8_BAR __builtin_amdgcn_s_barrier()
#define PG8_SCHED __builtin_amdgcn_sched_barrier(0)
    Unit cur, nxt; int ui = 0;
    if (!S.next(0, cur)) return;
    acc_t acc[2][2][4][2];
#pragma unroll
    for (int a = 0; a < 2; ++a)
#pragma unroll
        for (int b = 0; b < 2; ++b)
#pragma unroll
            for (int m = 0; m < 4; ++m)
#pragma unroll
                for (int n = 0; n < 2; ++n) acc[a][b][m][n] = (acc_t){0, 0, 0, 0};
    frag_t At[4][2], B0[2][2], B1[2][2];
    const char* cA = cur.a; const char* cB = cur.b;
    PG8_AOFF(voffC, 0); PG8_AOFF(voffN, 0);
    PG8_STAGE(PG8_SB(0, 0), cB, voffB); PG8_STAGE(PG8_SB(0, 1), cB + hstepB, voffB); PG8_STAGE(PG8_SA(0, 0), cA, voffC[0]); PG8_STAGE(PG8_SA(0, 1), cA, voffC[1]);
    if (wr == 1) PG8_BAR;
    PG8_WAIT_V(2); PG8_BAR;
    PG8_STAGE(PG8_SB(1, 0), cB + kstep, voffB); PG8_STAGE(PG8_SA(1, 0), cA + kstep, voffC[0]); PG8_STAGE(PG8_SB(1, 1), cB + hstepB + kstep, voffB);
    PG8_WAIT_V(6); PG8_BAR;
    for (;;) {
        const bool has_next = S.next(ui + 1, nxt);
        const char* nA = has_next ? nxt.a : cA; const char* nB = has_next ? nxt.b : cB;
        if constexpr (Sched::GATHER) { if (has_next) PG8_AOFF(voffN, ui + 1); }
#pragma clang loop unroll(disable)
        for (int t = 0; t < nt; t += 2) {
            const bool last = (t == nt - 2);
            const char* a1 = cA + (size_t)(t + 1) * kstep;
            const char* a2 = last ? nA : cA + (size_t)(t + 2) * kstep; const char* b2 = last ? nB : cB + (size_t)(t + 2) * kstep;
            const char* a3 = a2 + kstep; const char* b3 = b2 + kstep;
            unsigned vA0[2], vA1[2];
            if constexpr (Sched::GATHER) { vA0[0] = last ? voffN[0][0] : voffC[0][0]; vA0[1] = last ? voffN[0][1] : voffC[0][1]; vA1[0] = last ? voffN[1][0] : voffC[1][0]; vA1[1] = last ? voffN[1][1] : voffC[1][1]; }
            else { vA0[0] = voffC[0][0]; vA0[1] = voffC[0][1]; vA1[0] = voffC[1][0]; vA1[1] = voffC[1][1]; }
            PG8_LDB(B0, 0, 0); PG8_LDB(B1, 0, 1); PG8_SCHED; PG8_LDA(At, 0, 0); PG8_STAGE(PG8_SA(1, 1), a1, voffC[1]);
            PG8_WAIT_V(8); PG8_WAIT_L(0); PG8_BAR; PG8_MMA(0, 0, At, B0); PG8_MMA(0, 1, At, B1); PG8_BAR; PG8_SCHED;
            PG8_LDA(At, 0, 1); PG8_STAGE(PG8_SB(0, 0), b2, voffB); PG8_STAGE(PG8_SB(0, 1), b2 + hstepB, voffB); PG8_STAGE(PG8_SA(0, 0), a2, vA0);
            PG8_WAIT_V(8); PG8_WAIT_L(0); PG8_BAR; PG8_MMA(1, 0, At, B0); PG8_MMA(1, 1, At, B1); PG8_BAR; PG8_SCHED;
            PG8_LDB(B0, 1, 0); PG8_LDB(B1, 1, 1); PG8_SCHED; PG8_LDA(At, 1, 0); PG8_STAGE(PG8_SA(0, 1), a2, vA1);
            PG8_WAIT_V(8); PG8_WAIT_L(0); PG8_BAR; PG8_MMA(0, 0, At, B0); PG8_MMA(0, 1, At, B1); PG8_BAR; PG8_SCHED;
            PG8_LDA(At, 1, 1); PG8_STAGE(PG8_SB(1, 0), b3, voffB); PG8_STAGE(PG8_SB(1, 1), b3 + hstepB, voffB); PG8_STAGE(PG8_SA(1, 0), a3, vA0);
            PG8_WAIT_V(8); PG8_WAIT_L(0); PG8_BAR; PG8_MMA(1, 0, At, B0); PG8_MMA(1, 1, At, B1); PG8_BAR; PG8_SCHED;
        }
        if (wr == 0) PG8_BAR;
        { int te = tid; asm volatile("" : "+v"(te));
          const int we = __builtin_amdgcn_readfirstlane(te >> 6), le = te & 63;
          E(acc, cur, we >> 2, we & 3, le & 15, le >> 4); }
        if (!has_next) break;
#pragma unroll
        for (int a = 0; a < 2; ++a)
#pragma unroll
            for (int b = 0; b < 2; ++b)
#pragma unroll
                for (int m = 0; m < 4; ++m)
#pragma unroll
                    for (int n = 0; n < 2; ++n) acc[a][b][m][n] = (acc_t){0, 0, 0, 0};
        cur = nxt; cA = nA; cB = nB; ++ui;
        if constexpr (Sched::GATHER) {
#pragma unroll
            for (int h_ = 0; h_ < 2; ++h_) { voffC[h_][0] = voffN[h_][0]; voffC[h_][1] = voffN[h_][1]; } }
        if (wr == 1) PG8_BAR;
    }
    PG8_WAIT_V(0);
    PG8_BAR;
#undef PG8_AOFF
#undef PG8_SA
#undef PG8_SB
#undef PG8_STAGE
#undef PG8_LDA
#undef PG8_LDB
#undef PG8_MMA
#undef PG8_WAIT_V
#undef PG8_WAIT_L
#undef PG8_BAR
#undef PG8_SCHED
}

struct GridOrder {
    int nM, nN, nwg, G, c, uneven;
    __device__ __forceinline__ void init(int nM_, int nN_, int G_, int c_) { nM = nM_; nN = nN_; nwg = nM * nN; G = G_; c = c_; uneven = 0; }
    __device__ __forceinline__ bool tile(int i, int& pm, int& pn) const {
        long L = (long)i * G + c;
        if (uneven) {
            if (c < 128) { if (i >= 2) return false; L = i * 128 + c; } else { if (i >= 4) return false; L = 256 + (c - 128) + 128 * i; } }
        if (L >= nwg) return false;
        int wgid = (int)L; { const int q = nwg / 8, r = nwg % 8, xcd = wgid % 8, off = wgid / 8; wgid = (xcd < r ? xcd * (q + 1) : r * (q + 1) + (xcd - r) * q) + off; }
        const int nig = 8 * nN, gid = wgid / nig, fm = gid * 8, gsz = (nM - fm) < 8 ? (nM - fm) : 8;
        pm = fm + ((wgid % nig) % gsz); pn = (wgid % nig) / gsz; return true;
    }
};
}

__device__ __forceinline__ int uni(int v) { return __builtin_amdgcn_readfirstlane(v); }
__device__ __forceinline__ const char* uniptr(const char* p) { const unsigned long long v = (unsigned long long)p; const unsigned lo = __builtin_amdgcn_readfirstlane((unsigned)v), hi = __builtin_amdgcn_readfirstlane((unsigned)(v >> 32)); return (const char*)(((unsigned long long)hi << 32) | lo); }
struct DenseSched {
    static constexpr bool GATHER = false;
    pg8::GridOrder o; const char* A; size_t a_sel_stride; int pn_per_a; const char* B; size_t tstepA, tstepB;
    __device__ __forceinline__ bool next(int i, pg8::Unit& u) const {
        if (!o.tile(i, u.pm, u.pn)) return false;
        u.pm = uni(u.pm); u.pn = uni(u.pn); u.ui = i;
        u.a = uniptr(A + (size_t)(u.pn / pn_per_a) * a_sel_stride + (size_t)u.pm * tstepA); u.b = uniptr(B + (size_t)u.pn * tstepB); return true;
    }
};
struct MoeSched {
    static constexpr bool GATHER = false;
    const LAS int* tileE; int ntiles, npn, G, c; const char* A; const char* B; size_t tstepA, tstepB, estride;
    __device__ __forceinline__ bool next(int i, pg8::Unit& u) const {
        const int L = i * G + c; if (L >= ntiles * npn) return false;
        u.pm = uni(L / npn); u.pn = uni(L % npn); u.ui = i;
        const int e = __builtin_amdgcn_readfirstlane(tileE[u.pm]);
        u.a = uniptr(A + (size_t)u.pm * tstepA); u.b = uniptr(B + (size_t)e * estride + (size_t)u.pn * tstepB); return true;
    }
};
struct MoeGatherSched {
    static constexpr bool GATHER = true;
    const LAS int* tileE; const LAS int* rowtab; int ntiles, G, c; const char* A; const char* B; size_t tstepB, estride;
    __device__ __forceinline__ bool next(int i, pg8::Unit& u) const {
        const int L = i * G + c; if (L >= ntiles * 2) return false;
        u.pm = uni(L >> 1); u.pn = uni(L & 1); u.ui = i;
        const int e = __builtin_amdgcn_readfirstlane(tileE[u.pm]);
        u.a = A; u.b = uniptr(B + (size_t)e * estride + (size_t)u.pn * tstepB); return true;
    }
    __device__ __forceinline__ int row_of(int i, int r) const { return rowtab[i * 256 + r]; }
};
using pg8::Unit; using pg8::cvt_pk_bf16;
__device__ __forceinline__ void st8(bf16* p, const f32x4& v0, const f32x4& v1) {
    u32x4 w; w.x = cvt_pk_bf16(v0[0], v0[1]); w.y = cvt_pk_bf16(v0[2], v0[3]); w.z = cvt_pk_bf16(v1[0], v1[1]); w.w = cvt_pk_bf16(v1[2], v1[3]);
    *(u32x4*)p = w;
}
struct EpiSplit {
    static constexpr bool PERM = true, I8 = false;
    bf16* O; size_t split_stride; float scale;
    __device__ __forceinline__ void operator()(const f32x4 (&acc)[2][2][4][2], const Unit& u, int wr, int wc, int fr, int fq) const {
        const int row0 = u.pm * 256 + wr * 64 + fr; const int colt = u.pn * 256; const int t = colt >> 10;
        bf16* base = O + (size_t)t * split_stride; const int col0 = (colt & 1023) + wc * 32 + 8 * fq;
#pragma unroll
        for (int ai = 0; ai < 2; ++ai)
#pragma unroll
            for (int m = 0; m < 4; ++m) { bf16* rowp = base + (size_t)(row0 + ai * 128 + m * 16) * 1024 + col0;
#pragma unroll
                for (int bj = 0; bj < 2; ++bj) st8(rowp + bj * 128, acc[ai][bj][m][0] * scale, acc[ai][bj][m][1] * scale); }
    }
};
struct EpiLoraDn {
    static constexpr bool PERM = true, I8 = false;
    bf16* O;
    __device__ __forceinline__ void operator()(const f32x4 (&acc)[2][2][4][2], const Unit& u, int wr, int wc, int fr, int fq) const {
        const int row0 = u.pm * 256 + wr * 64 + fr; const int col0 = u.pn * 256 + wc * 32 + 8 * fq;
#pragma unroll
        for (int ai = 0; ai < 2; ++ai)
#pragma unroll
            for (int m = 0; m < 4; ++m) { bf16* rowp = O + (size_t)(row0 + ai * 128 + m * 16) * 512 + col0;
#pragma unroll
                for (int bj = 0; bj < 2; ++bj) { f32x4 v0 = acc[ai][bj][m][0], v1 = acc[ai][bj][m][1];
                    const int mode = (u.pn == 1) ? 2 : ((wc >> 1) & 1);
                    if (mode == 0) {
#pragma unroll
                        for (int j = 0; j < 4; ++j) { v0[j] = 1.0f - 2.0f / (__expf(2.0f * v0[j]) + 1.0f); v1[j] = 1.0f - 2.0f / (__expf(2.0f * v1[j]) + 1.0f); } }
                    else if (mode == 2) {
#pragma unroll
                        for (int j = 0; j < 4; ++j) { v0[j] = sigmoidf_(v0[j]); v1[j] = sigmoidf_(v1[j]); } }
                    st8(rowp + bj * 128, v0, v1); } }
    }
};
struct EpiLoraUpWA {
    static constexpr bool PERM = true, I8 = false;
    bf16* LD; bf16* AS; const float* w0; const float* a0;
    __device__ __forceinline__ void operator()(const f32x4 (&acc)[2][2][4][2], const Unit& u, int wr, int wc, int fr, int fq) const {
        const int z = u.pn >> 3, kind = (u.pn >> 2) & 1;
        const int row0 = u.pm * 256 + wr * 64 + fr; const int col0 = (u.pn & 3) * 256 + wc * 32 + 8 * fq;
        bf16* base = (kind ? AS : LD) + (size_t)z * T * D; const float* bias = (kind ? a0 : w0) + z * 1024;
        f32x4 bv[2][2];
#pragma unroll
        for (int bj = 0; bj < 2; ++bj)
#pragma unroll
            for (int n = 0; n < 2; ++n) bv[bj][n] = *(const f32x4*)(bias + col0 + bj * 128 + 4 * n);
#pragma unroll
        for (int ai = 0; ai < 2; ++ai)
#pragma unroll
            for (int m = 0; m < 4; ++m) { bf16* rowp = base + (size_t)(row0 + ai * 128 + m * 16) * 1024 + col0;
#pragma unroll
                for (int bj = 0; bj < 2; ++bj) { f32x4 v[2];
#pragma unroll
                    for (int n = 0; n < 2; ++n) { v[n] = acc[ai][bj][m][n] + bv[bj][n];
#pragma unroll
                        for (int j = 0; j < 4; ++j) { const float x = v[n][j];
                            if (kind == 0) v[n][j] = -0.8750612633917001f * sigmoidf_(x);
                            else v[n][j] = sigmoidf_(x); } }
                    st8(rowp + bj * 128, v[0], v[1]); } }
    }
};
struct EpiResid {
    static constexpr bool PERM = true, I8 = false;
    const void* xin; int xin_f32; bf16* out; const float* gate;
    __device__ __forceinline__ void operator()(const f32x4 (&acc)[2][2][4][2], const Unit& u, int wr, int wc, int fr, int fq) const {
        const int row0 = u.pm * 256 + wr * 64 + fr, col0 = u.pn * 256 + wc * 32 + 8 * fq; const int b = u.pm >> 3;
        f32x4 gv[2][2];
#pragma unroll
        for (int bj = 0; bj < 2; ++bj)
#pragma unroll
            for (int n = 0; n < 2; ++n) gv[bj][n] = *(const f32x4*)(gate + (size_t)b * 6144 + col0 + bj * 128 + 4 * n);
        if (xin_f32) {
#pragma unroll
            for (int ai = 0; ai < 2; ++ai)
#pragma unroll
                for (int m = 0; m < 4; ++m) { const size_t off = (size_t)(row0 + ai * 128 + m * 16) * D + col0;
#pragma unroll
                    for (int bj = 0; bj < 2; ++bj) { const f32x4 x0 = *(const f32x4*)((const float*)xin + off + bj * 128), x1 = *(const f32x4*)((const float*)xin + off + bj * 128 + 4);
                        st8(out + off + bj * 128, x0 + gv[bj][0] * acc[ai][bj][m][0], x1 + gv[bj][1] * acc[ai][bj][m][1]); } }
        } else {
#pragma unroll
            for (int ai = 0; ai < 2; ++ai) { u32x4 xr[4][2];
#pragma unroll
                for (int m = 0; m < 4; ++m)
#pragma unroll
                    for (int bj = 0; bj < 2; ++bj) xr[m][bj] = *(const u32x4*)((const bf16*)xin + (size_t)(row0 + ai * 128 + m * 16) * D + col0 + bj * 128);
#pragma unroll
                for (int m = 0; m < 4; ++m) { const size_t off = (size_t)(row0 + ai * 128 + m * 16) * D + col0;
#pragma unroll
                    for (int bj = 0; bj < 2; ++bj) { const u32x4 r = xr[m][bj];
                        const f32x4 x0 = {bf_lo(r.x), bf_hi(r.x), bf_lo(r.y), bf_hi(r.y)}, x1 = {bf_lo(r.z), bf_hi(r.z), bf_lo(r.w), bf_hi(r.w)};
                        st8(out + off + bj * 128, x0 + gv[bj][0] * acc[ai][bj][m][0], x1 + gv[bj][1] * acc[ai][bj][m][1]); } } }
        }
    }
};
struct EpiQKV {
    static constexpr bool PERM = true, I8 = false;
    bf16* Q; bf16* Kb; bf16* Vb; float qscale;
    __device__ __forceinline__ void operator()(const f32x4 (&acc)[2][2][4][2], const Unit& u, int wr, int wc, int fr, int fq) const {
        const int g = u.pn / 12, which = (u.pn % 12) >> 2, hp = u.pn & 3;
        const int row0 = u.pm * 256 + wr * 64 + fr;
        bf16* base = Q + (size_t)which * ((A_K - A_Q) / 2) + (size_t)g * T * D; const float sc = which ? 1.0f : qscale; const int col0 = hp * 256 + wc * 32 + 8 * fq;
#pragma unroll
        for (int ai = 0; ai < 2; ++ai)
#pragma unroll
            for (int m = 0; m < 4; ++m) { bf16* rowp = base + (size_t)(row0 + ai * 128 + m * 16) * 1024 + col0;
#pragma unroll
                for (int bj = 0; bj < 2; ++bj) st8(rowp + bj * 128, acc[ai][bj][m][0] * sc, acc[ai][bj][m][1] * sc); }
    }
};
template <class Inner> struct EpiI8 {
    static constexpr bool PERM = Inner::PERM, I8 = true;
    Inner in; const float* sa; size_t sa_sel; int pn_per_a; const float* sb;
    __device__ __forceinline__ void operator()(const pg8::i32x4 (&acc)[2][2][4][2], const Unit& u, int wr, int wc, int fr, int fq) const {
        const int row0 = u.pm * 256 + wr * 64 + fr; const float* sap = sa + (size_t)(u.pn / pn_per_a) * sa_sel;
        const int colb = u.pn * 256 + wc * 32 + (PERM ? 8 * fq : 4 * fq);
        f32x4 sbv[2][2]; f32x4 f[2][2][4][2];
#pragma unroll
        for (int bj = 0; bj < 2; ++bj)
#pragma unroll
            for (int n = 0; n < 2; ++n) sbv[bj][n] = *(const f32x4*)(sb + colb + bj * 128 + (PERM ? 4 * n : 16 * n));
        float srv[2][4];
#pragma unroll
        for (int ai = 0; ai < 2; ++ai)
#pragma unroll
            for (int m = 0; m < 4; ++m) srv[ai][m] = sap[row0 + ai * 128 + m * 16];
        asm volatile("" : "+v"(srv[0][0]), "+v"(srv[0][1]), "+v"(srv[0][2]), "+v"(srv[0][3]), "+v"(srv[1][0]), "+v"(srv[1][1]), "+v"(srv[1][2]), "+v"(srv[1][3]));
#pragma unroll
        for (int ai = 0; ai < 2; ++ai)
#pragma unroll
            for (int m = 0; m < 4; ++m) { const float sr = srv[ai][m];
#pragma unroll
                for (int bj = 0; bj < 2; ++bj)
#pragma unroll
                    for (int n = 0; n < 2; ++n) f[ai][bj][m][n] = __builtin_convertvector(acc[ai][bj][m][n], f32x4) * (sbv[bj][n] * sr); }
        in(f, u, wr, wc, fr, fq);
    }
};
struct EpiQKV8 {
    static constexpr bool PERM = true, I8 = true;
    bf16* Q; const float* SA; const float* SBq; float qscale;
    __device__ __forceinline__ void operator()(const pg8::i32x4 (&acc)[2][2][4][2], const Unit& u, int wr, int wc, int fr, int fq) const {
        const int g = u.pn / 12, which = (u.pn % 12) >> 2, hp = u.pn & 3;
        const int row0 = u.pm * 256 + wr * 64 + fr;
        bf16* base = Q + (size_t)which * ((A_K - A_Q) / 2) + (size_t)g * T * D; const float sc = which ? 1.0f : qscale; const int col0 = hp * 256 + wc * 32 + 8 * fq;
        const int colb = u.pn * 256 + wc * 32 + 8 * fq;
        f32x4 sbv[2][2];
#pragma unroll
        for (int bj = 0; bj < 2; ++bj)
#pragma unroll
            for (int n = 0; n < 2; ++n) sbv[bj][n] = *(const f32x4*)(SBq + colb + bj * 128 + 4 * n) * sc;
        float sav[2][4];
#pragma unroll
        for (int ai = 0; ai < 2; ++ai)
#pragma unroll
            for (int m = 0; m < 4; ++m) sav[ai][m] = SA[row0 + ai * 128 + m * 16];
#pragma unroll
        for (int ai = 0; ai < 2; ++ai)
#pragma unroll
            for (int m = 0; m < 4; ++m) { const int row = row0 + ai * 128 + m * 16; const float sa = sav[ai][m]; bf16* rowp = base + (size_t)row * 1024 + col0;
#pragma unroll
                for (int bj = 0; bj < 2; ++bj) st8(rowp + bj * 128, __builtin_convertvector(acc[ai][bj][m][0], f32x4) * (sbv[bj][0] * sa), __builtin_convertvector(acc[ai][bj][m][1], f32x4) * (sbv[bj][1] * sa)); }
    }
};
struct EpiGateUp {
    static constexpr bool PERM = true, I8 = false;
    bf16* H; const float* roww;
    __device__ __forceinline__ void operator()(const f32x4 (&acc)[2][2][4][2], const Unit& u, int wr, int wc, int fr, int fq) const {
        const int row0 = u.pm * 256 + wr * 64 + fr; const int col0 = u.pn * 128 + wc * 32 + 8 * fq;
#pragma unroll
        for (int ai = 0; ai < 2; ++ai)
#pragma unroll
            for (int m = 0; m < 4; ++m) { const int row = row0 + ai * 128 + m * 16; const float rw = roww[row]; f32x4 v[2];
#pragma unroll
                for (int n = 0; n < 2; ++n)
#pragma unroll
                    for (int j = 0; j < 4; ++j) { const float gg = acc[ai][0][m][n][j], uu = acc[ai][1][m][n][j]; v[n][j] = gg * sigmoidf_(gg) * uu * rw; }
                st8(H + (size_t)row * FEXP + col0, v[0], v[1]); }
    }
};
struct EpiGateUp8 {
    static constexpr bool PERM = true, I8 = true;
    bf16* H; const LAS float* wtab; const LAS float* stab; const float* sbe; const LAS int* tileE;
    __device__ __forceinline__ void operator()(const pg8::i32x4 (&acc)[2][2][4][2], const Unit& u, int wr, int wc, int fr, int fq) const {
        const int rl0 = wr * 64 + fr; const int col0 = u.pn * 128 + wc * 32 + 8 * fq;
        const int e = __builtin_amdgcn_readfirstlane(tileE[u.pm]); const float* sbp = sbe + (size_t)e * 512 + u.pn * 256 + wc * 32 + 8 * fq;
        f32x4 sg[2], su[2];
#pragma unroll
        for (int n = 0; n < 2; ++n) { sg[n] = *(const f32x4*)(sbp + 4 * n); su[n] = *(const f32x4*)(sbp + 128 + 4 * n); }
#pragma unroll
        for (int ai = 0; ai < 2; ++ai)
#pragma unroll
            for (int m = 0; m < 4; ++m) { const int rl = rl0 + ai * 128 + m * 16; const float rw = wtab[u.ui * 256 + rl]; const float sa = stab[u.ui * 256 + rl]; f32x4 v[2];
#pragma unroll
                for (int n = 0; n < 2; ++n) { const f32x4 g4 = __builtin_convertvector(acc[ai][0][m][n], f32x4) * (sg[n] * sa), u4 = __builtin_convertvector(acc[ai][1][m][n], f32x4) * (su[n] * sa);
#pragma unroll
                    for (int j = 0; j < 4; ++j) { const float gg = g4[j], uu = u4[j]; v[n][j] = gg * sigmoidf_(gg) * uu * rw; } }
                st8(H + (size_t)(u.pm * 256 + rl) * FEXP + col0, v[0], v[1]); }
    }
};
struct EpiPlain {
    static constexpr bool PERM = true, I8 = false;
    bf16* O;
    __device__ __forceinline__ void operator()(const f32x4 (&acc)[2][2][4][2], const Unit& u, int wr, int wc, int fr, int fq) const {
        const int row0 = u.pm * 256 + wr * 64 + fr; const int col0 = u.pn * 256 + wc * 32 + 8 * fq;
#pragma unroll
        for (int ai = 0; ai < 2; ++ai)
#pragma unroll
            for (int m = 0; m < 4; ++m) { bf16* rowp = O + (size_t)(row0 + ai * 128 + m * 16) * 1024 + col0;
#pragma unroll
                for (int bj = 0; bj < 2; ++bj) st8(rowp + bj * 128, acc[ai][bj][m][0], acc[ai][bj][m][1]); }
    }
};

struct Args {
    const float* in[32]; float* out; unsigned char* ws; int ph_lo, ph_hi;
};
enum { I_X = 0, I_C, I_ADAW, I_ADAB, I_NTM, I_NCM, I_MU, I_WRKV, I_W0, I_W1, I_W2, I_A0, I_A1, I_A2, I_G1, I_G2, I_KK, I_KA, I_RK, I_LNW, I_LNB, I_RWO,
       I_AQKV, I_AWO, I_RG, I_RGB, I_RE, I_REB, I_WG, I_WU, I_WD, I_FG };

struct Frame {
    LAS unsigned char* lds; int tid, lane, wave, G, gw, NGW;
    unsigned char* ws; const float* const* in; float* out;
};

__device__ __forceinline__ void row_load(const float* p, int lane, f32x4 (&v)[4]) {
#pragma unroll
    for (int j = 0; j < 4; ++j) v[j] = *(const f32x4*)(p + 4 * lane + 256 * j);
}
__device__ __forceinline__ void row_load_bf16(const bf16* p, int lane, f32x4 (&v)[4]) {
#pragma unroll
    for (int j = 0; j < 4; ++j) { const u32x2 r = *(const u32x2*)(p + 4 * lane + 256 * j); v[j] = (f32x4){bf_lo(r.x), bf_hi(r.x), bf_lo(r.y), bf_hi(r.y)}; }
}
__device__ __forceinline__ void row_store(float* p, int lane, const f32x4 (&v)[4]) {
#pragma unroll
    for (int j = 0; j < 4; ++j) *(f32x4*)(p + 4 * lane + 256 * j) = v[j];
}
__device__ __forceinline__ void row_store_bf16(bf16* p, int lane, const f32x4 (&v)[4]) {
#pragma unroll
    for (int j = 0; j < 4; ++j) { u32x2 w; w.x = pk2(v[j][0], v[j][1]); w.y = pk2(v[j][2], v[j][3]); *(u32x2*)(p + 4 * lane + 256 * j) = w; }
}
__device__ __forceinline__ void row_store_i8(signed char* p, float* scl, int lane, const f32x4 (&v)[4]) {
    float am = 0.f;
#pragma unroll
    for (int j = 0; j < 4; ++j) am = fmaxf(am, fmaxf(fmaxf(fabsf(v[j][0]), fabsf(v[j][1])), fmaxf(fabsf(v[j][2]), fabsf(v[j][3]))));
    am = fmaxf(wave_max(am), 1e-20f); const float inv = 127.0f / am;
    if (lane == 0) *scl = am * (1.0f / 127.0f);
#pragma unroll
    for (int j = 0; j < 4; ++j) *(unsigned*)(p + 4 * lane + 256 * j) = pack_i8x4(v[j], inv);
}
struct TokTab { const int* toke; const int* tokr; const LAS int* offs; };
__device__ __forceinline__ void row_combine(f32x4 (&v)[4], const bf16* ys, const TokTab& tt, int row, const float* gac, int lane) {
    const int p0 = tt.offs[tt.toke[2 * row]] + tt.tokr[2 * row], p1 = tt.offs[tt.toke[2 * row + 1]] + tt.tokr[2 * row + 1];
    const bf16* y0 = ys + (size_t)p0 * D; const bf16* y1 = ys + (size_t)p1 * D;
#pragma unroll
    for (int j = 0; j < 4; ++j) { const u32x2 a = *(const u32x2*)(y0 + 4 * lane + 256 * j), b = *(const u32x2*)(y1 + 4 * lane + 256 * j); const f32x4 g = *(const f32x4*)(gac + 4 * lane + 256 * j);
        v[j][0] += g[0] * (bf_lo(a.x) + bf_lo(b.x)); v[j][1] += g[1] * (bf_hi(a.x) + bf_hi(b.x)); v[j][2] += g[2] * (bf_lo(a.y) + bf_lo(b.y)); v[j][3] += g[3] * (bf_hi(a.y) + bf_hi(b.y)); }
}
__device__ __forceinline__ void row_norm_mod(const f32x4 (&x)[4], const float* gain, const float* sc, const float* sh, int lane, f32x4 (&h)[4]) {
    float s = 0.f;
#pragma unroll
    for (int j = 0; j < 4; ++j) s += (x[j][0] * x[j][0] + x[j][1] * x[j][1]) + (x[j][2] * x[j][2] + x[j][3] * x[j][3]);
    const float rstd = rsqrtf(wave_sum(s, lane) * (1.0f / D) + RMS_EPS);
#pragma unroll
    for (int j = 0; j < 4; ++j) { const f32x4 g = *(const f32x4*)(gain + 4 * lane + 256 * j), c = *(const f32x4*)(sc + 4 * lane + 256 * j), b = *(const f32x4*)(sh + 4 * lane + 256 * j);
        h[j] = x[j] * rstd * g * (1.0f + c) + b; }
}
__device__ __forceinline__ void transpose_item(const float* W, int ldw, bf16* dst, int ldd, LAS float* scr, int lane) {
    { const int r8 = lane >> 3, c4 = (lane & 7) * 4;
      f32x4 v[8];
#pragma unroll
      for (int i = 0; i < 8; ++i) v[i] = *(const f32x4*)(W + (size_t)(8 * i + r8) * ldw + c4);
#pragma unroll
      for (int i = 0; i < 8; ++i) { LAS float* p = scr + (8 * i + r8) * 33 + c4; p[0] = v[i][0]; p[1] = v[i][1]; p[2] = v[i][2]; p[3] = v[i][3]; } }
    LDS_WAIT(); asm volatile("" ::: "memory");
    const int c = lane & 7;
#pragma unroll
    for (int j = 0; j < 4; ++j) { const int n = (lane >> 3) + 8 * j; const LAS float* s = scr + (8 * c) * 33 + n;
        u32x4 o; o.x = pk2(s[0 * 33], s[1 * 33]); o.y = pk2(s[2 * 33], s[3 * 33]); o.z = pk2(s[4 * 33], s[5 * 33]); o.w = pk2(s[6 * 33], s[7 * 33]);
        *(u32x4*)(dst + (size_t)n * ldd + 8 * c) = o; }
    LDS_WAIT(); asm volatile("" ::: "memory");
}

__device__ __forceinline__ void conv8_cols32(Frame& F, const float* src, int ldw, signed char* dst, float* scl) {
    LAS float* scr = (LAS float*)(F.lds + 49152 + F.wave * 8704); LAS float* pm = (LAS float*)(F.lds + 118784);
    const int r8 = F.lane >> 3, c4 = (F.lane & 7) * 4;
    f32x4 v[16]; f32x4 mx = {0.f, 0.f, 0.f, 0.f};
#pragma unroll
    for (int i = 0; i < 16; ++i) { v[i] = *(const f32x4*)(src + (size_t)(F.wave * 128 + 8 * i + r8) * ldw + c4);
        mx[0] = fmaxf(mx[0], fabsf(v[i][0])); mx[1] = fmaxf(mx[1], fabsf(v[i][1])); mx[2] = fmaxf(mx[2], fabsf(v[i][2])); mx[3] = fmaxf(mx[3], fabsf(v[i][3])); }
#pragma unroll
    for (int q = 0; q < 4; ++q) { float a = mx[q]; a = fmaxf(a, dpp_ror(a, 8)); a = bfly16_max(a); a = bfly32_max(a); mx[q] = a; }
    if (r8 == 0) *(LAS f32x4*)(pm + F.wave * 32 + c4) = mx;
    __syncthreads();
    f32x4 cm = *(const LAS f32x4*)(pm + c4);
#pragma unroll
    for (int w = 1; w < 8; ++w) { const f32x4 o = *(const LAS f32x4*)(pm + w * 32 + c4); cm[0] = fmaxf(cm[0], o[0]); cm[1] = fmaxf(cm[1], o[1]); cm[2] = fmaxf(cm[2], o[2]); cm[3] = fmaxf(cm[3], o[3]); }
#pragma unroll
    for (int q = 0; q < 4; ++q) cm[q] = fmaxf(cm[q], 1e-20f);
    if (F.wave == 0 && r8 == 0) *(f32x4*)(scl + c4) = cm * (1.0f / 127.0f);
#pragma unroll
    for (int kh = 0; kh < 2; ++kh) {
#pragma unroll
        for (int i = 0; i < 8; ++i) { LAS float* p = scr + (8 * i + r8) * 33 + c4; const f32x4 x = v[8 * kh + i]; p[0] = x[0] * (127.0f / cm[0]); p[1] = x[1] * (127.0f / cm[1]); p[2] = x[2] * (127.0f / cm[2]); p[3] = x[3] * (127.0f / cm[3]); }
        LDS_WAIT(); asm volatile("" ::: "memory");
        const int c = F.lane & 7;
#pragma unroll
        for (int jj = 0; jj < 4; ++jj) { const int n = (F.lane >> 3) + 8 * jj; const LAS float* sp = scr + (8 * c) * 33 + n;
            u32x2 o; o.x = pack_i8x4((f32x4){sp[0 * 33], sp[1 * 33], sp[2 * 33], sp[3 * 33]}, 1.0f); o.y = pack_i8x4((f32x4){sp[4 * 33], sp[5 * 33], sp[6 * 33], sp[7 * 33]}, 1.0f);
            *(u32x2*)(dst + (size_t)n * D + (F.wave * 2 + kh) * 64 + 8 * c) = o; }
        LDS_WAIT(); asm volatile("" ::: "memory");
    }
    __syncthreads();
}
__device__ __forceinline__ void phase_prologue(Frame& F) {
    const float* c = F.in[I_C]; const float* adaw = F.in[I_ADAW]; const float* adab = F.in[I_ADAB];
    float* mod = (float*)(F.ws + WS_MOD);
    LAS float* sc = (LAS float*)F.lds;
    LAS float* part = (LAS float*)(F.lds + 32768);
    for (int i = F.tid; i < NB * D; i += NTHREADS) { const float v = c[i]; sc[i] = v / (1.0f + __expf(-v)); }
    __syncthreads();
    for (int u = blockIdx.x; u < DEPTH * 192; u += F.G) {
        const int l = u / 192, n0 = (u % 192) * 32; const int r8 = F.lane >> 3, c4 = (F.lane & 7) * 4;
        const float* W = adaw + (size_t)l * D * 6144 + n0 + c4;
        f32x4 v[16];
#pragma unroll
        for (int i = 0; i < 16; ++i) v[i] = *(const f32x4*)(W + (size_t)(F.wave * 128 + 8 * i + r8) * 6144);
        f32x4 acc[8];
#pragma unroll
        for (int b = 0; b < 8; ++b) acc[b] = (f32x4){0.f, 0.f, 0.f, 0.f};
#pragma unroll
        for (int i = 0; i < 16; ++i) { const int k = F.wave * 128 + 8 * i + r8;
#pragma unroll
            for (int b = 0; b < 8; ++b) acc[b] += v[i] * sc[b * D + k]; }
#pragma unroll
        for (int b = 0; b < 8; ++b)
#pragma unroll
            for (int q = 0; q < 4; ++q) { float a = acc[b][q]; a += dpp_ror(a, 8); a = bfly16_sum(a); a = bfly32_sum(a); acc[b][q] = a; }
        if (r8 == 0) {
#pragma unroll
            for (int b = 0; b < 8; ++b) *(LAS f32x4*)(part + (F.wave * 8 + b) * 32 + c4) = acc[b]; }
        __syncthreads();
        if (F.tid < 256) { const int b = F.tid >> 5, cc = F.tid & 31; float sum = adab[l * 6144 + n0 + cc];
#pragma unroll
            for (int w = 0; w < 8; ++w) sum += part[(w * 8 + b) * 32 + cc];
            mod[(size_t)(l * 8 + b) * 6144 + n0 + cc] = sum; }
        __syncthreads();
    }
    LAS float* scr = (LAS float*)(F.lds + 49152 + F.wave * 8704);
    constexpr int I_SQ = 16 * 32;
    constexpr int I_QKV = 16 * 288;
    constexpr int PER_RW = 4 * I_SQ, PER_AT = I_QKV + I_SQ, NIT = 2 * PER_RW + 2 * PER_AT;
    for (int it = F.gw; it < NIT; it += F.NGW) {
        int r = it;
        if (r < 2 * PER_RW) { const int j = r / PER_RW; r %= PER_RW; const int mi = r / I_SQ; r %= I_SQ; const int kb = r / 32, nb = r % 32;
            if (mi < 3) { }
            else transpose_item(F.in[I_RWO] + ((size_t)j * D + kb * 64) * D + nb * 32, D, (bf16*)(F.ws + WS_W + j * W_RW_STRIDE + W_RWO) + (size_t)(nb * 32) * D + kb * 64, D, scr, F.lane);
        } else { r -= 2 * PER_RW; const int j = r / PER_AT; r %= PER_AT;
            if (r < I_QKV) { }
            else { r -= I_QKV; const int kb = r / 32, nb = r % 32;
                transpose_item(F.in[I_AWO] + ((size_t)j * D + kb * 64) * D + nb * 32, D, (bf16*)(F.ws + WS_WA + j * W_AT_STRIDE + W_AWO) + (size_t)(nb * 32) * D + kb * 64, D, scr, F.lane); }
        }
    }
    for (int u = blockIdx.x; u < 2 * 288 + 2 * 96; u += F.G) {
        if (u < 2 * 288) { const int j = u / 288, n0 = (u % 288) * 32;
            conv8_cols32(F, F.in[I_AQKV] + (size_t)j * D * QKVW + n0, QKVW, (signed char*)(F.ws + WS_WA + j * W_AT_STRIDE + W_QKV) + (size_t)n0 * D, (float*)(F.ws + WS_WA + j * W_AT_STRIDE + W_QKVS) + n0); }
        else { const int r = u - 2 * 288, j = r / 96, mi = (r % 96) / 32, n0 = (r % 32) * 32;
            conv8_cols32(F, F.in[I_WRKV] + (size_t)(j * 3 + mi) * D * D + n0, D, (signed char*)(F.ws + WS_W + j * W_RW_STRIDE + W_RKV) + (size_t)(mi * D + n0) * D, (float*)(F.ws + WS_W + j * W_RW_STRIDE + W_RKVS) + mi * D + n0); }
    }
    const int gt = blockIdx.x * NTHREADS + F.tid, NGT = F.G * NTHREADS;
    for (int j = 0; j < 2; ++j) {
        bf16* ldn = (bf16*)(F.ws + WS_W + j * W_RW_STRIDE + W_LDN);
        const float* mu = F.in[I_MU] + (size_t)j * 6 * D;
        for (int i0 = gt; i0 < 512 * 2048; i0 += 8 * NGT) { float t[8];
#pragma unroll
            for (int u = 0; u < 8; ++u) { const int i = i0 + u * NGT; float v = 0.f;
                if (i < 512 * 2048) { const int n = i >> 11, k = i & 2047, kk = k & 1023; int mi;
                    if (n < 256) { const int blk = n >> 6, z = blk >> 1, isA = blk & 1, nn = n & 63;
                        v = (isA ? F.in[I_A1] : F.in[I_W1])[((size_t)(j * 2 + z) * D + kk) * 64 + nn]; mi = isA ? 4 : 3; }
                    else { const int z = (n - 256) >> 7, nn = n & 127; v = F.in[I_G1][((size_t)(j * 2 + z) * D + kk) * 128 + nn]; mi = 5; }
                    if (k >= 1024) v *= mu[mi * D + kk]; }
                t[u] = v; }
#pragma unroll
            for (int u = 0; u < 8; ++u) { const int i = i0 + u * NGT; if (i < 512 * 2048) ldn[i] = (bf16)f2bf(t[u]); } }
        bf16* lwa = (bf16*)(F.ws + WS_W + j * W_RW_STRIDE + W_LUPWA);
        for (int i0 = gt; i0 < 4096 * 128; i0 += 8 * NGT) { float t[8];
#pragma unroll
            for (int u = 0; u < 8; ++u) { const int i = i0 + u * NGT; float v = 0.f;
                if (i < 4096 * 128) { const int n = i >> 7, k = i & 127; const int z = n >> 11, isA = (n >> 10) & 1, col = n & 1023;
                    if ((k >> 6) == isA) v = (isA ? F.in[I_A2] : F.in[I_W2])[((size_t)(j * 2 + z) * 64 + (k & 63)) * D + col]; }
                t[u] = v; }
#pragma unroll
            for (int u = 0; u < 8; ++u) { const int i = i0 + u * NGT; if (i < 4096 * 128) lwa[i] = (bf16)f2bf(t[u]); } }
        bf16* lg = (bf16*)(F.ws + WS_W + j * W_RW_STRIDE + W_LUPG);
        for (int i0 = gt; i0 < 2048 * 128; i0 += 8 * NGT) { float t[8];
#pragma unroll
            for (int u = 0; u < 8; ++u) { const int i = i0 + u * NGT; float v = 0.f;
                if (i < 2048 * 128) { const int n = i >> 7, k = i & 127; const int z = n >> 10, col = n & 1023; v = F.in[I_G2][((size_t)(j * 2 + z) * 128 + k) * D + col]; }
                t[u] = v; }
#pragma unroll
            for (int u = 0; u < 8; ++u) { const int i = i0 + u * NGT; if (i < 2048 * 128) lg[i] = (bf16)f2bf(t[u]); } }
    }
}

__device__ __forceinline__ void moe_tables(Frame& F, int l) {
    LAS int* tileE = (LAS int*)(F.lds + TILEE_OFF); LAS int* tileJ = (LAS int*)(F.lds + TILEJ_OFF); LAS int* offs = (LAS int*)(F.lds + OFFS_OFF); LAS int* cl = (LAS int*)(F.lds + CNTL_OFF);
    const unsigned* cnt = (const unsigned*)(F.ws + WS_CTL) + CW_CNT + l * 32;
    if (F.tid < 32) cl[F.tid] = (int)__hip_atomic_load(cnt + F.tid, __ATOMIC_RELAXED, __HIP_MEMORY_SCOPE_AGENT);
    __syncthreads();
    if (F.tid < 32) {
        int tb = 0;
#pragma clang loop unroll(disable)
        for (int e = 0; e < F.tid; ++e) tb += (cl[e] + 255) >> 8;
        const int ne = (cl[F.tid] + 255) >> 8; offs[F.tid] = tb * 256;
#pragma clang loop unroll(disable)
        for (int k = 0; k < ne; ++k) if (tb + k < 160) { tileE[tb + k] = F.tid; tileJ[tb + k] = k; }
        if (F.tid == 31) { const int nt = tb + ne; tileE[160] = nt < 160 ? nt : 160; offs[32] = nt * 256; }
    }
    __syncthreads();
}
__device__ __forceinline__ void rw_hrow(Frame& F, int l, bool combine, const void* xsrc, bf16* xdst, bool own, int row, f32x4 (&h)[4]) {
    const int b = row >> 11; const float* mod = (const float*)(F.ws + WS_MOD);
    f32x4 x[4]; if (l == 0) row_load((const float*)xsrc + (size_t)row * D, F.lane, x); else row_load_bf16((const bf16*)xsrc + (size_t)row * D, F.lane, x);
    if (combine) { row_combine(x, (const bf16*)(F.ws + WS_ACT + A_YS), TokTab{(const int*)(F.ws + WS_TOKE), (const int*)(F.ws + WS_TOKR), (const LAS int*)(F.lds + OFFS_OFF)}, row, mod + (size_t)((l - 1) * 8 + b) * 6144 + 5 * D, F.lane);
        if (own) row_store_bf16(xdst + (size_t)row * D, F.lane, x); }
    const float* mp = mod + (size_t)(l * 8 + b) * 6144;
    row_norm_mod(x, F.in[I_NTM] + l * D, mp + 1 * D, mp + 0 * D, F.lane, h);
}
__device__ __forceinline__ void phase_rw_norm(Frame& F, int l, bool combine, const void* xsrc, bf16* xdst) {
    if (combine) moe_tables(F, l - 1);
    const int j = l >> 1; const float* mu = F.in[I_MU] + (size_t)j * 6 * D;
    signed char* xs = (signed char*)(F.ws + WS_ACT + A_XS); bf16* hx = (bf16*)(F.ws + WS_ACT + A_HX); float* sxs = (float*)(F.ws + WS_SCL + SCL_XS);
    for (int ch = F.gw; ch < T / 8; ch += F.NGW) {
        const int row0 = ch * 8, t0 = row0 & (SEQ - 1);
        f32x4 prev[4], cur[4], nxt[4];
        if (t0 > 0) rw_hrow(F, l, combine, xsrc, xdst, false, row0 - 1, prev);
        else {
#pragma unroll
            for (int q = 0; q < 4; ++q) prev[q] = (f32x4){0.f, 0.f, 0.f, 0.f}; }
        rw_hrow(F, l, combine, xsrc, xdst, true, row0, cur);
        for (int i = 0; i < 8; ++i) {
            const int row = row0 + i;
            if (t0 + i + 1 < SEQ) rw_hrow(F, l, combine, xsrc, xdst, i < 7, row + 1, nxt);
            else {
#pragma unroll
                for (int q = 0; q < 4; ++q) nxt[q] = (f32x4){0.f, 0.f, 0.f, 0.f}; }
            f32x4 xx[4];
#pragma unroll
            for (int q = 0; q < 4; ++q) xx[q] = 0.5f * (prev[q] + nxt[q]) - cur[q];
#pragma unroll
            for (int mi = 0; mi < 3; ++mi) { f32x4 o[4];
#pragma unroll
                for (int q = 0; q < 4; ++q) { const f32x4 m = *(const f32x4*)(mu + mi * D + 4 * F.lane + 256 * q); o[q] = cur[q] + xx[q] * m; }
                row_store_i8(xs + ((size_t)mi * T + row) * D, sxs + (size_t)mi * T + row, F.lane, o); }
            row_store_bf16(hx + (size_t)row * 2048, F.lane, cur);
            row_store_bf16(hx + (size_t)row * 2048 + D, F.lane, xx);
#pragma unroll
            for (int q = 0; q < 4; ++q) { prev[q] = cur[q]; cur[q] = nxt[q]; }
        }
    }
}

__device__ __forceinline__ void phase_at_norm(Frame& F, int l, const bf16* xsrc, bf16* xdst) {
    moe_tables(F, l - 1);
    const float* mod = (const float*)(F.ws + WS_MOD); signed char* H8 = (signed char*)(F.ws + WS_ACT + A_H); float* SA = (float*)(F.ws + WS_SA);
    for (int row = F.gw; row < T; row += F.NGW) {
        const int b = row >> 11; f32x4 x[4], h[4]; row_load_bf16(xsrc + (size_t)row * D, F.lane, x);
        row_combine(x, (const bf16*)(F.ws + WS_ACT + A_YS), TokTab{(const int*)(F.ws + WS_TOKE), (const int*)(F.ws + WS_TOKR), (const LAS int*)(F.lds + OFFS_OFF)}, row, mod + (size_t)((l - 1) * 8 + b) * 6144 + 5 * D, F.lane);
        row_store_bf16(xdst + (size_t)row * D, F.lane, x);
        const float* mp = mod + (size_t)(l * 8 + b) * 6144;
        row_norm_mod(x, F.in[I_NTM] + l * D, mp + 1 * D, mp + 0 * D, F.lane, h);
        float am = 0.f;
#pragma unroll
        for (int j = 0; j < 4; ++j) am = fmaxf(am, fmaxf(fmaxf(fabsf(h[j][0]), fabsf(h[j][1])), fmaxf(fabsf(h[j][2]), fabsf(h[j][3]))));
        am = fmaxf(wave_max(am), 1e-20f); const float inv = 127.0f / am;
        if (F.lane == 0) SA[row] = am * (1.0f / 127.0f);
#pragma unroll
        for (int j = 0; j < 4; ++j) *(unsigned*)(H8 + (size_t)row * D + 4 * F.lane + 256 * j) = pack_i8x4(h[j], inv);
    }
}
__device__ __forceinline__ void phase_final(Frame& F, const bf16* xsrc) {
    moe_tables(F, DEPTH - 1);
    const float* mod = (const float*)(F.ws + WS_MOD); const float* fg = F.in[I_FG];
    for (int row = F.gw; row < T; row += F.NGW) {
        const int b = row >> 11; f32x4 x[4]; row_load_bf16(xsrc + (size_t)row * D, F.lane, x);
        row_combine(x, (const bf16*)(F.ws + WS_ACT + A_YS), TokTab{(const int*)(F.ws + WS_TOKE), (const int*)(F.ws + WS_TOKR), (const LAS int*)(F.lds + OFFS_OFF)}, row, mod + (size_t)(3 * 8 + b) * 6144 + 5 * D, F.lane);
        float s = 0.f;
#pragma unroll
        for (int j = 0; j < 4; ++j) s += (x[j][0] * x[j][0] + x[j][1] * x[j][1]) + (x[j][2] * x[j][2] + x[j][3] * x[j][3]);
        const float rstd = rsqrtf(wave_sum(s, F.lane) * (1.0f / D) + RMS_EPS);
#pragma unroll
        for (int j = 0; j < 4; ++j) { const f32x4 g = *(const f32x4*)(fg + 4 * F.lane + 256 * j); x[j] = x[j] * rstd * g; }
        row_store(F.out + (size_t)row * D, F.lane, x);
    }
}

__device__ __forceinline__ void moe_convert(Frame& F, int l, int bfirst, int bstride);
__device__ __forceinline__ void phase_moe_route(Frame& F, int l, const bf16* xsrc, int cnt_shift = 0) {
    const float* mod = (const float*)(F.ws + WS_MOD); bf16* HN = (bf16*)(F.ws + WS_ACT + A_HN2);
    LAS int* lcnt = (LAS int*)F.lds; LAS int* gbase = lcnt + 32; LAS int* inf_e = lcnt + 64; LAS int* inf_r = inf_e + 128; LAS float* inf_w = (LAS float*)(inf_r + 128);
    unsigned* cnt = (unsigned*)(F.ws + WS_CTL) + CW_CNT + (l + cnt_shift) * 32;
    int* toke = (int*)(F.ws + WS_TOKE); int* tokr = (int*)(F.ws + WS_TOKR); float* tokw = (float*)(F.ws + WS_TOKW);
    const float* rg = F.in[I_RG] + (size_t)l * D * 4; const float* rgb = F.in[I_RGB] + l * 4;
    LAS float* RW = (LAS float*)(F.lds + 4096);
    { float t[8];
#pragma unroll
      for (int u = 0; u < 8; ++u) t[u] = rg[F.tid + u * NTHREADS];
#pragma unroll
      for (int u = 0; u < 8; ++u) { const int i = F.tid + u * NTHREADS; RW[(i & 3) * D + (i >> 2)] = t[u]; }
      const float* rea = F.in[I_RE] + (size_t)l * 4 * D * 8;
      for (int i0 = F.tid; i0 < 4 * D * 8; i0 += 8 * NTHREADS) {
#pragma unroll
          for (int u = 0; u < 8; ++u) t[u] = rea[i0 + u * NTHREADS];
#pragma unroll
          for (int u = 0; u < 8; ++u) { const int i = i0 + u * NTHREADS; RW[(4 + (i >> 13) * 8 + (i & 7)) * D + ((i >> 3) & 1023)] = t[u]; } } }
    for (int cb = blockIdx.x; cb < T / 64; cb += F.G) {
        if (F.tid < 32) lcnt[F.tid] = 0;
        __syncthreads();
        for (int i = 0; i < 8; ++i) {
            const int lr = F.wave * 8 + i, row = cb * 64 + lr, b = row >> 11;
            f32x4 x[4], h[4]; row_load_bf16(xsrc + (size_t)row * D, F.lane, x);
            const float* mp = mod + (size_t)(l * 8 + b) * 6144;
            row_norm_mod(x, F.in[I_NCM] + l * D, mp + 4 * D, mp + 3 * D, F.lane, h);
            row_store_i8((signed char*)HN + (size_t)row * D, (float*)(F.ws + WS_SCL + SCL_HN) + row, F.lane, h);
            float gl[4] = {0.f, 0.f, 0.f, 0.f};
#pragma unroll
            for (int e = 0; e < 4; ++e)
#pragma unroll
                for (int j = 0; j < 4; ++j) { const f32x4 w = *(const LAS f32x4*)(RW + e * D + 4 * F.lane + 256 * j); gl[e] += (h[j][0] * w[0] + h[j][1] * w[1]) + (h[j][2] * w[2] + h[j][3] * w[3]); }
#pragma unroll
            for (int e = 0; e < 4; ++e) gl[e] = wave_sum(gl[e], F.lane) + rgb[e];
            const float gm = fmaxf(fmaxf(gl[0], gl[1]), fmaxf(gl[2], gl[3]));
            const int gtop = (gl[0] == gm) ? 0 : (gl[1] == gm) ? 1 : (gl[2] == gm) ? 2 : 3;
            const float pg = 1.0f / (__expf(gl[0] - gm) + __expf(gl[1] - gm) + __expf(gl[2] - gm) + __expf(gl[3] - gm));
            const float* reb = F.in[I_REB] + (l * 4 + gtop) * 8; const LAS float* rwe = RW + (4 + gtop * 8) * D + 4 * F.lane;
            float el[8];
#pragma unroll
            for (int e = 0; e < 8; ++e) { el[e] = 0.f;
#pragma unroll
                for (int j = 0; j < 4; ++j) { const f32x4 w = *(const LAS f32x4*)(rwe + e * D + 256 * j); el[e] += (h[j][0] * w[0] + h[j][1] * w[1]) + (h[j][2] * w[2] + h[j][3] * w[3]); } }
#pragma unroll
            for (int e = 0; e < 8; ++e) el[e] = wave_sum(el[e], F.lane) + reb[e];
            float v0 = el[0]; int i0 = 0;
#pragma unroll
            for (int e = 1; e < 8; ++e) if (el[e] > v0) { v0 = el[e]; i0 = e; }
            float v1 = -3.0e38f; int i1 = 0;
#pragma unroll
            for (int e = 0; e < 8; ++e) if (e != i0 && el[e] > v1) { v1 = el[e]; i1 = e; }
            const float ex = __expf(v1 - v0); const float w0 = pg / (1.0f + ex), w1 = pg * ex / (1.0f + ex);
            if (F.lane == 0) {
                const int e0 = gtop * 8 + i0, e1 = gtop * 8 + i1;
                const int r0 = __hip_atomic_fetch_add(lcnt + e0, 1, __ATOMIC_RELAXED, __HIP_MEMORY_SCOPE_WORKGROUP);
                const int r1 = __hip_atomic_fetch_add(lcnt + e1, 1, __ATOMIC_RELAXED, __HIP_MEMORY_SCOPE_WORKGROUP);
                inf_e[lr * 2] = e0; inf_e[lr * 2 + 1] = e1; inf_r[lr * 2] = r0; inf_r[lr * 2 + 1] = r1; inf_w[lr * 2] = w0; inf_w[lr * 2 + 1] = w1;
            }
        }
        __syncthreads();
        if (F.tid < 32) gbase[F.tid] = (int)__hip_atomic_fetch_add(cnt + F.tid, (unsigned)lcnt[F.tid], __ATOMIC_RELAXED, __HIP_MEMORY_SCOPE_AGENT);
        __syncthreads();
        if (F.tid < 128) { const int idx = cb * 128 + F.tid; const int e = inf_e[F.tid]; const int rk = gbase[e] + inf_r[F.tid]; toke[idx] = e; tokr[idx] = rk;
            ((int*)(F.ws + WS_ACT + A_LSTT))[(size_t)e * LCAP + rk] = idx >> 1; ((float*)(F.ws + WS_ACT + A_LSTW))[(size_t)e * LCAP + rk] = inf_w[F.tid]; }
        __syncthreads();
    }
    if (l == 0 && cnt_shift == 0) moe_convert(F, 0, (int)blockIdx.x, F.G);
}
__device__ __forceinline__ void moe_convert(Frame& F, int l, int bfirst, int bstride) {
    LAS float* scr = (LAS float*)(F.lds + 49152 + F.wave * 8704);
    signed char* WGU = (signed char*)(F.ws + ws_wm_of(l) + W_GU); float* SGU = (float*)(F.ws + ws_wm_of(l) + W_GUS); bf16* WDN = (bf16*)(F.ws + ws_wm_of(l) + W_DN);
    for (int it = bfirst; it < NEXP * 16; it += bstride) {
        const int e = it >> 4, up = (it >> 3) & 1, nb = it & 7, n0 = nb * 32;
        const int drow = (n0 >> 7) * 256 + up * 128 + (n0 & 127);
        conv8_cols32(F, (up ? F.in[I_WU] : F.in[I_WG]) + (size_t)(l * 32 + e) * D * FEXP + n0, FEXP, WGU + ((size_t)e * 512 + drow) * D, SGU + (size_t)e * 512 + drow);
    }
    for (int it = bfirst * NWAVES + F.wave; it < NEXP * 128; it += bstride * NWAVES) {
        const int e = it >> 7, r = it & 127; const int kb = r / 32, nb = r % 32;
        const float* src = F.in[I_WD] + ((size_t)(l * 32 + e) * FEXP + kb * 64) * D + nb * 32;
        transpose_item(src, D, WDN + ((size_t)e * D + nb * 32) * FEXP + kb * 64, FEXP, scr, F.lane);
    }
}

#ifndef SCAN_DUP
#define SCAN_DUP 0
#endif
namespace wk {
constexpr int P = 72, PB = 144, MAT = 64 * PB;
constexpr int PF = 68;
constexpr int O_NAB = 0, O_GS = 17408, O_GC = 19456, O_M0 = 20480;
constexpr int O_AT = O_M0, O_RT = O_AT + MAT, O_BT = O_RT + MAT, O_KT = O_BT + MAT, O_VV = O_KT + MAT, O_LAK = O_VV + MAT, O_MRB = O_LAK + MAT, O_MRK = O_MRB + MAT,
              O_NB = O_MRK + MAT, O_TT = O_NB + MAT, O_XT = O_TT + MAT, O_UT = O_XT + MAT, O_MT = O_UT + MAT, O_H0 = O_MT + MAT, O_H1 = O_H0 + MAT, O_END = O_H1 + MAT;
static_assert(O_END <= LDS_MISC, "scan LDS map");
typedef union { u32x4 u; bf16x8 v; } frag_t;
__device__ __forceinline__ bf16x8 zfrag() { frag_t z; z.u = (u32x4){0u, 0u, 0u, 0u}; return z.v; }
__device__ __forceinline__ bf16x8 ldrow(const LAS unsigned char* M, int row, int col) { return *(const LAS bf16x8*)(M + row * PB + col * 2); }
__device__ __forceinline__ bf16x8 ldtr(unsigned base, int r0, int c0, int lane) {
    const int g = lane >> 4, i = lane & 15, qq = i >> 2, p = i & 3;
    const unsigned a0 = base + (unsigned)((r0 + 8 * g + qq) * PB + (c0 + 4 * p) * 2), a1 = a0 + 4u * PB;
    u32x2 lo, hi;
    asm volatile("ds_read_b64_tr_b16 %0, %2\n\tds_read_b64_tr_b16 %1, %3\n\ts_waitcnt lgkmcnt(0)" : "=&v"(lo), "=&v"(hi) : "v"(a0), "v"(a1) : "memory");
    frag_t f; f.u.x = lo.x; f.u.y = lo.y; f.u.z = hi.x; f.u.w = hi.y; return f.v;
}
__device__ __forceinline__ void st4bf(LAS unsigned char* M, int row, int col, const f32x4& v) { u32x2 w; w.x = pk2(v[0], v[1]); w.y = pk2(v[2], v[3]); *(LAS u32x2*)(M + row * PB + col * 2) = w; }
#define WK_MFMA(a, b, c) __builtin_amdgcn_mfma_f32_16x16x32_bf16(a, b, c, 0, 0, 0)
template <int M> __device__ __forceinline__ float rshare(float v) { return __int_as_float(__builtin_amdgcn_update_dpp(0, __float_as_int(v), 0x150 + M, 0xf, 0xf, false)); }
#define WK_BAR() do { asm volatile("s_waitcnt lgkmcnt(0)" ::: "memory"); __builtin_amdgcn_s_barrier(); asm volatile("" ::: "memory"); } while (0)
}

__device__ __forceinline__ void phase_scan(Frame& F, int l) {
    using namespace wk;
    const int j = l >> 1;
    const bf16* Rb = (const bf16*)(F.ws + WS_ACT + A_RKV); const bf16* Kb = Rb + (size_t)T * D; const bf16* Vb = Kb + (size_t)T * D;
    const bf16* LD = (const bf16*)(F.ws + WS_ACT + A_LDEC); const bf16* AS = (const bf16*)(F.ws + WS_ACT + A_ASIG);
    bf16* Y = (bf16*)(F.ws + WS_ACT + A_Y); float* SB = (float*)(F.ws + WS_SB);
    LAS unsigned char* L = F.lds; const unsigned La = (unsigned)(size_t)L;
    LAS float* NAB = (LAS float*)(L + O_NAB); LAS float* GS = (LAS float*)(L + O_GS); LAS float* GC = (LAS float*)(L + O_GC);
    const int tid0 = F.tid, wave = F.wave;
    for (int unit = blockIdx.x; unit < NB * NH_R * 2; unit += F.G) {
        const int b = unit >> 5, h = (unit >> 1) & 15, dir = unit & 1; const int col = h * 64 + 8 * (tid0 & 7);
        f32x4 kkc[2], kac[2], rkc[2];
#pragma unroll
        for (int e = 0; e < 2; ++e) { kkc[e] = *(const f32x4*)(F.in[I_KK] + j * D + col + 4 * e); kac[e] = *(const f32x4*)(F.in[I_KA] + j * D + col + 4 * e); rkc[e] = *(const f32x4*)(F.in[I_RK] + j * D + col + 4 * e); }
        for (int i = tid0; i < (O_END - O_LAK) / 16; i += NTHREADS) *(LAS u32x4*)(L + O_LAK + i * 16) = (u32x4){0u, 0u, 0u, 0u};
        f32x4 Hs[4];
        f32x4 Yh[4];
#define WK_YFLUSH(cc) do { if (wave >= 4) { const int lane_ = tid0 & 63, qi_ = lane_ & 15, q4_ = lane_ >> 4, vj_ = wave - 4; \
            _Pragma("unroll") for (int ti_ = 0; ti_ < 4; ++ti_) _Pragma("unroll") for (int r_ = 0; r_ < 4; ++r_) { const int st_ = (cc) * 64 + 16 * ti_ + 4 * q4_ + r_; const int t_ = dir ? (SEQ - 1 - st_) : st_; \
                Y[((size_t)dir * T + (size_t)b * SEQ + t_) * D + h * 64 + 16 * vj_ + qi_] = (bf16)f2bf(Yh[ti_][r_]); } } } while (0)
#pragma unroll
        for (int vj = 0; vj < 4; ++vj) Hs[vj] = (f32x4){0.f, 0.f, 0.f, 0.f};
        u32x4 gr, gk, gv, gl, ga;
#define WK_LOAD(c) do { const int st = (c) * 64 + (tid0 >> 3); const int t = dir ? (SEQ - 1 - st) : st; const size_t ro = ((size_t)b * SEQ + t) * D + col; \
            gr = *(const u32x4*)(Rb + ro); gk = *(const u32x4*)(Kb + ro); gv = *(const u32x4*)(Vb + ro); gl = *(const u32x4*)(LD + (size_t)dir * T * D + ro); ga = *(const u32x4*)(AS + (size_t)dir * T * D + ro); } while (0)
        WK_LOAD(0);
        WK_BAR();
        for (int c = 0; c < SEQ / 64; ++c) {
            int tid = tid0; asm volatile("" : "+v"(tid));
            const int lane = tid & 63, qi = lane & 15, q4 = lane >> 4, pt = tid >> 3, c8 = tid & 7;
            LAS unsigned char* H0 = L + ((c & 1) ? O_H1 : O_H0); LAS unsigned char* H1 = L + ((c & 1) ? O_H0 : O_H1);
            for (int sd0_ = 0; sd0_ < 1 + ((SCAN_DUP >> 0) & 1); ++sd0_) {
            float av[8], bv[8], kdv[8], rv[8], ldv[8];
            {
                const unsigned gku[4] = {gk.x, gk.y, gk.z, gk.w}, gru[4] = {gr.x, gr.y, gr.z, gr.w}, glu[4] = {gl.x, gl.y, gl.z, gl.w}, gau[4] = {ga.x, ga.y, ga.z, ga.w};
                float kf[8], af[8], kkv[8]; float ss = 0.f;
#pragma unroll
                for (int e = 0; e < 4; ++e) { kf[2 * e] = bf_lo(gku[e]); kf[2 * e + 1] = bf_hi(gku[e]); rv[2 * e] = bf_lo(gru[e]); rv[2 * e + 1] = bf_hi(gru[e]);
                    ldv[2 * e] = bf_lo(glu[e]); ldv[2 * e + 1] = bf_hi(glu[e]); af[2 * e] = bf_lo(gau[e]); af[2 * e + 1] = bf_hi(gau[e]); }
#pragma unroll
                for (int e = 0; e < 8; ++e) { kkv[e] = kf[e] * kkc[e >> 2][e & 3]; ss += kkv[e] * kkv[e]; }
                ss = sum8(ss);
                const float inv = 1.0f / fmaxf(sqrtf(ss), 1e-12f); float bo = 0.f;
#pragma unroll
                for (int e = 0; e < 8; ++e) { const float kn = kkv[e] * inv; kdv[e] = kf[e] * (1.0f + (af[e] - 1.0f) * kac[e >> 2][e & 3]); av[e] = -kn; bv[e] = kn * af[e]; bo += rv[e] * kdv[e] * rkc[e >> 2][e & 3]; }
                bo = sum8(bo);
                const int st = c * 64 + pt; const int t = dir ? (SEQ - 1 - st) : st;
                if (c8 == 0) SB[((size_t)dir * T + (size_t)b * SEQ + t) * 16 + h] = bo;
                *(LAS f32x4*)(NAB + pt * PF + 8 * c8) = (f32x4){ldv[0], ldv[1], ldv[2], ldv[3]}; *(LAS f32x4*)(NAB + pt * PF + 8 * c8 + 4) = (f32x4){ldv[4], ldv[5], ldv[6], ldv[7]};
                *(LAS u32x4*)(L + O_VV + pt * PB + 16 * c8) = gv;
            }
            if (sd0_ == ((SCAN_DUP >> 0) & 1)) { if (c > 0) WK_YFLUSH(c - 1); if (c + 1 < SEQ / 64) WK_LOAD(c + 1); }
            WK_BAR();
            { const int kc = tid & 63, g = tid >> 6; float pre[8]; float p = 0.f;
#pragma unroll
              for (int i = 0; i < 8; ++i) { p += NAB[(8 * g + i) * PF + kc]; pre[i] = p; }
              GS[g * 64 + kc] = p;
              WK_BAR();
              float off = 0.f;
#pragma unroll
              for (int gg = 0; gg < 7; ++gg) off += (gg < g) ? GS[gg * 64 + kc] : 0.f;
#pragma unroll
              for (int i = 0; i < 8; ++i) NAB[(8 * g + i) * PF + kc] = off + pre[i]; }
            WK_BAR();
            { f32x4 cl[2], cm[2];
#pragma unroll
              for (int e = 0; e < 2; ++e) { cl[e] = *(const LAS f32x4*)(NAB + pt * PF + 8 * c8 + 4 * e); cm[e] = (pt > 0) ? *(const LAS f32x4*)(NAB + (pt - 1) * PF + 8 * c8 + 4 * e) : (f32x4){0.f, 0.f, 0.f, 0.f}; }
              float oa[8], orr[8], ob[8], ok[8];
#pragma unroll
              for (int e = 0; e < 8; ++e) { const float c1 = cl[e >> 2][e & 3], c0 = cm[e >> 2][e & 3]; const float gp = __builtin_amdgcn_exp2f(c1), gn = __builtin_amdgcn_exp2f(-c1), g0 = __builtin_amdgcn_exp2f(c0);
                  oa[e] = av[e] * g0; orr[e] = rv[e] * gp; ob[e] = bv[e] * gn; ok[e] = kdv[e] * gn; if (pt == 63) GC[8 * c8 + e] = gp; }
              *(LAS u32x4*)(L + O_AT + pt * PB + 16 * c8) = (u32x4){pk2(oa[0], oa[1]), pk2(oa[2], oa[3]), pk2(oa[4], oa[5]), pk2(oa[6], oa[7])};
              *(LAS u32x4*)(L + O_RT + pt * PB + 16 * c8) = (u32x4){pk2(orr[0], orr[1]), pk2(orr[2], orr[3]), pk2(orr[4], orr[5]), pk2(orr[6], orr[7])};
              *(LAS u32x4*)(L + O_BT + pt * PB + 16 * c8) = (u32x4){pk2(ob[0], ob[1]), pk2(ob[2], ob[3]), pk2(ob[4], ob[5]), pk2(ob[6], ob[7])};
              *(LAS u32x4*)(L + O_KT + pt * PB + 16 * c8) = (u32x4){pk2(ok[0], ok[1]), pk2(ok[2], ok[3]), pk2(ok[4], ok[5]), pk2(ok[6], ok[7])}; }
            WK_BAR();
            }
            f32x4 X0[4], Y0[4];
            for (int sd1_ = 0; sd1_ < 1 + ((SCAN_DUP >> 1) & 1); ++sd1_) {
#pragma unroll
            for (int jj = 0; jj < 5; ++jj) {
                const int idx = wave * 5 + jj, blk = idx / 10, tri = idx % 10;
                const int ti = (tri >= 6) ? 3 : ((tri >= 3) ? 2 : ((tri >= 1) ? 1 : 0)); const int si = tri - (ti * (ti + 1)) / 2;
                const LAS unsigned char* Pm = L + ((blk < 2) ? O_AT : O_RT); const LAS unsigned char* Qm = L + ((blk & 1) ? O_KT : O_BT);
                f32x4 acc = {0.f, 0.f, 0.f, 0.f};
#pragma unroll
                for (int ks = 0; ks < 2; ++ks) acc = WK_MFMA(ldrow(Qm, 16 * si + qi, 32 * ks + 8 * q4), ldrow(Pm, 16 * ti + qi, 32 * ks + 8 * q4), acc);
                const int tt = 16 * ti + qi, s0 = 16 * si + 4 * q4;
#pragma unroll
                for (int r = 0; r < 4; ++r) { const int sidx = s0 + r; const bool keep = (blk < 2) ? (sidx < tt) : (sidx <= tt); acc[r] = keep ? acc[r] : 0.f; }
                if (blk == 0) { *(LAS f32x4*)(NAB + tt * PF + s0) = acc; st4bf(L + O_NB, tt, s0, acc); }
                else st4bf(L + (blk == 1 ? O_LAK : (blk == 2 ? O_MRB : O_MRK)), tt, s0, acc);
            }
            WK_BAR();
            }
            for (int sd2_ = 0; sd2_ < 1 + ((SCAN_DUP >> 2) & 1); ++sd2_) {
            if (wave >= 4) { const int vj = wave - 4;
#pragma unroll
                for (int ti = 0; ti < 4; ++ti) { X0[ti] = (f32x4){0.f, 0.f, 0.f, 0.f}; Y0[ti] = (f32x4){0.f, 0.f, 0.f, 0.f};
#pragma unroll
                    for (int ks = 0; ks < 2; ++ks) if (ks <= (ti >> 1)) { const bf16x8 vf = ldtr(La + O_VV, 32 * ks, 16 * vj, lane);
                        X0[ti] = WK_MFMA(ldrow(L + O_LAK, 16 * ti + qi, 32 * ks + 8 * q4), vf, X0[ti]); Y0[ti] = WK_MFMA(ldrow(L + O_MRK, 16 * ti + qi, 32 * ks + 8 * q4), vf, Y0[ti]); } } }
            if (wave == 0) {
                const int blk = q4, cj = qi; float nrow[16], x[16];
#pragma unroll
                for (int r = 0; r < 16; ++r) nrow[r] = NAB[(16 * blk + r) * PF + 16 * blk + cj];
#pragma unroll
                for (int r = 0; r < 16; ++r) { float acc = (r == cj) ? 1.0f : 0.0f;
#define WK_SUBM(m) if (m < r) acc += wk::rshare<m>(nrow[r]) * x[m];
                    WK_SUBM(0) WK_SUBM(1) WK_SUBM(2) WK_SUBM(3) WK_SUBM(4) WK_SUBM(5) WK_SUBM(6) WK_SUBM(7) WK_SUBM(8) WK_SUBM(9) WK_SUBM(10) WK_SUBM(11) WK_SUBM(12) WK_SUBM(13) WK_SUBM(14)
#undef WK_SUBM
                    x[r] = acc; *(LAS bf16*)(L + O_TT + (16 * blk + r) * PB + (16 * blk + cj) * 2) = (bf16)f2bf(acc); }
            }
            WK_BAR();
            if (wave < 2) {
                const int i = 2 * wave + 1, jb = 2 * wave;
                { bf16x8 a = ldrow(L + O_NB, 16 * i + qi, 16 * jb + 8 * (q4 & 1)), bfr = ldtr(La + O_TT, 16 * jb - 8 * (q4 & 2), 16 * jb, lane);
                  if (q4 >= 2) { a = zfrag(); bfr = zfrag(); }
                  f32x4 acc = {0.f, 0.f, 0.f, 0.f}; acc = WK_MFMA(a, bfr, acc);
                  st4bf(L + O_MT, 16 * wave + qi, 4 * q4, acc); }
                asm volatile("s_waitcnt lgkmcnt(0)" ::: "memory");
                { bf16x8 a = ldrow(L + O_TT, 16 * i + qi, 16 * i + 8 * (q4 & 1)), bfr = ldrow(L + O_MT, 16 * wave + qi, 8 * (q4 & 1));
                  if (q4 >= 2) { a = zfrag(); bfr = zfrag(); }
                  f32x4 acc = {0.f, 0.f, 0.f, 0.f}; acc = WK_MFMA(a, bfr, acc);
#pragma unroll
                  for (int r = 0; r < 4; ++r) *(LAS bf16*)(L + O_TT + (16 * i + 4 * q4 + r) * PB + (16 * jb + qi) * 2) = (bf16)f2bf(acc[r]); }
            }
            WK_BAR();
            if (wave < 4) {
                const int ti2 = wave >> 1, tj2 = wave & 1;
                { const bf16x8 bfr = ldtr(La + O_TT, 0, 16 * tj2, lane);
#pragma unroll
                  for (int tt = 0; tt < 2; ++tt) { f32x4 acc = {0.f, 0.f, 0.f, 0.f}; acc = WK_MFMA(ldrow(L + O_NB, 32 + 16 * tt + qi, 8 * q4), bfr, acc); st4bf(L + O_MT, 32 + 16 * tj2 + qi, 16 * tt + 4 * q4, acc); } }
                asm volatile("s_waitcnt lgkmcnt(0)" ::: "memory");
                { f32x4 acc = {0.f, 0.f, 0.f, 0.f}; acc = WK_MFMA(ldrow(L + O_TT, 32 + 16 * ti2 + qi, 32 + 8 * q4), ldrow(L + O_MT, 32 + 16 * tj2 + qi, 8 * q4), acc);
#pragma unroll
                  for (int r = 0; r < 4; ++r) *(LAS bf16*)(L + O_TT + (32 + 16 * ti2 + 4 * q4 + r) * PB + (16 * tj2 + qi) * 2) = (bf16)f2bf(acc[r]); }
            }
            }
            for (int sd3_ = 0; sd3_ < 1 + ((SCAN_DUP >> 3) & 1); ++sd3_) {
            if (wave >= 4) { const int vj = wave - 4;
#pragma unroll
                for (int ti = 0; ti < 4; ++ti) { f32x4 acc = X0[ti];
#pragma unroll
                    for (int ks = 0; ks < 2; ++ks) acc = WK_MFMA(ldrow(L + O_AT, 16 * ti + qi, 32 * ks + 8 * q4), ldrow(H0, 16 * vj + qi, 32 * ks + 8 * q4), acc);
                    st4bf(L + O_XT, 16 * vj + qi, 16 * ti + 4 * q4, acc); } }
            WK_BAR();
#pragma unroll
            for (int e = 0; e < 2; ++e) { const int id = wave * 2 + e, ti = id >> 2, vj = id & 3; f32x4 acc = {0.f, 0.f, 0.f, 0.f};
#pragma unroll
                for (int ks = 0; ks < 2; ++ks) if (ks <= (ti >> 1)) acc = WK_MFMA(ldrow(L + O_TT, 16 * ti + qi, 32 * ks + 8 * q4), ldrow(L + O_XT, 16 * vj + qi, 32 * ks + 8 * q4), acc);
                st4bf(L + O_UT, 16 * vj + qi, 16 * ti + 4 * q4, acc); }
            WK_BAR();
            }
            f32x4 Hsave[4]; for (int vj_ = 0; vj_ < 4; ++vj_) Hsave[vj_] = Hs[vj_];
            for (int sd5_ = 0; sd5_ < 1 + ((SCAN_DUP >> 4) & 1); ++sd5_) {
            for (int vj_ = 0; vj_ < 4; ++vj_) Hs[vj_] = Hsave[vj_];
            if (wave >= 4) { const int vj = wave - 4;
#pragma unroll
                for (int ti = 0; ti < 4; ++ti) { f32x4 acc = Y0[ti];
#pragma unroll
                    for (int ks = 0; ks < 2; ++ks) { acc = WK_MFMA(ldrow(L + O_RT, 16 * ti + qi, 32 * ks + 8 * q4), ldrow(H0, 16 * vj + qi, 32 * ks + 8 * q4), acc);
                        if (ks <= (ti >> 1)) acc = WK_MFMA(ldrow(L + O_MRB, 16 * ti + qi, 32 * ks + 8 * q4), ldrow(L + O_UT, 16 * vj + qi, 32 * ks + 8 * q4), acc); }
                    Yh[ti] = acc; } }
            else { const int kt = wave; const f32x4 gc = *(const LAS f32x4*)(GC + 16 * kt + 4 * q4);
#pragma unroll
                for (int ks = 0; ks < 2; ++ks) { const bf16x8 bt = ldtr(La + O_BT, 32 * ks, 16 * kt, lane), ktf = ldtr(La + O_KT, 32 * ks, 16 * kt, lane);
#pragma unroll
                    for (int vj = 0; vj < 4; ++vj) { Hs[vj] = WK_MFMA(bt, ldrow(L + O_UT, 16 * vj + qi, 32 * ks + 8 * q4), Hs[vj]); Hs[vj] = WK_MFMA(ktf, ldtr(La + O_VV, 32 * ks, 16 * vj, lane), Hs[vj]); } }
#pragma unroll
                for (int vj = 0; vj < 4; ++vj) { Hs[vj] = Hs[vj] * gc; st4bf(H1, 16 * vj + qi, 16 * kt + 4 * q4, Hs[vj]); } }
            WK_BAR();
            }
        }
        WK_YFLUSH(SEQ / 64 - 1);
#undef WK_LOAD
#undef WK_YFLUSH
    }
}

__device__ __forceinline__ void phase_rw_post(Frame& F, int l) {
    const int j = l >> 1; const float* lnw = F.in[I_LNW] + j * D; const float* lnb = F.in[I_LNB] + j * D;
    const bf16* Vb = (const bf16*)(F.ws + WS_ACT + A_RKV) + (size_t)2 * T * D; const bf16* Y = (const bf16*)(F.ws + WS_ACT + A_Y); const bf16* Gb = (const bf16*)(F.ws + WS_ACT + A_G);
    const float* SB = (const float*)(F.ws + WS_SB); bf16* O = (bf16*)(F.ws + WS_ACT + A_O);
    for (int row = F.gw; row < T; row += F.NGW) {
        f32x4 o[4];
#pragma unroll
        for (int q = 0; q < 4; ++q) {
            const int c = 4 * F.lane + 256 * q; const int head = 4 * q + (F.lane >> 4);
            const u32x2 vr = *(const u32x2*)(Vb + (size_t)row * D + c); const f32x4 vf = {bf_lo(vr.x), bf_hi(vr.x), bf_lo(vr.y), bf_hi(vr.y)};
            const f32x4 w = *(const f32x4*)(lnw + c), bb = *(const f32x4*)(lnb + c);
            f32x4 acc = {0.f, 0.f, 0.f, 0.f};
#pragma unroll
            for (int dir = 0; dir < 2; ++dir) {
                const size_t ro = ((size_t)dir * T + row) * D + c;
                const u32x2 yr = *(const u32x2*)(Y + ro), gr = *(const u32x2*)(Gb + ro);
                const f32x4 yf = {bf_lo(yr.x), bf_hi(yr.x), bf_lo(yr.y), bf_hi(yr.y)}; const f32x4 gf = {bf_lo(gr.x), bf_hi(gr.x), bf_lo(gr.y), bf_hi(gr.y)};
                const float sbv = SB[((size_t)dir * T + row) * 16 + head];
                const float mean = rowsum16((yf[0] + yf[1]) + (yf[2] + yf[3])) * (1.0f / 64.0f);
                const f32x4 d = yf - mean; const float var = rowsum16((d[0] * d[0] + d[1] * d[1]) + (d[2] * d[2] + d[3] * d[3])) * (1.0f / 64.0f);
                const float rs = rsqrtf(var + GN_EPS);
                acc += gf * (d * rs * w + bb + sbv * vf);
            }
            o[q] = acc;
        }
        row_store_bf16(O + (size_t)row * D, F.lane, o);
    }
}

__device__ __forceinline__ unsigned att_f(unsigned row) { return ((row & 3u) << 2) | ((row >> 2) & 3u); }
__device__ __forceinline__ unsigned att_off_b(unsigned row, unsigned ch) { return 256u * row + 16u * (ch ^ att_f(row)); }
__device__ __forceinline__ void phase_attn(Frame& F, bool dry = false) {
    bf16* Qb = (bf16*)(F.ws + WS_ACT + A_Q); const bf16* Kb = (const bf16*)(F.ws + WS_ACT + A_K); const bf16* Vb = (const bf16*)(F.ws + WS_ACT + A_VT);
    float* LSE = (float*)(F.ws + WS_SB);
    const int lane = F.lane, qi = lane & 15, q4 = lane >> 4, wave = F.wave;
    LAS unsigned char* KW = F.lds; LAS unsigned char* VW = F.lds + 9 * 8192;
    const unsigned vw_a = (unsigned)(size_t)VW;
    unsigned ka[2][4], va[8][2];
#pragma unroll
    for (int rb = 0; rb < 2; ++rb)
#pragma unroll
        for (int s = 0; s < 4; ++s) ka[rb][s] = att_off_b((unsigned)(qi + 16 * rb), (unsigned)(4 * s + q4));
    { const unsigned q = (unsigned)qi >> 2, p = (unsigned)lane & 3u;
#pragma unroll
      for (int c = 0; c < 8; ++c)
#pragma unroll
          for (int t = 0; t < 2; ++t) va[c][t] = vw_a + att_off_b(8u * q4 + 4u * t + q, 2u * c + (p >> 1)) + 8u * (p & 1u); }
    constexpr int NU = 3 * NB * 8 * 16;
    const int per = (NU + F.G - 1) / F.G; const int n0 = (int)blockIdx.x * per; const int n1 = min(NU, n0 + per);
#define ATT_DECODE(n_, g_, b_, hs_, cls_, chunk_) const int g_ = (n_) >> 10, b_ = ((n_) >> 7) & 7, hs_ = ((n_) >> 4) & 7; const int cc##g_ = (n_) & 15; \
        const int cls_ = (g_ == 0) ? 0 : ((g_ == 1) ? (cc##g_ >> 2) : cc##g_); const int chunk_ = (g_ == 0) ? cc##g_ : ((g_ == 1) ? (cc##g_ & 3) : 0);
#define ATT_DMA(gp_, la_) asm volatile("s_mov_b32 m0, %0\n\ts_nop 0\n\tglobal_load_lds_dwordx4 %1, off" :: "s"(la_), "v"(gp_) : "m0", "memory")
#define ATT_LOAD_TILES(g_, b_, hs_, cls_, chunk_, first_, nt_, beta_) do { const int tb_ = (first_) + ((nt_) == 2 ? (wave >> 2) : 0); const int dsh_ = 2 * (g_); const int pos0_ = 128 * (chunk_) - 64 + 32 * tb_; \
        if (pos0_ >= 0 && pos0_ < (SEQ >> dsh_)) { const int slot_ = (tb_ + (beta_)) % 9; \
            const bf16* ksrc_ = Kb + ((size_t)(g_) * T + (size_t)(b_) * SEQ) * D + (hs_) * 128; const bf16* vsrc_ = Vb + ((size_t)(g_) * T + (size_t)(b_) * SEQ) * D + (hs_) * 128; \
            _Pragma("unroll") for (int ii_ = 0; ii_ < (nt_); ++ii_) { const int i_ = ((nt_) == 2) ? (2 * (wave & 3) + ii_) : wave; const unsigned rho_ = 4u * (unsigned)i_ + (unsigned)q4, m_ = rho_ & 15u, rb_ = rho_ >> 4; \
                const int kidx_ = (int)(8u * (m_ >> 2) + (m_ & 3u) + 4u * rb_); const unsigned coff_ = 16u * ((unsigned)qi ^ att_f(rho_)); \
                ATT_DMA((const char*)(ksrc_ + (size_t)((cls_) + ((pos0_ + kidx_) << dsh_)) * D) + coff_, (unsigned)(size_t)KW + (unsigned)(slot_ * 8192 + i_ * 1024)); \
                ATT_DMA((const char*)(vsrc_ + (size_t)((cls_) + ((pos0_ + (int)rho_) << dsh_)) * D) + coff_, vw_a + (unsigned)(slot_ * 8192 + i_ * 1024)); } } } while (0)
    int beta = 0;
    bf16x8 Qn[4]; u32x2 Op[8]; float lsep = 0.f; bf16* qpp = Qb; float* lsepp = LSE;
#pragma unroll
    for (int dt = 0; dt < 8; ++dt) Op[dt] = (u32x2){0u, 0u};
#pragma unroll
    for (int kt = 0; kt < 4; ++kt) Qn[kt] = (bf16x8){0, 0, 0, 0, 0, 0, 0, 0};
    for (int n = n0; n < n1; ++n) {
        ATT_DECODE(n, g, b, hs, cls, chunk)
        const int dsh = 2 * g, Lg = SEQ >> dsh; const int P0 = 128 * chunk;
        asm volatile("s_waitcnt lgkmcnt(0)" ::: "memory"); __builtin_amdgcn_s_barrier(); asm volatile("" ::: "memory");
        const int Pq = P0 + 16 * wave + qi; const size_t qrow = (size_t)g * T + (size_t)b * SEQ + (size_t)(cls + (Pq << dsh));
        bf16* qp = Qb + qrow * D + hs * 128;
        bf16x8 Qf[4];
        if (n == n0) {
            ATT_LOAD_TILES(g, b, hs, cls, chunk, 0, 2, beta); ATT_LOAD_TILES(g, b, hs, cls, chunk, 2, 2, beta); ATT_LOAD_TILES(g, b, hs, cls, chunk, 4, 2, beta); ATT_LOAD_TILES(g, b, hs, cls, chunk, 6, 2, beta);
#pragma unroll
            for (int kt = 0; kt < 4; ++kt) Qf[kt] = *(const bf16x8*)(qp + 8 * q4 + 32 * kt);
        } else {
#pragma unroll
            for (int kt = 0; kt < 4; ++kt) Qf[kt] = Qn[kt];
        }
        const float slope2 = exp2f(-8.0f * (float)(g * 8 + hs + 1) / 24.0f) * LOG2E * (float)(1 << dsh);
        float m_run = -1e30f, l_run = 0.f; f32x4 O[8];
#pragma unroll
        for (int dt = 0; dt < 8; ++dt) O[dt] = (f32x4){0.f, 0.f, 0.f, 0.f};
        asm volatile("s_waitcnt vmcnt(0)" ::: "memory"); __builtin_amdgcn_s_barrier(); asm volatile("" ::: "memory");
        asm volatile("" : "+v"(Qf[0]), "+v"(Qf[1]), "+v"(Qf[2]), "+v"(Qf[3]));
        if (n > n0 && !dry) {
#pragma unroll
            for (int dt = 0; dt < 8; ++dt) *(u32x2*)(qpp + 4 * q4 + 16 * dt) = Op[dt];
            if (q4 == 0) *lsepp = lsep; }
        const bool has_next = (n + 1 < n1);
        if (has_next) { ATT_DECODE(n + 1, gx, bx, hsx, clsx, chunkx)
            if (chunkx == 0) ATT_LOAD_TILES(gx, bx, hsx, clsx, chunkx, 2, 2, beta + 4);
            ATT_LOAD_TILES(gx, bx, hsx, clsx, chunkx, 4, 1, beta + 4);
            const int Pqx = 128 * chunkx + 16 * wave + qi; const bf16* qx = Qb + ((size_t)gx * T + (size_t)bx * SEQ + (size_t)(clsx + (Pqx << (2 * gx)))) * D + hsx * 128;
#pragma unroll
            for (int kt = 0; kt < 4; ++kt) Qn[kt] = *(const bf16x8*)(qx + 8 * q4 + 32 * kt); }
#pragma unroll
        for (int s = 0; s < 5; ++s) {
            const int tb = (wave >> 1) + s; const int pos0 = P0 - 64 + 32 * tb;
            if (pos0 >= 0 && pos0 < Lg) {
            const int slot = (tb + beta) % 9; const LAS unsigned char* kl = KW + slot * 8192; const unsigned voff = (unsigned)slot * 8192u;
            union { u32x4 u; bf16x8 v; } KA[4], KB[4];
            { const unsigned kla = (unsigned)(size_t)kl;
              asm volatile("ds_read_b128 %0, %8\n\tds_read_b128 %1, %9\n\tds_read_b128 %2, %10\n\tds_read_b128 %3, %11\n\t"
                           "ds_read_b128 %4, %12\n\tds_read_b128 %5, %13\n\tds_read_b128 %6, %14\n\tds_read_b128 %7, %15\n\ts_waitcnt lgkmcnt(0)"
                           : "=&v"(KA[0].u), "=&v"(KB[0].u), "=&v"(KA[1].u), "=&v"(KB[1].u), "=&v"(KA[2].u), "=&v"(KB[2].u), "=&v"(KA[3].u), "=&v"(KB[3].u)
                           : "v"(kla + ka[0][0]), "v"(kla + ka[1][0]), "v"(kla + ka[0][1]), "v"(kla + ka[1][1]), "v"(kla + ka[0][2]), "v"(kla + ka[1][2]), "v"(kla + ka[0][3]), "v"(kla + ka[1][3])
                           : "memory"); }
            f32x4 SA = {0.f, 0.f, 0.f, 0.f}, SBt = {0.f, 0.f, 0.f, 0.f};
#pragma unroll
            for (int kt = 0; kt < 4; ++kt) { SA = __builtin_amdgcn_mfma_f32_16x16x32_bf16(KA[kt].v, Qf[kt], SA, 0, 0, 0); SBt = __builtin_amdgcn_mfma_f32_16x16x32_bf16(KB[kt].v, Qf[kt], SBt, 0, 0, 0); }
            const int cb = pos0 + 8 * q4;
            float sv[8]; bool ok[8]; float mx = -1e30f;
#pragma unroll
            for (int r = 0; r < 8; ++r) { const int p = cb + r; const int rel = abs(p - Pq); ok[r] = (rel <= 64);
                const float sc = (r < 4 ? SA[r & 3] : SBt[r & 3]) - slope2 * (float)rel; sv[r] = ok[r] ? sc : -1e30f; mx = fmaxf(mx, sv[r]); }
            mx = bfly16_max(mx); mx = bfly32_max(mx);
            const float m_new = fmaxf(m_run, mx); const float alpha = __builtin_amdgcn_exp2f(m_run - m_new); m_run = m_new;
            float pe[8]; float rs = 0.f;
#pragma unroll
            for (int r = 0; r < 8; ++r) { pe[r] = ok[r] ? __builtin_amdgcn_exp2f(sv[r] - m_new) : 0.f; rs += pe[r]; }
            rs = bfly16_sum(rs); rs = bfly32_sum(rs);
            l_run = l_run * alpha + rs;
            union { u32x4 u; bf16x8 v; } pf; pf.u.x = pk2(pe[0], pe[1]); pf.u.y = pk2(pe[2], pe[3]); pf.u.z = pk2(pe[4], pe[5]); pf.u.w = pk2(pe[6], pe[7]);
#pragma unroll
            for (int hf = 0; hf < 2; ++hf) {
                u32x2 vr[4][2];
                asm volatile("ds_read_b64_tr_b16 %0, %8\n\tds_read_b64_tr_b16 %1, %9\n\tds_read_b64_tr_b16 %2, %10\n\tds_read_b64_tr_b16 %3, %11\n\t"
                             "ds_read_b64_tr_b16 %4, %12\n\tds_read_b64_tr_b16 %5, %13\n\tds_read_b64_tr_b16 %6, %14\n\tds_read_b64_tr_b16 %7, %15\n\ts_waitcnt lgkmcnt(0)"
                             : "=&v"(vr[0][0]), "=&v"(vr[0][1]), "=&v"(vr[1][0]), "=&v"(vr[1][1]), "=&v"(vr[2][0]), "=&v"(vr[2][1]), "=&v"(vr[3][0]), "=&v"(vr[3][1])
                             : "v"(va[4 * hf + 0][0] + voff), "v"(va[4 * hf + 0][1] + voff), "v"(va[4 * hf + 1][0] + voff), "v"(va[4 * hf + 1][1] + voff), "v"(va[4 * hf + 2][0] + voff), "v"(va[4 * hf + 2][1] + voff), "v"(va[4 * hf + 3][0] + voff), "v"(va[4 * hf + 3][1] + voff)
                             : "memory");
#pragma unroll
                for (int c = 0; c < 4; ++c) { const int dt = 4 * hf + c; union { u32x4 u; bf16x8 v; } vf; vf.u.x = vr[c][0].x; vf.u.y = vr[c][0].y; vf.u.z = vr[c][1].x; vf.u.w = vr[c][1].y;
                    O[dt] = O[dt] * alpha; O[dt] = __builtin_amdgcn_mfma_f32_16x16x32_bf16(vf.v, pf.v, O[dt], 0, 0, 0); }
            }
            }
            if (s == 1 || s == 2) {
                asm volatile("s_waitcnt lgkmcnt(0)" ::: "memory"); __builtin_amdgcn_s_barrier(); asm volatile("" ::: "memory");
                if (has_next) { ATT_DECODE(n + 1, gy, by, hsy, clsy, chunky) if (s == 1) ATT_LOAD_TILES(gy, by, hsy, clsy, chunky, 5, 2, beta + 4); else ATT_LOAD_TILES(gy, by, hsy, clsy, chunky, 7, 1, beta + 4); }
            }
        }
        const float inv = 1.0f / l_run;
#pragma unroll
        for (int dt = 0; dt < 8; ++dt) { Op[dt].x = pk2(O[dt][0] * inv, O[dt][1] * inv); Op[dt].y = pk2(O[dt][2] * inv, O[dt][3] * inv); if (dry) asm volatile("" :: "v"(Op[dt].x), "v"(Op[dt].y)); }
        lsep = m_run + __builtin_amdgcn_logf(l_run); qpp = qp; lsepp = LSE + qrow * 8 + hs;
        beta = (beta + 4) % 9;
    }
    if (n1 > n0 && !dry) {
#pragma unroll
        for (int dt = 0; dt < 8; ++dt) *(u32x2*)(qpp + 4 * q4 + 16 * dt) = Op[dt];
        if (q4 == 0) *lsepp = lsep; }
#undef ATT_DECODE
#undef ATT_LOAD_TILES
#undef ATT_DMA
}
__device__ __forceinline__ void phase_attn_merge(Frame& F) {
    const bf16* Ob = (const bf16*)(F.ws + WS_ACT + A_Q); const float* LSE = (const float*)(F.ws + WS_SB); bf16* AO = (bf16*)(F.ws + WS_ACT + A_AO);
    for (int row = F.gw; row < T; row += F.NGW) {
        f32x4 o[4];
#pragma unroll
        for (int q = 0; q < 4; ++q) { const int c = 4 * F.lane + 256 * q; const int head = 2 * q + (F.lane >> 5);
            float ls[3];
#pragma unroll
            for (int g = 0; g < 3; ++g) ls[g] = LSE[((size_t)g * T + row) * 8 + head];
            const float mx = fmaxf(ls[0], fmaxf(ls[1], ls[2]));
            float w[3]; float sum = 0.f;
#pragma unroll
            for (int g = 0; g < 3; ++g) { w[g] = __builtin_amdgcn_exp2f(ls[g] - mx); sum += w[g]; }
            const float inv = 1.0f / sum; f32x4 acc = {0.f, 0.f, 0.f, 0.f};
#pragma unroll
            for (int g = 0; g < 3; ++g) { const u32x2 r = *(const u32x2*)(Ob + ((size_t)g * T + row) * D + c); const float a = w[g] * inv;
                acc[0] += a * bf_lo(r.x); acc[1] += a * bf_hi(r.x); acc[2] += a * bf_lo(r.y); acc[3] += a * bf_hi(r.y); }
            o[q] = acc; }
        row_store_bf16(AO + (size_t)row * D, F.lane, o);
    }
}

constexpr int PH_PER_LAYER = 10, N_PHASES = 1 + DEPTH * PH_PER_LAYER + 1;
template <int MASK> __global__ void __launch_bounds__(NTHREADS, 2) mk_fwd(Args args) {
    extern __shared__ __attribute__((aligned(16))) unsigned char lds_raw[];
#define PHASE_FRAME() Frame F; { int t_ = wave0 * 64 + lane_id_nh(); asm volatile("" : "+v"(t_)); size_t z_ = 0; asm volatile("" : "+s"(z_)); unsigned char* w_ = args.ws + z_;     \
        unsigned lb_ = 0; asm volatile("" : "+s"(lb_)); F.lds = (LAS unsigned char*)lds_raw + lb_; F.tid = t_; F.lane = t_ & 63; F.wave = __builtin_amdgcn_readfirstlane(t_ >> 6); \
        F.G = gridDim.x; F.gw = blockIdx.x * NWAVES + F.wave; F.NGW = F.G * NWAVES; F.ws = w_; F.in = args.in; F.out = args.out; }
    LAS unsigned char* lds0 = (LAS unsigned char*)lds_raw;
    const int wave0 = __builtin_amdgcn_readfirstlane((int)threadIdx.x >> 6);
    volatile LAS unsigned* MISC = (volatile LAS unsigned*)(lds0 + MISC_OFF);
    if (wave0 == 0) ((LAS unsigned*)(lds0 + LDS_MISC))[lane_id_nh() + 64] = 0u;
    __syncthreads();
    unsigned* ctl = (unsigned*)(args.ws + WS_CTL);
    XcdBarrier bar; bar.bar = ctl + CW_BAR; bar.x = 0; bar.st = nullptr;
#if ONE_LAUNCH
    bar = xcd_barrier_post(ctl + CW_BAR, MISC + 8, wave0 == 0 && lane_id_nh() == 0);
#endif
    const int lo = args.ph_lo, hi = args.ph_hi;
#define EN(b) ((MASK >> (b)) & 1)
#ifndef DUP_MASK
#define DUP_MASK 0
#endif
#define REP(b) for (int rep_ = 0; rep_ < 1 + ((DUP_MASK >> (b)) & 1); ++rep_)
#define IN(k) (lo <= (k) && (k) < hi)
#if ONE_LAUNCH
#ifndef BAR_REP
#define BAR_REP 1
#endif
#define SEAM(k) do { if (IN((k) + 1) || (k) + 1 < hi) { for (int br_ = 0; br_ < BAR_REP; ++br_) xcd_barrier(bar, wave0 == 0 && lane_id_nh() == 0); } } while (0)
#else
#define SEAM(k) do { } while (0)
#endif
    bf16* X0 = (bf16*)(args.ws + WS_X1); bf16* X1 = X0 + (size_t)T * D;
    if (EN(0) && IN(0)) { PHASE_FRAME(); REP(0) phase_prologue(F); SEAM(0); }
    for (int l = 0; l < DEPTH; ++l) {
        const int pb = 1 + l * PH_PER_LAYER; const int j = l >> 1;
        const void* xin = (l == 0) ? (const void*)args.in[I_X] : (const void*)((l & 1) ? X0 : X1);
        bf16* xcur = (l == 0) ? X0 : ((l & 1) ? X1 : X0);
        if ((l & 1) == 0) {
            if (EN(1) && IN(pb + 0)) { PHASE_FRAME(); REP(1) phase_rw_norm(F, l, l > 0, xin, xcur); SEAM(pb + 0); }
            if (EN(2) && IN(pb + 1)) { REP(2) {
                { PHASE_FRAME(); DenseSched S; S.o.init(T / 256, 2, F.G, blockIdx.x); S.A = (const char*)(F.ws + WS_ACT + A_HX); S.a_sel_stride = 0; S.pn_per_a = 1 << 20;
                  S.B = (const char*)(F.ws + WS_W + j * W_RW_STRIDE + W_LDN); S.tstepA = (size_t)256 * 2048 * 2; S.tstepB = (size_t)256 * 2048 * 2;
                  EpiLoraDn E{(bf16*)(F.ws + WS_ACT + A_LORAH)};
                  pg8::gemm_phase(F.lds, F.tid, 2048, 2048, 2048, S, E); }
                { PHASE_FRAME(); DenseSched S; S.o.init(T / 256, 12, F.G, blockIdx.x); S.o.uneven = (F.G == 256); S.A = (const char*)(F.ws + WS_ACT + A_XS); S.a_sel_stride = (size_t)T * D; S.pn_per_a = 4;
                  S.B = (const char*)(F.ws + WS_W + j * W_RW_STRIDE + W_RKV); S.tstepA = (size_t)256 * D; S.tstepB = (size_t)256 * D;
                  EpiI8<EpiSplit> E{EpiSplit{(bf16*)(F.ws + WS_ACT + A_RKV), (size_t)T * D, 1.0f}, (const float*)(F.ws + WS_SCL + SCL_XS), (size_t)T, 4, (const float*)(F.ws + WS_W + j * W_RW_STRIDE + W_RKVS)};
                  pg8::gemm_phase(F.lds, F.tid, D, D, D, S, E); }
                }
                SEAM(pb + 1);
            }
            if (EN(3) && IN(pb + 2)) { REP(3) {
                { PHASE_FRAME(); DenseSched S; S.o.init(T / 256, 16, F.G, blockIdx.x); S.A = (const char*)(F.ws + WS_ACT + A_LORAH); S.a_sel_stride = 256; S.pn_per_a = 8;
                  S.B = (const char*)(F.ws + WS_W + j * W_RW_STRIDE + W_LUPWA); S.tstepA = (size_t)256 * 512 * 2; S.tstepB = (size_t)256 * 128 * 2;
                  EpiLoraUpWA E{(bf16*)(F.ws + WS_ACT + A_LDEC), (bf16*)(F.ws + WS_ACT + A_ASIG), F.in[I_W0] + j * 2 * D, F.in[I_A0] + j * 2 * D};
                  pg8::gemm_phase(F.lds, F.tid, 128, 512, 128, S, E); }
                { PHASE_FRAME(); DenseSched S; S.o.init(T / 256, 8, F.G, blockIdx.x); S.A = (const char*)(F.ws + WS_ACT + A_LORAH) + 512; S.a_sel_stride = 256; S.pn_per_a = 4;
                  S.B = (const char*)(F.ws + WS_W + j * W_RW_STRIDE + W_LUPG); S.tstepA = (size_t)256 * 512 * 2; S.tstepB = (size_t)256 * 128 * 2;
                  EpiSplit E{(bf16*)(F.ws + WS_ACT + A_G), (size_t)T * D, 1.0f};
                  pg8::gemm_phase(F.lds, F.tid, 128, 512, 128, S, E); }
                }
                SEAM(pb + 2);
            }
            if (EN(4) && IN(pb + 3)) { PHASE_FRAME(); REP(4) phase_scan(F, l); SEAM(pb + 3); }
            if (EN(5) && IN(pb + 4)) { PHASE_FRAME(); REP(5) phase_rw_post(F, l); SEAM(pb + 4); }
            if (EN(6) && IN(pb + 5)) { PHASE_FRAME();
                DenseSched S; S.o.init(T / 256, 4, F.G, blockIdx.x); S.A = (const char*)(F.ws + WS_ACT + A_O); S.a_sel_stride = 0; S.pn_per_a = 1 << 20;
                S.B = (const char*)(F.ws + WS_W + j * W_RW_STRIDE + W_RWO); S.tstepA = (size_t)256 * D * 2; S.tstepB = (size_t)256 * D * 2;
                EpiResid E{(l == 0) ? (const void*)F.in[I_X] : (const void*)xcur, (l == 0) ? 1 : 0, xcur, (const float*)(F.ws + WS_MOD) + (size_t)l * 8 * 6144 + 2 * D};
                pg8::gemm_phase(F.lds, F.tid, D, D, D, S, E);
                SEAM(pb + 5);
            }
        } else {
            if (EN(7) && IN(pb + 0)) { PHASE_FRAME(); REP(7) phase_at_norm(F, l, (const bf16*)xin, xcur); SEAM(pb + 0); }
            if (EN(8) && IN(pb + 1)) { PHASE_FRAME(); REP(8) {
                DenseSched S; S.o.init(T / 256, 36, F.G, blockIdx.x); S.A = (const char*)(F.ws + WS_ACT + A_H); S.a_sel_stride = 0; S.pn_per_a = 1 << 20;
                S.B = (const char*)(F.ws + WS_WA + j * W_AT_STRIDE + W_QKV); S.tstepA = (size_t)256 * D; S.tstepB = (size_t)256 * D;
                EpiQKV8 E{(bf16*)(F.ws + WS_ACT + A_Q), (const float*)(F.ws + WS_SA), (const float*)(F.ws + WS_WA + j * W_AT_STRIDE + W_QKVS), 0.08838834764831845f * LOG2E};
                pg8::gemm_phase(F.lds, F.tid, D, D, D, S, E);
                }
                SEAM(pb + 1);
            }
            if (EN(9) && IN(pb + 2)) { PHASE_FRAME(); if ((DUP_MASK >> 9) & 1) phase_attn(F, true); phase_attn(F); SEAM(pb + 2); }
            if (EN(16) && IN(pb + 3)) { PHASE_FRAME(); REP(16) phase_attn_merge(F); SEAM(pb + 3); }
            if (EN(10) && IN(pb + 4)) { PHASE_FRAME();
                DenseSched S; S.o.init(T / 256, 4, F.G, blockIdx.x); S.A = (const char*)(F.ws + WS_ACT + A_AO); S.a_sel_stride = 0; S.pn_per_a = 1 << 20;
                S.B = (const char*)(F.ws + WS_WA + j * W_AT_STRIDE + W_AWO); S.tstepA = (size_t)256 * D * 2; S.tstepB = (size_t)256 * D * 2;
                EpiResid E{(const void*)xcur, 0, xcur, (const float*)(F.ws + WS_MOD) + (size_t)l * 8 * 6144 + 2 * D};
                pg8::gemm_phase(F.lds, F.tid, D, D, D, S, E);
                SEAM(pb + 4);
            }
        }
        if (EN(11) && IN(pb + 6)) { PHASE_FRAME(); if ((DUP_MASK >> 11) & 1) phase_moe_route(F, l, xcur, 4); phase_moe_route(F, l, xcur); SEAM(pb + 6); }
        if (EN(13) && IN(pb + 8)) { PHASE_FRAME();
            moe_tables(F, l);
            MoeGatherSched S; S.tileE = (const LAS int*)(F.lds + TILEE_OFF); S.ntiles = uni(S.tileE[160]); S.G = F.G; S.c = blockIdx.x;
            S.A = (const char*)(F.ws + WS_ACT + A_HN2); S.B = (const char*)(F.ws + ws_wm_of(l) + W_GU); S.tstepB = (size_t)256 * D; S.estride = (size_t)512 * D;
            LAS int* rt = (LAS int*)(F.lds + MOE_TAB); LAS float* wt = (LAS float*)(F.lds + MOE_TAB + 3072); LAS float* st = (LAS float*)(F.lds + MOE_TAB + 6144); S.rowtab = rt;
            { const LAS int* tileJ = (const LAS int*)(F.lds + TILEJ_OFF); const LAS int* cl = (const LAS int*)(F.lds + CNTL_OFF);
              const int* lstT = (const int*)(F.ws + WS_ACT + A_LSTT); const float* lstW = (const float*)(F.ws + WS_ACT + A_LSTW); const float* sat = (const float*)(F.ws + WS_SCL + SCL_HN);
              for (int i = F.tid; i < 3 * 256; i += NTHREADS) { const int L = (i >> 8) * F.G + (int)blockIdx.x; int tok = 0; float w = 0.f;
                  if (L < S.ntiles * 2) { const int m = L >> 1, e = S.tileE[m], rk = tileJ[m] * 256 + (i & 255); if (rk < cl[e]) { tok = lstT[(size_t)e * LCAP + rk]; w = lstW[(size_t)e * LCAP + rk]; } }
                  rt[i] = tok; wt[i] = w; st[i] = sat[tok]; }
              __syncthreads(); }
            EpiGateUp8 E{(bf16*)(F.ws + WS_ACT + A_HID), wt, st, (const float*)(F.ws + ws_wm_of(l) + W_GUS), (const LAS int*)(F.lds + TILEE_OFF)};
            pg8::gemm_phase(F.lds, F.tid, D, D, D, S, E);
            if (l + 1 < DEPTH) {
                const int nun = S.ntiles * 2, firstb = (nun > F.G) ? (nun - F.G) : 0;
                if ((int)blockIdx.x >= firstb) moe_convert(F, l + 1, (int)blockIdx.x - firstb, F.G - firstb);
            }
            SEAM(pb + 8);
        }
        if (EN(14) && IN(pb + 9)) { PHASE_FRAME(); REP(14) {
            moe_tables(F, l);
            MoeSched S; S.tileE = (const LAS int*)(F.lds + TILEE_OFF); S.ntiles = uni(S.tileE[160]); S.npn = 4; S.G = F.G; S.c = blockIdx.x;
            S.A = (const char*)(F.ws + WS_ACT + A_HID); S.B = (const char*)(F.ws + ws_wm_of(l) + W_DN); S.tstepA = (size_t)256 * FEXP * 2; S.tstepB = (size_t)256 * FEXP * 2; S.estride = (size_t)D * FEXP * 2;
            EpiPlain E{(bf16*)(F.ws + WS_ACT + A_YS)};
            pg8::gemm_phase(F.lds, F.tid, FEXP, FEXP, FEXP, S, E);
            }
            SEAM(pb + 9);
        }
    }
    if (EN(15) && IN(N_PHASES - 1)) { PHASE_FRAME(); phase_final(F, X1); }
#undef IN
#undef SEAM
}

typedef void (*kern_t)(Args);
template <int B> static kern_t kern_of_bit(int b) { if (b == B) return mk_fwd<(1 << B)>; if constexpr (B > 0) return kern_of_bit<B - 1>(b); else return nullptr; }
static int kind_of_phase(int p) {
    if (p == 0) return 0; if (p == N_PHASES - 1) return 15;
    const int l = (p - 1) / PH_PER_LAYER, k = (p - 1) % PH_PER_LAYER;
    if (k >= 6) return (k == 7) ? -1 : 11 + (k - 6);
    if ((l & 1) == 0) return 1 + k;
    return (k < 3) ? 7 + k : (k == 3 ? 16 : (k == 4 ? 10 : -1));
}
extern "C" void kernel_launch(void* const* d_in, const int* in_sizes, int n_in, void* d_out, int out_size, void* d_ws, size_t ws_size, hipStream_t stream) {
    static int grid = 0;
    if (grid == 0) {
        if (n_in != 32 || out_size != T * D || ws_size < WS_END) { fprintf(stderr, "kernel_launch: unexpected shapes (n_in %d out %d ws %zu need %zu)\n", n_in, out_size, ws_size, (size_t)WS_END); grid = -1; return; }
        int dev = 0, cus = 0;
        if (hipGetDevice(&dev) != hipSuccess || hipDeviceGetAttribute(&cus, hipDeviceAttributeMultiprocessorCount, dev) != hipSuccess) { grid = -1; return; }
#if ONE_LAUNCH
        if (hipFuncSetAttribute((const void*)mk_fwd<0x1ffff>, hipFuncAttributeMaxDynamicSharedMemorySize, LDS_BYTES) != hipSuccess) { fprintf(stderr, "kernel_launch: hipFuncSetAttribute failed\n"); grid = -1; return; }
#else
        for (int b = 0; b < 17; ++b) if (hipFuncSetAttribute((const void*)kern_of_bit<16>(b), hipFuncAttributeMaxDynamicSharedMemorySize, LDS_BYTES) != hipSuccess) { fprintf(stderr, "kernel_launch: hipFuncSetAttribute failed\n"); grid = -1; return; }
#endif
        (void)hipGetLastError();
        grid = cus;
    }
    if (grid < 0) return;
    (void)hipMemsetAsync((char*)d_ws + WS_CTL, 0, CTL_ZERO_BYTES, stream);
    Args a{};
    for (int i = 0; i < 32; ++i) a.in[i] = (const float*)d_in[i];
    a.out = (float*)d_out; a.ws = (unsigned char*)d_ws;
#if ONE_LAUNCH
#ifndef SPLIT_EVERY
#define SPLIT_EVERY N_PHASES
#endif
    for (int p = 0; p < N_PHASES; p += SPLIT_EVERY) {
        a.ph_lo = p; a.ph_hi = (p + SPLIT_EVERY < N_PHASES) ? p + SPLIT_EVERY : N_PHASES;
        hipLaunchKernelGGL(mk_fwd<0x1ffff>, dim3(grid), dim3(NTHREADS), LDS_BYTES, stream, a);
    }
#else
    for (int p = 0; p < N_PHASES; ++p) {
        const int kind = kind_of_phase(p); if (kind < 0) continue;
        a.ph_lo = p; a.ph_hi = p + 1;
        hipLaunchKernelGGL(kern_of_bit<16>(kind), dim3(grid), dim3(NTHREADS), LDS_BYTES, stream, a);
    }
#endif
}
```

```cpp
#include <hip/hip_runtime.h>
#include <cstdio>
#include <cstdint>

#ifndef ONE_LAUNCH
#define ONE_LAUNCH 1
#endif


#define LAS __attribute__((address_space(3)))
typedef unsigned short bf16;
typedef short bf16x8 __attribute__((ext_vector_type(8)));
typedef float f32x4 __attribute__((ext_vector_type(4)));
typedef float f32x2 __attribute__((ext_vector_type(2)));
typedef unsigned u32x4 __attribute__((ext_vector_type(4)));
typedef unsigned u32x2 __attribute__((ext_vector_type(2)));

constexpr int NB = 8, SEQ = 2048, D = 1024, T = NB * SEQ, DEPTH = 4;
constexpr int NH_R = 16, HD_R = 64;
constexpr int QKVW = 9216;
constexpr int NEXP = 32, FEXP = 256;
constexpr int MAXROWS = 40960;
constexpr int NWAVES = 8, NTHREADS = 512;
constexpr float RMS_EPS = 1e-6f, GN_EPS = 64e-5f;
constexpr float LOG2E = 1.4426950408889634f;

constexpr size_t MiB = 1u << 20;
constexpr size_t WS_CTL = 0, CTL_ZERO_BYTES = 64 * 1024;
constexpr size_t WS_MOD = 1 * MiB;
constexpr size_t WS_TOKE = 2 * MiB;
constexpr size_t WS_TOKR = WS_TOKE + 128 * 1024;
constexpr size_t WS_TOKW = WS_TOKR + 128 * 1024;
constexpr size_t WS_TOKP = WS_TOKW + 128 * 1024;
constexpr size_t WS_ROWW = WS_TOKP + 128 * 1024;
constexpr size_t WS_TILEE = WS_ROWW + 192 * 1024;
constexpr size_t WS_ROWT = WS_TILEE + 4096;
constexpr size_t WS_SB = 4 * MiB;
constexpr size_t WS_SA = WS_SB + 1536 * 1024;
constexpr size_t WS_SCL = 6 * MiB;
constexpr size_t SCL_XS = 0, SCL_HN = 4 * 65536;
constexpr size_t WS_W = 8 * MiB;
constexpr size_t W_RKV = 0, W_RKVS = 3 * MiB, W_LDN = 6 * MiB, W_LUPWA = 8 * MiB, W_LUPG = 10 * MiB, W_RWO = 11 * MiB, W_RW_STRIDE = 13 * MiB;
constexpr size_t WS_WA = WS_W + 2 * W_RW_STRIDE;
constexpr size_t W_QKV = 0, W_QKVS = 9 * MiB, W_AWO = 18 * MiB, W_AT_STRIDE = 20 * MiB;
constexpr size_t WS_WM = WS_WA + 2 * W_AT_STRIDE;
constexpr size_t W_GU = 0, W_GUS = 16 * MiB, W_DN = 32 * MiB;
__host__ __device__ constexpr size_t ws_wm_of(int l);
constexpr size_t WS_X1 = 128 * MiB;
constexpr size_t WS_ACT = 192 * MiB;
constexpr size_t A_XS = 0, A_HX = 96 * MiB;
constexpr size_t A_LDEC = 0, A_ASIG = 64 * MiB, A_G = 128 * MiB;
constexpr size_t A_RKV = 192 * MiB;
constexpr size_t A_O = 192 * MiB;
constexpr size_t A_LORAH = 288 * MiB;
constexpr size_t A_Y = 304 * MiB;
constexpr size_t A_H = 0;
constexpr size_t A_Q = 32 * MiB, A_K = 128 * MiB, A_VT = 224 * MiB;
constexpr size_t A_AO = 320 * MiB;
constexpr size_t A_HN2 = 0, A_LSTT = 32 * MiB, A_LSTW = 34 * MiB, A_HID = 112 * MiB, A_YS = 288 * MiB;
constexpr int LCAP = 16384;
static_assert(A_K - A_Q == A_VT - A_K, "q/k/v spacing");
constexpr size_t WS_WM2 = WS_ACT + 368 * MiB;
constexpr size_t WS_END = WS_WM2 + 48 * MiB;

constexpr int CW_BAR = 4096;
constexpr int CW_CNT = 8192;

__host__ __device__ constexpr size_t ws_wm_of(int l) { return (l & 1) ? WS_WM2 : WS_WM; }
constexpr int LDS_BYTES = 163840;
constexpr int LDS_MISC = 159744;
constexpr int MISC_OFF = LDS_MISC + 320;
constexpr int MOE_TAB = 131072;
constexpr int TILEE_OFF = MOE_TAB + 9216, TILEJ_OFF = TILEE_OFF + 768, CNTL_OFF = TILEJ_OFF + 768;
constexpr int OFFS_OFF = CNTL_OFF + 256;

__device__ __forceinline__ float bf_lo(unsigned u) { return __uint_as_float(u << 16); }
__device__ __forceinline__ float bf_hi(unsigned u) { return __uint_as_float(u & 0xffff0000u); }
__device__ __forceinline__ float bf2f(bf16 v) { return __uint_as_float(((unsigned)v) << 16); }
__device__ __forceinline__ unsigned f2bf(float f) { __bf16 r = (__bf16)f; return (unsigned)__builtin_bit_cast(unsigned short, r); }
__device__ __forceinline__ unsigned pk2(float lo, float hi) { typedef __bf16 b2_t __attribute__((ext_vector_type(2))); typedef float f2_t __attribute__((ext_vector_type(2))); f2_t v = {lo, hi}; b2_t r = __builtin_convertvector(v, b2_t); return __builtin_bit_cast(unsigned, r); }
__device__ __forceinline__ float dpp_ror(float x, const int ctrl_sel) {
    int r;
    if (ctrl_sel == 8) r = __builtin_amdgcn_update_dpp(0, __float_as_int(x), 0x128, 0xf, 0xf, false);
    else if (ctrl_sel == 4) r = __builtin_amdgcn_update_dpp(0, __float_as_int(x), 0x124, 0xf, 0xf, false);
    else if (ctrl_sel == 2) r = __builtin_amdgcn_update_dpp(0, __float_as_int(x), 0x122, 0xf, 0xf, false);
    else r = __builtin_amdgcn_update_dpp(0, __float_as_int(x), 0x121, 0xf, 0xf, false);
    return __int_as_float(r);
}
__device__ __forceinline__ float rowsum16(float x) { x += dpp_ror(x, 8); x += dpp_ror(x, 4); x += dpp_ror(x, 2); x += dpp_ror(x, 1); return x; }
__device__ __forceinline__ float sum8(float x) {
    x += __int_as_float(__builtin_amdgcn_update_dpp(0, __float_as_int(x), 0x141, 0xf, 0xf, false));
    x += __int_as_float(__builtin_amdgcn_update_dpp(0, __float_as_int(x), 0xB1, 0xf, 0xf, false));
    x += __int_as_float(__builtin_amdgcn_update_dpp(0, __float_as_int(x), 0x4E, 0xf, 0xf, false));
    return x;
}
__device__ __forceinline__ float lane_xor(float v, int lane, int o) { return __int_as_float(__builtin_amdgcn_ds_bpermute((lane ^ o) << 2, __float_as_int(v))); }
typedef unsigned v2u_t __attribute__((ext_vector_type(2)));
__device__ __forceinline__ float bfly16_sum(float x) { const v2u_t r = __builtin_amdgcn_permlane16_swap(__float_as_uint(x), __float_as_uint(x), false, false); return __uint_as_float(r[0]) + __uint_as_float(r[1]); }
__device__ __forceinline__ float bfly32_sum(float x) { const v2u_t r = __builtin_amdgcn_permlane32_swap(__float_as_uint(x), __float_as_uint(x), false, false); return __uint_as_float(r[0]) + __uint_as_float(r[1]); }
__device__ __forceinline__ float bfly16_max(float x) { const v2u_t r = __builtin_amdgcn_permlane16_swap(__float_as_uint(x), __float_as_uint(x), false, false); return fmaxf(__uint_as_float(r[0]), __uint_as_float(r[1])); }
__device__ __forceinline__ float bfly32_max(float x) { const v2u_t r = __builtin_amdgcn_permlane32_swap(__float_as_uint(x), __float_as_uint(x), false, false); return fmaxf(__uint_as_float(r[0]), __uint_as_float(r[1])); }
__device__ __forceinline__ float wave_max(float x) {
    x = fmaxf(x, dpp_ror(x, 8)); x = fmaxf(x, dpp_ror(x, 4)); x = fmaxf(x, dpp_ror(x, 2)); x = fmaxf(x, dpp_ror(x, 1)); x = bfly16_max(x); return bfly32_max(x);
}
__device__ __forceinline__ unsigned pack_i8x4(const f32x4& v, float inv) {
    const int q0 = (int)__builtin_rintf(fminf(fmaxf(v[0] * inv, -127.f), 127.f)), q1 = (int)__builtin_rintf(fminf(fmaxf(v[1] * inv, -127.f), 127.f));
    const int q2 = (int)__builtin_rintf(fminf(fmaxf(v[2] * inv, -127.f), 127.f)), q3 = (int)__builtin_rintf(fminf(fmaxf(v[3] * inv, -127.f), 127.f));
    return (unsigned)(q0 & 255) | ((unsigned)(q1 & 255) << 8) | ((unsigned)(q2 & 255) << 16) | ((unsigned)q3 << 24);
}
__device__ __forceinline__ float wave_sum(float v, int lane) { (void)lane; v = rowsum16(v); v = bfly16_sum(v); v = bfly32_sum(v); return v; }
__device__ __forceinline__ int lane_id_nh() { int lid; asm volatile("v_mbcnt_lo_u32_b32 %0, -1, 0\n\tv_mbcnt_hi_u32_b32 %0, -1, %0" : "=v"(lid)); return lid; }
__device__ __forceinline__ float sigmoidf_(float x) { return 1.0f / (1.0f + __expf(-x)); }
#define LDS_WAIT() asm volatile("s_waitcnt lgkmcnt(0)" ::: "memory")
#define VM_WAIT() asm volatile("s_waitcnt vmcnt(0)" ::: "memory")

#define XB_TMO      128
#define XB_XCNT(j)  (256  + 64 * (j))
#define XB_XSUB(j)  (1280 + 64 * (j))
#define XB_XGEN(j)  (2304 + 64 * (j))
#define XB_TOP      3328
#define XB_TOPGEN   3392
#define XCD_BAR_WORDS 3456
#define XB_SPIN_CAP (1u << 18)
__device__ __forceinline__ unsigned xb_ld(unsigned* p)              { return __hip_atomic_load(p, __ATOMIC_RELAXED, __HIP_MEMORY_SCOPE_AGENT); }
__device__ __forceinline__ unsigned xb_add(unsigned* p, unsigned v) { return __hip_atomic_fetch_add(p, v, __ATOMIC_RELAXED, __HIP_MEMORY_SCOPE_AGENT); }
__device__ __forceinline__ unsigned xb_xcc_id() { return (unsigned)__builtin_amdgcn_s_getreg((3 << 11) | 20) & 0xFu; }
#define XB_SPIN(cond, bar) do { unsigned _sp = 0; while (cond) { __builtin_amdgcn_s_sleep(1); \
    if ((++_sp & 255u) == 0u) { if (xb_ld(&(bar)[XB_TMO])) break; if (_sp > XB_SPIN_CAP) { atomicAdd(&(bar)[XB_TMO], 1u); break; } } } } while (0)
struct XcdBarrier { unsigned* bar; unsigned x; volatile LAS unsigned* st; };
__device__ __forceinline__ XcdBarrier xcd_barrier_post(unsigned* bar, volatile LAS unsigned* st, bool t0) {
    XcdBarrier b; b.bar = bar; b.x = xb_xcc_id(); b.st = st;
    if (t0) (void)xb_add(&bar[XB_XCNT(b.x)], 1u);
    return b;
}
__device__ __forceinline__ void xcd_barrier_complete(unsigned* bar, unsigned x, unsigned& nloc, unsigned& nx) {
    const unsigned G = gridDim.x * gridDim.y * gridDim.z;
    unsigned sum, cnt, mine, sp = 0u;
    for (;;) {
        sum = 0u; cnt = 0u; mine = 0u;
#pragma clang loop unroll(disable)
        for (unsigned j = 0; j < 16; ++j) { const unsigned c = xb_ld(&bar[XB_XCNT(j)]); sum += c; cnt += (c > 0u) ? 1u : 0u; mine = (j == x) ? c : mine; }
        if (sum == G) break;
        __builtin_amdgcn_s_sleep(1);
        if ((++sp & 255u) == 0u) { if (xb_ld(&bar[XB_TMO])) break; if (sp > XB_SPIN_CAP) { atomicAdd(&bar[XB_TMO], 1u); break; } }
    }
    nloc = mine > 0u ? mine : 1u; nx = cnt > 0u ? cnt : 1u;
}
__device__ __forceinline__ void xcd_barrier(const XcdBarrier& b, bool t0) {
    asm volatile("s_waitcnt vmcnt(0)" ::: "memory");
    __syncthreads();
    if (t0) {
        unsigned* bar = b.bar;
        __builtin_amdgcn_s_waitcnt(0);
        unsigned nloc = b.st[0], nx = b.st[1];
        if (nloc == 0u) { xcd_barrier_complete(bar, b.x, nloc, nx); b.st[0] = nloc; b.st[1] = nx; }
        const unsigned old = xb_add(&bar[XB_XSUB(b.x)], 1u);
        const unsigned gen = old / nloc;
        if (old + 1u == (gen + 1u) * nloc) {
            __builtin_amdgcn_fence(__ATOMIC_RELEASE, "agent");
            asm volatile("s_waitcnt vmcnt(0)" ::: "memory");
            const unsigned og = xb_add(&bar[XB_TOP], 1u);
            const unsigned tg = og / nx;
            if (og + 1u == (tg + 1u) * nx) xb_add(&bar[XB_TOPGEN], 1u);
            else XB_SPIN(xb_ld(&bar[XB_TOPGEN]) == tg, bar);
            __builtin_amdgcn_fence(__ATOMIC_ACQUIRE, "agent");
            xb_add(&bar[XB_XGEN(b.x)], 1u);
            asm volatile("s_waitcnt vmcnt(0)" ::: "memory");
        } else {
            XB_SPIN(xb_ld(&bar[XB_XGEN(b.x)]) == gen, bar);
            __builtin_amdgcn_fence(__ATOMIC_ACQUIRE, "agent");
            asm volatile("s_waitcnt vmcnt(0)" ::: "memory");
        }
    }
    __syncthreads();
}

namespace pg8 {
constexpr int BM = 256, BK = 64, HALF = 128, HTB = HALF * BK * 2, STAGE_BYTES = 8 * HTB;
__device__ __forceinline__ int lds_byte(int r, int c) { const int st = (r >> 4) * 2 + (c >> 5), rr = r & 15, cc = c & 31, ob = rr * 64 + cc * 2; return st * 1024 + (ob ^ (((ob >> 9) & 1) << 5)); }
__device__ __forceinline__ void stage_rc(int b, int& R, int& C) { const int st = b / 1024, sb = b % 1024, swz = sb ^ (((sb >> 9) & 1) << 5); R = (st >> 1) * 16 + swz / 64; C = (st & 1) * 32 + (swz % 64) / 2; }
__device__ __forceinline__ int perm32(int rho) { const int n = rho >> 4, i = rho & 15; return 8 * (i >> 2) + 4 * n + (i & 3); }
struct Unit { int pm, pn, ui; const char* a; const char* b; };
__device__ __forceinline__ unsigned cvt_pk_bf16(float lo, float hi) { unsigned r; asm volatile("v_cvt_pk_bf16_f32 %0, %1, %2" : "=v"(r) : "v"(lo), "v"(hi)); return r; }

typedef int i32x4 __attribute__((ext_vector_type(4)));
template <bool I8> struct OpT { typedef bf16x8 frag; typedef f32x4 acc; };
template <> struct OpT<true> { typedef i32x4 frag; typedef i32x4 acc; };
__device__ __forceinline__ f32x4 mma16(const bf16x8& a, const bf16x8& b, const f32x4& c) { return __builtin_amdgcn_mfma_f32_16x16x32_bf16(a, b, c, 0, 0, 0); }
__device__ __forceinline__ i32x4 mma16(const i32x4& a, const i32x4& b, const i32x4& c) { return __builtin_amdgcn_mfma_i32_16x16x64_i8(a, b, c, 0, 0, 0); }
template <class Epi, class Sched>
__device__ __forceinline__ void gemm_phase(LAS unsigned char* lds, const int tid, const int K, const int lda, const int ldb, const Sched& S, const Epi& E) {
    const int wid = __builtin_amdgcn_readfirstlane(tid >> 6), lane = tid & 63, wr = wid >> 2, wc = wid & 3, fr = lane & 15, fq = lane >> 4;
    int Kq = K; asm volatile("" : "+s"(Kq));
    constexpr bool I8 = Epi::I8; constexpr int EB = I8 ? 1 : 2;
    typedef typename OpT<I8>::frag frag_t; typedef typename OpT<I8>::acc acc_t;
    const int nt = Kq * EB / (BK * 2);
    unsigned voffC[2][2], voffN[2][2], voffB[2]; int RA[2], CA[2];
#pragma unroll
    for (int i = 0; i < 2; ++i) { int R, C; stage_rc(tid * 16 + i * 8192, R, C); const int Rb = Epi::PERM ? ((R & ~31) + perm32(R & 31)) : R; RA[i] = R; CA[i] = C;
        voffB[i] = (unsigned)(Rb * ldb * EB + C * 2); }
#define PG8_AOFF(dst, ui_) do { _Pragma("unroll") for (int h_ = 0; h_ < 2; ++h_) _Pragma("unroll") for (int i_ = 0; i_ < 2; ++i_) { \
        if constexpr (Sched::GATHER) dst[h_][i_] = (unsigned)(S.row_of(ui_, h_ * HALF + RA[i_]) * lda * EB + CA[i_] * 2); else dst[h_][i_] = (unsigned)((h_ * HALF + RA[i_]) * lda * EB + CA[i_] * 2); } } while (0)
    const size_t kstep = (size_t)(BK * 2);
    const size_t hstepB = (size_t)HALF * ldb * EB;
    const unsigned ldsw = (unsigned)wid * 1024u;
    const int aoff = lds_byte(wr * 64 + fr, fq * 8), boff = lds_byte(wc * 32 + fr, fq * 8);
#define PG8_SA(b, h) (((b) * 2 + (h)) * HTB)
#define PG8_SB(b, h) ((4 + (b) * 2 + (h)) * HTB)
#define PG8_STAGE(bufoff, gbase, voff) do { _Pragma("unroll") for (int _i = 0; _i < 2; ++_i) \
        __builtin_amdgcn_global_load_lds((const unsigned*)((const char*)(gbase) + (voff)[_i]), (LAS unsigned*)(lds + (bufoff) + ldsw + _i * 8192), 16, 0, 0); } while (0)
#define PG8_LDA(dst, b, h) do { _Pragma("unroll") for (int m = 0; m < 4; ++m) _Pragma("unroll") for (int k = 0; k < 2; ++k) dst[m][k] = *(const LAS frag_t*)(lds + PG8_SA(b, h) + aoff + m * 2048 + k * 1024); } while (0)
#define PG8_LDB(dst, b, h) do { _Pragma("unroll") for (int n = 0; n < 2; ++n) _Pragma("unroll") for (int k = 0; k < 2; ++k) dst[n][k] = *(const LAS frag_t*)(lds + PG8_SB(b, h) + boff + n * 2048 + k * 1024); } while (0)
#define PG8_MMA(ai, bj, At, Bt) do { __builtin_amdgcn_s_setprio(1); _Pragma("unroll") for (int m = 0; m < 4; ++m) _Pragma("unroll") for (int n = 0; n < 2; ++n) _Pragma("unroll") for (int k = 0; k < 2; ++k) \
        acc[ai][bj][m][n] = mma16(Bt[n][k], At[m][k], acc[ai][bj][m][n]); __builtin_amdgcn_s_setprio(0); } while (0)
#define PG8_WAIT_V(n) asm volatile("s_waitcnt vmcnt(" #n ")" ::: "memory")
#define PG8_WAIT_L(n) asm volatile("s_waitcnt lgkmcnt(" #n ")" ::: "memory")
#define PG8_BAR __builtin_amdgcn_s_barrier()
#define PG8_SCHED __builtin_amdgcn_sched_barrier(0)
    Unit cur, nxt; int ui = 0;
    if (!S.next(0, cur)) return;
    acc_t acc[2][2][4][2];
#pragma unroll
    for (int a = 0; a < 2; ++a)
#pragma unroll
        for (int b = 0; b < 2; ++b)
#pragma unroll
            for (int m = 0; m < 4; ++m)
#pragma unroll
                for (int n = 0; n < 2; ++n) acc[a][b][m][n] = (acc_t){0, 0, 0, 0};
    frag_t At[4][2], B0[2][2], B1[2][2];
    const char* cA = cur.a; const char* cB = cur.b;
    PG8_AOFF(voffC, 0); PG8_AOFF(voffN, 0);
    PG8_STAGE(PG8_SB(0, 0), cB, voffB); PG8_STAGE(PG8_SB(0, 1), cB + hstepB, voffB); PG8_STAGE(PG8_SA(0, 0), cA, voffC[0]); PG8_STAGE(PG8_SA(0, 1), cA, voffC[1]);
    if (wr == 1) PG8_BAR;
    PG8_WAIT_V(2); PG8_BAR;
    PG8_STAGE(PG8_SB(1, 0), cB + kstep, voffB); PG8_STAGE(PG8_SA(1, 0), cA + kstep, voffC[0]); PG8_STAGE(PG8_SB(1, 1), cB + hstepB + kstep, voffB);
    PG8_WAIT_V(6); PG8_BAR;
    for (;;) {
        const bool has_next = S.next(ui + 1, nxt);
        const char* nA = has_next ? nxt.a : cA; const char* nB = has_next ? nxt.b : cB;
        if constexpr (Sched::GATHER) { if (has_next) PG8_AOFF(voffN, ui + 1); }
#pragma clang loop unroll(disable)
        for (int t = 0; t < nt; t += 2) {
            const bool last = (t == nt - 2);
            const char* a1 = cA + (size_t)(t + 1) * kstep;
            const char* a2 = last ? nA : cA + (size_t)(t + 2) * kstep; const char* b2 = last ? nB : cB + (size_t)(t + 2) * kstep;
            const char* a3 = a2 + kstep; const char* b3 = b2 + kstep;
            unsigned vA0[2], vA1[2];
            if constexpr (Sched::GATHER) { vA0[0] = last ? voffN[0][0] : voffC[0][0]; vA0[1] = last ? voffN[0][1] : voffC[0][1]; vA1[0] = last ? voffN[1][0] : voffC[1][0]; vA1[1] = last ? voffN[1][1] : voffC[1][1]; }
            else { vA0[0] = voffC[0][0]; vA0[1] = voffC[0][1]; vA1[0] = voffC[1][0]; vA1[1] = voffC[1][1]; }
            PG8_LDB(B0, 0, 0); PG8_LDB(B1, 0, 1); PG8_SCHED; PG8_LDA(At, 0, 0); PG8_STAGE(PG8_SA(1, 1), a1, voffC[1]);
            PG8_WAIT_V(8); PG8_WAIT_L(0); PG8_BAR; PG8_MMA(0, 0, At, B0); PG8_MMA(0, 1, At, B1); PG8_BAR; PG8_SCHED;
            PG8_LDA(At, 0, 1); PG8_STAGE(PG8_SB(0, 0), b2, voffB); PG8_STAGE(PG8_SB(0, 1), b2 + hstepB, voffB); PG8_STAGE(PG8_SA(0, 0), a2, vA0);
            PG8_WAIT_V(8); PG8_WAIT_L(0); PG8_BAR; PG8_MMA(1, 0, At, B0); PG8_MMA(1, 1, At, B1); PG8_BAR; PG8_SCHED;
            PG8_LDB(B0, 1, 0); PG8_LDB(B1, 1, 1); PG8_SCHED; PG8_LDA(At, 1, 0); PG8_STAGE(PG8_SA(0, 1), a2, vA1);
            PG8_WAIT_V(8); PG8_WAIT_L(0); PG8_BAR; PG8_MMA(0, 0, At, B0); PG8_MMA(0, 1, At, B1); PG8_BAR; PG8_SCHED;
            PG8_LDA(At, 1, 1); PG8_STAGE(PG8_SB(1, 0), b3, voffB); PG8_STAGE(PG8_SB(1, 1), b3 + hstepB, voffB); PG8_STAGE(PG8_SA(1, 0), a3, vA0);
            PG8_WAIT_V(8); PG8_WAIT_L(0); PG8_BAR; PG8_MMA(1, 0, At, B0); PG8_MMA(1, 1, At, B1); PG8_BAR; PG8_SCHED;
        }
        if (wr == 0) PG8_BAR;
        { int te = tid; asm volatile("" : "+v"(te));
          const int we = __builtin_amdgcn_readfirstlane(te >> 6), le = te & 63;
          E(acc, cur, we >> 2, we & 3, le & 15, le >> 4); }
        if (!has_next) break;
#pragma unroll
        for (int a = 0; a < 2; ++a)
#pragma unroll
            for (int b = 0; b < 2; ++b)
#pragma unroll
                for (int m = 0; m < 4; ++m)
#pragma unroll
                    for (int n = 0; n < 2; ++n) acc[a][b][m][n] = (acc_t){0, 0, 0, 0};
        cur = nxt; cA = nA; cB = nB; ++ui;
        if constexpr (Sched::GATHER) {
#pragma unroll
            for (int h_ = 0; h_ < 2; ++h_) { voffC[h_][0] = voffN[h_][0]; voffC[h_][1] = voffN[h_][1]; } }
        if (wr == 1) PG8_BAR;
    }
    PG8_WAIT_V(0);
    PG8_BAR;
#undef PG8_AOFF
#undef PG8_SA
#undef PG8_SB
#undef PG8_STAGE
#undef PG8_LDA
#undef PG8_LDB
#undef PG8_MMA
#undef PG8_WAIT_V
#undef PG8_WAIT_L
#undef PG8_BAR
#undef PG8_SCHED
}

struct GridOrder {
    int nM, nN, nwg, G, c, uneven;
    __device__ __forceinline__ void init(int nM_, int nN_, int G_, int c_) { nM = nM_; nN = nN_; nwg = nM * nN; G = G_; c = c_; uneven = 0; }
    __device__ __forceinline__ bool tile(int i, int& pm, int& pn) const {
        long L = (long)i * G + c;
        if (uneven) {
            if (c < 128) { if (i >= 2) return false; L = i * 128 + c; } else { if (i >= 4) return false; L = 256 + (c - 128) + 128 * i; } }
        if (L >= nwg) return false;
        int wgid = (int)L; { const int q = nwg / 8, r = nwg % 8, xcd = wgid % 8, off = wgid / 8; wgid = (xcd < r ? xcd * (q + 1) : r * (q + 1) + (xcd - r) * q) + off; }
        const int nig = 8 * nN, gid = wgid / nig, fm = gid * 8, gsz = (nM - fm) < 8 ? (nM - fm) : 8;
        pm = fm + ((wgid % nig) % gsz); pn = (wgid % nig) / gsz; return true;
    }
};
}

__device__ __forceinline__ int uni(int v) { return __builtin_amdgcn_readfirstlane(v); }
__device__ __forceinline__ const char* uniptr(const char* p) { const unsigned long long v = (unsigned long long)p; const unsigned lo = __builtin_amdgcn_readfirstlane((unsigned)v), hi = __builtin_amdgcn_readfirstlane((unsigned)(v >> 32)); return (const char*)(((unsigned long long)hi << 32) | lo); }
struct DenseSched {
    static constexpr bool GATHER = false;
    pg8::GridOrder o; const char* A; size_t a_sel_stride; int pn_per_a; const char* B; size_t tstepA, tstepB;
    __device__ __forceinline__ bool next(int i, pg8::Unit& u) const {
        if (!o.tile(i, u.pm, u.pn)) return false;
        u.pm = uni(u.pm); u.pn = uni(u.pn); u.ui = i;
        u.a = uniptr(A + (size_t)(u.pn / pn_per_a) * a_sel_stride + (size_t)u.pm * tstepA); u.b = uniptr(B + (size_t)u.pn * tstepB); return true;
    }
};
struct MoeSched {
    static constexpr bool GATHER = false;
    const LAS int* tileE; int ntiles, npn, G, c; const char* A; const char* B; size_t tstepA, tstepB, estride;
    __device__ __forceinline__ bool next(int i, pg8::Unit& u) const {
        const int L = i * G + c; if (L >= ntiles * npn) return false;
        u.pm = uni(L / npn); u.pn = uni(L % npn); u.ui = i;
        const int e = __builtin_amdgcn_readfirstlane(tileE[u.pm]);
        u.a = uniptr(A + (size_t)u.pm * tstepA); u.b = uniptr(B + (size_t)e * estride + (size_t)u.pn * tstepB); return true;
    }
};
struct MoeGatherSched {
    static constexpr bool GATHER = true;
    const LAS int* tileE; const LAS int* rowtab; int ntiles, G, c; const char* A; const char* B; size_t tstepB, estride;
    __device__ __forceinline__ bool next(int i, pg8::Unit& u) const {
        const int L = i * G + c; if (L >= ntiles * 2) return false;
        u.pm = uni(L >> 1); u.pn = uni(L & 1); u.ui = i;
        const int e = __builtin_amdgcn_readfirstlane(tileE[u.pm]);
        u.a = A; u.b = uniptr(B + (size_t)e * estride + (size_t)u.pn * tstepB); return true;
    }
    __device__ __forceinline__ int row_of(int i, int r) const { return rowtab[i * 256 + r]; }
};
using pg8::Unit; using pg8::cvt_pk_bf16;
__device__ __forceinline__ void st8(bf16* p, const f32x4& v0, const f32x4& v1) {
    u32x4 w; w.x = cvt_pk_bf16(v0[0], v0[1]); w.y = cvt_pk_bf16(v0[2], v0[3]); w.z = cvt_pk_bf16(v1[0], v1[1]); w.w = cvt_pk_bf16(v1[2], v1[3]);
    *(u32x4*)p = w;
}
struct EpiSplit {
    static constexpr bool PERM = true, I8 = false;
    bf16* O; size_t split_stride; float scale;
    __device__ __forceinline__ void operator()(const f32x4 (&acc)[2][2][4][2], const Unit& u, int wr, int wc, int fr, int fq) const {
        const int row0 = u.pm * 256 + wr * 64 + fr; const int colt = u.pn * 256; const int t = colt >> 10;
        bf16* base = O + (size_t)t * split_stride; const int col0 = (colt & 1023) + wc * 32 + 8 * fq;
#pragma unroll
        for (int ai = 0; ai < 2; ++ai)
#pragma unroll
            for (int m = 0; m < 4; ++m) { bf16* rowp = base + (size_t)(row0 + ai * 128 + m * 16) * 1024 + col0;
#pragma unroll
                for (int bj = 0; bj < 2; ++bj) st8(rowp + bj * 128, acc[ai][bj][m][0] * scale, acc[ai][bj][m][1] * scale); }
    }
};
struct EpiLoraDn {
    static constexpr bool PERM = true, I8 = false;
    bf16* O;
    __device__ __forceinline__ void operator()(const f32x4 (&acc)[2][2][4][2], const Unit& u, int wr, int wc, int fr, int fq) const {
        const int row0 = u.pm * 256 + wr * 64 + fr; const int col0 = u.pn * 256 + wc * 32 + 8 * fq;
#pragma unroll
        for (int ai = 0; ai < 2; ++ai)
#pragma unroll
            for (int m = 0; m < 4; ++m) { bf16* rowp = O + (size_t)(row0 + ai * 128 + m * 16) * 512 + col0;
#pragma unroll
                for (int bj = 0; bj < 2; ++bj) { f32x4 v0 = acc[ai][bj][m][0], v1 = acc[ai][bj][m][1];
                    const int mode = (u.pn == 1) ? 2 : ((wc >> 1) & 1);
                    if (mode == 0) {
#pragma unroll
                        for (int j = 0; j < 4; ++j) { v0[j] = 1.0f - 2.0f / (__expf(2.0f * v0[j]) + 1.0f); v1[j] = 1.0f - 2.0f / (__expf(2.0f * v1[j]) + 1.0f); } }
                    else if (mode == 2) {
#pragma unroll
                        for (int j = 0; j < 4; ++j) { v0[j] = sigmoidf_(v0[j]); v1[j] = sigmoidf_(v1[j]); } }
                    st8(rowp + bj * 128, v0, v1); } }
    }
};
struct EpiLoraUpWA {
    static constexpr bool PERM = true, I8 = false;
    bf16* LD; bf16* AS; const float* w0; const float* a0;
    __device__ __forceinline__ void operator()(const f32x4 (&acc)[2][2][4][2], const Unit& u, int wr, int wc, int fr, int fq) const {
        const int z = u.pn >> 3, kind = (u.pn >> 2) & 1;
        const int row0 = u.pm * 256 + wr * 64 + fr; const int col0 = (u.pn & 3) * 256 + wc * 32 + 8 * fq;
        bf16* base = (kind ? AS : LD) + (size_t)z * T * D; const float* bias = (kind ? a0 : w0) + z * 1024;
        f32x4 bv[2][2];
#pragma unroll
        for (int bj = 0; bj < 2; ++bj)
#pragma unroll
            for (int n = 0; n < 2; ++n) bv[bj][n] = *(const f32x4*)(bias + col0 + bj * 128 + 4 * n);
#pragma unroll
        for (int ai = 0; ai < 2; ++ai)
#pragma unroll
            for (int m = 0; m < 4; ++m) { bf16* rowp = base + (size_t)(row0 + ai * 128 + m * 16) * 1024 + col0;
#pragma unroll
                for (int bj = 0; bj < 2; ++bj) { f32x4 v[2];
#pragma unroll
                    for (int n = 0; n < 2; ++n) { v[n] = acc[ai][bj][m][n] + bv[bj][n];
#pragma unroll
                        for (int j = 0; j < 4; ++j) { const float x = v[n][j];
                            if (kind == 0) v[n][j] = -0.8750612633917001f * sigmoidf_(x);
                            else v[n][j] = sigmoidf_(x); } }
                    st8(rowp + bj * 128, v[0], v[1]); } }
    }
};
struct EpiResid {
    static constexpr bool PERM = true, I8 = false;
    const void* xin; int xin_f32; bf16* out; const float* gate;
    __device__ __forceinline__ void operator()(const f32x4 (&acc)[2][2][4][2], const Unit& u, int wr, int wc, int fr, int fq) const {
        const int row0 = u.pm * 256 + wr * 64 + fr, col0 = u.pn * 256 + wc * 32 + 8 * fq; const int b = u.pm >> 3;
        f32x4 gv[2][2];
#pragma unroll
        for (int bj = 0; bj < 2; ++bj)
#pragma unroll
            for (int n = 0; n < 2; ++n) gv[bj][n] = *(const f32x4*)(gate + (size_t)b * 6144 + col0 + bj * 128 + 4 * n);
        if (xin_f32) {
#pragma unroll
            for (int ai = 0; ai < 2; ++ai)
#pragma unroll
                for (int m = 0; m < 4; ++m) { const size_t off = (size_t)(row0 + ai * 128 + m * 16) * D + col0;
#pragma unroll
                    for (int bj = 0; bj < 2; ++bj) { const f32x4 x0 = *(const f32x4*)((const float*)xin + off + bj * 128), x1 = *(const f32x4*)((const float*)xin + off + bj * 128 + 4);
                        st8(out + off + bj * 128, x0 + gv[bj][0] * acc[ai][bj][m][0], x1 + gv[bj][1] * acc[ai][bj][m][1]); } }
        } else {
#pragma unroll
            for (int ai = 0; ai < 2; ++ai) { u32x4 xr[4][2];
#pragma unroll
                for (int m = 0; m < 4; ++m)
#pragma unroll
                    for (int bj = 0; bj < 2; ++bj) xr[m][bj] = *(const u32x4*)((const bf16*)xin + (size_t)(row0 + ai * 128 + m * 16) * D + col0 + bj * 128);
#pragma unroll
                for (int m = 0; m < 4; ++m) { const size_t off = (size_t)(row0 + ai * 128 + m * 16) * D + col0;
#pragma unroll
                    for (int bj = 0; bj < 2; ++bj) { const u32x4 r = xr[m][bj];
                        const f32x4 x0 = {bf_lo(r.x), bf_hi(r.x), bf_lo(r.y), bf_hi(r.y)}, x1 = {bf_lo(r.z), bf_hi(r.z), bf_lo(r.w), bf_hi(r.w)};
                        st8(out + off + bj * 128, x0 + gv[bj][0] * acc[ai][bj][m][0], x1 + gv[bj][1] * acc[ai][bj][m][1]); } } }
        }
    }
};
struct EpiQKV {
    static constexpr bool PERM = true, I8 = false;
    bf16* Q; bf16* Kb; bf16* Vb; float qscale;
    __device__ __forceinline__ void operator()(const f32x4 (&acc)[2][2][4][2], const Unit& u, int wr, int wc, int fr, int fq) const {
        const int g = u.pn / 12, which = (u.pn % 12) >> 2, hp = u.pn & 3;
        const int row0 = u.pm * 256 + wr * 64 + fr;
        bf16* base = Q + (size_t)which * ((A_K - A_Q) / 2) + (size_t)g * T * D; const float sc = which ? 1.0f : qscale; const int col0 = hp * 256 + wc * 32 + 8 * fq;
#pragma unroll
        for (int ai = 0; ai < 2; ++ai)
#pragma unroll
            for (int m = 0; m < 4; ++m) { bf16* rowp = base + (size_t)(row0 + ai * 128 + m * 16) * 1024 + col0;
#pragma unroll
                for (int bj = 0; bj < 2; ++bj) st8(rowp + bj * 128, acc[ai][bj][m][0] * sc, acc[ai][bj][m][1] * sc); }
    }
};
template <class Inner> struct EpiI8 {
    static constexpr bool PERM = Inner::PERM, I8 = true;
    Inner in; const float* sa; size_t sa_sel; int pn_per_a; const float* sb;
    __device__ __forceinline__ void operator()(const pg8::i32x4 (&acc)[2][2][4][2], const Unit& u, int wr, int wc, int fr, int fq) const {
        const int row0 = u.pm * 256 + wr * 64 + fr; const float* sap = sa + (size_t)(u.pn / pn_per_a) * sa_sel;
        const int colb = u.pn * 256 + wc * 32 + (PERM ? 8 * fq : 4 * fq);
        f32x4 sbv[2][2]; f32x4 f[2][2][4][2];
#pragma unroll
        for (int bj = 0; bj < 2; ++bj)
#pragma unroll
            for (int n = 0; n < 2; ++n) sbv[bj][n] = *(const f32x4*)(sb + colb + bj * 128 + (PERM ? 4 * n : 16 * n));
        float srv[2][4];
#pragma unroll
        for (int ai = 0; ai < 2; ++ai)
#pragma unroll
            for (int m = 0; m < 4; ++m) srv[ai][m] = sap[row0 + ai * 128 + m * 16];
        asm volatile("" : "+v"(srv[0][0]), "+v"(srv[0][1]), "+v"(srv[0][2]), "+v"(srv[0][3]), "+v"(srv[1][0]), "+v"(srv[1][1]), "+v"(srv[1][2]), "+v"(srv[1][3]));
#pragma unroll
        for (int ai = 0; ai < 2; ++ai)
#pragma unroll
            for (int m = 0; m < 4; ++m) { const float sr = srv[ai][m];
#pragma unroll
                for (int bj = 0; bj < 2; ++bj)
#pragma unroll
                    for (int n = 0; n < 2; ++n) f[ai][bj][m][n] = __builtin_convertvector(acc[ai][bj][m][n], f32x4) * (sbv[bj][n] * sr); }
        in(f, u, wr, wc, fr, fq);
    }
};
struct EpiQKV8 {
    static constexpr bool PERM = true, I8 = true;
    bf16* Q; const float* SA; const float* SBq; float qscale;
    __device__ __forceinline__ void operator()(const pg8::i32x4 (&acc)[2][2][4][2], const Unit& u, int wr, int wc, int fr, int fq) const {
        const int g = u.pn / 12, which = (u.pn % 12) >> 2, hp = u.pn & 3;
        const int row0 = u.pm * 256 + wr * 64 + fr;
        bf16* base = Q + (size_t)which * ((A_K - A_Q) / 2) + (size_t)g * T * D; const float sc = which ? 1.0f : qscale; const int col0 = hp * 256 + wc * 32 + 8 * fq;
        const int colb = u.pn * 256 + wc * 32 + 8 * fq;
        f32x4 sbv[2][2];
#pragma unroll
        for (int bj = 0; bj < 2; ++bj)
#pragma unroll
            for (int n = 0; n < 2; ++n) sbv[bj][n] = *(const f32x4*)(SBq + colb + bj * 128 + 4 * n) * sc;
        float sav[2][4];
#pragma unroll
        for (int ai = 0; ai < 2; ++ai)
#pragma unroll
            for (int m = 0; m < 4; ++m) sav[ai][m] = SA[row0 + ai * 128 + m * 16];
#pragma unroll
        for (int ai = 0; ai < 2; ++ai)
#pragma unroll
            for (int m = 0; m < 4; ++m) { const int row = row0 + ai * 128 + m * 16; const float sa = sav[ai][m]; bf16* rowp = base + (size_t)row * 1024 + col0;
#pragma unroll
                for (int bj = 0; bj < 2; ++bj) st8(rowp + bj * 128, __builtin_convertvector(acc[ai][bj][m][0], f32x4) * (sbv[bj][0] * sa), __builtin_convertvector(acc[ai][bj][m][1], f32x4) * (sbv[bj][1] * sa)); }
    }
};
struct EpiGateUp {
    static constexpr bool PERM = true, I8 = false;
    bf16* H; const float* roww;
    __device__ __forceinline__ void operator()(const f32x4 (&acc)[2][2][4][2], const Unit& u, int wr, int wc, int fr, int fq) const {
        const int row0 = u.pm * 256 + wr * 64 + fr; const int col0 = u.pn * 128 + wc * 32 + 8 * fq;
#pragma unroll
        for (int ai = 0; ai < 2; ++ai)
#pragma unroll
            for (int m = 0; m < 4; ++m) { const int row = row0 + ai * 128 + m * 16; const float rw = roww[row]; f32x4 v[2];
#pragma unroll
                for (int n = 0; n < 2; ++n)
#pragma unroll
                    for (int j = 0; j < 4; ++j) { const float gg = acc[ai][0][m][n][j], uu = acc[ai][1][m][n][j]; v[n][j] = gg * sigmoidf_(gg) * uu * rw; }
                st8(H + (size_t)row * FEXP + col0, v[0], v[1]); }
    }
};
struct EpiGateUp8 {
    static constexpr bool PERM = true, I8 = true;
    bf16* H; const LAS float* wtab; const LAS float* stab; const float* sbe; const LAS int* tileE;
    __device__ __forceinline__ void operator()(const pg8::i32x4 (&acc)[2][2][4][2], const Unit& u, int wr, int wc, int fr, int fq) const {
        const int rl0 = wr * 64 + fr; const int col0 = u.pn * 128 + wc * 32 + 8 * fq;
        const int e = __builtin_amdgcn_readfirstlane(tileE[u.pm]); const float* sbp = sbe + (size_t)e * 512 + u.pn * 256 + wc * 32 + 8 * fq;
        f32x4 sg[2], su[2];
#pragma unroll
        for (int n = 0; n < 2; ++n) { sg[n] = *(const f32x4*)(sbp + 4 * n); su[n] = *(const f32x4*)(sbp + 128 + 4 * n); }
#pragma unroll
        for (int ai = 0; ai < 2; ++ai)
#pragma unroll
            for (int m = 0; m < 4; ++m) { const int rl = rl0 + ai * 128 + m * 16; const float rw = wtab[u.ui * 256 + rl]; const float sa = stab[u.ui * 256 + rl]; f32x4 v[2];
#pragma unroll
                for (int n = 0; n < 2; ++n) { const f32x4 g4 = __builtin_convertvector(acc[ai][0][m][n], f32x4) * (sg[n] * sa), u4 = __builtin_convertvector(acc[ai][1][m][n], f32x4) * (su[n] * sa);
#pragma unroll
                    for (int j = 0; j < 4; ++j) { const float gg = g4[j], uu = u4[j]; v[n][j] = gg * sigmoidf_(gg) * uu * rw; } }
                st8(H + (size_t)(u.pm * 256 + rl) * FEXP + col0, v[0], v[1]); }
    }
};
struct EpiPlain {
    static constexpr bool PERM = true, I8 = false;
    bf16* O;
    __device__ __forceinline__ void operator()(const f32x4 (&acc)[2][2][4][2], const Unit& u, int wr, int wc, int fr, int fq) const {
        const int row0 = u.pm * 256 + wr * 64 + fr; const int col0 = u.pn * 256 + wc * 32 + 8 * fq;
#pragma unroll
        for (int ai = 0; ai < 2; ++ai)
#pragma unroll
            for (int m = 0; m < 4; ++m) { bf16* rowp = O + (size_t)(row0 + ai * 128 + m * 16) * 1024 + col0;
#pragma unroll
                for (int bj = 0; bj < 2; ++bj) st8(rowp + bj * 128, acc[ai][bj][m][0], acc[ai][bj][m][1]); }
    }
};

struct Args {
    const float* in[32]; float* out; unsigned char* ws; int ph_lo, ph_hi;
};
enum { I_X = 0, I_C, I_ADAW, I_ADAB, I_NTM, I_NCM, I_MU, I_WRKV, I_W0, I_W1, I_W2, I_A0, I_A1, I_A2, I_G1, I_G2, I_KK, I_KA, I_RK, I_LNW, I_LNB, I_RWO,
       I_AQKV, I_AWO, I_RG, I_RGB, I_RE, I_REB, I_WG, I_WU, I_WD, I_FG };

struct Frame {
    LAS unsigned char* lds; int tid, lane, wave, G, gw, NGW;
    unsigned char* ws; const float* const* in; float* out;
};

__device__ __forceinline__ void row_load(const float* p, int lane, f32x4 (&v)[4]) {
#pragma unroll
    for (int j = 0; j < 4; ++j) v[j] = *(const f32x4*)(p + 4 * lane + 256 * j);
}
__device__ __forceinline__ void row_load_bf16(const bf16* p, int lane, f32x4 (&v)[4]) {
#pragma unroll
    for (int j = 0; j < 4; ++j) { const u32x2 r = *(const u32x2*)(p + 4 * lane + 256 * j); v[j] = (f32x4){bf_lo(r.x), bf_hi(r.x), bf_lo(r.y), bf_hi(r.y)}; }
}
__device__ __forceinline__ void row_store(float* p, int lane, const f32x4 (&v)[4]) {
#pragma unroll
    for (int j = 0; j < 4; ++j) *(f32x4*)(p + 4 * lane + 256 * j) = v[j];
}
__device__ __forceinline__ void row_store_bf16(bf16* p, int lane, const f32x4 (&v)[4]) {
#pragma unroll
    for (int j = 0; j < 4; ++j) { u32x2 w; w.x = pk2(v[j][0], v[j][1]); w.y = pk2(v[j][2], v[j][3]); *(u32x2*)(p + 4 * lane + 256 * j) = w; }
}
__device__ __forceinline__ void row_store_i8(signed char* p, float* scl, int lane, const f32x4 (&v)[4]) {
    float am = 0.f;
#pragma unroll
    for (int j = 0; j < 4; ++j) am = fmaxf(am, fmaxf(fmaxf(fabsf(v[j][0]), fabsf(v[j][1])), fmaxf(fabsf(v[j][2]), fabsf(v[j][3]))));
    am = fmaxf(wave_max(am), 1e-20f); const float inv = 127.0f / am;
    if (lane == 0) *scl = am * (1.0f / 127.0f);
#pragma unroll
    for (int j = 0; j < 4; ++j) *(unsigned*)(p + 4 * lane + 256 * j) = pack_i8x4(v[j], inv);
}
struct TokTab { const int* toke; const int* tokr; const LAS int* offs; };
__device__ __forceinline__ void row_combine(f32x4 (&v)[4], const bf16* ys, const TokTab& tt, int row, const float* gac, int lane) {
    const int p0 = tt.offs[tt.toke[2 * row]] + tt.tokr[2 * row], p1 = tt.offs[tt.toke[2 * row + 1]] + tt.tokr[2 * row + 1];
    const bf16* y0 = ys + (size_t)p0 * D; const bf16* y1 = ys + (size_t)p1 * D;
#pragma unroll
    for (int j = 0; j < 4; ++j) { const u32x2 a = *(const u32x2*)(y0 + 4 * lane + 256 * j), b = *(const u32x2*)(y1 + 4 * lane + 256 * j); const f32x4 g = *(const f32x4*)(gac + 4 * lane + 256 * j);
        v[j][0] += g[0] * (bf_lo(a.x) + bf_lo(b.x)); v[j][1] += g[1] * (bf_hi(a.x) + bf_hi(b.x)); v[j][2] += g[2] * (bf_lo(a.y) + bf_lo(b.y)); v[j][3] += g[3] * (bf_hi(a.y) + bf_hi(b.y)); }
}
__device__ __forceinline__ void row_norm_mod(const f32x4 (&x)[4], const float* gain, const float* sc, const float* sh, int lane, f32x4 (&h)[4]) {
    float s = 0.f;
#pragma unroll
    for (int j = 0; j < 4; ++j) s += (x[j][0] * x[j][0] + x[j][1] * x[j][1]) + (x[j][2] * x[j][2] + x[j][3] * x[j][3]);
    const float rstd = rsqrtf(wave_sum(s, lane) * (1.0f / D) + RMS_EPS);
#pragma unroll
    for (int j = 0; j < 4; ++j) { const f32x4 g = *(const f32x4*)(gain + 4 * lane + 256 * j), c = *(const f32x4*)(sc + 4 * lane + 256 * j), b = *(const f32x4*)(sh + 4 * lane + 256 * j);
        h[j] = x[j] * rstd * g * (1.0f + c) + b; }
}
__device__ __forceinline__ void transpose_item(const float* W, int ldw, bf16* dst, int ldd, LAS float* scr, int lane) {
    { const int r8 = lane >> 3, c4 = (lane & 7) * 4;
      f32x4 v[8];
#pragma unroll
      for (int i = 0; i < 8; ++i) v[i] = *(const f32x4*)(W + (size_t)(8 * i + r8) * ldw + c4);
#pragma unroll
      for (int i = 0; i < 8; ++i) { LAS float* p = scr + (8 * i + r8) * 33 + c4; p[0] = v[i][0]; p[1] = v[i][1]; p[2] = v[i][2]; p[3] = v[i][3]; } }
    LDS_WAIT(); asm volatile("" ::: "memory");
    const int c = lane & 7;
#pragma unroll
    for (int j = 0; j < 4; ++j) { const int n = (lane >> 3) + 8 * j; const LAS float* s = scr + (8 * c) * 33 + n;
        u32x4 o; o.x = pk2(s[0 * 33], s[1 * 33]); o.y = pk2(s[2 * 33], s[3 * 33]); o.z = pk2(s[4 * 33], s[5 * 33]); o.w = pk2(s[6 * 33], s[7 * 33]);
        *(u32x4*)(dst + (size_t)n * ldd + 8 * c) = o; }
    LDS_WAIT(); asm volatile("" ::: "memory");
}

__device__ __forceinline__ void conv8_cols32(Frame& F, const float* src, int ldw, signed char* dst, float* scl) {
    LAS float* scr = (LAS float*)(F.lds + 49152 + F.wave * 8704); LAS float* pm = (LAS float*)(F.lds + 118784);
    const int r8 = F.lane >> 3, c4 = (F.lane & 7) * 4;
    f32x4 v[16]; f32x4 mx = {0.f, 0.f, 0.f, 0.f};
#pragma unroll
    for (int i = 0; i < 16; ++i) { v[i] = *(const f32x4*)(src + (size_t)(F.wave * 128 + 8 * i + r8) * ldw + c4);
        mx[0] = fmaxf(mx[0], fabsf(v[i][0])); mx[1] = fmaxf(mx[1], fabsf(v[i][1])); mx[2] = fmaxf(mx[2], fabsf(v[i][2])); mx[3] = fmaxf(mx[3], fabsf(v[i][3])); }
#pragma unroll
    for (int q = 0; q < 4; ++q) { float a = mx[q]; a = fmaxf(a, dpp_ror(a, 8)); a = bfly16_max(a); a = bfly32_max(a); mx[q] = a; }
    if (r8 == 0) *(LAS f32x4*)(pm + F.wave * 32 + c4) = mx;
    __syncthreads();
    f32x4 cm = *(const LAS f32x4*)(pm + c4);
#pragma unroll
    for (int w = 1; w < 8; ++w) { const f32x4 o = *(const LAS f32x4*)(pm + w * 32 + c4); cm[0] = fmaxf(cm[0], o[0]); cm[1] = fmaxf(cm[1], o[1]); cm[2] = fmaxf(cm[2], o[2]); cm[3] = fmaxf(cm[3], o[3]); }
#pragma unroll
    for (int q = 0; q < 4; ++q) cm[q] = fmaxf(cm[q], 1e-20f);
    if (F.wave == 0 && r8 == 0) *(f32x4*)(scl + c4) = cm * (1.0f / 127.0f);
#pragma unroll
    for (int kh = 0; kh < 2; ++kh) {
#pragma unroll
        for (int i = 0; i < 8; ++i) { LAS float* p = scr + (8 * i + r8) * 33 + c4; const f32x4 x = v[8 * kh + i]; p[0] = x[0] * (127.0f / cm[0]); p[1] = x[1] * (127.0f / cm[1]); p[2] = x[2] * (127.0f / cm[2]); p[3] = x[3] * (127.0f / cm[3]); }
        LDS_WAIT(); asm volatile("" ::: "memory");
        const int c = F.lane & 7;
#pragma unroll
        for (int jj = 0; jj < 4; ++jj) { const int n = (F.lane >> 3) + 8 * jj; const LAS float* sp = scr + (8 * c) * 33 + n;
            u32x2 o; o.x = pack_i8x4((f32x4){sp[0 * 33], sp[1 * 33], sp[2 * 33], sp[3 * 33]}, 1.0f); o.y = pack_i8x4((f32x4){sp[4 * 33], sp[5 * 33], sp[6 * 33], sp[7 * 33]}, 1.0f);
            *(u32x2*)(dst + (size_t)n * D + (F.wave * 2 + kh) * 64 + 8 * c) = o; }
        LDS_WAIT(); asm volatile("" ::: "memory");
    }
    __syncthreads();
}
__device__ __forceinline__ void phase_prologue(Frame& F) {
    const float* c = F.in[I_C]; const float* adaw = F.in[I_ADAW]; const float* adab = F.in[I_ADAB];
    float* mod = (float*)(F.ws + WS_MOD);
    LAS float* sc = (LAS float*)F.lds;
    LAS float* part = (LAS float*)(F.lds + 32768);
    for (int i = F.tid; i < NB * D; i += NTHREADS) { const float v = c[i]; sc[i] = v / (1.0f + __expf(-v)); }
    __syncthreads();
    for (int u = blockIdx.x; u < DEPTH * 192; u += F.G) {
        const int l = u / 192, n0 = (u % 192) * 32; const int r8 = F.lane >> 3, c4 = (F.lane & 7) * 4;
        const float* W = adaw + (size_t)l * D * 6144 + n0 + c4;
        f32x4 v[16];
#pragma unroll
        for (int i = 0; i < 16; ++i) v[i] = *(const f32x4*)(W + (size_t)(F.wave * 128 + 8 * i + r8) * 6144);
        f32x4 acc[8];
#pragma unroll
        for (int b = 0; b < 8; ++b) acc[b] = (f32x4){0.f, 0.f, 0.f, 0.f};
#pragma unroll
        for (int i = 0; i < 16; ++i) { const int k = F.wave * 128 + 8 * i + r8;
#pragma unroll
            for (int b = 0; b < 8; ++b) acc[b] += v[i] * sc[b * D + k]; }
#pragma unroll
        for (int b = 0; b < 8; ++b)
#pragma unroll
            for (int q = 0; q < 4; ++q) { float a = acc[b][q]; a += dpp_ror(a, 8); a = bfly16_sum(a); a = bfly32_sum(a); acc[b][q] = a; }
        if (r8 == 0) {
#pragma unroll
            for (int b = 0; b < 8; ++b) *(LAS f32x4*)(part + (F.wave * 8 + b) * 32 + c4) = acc[b]; }
        __syncthreads();
        if (F.tid < 256) { const int b = F.tid >> 5, cc = F.tid & 31; float sum = adab[l * 6144 + n0 + cc];
#pragma unroll
            for (int w = 0; w < 8; ++w) sum += part[(w * 8 + b) * 32 + cc];
            mod[(size_t)(l * 8 + b) * 6144 + n0 + cc] = sum; }
        __syncthreads();
    }
    LAS float* scr = (LAS float*)(F.lds + 49152 + F.wave * 8704);
    constexpr int I_SQ = 16 * 32;
    constexpr int I_QKV = 16 * 288;
    constexpr int PER_RW = 4 * I_SQ, PER_AT = I_QKV + I_SQ, NIT = 2 * PER_RW + 2 * PER_AT;
    for (int it = F.gw; it < NIT; it += F.NGW) {
        int r = it;
        if (r < 2 * PER_RW) { const int j = r / PER_RW; r %= PER_RW; const int mi = r / I_SQ; r %= I_SQ; const int kb = r / 32, nb = r % 32;
            if (mi < 3) { }
            else transpose_item(F.in[I_RWO] + ((size_t)j * D + kb * 64) * D + nb * 32, D, (bf16*)(F.ws + WS_W + j * W_RW_STRIDE + W_RWO) + (size_t)(nb * 32) * D + kb * 64, D, scr, F.lane);
        } else { r -= 2 * PER_RW; const int j = r / PER_AT; r %= PER_AT;
            if (r < I_QKV) { }
            else { r -= I_QKV; const int kb = r / 32, nb = r % 32;
                transpose_item(F.in[I_AWO] + ((size_t)j * D + kb * 64) * D + nb * 32, D, (bf16*)(F.ws + WS_WA + j * W_AT_STRIDE + W_AWO) + (size_t)(nb * 32) * D + kb * 64, D, scr, F.lane); }
        }
    }
    for (int u = blockIdx.x; u < 2 * 288 + 2 * 96; u += F.G) {
        if (u < 2 * 288) { const int j = u / 288, n0 = (u % 288) * 32;
            conv8_cols32(F, F.in[I_AQKV] + (size_t)j * D * QKVW + n0, QKVW, (signed char*)(F.ws + WS_WA + j * W_AT_STRIDE + W_QKV) + (size_t)n0 * D, (float*)(F.ws + WS_WA + j * W_AT_STRIDE + W_QKVS) + n0); }
        else { const int r = u - 2 * 288, j = r / 96, mi = (r % 96) / 32, n0 = (r % 32) * 32;
            conv8_cols32(F, F.in[I_WRKV] + (size_t)(j * 3 + mi) * D * D + n0, D, (signed char*)(F.ws + WS_W + j * W_RW_STRIDE + W_RKV) + (size_t)(mi * D + n0) * D, (float*)(F.ws + WS_W + j * W_RW_STRIDE + W_RKVS) + mi * D + n0); }
    }
    const int gt = blockIdx.x * NTHREADS + F.tid, NGT = F.G * NTHREADS;
    for (int j = 0; j < 2; ++j) {
        bf16* ldn = (bf16*)(F.ws + WS_W + j * W_RW_STRIDE + W_LDN);
        const float* mu = F.in[I_MU] + (size_t)j * 6 * D;
        for (int i0 = gt; i0 < 512 * 2048; i0 += 8 * NGT) { float t[8];
#pragma unroll
            for (int u = 0; u < 8; ++u) { const int i = i0 + u * NGT; float v = 0.f;
                if (i < 512 * 2048) { const int n = i >> 11, k = i & 2047, kk = k & 1023; int mi;
                    if (n < 256) { const int blk = n >> 6, z = blk >> 1, isA = blk & 1, nn = n & 63;
                        v = (isA ? F.in[I_A1] : F.in[I_W1])[((size_t)(j * 2 + z) * D + kk) * 64 + nn]; mi = isA ? 4 : 3; }
                    else { const int z = (n - 256) >> 7, nn = n & 127; v = F.in[I_G1][((size_t)(j * 2 + z) * D + kk) * 128 + nn]; mi = 5; }
                    if (k >= 1024) v *= mu[mi * D + kk]; }
                t[u] = v; }
#pragma unroll
            for (int u = 0; u < 8; ++u) { const int i = i0 + u * NGT; if (i < 512 * 2048) ldn[i] = (bf16)f2bf(t[u]); } }
        bf16* lwa = (bf16*)(F.ws + WS_W + j * W_RW_STRIDE + W_LUPWA);
        for (int i0 = gt; i0 < 4096 * 128; i0 += 8 * NGT) { float t[8];
#pragma unroll
            for (int u = 0; u < 8; ++u) { const int i = i0 + u * NGT; float v = 0.f;
                if (i < 4096 * 128) { const int n = i >> 7, k = i & 127; const int z = n >> 11, isA = (n >> 10) & 1, col = n & 1023;
                    if ((k >> 6) == isA) v = (isA ? F.in[I_A2] : F.in[I_W2])[((size_t)(j * 2 + z) * 64 + (k & 63)) * D + col]; }
                t[u] = v; }
#pragma unroll
            for (int u = 0; u < 8; ++u) { const int i = i0 + u * NGT; if (i < 4096 * 128) lwa[i] = (bf16)f2bf(t[u]); } }
        bf16* lg = (bf16*)(F.ws + WS_W + j * W_RW_STRIDE + W_LUPG);
        for (int i0 = gt; i0 < 2048 * 128; i0 += 8 * NGT) { float t[8];
#pragma unroll
            for (int u = 0; u < 8; ++u) { const int i = i0 + u * NGT; float v = 0.f;
                if (i < 2048 * 128) { const int n = i >> 7, k = i & 127; const int z = n >> 10, col = n & 1023; v = F.in[I_G2][((size_t)(j * 2 + z) * 128 + k) * D + col]; }
                t[u] = v; }
#pragma unroll
            for (int u = 0; u < 8; ++u) { const int i = i0 + u * NGT; if (i < 2048 * 128) lg[i] = (bf16)f2bf(t[u]); } }
    }
}

__device__ __forceinline__ void moe_tables(Frame& F, int l) {
    LAS int* tileE = (LAS int*)(F.lds + TILEE_OFF); LAS int* tileJ = (LAS int*)(F.lds + TILEJ_OFF); LAS int* offs = (LAS int*)(F.lds + OFFS_OFF); LAS int* cl = (LAS int*)(F.lds + CNTL_OFF);
    const unsigned* cnt = (const unsigned*)(F.ws + WS_CTL) + CW_CNT + l * 32;
    if (F.tid < 32) cl[F.tid] = (int)__hip_atomic_load(cnt + F.tid, __ATOMIC_RELAXED, __HIP_MEMORY_SCOPE_AGENT);
    __syncthreads();
    if (F.tid < 32) {
        int tb = 0;
#pragma clang loop unroll(disable)
        for (int e = 0; e < F.tid; ++e) tb += (cl[e] + 255) >> 8;
        const int ne = (cl[F.tid] + 255) >> 8; offs[F.tid] = tb * 256;
#pragma clang loop unroll(disable)
        for (int k = 0; k < ne; ++k) if (tb + k < 160) { tileE[tb + k] = F.tid; tileJ[tb + k] = k; }
        if (F.tid == 31) { const int nt = tb + ne; tileE[160] = nt < 160 ? nt : 160; offs[32] = nt * 256; }
    }
    __syncthreads();
}
__device__ __forceinline__ void rw_hrow(Frame& F, int l, bool combine, const void* xsrc, bf16* xdst, bool own, int row, f32x4 (&h)[4]) {
    const int b = row >> 11; const float* mod = (const float*)(F.ws + WS_MOD);
    f32x4 x[4]; if (l == 0) row_load((const float*)xsrc + (size_t)row * D, F.lane, x); else row_load_bf16((const bf16*)xsrc + (size_t)row * D, F.lane, x);
    if (combine) { row_combine(x, (const bf16*)(F.ws + WS_ACT + A_YS), TokTab{(const int*)(F.ws + WS_TOKE), (const int*)(F.ws + WS_TOKR), (const LAS int*)(F.lds + OFFS_OFF)}, row, mod + (size_t)((l - 1) * 8 + b) * 6144 + 5 * D, F.lane);
        if (own) row_store_bf16(xdst + (size_t)row * D, F.lane, x); }
    const float* mp = mod + (size_t)(l * 8 + b) * 6144;
    row_norm_mod(x, F.in[I_NTM] + l * D, mp + 1 * D, mp + 0 * D, F.lane, h);
}
__device__ __forceinline__ void phase_rw_norm(Frame& F, int l, bool combine, const void* xsrc, bf16* xdst) {
    if (combine) moe_tables(F, l - 1);
    const int j = l >> 1; const float* mu = F.in[I_MU] + (size_t)j * 6 * D;
    signed char* xs = (signed char*)(F.ws + WS_ACT + A_XS); bf16* hx = (bf16*)(F.ws + WS_ACT + A_HX); float* sxs = (float*)(F.ws + WS_SCL + SCL_XS);
    for (int ch = F.gw; ch < T / 8; ch += F.NGW) {
        const int row0 = ch * 8, t0 = row0 & (SEQ - 1);
        f32x4 prev[4], cur[4], nxt[4];
        if (t0 > 0) rw_hrow(F, l, combine, xsrc, xdst, false, row0 - 1, prev);
        else {
#pragma unroll
            for (int q = 0; q < 4; ++q) prev[q] = (f32x4){0.f, 0.f, 0.f, 0.f}; }
        rw_hrow(F, l, combine, xsrc, xdst, true, row0, cur);
        for (int i = 0; i < 8; ++i) {
            const int row = row0 + i;
            if (t0 + i + 1 < SEQ) rw_hrow(F, l, combine, xsrc, xdst, i < 7, row + 1, nxt);
            else {
#pragma unroll
                for (int q = 0; q < 4; ++q) nxt[q] = (f32x4){0.f, 0.f, 0.f, 0.f}; }
            f32x4 xx[4];
#pragma unroll
            for (int q = 0; q < 4; ++q) xx[q] = 0.5f * (prev[q] + nxt[q]) - cur[q];
#pragma unroll
            for (int mi = 0; mi < 3; ++mi) { f32x4 o[4];
#pragma unroll
                for (int q = 0; q < 4; ++q) { const f32x4 m = *(const f32x4*)(mu + mi * D + 4 * F.lane + 256 * q); o[q] = cur[q] + xx[q] * m; }
                row_store_i8(xs + ((size_t)mi * T + row) * D, sxs + (size_t)mi * T + row, F.lane, o); }
            row_store_bf16(hx + (size_t)row * 2048, F.lane, cur);
            row_store_bf16(hx + (size_t)row * 2048 + D, F.lane, xx);
#pragma unroll
            for (int q = 0; q < 4; ++q) { prev[q] = cur[q]; cur[q] = nxt[q]; }
        }
    }
}

struct RowPipe { u32x2 xr[4], ya[4], yb[4]; int p0, p1; };
#define RP_IDX(P_, r_) do { P_.p0 = offs_[toke_[2 * (r_)]] + tokr_[2 * (r_)]; P_.p1 = offs_[toke_[2 * (r_) + 1]] + tokr_[2 * (r_) + 1]; } while (0)
#define RP_LOAD(P_, r_) do { _Pragma("unroll") for (int j_ = 0; j_ < 4; ++j_) { P_.xr[j_] = *(const u32x2*)(xsrc + (size_t)(r_) * D + 4 * F.lane + 256 * j_); \
        P_.ya[j_] = *(const u32x2*)(ys_ + (size_t)P_.p0 * D + 4 * F.lane + 256 * j_); P_.yb[j_] = *(const u32x2*)(ys_ + (size_t)P_.p1 * D + 4 * F.lane + 256 * j_); } } while (0)
#define RP_COMBINE(P_, x_, gac_) do { _Pragma("unroll") for (int j_ = 0; j_ < 4; ++j_) { const u32x2 r_ = P_.xr[j_], a_ = P_.ya[j_], b_ = P_.yb[j_]; \
        x_[j_][0] = bf_lo(r_.x) + gac_[j_][0] * (bf_lo(a_.x) + bf_lo(b_.x)); x_[j_][1] = bf_hi(r_.x) + gac_[j_][1] * (bf_hi(a_.x) + bf_hi(b_.x)); \
        x_[j_][2] = bf_lo(r_.y) + gac_[j_][2] * (bf_lo(a_.y) + bf_lo(b_.y)); x_[j_][3] = bf_hi(r_.y) + gac_[j_][3] * (bf_hi(a_.y) + bf_hi(b_.y)); } } while (0)
__device__ __forceinline__ void phase_at_norm(Frame& F, int l, const bf16* xsrc, bf16* xdst) {
    moe_tables(F, l - 1);
    const float* mod = (const float*)(F.ws + WS_MOD); signed char* H8 = (signed char*)(F.ws + WS_ACT + A_H); float* SA = (float*)(F.ws + WS_SA);
    const bf16* ys_ = (const bf16*)(F.ws + WS_ACT + A_YS); const int* toke_ = (const int*)(F.ws + WS_TOKE); const int* tokr_ = (const int*)(F.ws + WS_TOKR); const LAS int* offs_ = (const LAS int*)(F.lds + OFFS_OFF);
    for (int base = F.gw * 8; base < T; base += F.NGW * 8) {
        const int b = base >> 11;
        f32x4 gac[4], gcv[4], shv[4];
        { const float* mp = mod + (size_t)(l * 8 + b) * 6144; const float* gp = mod + (size_t)((l - 1) * 8 + b) * 6144 + 5 * D;
#pragma unroll
          for (int j = 0; j < 4; ++j) { gac[j] = *(const f32x4*)(gp + 4 * F.lane + 256 * j); const f32x4 g = *(const f32x4*)(F.in[I_NTM] + l * D + 4 * F.lane + 256 * j), c = *(const f32x4*)(mp + 1 * D + 4 * F.lane + 256 * j);
              gcv[j] = g * (1.0f + c); shv[j] = *(const f32x4*)(mp + 0 * D + 4 * F.lane + 256 * j); } }
        RowPipe P; RP_IDX(P, base); RP_LOAD(P, base); int q0 = 0, q1 = 0;
        { const int r1 = base + 1; q0 = offs_[toke_[2 * r1]] + tokr_[2 * r1]; q1 = offs_[toke_[2 * r1 + 1]] + tokr_[2 * r1 + 1]; }
#pragma clang loop unroll(disable)
        for (int i = 0; i < 8; ++i) {
            const int row = base + i;
            f32x4 x[4], h[4]; RP_COMBINE(P, x, gac);
            if (i < 7) { P.p0 = q0; P.p1 = q1; RP_LOAD(P, row + 1); const int r2 = (i < 6) ? row + 2 : row + 1; q0 = offs_[toke_[2 * r2]] + tokr_[2 * r2]; q1 = offs_[toke_[2 * r2 + 1]] + tokr_[2 * r2 + 1]; }
            row_store_bf16(xdst + (size_t)row * D, F.lane, x);
            { float ss = 0.f;
#pragma unroll
              for (int j = 0; j < 4; ++j) ss += (x[j][0] * x[j][0] + x[j][1] * x[j][1]) + (x[j][2] * x[j][2] + x[j][3] * x[j][3]);
              const float rstd = rsqrtf(wave_sum(ss, F.lane) * (1.0f / D) + RMS_EPS);
#pragma unroll
              for (int j = 0; j < 4; ++j) h[j] = x[j] * rstd * gcv[j] + shv[j]; }
            float am = 0.f;
#pragma unroll
            for (int j = 0; j < 4; ++j) am = fmaxf(am, fmaxf(fmaxf(fabsf(h[j][0]), fabsf(h[j][1])), fmaxf(fabsf(h[j][2]), fabsf(h[j][3]))));
            am = fmaxf(wave_max(am), 1e-20f); const float inv = 127.0f / am;
            if (F.lane == 0) SA[row] = am * (1.0f / 127.0f);
#pragma unroll
            for (int j = 0; j < 4; ++j) *(unsigned*)(H8 + (size_t)row * D + 4 * F.lane + 256 * j) = pack_i8x4(h[j], inv);
        }
    }
}
__device__ __forceinline__ void phase_final(Frame& F, const bf16* xsrc) {
    moe_tables(F, DEPTH - 1);
    const float* mod = (const float*)(F.ws + WS_MOD); const float* fg = F.in[I_FG];
    const bf16* ys_ = (const bf16*)(F.ws + WS_ACT + A_YS); const int* toke_ = (const int*)(F.ws + WS_TOKE); const int* tokr_ = (const int*)(F.ws + WS_TOKR); const LAS int* offs_ = (const LAS int*)(F.lds + OFFS_OFF);
    for (int base = F.gw * 8; base < T; base += F.NGW * 8) {
        const int b = base >> 11;
        f32x4 gac[4], fgv[4];
#pragma unroll
        for (int j = 0; j < 4; ++j) { gac[j] = *(const f32x4*)(mod + (size_t)(3 * 8 + b) * 6144 + 5 * D + 4 * F.lane + 256 * j); fgv[j] = *(const f32x4*)(fg + 4 * F.lane + 256 * j); }
        RowPipe P; RP_IDX(P, base); RP_LOAD(P, base); int q0 = 0, q1 = 0;
        { const int r1 = base + 1; q0 = offs_[toke_[2 * r1]] + tokr_[2 * r1]; q1 = offs_[toke_[2 * r1 + 1]] + tokr_[2 * r1 + 1]; }
#pragma clang loop unroll(disable)
        for (int i = 0; i < 8; ++i) {
            const int row = base + i;
            f32x4 x[4]; RP_COMBINE(P, x, gac);
            if (i < 7) { P.p0 = q0; P.p1 = q1; RP_LOAD(P, row + 1); const int r2 = (i < 6) ? row + 2 : row + 1; q0 = offs_[toke_[2 * r2]] + tokr_[2 * r2]; q1 = offs_[toke_[2 * r2 + 1]] + tokr_[2 * r2 + 1]; }
            float s = 0.f;
#pragma unroll
            for (int j = 0; j < 4; ++j) s += (x[j][0] * x[j][0] + x[j][1] * x[j][1]) + (x[j][2] * x[j][2] + x[j][3] * x[j][3]);
            const float rstd = rsqrtf(wave_sum(s, F.lane) * (1.0f / D) + RMS_EPS);
#pragma unroll
            for (int j = 0; j < 4; ++j) x[j] = x[j] * rstd * fgv[j];
            row_store(F.out + (size_t)row * D, F.lane, x);
        }
    }
}
#undef RP_IDX
#undef RP_LOAD
#undef RP_COMBINE

__device__ __forceinline__ void moe_convert(Frame& F, int l, int bfirst, int bstride);
__device__ __forceinline__ void phase_moe_route(Frame& F, int l, const bf16* xsrc, int cnt_shift = 0) {
    const float* mod = (const float*)(F.ws + WS_MOD); bf16* HN = (bf16*)(F.ws + WS_ACT + A_HN2);
    LAS int* lcnt = (LAS int*)F.lds; LAS int* gbase = lcnt + 32; LAS int* inf_e = lcnt + 64; LAS int* inf_r = inf_e + 128; LAS float* inf_w = (LAS float*)(inf_r + 128);
    unsigned* cnt = (unsigned*)(F.ws + WS_CTL) + CW_CNT + (l + cnt_shift) * 32;
    int* toke = (int*)(F.ws + WS_TOKE); int* tokr = (int*)(F.ws + WS_TOKR); float* tokw = (float*)(F.ws + WS_TOKW);
    const float* rg = F.in[I_RG] + (size_t)l * D * 4; const float* rgb = F.in[I_RGB] + l * 4;
    LAS float* RW = (LAS float*)(F.lds + 4096);
    {
      f32x4 tg[2];
#pragma unroll
      for (int u = 0; u < 2; ++u) tg[u] = *(const f32x4*)(rg + 4 * (F.tid + u * NTHREADS));
      const float* rea = F.in[I_RE] + (size_t)l * 4 * D * 8;
      f32x4 te[4][2];
#pragma unroll
      for (int u = 0; u < 4; ++u) { const int p = F.tid + u * NTHREADS; te[u][0] = *(const f32x4*)(rea + 8 * p); te[u][1] = *(const f32x4*)(rea + 8 * p + 4); }
#pragma unroll
      for (int u = 0; u < 2; ++u) { const int k = F.tid + u * NTHREADS;
#pragma unroll
          for (int e = 0; e < 4; ++e) RW[e * D + k] = tg[u][e]; }
#pragma unroll
      for (int hh = 0; hh < 2; ++hh) {
          if (hh == 1) {
#pragma unroll
              for (int u = 0; u < 4; ++u) { const int p = F.tid + (4 + u) * NTHREADS; te[u][0] = *(const f32x4*)(rea + 8 * p); te[u][1] = *(const f32x4*)(rea + 8 * p + 4); } }
#pragma unroll
          for (int u = 0; u < 4; ++u) { const int p = F.tid + (4 * hh + u) * NTHREADS; const int g = p >> 10, k = p & 1023;
#pragma unroll
              for (int e = 0; e < 8; ++e) RW[(4 + g * 8 + e) * D + k] = te[u][e >> 2][e & 3]; } } }
    for (int cb = blockIdx.x; cb < T / 64; cb += F.G) {
        if (F.tid < 32) lcnt[F.tid] = 0;
        __syncthreads();
        f32x4 gcv[4], shv[4];
        { const float* mp = mod + (size_t)(l * 8 + ((cb * 64) >> 11)) * 6144;
#pragma unroll
          for (int j = 0; j < 4; ++j) { const f32x4 g = *(const f32x4*)(F.in[I_NCM] + l * D + 4 * F.lane + 256 * j), c = *(const f32x4*)(mp + 4 * D + 4 * F.lane + 256 * j); gcv[j] = g * (1.0f + c); shv[j] = *(const f32x4*)(mp + 3 * D + 4 * F.lane + 256 * j); } }
        u32x2 raw[4];
#pragma unroll
        for (int j = 0; j < 4; ++j) raw[j] = *(const u32x2*)(xsrc + (size_t)(cb * 64 + F.wave * 8) * D + 4 * F.lane + 256 * j);
#pragma clang loop unroll(disable)
        for (int i = 0; i < 8; ++i) {
            const int lr = F.wave * 8 + i, row = cb * 64 + lr;
            f32x4 x[4], h[4];
#pragma unroll
            for (int j = 0; j < 4; ++j) x[j] = (f32x4){bf_lo(raw[j].x), bf_hi(raw[j].x), bf_lo(raw[j].y), bf_hi(raw[j].y)};
            { const int rn = (i < 7) ? row + 1 : row;
#pragma unroll
              for (int j = 0; j < 4; ++j) raw[j] = *(const u32x2*)(xsrc + (size_t)rn * D + 4 * F.lane + 256 * j); }
            { float ss = 0.f;
#pragma unroll
              for (int j = 0; j < 4; ++j) ss += (x[j][0] * x[j][0] + x[j][1] * x[j][1]) + (x[j][2] * x[j][2] + x[j][3] * x[j][3]);
              const float rstd = rsqrtf(wave_sum(ss, F.lane) * (1.0f / D) + RMS_EPS);
#pragma unroll
              for (int j = 0; j < 4; ++j) h[j] = x[j] * rstd * gcv[j] + shv[j]; }
            row_store_i8((signed char*)HN + (size_t)row * D, (float*)(F.ws + WS_SCL + SCL_HN) + row, F.lane, h);
            float gl[4] = {0.f, 0.f, 0.f, 0.f};
#pragma unroll
            for (int e = 0; e < 4; ++e)
#pragma unroll
                for (int j = 0; j < 4; ++j) { const f32x4 w = *(const LAS f32x4*)(RW + e * D + 4 * F.lane + 256 * j); gl[e] += (h[j][0] * w[0] + h[j][1] * w[1]) + (h[j][2] * w[2] + h[j][3] * w[3]); }
#pragma unroll
            for (int e = 0; e < 4; ++e) gl[e] = wave_sum(gl[e], F.lane) + rgb[e];
            const float gm = fmaxf(fmaxf(gl[0], gl[1]), fmaxf(gl[2], gl[3]));
            const int gtop = (gl[0] == gm) ? 0 : (gl[1] == gm) ? 1 : (gl[2] == gm) ? 2 : 3;
            const float pg = 1.0f / (__expf(gl[0] - gm) + __expf(gl[1] - gm) + __expf(gl[2] - gm) + __expf(gl[3] - gm));
            const float* reb = F.in[I_REB] + (l * 4 + gtop) * 8; const LAS float* rwe = RW + (4 + gtop * 8) * D + 4 * F.lane;
            float el[8];
#pragma unroll
            for (int e = 0; e < 8; ++e) { el[e] = 0.f;
#pragma unroll
                for (int j = 0; j < 4; ++j) { const f32x4 w = *(const LAS f32x4*)(rwe + e * D + 256 * j); el[e] += (h[j][0] * w[0] + h[j][1] * w[1]) + (h[j][2] * w[2] + h[j][3] * w[3]); } }
#pragma unroll
            for (int e = 0; e < 8; ++e) el[e] = wave_sum(el[e], F.lane) + reb[e];
            float v0 = el[0]; int i0 = 0;
#pragma unroll
            for (int e = 1; e < 8; ++e) if (el[e] > v0) { v0 = el[e]; i0 = e; }
            float v1 = -3.0e38f; int i1 = 0;
#pragma unroll
            for (int e = 0; e < 8; ++e) if (e != i0 && el[e] > v1) { v1 = el[e]; i1 = e; }
            const float ex = __expf(v1 - v0); const float w0 = pg / (1.0f + ex), w1 = pg * ex / (1.0f + ex);
            if (F.lane == 0) {
                const int e0 = gtop * 8 + i0, e1 = gtop * 8 + i1;
                const int r0 = __hip_atomic_fetch_add(lcnt + e0, 1, __ATOMIC_RELAXED, __HIP_MEMORY_SCOPE_WORKGROUP);
                const int r1 = __hip_atomic_fetch_add(lcnt + e1, 1, __ATOMIC_RELAXED, __HIP_MEMORY_SCOPE_WORKGROUP);
                inf_e[lr * 2] = e0; inf_e[lr * 2 + 1] = e1; inf_r[lr * 2] = r0; inf_r[lr * 2 + 1] = r1; inf_w[lr * 2] = w0; inf_w[lr * 2 + 1] = w1;
            }
        }
        __syncthreads();
        if (F.tid < 32) gbase[F.tid] = (int)__hip_atomic_fetch_add(cnt + F.tid, (unsigned)lcnt[F.tid], __ATOMIC_RELAXED, __HIP_MEMORY_SCOPE_AGENT);
        __syncthreads();
        if (F.tid < 128) { const int idx = cb * 128 + F.tid; const int e = inf_e[F.tid]; const int rk = gbase[e] + inf_r[F.tid]; toke[idx] = e; tokr[idx] = rk;
            ((int*)(F.ws + WS_ACT + A_LSTT))[(size_t)e * LCAP + rk] = idx >> 1; ((float*)(F.ws + WS_ACT + A_LSTW))[(size_t)e * LCAP + rk] = inf_w[F.tid]; }
        __syncthreads();
    }
    if (l == 0 && cnt_shift == 0) moe_convert(F, 0, (int)blockIdx.x, F.G);
}
__device__ __forceinline__ void moe_convert(Frame& F, int l, int bfirst, int bstride) {
    LAS float* scr = (LAS float*)(F.lds + 49152 + F.wave * 8704);
    signed char* WGU = (signed char*)(F.ws + ws_wm_of(l) + W_GU); float* SGU = (float*)(F.ws + ws_wm_of(l) + W_GUS); bf16* WDN = (bf16*)(F.ws + ws_wm_of(l) + W_DN);
    for (int it = bfirst; it < NEXP * 16; it += bstride) {
        const int e = it >> 4, up = (it >> 3) & 1, nb = it & 7, n0 = nb * 32;
        const int drow = (n0 >> 7) * 256 + up * 128 + (n0 & 127);
        conv8_cols32(F, (up ? F.in[I_WU] : F.in[I_WG]) + (size_t)(l * 32 + e) * D * FEXP + n0, FEXP, WGU + ((size_t)e * 512 + drow) * D, SGU + (size_t)e * 512 + drow);
    }
    for (int it = bfirst * NWAVES + F.wave; it < NEXP * 128; it += bstride * NWAVES) {
        const int e = it >> 7, r = it & 127; const int kb = r / 32, nb = r % 32;
        const float* src = F.in[I_WD] + ((size_t)(l * 32 + e) * FEXP + kb * 64) * D + nb * 32;
        transpose_item(src, D, WDN + ((size_t)e * D + nb * 32) * FEXP + kb * 64, FEXP, scr, F.lane);
    }
}

#ifndef SCAN_DUP
#define SCAN_DUP 0
#endif
namespace wk {
constexpr int P = 72, PB = 144, MAT = 64 * PB;
constexpr int PF = 68;
constexpr int O_NAB = 0, O_GS = 17408, O_GC = 19456, O_M0 = 20480;
constexpr int O_AT = O_M0, O_RT = O_AT + MAT, O_BT = O_RT + MAT, O_KT = O_BT + MAT, O_VV = O_KT + MAT, O_LAK = O_VV + MAT, O_MRB = O_LAK + MAT, O_MRK = O_MRB + MAT,
              O_NB = O_MRK + MAT, O_TT = O_NB + MAT, O_XT = O_TT + MAT, O_UT = O_XT + MAT, O_MT = O_UT + MAT, O_H0 = O_MT + MAT, O_H1 = O_H0 + MAT, O_END = O_H1 + MAT;
static_assert(O_END <= LDS_MISC, "scan LDS map");
typedef union { u32x4 u; bf16x8 v; } frag_t;
__device__ __forceinline__ bf16x8 zfrag() { frag_t z; z.u = (u32x4){0u, 0u, 0u, 0u}; return z.v; }
__device__ __forceinline__ bf16x8 ldrow(const LAS unsigned char* M, int row, int col) { return *(const LAS bf16x8*)(M + row * PB + col * 2); }
__device__ __forceinline__ bf16x8 ldtr(unsigned base, int r0, int c0, int lane) {
    const int g = lane >> 4, i = lane & 15, qq = i >> 2, p = i & 3;
    const unsigned a0 = base + (unsigned)((r0 + 8 * g + qq) * PB + (c0 + 4 * p) * 2), a1 = a0 + 4u * PB;
    u32x2 lo, hi;
    asm volatile("ds_read_b64_tr_b16 %0, %2\n\tds_read_b64_tr_b16 %1, %3\n\ts_waitcnt lgkmcnt(0)" : "=&v"(lo), "=&v"(hi) : "v"(a0), "v"(a1) : "memory");
    frag_t f; f.u.x = lo.x; f.u.y = lo.y; f.u.z = hi.x; f.u.w = hi.y; return f.v;
}
__device__ __forceinline__ void st4bf(LAS unsigned char* M, int row, int col, const f32x4& v) { u32x2 w; w.x = pk2(v[0], v[1]); w.y = pk2(v[2], v[3]); *(LAS u32x2*)(M + row * PB + col * 2) = w; }
#define WK_MFMA(a, b, c) __builtin_amdgcn_mfma_f32_16x16x32_bf16(a, b, c, 0, 0, 0)
template <int M> __device__ __forceinline__ float rshare(float v) { return __int_as_float(__builtin_amdgcn_update_dpp(0, __float_as_int(v), 0x150 + M, 0xf, 0xf, false)); }
#define WK_BAR() do { asm volatile("s_waitcnt lgkmcnt(0)" ::: "memory"); __builtin_amdgcn_s_barrier(); asm volatile("" ::: "memory"); } while (0)
}

__device__ __forceinline__ void phase_scan(Frame& F, int l) {
    using namespace wk;
    const int j = l >> 1;
    const bf16* Rb = (const bf16*)(F.ws + WS_ACT + A_RKV); const bf16* Kb = Rb + (size_t)T * D; const bf16* Vb = Kb + (size_t)T * D;
    const bf16* LD = (const bf16*)(F.ws + WS_ACT + A_LDEC); const bf16* AS = (const bf16*)(F.ws + WS_ACT + A_ASIG);
    bf16* Y = (bf16*)(F.ws + WS_ACT + A_Y); float* SB = (float*)(F.ws + WS_SB);
    LAS unsigned char* L = F.lds; const unsigned La = (unsigned)(size_t)L;
    LAS float* NAB = (LAS float*)(L + O_NAB); LAS float* GS = (LAS float*)(L + O_GS); LAS float* GC = (LAS float*)(L + O_GC);
    const int tid0 = F.tid, wave = F.wave;
    for (int unit = blockIdx.x; unit < NB * NH_R * 2; unit += F.G) {
        const int b = unit >> 5, h = (unit >> 1) & 15, dir = unit & 1; const int col = h * 64 + 8 * (tid0 & 7);
        f32x4 kkc[2], kac[2], rkc[2];
#pragma unroll
        for (int e = 0; e < 2; ++e) { kkc[e] = *(const f32x4*)(F.in[I_KK] + j * D + col + 4 * e); kac[e] = *(const f32x4*)(F.in[I_KA] + j * D + col + 4 * e); rkc[e] = *(const f32x4*)(F.in[I_RK] + j * D + col + 4 * e); }
        for (int i = tid0; i < (O_END - O_LAK) / 16; i += NTHREADS) *(LAS u32x4*)(L + O_LAK + i * 16) = (u32x4){0u, 0u, 0u, 0u};
        f32x4 Hs[4];
        f32x4 Yh[4];
#define WK_YFLUSH(cc) do { if (wave >= 4) { const int lane_ = tid0 & 63, qi_ = lane_ & 15, q4_ = lane_ >> 4, vj_ = wave - 4; \
            _Pragma("unroll") for (int ti_ = 0; ti_ < 4; ++ti_) _Pragma("unroll") for (int r_ = 0; r_ < 4; ++r_) { const int st_ = (cc) * 64 + 16 * ti_ + 4 * q4_ + r_; const int t_ = dir ? (SEQ - 1 - st_) : st_; \
                Y[((size_t)dir * T + (size_t)b * SEQ + t_) * D + h * 64 + 16 * vj_ + qi_] = (bf16)f2bf(Yh[ti_][r_]); } } } while (0)
#pragma unroll
        for (int vj = 0; vj < 4; ++vj) Hs[vj] = (f32x4){0.f, 0.f, 0.f, 0.f};
        u32x4 gr, gk, gv, gl, ga;
#define WK_LOAD(c) do { const int st = (c) * 64 + (tid0 >> 3); const int t = dir ? (SEQ - 1 - st) : st; const size_t ro = ((size_t)b * SEQ + t) * D + col; \
            gr = *(const u32x4*)(Rb + ro); gk = *(const u32x4*)(Kb + ro); gv = *(const u32x4*)(Vb + ro); gl = *(const u32x4*)(LD + (size_t)dir * T * D + ro); ga = *(const u32x4*)(AS + (size_t)dir * T * D + ro); } while (0)
        WK_LOAD(0);
        WK_BAR();
        for (int c = 0; c < SEQ / 64; ++c) {
            int tid = tid0; asm volatile("" : "+v"(tid));
            const int lane = tid & 63, qi = lane & 15, q4 = lane >> 4, pt = tid >> 3, c8 = tid & 7;
            LAS unsigned char* H0 = L + ((c & 1) ? O_H1 : O_H0); LAS unsigned char* H1 = L + ((c & 1) ? O_H0 : O_H1);
            for (int sd0_ = 0; sd0_ < 1 + ((SCAN_DUP >> 0) & 1); ++sd0_) {
            float av[8], bv[8], kdv[8], rv[8], ldv[8];
            {
                const unsigned gku[4] = {gk.x, gk.y, gk.z, gk.w}, gru[4] = {gr.x, gr.y, gr.z, gr.w}, glu[4] = {gl.x, gl.y, gl.z, gl.w}, gau[4] = {ga.x, ga.y, ga.z, ga.w};
                float kf[8], af[8], kkv[8]; float ss = 0.f;
#pragma unroll
                for (int e = 0; e < 4; ++e) { kf[2 * e] = bf_lo(gku[e]); kf[2 * e + 1] = bf_hi(gku[e]); rv[2 * e] = bf_lo(gru[e]); rv[2 * e + 1] = bf_hi(gru[e]);
                    ldv[2 * e] = bf_lo(glu[e]); ldv[2 * e + 1] = bf_hi(glu[e]); af[2 * e] = bf_lo(gau[e]); af[2 * e + 1] = bf_hi(gau[e]); }
#pragma unroll
                for (int e = 0; e < 8; ++e) { kkv[e] = kf[e] * kkc[e >> 2][e & 3]; ss += kkv[e] * kkv[e]; }
                ss = sum8(ss);
                const float inv = 1.0f / fmaxf(sqrtf(ss), 1e-12f); float bo = 0.f;
#pragma unroll
                for (int e = 0; e < 8; ++e) { const float kn = kkv[e] * inv; kdv[e] = kf[e] * (1.0f + (af[e] - 1.0f) * kac[e >> 2][e & 3]); av[e] = -kn; bv[e] = kn * af[e]; bo += rv[e] * kdv[e] * rkc[e >> 2][e & 3]; }
                bo = sum8(bo);
                const int st = c * 64 + pt; const int t = dir ? (SEQ - 1 - st) : st;
                if (c8 == 0) SB[((size_t)dir * T + (size_t)b * SEQ + t) * 16 + h] = bo;
                *(LAS f32x4*)(NAB + pt * PF + 8 * c8) = (f32x4){ldv[0], ldv[1], ldv[2], ldv[3]}; *(LAS f32x4*)(NAB + pt * PF + 8 * c8 + 4) = (f32x4){ldv[4], ldv[5], ldv[6], ldv[7]};
                *(LAS u32x4*)(L + O_VV + pt * PB + 16 * c8) = gv;
            }
            if (sd0_ == ((SCAN_DUP >> 0) & 1)) { if (c > 0) WK_YFLUSH(c - 1); if (c + 1 < SEQ / 64) WK_LOAD(c + 1); }
            WK_BAR();
            { const int kc = tid & 63, g = tid >> 6; float pre[8]; float p = 0.f;
#pragma unroll
              for (int i = 0; i < 8; ++i) { p += NAB[(8 * g + i) * PF + kc]; pre[i] = p; }
              GS[g * 64 + kc] = p;
              WK_BAR();
              float off = 0.f;
#pragma unroll
              for (int gg = 0; gg < 7; ++gg) off += (gg < g) ? GS[gg * 64 + kc] : 0.f;
#pragma unroll
              for (int i = 0; i < 8; ++i) NAB[(8 * g + i) * PF + kc] = off + pre[i]; }
            WK_BAR();
            { f32x4 cl[2], cm[2];
#pragma unroll
              for (int e = 0; e < 2; ++e) { cl[e] = *(const LAS f32x4*)(NAB + pt * PF + 8 * c8 + 4 * e); cm[e] = (pt > 0) ? *(const LAS f32x4*)(NAB + (pt - 1) * PF + 8 * c8 + 4 * e) : (f32x4){0.f, 0.f, 0.f, 0.f}; }
              float oa[8], orr[8], ob[8], ok[8];
#pragma unroll
              for (int e = 0; e < 8; ++e) { const float c1 = cl[e >> 2][e & 3], c0 = cm[e >> 2][e & 3]; const float gp = __builtin_amdgcn_exp2f(c1), gn = __builtin_amdgcn_exp2f(-c1), g0 = __builtin_amdgcn_exp2f(c0);
                  oa[e] = av[e] * g0; orr[e] = rv[e] * gp; ob[e] = bv[e] * gn; ok[e] = kdv[e] * gn; if (pt == 63) GC[8 * c8 + e] = gp; }
              *(LAS u32x4*)(L + O_AT + pt * PB + 16 * c8) = (u32x4){pk2(oa[0], oa[1]), pk2(oa[2], oa[3]), pk2(oa[4], oa[5]), pk2(oa[6], oa[7])};
              *(LAS u32x4*)(L + O_RT + pt * PB + 16 * c8) = (u32x4){pk2(orr[0], orr[1]), pk2(orr[2], orr[3]), pk2(orr[4], orr[5]), pk2(orr[6], orr[7])};
              *(LAS u32x4*)(L + O_BT + pt * PB + 16 * c8) = (u32x4){pk2(ob[0], ob[1]), pk2(ob[2], ob[3]), pk2(ob[4], ob[5]), pk2(ob[6], ob[7])};
              *(LAS u32x4*)(L + O_KT + pt * PB + 16 * c8) = (u32x4){pk2(ok[0], ok[1]), pk2(ok[2], ok[3]), pk2(ok[4], ok[5]), pk2(ok[6], ok[7])}; }
            WK_BAR();
            }
            f32x4 X0[4], Y0[4];
            for (int sd1_ = 0; sd1_ < 1 + ((SCAN_DUP >> 1) & 1); ++sd1_) {
#pragma unroll
            for (int jj = 0; jj < 5; ++jj) {
                const int idx = wave * 5 + jj, blk = idx / 10, tri = idx % 10;
                const int ti = (tri >= 6) ? 3 : ((tri >= 3) ? 2 : ((tri >= 1) ? 1 : 0)); const int si = tri - (ti * (ti + 1)) / 2;
                const LAS unsigned char* Pm = L + ((blk < 2) ? O_AT : O_RT); const LAS unsigned char* Qm = L + ((blk & 1) ? O_KT : O_BT);
                f32x4 acc = {0.f, 0.f, 0.f, 0.f};
#pragma unroll
                for (int ks = 0; ks < 2; ++ks) acc = WK_MFMA(ldrow(Qm, 16 * si + qi, 32 * ks + 8 * q4), ldrow(Pm, 16 * ti + qi, 32 * ks + 8 * q4), acc);
                const int tt = 16 * ti + qi, s0 = 16 * si + 4 * q4;
#pragma unroll
                for (int r = 0; r < 4; ++r) { const int sidx = s0 + r; const bool keep = (blk < 2) ? (sidx < tt) : (sidx <= tt); acc[r] = keep ? acc[r] : 0.f; }
                if (blk == 0) { *(LAS f32x4*)(NAB + tt * PF + s0) = acc; st4bf(L + O_NB, tt, s0, acc); }
                else st4bf(L + (blk == 1 ? O_LAK : (blk == 2 ? O_MRB : O_MRK)), tt, s0, acc);
            }
            WK_BAR();
            }
            for (int sd2_ = 0; sd2_ < 1 + ((SCAN_DUP >> 2) & 1); ++sd2_) {
            if (wave >= 4) { const int vj = wave - 4;
#pragma unroll
                for (int ti = 0; ti < 4; ++ti) { X0[ti] = (f32x4){0.f, 0.f, 0.f, 0.f}; Y0[ti] = (f32x4){0.f, 0.f, 0.f, 0.f};
#pragma unroll
                    for (int ks = 0; ks < 2; ++ks) if (ks <= (ti >> 1)) { const bf16x8 vf = ldtr(La + O_VV, 32 * ks, 16 * vj, lane);
                        X0[ti] = WK_MFMA(ldrow(L + O_LAK, 16 * ti + qi, 32 * ks + 8 * q4), vf, X0[ti]); Y0[ti] = WK_MFMA(ldrow(L + O_MRK, 16 * ti + qi, 32 * ks + 8 * q4), vf, Y0[ti]); } } }
            if (wave == 0) {
                const int blk = q4, cj = qi; float nrow[16], x[16];
#pragma unroll
                for (int r = 0; r < 16; ++r) nrow[r] = NAB[(16 * blk + r) * PF + 16 * blk + cj];
#pragma unroll
                for (int r = 0; r < 16; ++r) { float acc = (r == cj) ? 1.0f : 0.0f;
#define WK_SUBM(m) if (m < r) acc += wk::rshare<m>(nrow[r]) * x[m];
                    WK_SUBM(0) WK_SUBM(1) WK_SUBM(2) WK_SUBM(3) WK_SUBM(4) WK_SUBM(5) WK_SUBM(6) WK_SUBM(7) WK_SUBM(8) WK_SUBM(9) WK_SUBM(10) WK_SUBM(11) WK_SUBM(12) WK_SUBM(13) WK_SUBM(14)
#undef WK_SUBM
                    x[r] = acc; *(LAS bf16*)(L + O_TT + (16 * blk + r) * PB + (16 * blk + cj) * 2) = (bf16)f2bf(acc); }
            }
            WK_BAR();
            if (wave < 2) {
                const int i = 2 * wave + 1, jb = 2 * wave;
                { bf16x8 a = ldrow(L + O_NB, 16 * i + qi, 16 * jb + 8 * (q4 & 1)), bfr = ldtr(La + O_TT, 16 * jb - 8 * (q4 & 2), 16 * jb, lane);
                  if (q4 >= 2) { a = zfrag(); bfr = zfrag(); }
                  f32x4 acc = {0.f, 0.f, 0.f, 0.f}; acc = WK_MFMA(a, bfr, acc);
                  st4bf(L + O_MT, 16 * wave + qi, 4 * q4, acc); }
                asm volatile("s_waitcnt lgkmcnt(0)" ::: "memory");
                { bf16x8 a = ldrow(L + O_TT, 16 * i + qi, 16 * i + 8 * (q4 & 1)), bfr = ldrow(L + O_MT, 16 * wave + qi, 8 * (q4 & 1));
                  if (q4 >= 2) { a = zfrag(); bfr = zfrag(); }
                  f32x4 acc = {0.f, 0.f, 0.f, 0.f}; acc = WK_MFMA(a, bfr, acc);
#pragma unroll
                  for (int r = 0; r < 4; ++r) *(LAS bf16*)(L + O_TT + (16 * i + 4 * q4 + r) * PB + (16 * jb + qi) * 2) = (bf16)f2bf(acc[r]); }
            }
            WK_BAR();
            if (wave < 4) {
                const int ti2 = wave >> 1, tj2 = wave & 1;
                { const bf16x8 bfr = ldtr(La + O_TT, 0, 16 * tj2, lane);
#pragma unroll
                  for (int tt = 0; tt < 2; ++tt) { f32x4 acc = {0.f, 0.f, 0.f, 0.f}; acc = WK_MFMA(ldrow(L + O_NB, 32 + 16 * tt + qi, 8 * q4), bfr, acc); st4bf(L + O_MT, 32 + 16 * tj2 + qi, 16 * tt + 4 * q4, acc); } }
                asm volatile("s_waitcnt lgkmcnt(0)" ::: "memory");
                { f32x4 acc = {0.f, 0.f, 0.f, 0.f}; acc = WK_MFMA(ldrow(L + O_TT, 32 + 16 * ti2 + qi, 32 + 8 * q4), ldrow(L + O_MT, 32 + 16 * tj2 + qi, 8 * q4), acc);
#pragma unroll
                  for (int r = 0; r < 4; ++r) *(LAS bf16*)(L + O_TT + (32 + 16 * ti2 + 4 * q4 + r) * PB + (16 * tj2 + qi) * 2) = (bf16)f2bf(acc[r]); }
            }
            }
            for (int sd3_ = 0; sd3_ < 1 + ((SCAN_DUP >> 3) & 1); ++sd3_) {
            if (wave >= 4) { const int vj = wave - 4;
#pragma unroll
                for (int ti = 0; ti < 4; ++ti) { f32x4 acc = X0[ti];
#pragma unroll
                    for (int ks = 0; ks < 2; ++ks) acc = WK_MFMA(ldrow(L + O_AT, 16 * ti + qi, 32 * ks + 8 * q4), ldrow(H0, 16 * vj + qi, 32 * ks + 8 * q4), acc);
                    st4bf(L + O_XT, 16 * vj + qi, 16 * ti + 4 * q4, acc); } }
            WK_BAR();
#pragma unroll
            for (int e = 0; e < 2; ++e) { const int id = wave * 2 + e, ti = id >> 2, vj = id & 3; f32x4 acc = {0.f, 0.f, 0.f, 0.f};
#pragma unroll
                for (int ks = 0; ks < 2; ++ks) if (ks <= (ti >> 1)) acc = WK_MFMA(ldrow(L + O_TT, 16 * ti + qi, 32 * ks + 8 * q4), ldrow(L + O_XT, 16 * vj + qi, 32 * ks + 8 * q4), acc);
                st4bf(L + O_UT, 16 * vj + qi, 16 * ti + 4 * q4, acc); }
            WK_BAR();
            }
            f32x4 Hsave[4]; for (int vj_ = 0; vj_ < 4; ++vj_) Hsave[vj_] = Hs[vj_];
            for (int sd5_ = 0; sd5_ < 1 + ((SCAN_DUP >> 4) & 1); ++sd5_) {
            for (int vj_ = 0; vj_ < 4; ++vj_) Hs[vj_] = Hsave[vj_];
            if (wave >= 4) { const int vj = wave - 4;
#pragma unroll
                for (int ti = 0; ti < 4; ++ti) { f32x4 acc = Y0[ti];
#pragma unroll
                    for (int ks = 0; ks < 2; ++ks) { acc = WK_MFMA(ldrow(L + O_RT, 16 * ti + qi, 32 * ks + 8 * q4), ldrow(H0, 16 * vj + qi, 32 * ks + 8 * q4), acc);
                        if (ks <= (ti >> 1)) acc = WK_MFMA(ldrow(L + O_MRB, 16 * ti + qi, 32 * ks + 8 * q4), ldrow(L + O_UT, 16 * vj + qi, 32 * ks + 8 * q4), acc); }
                    Yh[ti] = acc; } }
            else { const int kt = wave; const f32x4 gc = *(const LAS f32x4*)(GC + 16 * kt + 4 * q4);
#pragma unroll
                for (int ks = 0; ks < 2; ++ks) { const bf16x8 bt = ldtr(La + O_BT, 32 * ks, 16 * kt, lane), ktf = ldtr(La + O_KT, 32 * ks, 16 * kt, lane);
#pragma unroll
                    for (int vj = 0; vj < 4; ++vj) { Hs[vj] = WK_MFMA(bt, ldrow(L + O_UT, 16 * vj + qi, 32 * ks + 8 * q4), Hs[vj]); Hs[vj] = WK_MFMA(ktf, ldtr(La + O_VV, 32 * ks, 16 * vj, lane), Hs[vj]); } }
#pragma unroll
                for (int vj = 0; vj < 4; ++vj) { Hs[vj] = Hs[vj] * gc; st4bf(H1, 16 * vj + qi, 16 * kt + 4 * q4, Hs[vj]); } }
            WK_BAR();
            }
        }
        WK_YFLUSH(SEQ / 64 - 1);
#undef WK_LOAD
#undef WK_YFLUSH
    }
}

__device__ __forceinline__ void phase_rw_post(Frame& F, int l) {
    const int j = l >> 1; const float* lnw = F.in[I_LNW] + j * D; const float* lnb = F.in[I_LNB] + j * D;
    const bf16* Vb = (const bf16*)(F.ws + WS_ACT + A_RKV) + (size_t)2 * T * D; const bf16* Y = (const bf16*)(F.ws + WS_ACT + A_Y); const bf16* Gb = (const bf16*)(F.ws + WS_ACT + A_G);
    const float* SB = (const float*)(F.ws + WS_SB); bf16* O = (bf16*)(F.ws + WS_ACT + A_O);
    for (int row = F.gw; row < T; row += F.NGW) {
        f32x4 o[4];
#pragma unroll
        for (int q = 0; q < 4; ++q) {
            const int c = 4 * F.lane + 256 * q; const int head = 4 * q + (F.lane >> 4);
            const u32x2 vr = *(const u32x2*)(Vb + (size_t)row * D + c); const f32x4 vf = {bf_lo(vr.x), bf_hi(vr.x), bf_lo(vr.y), bf_hi(vr.y)};
            const f32x4 w = *(const f32x4*)(lnw + c), bb = *(const f32x4*)(lnb + c);
            f32x4 acc = {0.f, 0.f, 0.f, 0.f};
#pragma unroll
            for (int dir = 0; dir < 2; ++dir) {
                const size_t ro = ((size_t)dir * T + row) * D + c;
                const u32x2 yr = *(const u32x2*)(Y + ro), gr = *(const u32x2*)(Gb + ro);
                const f32x4 yf = {bf_lo(yr.x), bf_hi(yr.x), bf_lo(yr.y), bf_hi(yr.y)}; const f32x4 gf = {bf_lo(gr.x), bf_hi(gr.x), bf_lo(gr.y), bf_hi(gr.y)};
                const float sbv = SB[((size_t)dir * T + row) * 16 + head];
                const float mean = rowsum16((yf[0] + yf[1]) + (yf[2] + yf[3])) * (1.0f / 64.0f);
                const f32x4 d = yf - mean; const float var = rowsum16((d[0] * d[0] + d[1] * d[1]) + (d[2] * d[2] + d[3] * d[3])) * (1.0f / 64.0f);
                const float rs = rsqrtf(var + GN_EPS);
                acc += gf * (d * rs * w + bb + sbv * vf);
            }
            o[q] = acc;
        }
        row_store_bf16(O + (size_t)row * D, F.lane, o);
    }
}

__device__ __forceinline__ unsigned att_f(unsigned row) { return ((row & 3u) << 2) | ((row >> 2) & 3u); }
__device__ __forceinline__ unsigned att_off_b(unsigned row, unsigned ch) { return 256u * row + 16u * (ch ^ att_f(row)); }
__device__ __forceinline__ void phase_attn(Frame& F, bool dry = false) {
    bf16* Qb = (bf16*)(F.ws + WS_ACT + A_Q); const bf16* Kb = (const bf16*)(F.ws + WS_ACT + A_K); const bf16* Vb = (const bf16*)(F.ws + WS_ACT + A_VT);
    float* LSE = (float*)(F.ws + WS_SB);
    const int lane = F.lane, qi = lane & 15, q4 = lane >> 4, wave = F.wave;
    LAS unsigned char* KW = F.lds; LAS unsigned char* VW = F.lds + 9 * 8192;
    const unsigned vw_a = (unsigned)(size_t)VW;
    unsigned ka[2][4], va[8][2];
#pragma unroll
    for (int rb = 0; rb < 2; ++rb)
#pragma unroll
        for (int s = 0; s < 4; ++s) ka[rb][s] = att_off_b((unsigned)(qi + 16 * rb), (unsigned)(4 * s + q4));
    { const unsigned q = (unsigned)qi >> 2, p = (unsigned)lane & 3u;
#pragma unroll
      for (int c = 0; c < 8; ++c)
#pragma unroll
          for (int t = 0; t < 2; ++t) va[c][t] = vw_a + att_off_b(8u * q4 + 4u * t + q, 2u * c + (p >> 1)) + 8u * (p & 1u); }
    constexpr int NU = 3 * NB * 8 * 16;
    const int per = (NU + F.G - 1) / F.G; const int n0 = (int)blockIdx.x * per; const int n1 = min(NU, n0 + per);
#define ATT_DECODE(n_, g_, b_, hs_, cls_, chunk_) const int g_ = (n_) >> 10, b_ = ((n_) >> 7) & 7, hs_ = ((n_) >> 4) & 7; const int cc##g_ = (n_) & 15; \
        const int cls_ = (g_ == 0) ? 0 : ((g_ == 1) ? (cc##g_ >> 2) : cc##g_); const int chunk_ = (g_ == 0) ? cc##g_ : ((g_ == 1) ? (cc##g_ & 3) : 0);
#define ATT_DMA(gp_, la_) asm volatile("s_mov_b32 m0, %0\n\ts_nop 0\n\tglobal_load_lds_dwordx4 %1, off" :: "s"(la_), "v"(gp_) : "m0", "memory")
#define ATT_LOAD_TILES(g_, b_, hs_, cls_, chunk_, first_, nt_, beta_) do { const int tb_ = (first_) + ((nt_) == 2 ? (wave >> 2) : 0); const int dsh_ = 2 * (g_); const int pos0_ = 128 * (chunk_) - 64 + 32 * tb_; \
        if (pos0_ >= 0 && pos0_ < (SEQ >> dsh_)) { const int slot_ = (tb_ + (beta_)) % 9; \
            const bf16* ksrc_ = Kb + ((size_t)(g_) * T + (size_t)(b_) * SEQ) * D + (hs_) * 128; const bf16* vsrc_ = Vb + ((size_t)(g_) * T + (size_t)(b_) * SEQ) * D + (hs_) * 128; \
            _Pragma("unroll") for (int ii_ = 0; ii_ < (nt_); ++ii_) { const int i_ = ((nt_) == 2) ? (2 * (wave & 3) + ii_) : wave; const unsigned rho_ = 4u * (unsigned)i_ + (unsigned)q4, m_ = rho_ & 15u, rb_ = rho_ >> 4; \
                const int kidx_ = (int)(8u * (m_ >> 2) + (m_ & 3u) + 4u * rb_); const unsigned coff_ = 16u * ((unsigned)qi ^ att_f(rho_)); \
                ATT_DMA((const char*)(ksrc_ + (size_t)((cls_) + ((pos0_ + kidx_) << dsh_)) * D) + coff_, (unsigned)(size_t)KW + (unsigned)(slot_ * 8192 + i_ * 1024)); \
                ATT_DMA((const char*)(vsrc_ + (size_t)((cls_) + ((pos0_ + (int)rho_) << dsh_)) * D) + coff_, vw_a + (unsigned)(slot_ * 8192 + i_ * 1024)); } } } while (0)
    int beta = 0;
    bf16x8 Qn[4]; u32x2 Op[8]; float lsep = 0.f; bf16* qpp = Qb; float* lsepp = LSE;
#pragma unroll
    for (int dt = 0; dt < 8; ++dt) Op[dt] = (u32x2){0u, 0u};
#pragma unroll
    for (int kt = 0; kt < 4; ++kt) Qn[kt] = (bf16x8){0, 0, 0, 0, 0, 0, 0, 0};
    for (int n = n0; n < n1; ++n) {
        ATT_DECODE(n, g, b, hs, cls, chunk)
        const int dsh = 2 * g, Lg = SEQ >> dsh; const int P0 = 128 * chunk;
        asm volatile("s_waitcnt lgkmcnt(0)" ::: "memory"); __builtin_amdgcn_s_barrier(); asm volatile("" ::: "memory");
        const int Pq = P0 + 16 * wave + qi; const size_t qrow = (size_t)g * T + (size_t)b * SEQ + (size_t)(cls + (Pq << dsh));
        bf16* qp = Qb + qrow * D + hs * 128;
        bf16x8 Qf[4];
        if (n == n0) {
            ATT_LOAD_TILES(g, b, hs, cls, chunk, 0, 2, beta); ATT_LOAD_TILES(g, b, hs, cls, chunk, 2, 2, beta); ATT_LOAD_TILES(g, b, hs, cls, chunk, 4, 2, beta); ATT_LOAD_TILES(g, b, hs, cls, chunk, 6, 2, beta);
#pragma unroll
            for (int kt = 0; kt < 4; ++kt) Qf[kt] = *(const bf16x8*)(qp + 8 * q4 + 32 * kt);
        } else {
#pragma unroll
            for (int kt = 0; kt < 4; ++kt) Qf[kt] = Qn[kt];
        }
        const float slope2 = exp2f(-8.0f * (float)(g * 8 + hs + 1) / 24.0f) * LOG2E * (float)(1 << dsh);
        float m_run = -1e30f, l_run = 0.f; f32x4 O[8];
#pragma unroll
        for (int dt = 0; dt < 8; ++dt) O[dt] = (f32x4){0.f, 0.f, 0.f, 0.f};
        asm volatile("s_waitcnt vmcnt(0)" ::: "memory"); __builtin_amdgcn_s_barrier(); asm volatile("" ::: "memory");
        asm volatile("" : "+v"(Qf[0]), "+v"(Qf[1]), "+v"(Qf[2]), "+v"(Qf[3]));
        if (n > n0 && !dry) {
#pragma unroll
            for (int dt = 0; dt < 8; ++dt) *(u32x2*)(qpp + 4 * q4 + 16 * dt) = Op[dt];
            if (q4 == 0) *lsepp = lsep; }
        const bool has_next = (n + 1 < n1);
        if (has_next) { ATT_DECODE(n + 1, gx, bx, hsx, clsx, chunkx)
            if (chunkx == 0) ATT_LOAD_TILES(gx, bx, hsx, clsx, chunkx, 2, 2, beta + 4);
            ATT_LOAD_TILES(gx, bx, hsx, clsx, chunkx, 4, 1, beta + 4);
            const int Pqx = 128 * chunkx + 16 * wave + qi; const bf16* qx = Qb + ((size_t)gx * T + (size_t)bx * SEQ + (size_t)(clsx + (Pqx << (2 * gx)))) * D + hsx * 128;
#pragma unroll
            for (int kt = 0; kt < 4; ++kt) Qn[kt] = *(const bf16x8*)(qx + 8 * q4 + 32 * kt); }
#pragma unroll
        for (int s = 0; s < 5; ++s) {
            const int tb = (wave >> 1) + s; const int pos0 = P0 - 64 + 32 * tb;
            if (pos0 >= 0 && pos0 < Lg) {
            const int slot = (tb + beta) % 9; const LAS unsigned char* kl = KW + slot * 8192; const unsigned voff = (unsigned)slot * 8192u;
            union { u32x4 u; bf16x8 v; } KA[4], KB[4];
            { const unsigned kla = (unsigned)(size_t)kl;
              asm volatile("ds_read_b128 %0, %8\n\tds_read_b128 %1, %9\n\tds_read_b128 %2, %10\n\tds_read_b128 %3, %11\n\t"
                           "ds_read_b128 %4, %12\n\tds_read_b128 %5, %13\n\tds_read_b128 %6, %14\n\tds_read_b128 %7, %15\n\ts_waitcnt lgkmcnt(0)"
                           : "=&v"(KA[0].u), "=&v"(KB[0].u), "=&v"(KA[1].u), "=&v"(KB[1].u), "=&v"(KA[2].u), "=&v"(KB[2].u), "=&v"(KA[3].u), "=&v"(KB[3].u)
                           : "v"(kla + ka[0][0]), "v"(kla + ka[1][0]), "v"(kla + ka[0][1]), "v"(kla + ka[1][1]), "v"(kla + ka[0][2]), "v"(kla + ka[1][2]), "v"(kla + ka[0][3]), "v"(kla + ka[1][3])
                           : "memory"); }
            f32x4 SA = {0.f, 0.f, 0.f, 0.f}, SBt = {0.f, 0.f, 0.f, 0.f};
#pragma unroll
            for (int kt = 0; kt < 4; ++kt) { SA = __builtin_amdgcn_mfma_f32_16x16x32_bf16(KA[kt].v, Qf[kt], SA, 0, 0, 0); SBt = __builtin_amdgcn_mfma_f32_16x16x32_bf16(KB[kt].v, Qf[kt], SBt, 0, 0, 0); }
            const int cb = pos0 + 8 * q4;
            float sv[8]; bool ok[8]; float mx = -1e30f;
#pragma unroll
            for (int r = 0; r < 8; ++r) { const int p = cb + r; const int rel = abs(p - Pq); ok[r] = (rel <= 64);
                const float sc = (r < 4 ? SA[r & 3] : SBt[r & 3]) - slope2 * (float)rel; sv[r] = ok[r] ? sc : -1e30f; mx = fmaxf(mx, sv[r]); }
            mx = bfly16_max(mx); mx = bfly32_max(mx);
            const float m_new = fmaxf(m_run, mx); const float alpha = __builtin_amdgcn_exp2f(m_run - m_new); m_run = m_new;
            float pe[8]; float rs = 0.f;
#pragma unroll
            for (int r = 0; r < 8; ++r) { pe[r] = ok[r] ? __builtin_amdgcn_exp2f(sv[r] - m_new) : 0.f; rs += pe[r]; }
            rs = bfly16_sum(rs); rs = bfly32_sum(rs);
            l_run = l_run * alpha + rs;
            union { u32x4 u; bf16x8 v; } pf; pf.u.x = pk2(pe[0], pe[1]); pf.u.y = pk2(pe[2], pe[3]); pf.u.z = pk2(pe[4], pe[5]); pf.u.w = pk2(pe[6], pe[7]);
#pragma unroll
            for (int hf = 0; hf < 2; ++hf) {
                u32x2 vr[4][2];
                asm volatile("ds_read_b64_tr_b16 %0, %8\n\tds_read_b64_tr_b16 %1, %9\n\tds_read_b64_tr_b16 %2, %10\n\tds_read_b64_tr_b16 %3, %11\n\t"
                             "ds_read_b64_tr_b16 %4, %12\n\tds_read_b64_tr_b16 %5, %13\n\tds_read_b64_tr_b16 %6, %14\n\tds_read_b64_tr_b16 %7, %15\n\ts_waitcnt lgkmcnt(0)"
                             : "=&v"(vr[0][0]), "=&v"(vr[0][1]), "=&v"(vr[1][0]), "=&v"(vr[1][1]), "=&v"(vr[2][0]), "=&v"(vr[2][1]), "=&v"(vr[3][0]), "=&v"(vr[3][1])
                             : "v"(va[4 * hf + 0][0] + voff), "v"(va[4 * hf + 0][1] + voff), "v"(va[4 * hf + 1][0] + voff), "v"(va[4 * hf + 1][1] + voff), "v"(va[4 * hf + 2][0] + voff), "v"(va[4 * hf + 2][1] + voff), "v"(va[4 * hf + 3][0] + voff), "v"(va[4 * hf + 3][1] + voff)
                             : "memory");
#pragma unroll
                for (int c = 0; c < 4; ++c) { const int dt = 4 * hf + c; union { u32x4 u; bf16x8 v; } vf; vf.u.x = vr[c][0].x; vf.u.y = vr[c][0].y; vf.u.z = vr[c][1].x; vf.u.w = vr[c][1].y;
                    O[dt] = O[dt] * alpha; O[dt] = __builtin_amdgcn_mfma_f32_16x16x32_bf16(vf.v, pf.v, O[dt], 0, 0, 0); }
            }
            }
            if (s == 1 || s == 2) {
                asm volatile("s_waitcnt lgkmcnt(0)" ::: "memory"); __builtin_amdgcn_s_barrier(); asm volatile("" ::: "memory");
                if (has_next) { ATT_DECODE(n + 1, gy, by, hsy, clsy, chunky) if (s == 1) ATT_LOAD_TILES(gy, by, hsy, clsy, chunky, 5, 2, beta + 4); else ATT_LOAD_TILES(gy, by, hsy, clsy, chunky, 7, 1, beta + 4); }
            }
        }
        const float inv = 1.0f / l_run;
#pragma unroll
        for (int dt = 0; dt < 8; ++dt) { Op[dt].x = pk2(O[dt][0] * inv, O[dt][1] * inv); Op[dt].y = pk2(O[dt][2] * inv, O[dt][3] * inv); if (dry) asm volatile("" :: "v"(Op[dt].x), "v"(Op[dt].y)); }
        lsep = m_run + __builtin_amdgcn_logf(l_run); qpp = qp; lsepp = LSE + qrow * 8 + hs;
        beta = (beta + 4) % 9;
    }
    if (n1 > n0 && !dry) {
#pragma unroll
        for (int dt = 0; dt < 8; ++dt) *(u32x2*)(qpp + 4 * q4 + 16 * dt) = Op[dt];
        if (q4 == 0) *lsepp = lsep; }
#undef ATT_DECODE
#undef ATT_LOAD_TILES
#undef ATT_DMA
}
__device__ __forceinline__ void phase_attn_merge(Frame& F) {
    const bf16* Ob = (const bf16*)(F.ws + WS_ACT + A_Q); const float* LSE = (const float*)(F.ws + WS_SB); bf16* AO = (bf16*)(F.ws + WS_ACT + A_AO);
    for (int row = F.gw; row < T; row += F.NGW) {
        f32x4 o[4];
#pragma unroll
        for (int q = 0; q < 4; ++q) { const int c = 4 * F.lane + 256 * q; const int head = 2 * q + (F.lane >> 5);
            float ls[3];
#pragma unroll
            for (int g = 0; g < 3; ++g) ls[g] = LSE[((size_t)g * T + row) * 8 + head];
            const float mx = fmaxf(ls[0], fmaxf(ls[1], ls[2]));
            float w[3]; float sum = 0.f;
#pragma unroll
            for (int g = 0; g < 3; ++g) { w[g] = __builtin_amdgcn_exp2f(ls[g] - mx); sum += w[g]; }
            const float inv = 1.0f / sum; f32x4 acc = {0.f, 0.f, 0.f, 0.f};
#pragma unroll
            for (int g = 0; g < 3; ++g) { const u32x2 r = *(const u32x2*)(Ob + ((size_t)g * T + row) * D + c); const float a = w[g] * inv;
                acc[0] += a * bf_lo(r.x); acc[1] += a * bf_hi(r.x); acc[2] += a * bf_lo(r.y); acc[3] += a * bf_hi(r.y); }
            o[q] = acc; }
        row_store_bf16(AO + (size_t)row * D, F.lane, o);
    }
}

constexpr int PH_PER_LAYER = 10, N_PHASES = 1 + DEPTH * PH_PER_LAYER + 1;
template <int MASK> __global__ void __launch_bounds__(NTHREADS, 2) mk_fwd(Args args) {
    extern __shared__ __attribute__((aligned(16))) unsigned char lds_raw[];
#define PHASE_FRAME() Frame F; { int t_ = wave0 * 64 + lane_id_nh(); asm volatile("" : "+v"(t_)); size_t z_ = 0; asm volatile("" : "+s"(z_)); unsigned char* w_ = args.ws + z_;     \
        unsigned lb_ = 0; asm volatile("" : "+s"(lb_)); F.lds = (LAS unsigned char*)lds_raw + lb_; F.tid = t_; F.lane = t_ & 63; F.wave = __builtin_amdgcn_readfirstlane(t_ >> 6); \
        F.G = gridDim.x; F.gw = blockIdx.x * NWAVES + F.wave; F.NGW = F.G * NWAVES; F.ws = w_; F.in = args.in; F.out = args.out; }
    LAS unsigned char* lds0 = (LAS unsigned char*)lds_raw;
    const int wave0 = __builtin_amdgcn_readfirstlane((int)threadIdx.x >> 6);
    volatile LAS unsigned* MISC = (volatile LAS unsigned*)(lds0 + MISC_OFF);
    if (wave0 == 0) ((LAS unsigned*)(lds0 + LDS_MISC))[lane_id_nh() + 64] = 0u;
    __syncthreads();
    unsigned* ctl = (unsigned*)(args.ws + WS_CTL);
    XcdBarrier bar; bar.bar = ctl + CW_BAR; bar.x = 0; bar.st = nullptr;
#if ONE_LAUNCH
    bar = xcd_barrier_post(ctl + CW_BAR, MISC + 8, wave0 == 0 && lane_id_nh() == 0);
#endif
    const int lo = args.ph_lo, hi = args.ph_hi;
#define EN(b) ((MASK >> (b)) & 1)
#ifndef DUP_MASK
#define DUP_MASK 0
#endif
#define REP(b) for (int rep_ = 0; rep_ < 1 + ((DUP_MASK >> (b)) & 1); ++rep_)
#define IN(k) (lo <= (k) && (k) < hi)
#if ONE_LAUNCH
#ifndef BAR_REP
#define BAR_REP 1
#endif
#define SEAM(k) do { if (IN((k) + 1) || (k) + 1 < hi) { for (int br_ = 0; br_ < BAR_REP; ++br_) xcd_barrier(bar, wave0 == 0 && lane_id_nh() == 0); } } while (0)
#else
#define SEAM(k) do { } while (0)
#endif
    bf16* X0 = (bf16*)(args.ws + WS_X1); bf16* X1 = X0 + (size_t)T * D;
    if (EN(0) && IN(0)) { PHASE_FRAME(); REP(0) phase_prologue(F); SEAM(0); }
    for (int l = 0; l < DEPTH; ++l) {
        const int pb = 1 + l * PH_PER_LAYER; const int j = l >> 1;
        const void* xin = (l == 0) ? (const void*)args.in[I_X] : (const void*)((l & 1) ? X0 : X1);
        bf16* xcur = (l == 0) ? X0 : ((l & 1) ? X1 : X0);
        if ((l & 1) == 0) {
            if (EN(1) && IN(pb + 0)) { PHASE_FRAME(); REP(1) phase_rw_norm(F, l, l > 0, xin, xcur); SEAM(pb + 0); }
            if (EN(2) && IN(pb + 1)) { REP(2) {
                { PHASE_FRAME(); DenseSched S; S.o.init(T / 256, 2, F.G, blockIdx.x); S.A = (const char*)(F.ws + WS_ACT + A_HX); S.a_sel_stride = 0; S.pn_per_a = 1 << 20;
                  S.B = (const char*)(F.ws + WS_W + j * W_RW_STRIDE + W_LDN); S.tstepA = (size_t)256 * 2048 * 2; S.tstepB = (size_t)256 * 2048 * 2;
                  EpiLoraDn E{(bf16*)(F.ws + WS_ACT + A_LORAH)};
                  pg8::gemm_phase(F.lds, F.tid, 2048, 2048, 2048, S, E); }
                { PHASE_FRAME(); DenseSched S; S.o.init(T / 256, 12, F.G, blockIdx.x); S.o.uneven = (F.G == 256); S.A = (const char*)(F.ws + WS_ACT + A_XS); S.a_sel_stride = (size_t)T * D; S.pn_per_a = 4;
                  S.B = (const char*)(F.ws + WS_W + j * W_RW_STRIDE + W_RKV); S.tstepA = (size_t)256 * D; S.tstepB = (size_t)256 * D;
                  EpiI8<EpiSplit> E{EpiSplit{(bf16*)(F.ws + WS_ACT + A_RKV), (size_t)T * D, 1.0f}, (const float*)(F.ws + WS_SCL + SCL_XS), (size_t)T, 4, (const float*)(F.ws + WS_W + j * W_RW_STRIDE + W_RKVS)};
                  pg8::gemm_phase(F.lds, F.tid, D, D, D, S, E); }
                }
                SEAM(pb + 1);
            }
            if (EN(3) && IN(pb + 2)) { REP(3) {
                { PHASE_FRAME(); DenseSched S; S.o.init(T / 256, 16, F.G, blockIdx.x); S.A = (const char*)(F.ws + WS_ACT + A_LORAH); S.a_sel_stride = 256; S.pn_per_a = 8;
                  S.B = (const char*)(F.ws + WS_W + j * W_RW_STRIDE + W_LUPWA); S.tstepA = (size_t)256 * 512 * 2; S.tstepB = (size_t)256 * 128 * 2;
                  EpiLoraUpWA E{(bf16*)(F.ws + WS_ACT + A_LDEC), (bf16*)(F.ws + WS_ACT + A_ASIG), F.in[I_W0] + j * 2 * D, F.in[I_A0] + j * 2 * D};
                  pg8::gemm_phase(F.lds, F.tid, 128, 512, 128, S, E); }
                { PHASE_FRAME(); DenseSched S; S.o.init(T / 256, 8, F.G, blockIdx.x); S.A = (const char*)(F.ws + WS_ACT + A_LORAH) + 512; S.a_sel_stride = 256; S.pn_per_a = 4;
                  S.B = (const char*)(F.ws + WS_W + j * W_RW_STRIDE + W_LUPG); S.tstepA = (size_t)256 * 512 * 2; S.tstepB = (size_t)256 * 128 * 2;
                  EpiSplit E{(bf16*)(F.ws + WS_ACT + A_G), (size_t)T * D, 1.0f};
                  pg8::gemm_phase(F.lds, F.tid, 128, 512, 128, S, E); }
                }
                SEAM(pb + 2);
            }
            if (EN(4) && IN(pb + 3)) { PHASE_FRAME(); REP(4) phase_scan(F, l); SEAM(pb + 3); }
            if (EN(5) && IN(pb + 4)) { PHASE_FRAME(); REP(5) phase_rw_post(F, l); SEAM(pb + 4); }
            if (EN(6) && IN(pb + 5)) { PHASE_FRAME();
                DenseSched S; S.o.init(T / 256, 4, F.G, blockIdx.x); S.A = (const char*)(F.ws + WS_ACT + A_O); S.a_sel_stride = 0; S.pn_per_a = 1 << 20;
                S.B = (const char*)(F.ws + WS_W + j * W_RW_STRIDE + W_RWO); S.tstepA = (size_t)256 * D * 2; S.tstepB = (size_t)256 * D * 2;
                EpiResid E{(l == 0) ? (const void*)F.in[I_X] : (const void*)xcur, (l == 0) ? 1 : 0, xcur, (const float*)(F.ws + WS_MOD) + (size_t)l * 8 * 6144 + 2 * D};
                pg8::gemm_phase(F.lds, F.tid, D, D, D, S, E);
                SEAM(pb + 5);
            }
        } else {
            if (EN(7) && IN(pb + 0)) { PHASE_FRAME(); REP(7) phase_at_norm(F, l, (const bf16*)xin, xcur); SEAM(pb + 0); }
            if (EN(8) && IN(pb + 1)) { PHASE_FRAME(); REP(8) {
                DenseSched S; S.o.init(T / 256, 36, F.G, blockIdx.x); S.A = (const char*)(F.ws + WS_ACT + A_H); S.a_sel_stride = 0; S.pn_per_a = 1 << 20;
                S.B = (const char*)(F.ws + WS_WA + j * W_AT_STRIDE + W_QKV); S.tstepA = (size_t)256 * D; S.tstepB = (size_t)256 * D;
                EpiQKV8 E{(bf16*)(F.ws + WS_ACT + A_Q), (const float*)(F.ws + WS_SA), (const float*)(F.ws + WS_WA + j * W_AT_STRIDE + W_QKVS), 0.08838834764831845f * LOG2E};
                pg8::gemm_phase(F.lds, F.tid, D, D, D, S, E);
                }
                SEAM(pb + 1);
            }
            if (EN(9) && IN(pb + 2)) { PHASE_FRAME(); if ((DUP_MASK >> 9) & 1) phase_attn(F, true); phase_attn(F); SEAM(pb + 2); }
            if (EN(16) && IN(pb + 3)) { PHASE_FRAME(); REP(16) phase_attn_merge(F); SEAM(pb + 3); }
            if (EN(10) && IN(pb + 4)) { PHASE_FRAME();
                DenseSched S; S.o.init(T / 256, 4, F.G, blockIdx.x); S.A = (const char*)(F.ws + WS_ACT + A_AO); S.a_sel_stride = 0; S.pn_per_a = 1 << 20;
                S.B = (const char*)(F.ws + WS_WA + j * W_AT_STRIDE + W_AWO); S.tstepA = (size_t)256 * D * 2; S.tstepB = (size_t)256 * D * 2;
                EpiResid E{(const void*)xcur, 0, xcur, (const float*)(F.ws + WS_MOD) + (size_t)l * 8 * 6144 + 2 * D};
                pg8::gemm_phase(F.lds, F.tid, D, D, D, S, E);
                SEAM(pb + 4);
            }
        }
        if (EN(11) && IN(pb + 6)) { PHASE_FRAME(); if ((DUP_MASK >> 11) & 1) phase_moe_route(F, l, xcur, 4); phase_moe_route(F, l, xcur); SEAM(pb + 6); }
        if (EN(13) && IN(pb + 8)) { PHASE_FRAME();
            moe_tables(F, l);
            MoeGatherSched S; S.tileE = (const LAS int*)(F.lds + TILEE_OFF); S.ntiles = uni(S.tileE[160]); S.G = F.G; S.c = blockIdx.x;
            S.A = (const char*)(F.ws + WS_ACT + A_HN2); S.B = (const char*)(F.ws + ws_wm_of(l) + W_GU); S.tstepB = (size_t)256 * D; S.estride = (size_t)512 * D;
            LAS int* rt = (LAS int*)(F.lds + MOE_TAB); LAS float* wt = (LAS float*)(F.lds + MOE_TAB + 3072); LAS float* st = (LAS float*)(F.lds + MOE_TAB + 6144); S.rowtab = rt;
            { const LAS int* tileJ = (const LAS int*)(F.lds + TILEJ_OFF); const LAS int* cl = (const LAS int*)(F.lds + CNTL_OFF);
              const int* lstT = (const int*)(F.ws + WS_ACT + A_LSTT); const float* lstW = (const float*)(F.ws + WS_ACT + A_LSTW); const float* sat = (const float*)(F.ws + WS_SCL + SCL_HN);
              for (int i = F.tid; i < 3 * 256; i += NTHREADS) { const int L = (i >> 8) * F.G + (int)blockIdx.x; int tok = 0; float w = 0.f;
                  if (L < S.ntiles * 2) { const int m = L >> 1, e = S.tileE[m], rk = tileJ[m] * 256 + (i & 255); if (rk < cl[e]) { tok = lstT[(size_t)e * LCAP + rk]; w = lstW[(size_t)e * LCAP + rk]; } }
                  rt[i] = tok; wt[i] = w; st[i] = sat[tok]; }
              __syncthreads(); }
            EpiGateUp8 E{(bf16*)(F.ws + WS_ACT + A_HID), wt, st, (const float*)(F.ws + ws_wm_of(l) + W_GUS), (const LAS int*)(F.lds + TILEE_OFF)};
            pg8::gemm_phase(F.lds, F.tid, D, D, D, S, E);
            if (l + 1 < DEPTH) {
                const int nun = S.ntiles * 2, firstb = (nun > F.G) ? (nun - F.G) : 0;
                if ((int)blockIdx.x >= firstb) moe_convert(F, l + 1, (int)blockIdx.x - firstb, F.G - firstb);
            }
            SEAM(pb + 8);
        }
        if (EN(14) && IN(pb + 9)) { PHASE_FRAME(); REP(14) {
            moe_tables(F, l);
            MoeSched S; S.tileE = (const LAS int*)(F.lds + TILEE_OFF); S.ntiles = uni(S.tileE[160]); S.npn = 4; S.G = F.G; S.c = blockIdx.x;
            S.A = (const char*)(F.ws + WS_ACT + A_HID); S.B = (const char*)(F.ws + ws_wm_of(l) + W_DN); S.tstepA = (size_t)256 * FEXP * 2; S.tstepB = (size_t)256 * FEXP * 2; S.estride = (size_t)D * FEXP * 2;
            EpiPlain E{(bf16*)(F.ws + WS_ACT + A_YS)};
            pg8::gemm_phase(F.lds, F.tid, FEXP, FEXP, FEXP, S, E);
            }
            SEAM(pb + 9);
        }
    }
    if (EN(15) && IN(N_PHASES - 1)) { PHASE_FRAME(); phase_final(F, X1); }
#undef IN
#undef SEAM
}

typedef void (*kern_t)(Args);
template <int B> static kern_t kern_of_bit(int b) { if (b == B) return mk_fwd<(1 << B)>; if constexpr (B > 0) return kern_of_bit<B - 1>(b); else return nullptr; }
static int kind_of_phase(int p) {
    if (p == 0) return 0; if (p == N_PHASES - 1) return 15;
    const int l = (p - 1) / PH_PER_LAYER, k = (p - 1) % PH_PER_LAYER;
    if (k >= 6) return (k == 7) ? -1 : 11 + (k - 6);
    if ((l & 1) == 0) return 1 + k;
    return (k < 3) ? 7 + k : (k == 3 ? 16 : (k == 4 ? 10 : -1));
}
extern "C" void kernel_launch(void* const* d_in, const int* in_sizes, int n_in, void* d_out, int out_size, void* d_ws, size_t ws_size, hipStream_t stream) {
    static int grid = 0;
    if (grid == 0) {
        if (n_in != 32 || out_size != T * D || ws_size < WS_END) { fprintf(stderr, "kernel_launch: unexpected shapes (n_in %d out %d ws %zu need %zu)\n", n_in, out_size, ws_size, (size_t)WS_END); grid = -1; return; }
        int dev = 0, cus = 0;
        if (hipGetDevice(&dev) != hipSuccess || hipDeviceGetAttribute(&cus, hipDeviceAttributeMultiprocessorCount, dev) != hipSuccess) { grid = -1; return; }
#if ONE_LAUNCH
        if (hipFuncSetAttribute((const void*)mk_fwd<0x1ffff>, hipFuncAttributeMaxDynamicSharedMemorySize, LDS_BYTES) != hipSuccess) { fprintf(stderr, "kernel_launch: hipFuncSetAttribute failed\n"); grid = -1; return; }
#else
        for (int b = 0; b < 17; ++b) if (hipFuncSetAttribute((const void*)kern_of_bit<16>(b), hipFuncAttributeMaxDynamicSharedMemorySize, LDS_BYTES) != hipSuccess) { fprintf(stderr, "kernel_launch: hipFuncSetAttribute failed\n"); grid = -1; return; }
#endif
        (void)hipGetLastError();
        grid = cus;
    }
    if (grid < 0) return;
    (void)hipMemsetAsync((char*)d_ws + WS_CTL, 0, CTL_ZERO_BYTES, stream);
    Args a{};
    for (int i = 0; i < 32; ++i) a.in[i] = (const float*)d_in[i];
    a.out = (float*)d_out; a.ws = (unsigned char*)d_ws;
#if ONE_LAUNCH
#ifndef SPLIT_EVERY
#define SPLIT_EVERY N_PHASES
#endif
    for (int p = 0; p < N_PHASES; p += SPLIT_EVERY) {
        a.ph_lo = p; a.ph_hi = (p + SPLIT_EVERY < N_PHASES) ? p + SPLIT_EVERY : N_PHASES;
        hipLaunchKernelGGL(mk_fwd<0x1ffff>, dim3(grid), dim3(NTHREADS), LDS_BYTES, stream, a);
    }
#else
    for (int p = 0; p < N_PHASES; ++p) {
        const int kind = kind_of_phase(p); if (kind < 0) continue;
        a.ph_lo = p; a.ph_hi = p + 1;
        hipLaunchKernelGGL(kern_of_bit<16>(kind), dim3(grid), dim3(NTHREADS), LDS_BYTES, stream, a);
    }
#endif
}
```

```cpp
#include <hip/hip_runtime.h>
#include <cstdio>
#include <cstdint>

#ifndef ONE_LAUNCH
#define ONE_LAUNCH 1
#endif


#define LAS __attribute__((address_space(3)))
typedef unsigned short bf16;
typedef short bf16x8 __attribute__((ext_vector_type(8)));
typedef float f32x4 __attribute__((ext_vector_type(4)));
typedef float f32x2 __attribute__((ext_vector_type(2)));
typedef unsigned u32x4 __attribute__((ext_vector_type(4)));
typedef unsigned u32x2 __attribute__((ext_vector_type(2)));

constexpr int NB = 8, SEQ = 2048, D = 1024, T = NB * SEQ, DEPTH = 4;
constexpr int NH_R = 16, HD_R = 64;
constexpr int QKVW = 9216;
constexpr int NEXP = 32, FEXP = 256;
constexpr int MAXROWS = 40960;
constexpr int NWAVES = 8, NTHREADS = 512;
constexpr float RMS_EPS = 1e-6f, GN_EPS = 64e-5f;
constexpr float LOG2E = 1.4426950408889634f;

constexpr size_t MiB = 1u << 20;
constexpr size_t WS_CTL = 0, CTL_ZERO_BYTES = 64 * 1024;
constexpr size_t WS_MOD = 1 * MiB;
constexpr size_t WS_TOKE = 2 * MiB;
constexpr size_t WS_TOKR = WS_TOKE + 128 * 1024;
constexpr size_t WS_TOKW = WS_TOKR + 128 * 1024;
constexpr size_t WS_TOKP = WS_TOKW + 128 * 1024;
constexpr size_t WS_ROWW = WS_TOKP + 128 * 1024;
constexpr size_t WS_TILEE = WS_ROWW + 192 * 1024;
constexpr size_t WS_ROWT = WS_TILEE + 4096;
constexpr size_t WS_SB = 4 * MiB;
constexpr size_t WS_SA = WS_SB + 1536 * 1024;
constexpr size_t WS_SCL = 6 * MiB;
constexpr size_t SCL_XS = 0, SCL_HN = 4 * 65536;
constexpr size_t WS_W = 8 * MiB;
constexpr size_t W_RKV = 0, W_RKVS = 3 * MiB, W_LDN = 6 * MiB, W_LUPWA = 8 * MiB, W_LUPG = 10 * MiB, W_RWO = 11 * MiB, W_RW_STRIDE = 13 * MiB;
constexpr size_t WS_WA = WS_W + 2 * W_RW_STRIDE;
constexpr size_t W_QKV = 0, W_QKVS = 9 * MiB, W_AWO = 18 * MiB, W_AT_STRIDE = 20 * MiB;
constexpr size_t WS_WM = WS_WA + 2 * W_AT_STRIDE;
constexpr size_t W_GU = 0, W_GUS = 16 * MiB, W_DN = 32 * MiB;
__host__ __device__ constexpr size_t ws_wm_of(int l);
constexpr size_t WS_X1 = 128 * MiB;
constexpr size_t WS_ACT = 192 * MiB;
constexpr size_t A_XS = 0, A_HX = 96 * MiB;
constexpr size_t A_LDEC = 0, A_ASIG = 64 * MiB, A_G = 128 * MiB;
constexpr size_t A_RKV = 192 * MiB;
constexpr size_t A_O = 192 * MiB;
constexpr size_t A_LORAH = 288 * MiB;
constexpr size_t A_Y = 304 * MiB;
constexpr size_t A_H = 0;
constexpr size_t A_Q = 32 * MiB, A_K = 128 * MiB, A_VT = 224 * MiB;
constexpr size_t A_AO = 320 * MiB;
constexpr size_t A_HN2 = 0, A_LSTT = 32 * MiB, A_LSTW = 34 * MiB, A_HID = 112 * MiB, A_YS = 288 * MiB;
constexpr int LCAP = 16384;
static_assert(A_K - A_Q == A_VT - A_K, "q/k/v spacing");
constexpr size_t WS_WM2 = WS_ACT + 368 * MiB;
constexpr size_t WS_END = WS_WM2 + 48 * MiB;

constexpr int CW_BAR = 4096;
constexpr int CW_CNT = 8192;

__host__ __device__ constexpr size_t ws_wm_of(int l) { return (l & 1) ? WS_WM2 : WS_WM; }
constexpr int LDS_BYTES = 163840;
constexpr int LDS_MISC = 159744;
constexpr int MISC_OFF = LDS_MISC + 320;
constexpr int MOE_TAB = 131072;
constexpr int TILEE_OFF = MOE_TAB + 9216, TILEJ_OFF = TILEE_OFF + 768, CNTL_OFF = TILEJ_OFF + 768;
constexpr int OFFS_OFF = CNTL_OFF + 256;

__device__ __forceinline__ float bf_lo(unsigned u) { return __uint_as_float(u << 16); }
__device__ __forceinline__ float bf_hi(unsigned u) { return __uint_as_float(u & 0xffff0000u); }
__device__ __forceinline__ float bf2f(bf16 v) { return __uint_as_float(((unsigned)v) << 16); }
__device__ __forceinline__ unsigned f2bf(float f) { __bf16 r = (__bf16)f; return (unsigned)__builtin_bit_cast(unsigned short, r); }
__device__ __forceinline__ unsigned pk2(float lo, float hi) { typedef __bf16 b2_t __attribute__((ext_vector_type(2))); typedef float f2_t __attribute__((ext_vector_type(2))); f2_t v = {lo, hi}; b2_t r = __builtin_convertvector(v, b2_t); return __builtin_bit_cast(unsigned, r); }
__device__ __forceinline__ float dpp_ror(float x, const int ctrl_sel) {
    int r;
    if (ctrl_sel == 8) r = __builtin_amdgcn_update_dpp(0, __float_as_int(x), 0x128, 0xf, 0xf, false);
    else if (ctrl_sel == 4) r = __builtin_amdgcn_update_dpp(0, __float_as_int(x), 0x124, 0xf, 0xf, false);
    else if (ctrl_sel == 2) r = __builtin_amdgcn_update_dpp(0, __float_as_int(x), 0x122, 0xf, 0xf, false);
    else r = __builtin_amdgcn_update_dpp(0, __float_as_int(x), 0x121, 0xf, 0xf, false);
    return __int_as_float(r);
}
__device__ __forceinline__ float rowsum16(float x) { x += dpp_ror(x, 8); x += dpp_ror(x, 4); x += dpp_ror(x, 2); x += dpp_ror(x, 1); return x; }
__device__ __forceinline__ float sum8(float x) {
    x += __int_as_float(__builtin_amdgcn_update_dpp(0, __float_as_int(x), 0x141, 0xf, 0xf, false));
    x += __int_as_float(__builtin_amdgcn_update_dpp(0, __float_as_int(x), 0xB1, 0xf, 0xf, false));
    x += __int_as_float(__builtin_amdgcn_update_dpp(0, __float_as_int(x), 0x4E, 0xf, 0xf, false));
    return x;
}
__device__ __forceinline__ float lane_xor(float v, int lane, int o) { return __int_as_float(__builtin_amdgcn_ds_bpermute((lane ^ o) << 2, __float_as_int(v))); }
typedef unsigned v2u_t __attribute__((ext_vector_type(2)));
__device__ __forceinline__ float bfly16_sum(float x) { const v2u_t r = __builtin_amdgcn_permlane16_swap(__float_as_uint(x), __float_as_uint(x), false, false); return __uint_as_float(r[0]) + __uint_as_float(r[1]); }
__device__ __forceinline__ float bfly32_sum(float x) { const v2u_t r = __builtin_amdgcn_permlane32_swap(__float_as_uint(x), __float_as_uint(x), false, false); return __uint_as_float(r[0]) + __uint_as_float(r[1]); }
__device__ __forceinline__ float bfly16_max(float x) { const v2u_t r = __builtin_amdgcn_permlane16_swap(__float_as_uint(x), __float_as_uint(x), false, false); return fmaxf(__uint_as_float(r[0]), __uint_as_float(r[1])); }
__device__ __forceinline__ float bfly32_max(float x) { const v2u_t r = __builtin_amdgcn_permlane32_swap(__float_as_uint(x), __float_as_uint(x), false, false); return fmaxf(__uint_as_float(r[0]), __uint_as_float(r[1])); }
__device__ __forceinline__ float wave_max(float x) {
    x = fmaxf(x, dpp_ror(x, 8)); x = fmaxf(x, dpp_ror(x, 4)); x = fmaxf(x, dpp_ror(x, 2)); x = fmaxf(x, dpp_ror(x, 1)); x = bfly16_max(x); return bfly32_max(x);
}
__device__ __forceinline__ unsigned pack_i8x4(const f32x4& v, float inv) {
    const int q0 = (int)__builtin_rintf(fminf(fmaxf(v[0] * inv, -127.f), 127.f)), q1 = (int)__builtin_rintf(fminf(fmaxf(v[1] * inv, -127.f), 127.f));
    const int q2 = (int)__builtin_rintf(fminf(fmaxf(v[2] * inv, -127.f), 127.f)), q3 = (int)__builtin_rintf(fminf(fmaxf(v[3] * inv, -127.f), 127.f));
    return (unsigned)(q0 & 255) | ((unsigned)(q1 & 255) << 8) | ((unsigned)(q2 & 255) << 16) | ((unsigned)q3 << 24);
}
__device__ __forceinline__ float wave_sum(float v, int lane) { (void)lane; v = rowsum16(v); v = bfly16_sum(v); v = bfly32_sum(v); return v; }
__device__ __forceinline__ int lane_id_nh() { int lid; asm volatile("v_mbcnt_lo_u32_b32 %0, -1, 0\n\tv_mbcnt_hi_u32_b32 %0, -1, %0" : "=v"(lid)); return lid; }
__device__ __forceinline__ float sigmoidf_(float x) { return 1.0f / (1.0f + __expf(-x)); }
#define LDS_WAIT() asm volatile("s_waitcnt lgkmcnt(0)" ::: "memory")
#define VM_WAIT() asm volatile("s_waitcnt vmcnt(0)" ::: "memory")

#define XB_TMO      128
#define XB_XCNT(j)  (256  + 64 * (j))
#define XB_XSUB(j)  (1280 + 64 * (j))
#define XB_XGEN(j)  (2304 + 64 * (j))
#define XB_TOP      3328
#define XB_TOPGEN   3392
#define XCD_BAR_WORDS 3456
#define XB_SPIN_CAP (1u << 18)
__device__ __forceinline__ unsigned xb_ld(unsigned* p)              { return __hip_atomic_load(p, __ATOMIC_RELAXED, __HIP_MEMORY_SCOPE_AGENT); }
__device__ __forceinline__ unsigned xb_add(unsigned* p, unsigned v) { return __hip_atomic_fetch_add(p, v, __ATOMIC_RELAXED, __HIP_MEMORY_SCOPE_AGENT); }
__device__ __forceinline__ unsigned xb_xcc_id() { return (unsigned)__builtin_amdgcn_s_getreg((3 << 11) | 20) & 0xFu; }
#define XB_SPIN(cond, bar) do { unsigned _sp = 0; while (cond) { __builtin_amdgcn_s_sleep(1); \
    if ((++_sp & 255u) == 0u) { if (xb_ld(&(bar)[XB_TMO])) break; if (_sp > XB_SPIN_CAP) { atomicAdd(&(bar)[XB_TMO], 1u); break; } } } } while (0)
struct XcdBarrier { unsigned* bar; unsigned x; volatile LAS unsigned* st; };
__device__ __forceinline__ XcdBarrier xcd_barrier_post(unsigned* bar, volatile LAS unsigned* st, bool t0) {
    XcdBarrier b; b.bar = bar; b.x = xb_xcc_id(); b.st = st;
    if (t0) (void)xb_add(&bar[XB_XCNT(b.x)], 1u);
    return b;
}
__device__ __forceinline__ void xcd_barrier_complete(unsigned* bar, unsigned x, unsigned& nloc, unsigned& nx) {
    const unsigned G = gridDim.x * gridDim.y * gridDim.z;
    unsigned sum, cnt, mine, sp = 0u;
    for (;;) {
        sum = 0u; cnt = 0u; mine = 0u;
#pragma clang loop unroll(disable)
        for (unsigned j = 0; j < 16; ++j) { const unsigned c = xb_ld(&bar[XB_XCNT(j)]); sum += c; cnt += (c > 0u) ? 1u : 0u; mine = (j == x) ? c : mine; }
        if (sum == G) break;
        __builtin_amdgcn_s_sleep(1);
        if ((++sp & 255u) == 0u) { if (xb_ld(&bar[XB_TMO])) break; if (sp > XB_SPIN_CAP) { atomicAdd(&bar[XB_TMO], 1u); break; } }
    }
    nloc = mine > 0u ? mine : 1u; nx = cnt > 0u ? cnt : 1u;
}
__device__ __forceinline__ void xcd_barrier(const XcdBarrier& b, bool t0) {
    asm volatile("s_waitcnt vmcnt(0)" ::: "memory");
    __syncthreads();
    if (t0) {
        unsigned* bar = b.bar;
        __builtin_amdgcn_s_waitcnt(0);
        unsigned nloc = b.st[0], nx = b.st[1];
        if (nloc == 0u) { xcd_barrier_complete(bar, b.x, nloc, nx); b.st[0] = nloc; b.st[1] = nx; }
        const unsigned old = xb_add(&bar[XB_XSUB(b.x)], 1u);
        const unsigned gen = old / nloc;
        if (old + 1u == (gen + 1u) * nloc) {
            __builtin_amdgcn_fence(__ATOMIC_RELEASE, "agent");
            asm volatile("s_waitcnt vmcnt(0)" ::: "memory");
            const unsigned og = xb_add(&bar[XB_TOP], 1u);
            const unsigned tg = og / nx;
            if (og + 1u == (tg + 1u) * nx) xb_add(&bar[XB_TOPGEN], 1u);
            else XB_SPIN(xb_ld(&bar[XB_TOPGEN]) == tg, bar);
            __builtin_amdgcn_fence(__ATOMIC_ACQUIRE, "agent");
            xb_add(&bar[XB_XGEN(b.x)], 1u);
            asm volatile("s_waitcnt vmcnt(0)" ::: "memory");
        } else {
            XB_SPIN(xb_ld(&bar[XB_XGEN(b.x)]) == gen, bar);
            __builtin_amdgcn_fence(__ATOMIC_ACQUIRE, "agent");
            asm volatile("s_waitcnt vmcnt(0)" ::: "memory");
        }
    }
    __syncthreads();
}

namespace pg8 {
constexpr int BM = 256, BK = 64, HALF = 128, HTB = HALF * BK * 2, STAGE_BYTES = 8 * HTB;
__device__ __forceinline__ int lds_byte(int r, int c) { const int st = (r >> 4) * 2 + (c >> 5), rr = r & 15, cc = c & 31, ob = rr * 64 + cc * 2; return st * 1024 + (ob ^ (((ob >> 9) & 1) << 5)); }
__device__ __forceinline__ void stage_rc(int b, int& R, int& C) { const int st = b / 1024, sb = b % 1024, swz = sb ^ (((sb >> 9) & 1) << 5); R = (st >> 1) * 16 + swz / 64; C = (st & 1) * 32 + (swz % 64) / 2; }
__device__ __forceinline__ int perm32(int rho) { const int n = rho >> 4, i = rho & 15; return 8 * (i >> 2) + 4 * n + (i & 3); }
struct Unit { int pm, pn, ui; const char* a; const char* b; };
__device__ __forceinline__ unsigned cvt_pk_bf16(float lo, float hi) { unsigned r; asm volatile("v_cvt_pk_bf16_f32 %0, %1, %2" : "=v"(r) : "v"(lo), "v"(hi)); return r; }

typedef int i32x4 __attribute__((ext_vector_type(4)));
template <bool I8> struct OpT { typedef bf16x8 frag; typedef f32x4 acc; };
template <> struct OpT<true> { typedef i32x4 frag; typedef i32x4 acc; };
__device__ __forceinline__ f32x4 mma16(const bf16x8& a, const bf16x8& b, const f32x4& c) { return __builtin_amdgcn_mfma_f32_16x16x32_bf16(a, b, c, 0, 0, 0); }
__device__ __forceinline__ i32x4 mma16(const i32x4& a, const i32x4& b, const i32x4& c) { return __builtin_amdgcn_mfma_i32_16x16x64_i8(a, b, c, 0, 0, 0); }
template <class Epi, class Sched>
__device__ __forceinline__ void gemm_phase(LAS unsigned char* lds, const int tid, const int K, const int lda, const int ldb, const Sched& S, const Epi& E) {
    const int wid = __builtin_amdgcn_readfirstlane(tid >> 6), lane = tid & 63, wr = wid >> 2, wc = wid & 3, fr = lane & 15, fq = lane >> 4;
    int Kq = K; asm volatile("" : "+s"(Kq));
    constexpr bool I8 = Epi::I8; constexpr int EB = I8 ? 1 : 2;
    typedef typename OpT<I8>::frag frag_t; typedef typename OpT<I8>::acc acc_t;
    const int nt = Kq * EB / (BK * 2);
    unsigned voffC[2][2], voffN[2][2], voffB[2]; int RA[2], CA[2];
#pragma unroll
    for (int i = 0; i < 2; ++i) { int R, C; stage_rc(tid * 16 + i * 8192, R, C); const int Rb = Epi::PERM ? ((R & ~31) + perm32(R & 31)) : R; RA[i] = R; CA[i] = C;
        voffB[i] = (unsigned)(Rb * ldb * EB + C * 2); }
#define PG8_AOFF(dst, ui_) do { _Pragma("unroll") for (int h_ = 0; h_ < 2; ++h_) _Pragma("unroll") for (int i_ = 0; i_ < 2; ++i_) { \
        if constexpr (Sched::GATHER) dst[h_][i_] = (unsigned)(S.row_of(ui_, h_ * HALF + RA[i_]) * lda * EB + CA[i_] * 2); else dst[h_][i_] = (unsigned)((h_ * HALF + RA[i_]) * lda * EB + CA[i_] * 2); } } while (0)
    const size_t kstep = (size_t)(BK * 2);
    const size_t hstepB = (size_t)HALF * ldb * EB;
    const unsigned ldsw = (unsigned)wid * 1024u;
    const int aoff = lds_byte(wr * 64 + fr, fq * 8), boff = lds_byte(wc * 32 + fr, fq * 8);
#define PG8_SA(b, h) (((b) * 2 + (h)) * HTB)
#define PG8_SB(b, h) ((4 + (b) * 2 + (h)) * HTB)
#define PG8_STAGE(bufoff, gbase, voff) do { _Pragma("unroll") for (int _i = 0; _i < 2; ++_i) \
        __builtin_amdgcn_global_load_lds((const unsigned*)((const char*)(gbase) + (voff)[_i]), (LAS unsigned*)(lds + (bufoff) + ldsw + _i * 8192), 16, 0, 0); } while (0)
#define PG8_LDA(dst, b, h) do { _Pragma("unroll") for (int m = 0; m < 4; ++m) _Pragma("unroll") for (int k = 0; k < 2; ++k) dst[m][k] = *(const LAS frag_t*)(lds + PG8_SA(b, h) + aoff + m * 2048 + k * 1024); } while (0)
#define PG8_LDB(dst, b, h) do { _Pragma("unroll") for (int n = 0; n < 2; ++n) _Pragma("unroll") for (int k = 0; k < 2; ++k) dst[n][k] = *(const LAS frag_t*)(lds + PG8_SB(b, h) + boff + n * 2048 + k * 1024); } while (0)
#define PG8_MMA(ai, bj, At, Bt) do { __builtin_amdgcn_s_setprio(1); _Pragma("unroll") for (int m = 0; m < 4; ++m) _Pragma("unroll") for (int n = 0; n < 2; ++n) _Pragma("unroll") for (int k = 0; k < 2; ++k) \
        acc[ai][bj][m][n] = mma16(Bt[n][k], At[m][k], acc[ai][bj][m][n]); __builtin_amdgcn_s_setprio(0); } while (0)
#define PG8_WAIT_V(n) asm volatile("s_waitcnt vmcnt(" #n ")" ::: "memory")
#define PG8_WAIT_L(n) asm volatile("s_waitcnt lgkmcnt(" #n ")" ::: "memory")
#define PG8_BAR __builtin_amdgcn_s_barrier()
#define PG8_SCHED __builtin_amdgcn_sched_barrier(0)
    Unit cur, nxt; int ui = 0;
    if (!S.next(0, cur)) return;
    acc_t acc[2][2][4][2];
#pragma unroll
    for (int a = 0; a < 2; ++a)
#pragma unroll
        for (int b = 0; b < 2; ++b)
#pragma unroll
            for (int m = 0; m < 4; ++m)
#pragma unroll
                for (int n = 0; n < 2; ++n) acc[a][b][m][n] = (acc_t){0, 0, 0, 0};
    frag_t At[4][2], B0[2][2], B1[2][2];
    const char* cA = cur.a; const char* cB = cur.b;
    PG8_AOFF(voffC, 0); PG8_AOFF(voffN, 0);
    PG8_STAGE(PG8_SB(0, 0), cB, voffB); PG8_STAGE(PG8_SB(0, 1), cB + hstepB, voffB); PG8_STAGE(PG8_SA(0, 0), cA, voffC[0]); PG8_STAGE(PG8_SA(0, 1), cA, voffC[1]);
    if (wr == 1) PG8_BAR;
    PG8_WAIT_V(2); PG8_BAR;
    PG8_STAGE(PG8_SB(1, 0), cB + kstep, voffB); PG8_STAGE(PG8_SA(1, 0), cA + kstep, voffC[0]); PG8_STAGE(PG8_SB(1, 1), cB + hstepB + kstep, voffB);
    PG8_WAIT_V(6); PG8_BAR;
    for (;;) {
        const bool has_next = S.next(ui + 1, nxt);
        const char* nA = has_next ? nxt.a : cA; const char* nB = has_next ? nxt.b : cB;
        if constexpr (Sched::GATHER) { if (has_next) PG8_AOFF(voffN, ui + 1); }
#pragma clang loop unroll(disable)
        for (int t = 0; t < nt; t += 2) {
            const bool last = (t == nt - 2);
            const char* a1 = cA + (size_t)(t + 1) * kstep;
            const char* a2 = last ? nA : cA + (size_t)(t + 2) * kstep; const char* b2 = last ? nB : cB + (size_t)(t + 2) * kstep;
            const char* a3 = a2 + kstep; const char* b3 = b2 + kstep;
            unsigned vA0[2], vA1[2];
            if constexpr (Sched::GATHER) { vA0[0] = last ? voffN[0][0] : voffC[0][0]; vA0[1] = last ? voffN[0][1] : voffC[0][1]; vA1[0] = last ? voffN[1][0] : voffC[1][0]; vA1[1] = last ? voffN[1][1] : voffC[1][1]; }
            else { vA0[0] = voffC[0][0]; vA0[1] = voffC[0][1]; vA1[0] = voffC[1][0]; vA1[1] = voffC[1][1]; }
            PG8_LDB(B0, 0, 0); PG8_LDB(B1, 0, 1); PG8_SCHED; PG8_LDA(At, 0, 0); PG8_STAGE(PG8_SA(1, 1), a1, voffC[1]);
            PG8_WAIT_V(8); PG8_WAIT_L(0); PG8_BAR; PG8_MMA(0, 0, At, B0); PG8_MMA(0, 1, At, B1); PG8_BAR; PG8_SCHED;
            PG8_LDA(At, 0, 1); PG8_STAGE(PG8_SB(0, 0), b2, voffB); PG8_STAGE(PG8_SB(0, 1), b2 + hstepB, voffB); PG8_STAGE(PG8_SA(0, 0), a2, vA0);
            PG8_WAIT_V(8); PG8_WAIT_L(0); PG8_BAR; PG8_MMA(1, 0, At, B0); PG8_MMA(1, 1, At, B1); PG8_BAR; PG8_SCHED;
            PG8_LDB(B0, 1, 0); PG8_LDB(B1, 1, 1); PG8_SCHED; PG8_LDA(At, 1, 0); PG8_STAGE(PG8_SA(0, 1), a2, vA1);
            PG8_WAIT_V(8); PG8_WAIT_L(0); PG8_BAR; PG8_MMA(0, 0, At, B0); PG8_MMA(0, 1, At, B1); PG8_BAR; PG8_SCHED;
            PG8_LDA(At, 1, 1); PG8_STAGE(PG8_SB(1, 0), b3, voffB); PG8_STAGE(PG8_SB(1, 1), b3 + hstepB, voffB); PG8_STAGE(PG8_SA(1, 0), a3, vA0);
            PG8_WAIT_V(8); PG8_WAIT_L(0); PG8_BAR; PG8_MMA(1, 0, At, B0); PG8_MMA(1, 1, At, B1); PG8_BAR; PG8_SCHED;
        }
        if (wr == 0) PG8_BAR;
        { int te = tid; asm volatile("" : "+v"(te));
          const int we = __builtin_amdgcn_readfirstlane(te >> 6), le = te & 63;
          E(acc, cur, we >> 2, we & 3, le & 15, le >> 4); }
        if (!has_next) break;
#pragma unroll
        for (int a = 0; a < 2; ++a)
#pragma unroll
            for (int b = 0; b < 2; ++b)
#pragma unroll
                for (int m = 0; m < 4; ++m)
#pragma unroll
                    for (int n = 0; n < 2; ++n) acc[a][b][m][n] = (acc_t){0, 0, 0, 0};
        cur = nxt; cA = nA; cB = nB; ++ui;
        if constexpr (Sched::GATHER) {
#pragma unroll
            for (int h_ = 0; h_ < 2; ++h_) { voffC[h_][0] = voffN[h_][0]; voffC[h_][1] = voffN[h_][1]; } }
        if (wr == 1) PG8_BAR;
    }
    PG8_WAIT_V(0);
    PG8_BAR;
#undef PG8_AOFF
#undef PG8_SA
#undef PG8_SB
#undef PG8_STAGE
#undef PG8_LDA
#undef PG8_LDB
#undef PG8_MMA
#undef PG8_WAIT_V
#undef PG8_WAIT_L
#undef PG8_BAR
#undef PG8_SCHED
}

struct GridOrder {
    int nM, nN, nwg, G, c, uneven;
    __device__ __forceinline__ void init(int nM_, int nN_, int G_, int c_) { nM = nM_; nN = nN_; nwg = nM * nN; G = G_; c = c_; uneven = 0; }
    __device__ __forceinline__ bool tile(int i, int& pm, int& pn) const {
        long L = (long)i * G + c;
        if (uneven) {
            if (c < 128) { if (i >= 2) return false; L = i * 128 + c; } else { if (i >= 4) return false; L = 256 + (c - 128) + 128 * i; } }
        if (L >= nwg) return false;
        int wgid = (int)L; { const int q = nwg / 8, r = nwg % 8, xcd = wgid % 8, off = wgid / 8; wgid = (xcd < r ? xcd * (q + 1) : r * (q + 1) + (xcd - r) * q) + off; }
        const int nig = 8 * nN, gid = wgid / nig, fm = gid * 8, gsz = (nM - fm) < 8 ? (nM - fm) : 8;
        pm = fm + ((wgid % nig) % gsz); pn = (wgid % nig) / gsz; return true;
    }
};
}

__device__ __forceinline__ int uni(int v) { return __builtin_amdgcn_readfirstlane(v); }
__device__ __forceinline__ const char* uniptr(const char* p) { const unsigned long long v = (unsigned long long)p; const unsigned lo = __builtin_amdgcn_readfirstlane((unsigned)v), hi = __builtin_amdgcn_readfirstlane((unsigned)(v >> 32)); return (const char*)(((unsigned long long)hi << 32) | lo); }
struct DenseSched {
    static constexpr bool GATHER = false;
    pg8::GridOrder o; const char* A; size_t a_sel_stride; int pn_per_a; const char* B; size_t tstepA, tstepB;
    __device__ __forceinline__ bool next(int i, pg8::Unit& u) const {
        if (!o.tile(i, u.pm, u.pn)) return false;
        u.pm = uni(u.pm); u.pn = uni(u.pn); u.ui = i;
        u.a = uniptr(A + (size_t)(u.pn / pn_per_a) * a_sel_stride + (size_t)u.pm * tstepA); u.b = uniptr(B + (size_t)u.pn * tstepB); return true;
    }
};
struct MoeSched {
    static constexpr bool GATHER = false;
    const LAS int* tileE; int ntiles, npn, G, c; const char* A; const char* B; size_t tstepA, tstepB, estride;
    __device__ __forceinline__ bool next(int i, pg8::Unit& u) const {
        const int L = i * G + c; if (L >= ntiles * npn) return false;
        u.pm = uni(L / npn); u.pn = uni(L % npn); u.ui = i;
        const int e = __builtin_amdgcn_readfirstlane(tileE[u.pm]);
        u.a = uniptr(A + (size_t)u.pm * tstepA); u.b = uniptr(B + (size_t)e * estride + (size_t)u.pn * tstepB); return true;
    }
};
struct MoeGatherSched {
    static constexpr bool GATHER = true;
    const LAS int* tileE; const LAS int* rowtab; int ntiles, G, c; const char* A; const char* B; size_t tstepB, estride;
    __device__ __forceinline__ bool next(int i, pg8::Unit& u) const {
        const int L = i * G + c; if (L >= ntiles * 2) return false;
        u.pm = uni(L >> 1); u.pn = uni(L & 1); u.ui = i;
        const int e = __builtin_amdgcn_readfirstlane(tileE[u.pm]);
        u.a = A; u.b = uniptr(B + (size_t)e * estride + (size_t)u.pn * tstepB); return true;
    }
    __device__ __forceinline__ int row_of(int i, int r) const { return rowtab[i * 256 + r]; }
};
using pg8::Unit; using pg8::cvt_pk_bf16;
__device__ __forceinline__ void st8(bf16* p, const f32x4& v0, const f32x4& v1) {
    u32x4 w; w.x = cvt_pk_bf16(v0[0], v0[1]); w.y = cvt_pk_bf16(v0[2], v0[3]); w.z = cvt_pk_bf16(v1[0], v1[1]); w.w = cvt_pk_bf16(v1[2], v1[3]);
    *(u32x4*)p = w;
}
struct EpiSplit {
    static constexpr bool PERM = true, I8 = false;
    bf16* O; size_t split_stride; float scale;
    __device__ __forceinline__ void operator()(const f32x4 (&acc)[2][2][4][2], const Unit& u, int wr, int wc, int fr, int fq) const {
        const int row0 = u.pm * 256 + wr * 64 + fr; const int colt = u.pn * 256; const int t = colt >> 10;
        bf16* base = O + (size_t)t * split_stride; const int col0 = (colt & 1023) + wc * 32 + 8 * fq;
#pragma unroll
        for (int ai = 0; ai < 2; ++ai)
#pragma unroll
            for (int m = 0; m < 4; ++m) { bf16* rowp = base + (size_t)(row0 + ai * 128 + m * 16) * 1024 + col0;
#pragma unroll
                for (int bj = 0; bj < 2; ++bj) st8(rowp + bj * 128, acc[ai][bj][m][0] * scale, acc[ai][bj][m][1] * scale); }
    }
};
struct EpiLoraDn {
    static constexpr bool PERM = true, I8 = false;
    bf16* O;
    __device__ __forceinline__ void operator()(const f32x4 (&acc)[2][2][4][2], const Unit& u, int wr, int wc, int fr, int fq) const {
        const int row0 = u.pm * 256 + wr * 64 + fr; const int col0 = u.pn * 256 + wc * 32 + 8 * fq;
#pragma unroll
        for (int ai = 0; ai < 2; ++ai)
#pragma unroll
            for (int m = 0; m < 4; ++m) { bf16* rowp = O + (size_t)(row0 + ai * 128 + m * 16) * 512 + col0;
#pragma unroll
                for (int bj = 0; bj < 2; ++bj) { f32x4 v0 = acc[ai][bj][m][0], v1 = acc[ai][bj][m][1];
                    const int mode = (u.pn == 1) ? 2 : ((wc >> 1) & 1);
                    if (mode == 0) {
#pragma unroll
                        for (int j = 0; j < 4; ++j) { v0[j] = 1.0f - 2.0f / (__expf(2.0f * v0[j]) + 1.0f); v1[j] = 1.0f - 2.0f / (__expf(2.0f * v1[j]) + 1.0f); } }
                    else if (mode == 2) {
#pragma unroll
                        for (int j = 0; j < 4; ++j) { v0[j] = sigmoidf_(v0[j]); v1[j] = sigmoidf_(v1[j]); } }
                    st8(rowp + bj * 128, v0, v1); } }
    }
};
struct EpiLoraUpWA {
    static constexpr bool PERM = true, I8 = false;
    bf16* LD; bf16* AS; const float* w0; const float* a0;
    __device__ __forceinline__ void operator()(const f32x4 (&acc)[2][2][4][2], const Unit& u, int wr, int wc, int fr, int fq) const {
        const int z = u.pn >> 3, kind = (u.pn >> 2) & 1;
        const int row0 = u.pm * 256 + wr * 64 + fr; const int col0 = (u.pn & 3) * 256 + wc * 32 + 8 * fq;
        bf16* base = (kind ? AS : LD) + (size_t)z * T * D; const float* bias = (kind ? a0 : w0) + z * 1024;
        f32x4 bv[2][2];
#pragma unroll
        for (int bj = 0; bj < 2; ++bj)
#pragma unroll
            for (int n = 0; n < 2; ++n) bv[bj][n] = *(const f32x4*)(bias + col0 + bj * 128 + 4 * n);
#pragma unroll
        for (int ai = 0; ai < 2; ++ai)
#pragma unroll
            for (int m = 0; m < 4; ++m) { bf16* rowp = base + (size_t)(row0 + ai * 128 + m * 16) * 1024 + col0;
#pragma unroll
                for (int bj = 0; bj < 2; ++bj) { f32x4 v[2];
#pragma unroll
                    for (int n = 0; n < 2; ++n) { v[n] = acc[ai][bj][m][n] + bv[bj][n];
#pragma unroll
                        for (int j = 0; j < 4; ++j) { const float x = v[n][j];
                            if (kind == 0) v[n][j] = -0.8750612633917001f * sigmoidf_(x);
                            else v[n][j] = sigmoidf_(x); } }
                    st8(rowp + bj * 128, v[0], v[1]); } }
    }
};
struct EpiResid {
    static constexpr bool PERM = true, I8 = false;
    const void* xin; int xin_f32; bf16* out; const float* gate;
    __device__ __forceinline__ void operator()(const f32x4 (&acc)[2][2][4][2], const Unit& u, int wr, int wc, int fr, int fq) const {
        const int row0 = u.pm * 256 + wr * 64 + fr, col0 = u.pn * 256 + wc * 32 + 8 * fq; const int b = u.pm >> 3;
        f32x4 gv[2][2];
#pragma unroll
        for (int bj = 0; bj < 2; ++bj)
#pragma unroll
            for (int n = 0; n < 2; ++n) gv[bj][n] = *(const f32x4*)(gate + (size_t)b * 6144 + col0 + bj * 128 + 4 * n);
        if (xin_f32) {
#pragma unroll
            for (int ai = 0; ai < 2; ++ai)
#pragma unroll
                for (int m = 0; m < 4; ++m) { const size_t off = (size_t)(row0 + ai * 128 + m * 16) * D + col0;
#pragma unroll
                    for (int bj = 0; bj < 2; ++bj) { const f32x4 x0 = *(const f32x4*)((const float*)xin + off + bj * 128), x1 = *(const f32x4*)((const float*)xin + off + bj * 128 + 4);
                        st8(out + off + bj * 128, x0 + gv[bj][0] * acc[ai][bj][m][0], x1 + gv[bj][1] * acc[ai][bj][m][1]); } }
        } else {
#pragma unroll
            for (int ai = 0; ai < 2; ++ai) { u32x4 xr[4][2];
#pragma unroll
                for (int m = 0; m < 4; ++m)
#pragma unroll
                    for (int bj = 0; bj < 2; ++bj) xr[m][bj] = *(const u32x4*)((const bf16*)xin + (size_t)(row0 + ai * 128 + m * 16) * D + col0 + bj * 128);
#pragma unroll
                for (int m = 0; m < 4; ++m) { const size_t off = (size_t)(row0 + ai * 128 + m * 16) * D + col0;
#pragma unroll
                    for (int bj = 0; bj < 2; ++bj) { const u32x4 r = xr[m][bj];
                        const f32x4 x0 = {bf_lo(r.x), bf_hi(r.x), bf_lo(r.y), bf_hi(r.y)}, x1 = {bf_lo(r.z), bf_hi(r.z), bf_lo(r.w), bf_hi(r.w)};
                        st8(out + off + bj * 128, x0 + gv[bj][0] * acc[ai][bj][m][0], x1 + gv[bj][1] * acc[ai][bj][m][1]); } } }
        }
    }
};
struct EpiQKV {
    static constexpr bool PERM = true, I8 = false;
    bf16* Q; bf16* Kb; bf16* Vb; float qscale;
    __device__ __forceinline__ void operator()(const f32x4 (&acc)[2][2][4][2], const Unit& u, int wr, int wc, int fr, int fq) const {
        const int g = u.pn / 12, which = (u.pn % 12) >> 2, hp = u.pn & 3;
        const int row0 = u.pm * 256 + wr * 64 + fr;
        bf16* base = Q + (size_t)which * ((A_K - A_Q) / 2) + (size_t)g * T * D; const float sc = which ? 1.0f : qscale; const int col0 = hp * 256 + wc * 32 + 8 * fq;
#pragma unroll
        for (int ai = 0; ai < 2; ++ai)
#pragma unroll
            for (int m = 0; m < 4; ++m) { bf16* rowp = base + (size_t)(row0 + ai * 128 + m * 16) * 1024 + col0;
#pragma unroll
                for (int bj = 0; bj < 2; ++bj) st8(rowp + bj * 128, acc[ai][bj][m][0] * sc, acc[ai][bj][m][1] * sc); }
    }
};
template <class Inner> struct EpiI8 {
    static constexpr bool PERM = Inner::PERM, I8 = true;
    Inner in; const float* sa; size_t sa_sel; int pn_per_a; const float* sb;
    __device__ __forceinline__ void operator()(const pg8::i32x4 (&acc)[2][2][4][2], const Unit& u, int wr, int wc, int fr, int fq) const {
        const int row0 = u.pm * 256 + wr * 64 + fr; const float* sap = sa + (size_t)(u.pn / pn_per_a) * sa_sel;
        const int colb = u.pn * 256 + wc * 32 + (PERM ? 8 * fq : 4 * fq);
        f32x4 sbv[2][2]; f32x4 f[2][2][4][2];
#pragma unroll
        for (int bj = 0; bj < 2; ++bj)
#pragma unroll
            for (int n = 0; n < 2; ++n) sbv[bj][n] = *(const f32x4*)(sb + colb + bj * 128 + (PERM ? 4 * n : 16 * n));
        float srv[2][4];
#pragma unroll
        for (int ai = 0; ai < 2; ++ai)
#pragma unroll
            for (int m = 0; m < 4; ++m) srv[ai][m] = sap[row0 + ai * 128 + m * 16];
        asm volatile("" : "+v"(srv[0][0]), "+v"(srv[0][1]), "+v"(srv[0][2]), "+v"(srv[0][3]), "+v"(srv[1][0]), "+v"(srv[1][1]), "+v"(srv[1][2]), "+v"(srv[1][3]));
#pragma unroll
        for (int ai = 0; ai < 2; ++ai)
#pragma unroll
            for (int m = 0; m < 4; ++m) { const float sr = srv[ai][m];
#pragma unroll
                for (int bj = 0; bj < 2; ++bj)
#pragma unroll
                    for (int n = 0; n < 2; ++n) f[ai][bj][m][n] = __builtin_convertvector(acc[ai][bj][m][n], f32x4) * (sbv[bj][n] * sr); }
        in(f, u, wr, wc, fr, fq);
    }
};
struct EpiQKV8 {
    static constexpr bool PERM = true, I8 = true;
    bf16* Q; const float* SA; const float* SBq; float qscale;
    __device__ __forceinline__ void operator()(const pg8::i32x4 (&acc)[2][2][4][2], const Unit& u, int wr, int wc, int fr, int fq) const {
        const int g = u.pn / 12, which = (u.pn % 12) >> 2, hp = u.pn & 3;
        const int row0 = u.pm * 256 + wr * 64 + fr;
        bf16* base = Q + (size_t)which * ((A_K - A_Q) / 2) + (size_t)g * T * D; const float sc = which ? 1.0f : qscale; const int col0 = hp * 256 + wc * 32 + 8 * fq;
        const int colb = u.pn * 256 + wc * 32 + 8 * fq;
        f32x4 sbv[2][2];
#pragma unroll
        for (int bj = 0; bj < 2; ++bj)
#pragma unroll
            for (int n = 0; n < 2; ++n) sbv[bj][n] = *(const f32x4*)(SBq + colb + bj * 128 + 4 * n) * sc;
        float sav[2][4];
#pragma unroll
        for (int ai = 0; ai < 2; ++ai)
#pragma unroll
            for (int m = 0; m < 4; ++m) sav[ai][m] = SA[row0 + ai * 128 + m * 16];
#pragma unroll
        for (int ai = 0; ai < 2; ++ai)
#pragma unroll
            for (int m = 0; m < 4; ++m) { const int row = row0 + ai * 128 + m * 16; const float sa = sav[ai][m]; bf16* rowp = base + (size_t)row * 1024 + col0;
#pragma unroll
                for (int bj = 0; bj < 2; ++bj) st8(rowp + bj * 128, __builtin_convertvector(acc[ai][bj][m][0], f32x4) * (sbv[bj][0] * sa), __builtin_convertvector(acc[ai][bj][m][1], f32x4) * (sbv[bj][1] * sa)); }
    }
};
struct EpiGateUp {
    static constexpr bool PERM = true, I8 = false;
    bf16* H; const float* roww;
    __device__ __forceinline__ void operator()(const f32x4 (&acc)[2][2][4][2], const Unit& u, int wr, int wc, int fr, int fq) const {
        const int row0 = u.pm * 256 + wr * 64 + fr; const int col0 = u.pn * 128 + wc * 32 + 8 * fq;
#pragma unroll
        for (int ai = 0; ai < 2; ++ai)
#pragma unroll
            for (int m = 0; m < 4; ++m) { const int row = row0 + ai * 128 + m * 16; const float rw = roww[row]; f32x4 v[2];
#pragma unroll
                for (int n = 0; n < 2; ++n)
#pragma unroll
                    for (int j = 0; j < 4; ++j) { const float gg = acc[ai][0][m][n][j], uu = acc[ai][1][m][n][j]; v[n][j] = gg * sigmoidf_(gg) * uu * rw; }
                st8(H + (size_t)row * FEXP + col0, v[0], v[1]); }
    }
};
struct EpiGateUp8 {
    static constexpr bool PERM = true, I8 = true;
    bf16* H; const LAS float* wtab; const LAS float* stab; const float* sbe; const LAS int* tileE;
    __device__ __forceinline__ void operator()(const pg8::i32x4 (&acc)[2][2][4][2], const Unit& u, int wr, int wc, int fr, int fq) const {
        const int rl0 = wr * 64 + fr; const int col0 = u.pn * 128 + wc * 32 + 8 * fq;
        const int e = __builtin_amdgcn_readfirstlane(tileE[u.pm]); const float* sbp = sbe + (size_t)e * 512 + u.pn * 256 + wc * 32 + 8 * fq;
        f32x4 sg[2], su[2];
#pragma unroll
        for (int n = 0; n < 2; ++n) { sg[n] = *(const f32x4*)(sbp + 4 * n); su[n] = *(const f32x4*)(sbp + 128 + 4 * n); }
#pragma unroll
        for (int ai = 0; ai < 2; ++ai)
#pragma unroll
            for (int m = 0; m < 4; ++m) { const int rl = rl0 + ai * 128 + m * 16; const float rw = wtab[u.ui * 256 + rl]; const float sa = stab[u.ui * 256 + rl]; f32x4 v[2];
#pragma unroll
                for (int n = 0; n < 2; ++n) { const f32x4 g4 = __builtin_convertvector(acc[ai][0][m][n], f32x4) * (sg[n] * sa), u4 = __builtin_convertvector(acc[ai][1][m][n], f32x4) * (su[n] * sa);
#pragma unroll
                    for (int j = 0; j < 4; ++j) { const float gg = g4[j], uu = u4[j]; v[n][j] = gg * sigmoidf_(gg) * uu * rw; } }
                st8(H + (size_t)(u.pm * 256 + rl) * FEXP + col0, v[0], v[1]); }
    }
};
struct EpiPlain {
    static constexpr bool PERM = true, I8 = false;
    bf16* O;
    __device__ __forceinline__ void operator()(const f32x4 (&acc)[2][2][4][2], const Unit& u, int wr, int wc, int fr, int fq) const {
        const int row0 = u.pm * 256 + wr * 64 + fr; const int col0 = u.pn * 256 + wc * 32 + 8 * fq;
#pragma unroll
        for (int ai = 0; ai < 2; ++ai)
#pragma unroll
            for (int m = 0; m < 4; ++m) { bf16* rowp = O + (size_t)(row0 + ai * 128 + m * 16) * 1024 + col0;
#pragma unroll
                for (int bj = 0; bj < 2; ++bj) st8(rowp + bj * 128, acc[ai][bj][m][0], acc[ai][bj][m][1]); }
    }
};

struct Args {
    const float* in[32]; float* out; unsigned char* ws; int ph_lo, ph_hi;
};
enum { I_X = 0, I_C, I_ADAW, I_ADAB, I_NTM, I_NCM, I_MU, I_WRKV, I_W0, I_W1, I_W2, I_A0, I_A1, I_A2, I_G1, I_G2, I_KK, I_KA, I_RK, I_LNW, I_LNB, I_RWO,
       I_AQKV, I_AWO, I_RG, I_RGB, I_RE, I_REB, I_WG, I_WU, I_WD, I_FG };

struct Frame {
    LAS unsigned char* lds; int tid, lane, wave, G, gw, NGW;
    unsigned char* ws; const float* const* in; float* out;
};

__device__ __forceinline__ void row_load(const float* p, int lane, f32x4 (&v)[4]) {
#pragma unroll
    for (int j = 0; j < 4; ++j) v[j] = *(const f32x4*)(p + 4 * lane + 256 * j);
}
__device__ __forceinline__ void row_load_bf16(const bf16* p, int lane, f32x4 (&v)[4]) {
#pragma unroll
    for (int j = 0; j < 4; ++j) { const u32x2 r = *(const u32x2*)(p + 4 * lane + 256 * j); v[j] = (f32x4){bf_lo(r.x), bf_hi(r.x), bf_lo(r.y), bf_hi(r.y)}; }
}
__device__ __forceinline__ void row_store(float* p, int lane, const f32x4 (&v)[4]) {
#pragma unroll
    for (int j = 0; j < 4; ++j) *(f32x4*)(p + 4 * lane + 256 * j) = v[j];
}
__device__ __forceinline__ void row_store_bf16(bf16* p, int lane, const f32x4 (&v)[4]) {
#pragma unroll
    for (int j = 0; j < 4; ++j) { u32x2 w; w.x = pk2(v[j][0], v[j][1]); w.y = pk2(v[j][2], v[j][3]); *(u32x2*)(p + 4 * lane + 256 * j) = w; }
}
__device__ __forceinline__ void row_store_i8(signed char* p, float* scl, int lane, const f32x4 (&v)[4]) {
    float am = 0.f;
#pragma unroll
    for (int j = 0; j < 4; ++j) am = fmaxf(am, fmaxf(fmaxf(fabsf(v[j][0]), fabsf(v[j][1])), fmaxf(fabsf(v[j][2]), fabsf(v[j][3]))));
    am = fmaxf(wave_max(am), 1e-20f); const float inv = 127.0f / am;
    if (lane == 0) *scl = am * (1.0f / 127.0f);
#pragma unroll
    for (int j = 0; j < 4; ++j) *(unsigned*)(p + 4 * lane + 256 * j) = pack_i8x4(v[j], inv);
}
struct TokTab { const int* toke; const int* tokr; const LAS int* offs; };
__device__ __forceinline__ void row_combine(f32x4 (&v)[4], const bf16* ys, const TokTab& tt, int row, const float* gac, int lane) {
    const int p0 = tt.offs[tt.toke[2 * row]] + tt.tokr[2 * row], p1 = tt.offs[tt.toke[2 * row + 1]] + tt.tokr[2 * row + 1];
    const bf16* y0 = ys + (size_t)p0 * D; const bf16* y1 = ys + (size_t)p1 * D;
#pragma unroll
    for (int j = 0; j < 4; ++j) { const u32x2 a = *(const u32x2*)(y0 + 4 * lane + 256 * j), b = *(const u32x2*)(y1 + 4 * lane + 256 * j); const f32x4 g = *(const f32x4*)(gac + 4 * lane + 256 * j);
        v[j][0] += g[0] * (bf_lo(a.x) + bf_lo(b.x)); v[j][1] += g[1] * (bf_hi(a.x) + bf_hi(b.x)); v[j][2] += g[2] * (bf_lo(a.y) + bf_lo(b.y)); v[j][3] += g[3] * (bf_hi(a.y) + bf_hi(b.y)); }
}
__device__ __forceinline__ void row_norm_mod(const f32x4 (&x)[4], const float* gain, const float* sc, const float* sh, int lane, f32x4 (&h)[4]) {
    float s = 0.f;
#pragma unroll
    for (int j = 0; j < 4; ++j) s += (x[j][0] * x[j][0] + x[j][1] * x[j][1]) + (x[j][2] * x[j][2] + x[j][3] * x[j][3]);
    const float rstd = rsqrtf(wave_sum(s, lane) * (1.0f / D) + RMS_EPS);
#pragma unroll
    for (int j = 0; j < 4; ++j) { const f32x4 g = *(const f32x4*)(gain + 4 * lane + 256 * j), c = *(const f32x4*)(sc + 4 * lane + 256 * j), b = *(const f32x4*)(sh + 4 * lane + 256 * j);
        h[j] = x[j] * rstd * g * (1.0f + c) + b; }
}
__device__ __forceinline__ void transpose_item(const float* W, int ldw, bf16* dst, int ldd, LAS float* scr, int lane) {
    { const int r8 = lane >> 3, c4 = (lane & 7) * 4;
      f32x4 v[8];
#pragma unroll
      for (int i = 0; i < 8; ++i) v[i] = *(const f32x4*)(W + (size_t)(8 * i + r8) * ldw + c4);
#pragma unroll
      for (int i = 0; i < 8; ++i) { LAS float* p = scr + (8 * i + r8) * 33 + c4; p[0] = v[i][0]; p[1] = v[i][1]; p[2] = v[i][2]; p[3] = v[i][3]; } }
    LDS_WAIT(); asm volatile("" ::: "memory");
    const int c = lane & 7;
#pragma unroll
    for (int j = 0; j < 4; ++j) { const int n = (lane >> 3) + 8 * j; const LAS float* s = scr + (8 * c) * 33 + n;
        u32x4 o; o.x = pk2(s[0 * 33], s[1 * 33]); o.y = pk2(s[2 * 33], s[3 * 33]); o.z = pk2(s[4 * 33], s[5 * 33]); o.w = pk2(s[6 * 33], s[7 * 33]);
        *(u32x4*)(dst + (size_t)n * ldd + 8 * c) = o; }
    LDS_WAIT(); asm volatile("" ::: "memory");
}

__device__ __forceinline__ void conv8_cols32(Frame& F, const float* src, int ldw, signed char* dst, float* scl) {
    LAS float* scr = (LAS float*)(F.lds + 49152 + F.wave * 8704); LAS float* pm = (LAS float*)(F.lds + 118784);
    const int r8 = F.lane >> 3, c4 = (F.lane & 7) * 4;
    f32x4 v[16]; f32x4 mx = {0.f, 0.f, 0.f, 0.f};
#pragma unroll
    for (int i = 0; i < 16; ++i) { v[i] = *(const f32x4*)(src + (size_t)(F.wave * 128 + 8 * i + r8) * ldw + c4);
        mx[0] = fmaxf(mx[0], fabsf(v[i][0])); mx[1] = fmaxf(mx[1], fabsf(v[i][1])); mx[2] = fmaxf(mx[2], fabsf(v[i][2])); mx[3] = fmaxf(mx[3], fabsf(v[i][3])); }
#pragma unroll
    for (int q = 0; q < 4; ++q) { float a = mx[q]; a = fmaxf(a, dpp_ror(a, 8)); a = bfly16_max(a); a = bfly32_max(a); mx[q] = a; }
    if (r8 == 0) *(LAS f32x4*)(pm + F.wave * 32 + c4) = mx;
    __syncthreads();
    f32x4 cm = *(const LAS f32x4*)(pm + c4);
#pragma unroll
    for (int w = 1; w < 8; ++w) { const f32x4 o = *(const LAS f32x4*)(pm + w * 32 + c4); cm[0] = fmaxf(cm[0], o[0]); cm[1] = fmaxf(cm[1], o[1]); cm[2] = fmaxf(cm[2], o[2]); cm[3] = fmaxf(cm[3], o[3]); }
#pragma unroll
    for (int q = 0; q < 4; ++q) cm[q] = fmaxf(cm[q], 1e-20f);
    if (F.wave == 0 && r8 == 0) *(f32x4*)(scl + c4) = cm * (1.0f / 127.0f);
#pragma unroll
    for (int kh = 0; kh < 2; ++kh) {
#pragma unroll
        for (int i = 0; i < 8; ++i) { LAS float* p = scr + (8 * i + r8) * 33 + c4; const f32x4 x = v[8 * kh + i]; p[0] = x[0] * (127.0f / cm[0]); p[1] = x[1] * (127.0f / cm[1]); p[2] = x[2] * (127.0f / cm[2]); p[3] = x[3] * (127.0f / cm[3]); }
        LDS_WAIT(); asm volatile("" ::: "memory");
        const int c = F.lane & 7;
#pragma unroll
        for (int jj = 0; jj < 4; ++jj) { const int n = (F.lane >> 3) + 8 * jj; const LAS float* sp = scr + (8 * c) * 33 + n;
            u32x2 o; o.x = pack_i8x4((f32x4){sp[0 * 33], sp[1 * 33], sp[2 * 33], sp[3 * 33]}, 1.0f); o.y = pack_i8x4((f32x4){sp[4 * 33], sp[5 * 33], sp[6 * 33], sp[7 * 33]}, 1.0f);
            *(u32x2*)(dst + (size_t)n * D + (F.wave * 2 + kh) * 64 + 8 * c) = o; }
        LDS_WAIT(); asm volatile("" ::: "memory");
    }
    __syncthreads();
}
__device__ __forceinline__ void phase_prologue(Frame& F) {
    const float* c = F.in[I_C]; const float* adaw = F.in[I_ADAW]; const float* adab = F.in[I_ADAB];
    float* mod = (float*)(F.ws + WS_MOD);
    LAS float* sc = (LAS float*)F.lds;
    LAS float* part = (LAS float*)(F.lds + 32768);
    for (int i = F.tid; i < NB * D; i += NTHREADS) { const float v = c[i]; sc[i] = v / (1.0f + __expf(-v)); }
    __syncthreads();
    for (int u = blockIdx.x; u < DEPTH * 192; u += F.G) {
        const int l = u / 192, n0 = (u % 192) * 32; const int r8 = F.lane >> 3, c4 = (F.lane & 7) * 4;
        const float* W = adaw + (size_t)l * D * 6144 + n0 + c4;
        f32x4 v[16];
#pragma unroll
        for (int i = 0; i < 16; ++i) v[i] = *(const f32x4*)(W + (size_t)(F.wave * 128 + 8 * i + r8) * 6144);
        f32x4 acc[8];
#pragma unroll
        for (int b = 0; b < 8; ++b) acc[b] = (f32x4){0.f, 0.f, 0.f, 0.f};
#pragma unroll
        for (int i = 0; i < 16; ++i) { const int k = F.wave * 128 + 8 * i + r8;
#pragma unroll
            for (int b = 0; b < 8; ++b) acc[b] += v[i] * sc[b * D + k]; }
#pragma unroll
        for (int b = 0; b < 8; ++b)
#pragma unroll
            for (int q = 0; q < 4; ++q) { float a = acc[b][q]; a += dpp_ror(a, 8); a = bfly16_sum(a); a = bfly32_sum(a); acc[b][q] = a; }
        if (r8 == 0) {
#pragma unroll
            for (int b = 0; b < 8; ++b) *(LAS f32x4*)(part + (F.wave * 8 + b) * 32 + c4) = acc[b]; }
        __syncthreads();
        if (F.tid < 256) { const int b = F.tid >> 5, cc = F.tid & 31; float sum = adab[l * 6144 + n0 + cc];
#pragma unroll
            for (int w = 0; w < 8; ++w) sum += part[(w * 8 + b) * 32 + cc];
            mod[(size_t)(l * 8 + b) * 6144 + n0 + cc] = sum; }
        __syncthreads();
    }
    LAS float* scr = (LAS float*)(F.lds + 49152 + F.wave * 8704);
    constexpr int I_SQ = 16 * 32;
    constexpr int I_QKV = 16 * 288;
    constexpr int PER_RW = 4 * I_SQ, PER_AT = I_QKV + I_SQ, NIT = 2 * PER_RW + 2 * PER_AT;
    for (int it = F.gw; it < NIT; it += F.NGW) {
        int r = it;
        if (r < 2 * PER_RW) { const int j = r / PER_RW; r %= PER_RW; const int mi = r / I_SQ; r %= I_SQ; const int kb = r / 32, nb = r % 32;
            if (mi < 3) { }
            else transpose_item(F.in[I_RWO] + ((size_t)j * D + kb * 64) * D + nb * 32, D, (bf16*)(F.ws + WS_W + j * W_RW_STRIDE + W_RWO) + (size_t)(nb * 32) * D + kb * 64, D, scr, F.lane);
        } else { r -= 2 * PER_RW; const int j = r / PER_AT; r %= PER_AT;
            if (r < I_QKV) { }
            else { r -= I_QKV; const int kb = r / 32, nb = r % 32;
                transpose_item(F.in[I_AWO] + ((size_t)j * D + kb * 64) * D + nb * 32, D, (bf16*)(F.ws + WS_WA + j * W_AT_STRIDE + W_AWO) + (size_t)(nb * 32) * D + kb * 64, D, scr, F.lane); }
        }
    }
    for (int u = blockIdx.x; u < 2 * 288 + 2 * 96; u += F.G) {
        if (u < 2 * 288) { const int j = u / 288, n0 = (u % 288) * 32;
            conv8_cols32(F, F.in[I_AQKV] + (size_t)j * D * QKVW + n0, QKVW, (signed char*)(F.ws + WS_WA + j * W_AT_STRIDE + W_QKV) + (size_t)n0 * D, (float*)(F.ws + WS_WA + j * W_AT_STRIDE + W_QKVS) + n0); }
        else { const int r = u - 2 * 288, j = r / 96, mi = (r % 96) / 32, n0 = (r % 32) * 32;
            conv8_cols32(F, F.in[I_WRKV] + (size_t)(j * 3 + mi) * D * D + n0, D, (signed char*)(F.ws + WS_W + j * W_RW_STRIDE + W_RKV) + (size_t)(mi * D + n0) * D, (float*)(F.ws + WS_W + j * W_RW_STRIDE + W_RKVS) + mi * D + n0); }
    }
    const int gt = blockIdx.x * NTHREADS + F.tid, NGT = F.G * NTHREADS;
    for (int j = 0; j < 2; ++j) {
        bf16* ldn = (bf16*)(F.ws + WS_W + j * W_RW_STRIDE + W_LDN);
        const float* mu = F.in[I_MU] + (size_t)j * 6 * D;
        for (int i0 = gt; i0 < 512 * 2048; i0 += 8 * NGT) { float t[8];
#pragma unroll
            for (int u = 0; u < 8; ++u) { const int i = i0 + u * NGT; float v = 0.f;
                if (i < 512 * 2048) { const int n = i >> 11, k = i & 2047, kk = k & 1023; int mi;
                    if (n < 256) { const int blk = n >> 6, z = blk >> 1, isA = blk & 1, nn = n & 63;
                        v = (isA ? F.in[I_A1] : F.in[I_W1])[((size_t)(j * 2 + z) * D + kk) * 64 + nn]; mi = isA ? 4 : 3; }
                    else { const int z = (n - 256) >> 7, nn = n & 127; v = F.in[I_G1][((size_t)(j * 2 + z) * D + kk) * 128 + nn]; mi = 5; }
                    if (k >= 1024) v *= mu[mi * D + kk]; }
                t[u] = v; }
#pragma unroll
            for (int u = 0; u < 8; ++u) { const int i = i0 + u * NGT; if (i < 512 * 2048) ldn[i] = (bf16)f2bf(t[u]); } }
        bf16* lwa = (bf16*)(F.ws + WS_W + j * W_RW_STRIDE + W_LUPWA);
        for (int i0 = gt; i0 < 4096 * 128; i0 += 8 * NGT) { float t[8];
#pragma unroll
            for (int u = 0; u < 8; ++u) { const int i = i0 + u * NGT; float v = 0.f;
                if (i < 4096 * 128) { const int n = i >> 7, k = i & 127; const int z = n >> 11, isA = (n >> 10) & 1, col = n & 1023;
                    if ((k >> 6) == isA) v = (isA ? F.in[I_A2] : F.in[I_W2])[((size_t)(j * 2 + z) * 64 + (k & 63)) * D + col]; }
                t[u] = v; }
#pragma unroll
            for (int u = 0; u < 8; ++u) { const int i = i0 + u * NGT; if (i < 4096 * 128) lwa[i] = (bf16)f2bf(t[u]); } }
        bf16* lg = (bf16*)(F.ws + WS_W + j * W_RW_STRIDE + W_LUPG);
        for (int i0 = gt; i0 < 2048 * 128; i0 += 8 * NGT) { float t[8];
#pragma unroll
            for (int u = 0; u < 8; ++u) { const int i = i0 + u * NGT; float v = 0.f;
                if (i < 2048 * 128) { const int n = i >> 7, k = i & 127; const int z = n >> 10, col = n & 1023; v = F.in[I_G2][((size_t)(j * 2 + z) * 128 + k) * D + col]; }
                t[u] = v; }
#pragma unroll
            for (int u = 0; u < 8; ++u) { const int i = i0 + u * NGT; if (i < 2048 * 128) lg[i] = (bf16)f2bf(t[u]); } }
    }
}

__device__ __forceinline__ void moe_tables(Frame& F, int l) {
    LAS int* tileE = (LAS int*)(F.lds + TILEE_OFF); LAS int* tileJ = (LAS int*)(F.lds + TILEJ_OFF); LAS int* offs = (LAS int*)(F.lds + OFFS_OFF); LAS int* cl = (LAS int*)(F.lds + CNTL_OFF);
    const unsigned* cnt = (const unsigned*)(F.ws + WS_CTL) + CW_CNT + l * 32;
    if (F.tid < 32) cl[F.tid] = (int)__hip_atomic_load(cnt + F.tid, __ATOMIC_RELAXED, __HIP_MEMORY_SCOPE_AGENT);
    __syncthreads();
    if (F.tid < 32) {
        int tb = 0;
#pragma clang loop unroll(disable)
        for (int e = 0; e < F.tid; ++e) tb += (cl[e] + 255) >> 8;
        const int ne = (cl[F.tid] + 255) >> 8; offs[F.tid] = tb * 256;
#pragma clang loop unroll(disable)
        for (int k = 0; k < ne; ++k) if (tb + k < 160) { tileE[tb + k] = F.tid; tileJ[tb + k] = k; }
        if (F.tid == 31) { const int nt = tb + ne; tileE[160] = nt < 160 ? nt : 160; offs[32] = nt * 256; }
    }
    __syncthreads();
}
struct RowPipe { u32x2 xr[4], ya[4], yb[4]; int p0, p1; };
#define RP_IDX(P_, r_) do { P_.p0 = offs_[toke_[2 * (r_)]] + tokr_[2 * (r_)]; P_.p1 = offs_[toke_[2 * (r_) + 1]] + tokr_[2 * (r_) + 1]; } while (0)
#define RP_LOAD(P_, r_) do { _Pragma("unroll") for (int j_ = 0; j_ < 4; ++j_) { P_.xr[j_] = *(const u32x2*)(xsrc + (size_t)(r_) * D + 4 * F.lane + 256 * j_); \
        P_.ya[j_] = *(const u32x2*)(ys_ + (size_t)P_.p0 * D + 4 * F.lane + 256 * j_); P_.yb[j_] = *(const u32x2*)(ys_ + (size_t)P_.p1 * D + 4 * F.lane + 256 * j_); } } while (0)
#define RP_COMBINE(P_, x_, gac_) do { _Pragma("unroll") for (int j_ = 0; j_ < 4; ++j_) { const u32x2 r_ = P_.xr[j_], a_ = P_.ya[j_], b_ = P_.yb[j_]; \
        x_[j_][0] = bf_lo(r_.x) + gac_[j_][0] * (bf_lo(a_.x) + bf_lo(b_.x)); x_[j_][1] = bf_hi(r_.x) + gac_[j_][1] * (bf_hi(a_.x) + bf_hi(b_.x)); \
        x_[j_][2] = bf_lo(r_.y) + gac_[j_][2] * (bf_lo(a_.y) + bf_lo(b_.y)); x_[j_][3] = bf_hi(r_.y) + gac_[j_][3] * (bf_hi(a_.y) + bf_hi(b_.y)); } } while (0)
template <bool FIRST>
__device__ __forceinline__ void phase_rw_norm(Frame& F, int l, const void* xsrc_, bf16* xdst) {
    if (!FIRST) moe_tables(F, l - 1);
    const int j = l >> 1; const float* mu = F.in[I_MU] + (size_t)j * 6 * D;
    LAS float* MU = (LAS float*)F.lds;
    for (int i = F.tid; i < 3 * D / 4; i += NTHREADS) *(LAS f32x4*)(MU + 4 * i) = *(const f32x4*)(mu + 4 * i);
    __syncthreads();
    signed char* xs = (signed char*)(F.ws + WS_ACT + A_XS); bf16* hx = (bf16*)(F.ws + WS_ACT + A_HX); float* sxs = (float*)(F.ws + WS_SCL + SCL_XS);
    const float* mod = (const float*)(F.ws + WS_MOD); const bf16* xsrc = (const bf16*)xsrc_; const float* xsrcf = (const float*)xsrc_;
    const bf16* ys_ = (const bf16*)(F.ws + WS_ACT + A_YS); const int* toke_ = (const int*)(F.ws + WS_TOKE); const int* tokr_ = (const int*)(F.ws + WS_TOKR); const LAS int* offs_ = (const LAS int*)(F.lds + OFFS_OFF);
    for (int ch = F.gw; ch < T / 8; ch += F.NGW) {
        const int row0 = ch * 8, t0 = row0 & (SEQ - 1), b = row0 >> 11;
        f32x4 gac[4], gcv[4], shv[4];
        { const float* mp = mod + (size_t)(l * 8 + b) * 6144; const float* gp = mod + (size_t)((FIRST ? 0 : (l - 1)) * 8 + b) * 6144 + 5 * D;
#pragma unroll
          for (int q = 0; q < 4; ++q) { if (!FIRST) gac[q] = *(const f32x4*)(gp + 4 * F.lane + 256 * q); else gac[q] = (f32x4){0.f, 0.f, 0.f, 0.f};
              const f32x4 g = *(const f32x4*)(F.in[I_NTM] + l * D + 4 * F.lane + 256 * q), c = *(const f32x4*)(mp + 1 * D + 4 * F.lane + 256 * q);
              gcv[q] = g * (1.0f + c); shv[q] = *(const f32x4*)(mp + 0 * D + 4 * F.lane + 256 * q); } }
        const bool v0 = (t0 > 0), v9 = (t0 + 8 < SEQ);
#define RW_RC(k_) (((k_) == 0 && !v0) || ((k_) == 9 && !v9) ? row0 : row0 - 1 + (k_))
        RowPipe P; f32x4 xf[4]; int q0 = 0, q1 = 0;
        { const int r = RW_RC(0);
          if (FIRST) {
#pragma unroll
              for (int q = 0; q < 4; ++q) xf[q] = *(const f32x4*)(xsrcf + (size_t)r * D + 4 * F.lane + 256 * q); }
          else { RP_IDX(P, r); RP_LOAD(P, r); const int r1 = RW_RC(1); q0 = offs_[toke_[2 * r1]] + tokr_[2 * r1]; q1 = offs_[toke_[2 * r1 + 1]] + tokr_[2 * r1 + 1]; } }
        f32x4 prev[4], cur[4], nxt[4];
#pragma unroll
        for (int q = 0; q < 4; ++q) { prev[q] = (f32x4){0.f, 0.f, 0.f, 0.f}; cur[q] = prev[q]; nxt[q] = prev[q]; }
#pragma clang loop unroll(disable)
        for (int k = 0; k < 10; ++k) {
            const int r = row0 - 1 + k; const bool valid = (k == 0) ? v0 : ((k == 9) ? v9 : true);
            f32x4 x[4];
            if (FIRST) {
#pragma unroll
                for (int q = 0; q < 4; ++q) x[q] = xf[q]; }
            else RP_COMBINE(P, x, gac);
            if (k < 9) { const int rn = RW_RC(k + 1);
                if (FIRST) {
#pragma unroll
                    for (int q = 0; q < 4; ++q) xf[q] = *(const f32x4*)(xsrcf + (size_t)rn * D + 4 * F.lane + 256 * q); }
                else { P.p0 = q0; P.p1 = q1; RP_LOAD(P, rn); const int r2 = RW_RC(k < 8 ? k + 2 : 9); q0 = offs_[toke_[2 * r2]] + tokr_[2 * r2]; q1 = offs_[toke_[2 * r2 + 1]] + tokr_[2 * r2 + 1]; } }
            if (!FIRST && k >= 1 && k <= 8) row_store_bf16(xdst + (size_t)r * D, F.lane, x);
            { float ss = 0.f;
#pragma unroll
              for (int q = 0; q < 4; ++q) ss += (x[q][0] * x[q][0] + x[q][1] * x[q][1]) + (x[q][2] * x[q][2] + x[q][3] * x[q][3]);
              const float rstd = valid ? rsqrtf(wave_sum(ss, F.lane) * (1.0f / D) + RMS_EPS) : 0.f; const float vm = valid ? 1.0f : 0.f;
#pragma unroll
              for (int q = 0; q < 4; ++q) { prev[q] = cur[q]; cur[q] = nxt[q]; nxt[q] = x[q] * rstd * gcv[q] + shv[q] * vm; } }
            if (k >= 2) { const int row = row0 + k - 2;
                f32x4 xx[4];
#pragma unroll
                for (int q = 0; q < 4; ++q) xx[q] = 0.5f * (prev[q] + nxt[q]) - cur[q];
#pragma unroll
                for (int mi = 0; mi < 3; ++mi) { f32x4 o[4];
#pragma unroll
                    for (int q = 0; q < 4; ++q) { const f32x4 m = *(const LAS f32x4*)(MU + mi * D + 4 * F.lane + 256 * q); o[q] = cur[q] + xx[q] * m; }
                    row_store_i8(xs + ((size_t)mi * T + row) * D, sxs + (size_t)mi * T + row, F.lane, o); }
                row_store_bf16(hx + (size_t)row * 2048, F.lane, cur);
                row_store_bf16(hx + (size_t)row * 2048 + D, F.lane, xx); }
        }
#undef RW_RC
    }
}

__device__ __forceinline__ void phase_at_norm(Frame& F, int l, const bf16* xsrc, bf16* xdst) {
    moe_tables(F, l - 1);
    const float* mod = (const float*)(F.ws + WS_MOD); signed char* H8 = (signed char*)(F.ws + WS_ACT + A_H); float* SA = (float*)(F.ws + WS_SA);
    const bf16* ys_ = (const bf16*)(F.ws + WS_ACT + A_YS); const int* toke_ = (const int*)(F.ws + WS_TOKE); const int* tokr_ = (const int*)(F.ws + WS_TOKR); const LAS int* offs_ = (const LAS int*)(F.lds + OFFS_OFF);
    for (int base = F.gw * 8; base < T; base += F.NGW * 8) {
        const int b = base >> 11;
        f32x4 gac[4], gcv[4], shv[4];
        { const float* mp = mod + (size_t)(l * 8 + b) * 6144; const float* gp = mod + (size_t)((l - 1) * 8 + b) * 6144 + 5 * D;
#pragma unroll
          for (int j = 0; j < 4; ++j) { gac[j] = *(const f32x4*)(gp + 4 * F.lane + 256 * j); const f32x4 g = *(const f32x4*)(F.in[I_NTM] + l * D + 4 * F.lane + 256 * j), c = *(const f32x4*)(mp + 1 * D + 4 * F.lane + 256 * j);
              gcv[j] = g * (1.0f + c); shv[j] = *(const f32x4*)(mp + 0 * D + 4 * F.lane + 256 * j); } }
        RowPipe P; RP_IDX(P, base); RP_LOAD(P, base); int q0 = 0, q1 = 0;
        { const int r1 = base + 1; q0 = offs_[toke_[2 * r1]] + tokr_[2 * r1]; q1 = offs_[toke_[2 * r1 + 1]] + tokr_[2 * r1 + 1]; }
#pragma clang loop unroll(disable)
        for (int i = 0; i < 8; ++i) {
            const int row = base + i;
            f32x4 x[4], h[4]; RP_COMBINE(P, x, gac);
            if (i < 7) { P.p0 = q0; P.p1 = q1; RP_LOAD(P, row + 1); const int r2 = (i < 6) ? row + 2 : row + 1; q0 = offs_[toke_[2 * r2]] + tokr_[2 * r2]; q1 = offs_[toke_[2 * r2 + 1]] + tokr_[2 * r2 + 1]; }
            row_store_bf16(xdst + (size_t)row * D, F.lane, x);
            { float ss = 0.f;
#pragma unroll
              for (int j = 0; j < 4; ++j) ss += (x[j][0] * x[j][0] + x[j][1] * x[j][1]) + (x[j][2] * x[j][2] + x[j][3] * x[j][3]);
              const float rstd = rsqrtf(wave_sum(ss, F.lane) * (1.0f / D) + RMS_EPS);
#pragma unroll
              for (int j = 0; j < 4; ++j) h[j] = x[j] * rstd * gcv[j] + shv[j]; }
            float am = 0.f;
#pragma unroll
            for (int j = 0; j < 4; ++j) am = fmaxf(am, fmaxf(fmaxf(fabsf(h[j][0]), fabsf(h[j][1])), fmaxf(fabsf(h[j][2]), fabsf(h[j][3]))));
            am = fmaxf(wave_max(am), 1e-20f); const float inv = 127.0f / am;
            if (F.lane == 0) SA[row] = am * (1.0f / 127.0f);
#pragma unroll
            for (int j = 0; j < 4; ++j) *(unsigned*)(H8 + (size_t)row * D + 4 * F.lane + 256 * j) = pack_i8x4(h[j], inv);
        }
    }
}
__device__ __forceinline__ void phase_final(Frame& F, const bf16* xsrc) {
    moe_tables(F, DEPTH - 1);
    const float* mod = (const float*)(F.ws + WS_MOD); const float* fg = F.in[I_FG];
    const bf16* ys_ = (const bf16*)(F.ws + WS_ACT + A_YS); const int* toke_ = (const int*)(F.ws + WS_TOKE); const int* tokr_ = (const int*)(F.ws + WS_TOKR); const LAS int* offs_ = (const LAS int*)(F.lds + OFFS_OFF);
    for (int base = F.gw * 8; base < T; base += F.NGW * 8) {
        const int b = base >> 11;
        f32x4 gac[4], fgv[4];
#pragma unroll
        for (int j = 0; j < 4; ++j) { gac[j] = *(const f32x4*)(mod + (size_t)(3 * 8 + b) * 6144 + 5 * D + 4 * F.lane + 256 * j); fgv[j] = *(const f32x4*)(fg + 4 * F.lane + 256 * j); }
        RowPipe P; RP_IDX(P, base); RP_LOAD(P, base); int q0 = 0, q1 = 0;
        { const int r1 = base + 1; q0 = offs_[toke_[2 * r1]] + tokr_[2 * r1]; q1 = offs_[toke_[2 * r1 + 1]] + tokr_[2 * r1 + 1]; }
#pragma clang loop unroll(disable)
        for (int i = 0; i < 8; ++i) {
            const int row = base + i;
            f32x4 x[4]; RP_COMBINE(P, x, gac);
            if (i < 7) { P.p0 = q0; P.p1 = q1; RP_LOAD(P, row + 1); const int r2 = (i < 6) ? row + 2 : row + 1; q0 = offs_[toke_[2 * r2]] + tokr_[2 * r2]; q1 = offs_[toke_[2 * r2 + 1]] + tokr_[2 * r2 + 1]; }
            float s = 0.f;
#pragma unroll
            for (int j = 0; j < 4; ++j) s += (x[j][0] * x[j][0] + x[j][1] * x[j][1]) + (x[j][2] * x[j][2] + x[j][3] * x[j][3]);
            const float rstd = rsqrtf(wave_sum(s, F.lane) * (1.0f / D) + RMS_EPS);
#pragma unroll
            for (int j = 0; j < 4; ++j) x[j] = x[j] * rstd * fgv[j];
            row_store(F.out + (size_t)row * D, F.lane, x);
        }
    }
}
#undef RP_IDX
#undef RP_LOAD
#undef RP_COMBINE

__device__ __forceinline__ void moe_convert(Frame& F, int l, int bfirst, int bstride);
__device__ __forceinline__ void phase_moe_route(Frame& F, int l, const bf16* xsrc, int cnt_shift = 0) {
    const float* mod = (const float*)(F.ws + WS_MOD); bf16* HN = (bf16*)(F.ws + WS_ACT + A_HN2);
    LAS int* lcnt = (LAS int*)F.lds; LAS int* gbase = lcnt + 32; LAS int* inf_e = lcnt + 64; LAS int* inf_r = inf_e + 128; LAS float* inf_w = (LAS float*)(inf_r + 128);
    unsigned* cnt = (unsigned*)(F.ws + WS_CTL) + CW_CNT + (l + cnt_shift) * 32;
    int* toke = (int*)(F.ws + WS_TOKE); int* tokr = (int*)(F.ws + WS_TOKR); float* tokw = (float*)(F.ws + WS_TOKW);
    const float* rg = F.in[I_RG] + (size_t)l * D * 4; const float* rgb = F.in[I_RGB] + l * 4;
    LAS float* RW = (LAS float*)(F.lds + 4096);
    {
      f32x4 tg[2];
#pragma unroll
      for (int u = 0; u < 2; ++u) tg[u] = *(const f32x4*)(rg + 4 * (F.tid + u * NTHREADS));
      const float* rea = F.in[I_RE] + (size_t)l * 4 * D * 8;
      f32x4 te[4][2];
#pragma unroll
      for (int u = 0; u < 4; ++u) { const int p = F.tid + u * NTHREADS; te[u][0] = *(const f32x4*)(rea + 8 * p); te[u][1] = *(const f32x4*)(rea + 8 * p + 4); }
#pragma unroll
      for (int u = 0; u < 2; ++u) { const int k = F.tid + u * NTHREADS;
#pragma unroll
          for (int e = 0; e < 4; ++e) RW[e * D + k] = tg[u][e]; }
#pragma unroll
      for (int hh = 0; hh < 2; ++hh) {
          if (hh == 1) {
#pragma unroll
              for (int u = 0; u < 4; ++u) { const int p = F.tid + (4 + u) * NTHREADS; te[u][0] = *(const f32x4*)(rea + 8 * p); te[u][1] = *(const f32x4*)(rea + 8 * p + 4); } }
#pragma unroll
          for (int u = 0; u < 4; ++u) { const int p = F.tid + (4 * hh + u) * NTHREADS; const int g = p >> 10, k = p & 1023;
#pragma unroll
              for (int e = 0; e < 8; ++e) RW[(4 + g * 8 + e) * D + k] = te[u][e >> 2][e & 3]; } } }
    for (int cb = blockIdx.x; cb < T / 64; cb += F.G) {
        if (F.tid < 32) lcnt[F.tid] = 0;
        __syncthreads();
        f32x4 gcv[4], shv[4];
        { const float* mp = mod + (size_t)(l * 8 + ((cb * 64) >> 11)) * 6144;
#pragma unroll
          for (int j = 0; j < 4; ++j) { const f32x4 g = *(const f32x4*)(F.in[I_NCM] + l * D + 4 * F.lane + 256 * j), c = *(const f32x4*)(mp + 4 * D + 4 * F.lane + 256 * j); gcv[j] = g * (1.0f + c); shv[j] = *(const f32x4*)(mp + 3 * D + 4 * F.lane + 256 * j); } }
        u32x2 raw[4];
#pragma unroll
        for (int j = 0; j < 4; ++j) raw[j] = *(const u32x2*)(xsrc + (size_t)(cb * 64 + F.wave * 8) * D + 4 * F.lane + 256 * j);
#pragma clang loop unroll(disable)
        for (int i = 0; i < 8; ++i) {
            const int lr = F.wave * 8 + i, row = cb * 64 + lr;
            f32x4 x[4], h[4];
#pragma unroll
            for (int j = 0; j < 4; ++j) x[j] = (f32x4){bf_lo(raw[j].x), bf_hi(raw[j].x), bf_lo(raw[j].y), bf_hi(raw[j].y)};
            { const int rn = (i < 7) ? row + 1 : row;
#pragma unroll
              for (int j = 0; j < 4; ++j) raw[j] = *(const u32x2*)(xsrc + (size_t)rn * D + 4 * F.lane + 256 * j); }
            { float ss = 0.f;
#pragma unroll
              for (int j = 0; j < 4; ++j) ss += (x[j][0] * x[j][0] + x[j][1] * x[j][1]) + (x[j][2] * x[j][2] + x[j][3] * x[j][3]);
              const float rstd = rsqrtf(wave_sum(ss, F.lane) * (1.0f / D) + RMS_EPS);
#pragma unroll
              for (int j = 0; j < 4; ++j) h[j] = x[j] * rstd * gcv[j] + shv[j]; }
            row_store_i8((signed char*)HN + (size_t)row * D, (float*)(F.ws + WS_SCL + SCL_HN) + row, F.lane, h);
            float gl[4] = {0.f, 0.f, 0.f, 0.f};
#pragma unroll
            for (int e = 0; e < 4; ++e)
#pragma unroll
                for (int j = 0; j < 4; ++j) { const f32x4 w = *(const LAS f32x4*)(RW + e * D + 4 * F.lane + 256 * j); gl[e] += (h[j][0] * w[0] + h[j][1] * w[1]) + (h[j][2] * w[2] + h[j][3] * w[3]); }
#pragma unroll
            for (int e = 0; e < 4; ++e) gl[e] = wave_sum(gl[e], F.lane) + rgb[e];
            const float gm = fmaxf(fmaxf(gl[0], gl[1]), fmaxf(gl[2], gl[3]));
            const int gtop = (gl[0] == gm) ? 0 : (gl[1] == gm) ? 1 : (gl[2] == gm) ? 2 : 3;
            const float pg = 1.0f / (__expf(gl[0] - gm) + __expf(gl[1] - gm) + __expf(gl[2] - gm) + __expf(gl[3] - gm));
            const float* reb = F.in[I_REB] + (l * 4 + gtop) * 8; const LAS float* rwe = RW + (4 + gtop * 8) * D + 4 * F.lane;
            float el[8];
#pragma unroll
            for (int e = 0; e < 8; ++e) { el[e] = 0.f;
#pragma unroll
                for (int j = 0; j < 4; ++j) { const f32x4 w = *(const LAS f32x4*)(rwe + e * D + 256 * j); el[e] += (h[j][0] * w[0] + h[j][1] * w[1]) + (h[j][2] * w[2] + h[j][3] * w[3]); } }
#pragma unroll
            for (int e = 0; e < 8; ++e) el[e] = wave_sum(el[e], F.lane) + reb[e];
            float v0 = el[0]; int i0 = 0;
#pragma unroll
            for (int e = 1; e < 8; ++e) if (el[e] > v0) { v0 = el[e]; i0 = e; }
            float v1 = -3.0e38f; int i1 = 0;
#pragma unroll
            for (int e = 0; e < 8; ++e) if (e != i0 && el[e] > v1) { v1 = el[e]; i1 = e; }
            const float ex = __expf(v1 - v0); const float w0 = pg / (1.0f + ex), w1 = pg * ex / (1.0f + ex);
            if (F.lane == 0) {
                const int e0 = gtop * 8 + i0, e1 = gtop * 8 + i1;
                const int r0 = __hip_atomic_fetch_add(lcnt + e0, 1, __ATOMIC_RELAXED, __HIP_MEMORY_SCOPE_WORKGROUP);
                const int r1 = __hip_atomic_fetch_add(lcnt + e1, 1, __ATOMIC_RELAXED, __HIP_MEMORY_SCOPE_WORKGROUP);
                inf_e[lr * 2] = e0; inf_e[lr * 2 + 1] = e1; inf_r[lr * 2] = r0; inf_r[lr * 2 + 1] = r1; inf_w[lr * 2] = w0; inf_w[lr * 2 + 1] = w1;
            }
        }
        __syncthreads();
        if (F.tid < 32) gbase[F.tid] = (int)__hip_atomic_fetch_add(cnt + F.tid, (unsigned)lcnt[F.tid], __ATOMIC_RELAXED, __HIP_MEMORY_SCOPE_AGENT);
        __syncthreads();
        if (F.tid < 128) { const int idx = cb * 128 + F.tid; const int e = inf_e[F.tid]; const int rk = gbase[e] + inf_r[F.tid]; toke[idx] = e; tokr[idx] = rk;
            ((int*)(F.ws + WS_ACT + A_LSTT))[(size_t)e * LCAP + rk] = idx >> 1; ((float*)(F.ws + WS_ACT + A_LSTW))[(size_t)e * LCAP + rk] = inf_w[F.tid]; }
        __syncthreads();
    }
    if (l == 0 && cnt_shift == 0) moe_convert(F, 0, (int)blockIdx.x, F.G);
}
__device__ __forceinline__ void moe_convert(Frame& F, int l, int bfirst, int bstride) {
    LAS float* scr = (LAS float*)(F.lds + 49152 + F.wave * 8704);
    signed char* WGU = (signed char*)(F.ws + ws_wm_of(l) + W_GU); float* SGU = (float*)(F.ws + ws_wm_of(l) + W_GUS); bf16* WDN = (bf16*)(F.ws + ws_wm_of(l) + W_DN);
    for (int it = bfirst; it < NEXP * 16; it += bstride) {
        const int e = it >> 4, up = (it >> 3) & 1, nb = it & 7, n0 = nb * 32;
        const int drow = (n0 >> 7) * 256 + up * 128 + (n0 & 127);
        conv8_cols32(F, (up ? F.in[I_WU] : F.in[I_WG]) + (size_t)(l * 32 + e) * D * FEXP + n0, FEXP, WGU + ((size_t)e * 512 + drow) * D, SGU + (size_t)e * 512 + drow);
    }
    for (int it = bfirst * NWAVES + F.wave; it < NEXP * 128; it += bstride * NWAVES) {
        const int e = it >> 7, r = it & 127; const int kb = r / 32, nb = r % 32;
        const float* src = F.in[I_WD] + ((size_t)(l * 32 + e) * FEXP + kb * 64) * D + nb * 32;
        transpose_item(src, D, WDN + ((size_t)e * D + nb * 32) * FEXP + kb * 64, FEXP, scr, F.lane);
    }
}

#ifndef SCAN_DUP
#define SCAN_DUP 0
#endif
namespace wk {
constexpr int P = 72, PB = 144, MAT = 64 * PB;
constexpr int PF = 68;
constexpr int O_NAB = 0, O_GS = 17408, O_GC = 19456, O_M0 = 20480;
constexpr int O_AT = O_M0, O_RT = O_AT + MAT, O_BT = O_RT + MAT, O_KT = O_BT + MAT, O_VV = O_KT + MAT, O_LAK = O_VV + MAT, O_MRB = O_LAK + MAT, O_MRK = O_MRB + MAT,
              O_NB = O_MRK + MAT, O_TT = O_NB + MAT, O_XT = O_TT + MAT, O_UT = O_XT + MAT, O_MT = O_UT + MAT, O_H0 = O_MT + MAT, O_H1 = O_H0 + MAT, O_END = O_H1 + MAT;
static_assert(O_END <= LDS_MISC, "scan LDS map");
typedef union { u32x4 u; bf16x8 v; } frag_t;
__device__ __forceinline__ bf16x8 zfrag() { frag_t z; z.u = (u32x4){0u, 0u, 0u, 0u}; return z.v; }
__device__ __forceinline__ bf16x8 ldrow(const LAS unsigned char* M, int row, int col) { return *(const LAS bf16x8*)(M + row * PB + col * 2); }
__device__ __forceinline__ bf16x8 ldtr(unsigned base, int r0, int c0, int lane) {
    const int g = lane >> 4, i = lane & 15, qq = i >> 2, p = i & 3;
    const unsigned a0 = base + (unsigned)((r0 + 8 * g + qq) * PB + (c0 + 4 * p) * 2), a1 = a0 + 4u * PB;
    u32x2 lo, hi;
    asm volatile("ds_read_b64_tr_b16 %0, %2\n\tds_read_b64_tr_b16 %1, %3\n\ts_waitcnt lgkmcnt(0)" : "=&v"(lo), "=&v"(hi) : "v"(a0), "v"(a1) : "memory");
    frag_t f; f.u.x = lo.x; f.u.y = lo.y; f.u.z = hi.x; f.u.w = hi.y; return f.v;
}
__device__ __forceinline__ void st4bf(LAS unsigned char* M, int row, int col, const f32x4& v) { u32x2 w; w.x = pk2(v[0], v[1]); w.y = pk2(v[2], v[3]); *(LAS u32x2*)(M + row * PB + col * 2) = w; }
#define WK_MFMA(a, b, c) __builtin_amdgcn_mfma_f32_16x16x32_bf16(a, b, c, 0, 0, 0)
template <int M> __device__ __forceinline__ float rshare(float v) { return __int_as_float(__builtin_amdgcn_update_dpp(0, __float_as_int(v), 0x150 + M, 0xf, 0xf, false)); }
#define WK_BAR() do { asm volatile("s_waitcnt lgkmcnt(0)" ::: "memory"); __builtin_amdgcn_s_barrier(); asm volatile("" ::: "memory"); } while (0)
}

__device__ __forceinline__ void phase_scan(Frame& F, int l) {
    using namespace wk;
    const int j = l >> 1;
    const bf16* Rb = (const bf16*)(F.ws + WS_ACT + A_RKV); const bf16* Kb = Rb + (size_t)T * D; const bf16* Vb = Kb + (size_t)T * D;
    const bf16* LD = (const bf16*)(F.ws + WS_ACT + A_LDEC); const bf16* AS = (const bf16*)(F.ws + WS_ACT + A_ASIG);
    bf16* Y = (bf16*)(F.ws + WS_ACT + A_Y); float* SB = (float*)(F.ws + WS_SB);
    LAS unsigned char* L = F.lds; const unsigned La = (unsigned)(size_t)L;
    LAS float* NAB = (LAS float*)(L + O_NAB); LAS float* GS = (LAS float*)(L + O_GS); LAS float* GC = (LAS float*)(L + O_GC);
    const int tid0 = F.tid, wave = F.wave;
    for (int unit = blockIdx.x; unit < NB * NH_R * 2; unit += F.G) {
        const int b = unit >> 5, h = (unit >> 1) & 15, dir = unit & 1; const int col = h * 64 + 8 * (tid0 & 7);
        f32x4 kkc[2], kac[2], rkc[2];
#pragma unroll
        for (int e = 0; e < 2; ++e) { kkc[e] = *(const f32x4*)(F.in[I_KK] + j * D + col + 4 * e); kac[e] = *(const f32x4*)(F.in[I_KA] + j * D + col + 4 * e); rkc[e] = *(const f32x4*)(F.in[I_RK] + j * D + col + 4 * e); }
        for (int i = tid0; i < (O_END - O_LAK) / 16; i += NTHREADS) *(LAS u32x4*)(L + O_LAK + i * 16) = (u32x4){0u, 0u, 0u, 0u};
        f32x4 Hs[4];
        f32x4 Yh[4];
#define WK_YFLUSH(cc) do { if (wave >= 4) { const int lane_ = tid0 & 63, qi_ = lane_ & 15, q4_ = lane_ >> 4, vj_ = wave - 4; \
            _Pragma("unroll") for (int ti_ = 0; ti_ < 4; ++ti_) _Pragma("unroll") for (int r_ = 0; r_ < 4; ++r_) { const int st_ = (cc) * 64 + 16 * ti_ + 4 * q4_ + r_; const int t_ = dir ? (SEQ - 1 - st_) : st_; \
                Y[((size_t)dir * T + (size_t)b * SEQ + t_) * D + h * 64 + 16 * vj_ + qi_] = (bf16)f2bf(Yh[ti_][r_]); } } } while (0)
#pragma unroll
        for (int vj = 0; vj < 4; ++vj) Hs[vj] = (f32x4){0.f, 0.f, 0.f, 0.f};
        u32x4 gr, gk, gv, gl, ga;
#define WK_LOAD(c) do { const int st = (c) * 64 + (tid0 >> 3); const int t = dir ? (SEQ - 1 - st) : st; const size_t ro = ((size_t)b * SEQ + t) * D + col; \
            gr = *(const u32x4*)(Rb + ro); gk = *(const u32x4*)(Kb + ro); gv = *(const u32x4*)(Vb + ro); gl = *(const u32x4*)(LD + (size_t)dir * T * D + ro); ga = *(const u32x4*)(AS + (size_t)dir * T * D + ro); } while (0)
        WK_LOAD(0);
        WK_BAR();
        for (int c = 0; c < SEQ / 64; ++c) {
            int tid = tid0; asm volatile("" : "+v"(tid));
            const int lane = tid & 63, qi = lane & 15, q4 = lane >> 4, pt = tid >> 3, c8 = tid & 7;
            LAS unsigned char* H0 = L + ((c & 1) ? O_H1 : O_H0); LAS unsigned char* H1 = L + ((c & 1) ? O_H0 : O_H1);
            for (int sd0_ = 0; sd0_ < 1 + ((SCAN_DUP >> 0) & 1); ++sd0_) {
            float av[8], bv[8], kdv[8], rv[8], ldv[8];
            {
                const unsigned gku[4] = {gk.x, gk.y, gk.z, gk.w}, gru[4] = {gr.x, gr.y, gr.z, gr.w}, glu[4] = {gl.x, gl.y, gl.z, gl.w}, gau[4] = {ga.x, ga.y, ga.z, ga.w};
                float kf[8], af[8], kkv[8]; float ss = 0.f;
#pragma unroll
                for (int e = 0; e < 4; ++e) { kf[2 * e] = bf_lo(gku[e]); kf[2 * e + 1] = bf_hi(gku[e]); rv[2 * e] = bf_lo(gru[e]); rv[2 * e + 1] = bf_hi(gru[e]);
                    ldv[2 * e] = bf_lo(glu[e]); ldv[2 * e + 1] = bf_hi(glu[e]); af[2 * e] = bf_lo(gau[e]); af[2 * e + 1] = bf_hi(gau[e]); }
#pragma unroll
                for (int e = 0; e < 8; ++e) { kkv[e] = kf[e] * kkc[e >> 2][e & 3]; ss += kkv[e] * kkv[e]; }
                ss = sum8(ss);
                const float inv = 1.0f / fmaxf(sqrtf(ss), 1e-12f); float bo = 0.f;
#pragma unroll
                for (int e = 0; e < 8; ++e) { const float kn = kkv[e] * inv; kdv[e] = kf[e] * (1.0f + (af[e] - 1.0f) * kac[e >> 2][e & 3]); av[e] = -kn; bv[e] = kn * af[e]; bo += rv[e] * kdv[e] * rkc[e >> 2][e & 3]; }
                bo = sum8(bo);
                const int st = c * 64 + pt; const int t = dir ? (SEQ - 1 - st) : st;
                if (c8 == 0) SB[((size_t)dir * T + (size_t)b * SEQ + t) * 16 + h] = bo;
                *(LAS f32x4*)(NAB + pt * PF + 8 * c8) = (f32x4){ldv[0], ldv[1], ldv[2], ldv[3]}; *(LAS f32x4*)(NAB + pt * PF + 8 * c8 + 4) = (f32x4){ldv[4], ldv[5], ldv[6], ldv[7]};
                *(LAS u32x4*)(L + O_VV + pt * PB + 16 * c8) = gv;
            }
            if (sd0_ == ((SCAN_DUP >> 0) & 1)) { if (c > 0) WK_YFLUSH(c - 1); if (c + 1 < SEQ / 64) WK_LOAD(c + 1); }
            WK_BAR();
            { const int kc = tid & 63, g = tid >> 6; float pre[8]; float p = 0.f;
#pragma unroll
              for (int i = 0; i < 8; ++i) { p += NAB[(8 * g + i) * PF + kc]; pre[i] = p; }
              GS[g * 64 + kc] = p;
              WK_BAR();
              float off = 0.f;
#pragma unroll
              for (int gg = 0; gg < 7; ++gg) off += (gg < g) ? GS[gg * 64 + kc] : 0.f;
#pragma unroll
              for (int i = 0; i < 8; ++i) NAB[(8 * g + i) * PF + kc] = off + pre[i]; }
            WK_BAR();
            { f32x4 cl[2], cm[2];
#pragma unroll
              for (int e = 0; e < 2; ++e) { cl[e] = *(const LAS f32x4*)(NAB + pt * PF + 8 * c8 + 4 * e); cm[e] = (pt > 0) ? *(const LAS f32x4*)(NAB + (pt - 1) * PF + 8 * c8 + 4 * e) : (f32x4){0.f, 0.f, 0.f, 0.f}; }
              float oa[8], orr[8], ob[8], ok[8];
#pragma unroll
              for (int e = 0; e < 8; ++e) { const float c1 = cl[e >> 2][e & 3], c0 = cm[e >> 2][e & 3]; const float gp = __builtin_amdgcn_exp2f(c1), gn = __builtin_amdgcn_exp2f(-c1), g0 = __builtin_amdgcn_exp2f(c0);
                  oa[e] = av[e] * g0; orr[e] = rv[e] * gp; ob[e] = bv[e] * gn; ok[e] = kdv[e] * gn; if (pt == 63) GC[8 * c8 + e] = gp; }
              *(LAS u32x4*)(L + O_AT + pt * PB + 16 * c8) = (u32x4){pk2(oa[0], oa[1]), pk2(oa[2], oa[3]), pk2(oa[4], oa[5]), pk2(oa[6], oa[7])};
              *(LAS u32x4*)(L + O_RT + pt * PB + 16 * c8) = (u32x4){pk2(orr[0], orr[1]), pk2(orr[2], orr[3]), pk2(orr[4], orr[5]), pk2(orr[6], orr[7])};
              *(LAS u32x4*)(L + O_BT + pt * PB + 16 * c8) = (u32x4){pk2(ob[0], ob[1]), pk2(ob[2], ob[3]), pk2(ob[4], ob[5]), pk2(ob[6], ob[7])};
              *(LAS u32x4*)(L + O_KT + pt * PB + 16 * c8) = (u32x4){pk2(ok[0], ok[1]), pk2(ok[2], ok[3]), pk2(ok[4], ok[5]), pk2(ok[6], ok[7])}; }
            WK_BAR();
            }
            f32x4 X0[4], Y0[4];
            for (int sd1_ = 0; sd1_ < 1 + ((SCAN_DUP >> 1) & 1); ++sd1_) {
#pragma unroll
            for (int jj = 0; jj < 5; ++jj) {
                const int idx = wave * 5 + jj, blk = idx / 10, tri = idx % 10;
                const int ti = (tri >= 6) ? 3 : ((tri >= 3) ? 2 : ((tri >= 1) ? 1 : 0)); const int si = tri - (ti * (ti + 1)) / 2;
                const LAS unsigned char* Pm = L + ((blk < 2) ? O_AT : O_RT); const LAS unsigned char* Qm = L + ((blk & 1) ? O_KT : O_BT);
                f32x4 acc = {0.f, 0.f, 0.f, 0.f};
#pragma unroll
                for (int ks = 0; ks < 2; ++ks) acc = WK_MFMA(ldrow(Qm, 16 * si + qi, 32 * ks + 8 * q4), ldrow(Pm, 16 * ti + qi, 32 * ks + 8 * q4), acc);
                const int tt = 16 * ti + qi, s0 = 16 * si + 4 * q4;
#pragma unroll
                for (int r = 0; r < 4; ++r) { const int sidx = s0 + r; const bool keep = (blk < 2) ? (sidx < tt) : (sidx <= tt); acc[r] = keep ? acc[r] : 0.f; }
                if (blk == 0) { *(LAS f32x4*)(NAB + tt * PF + s0) = acc; st4bf(L + O_NB, tt, s0, acc); }
                else st4bf(L + (blk == 1 ? O_LAK : (blk == 2 ? O_MRB : O_MRK)), tt, s0, acc);
            }
            WK_BAR();
            }
            for (int sd2_ = 0; sd2_ < 1 + ((SCAN_DUP >> 2) & 1); ++sd2_) {
            if (wave >= 4) { const int vj = wave - 4;
#pragma unroll
                for (int ti = 0; ti < 4; ++ti) { X0[ti] = (f32x4){0.f, 0.f, 0.f, 0.f}; Y0[ti] = (f32x4){0.f, 0.f, 0.f, 0.f};
#pragma unroll
                    for (int ks = 0; ks < 2; ++ks) if (ks <= (ti >> 1)) { const bf16x8 vf = ldtr(La + O_VV, 32 * ks, 16 * vj, lane);
                        X0[ti] = WK_MFMA(ldrow(L + O_LAK, 16 * ti + qi, 32 * ks + 8 * q4), vf, X0[ti]); Y0[ti] = WK_MFMA(ldrow(L + O_MRK, 16 * ti + qi, 32 * ks + 8 * q4), vf, Y0[ti]); } } }
            if (wave == 0) {
                const int blk = q4, cj = qi; float nrow[16], x[16];
#pragma unroll
                for (int r = 0; r < 16; ++r) nrow[r] = NAB[(16 * blk + r) * PF + 16 * blk + cj];
#pragma unroll
                for (int r = 0; r < 16; ++r) { float acc = (r == cj) ? 1.0f : 0.0f;
#define WK_SUBM(m) if (m < r) acc += wk::rshare<m>(nrow[r]) * x[m];
                    WK_SUBM(0) WK_SUBM(1) WK_SUBM(2) WK_SUBM(3) WK_SUBM(4) WK_SUBM(5) WK_SUBM(6) WK_SUBM(7) WK_SUBM(8) WK_SUBM(9) WK_SUBM(10) WK_SUBM(11) WK_SUBM(12) WK_SUBM(13) WK_SUBM(14)
#undef WK_SUBM
                    x[r] = acc; *(LAS bf16*)(L + O_TT + (16 * blk + r) * PB + (16 * blk + cj) * 2) = (bf16)f2bf(acc); }
            }
            WK_BAR();
            if (wave < 2) {
                const int i = 2 * wave + 1, jb = 2 * wave;
                { bf16x8 a = ldrow(L + O_NB, 16 * i + qi, 16 * jb + 8 * (q4 & 1)), bfr = ldtr(La + O_TT, 16 * jb - 8 * (q4 & 2), 16 * jb, lane);
                  if (q4 >= 2) { a = zfrag(); bfr = zfrag(); }
                  f32x4 acc = {0.f, 0.f, 0.f, 0.f}; acc = WK_MFMA(a, bfr, acc);
                  st4bf(L + O_MT, 16 * wave + qi, 4 * q4, acc); }
                asm volatile("s_waitcnt lgkmcnt(0)" ::: "memory");
                { bf16x8 a = ldrow(L + O_TT, 16 * i + qi, 16 * i + 8 * (q4 & 1)), bfr = ldrow(L + O_MT, 16 * wave + qi, 8 * (q4 & 1));
                  if (q4 >= 2) { a = zfrag(); bfr = zfrag(); }
                  f32x4 acc = {0.f, 0.f, 0.f, 0.f}; acc = WK_MFMA(a, bfr, acc);
#pragma unroll
                  for (int r = 0; r < 4; ++r) *(LAS bf16*)(L + O_TT + (16 * i + 4 * q4 + r) * PB + (16 * jb + qi) * 2) = (bf16)f2bf(acc[r]); }
            }
            WK_BAR();
            if (wave < 4) {
                const int ti2 = wave >> 1, tj2 = wave & 1;
                { const bf16x8 bfr = ldtr(La + O_TT, 0, 16 * tj2, lane);
#pragma unroll
                  for (int tt = 0; tt < 2; ++tt) { f32x4 acc = {0.f, 0.f, 0.f, 0.f}; acc = WK_MFMA(ldrow(L + O_NB, 32 + 16 * tt + qi, 8 * q4), bfr, acc); st4bf(L + O_MT, 32 + 16 * tj2 + qi, 16 * tt + 4 * q4, acc); } }
                asm volatile("s_waitcnt lgkmcnt(0)" ::: "memory");
                { f32x4 acc = {0.f, 0.f, 0.f, 0.f}; acc = WK_MFMA(ldrow(L + O_TT, 32 + 16 * ti2 + qi, 32 + 8 * q4), ldrow(L + O_MT, 32 + 16 * tj2 + qi, 8 * q4), acc);
#pragma unroll
                  for (int r = 0; r < 4; ++r) *(LAS bf16*)(L + O_TT + (32 + 16 * ti2 + 4 * q4 + r) * PB + (16 * tj2 + qi) * 2) = (bf16)f2bf(acc[r]); }
            }
            }
            for (int sd3_ = 0; sd3_ < 1 + ((SCAN_DUP >> 3) & 1); ++sd3_) {
            if (wave >= 4) { const int vj = wave - 4;
#pragma unroll
                for (int ti = 0; ti < 4; ++ti) { f32x4 acc = X0[ti];
#pragma unroll
                    for (int ks = 0; ks < 2; ++ks) acc = WK_MFMA(ldrow(L + O_AT, 16 * ti + qi, 32 * ks + 8 * q4), ldrow(H0, 16 * vj + qi, 32 * ks + 8 * q4), acc);
                    st4bf(L + O_XT, 16 * vj + qi, 16 * ti + 4 * q4, acc); } }
            WK_BAR();
#pragma unroll
            for (int e = 0; e < 2; ++e) { const int id = wave * 2 + e, ti = id >> 2, vj = id & 3; f32x4 acc = {0.f, 0.f, 0.f, 0.f};
#pragma unroll
                for (int ks = 0; ks < 2; ++ks) if (ks <= (ti >> 1)) acc = WK_MFMA(ldrow(L + O_TT, 16 * ti + qi, 32 * ks + 8 * q4), ldrow(L + O_XT, 16 * vj + qi, 32 * ks + 8 * q4), acc);
                st4bf(L + O_UT, 16 * vj + qi, 16 * ti + 4 * q4, acc); }
            WK_BAR();
            }
            f32x4 Hsave[4]; for (int vj_ = 0; vj_ < 4; ++vj_) Hsave[vj_] = Hs[vj_];
            for (int sd5_ = 0; sd5_ < 1 + ((SCAN_DUP >> 4) & 1); ++sd5_) {
            for (int vj_ = 0; vj_ < 4; ++vj_) Hs[vj_] = Hsave[vj_];
            if (wave >= 4) { const int vj = wave - 4;
#pragma unroll
                for (int ti = 0; ti < 4; ++ti) { f32x4 acc = Y0[ti];
#pragma unroll
                    for (int ks = 0; ks < 2; ++ks) { acc = WK_MFMA(ldrow(L + O_RT, 16 * ti + qi, 32 * ks + 8 * q4), ldrow(H0, 16 * vj + qi, 32 * ks + 8 * q4), acc);
                        if (ks <= (ti >> 1)) acc = WK_MFMA(ldrow(L + O_MRB, 16 * ti + qi, 32 * ks + 8 * q4), ldrow(L + O_UT, 16 * vj + qi, 32 * ks + 8 * q4), acc); }
                    Yh[ti] = acc; } }
            else { const int kt = wave; const f32x4 gc = *(const LAS f32x4*)(GC + 16 * kt + 4 * q4);
#pragma unroll
                for (int ks = 0; ks < 2; ++ks) { const bf16x8 bt = ldtr(La + O_BT, 32 * ks, 16 * kt, lane), ktf = ldtr(La + O_KT, 32 * ks, 16 * kt, lane);
#pragma unroll
                    for (int vj = 0; vj < 4; ++vj) { Hs[vj] = WK_MFMA(bt, ldrow(L + O_UT, 16 * vj + qi, 32 * ks + 8 * q4), Hs[vj]); Hs[vj] = WK_MFMA(ktf, ldtr(La + O_VV, 32 * ks, 16 * vj, lane), Hs[vj]); } }
#pragma unroll
                for (int vj = 0; vj < 4; ++vj) { Hs[vj] = Hs[vj] * gc; st4bf(H1, 16 * vj + qi, 16 * kt + 4 * q4, Hs[vj]); } }
            WK_BAR();
            }
        }
        WK_YFLUSH(SEQ / 64 - 1);
#undef WK_LOAD
#undef WK_YFLUSH
    }
}

__device__ __forceinline__ void phase_rw_post(Frame& F, int l) {
    const int j = l >> 1; const float* lnw = F.in[I_LNW] + j * D; const float* lnb = F.in[I_LNB] + j * D;
    const bf16* Vb = (const bf16*)(F.ws + WS_ACT + A_RKV) + (size_t)2 * T * D; const bf16* Y = (const bf16*)(F.ws + WS_ACT + A_Y); const bf16* Gb = (const bf16*)(F.ws + WS_ACT + A_G);
    const float* SB = (const float*)(F.ws + WS_SB); bf16* O = (bf16*)(F.ws + WS_ACT + A_O);
    f32x4 wv[4], bv[4];
#pragma unroll
    for (int q = 0; q < 4; ++q) { wv[q] = *(const f32x4*)(lnw + 4 * F.lane + 256 * q); bv[q] = *(const f32x4*)(lnb + 4 * F.lane + 256 * q); }
    u32x2 vr[4], yr[2][4], gr[2][4]; float sb[2][4];
#define RWP_LOAD(row_) do { _Pragma("unroll") for (int q = 0; q < 4; ++q) { const int c = 4 * F.lane + 256 * q; const int head = 4 * q + (F.lane >> 4); vr[q] = *(const u32x2*)(Vb + (size_t)(row_) * D + c); \
        _Pragma("unroll") for (int dir = 0; dir < 2; ++dir) { const size_t ro = ((size_t)dir * T + (row_)) * D + c; yr[dir][q] = *(const u32x2*)(Y + ro); gr[dir][q] = *(const u32x2*)(Gb + ro); sb[dir][q] = SB[((size_t)dir * T + (row_)) * 16 + head]; } } } while (0)
    if (F.gw < T) RWP_LOAD(F.gw);
#pragma clang loop unroll(disable)
    for (int row = F.gw; row < T; row += F.NGW) {
        f32x4 o[4];
        u32x2 cv[4], cy[2][4], cg[2][4]; float cs[2][4];
#pragma unroll
        for (int q = 0; q < 4; ++q) { cv[q] = vr[q];
#pragma unroll
            for (int dir = 0; dir < 2; ++dir) { cy[dir][q] = yr[dir][q]; cg[dir][q] = gr[dir][q]; cs[dir][q] = sb[dir][q]; } }
        { const int rn = (row + F.NGW < T) ? row + F.NGW : row; RWP_LOAD(rn); }
#pragma unroll
        for (int q = 0; q < 4; ++q) {
            const f32x4 vf = {bf_lo(cv[q].x), bf_hi(cv[q].x), bf_lo(cv[q].y), bf_hi(cv[q].y)};
            f32x4 acc = {0.f, 0.f, 0.f, 0.f};
#pragma unroll
            for (int dir = 0; dir < 2; ++dir) {
                const u32x2 yy = cy[dir][q], gg = cg[dir][q];
                const f32x4 yf = {bf_lo(yy.x), bf_hi(yy.x), bf_lo(yy.y), bf_hi(yy.y)}; const f32x4 gf = {bf_lo(gg.x), bf_hi(gg.x), bf_lo(gg.y), bf_hi(gg.y)};
                const float sbv = cs[dir][q];
                const float mean = rowsum16((yf[0] + yf[1]) + (yf[2] + yf[3])) * (1.0f / 64.0f);
                const f32x4 d = yf - mean; const float var = rowsum16((d[0] * d[0] + d[1] * d[1]) + (d[2] * d[2] + d[3] * d[3])) * (1.0f / 64.0f);
                const float rs = rsqrtf(var + GN_EPS);
                acc += gf * (d * rs * wv[q] + bv[q] + sbv * vf);
            }
            o[q] = acc;
        }
        row_store_bf16(O + (size_t)row * D, F.lane, o);
    }
#undef RWP_LOAD
}

__device__ __forceinline__ unsigned att_f(unsigned row) { return ((row & 3u) << 2) | ((row >> 2) & 3u); }
__device__ __forceinline__ unsigned att_off_b(unsigned row, unsigned ch) { return 256u * row + 16u * (ch ^ att_f(row)); }
__device__ __forceinline__ void phase_attn(Frame& F, bool dry = false) {
    bf16* Qb = (bf16*)(F.ws + WS_ACT + A_Q); const bf16* Kb = (const bf16*)(F.ws + WS_ACT + A_K); const bf16* Vb = (const bf16*)(F.ws + WS_ACT + A_VT);
    float* LSE = (float*)(F.ws + WS_SB);
    const int lane = F.lane, qi = lane & 15, q4 = lane >> 4, wave = F.wave;
    LAS unsigned char* KW = F.lds; LAS unsigned char* VW = F.lds + 9 * 8192;
    const unsigned vw_a = (unsigned)(size_t)VW;
    unsigned ka[2][4], va[8][2];
#pragma unroll
    for (int rb = 0; rb < 2; ++rb)
#pragma unroll
        for (int s = 0; s < 4; ++s) ka[rb][s] = att_off_b((unsigned)(qi + 16 * rb), (unsigned)(4 * s + q4));
    { const unsigned q = (unsigned)qi >> 2, p = (unsigned)lane & 3u;
#pragma unroll
      for (int c = 0; c < 8; ++c)
#pragma unroll
          for (int t = 0; t < 2; ++t) va[c][t] = vw_a + att_off_b(8u * q4 + 4u * t + q, 2u * c + (p >> 1)) + 8u * (p & 1u); }
    constexpr int NU = 3 * NB * 8 * 16;
    const int per = (NU + F.G - 1) / F.G; const int n0 = (int)blockIdx.x * per; const int n1 = min(NU, n0 + per);
#define ATT_DECODE(n_, g_, b_, hs_, cls_, chunk_) const int g_ = (n_) >> 10, b_ = ((n_) >> 7) & 7, hs_ = ((n_) >> 4) & 7; const int cc##g_ = (n_) & 15; \
        const int cls_ = (g_ == 0) ? 0 : ((g_ == 1) ? (cc##g_ >> 2) : cc##g_); const int chunk_ = (g_ == 0) ? cc##g_ : ((g_ == 1) ? (cc##g_ & 3) : 0);
#define ATT_DMA(gp_, la_) asm volatile("s_mov_b32 m0, %0\n\ts_nop 0\n\tglobal_load_lds_dwordx4 %1, off" :: "s"(la_), "v"(gp_) : "m0", "memory")
#define ATT_LOAD_TILES(g_, b_, hs_, cls_, chunk_, first_, nt_, beta_) do { const int tb_ = (first_) + ((nt_) == 2 ? (wave >> 2) : 0); const int dsh_ = 2 * (g_); const int pos0_ = 128 * (chunk_) - 64 + 32 * tb_; \
        if (pos0_ >= 0 && pos0_ < (SEQ >> dsh_)) { const int slot_ = (tb_ + (beta_)) % 9; \
            const bf16* ksrc_ = Kb + ((size_t)(g_) * T + (size_t)(b_) * SEQ) * D + (hs_) * 128; const bf16* vsrc_ = Vb + ((size_t)(g_) * T + (size_t)(b_) * SEQ) * D + (hs_) * 128; \
            _Pragma("unroll") for (int ii_ = 0; ii_ < (nt_); ++ii_) { const int i_ = ((nt_) == 2) ? (2 * (wave & 3) + ii_) : wave; const unsigned rho_ = 4u * (unsigned)i_ + (unsigned)q4, m_ = rho_ & 15u, rb_ = rho_ >> 4; \
                const int kidx_ = (int)(8u * (m_ >> 2) + (m_ & 3u) + 4u * rb_); const unsigned coff_ = 16u * ((unsigned)qi ^ att_f(rho_)); \
                ATT_DMA((const char*)(ksrc_ + (size_t)((cls_) + ((pos0_ + kidx_) << dsh_)) * D) + coff_, (unsigned)(size_t)KW + (unsigned)(slot_ * 8192 + i_ * 1024)); \
                ATT_DMA((const char*)(vsrc_ + (size_t)((cls_) + ((pos0_ + (int)rho_) << dsh_)) * D) + coff_, vw_a + (unsigned)(slot_ * 8192 + i_ * 1024)); } } } while (0)
    int beta = 0;
    bf16x8 Qn[4]; u32x2 Op[8]; float lsep = 0.f; bf16* qpp = Qb; float* lsepp = LSE;
#pragma unroll
    for (int dt = 0; dt < 8; ++dt) Op[dt] = (u32x2){0u, 0u};
#pragma unroll
    for (int kt = 0; kt < 4; ++kt) Qn[kt] = (bf16x8){0, 0, 0, 0, 0, 0, 0, 0};
    for (int n = n0; n < n1; ++n) {
        ATT_DECODE(n, g, b, hs, cls, chunk)
        const int dsh = 2 * g, Lg = SEQ >> dsh; const int P0 = 128 * chunk;
        asm volatile("s_waitcnt lgkmcnt(0)" ::: "memory"); __builtin_amdgcn_s_barrier(); asm volatile("" ::: "memory");
        const int Pq = P0 + 16 * wave + qi; const size_t qrow = (size_t)g * T + (size_t)b * SEQ + (size_t)(cls + (Pq << dsh));
        bf16* qp = Qb + qrow * D + hs * 128;
        bf16x8 Qf[4];
        if (n == n0) {
            ATT_LOAD_TILES(g, b, hs, cls, chunk, 0, 2, beta); ATT_LOAD_TILES(g, b, hs, cls, chunk, 2, 2, beta); ATT_LOAD_TILES(g, b, hs, cls, chunk, 4, 2, beta); ATT_LOAD_TILES(g, b, hs, cls, chunk, 6, 2, beta);
#pragma unroll
            for (int kt = 0; kt < 4; ++kt) Qf[kt] = *(const bf16x8*)(qp + 8 * q4 + 32 * kt);
        } else {
#pragma unroll
            for (int kt = 0; kt < 4; ++kt) Qf[kt] = Qn[kt];
        }
        const float slope2 = exp2f(-8.0f * (float)(g * 8 + hs + 1) / 24.0f) * LOG2E * (float)(1 << dsh);
        float m_run = -1e30f, l_run = 0.f; f32x4 O[8];
#pragma unroll
        for (int dt = 0; dt < 8; ++dt) O[dt] = (f32x4){0.f, 0.f, 0.f, 0.f};
        asm volatile("s_waitcnt vmcnt(0)" ::: "memory"); __builtin_amdgcn_s_barrier(); asm volatile("" ::: "memory");
        asm volatile("" : "+v"(Qf[0]), "+v"(Qf[1]), "+v"(Qf[2]), "+v"(Qf[3]));
        if (n > n0 && !dry) {
#pragma unroll
            for (int dt = 0; dt < 8; ++dt) *(u32x2*)(qpp + 4 * q4 + 16 * dt) = Op[dt];
            if (q4 == 0) *lsepp = lsep; }
        const bool has_next = (n + 1 < n1);
        if (has_next) { ATT_DECODE(n + 1, gx, bx, hsx, clsx, chunkx)
            if (chunkx == 0) ATT_LOAD_TILES(gx, bx, hsx, clsx, chunkx, 2, 2, beta + 4);
            ATT_LOAD_TILES(gx, bx, hsx, clsx, chunkx, 4, 1, beta + 4);
            const int Pqx = 128 * chunkx + 16 * wave + qi; const bf16* qx = Qb + ((size_t)gx * T + (size_t)bx * SEQ + (size_t)(clsx + (Pqx << (2 * gx)))) * D + hsx * 128;
#pragma unroll
            for (int kt = 0; kt < 4; ++kt) Qn[kt] = *(const bf16x8*)(qx + 8 * q4 + 32 * kt); }
#pragma unroll
        for (int s = 0; s < 5; ++s) {
            const int tb = (wave >> 1) + s; const int pos0 = P0 - 64 + 32 * tb;
            if (pos0 >= 0 && pos0 < Lg) {
            const int slot = (tb + beta) % 9; const LAS unsigned char* kl = KW + slot * 8192; const unsigned voff = (unsigned)slot * 8192u;
            union { u32x4 u; bf16x8 v; } KA[4], KB[4];
            { const unsigned kla = (unsigned)(size_t)kl;
              asm volatile("ds_read_b128 %0, %8\n\tds_read_b128 %1, %9\n\tds_read_b128 %2, %10\n\tds_read_b128 %3, %11\n\t"
                           "ds_read_b128 %4, %12\n\tds_read_b128 %5, %13\n\tds_read_b128 %6, %14\n\tds_read_b128 %7, %15\n\ts_waitcnt lgkmcnt(0)"
                           : "=&v"(KA[0].u), "=&v"(KB[0].u), "=&v"(KA[1].u), "=&v"(KB[1].u), "=&v"(KA[2].u), "=&v"(KB[2].u), "=&v"(KA[3].u), "=&v"(KB[3].u)
                           : "v"(kla + ka[0][0]), "v"(kla + ka[1][0]), "v"(kla + ka[0][1]), "v"(kla + ka[1][1]), "v"(kla + ka[0][2]), "v"(kla + ka[1][2]), "v"(kla + ka[0][3]), "v"(kla + ka[1][3])
                           : "memory"); }
            f32x4 SA = {0.f, 0.f, 0.f, 0.f}, SBt = {0.f, 0.f, 0.f, 0.f};
#pragma unroll
            for (int kt = 0; kt < 4; ++kt) { SA = __builtin_amdgcn_mfma_f32_16x16x32_bf16(KA[kt].v, Qf[kt], SA, 0, 0, 0); SBt = __builtin_amdgcn_mfma_f32_16x16x32_bf16(KB[kt].v, Qf[kt], SBt, 0, 0, 0); }
            const int cb = pos0 + 8 * q4;
            float sv[8]; bool ok[8]; float mx = -1e30f;
#pragma unroll
            for (int r = 0; r < 8; ++r) { const int p = cb + r; const int rel = abs(p - Pq); ok[r] = (rel <= 64);
                const float sc = (r < 4 ? SA[r & 3] : SBt[r & 3]) - slope2 * (float)rel; sv[r] = ok[r] ? sc : -1e30f; mx = fmaxf(mx, sv[r]); }
            mx = bfly16_max(mx); mx = bfly32_max(mx);
            const float m_new = fmaxf(m_run, mx); const float alpha = __builtin_amdgcn_exp2f(m_run - m_new); m_run = m_new;
            float pe[8]; float rs = 0.f;
#pragma unroll
            for (int r = 0; r < 8; ++r) { pe[r] = ok[r] ? __builtin_amdgcn_exp2f(sv[r] - m_new) : 0.f; rs += pe[r]; }
            rs = bfly16_sum(rs); rs = bfly32_sum(rs);
            l_run = l_run * alpha + rs;
            union { u32x4 u; bf16x8 v; } pf; pf.u.x = pk2(pe[0], pe[1]); pf.u.y = pk2(pe[2], pe[3]); pf.u.z = pk2(pe[4], pe[5]); pf.u.w = pk2(pe[6], pe[7]);
#pragma unroll
            for (int hf = 0; hf < 2; ++hf) {
                u32x2 vr[4][2];
                asm volatile("ds_read_b64_tr_b16 %0, %8\n\tds_read_b64_tr_b16 %1, %9\n\tds_read_b64_tr_b16 %2, %10\n\tds_read_b64_tr_b16 %3, %11\n\t"
                             "ds_read_b64_tr_b16 %4, %12\n\tds_read_b64_tr_b16 %5, %13\n\tds_read_b64_tr_b16 %6, %14\n\tds_read_b64_tr_b16 %7, %15\n\ts_waitcnt lgkmcnt(0)"
                             : "=&v"(vr[0][0]), "=&v"(vr[0][1]), "=&v"(vr[1][0]), "=&v"(vr[1][1]), "=&v"(vr[2][0]), "=&v"(vr[2][1]), "=&v"(vr[3][0]), "=&v"(vr[3][1])
                             : "v"(va[4 * hf + 0][0] + voff), "v"(va[4 * hf + 0][1] + voff), "v"(va[4 * hf + 1][0] + voff), "v"(va[4 * hf + 1][1] + voff), "v"(va[4 * hf + 2][0] + voff), "v"(va[4 * hf + 2][1] + voff), "v"(va[4 * hf + 3][0] + voff), "v"(va[4 * hf + 3][1] + voff)
                             : "memory");
#pragma unroll
                for (int c = 0; c < 4; ++c) { const int dt = 4 * hf + c; union { u32x4 u; bf16x8 v; } vf; vf.u.x = vr[c][0].x; vf.u.y = vr[c][0].y; vf.u.z = vr[c][1].x; vf.u.w = vr[c][1].y;
                    O[dt] = O[dt] * alpha; O[dt] = __builtin_amdgcn_mfma_f32_16x16x32_bf16(vf.v, pf.v, O[dt], 0, 0, 0); }
            }
            }
            if (s == 1 || s == 2) {
                asm volatile("s_waitcnt lgkmcnt(0)" ::: "memory"); __builtin_amdgcn_s_barrier(); asm volatile("" ::: "memory");
                if (has_next) { ATT_DECODE(n + 1, gy, by, hsy, clsy, chunky) if (s == 1) ATT_LOAD_TILES(gy, by, hsy, clsy, chunky, 5, 2, beta + 4); else ATT_LOAD_TILES(gy, by, hsy, clsy, chunky, 7, 1, beta + 4); }
            }
        }
        const float inv = 1.0f / l_run;
#pragma unroll
        for (int dt = 0; dt < 8; ++dt) { Op[dt].x = pk2(O[dt][0] * inv, O[dt][1] * inv); Op[dt].y = pk2(O[dt][2] * inv, O[dt][3] * inv); if (dry) asm volatile("" :: "v"(Op[dt].x), "v"(Op[dt].y)); }
        lsep = m_run + __builtin_amdgcn_logf(l_run); qpp = qp; lsepp = LSE + qrow * 8 + hs;
        beta = (beta + 4) % 9;
    }
    if (n1 > n0 && !dry) {
#pragma unroll
        for (int dt = 0; dt < 8; ++dt) *(u32x2*)(qpp + 4 * q4 + 16 * dt) = Op[dt];
        if (q4 == 0) *lsepp = lsep; }
#undef ATT_DECODE
#undef ATT_LOAD_TILES
#undef ATT_DMA
}
__device__ __forceinline__ void phase_attn_merge(Frame& F) {
    const bf16* Ob = (const bf16*)(F.ws + WS_ACT + A_Q); const float* LSE = (const float*)(F.ws + WS_SB); bf16* AO = (bf16*)(F.ws + WS_ACT + A_AO);
    u32x2 orr[3][4]; float lsr[3][4];
#define AM_LOAD(row_) do { _Pragma("unroll") for (int q = 0; q < 4; ++q) { const int c = 4 * F.lane + 256 * q; const int head = 2 * q + (F.lane >> 5); \
        _Pragma("unroll") for (int g = 0; g < 3; ++g) { orr[g][q] = *(const u32x2*)(Ob + ((size_t)g * T + (row_)) * D + c); lsr[g][q] = LSE[((size_t)g * T + (row_)) * 8 + head]; } } } while (0)
    if (F.gw < T) AM_LOAD(F.gw);
#pragma clang loop unroll(disable)
    for (int row = F.gw; row < T; row += F.NGW) {
        u32x2 co[3][4]; float cl[3][4];
#pragma unroll
        for (int q = 0; q < 4; ++q)
#pragma unroll
            for (int g = 0; g < 3; ++g) { co[g][q] = orr[g][q]; cl[g][q] = lsr[g][q]; }
        { const int rn = (row + F.NGW < T) ? row + F.NGW : row; AM_LOAD(rn); }
        f32x4 o[4];
#pragma unroll
        for (int q = 0; q < 4; ++q) {
            const float mx = fmaxf(cl[0][q], fmaxf(cl[1][q], cl[2][q]));
            float w[3]; float sum = 0.f;
#pragma unroll
            for (int g = 0; g < 3; ++g) { w[g] = __builtin_amdgcn_exp2f(cl[g][q] - mx); sum += w[g]; }
            const float inv = 1.0f / sum; f32x4 acc = {0.f, 0.f, 0.f, 0.f};
#pragma unroll
            for (int g = 0; g < 3; ++g) { const u32x2 r = co[g][q]; const float a = w[g] * inv;
                acc[0] += a * bf_lo(r.x); acc[1] += a * bf_hi(r.x); acc[2] += a * bf_lo(r.y); acc[3] += a * bf_hi(r.y); }
            o[q] = acc; }
        row_store_bf16(AO + (size_t)row * D, F.lane, o);
    }
#undef AM_LOAD
}

constexpr int PH_PER_LAYER = 10, N_PHASES = 1 + DEPTH * PH_PER_LAYER + 1;
template <int MASK> __global__ void __launch_bounds__(NTHREADS, 2) mk_fwd(Args args) {
    extern __shared__ __attribute__((aligned(16))) unsigned char lds_raw[];
#define PHASE_FRAME() Frame F; { int t_ = wave0 * 64 + lane_id_nh(); asm volatile("" : "+v"(t_)); size_t z_ = 0; asm volatile("" : "+s"(z_)); unsigned char* w_ = args.ws + z_;     \
        unsigned lb_ = 0; asm volatile("" : "+s"(lb_)); F.lds = (LAS unsigned char*)lds_raw + lb_; F.tid = t_; F.lane = t_ & 63; F.wave = __builtin_amdgcn_readfirstlane(t_ >> 6); \
        F.G = gridDim.x; F.gw = blockIdx.x * NWAVES + F.wave; F.NGW = F.G * NWAVES; F.ws = w_; F.in = args.in; F.out = args.out; }
    LAS unsigned char* lds0 = (LAS unsigned char*)lds_raw;
    const int wave0 = __builtin_amdgcn_readfirstlane((int)threadIdx.x >> 6);
    volatile LAS unsigned* MISC = (volatile LAS unsigned*)(lds0 + MISC_OFF);
    if (wave0 == 0) ((LAS unsigned*)(lds0 + LDS_MISC))[lane_id_nh() + 64] = 0u;
    __syncthreads();
    unsigned* ctl = (unsigned*)(args.ws + WS_CTL);
    XcdBarrier bar; bar.bar = ctl + CW_BAR; bar.x = 0; bar.st = nullptr;
#if ONE_LAUNCH
    bar = xcd_barrier_post(ctl + CW_BAR, MISC + 8, wave0 == 0 && lane_id_nh() == 0);
#endif
    const int lo = args.ph_lo, hi = args.ph_hi;
#define EN(b) ((MASK >> (b)) & 1)
#ifndef DUP_MASK
#define DUP_MASK 0
#endif
#define REP(b) for (int rep_ = 0; rep_ < 1 + ((DUP_MASK >> (b)) & 1); ++rep_)
#define IN(k) (lo <= (k) && (k) < hi)
#if ONE_LAUNCH
#ifndef BAR_REP
#define BAR_REP 1
#endif
#define SEAM(k) do { if (IN((k) + 1) || (k) + 1 < hi) { for (int br_ = 0; br_ < BAR_REP; ++br_) xcd_barrier(bar, wave0 == 0 && lane_id_nh() == 0); } } while (0)
#else
#define SEAM(k) do { } while (0)
#endif
    bf16* X0 = (bf16*)(args.ws + WS_X1); bf16* X1 = X0 + (size_t)T * D;
    if (EN(0) && IN(0)) { PHASE_FRAME(); REP(0) phase_prologue(F); SEAM(0); }
    for (int l = 0; l < DEPTH; ++l) {
        const int pb = 1 + l * PH_PER_LAYER; const int j = l >> 1;
        const void* xin = (l == 0) ? (const void*)args.in[I_X] : (const void*)((l & 1) ? X0 : X1);
        bf16* xcur = (l == 0) ? X0 : ((l & 1) ? X1 : X0);
        if ((l & 1) == 0) {
            if (EN(1) && IN(pb + 0)) { PHASE_FRAME(); REP(1) { if (l == 0) phase_rw_norm<true>(F, l, xin, xcur); else phase_rw_norm<false>(F, l, xin, xcur); } SEAM(pb + 0); }
            if (EN(2) && IN(pb + 1)) { REP(2) {
                { PHASE_FRAME(); DenseSched S; S.o.init(T / 256, 2, F.G, blockIdx.x); S.A = (const char*)(F.ws + WS_ACT + A_HX); S.a_sel_stride = 0; S.pn_per_a = 1 << 20;
                  S.B = (const char*)(F.ws + WS_W + j * W_RW_STRIDE + W_LDN); S.tstepA = (size_t)256 * 2048 * 2; S.tstepB = (size_t)256 * 2048 * 2;
                  EpiLoraDn E{(bf16*)(F.ws + WS_ACT + A_LORAH)};
                  pg8::gemm_phase(F.lds, F.tid, 2048, 2048, 2048, S, E); }
                { PHASE_FRAME(); DenseSched S; S.o.init(T / 256, 12, F.G, blockIdx.x); S.o.uneven = (F.G == 256); S.A = (const char*)(F.ws + WS_ACT + A_XS); S.a_sel_stride = (size_t)T * D; S.pn_per_a = 4;
                  S.B = (const char*)(F.ws + WS_W + j * W_RW_STRIDE + W_RKV); S.tstepA = (size_t)256 * D; S.tstepB = (size_t)256 * D;
                  EpiI8<EpiSplit> E{EpiSplit{(bf16*)(F.ws + WS_ACT + A_RKV), (size_t)T * D, 1.0f}, (const float*)(F.ws + WS_SCL + SCL_XS), (size_t)T, 4, (const float*)(F.ws + WS_W + j * W_RW_STRIDE + W_RKVS)};
                  pg8::gemm_phase(F.lds, F.tid, D, D, D, S, E); }
                }
                SEAM(pb + 1);
            }
            if (EN(3) && IN(pb + 2)) { REP(3) {
                { PHASE_FRAME(); DenseSched S; S.o.init(T / 256, 16, F.G, blockIdx.x); S.A = (const char*)(F.ws + WS_ACT + A_LORAH); S.a_sel_stride = 256; S.pn_per_a = 8;
                  S.B = (const char*)(F.ws + WS_W + j * W_RW_STRIDE + W_LUPWA); S.tstepA = (size_t)256 * 512 * 2; S.tstepB = (size_t)256 * 128 * 2;
                  EpiLoraUpWA E{(bf16*)(F.ws + WS_ACT + A_LDEC), (bf16*)(F.ws + WS_ACT + A_ASIG), F.in[I_W0] + j * 2 * D, F.in[I_A0] + j * 2 * D};
                  pg8::gemm_phase(F.lds, F.tid, 128, 512, 128, S, E); }
                { PHASE_FRAME(); DenseSched S; S.o.init(T / 256, 8, F.G, blockIdx.x); S.A = (const char*)(F.ws + WS_ACT + A_LORAH) + 512; S.a_sel_stride = 256; S.pn_per_a = 4;
                  S.B = (const char*)(F.ws + WS_W + j * W_RW_STRIDE + W_LUPG); S.tstepA = (size_t)256 * 512 * 2; S.tstepB = (size_t)256 * 128 * 2;
                  EpiSplit E{(bf16*)(F.ws + WS_ACT + A_G), (size_t)T * D, 1.0f};
                  pg8::gemm_phase(F.lds, F.tid, 128, 512, 128, S, E); }
                }
                SEAM(pb + 2);
            }
            if (EN(4) && IN(pb + 3)) { PHASE_FRAME(); REP(4) phase_scan(F, l); SEAM(pb + 3); }
            if (EN(5) && IN(pb + 4)) { PHASE_FRAME(); REP(5) phase_rw_post(F, l); SEAM(pb + 4); }
            if (EN(6) && IN(pb + 5)) { PHASE_FRAME();
                DenseSched S; S.o.init(T / 256, 4, F.G, blockIdx.x); S.A = (const char*)(F.ws + WS_ACT + A_O); S.a_sel_stride = 0; S.pn_per_a = 1 << 20;
                S.B = (const char*)(F.ws + WS_W + j * W_RW_STRIDE + W_RWO); S.tstepA = (size_t)256 * D * 2; S.tstepB = (size_t)256 * D * 2;
                EpiResid E{(l == 0) ? (const void*)F.in[I_X] : (const void*)xcur, (l == 0) ? 1 : 0, xcur, (const float*)(F.ws + WS_MOD) + (size_t)l * 8 * 6144 + 2 * D};
                pg8::gemm_phase(F.lds, F.tid, D, D, D, S, E);
                SEAM(pb + 5);
            }
        } else {
            if (EN(7) && IN(pb + 0)) { PHASE_FRAME(); REP(7) phase_at_norm(F, l, (const bf16*)xin, xcur); SEAM(pb + 0); }
            if (EN(8) && IN(pb + 1)) { PHASE_FRAME(); REP(8) {
                DenseSched S; S.o.init(T / 256, 36, F.G, blockIdx.x); S.A = (const char*)(F.ws + WS_ACT + A_H); S.a_sel_stride = 0; S.pn_per_a = 1 << 20;
                S.B = (const char*)(F.ws + WS_WA + j * W_AT_STRIDE + W_QKV); S.tstepA = (size_t)256 * D; S.tstepB = (size_t)256 * D;
                EpiQKV8 E{(bf16*)(F.ws + WS_ACT + A_Q), (const float*)(F.ws + WS_SA), (const float*)(F.ws + WS_WA + j * W_AT_STRIDE + W_QKVS), 0.08838834764831845f * LOG2E};
                pg8::gemm_phase(F.lds, F.tid, D, D, D, S, E);
                }
                SEAM(pb + 1);
            }
            if (EN(9) && IN(pb + 2)) { PHASE_FRAME(); if ((DUP_MASK >> 9) & 1) phase_attn(F, true); phase_attn(F); SEAM(pb + 2); }
            if (EN(16) && IN(pb + 3)) { PHASE_FRAME(); REP(16) phase_attn_merge(F); SEAM(pb + 3); }
            if (EN(10) && IN(pb + 4)) { PHASE_FRAME();
                DenseSched S; S.o.init(T / 256, 4, F.G, blockIdx.x); S.A = (const char*)(F.ws + WS_ACT + A_AO); S.a_sel_stride = 0; S.pn_per_a = 1 << 20;
                S.B = (const char*)(F.ws + WS_WA + j * W_AT_STRIDE + W_AWO); S.tstepA = (size_t)256 * D * 2; S.tstepB = (size_t)256 * D * 2;
                EpiResid E{(const void*)xcur, 0, xcur, (const float*)(F.ws + WS_MOD) + (size_t)l * 8 * 6144 + 2 * D};
                pg8::gemm_phase(F.lds, F.tid, D, D, D, S, E);
                SEAM(pb + 4);
            }
        }
        if (EN(11) && IN(pb + 6)) { PHASE_FRAME(); if ((DUP_MASK >> 11) & 1) phase_moe_route(F, l, xcur, 4); phase_moe_route(F, l, xcur); SEAM(pb + 6); }
        if (EN(13) && IN(pb + 8)) { PHASE_FRAME();
            moe_tables(F, l);
            MoeGatherSched S; S.tileE = (const LAS int*)(F.lds + TILEE_OFF); S.ntiles = uni(S.tileE[160]); S.G = F.G; S.c = blockIdx.x;
            S.A = (const char*)(F.ws + WS_ACT + A_HN2); S.B = (const char*)(F.ws + ws_wm_of(l) + W_GU); S.tstepB = (size_t)256 * D; S.estride = (size_t)512 * D;
            LAS int* rt = (LAS int*)(F.lds + MOE_TAB); LAS float* wt = (LAS float*)(F.lds + MOE_TAB + 3072); LAS float* st = (LAS float*)(F.lds + MOE_TAB + 6144); S.rowtab = rt;
            { const LAS int* tileJ = (const LAS int*)(F.lds + TILEJ_OFF); const LAS int* cl = (const LAS int*)(F.lds + CNTL_OFF);
              const int* lstT = (const int*)(F.ws + WS_ACT + A_LSTT); const float* lstW = (const float*)(F.ws + WS_ACT + A_LSTW); const float* sat = (const float*)(F.ws + WS_SCL + SCL_HN);
              for (int i = F.tid; i < 3 * 256; i += NTHREADS) { const int L = (i >> 8) * F.G + (int)blockIdx.x; int tok = 0; float w = 0.f;
                  if (L < S.ntiles * 2) { const int m = L >> 1, e = S.tileE[m], rk = tileJ[m] * 256 + (i & 255); if (rk < cl[e]) { tok = lstT[(size_t)e * LCAP + rk]; w = lstW[(size_t)e * LCAP + rk]; } }
                  rt[i] = tok; wt[i] = w; st[i] = sat[tok]; }
              __syncthreads(); }
            EpiGateUp8 E{(bf16*)(F.ws + WS_ACT + A_HID), wt, st, (const float*)(F.ws + ws_wm_of(l) + W_GUS), (const LAS int*)(F.lds + TILEE_OFF)};
            pg8::gemm_phase(F.lds, F.tid, D, D, D, S, E);
            if (l + 1 < DEPTH) {
                const int nun = S.ntiles * 2, firstb = (nun > F.G) ? (nun - F.G) : 0;
                if ((int)blockIdx.x >= firstb) moe_convert(F, l + 1, (int)blockIdx.x - firstb, F.G - firstb);
            }
            SEAM(pb + 8);
        }
        if (EN(14) && IN(pb + 9)) { PHASE_FRAME(); REP(14) {
            moe_tables(F, l);
            MoeSched S; S.tileE = (const LAS int*)(F.lds + TILEE_OFF); S.ntiles = uni(S.tileE[160]); S.npn = 4; S.G = F.G; S.c = blockIdx.x;
            S.A = (const char*)(F.ws + WS_ACT + A_HID); S.B = (const char*)(F.ws + ws_wm_of(l) + W_DN); S.tstepA = (size_t)256 * FEXP * 2; S.tstepB = (size_t)256 * FEXP * 2; S.estride = (size_t)D * FEXP * 2;
            EpiPlain E{(bf16*)(F.ws + WS_ACT + A_YS)};
            pg8::gemm_phase(F.lds, F.tid, FEXP, FEXP, FEXP, S, E);
            }
            SEAM(pb + 9);
        }
    }
    if (EN(15) && IN(N_PHASES - 1)) { PHASE_FRAME(); phase_final(F, X1); }
#undef IN
#undef SEAM
}

typedef void (*kern_t)(Args);
template <int B> static kern_t kern_of_bit(int b) { if (b == B) return mk_fwd<(1 << B)>; if constexpr (B > 0) return kern_of_bit<B - 1>(b); else return nullptr; }
static int kind_of_phase(int p) {
    if (p == 0) return 0; if (p == N_PHASES - 1) return 15;
    const int l = (p - 1) / PH_PER_LAYER, k = (p - 1) % PH_PER_LAYER;
    if (k >= 6) return (k == 7) ? -1 : 11 + (k - 6);
    if ((l & 1) == 0) return 1 + k;
    return (k < 3) ? 7 + k : (k == 3 ? 16 : (k == 4 ? 10 : -1));
}
extern "C" void kernel_launch(void* const* d_in, const int* in_sizes, int n_in, void* d_out, int out_size, void* d_ws, size_t ws_size, hipStream_t stream) {
    static int grid = 0;
    if (grid == 0) {
        if (n_in != 32 || out_size != T * D || ws_size < WS_END) { fprintf(stderr, "kernel_launch: unexpected shapes (n_in %d out %d ws %zu need %zu)\n", n_in, out_size, ws_size, (size_t)WS_END); grid = -1; return; }
        int dev = 0, cus = 0;
        if (hipGetDevice(&dev) != hipSuccess || hipDeviceGetAttribute(&cus, hipDeviceAttributeMultiprocessorCount, dev) != hipSuccess) { grid = -1; return; }
#if ONE_LAUNCH
        if (hipFuncSetAttribute((const void*)mk_fwd<0x1ffff>, hipFuncAttributeMaxDynamicSharedMemorySize, LDS_BYTES) != hipSuccess) { fprintf(stderr, "kernel_launch: hipFuncSetAttribute failed\n"); grid = -1; return; }
#else
        for (int b = 0; b < 17; ++b) if (hipFuncSetAttribute((const void*)kern_of_bit<16>(b), hipFuncAttributeMaxDynamicSharedMemorySize, LDS_BYTES) != hipSuccess) { fprintf(stderr, "kernel_launch: hipFuncSetAttribute failed\n"); grid = -1; return; }
#endif
        (void)hipGetLastError();
        grid = cus;
    }
    if (grid < 0) return;
    (void)hipMemsetAsync((char*)d_ws + WS_CTL, 0, CTL_ZERO_BYTES, stream);
    Args a{};
    for (int i = 0; i < 32; ++i) a.in[i] = (const float*)d_in[i];
    a.out = (float*)d_out; a.ws = (unsigned char*)d_ws;
#if ONE_LAUNCH
#ifndef SPLIT_EVERY
#define SPLIT_EVERY N_PHASES
#endif
    for (int p = 0; p < N_PHASES; p += SPLIT_EVERY) {
        a.ph_lo = p; a.ph_hi = (p + SPLIT_EVERY < N_PHASES) ? p + SPLIT_EVERY : N_PHASES;
        hipLaunchKernelGGL(mk_fwd<0x1ffff>, dim3(grid), dim3(NTHREADS), LDS_BYTES, stream, a);
    }
#else
    for (int p = 0; p < N_PHASES; ++p) {
        const int kind = kind_of_phase(p); if (kind < 0) continue;
        a.ph_lo = p; a.ph_hi = p + 1;
        hipLaunchKernelGGL(kern_of_bit<16>(kind), dim3(grid), dim3(NTHREADS), LDS_BYTES, stream, a);
    }
#endif
}
```
